# Optimizing an MI355X kernel written in HIP

```python
import jax, jax.numpy as jnp
from jax import lax
import numpy as np

D_MODEL = 1024
BATCH = 32
SEQ = 2048
DEPTH = 1

CTX_LEN = 256
GRID_W = 64
MIX_WIDTH = D_MODEL
HG_WIDTH = MIX_WIDTH // 2
HG_HEADS = 4
HG_DK = HG_WIDTH // HG_HEADS
HG_CHUNK = 32
RG_WIDTH = MIX_WIDTH - HG_WIDTH
RG_HEADS = 8
RG_HD = RG_WIDTH // RG_HEADS
RG_CONV = 4
RG_PAD_L = 2
RG_PAD_R = RG_CONV - 1 - RG_PAD_L
RG_C = 8.0
IN_WIDTH = 5 * HG_WIDTH + 2 * RG_WIDTH
N_EXPERTS = 32
TOP_K = 4
D_FF = D_MODEL
SWIGLU_LIMIT = 7.0
SWIGLU_ALPHA = 1.702
MOE_BLOCK = 128
EPS = 1e-6

kernel_name = 'hymba_hgrn2_rglru_moe_dit_layer'


def rmsnorm(x, w):
    xf = x.astype(jnp.float32)
    y = xf * lax.rsqrt(jnp.mean(xf * xf, axis=-1, keepdims=True) + EPS)
    return (y * w.astype(jnp.float32)).astype(x.dtype)


def modulate(h, shift, scale):
    return h * (1.0 + scale) + shift


def to_colmajor(a, rows):
    b, t, ch = a.shape
    return a.reshape(b, rows, GRID_W, ch).transpose(0, 2, 1, 3).reshape(b, t, ch)


def from_colmajor(a, rows):
    b, t, ch = a.shape
    return a.reshape(b, GRID_W, rows, ch).transpose(0, 2, 1, 3).reshape(b, t, ch)


def gla_chunked(q, k, v, log_f, s0):
    bn, t, h, _ = q.shape
    dv = v.shape[-1]
    n_chunks = t // HG_CHUNK

    def chunks(a):
        a = a.astype(jnp.float32).reshape(bn, n_chunks, HG_CHUNK, h, a.shape[-1])
        return jnp.moveaxis(a, 1, 0)

    mask = jnp.tril(jnp.ones((HG_CHUNK, HG_CHUNK), dtype=bool))

    def step(s, xs):
        qc, kc, vc, gc = xs
        bcum = jnp.cumsum(gc, axis=1)
        blast = bcum[:, -1]
        q_dec = qc * jnp.exp(bcum)
        k_dec = kc * jnp.exp(-bcum)
        scores = jnp.einsum('bchk,bjhk->bhcj', q_dec, k_dec)
        scores = jnp.where(mask[None, None], scores, 0.0)
        o = jnp.einsum('bhcj,bjhv->bchv', scores, vc) + jnp.einsum('bchk,bhkv->bchv', q_dec, s)
        k_end = kc * jnp.exp(blast[:, None] - bcum)
        s = jnp.exp(blast)[..., None] * s + jnp.einsum('bjhk,bjhv->bhkv', k_end, vc)
        return s, o

    s_final, o = lax.scan(step, s0, (chunks(q), chunks(k), chunks(v), chunks(log_f)))
    return jnp.moveaxis(o, 0, 1).reshape(bn, t, h, dv), s_final


def hgrn2_direction(q, v, f_logit, lb, s0, reverse):
    if reverse:
        q, v, f_logit = q[:, ::-1], v[:, ::-1], f_logit[:, ::-1]
    b, t = f_logit.shape[:2]
    f = lb + (1.0 - lb) * jax.nn.sigmoid(f_logit.astype(jnp.float32))
    k = (1.0 - f).reshape(b, t, HG_HEADS, HG_DK)
    log_f = jnp.log(f).reshape(b, t, HG_HEADS, HG_DK)
    o, s = gla_chunked(q, k, v, log_f, s0)
    if reverse:
        o = o[:, ::-1]
    return o, s


def hgrn2_group(hq, hi, hf_fwd, hf_bwd, hg, lb, norm_w, s0_fwd, s0_bwd):
    b, t, _ = hq.shape
    q = jax.nn.silu(hq).reshape(b, t, HG_HEADS, HG_DK)
    v = hi.reshape(b, t, HG_HEADS, HG_DK)
    o_f, s_f = hgrn2_direction(q, v, hf_fwd, lb[0], s0_fwd, False)
    o_b, s_b = hgrn2_direction(q, v, hf_bwd, lb[1], s0_bwd, True)
    o = o_f + o_b
    o = o * lax.rsqrt(jnp.mean(o * o, axis=-1, keepdims=True) + EPS)
    o = o * norm_w.astype(jnp.float32).reshape(HG_HEADS, HG_DK)
    o = o.reshape(b, t, HG_WIDTH).astype(hq.dtype) * jax.nn.silu(hg)
    return o, s_f, s_b


def centred_dwconv(x, w, bias):
    t = x.shape[1]
    xp = jnp.pad(x, ((0, 0), (RG_PAD_L, RG_PAD_R), (0, 0)))
    y = bias
    for j in range(RG_CONV):
        y = y + xp[:, j:j + t] * w[j]
    return y


def linear_scan(a, bx, h0):
    def combine(e1, e2):
        a1, b1 = e1
        a2, b2 = e2
        return a1 * a2, a2 * b1 + b2
    a_cum, b_cum = lax.associative_scan(combine, (a, bx), axis=1)
    return a_cum * h0[:, None] + b_cum


def rglru_direction(xc, wa, ba, wx, bx, lam, h0, reverse):
    if reverse:
        xc = xc[:, ::-1]
    b, t, ch = xc.shape
    xh = xc.reshape(b, t, RG_HEADS, RG_HD)
    r = jax.nn.sigmoid((jnp.einsum('bthi,hij->bthj', xh, wa).reshape(b, t, ch) + ba).astype(jnp.float32))
    ig = jax.nn.sigmoid((jnp.einsum('bthi,hij->bthj', xh, wx).reshape(b, t, ch) + bx).astype(jnp.float32))
    log_a = -RG_C * jax.nn.softplus(-lam.astype(jnp.float32)) * r
    a = jnp.exp(log_a)
    mult = jnp.sqrt(-jnp.expm1(2.0 * log_a))
    h = linear_scan(a, mult * ig * xc.astype(jnp.float32), h0)
    h_last = h[:, -1]
    if reverse:
        h = h[:, ::-1]
    return h, h_last


def rglru_group(rx, rgate, conv_w, conv_b, wa, ba, wx, bx, lam, h0_fwd, h0_bwd):
    xc = centred_dwconv(rx, conv_w, conv_b)
    h_f, s_f = rglru_direction(xc, wa[0], ba[0], wx[0], bx[0], lam[0], h0_fwd, False)
    h_b, s_b = rglru_direction(xc, wa[1], ba[1], wx[1], bx[1], lam[1], h0_bwd, True)
    y = jax.nn.gelu(rgate) * (h_f + h_b).astype(rx.dtype)
    return y, s_f, s_b


def hybrid_mixer(h_lat, h_ctx, rows, need_ctx_out, w_in, lb, hg_norm_w, conv_w, conv_b,
                 wa, ba, wx, bx, lam, w_out):
    cuts = [HG_WIDTH, 2 * HG_WIDTH, 3 * HG_WIDTH, 4 * HG_WIDTH, 5 * HG_WIDTH, 5 * HG_WIDTH + RG_WIDTH]
    cq, ci, cff, cfb, cg, crx, crg = jnp.split(h_ctx @ w_in, cuts, axis=-1)
    lq, li, lff, lfb, lg, lrx, lrg = jnp.split(h_lat @ w_in, cuts, axis=-1)
    b = h_ctx.shape[0]
    s_zero = jnp.zeros((b, HG_HEADS, HG_DK, HG_DK), jnp.float32)
    h_zero = jnp.zeros((b, RG_WIDTH), jnp.float32)
    hg_ctx, s_ctx_f, s_ctx_b = hgrn2_group(cq, ci, cff, cfb, cg, lb, hg_norm_w, s_zero, s_zero)
    rg_ctx, h_ctx_f, h_ctx_b = rglru_group(crx, crg, conv_w, conv_b, wa, ba, wx, bx, lam, h_zero, h_zero)
    hg_lat, _, _ = hgrn2_group(lq, li, lff, lfb, lg, lb, hg_norm_w, s_ctx_f, s_ctx_b)
    rg_lat, _, _ = rglru_group(to_colmajor(lrx, rows), to_colmajor(lrg, rows), conv_w, conv_b,
                               wa, ba, wx, bx, lam, h_ctx_f, h_ctx_b)
    rg_lat = from_colmajor(rg_lat, rows)
    o_lat = jnp.concatenate([hg_lat, rg_lat], axis=-1) @ w_out
    o_ctx = jnp.concatenate([hg_ctx, rg_ctx], axis=-1) @ w_out if need_ctx_out else None
    return o_lat, o_ctx


def expert_swiglu(xb, wgu, bgu, wd, bd):
    gu = xb @ wgu + bgu
    gate, up = gu[:, :D_FF], gu[:, D_FF:]
    gate = jnp.minimum(gate, SWIGLU_LIMIT)
    up = jnp.clip(up, -SWIGLU_LIMIT, SWIGLU_LIMIT)
    glu = gate * jax.nn.sigmoid(SWIGLU_ALPHA * gate)
    return (glu * (up + 1.0)) @ wd + bd


def moe_ffn(h, router_w, router_b, w_gate_up, b_gate_up, w_down, b_down):
    bn, t, d = h.shape
    xf = h.reshape(bn * t, d)
    n_tok = bn * t
    n_assign = n_tok * TOP_K
    logits = (xf @ router_w + router_b).astype(jnp.float32)
    top_val, top_idx = lax.top_k(logits, TOP_K)
    gates = jax.nn.softmax(top_val, axis=-1)
    e_flat = top_idx.reshape(-1)
    order = jnp.argsort(e_flat)
    e_sorted = e_flat[order]
    tok_sorted = (order // TOP_K).astype(jnp.int32)
    w_sorted = gates.reshape(-1)[order].astype(h.dtype)
    counts = jnp.bincount(e_flat, length=N_EXPERTS)
    padded = (counts + MOE_BLOCK - 1) // MOE_BLOCK * MOE_BLOCK
    pad_end = jnp.cumsum(padded)
    pad_start = pad_end - padded
    cnt_start = jnp.cumsum(counts) - counts
    dest = pad_start[e_sorted] + jnp.arange(n_assign) - cnt_start[e_sorted]
    n_blocks = -(-n_assign // MOE_BLOCK) + N_EXPERTS
    n_slots = n_blocks * MOE_BLOCK
    slot_tok = jnp.full((n_slots,), n_tok, jnp.int32).at[dest].set(tok_sorted)
    slot_w = jnp.zeros((n_slots,), h.dtype).at[dest].set(w_sorted)
    block_expert = jnp.minimum(
        jnp.searchsorted(pad_end, jnp.arange(n_blocks) * MOE_BLOCK, side='right'), N_EXPERTS - 1)
    x_src = jnp.concatenate([xf, jnp.zeros((1, d), xf.dtype)], axis=0)

    def block_step(acc, blk):
        start = blk * MOE_BLOCK
        tok = lax.dynamic_slice(slot_tok, (start,), (MOE_BLOCK,))
        wgt = lax.dynamic_slice(slot_w, (start,), (MOE_BLOCK,))
        e = block_expert[blk]
        y = expert_swiglu(x_src[tok], w_gate_up[e], b_gate_up[e], w_down[e], b_down[e])
        return acc.at[tok].add(wgt[:, None] * y.astype(acc.dtype)), None

    acc, _ = lax.scan(block_step, jnp.zeros((n_tok + 1, d), xf.dtype), jnp.arange(n_blocks))
    return acc[:n_tok].reshape(bn, t, d)


def setup_inputs(seed: int = 0) -> dict:
    key = jax.random.key(seed)
    ks = jax.random.split(key, 26)
    nrm = lambda k, shape, s: jax.random.normal(k, shape, jnp.float32) * s
    a0 = jax.random.uniform(ks[17], (DEPTH, 2, RG_WIDTH), jnp.float32, 0.9, 0.999)
    s_lam = a0 ** (1.0 / RG_C)
    return {
        'x': nrm(ks[0], (BATCH, SEQ, D_MODEL), 1.0),
        'c': nrm(ks[1], (BATCH, D_MODEL), 1.0),
        'ctx': nrm(ks[2], (BATCH, CTX_LEN, D_MODEL), 1.0),
        'c_ctx': nrm(ks[3], (D_MODEL,), 1.0),
        'norm1_w': 1.0 + nrm(ks[4], (DEPTH, D_MODEL), 0.01),
        'norm2_w': 1.0 + nrm(ks[5], (DEPTH, D_MODEL), 0.01),
        'w_ada': nrm(ks[6], (DEPTH, D_MODEL, 6 * D_MODEL), D_MODEL ** -0.5),
        'b_ada': nrm(ks[7], (DEPTH, 6 * D_MODEL), 0.01),
        'w_in': nrm(ks[8], (DEPTH, D_MODEL, IN_WIDTH), D_MODEL ** -0.5),
        'hg_lb_logits': nrm(ks[9], (DEPTH + 1, 2, HG_WIDTH), 0.1),
        'hg_norm_w': 1.0 + nrm(ks[10], (DEPTH, HG_WIDTH), 0.01),
        'rg_conv_w': nrm(ks[11], (DEPTH, RG_CONV, RG_WIDTH), RG_CONV ** -0.5),
        'rg_conv_b': nrm(ks[12], (DEPTH, RG_WIDTH), 0.01),
        'rg_wa': nrm(ks[13], (DEPTH, 2, RG_HEADS, RG_HD, RG_HD), RG_HD ** -0.5),
        'rg_ba': nrm(ks[14], (DEPTH, 2, RG_WIDTH), 0.01),
        'rg_wx': nrm(ks[15], (DEPTH, 2, RG_HEADS, RG_HD, RG_HD), RG_HD ** -0.5),
        'rg_bx': nrm(ks[16], (DEPTH, 2, RG_WIDTH), 0.01),
        'rg_lambda': jnp.log(s_lam) - jnp.log1p(-s_lam),
        'w_out': nrm(ks[18], (DEPTH, MIX_WIDTH, D_MODEL), MIX_WIDTH ** -0.5),
        'router_w': nrm(ks[19], (DEPTH, D_MODEL, N_EXPERTS), D_MODEL ** -0.5),
        'router_b': nrm(ks[20], (DEPTH, N_EXPERTS), 0.01),
        'w_gate_up': nrm(ks[21], (DEPTH, N_EXPERTS, D_MODEL, 2 * D_FF), D_MODEL ** -0.5),
        'b_gate_up': nrm(ks[22], (DEPTH, N_EXPERTS, 2 * D_FF), 0.01),
        'w_down': nrm(ks[23], (DEPTH, N_EXPERTS, D_FF, D_MODEL), D_FF ** -0.5),
        'b_down': nrm(ks[24], (DEPTH, N_EXPERTS, D_MODEL), 0.01),
        'final_norm_w': 1.0 + nrm(ks[25], (D_MODEL,), 0.01),
    }


def reference(x, c, ctx, c_ctx, norm1_w, norm2_w, w_ada, b_ada, w_in, hg_lb_logits, hg_norm_w,
              rg_conv_w, rg_conv_b, rg_wa, rg_ba, rg_wx, rg_bx, rg_lambda, w_out, router_w, router_b,
              w_gate_up, b_gate_up, w_down, b_down, final_norm_w):
    rows = x.shape[1] // GRID_W
    lb_all = jnp.cumsum(jax.nn.softmax(hg_lb_logits.astype(jnp.float32), axis=0), axis=0)
    silu_c = jax.nn.silu(c)
    silu_cc = jax.nn.silu(c_ctx)
    for l in range(DEPTH):
        mod = silu_c @ w_ada[l] + b_ada[l]
        mod_c = silu_cc @ w_ada[l] + b_ada[l]
        sh1, sc1, g1, sh2, sc2, g2 = [m[:, None] for m in jnp.split(mod, 6, axis=-1)]
        csh1, csc1, cg1, csh2, csc2, cg2 = jnp.split(mod_c, 6, axis=-1)
        last = l == DEPTH - 1
        h_lat = modulate(rmsnorm(x, norm1_w[l]), sh1, sc1)
        h_ctx = modulate(rmsnorm(ctx, norm1_w[l]), csh1, csc1)
        o_lat, o_ctx = hybrid_mixer(h_lat, h_ctx, rows, not last, w_in[l], lb_all[l], hg_norm_w[l],
                                    rg_conv_w[l], rg_conv_b[l], rg_wa[l], rg_ba[l], rg_wx[l], rg_bx[l],
                                    rg_lambda[l], w_out[l])
        x = x + g1 * o_lat
        h2 = modulate(rmsnorm(x, norm2_w[l]), sh2, sc2)
        x = x + g2 * moe_ffn(h2, router_w[l], router_b[l], w_gate_up[l], b_gate_up[l], w_down[l], b_down[l])
        if not last:
            ctx = ctx + cg1 * o_ctx
            hc2 = modulate(rmsnorm(ctx, norm2_w[l]), csh2, csc2)
            ctx = ctx + cg2 * moe_ffn(hc2, router_w[l], router_b[l], w_gate_up[l], b_gate_up[l],
                                      w_down[l], b_down[l])
    return rmsnorm(x, final_norm_w)
```

```cpp
#include <hip/hip_runtime.h>
#include <cstdio>
#include <cstdint>

typedef unsigned short bf16_t;
typedef unsigned int u32;

constexpr int D = 1024, NB = 32, T = 2048, CTXL = 256, GRIDW = 64, GROWS = T / GRIDW;
constexpr int NLAT = NB * T;
constexpr int NCTX = NB * CTXL;
constexpr int NROWS = NLAT + NCTX;
constexpr int HGW = 512, RGW = 512, INW = 3584;
constexpr int C_Q = 0, C_I = 512, C_FF = 1024, C_FB = 1536, C_G = 2048, C_RX = 2560, C_RG = 3072;
constexpr int NE = 32, TOPK = 4, DFF = 1024;
constexpr int HALF_TOK = NLAT / 2;
constexpr int CAP = HALF_TOK;
constexpr int MAXSLOT = HALF_TOK * TOPK + NE * 256;
constexpr float EPS = 1e-6f;

constexpr size_t MiB = 1u << 20;
constexpr size_t WS_CTL = 0;
constexpr size_t WS_MOD = 1 * MiB;
constexpr size_t WS_LB = WS_MOD + 33 * 6144 * 4;
constexpr size_t WS_TOKTAB = 2 * MiB;
constexpr size_t WS_WTAB = 10 * MiB;
constexpr size_t WS_SCR = 28 * MiB;
constexpr size_t WS_OACC = WS_SCR, WS_HACC = WS_SCR + 128 * MiB;
constexpr size_t WS_H = 284 * MiB;
constexpr size_t WS_PROJ = 428 * MiB;
constexpr size_t WS_ACT = 428 * MiB;
constexpr size_t WS_Y = 428 * MiB + 272 * MiB;

constexpr size_t WS_MIX2 = WS_H;
constexpr size_t WS_H2 = WS_SCR;

__device__ __forceinline__ float bf2f(bf16_t b) { return __uint_as_float(((u32)b) << 16); }
__device__ __forceinline__ bf16_t f2bf(float f) { u32 u = __float_as_uint(f); u += 0x7fffu + ((u >> 16) & 1u); return (bf16_t)(u >> 16); }
__device__ __forceinline__ u32 pk2(float lo, float hi) { return (u32)f2bf(lo) | ((u32)f2bf(hi) << 16); }
__device__ __forceinline__ float sigmoidf_(float x) { return 1.0f / (1.0f + __expf(-x)); }
__device__ __forceinline__ float wave_sum(float v) {
#pragma unroll
    for (int o = 1; o < 64; o <<= 1) v += __shfl_xor(v, o);
    return v;
}

__global__ __launch_bounds__(256) void k_mod(const float* __restrict__ c, const float* __restrict__ c_ctx, const float* __restrict__ w_ada,
                                             const float* __restrict__ b_ada, const float* __restrict__ lbl, float* __restrict__ mod, float* __restrict__ lb) {
    __shared__ float s[D];
    const int b = blockIdx.y, n = blockIdx.x * 256 + threadIdx.x;
    const float* cv = b < NB ? c + (size_t)b * D : c_ctx;
    for (int k = threadIdx.x; k < D; k += 256) { float v = cv[k]; s[k] = v * sigmoidf_(v); }
    __syncthreads();
    float acc = b_ada[n];
    for (int k = 0; k < D; ++k) acc += s[k] * w_ada[(size_t)k * 6144 + n];
    mod[(size_t)b * 6144 + n] = acc;
    if (blockIdx.x == 0 && blockIdx.y == 0) {
        for (int i = threadIdx.x; i < 2 * HGW; i += 256) { float l0 = lbl[i], l1 = lbl[2 * HGW + i]; lb[i] = 1.0f / (1.0f + __expf(l1 - l0)); }
    }
}

__global__ __launch_bounds__(256) void k_norm1(const float* __restrict__ x, const float* __restrict__ ctx, const float* __restrict__ nw,
                                               const float* __restrict__ mod, bf16_t* __restrict__ H) {
    const int lane = threadIdx.x & 63, r = blockIdx.x * 4 + (threadIdx.x >> 6);
    const float* src = r < NLAT ? x + (size_t)r * D : ctx + (size_t)(r - NLAT) * D;
    const float* m = mod + (size_t)(r < NLAT ? (r >> 11) : NB) * 6144;
    float4 v[4]; float ss = 0.f;
#pragma unroll
    for (int j = 0; j < 4; ++j) { v[j] = *(const float4*)(src + j * 256 + lane * 4); ss += v[j].x * v[j].x + v[j].y * v[j].y + v[j].z * v[j].z + v[j].w * v[j].w; }
    const float rstd = rsqrtf(wave_sum(ss) * (1.0f / D) + EPS);
#pragma unroll
    for (int j = 0; j < 4; ++j) {
        const int c0 = j * 256 + lane * 4;
        const float4 w = *(const float4*)(nw + c0), sh = *(const float4*)(m + c0), sc = *(const float4*)(m + 1024 + c0);
        float o0 = v[j].x * rstd * w.x * (1.f + sc.x) + sh.x, o1 = v[j].y * rstd * w.y * (1.f + sc.y) + sh.y;
        float o2 = v[j].z * rstd * w.z * (1.f + sc.z) + sh.z, o3 = v[j].w * rstd * w.w * (1.f + sc.w) + sh.w;
        uint2 p; p.x = pk2(o0, o1); p.y = pk2(o2, o3);
        *(uint2*)(H + (size_t)r * D + c0) = p;
    }
}

__device__ __forceinline__ void gemm_tile_128(const bf16_t* __restrict__ arow, const float* __restrict__ Bp, int ldb, int K, float (&acc)[8][8],
                                              float (*As)[132], float (*Bs)[132]) {
    const int t = threadIdx.x, ak = (t & 1) * 8, ar = t >> 1, bk = t >> 4, bc = (t & 15) * 8, ty = t >> 4, tx = t & 15;
    for (int k0 = 0; k0 < K; k0 += 16) {
        const uint4 av = *(const uint4*)(arow + k0 + ak);
        const float4 b0 = *(const float4*)(Bp + (size_t)(k0 + bk) * ldb + bc), b1 = *(const float4*)(Bp + (size_t)(k0 + bk) * ldb + bc + 4);
        __syncthreads();
        As[ak + 0][ar] = __uint_as_float(av.x << 16); As[ak + 1][ar] = __uint_as_float(av.x & 0xffff0000u);
        As[ak + 2][ar] = __uint_as_float(av.y << 16); As[ak + 3][ar] = __uint_as_float(av.y & 0xffff0000u);
        As[ak + 4][ar] = __uint_as_float(av.z << 16); As[ak + 5][ar] = __uint_as_float(av.z & 0xffff0000u);
        As[ak + 6][ar] = __uint_as_float(av.w << 16); As[ak + 7][ar] = __uint_as_float(av.w & 0xffff0000u);
        *(float4*)&Bs[bk][bc] = b0; *(float4*)&Bs[bk][bc + 4] = b1;
        __syncthreads();
#pragma unroll
        for (int kk = 0; kk < 16; ++kk) {
            const float4 a0 = *(const float4*)&As[kk][ty * 8], a1 = *(const float4*)&As[kk][ty * 8 + 4];
            const float4 c0 = *(const float4*)&Bs[kk][tx * 8], c1 = *(const float4*)&Bs[kk][tx * 8 + 4];
            const float a[8] = {a0.x, a0.y, a0.z, a0.w, a1.x, a1.y, a1.z, a1.w}, b[8] = {c0.x, c0.y, c0.z, c0.w, c1.x, c1.y, c1.z, c1.w};
#pragma unroll
            for (int i = 0; i < 8; ++i)
#pragma unroll
                for (int j = 0; j < 8; ++j) acc[i][j] += a[i] * b[j];
        }
    }
}
#define ZERO_ACC(acc) do { _Pragma("unroll") for (int i_ = 0; i_ < 8; ++i_) _Pragma("unroll") for (int j_ = 0; j_ < 8; ++j_) acc[i_][j_] = 0.f; } while (0)

__global__ __launch_bounds__(256) void k_inproj(const bf16_t* __restrict__ H, const float* __restrict__ w_in, bf16_t* __restrict__ P) {
    __shared__ float As[16][132]; __shared__ float Bs[16][132];
    const int bn = blockIdx.x, bm = blockIdx.y, t = threadIdx.x, ty = t >> 4, tx = t & 15;
    float acc[8][8]; ZERO_ACC(acc);
    gemm_tile_128(H + (size_t)(bm * 128 + (t >> 1)) * D, w_in + bn * 128, INW, D, acc, As, Bs);
#pragma unroll
    for (int i = 0; i < 8; ++i) {
        uint4 o; o.x = pk2(acc[i][0], acc[i][1]); o.y = pk2(acc[i][2], acc[i][3]); o.z = pk2(acc[i][4], acc[i][5]); o.w = pk2(acc[i][6], acc[i][7]);
        *(uint4*)(P + (size_t)(bm * 128 + ty * 8 + i) * INW + bn * 128 + tx * 8) = o;
    }
}

__global__ __launch_bounds__(256) void k_outproj(const bf16_t* __restrict__ MIX, const float* __restrict__ w_out, const float* __restrict__ x,
                                                 const float* __restrict__ mod, float* __restrict__ out) {
    __shared__ float As[16][132]; __shared__ float Bs[16][132];
    const int bn = blockIdx.x, bm = blockIdx.y, t = threadIdx.x, ty = t >> 4, tx = t & 15;
    float acc[8][8]; ZERO_ACC(acc);
    gemm_tile_128(MIX + (size_t)(bm * 128 + (t >> 1)) * D, w_out + bn * 128, D, D, acc, As, Bs);
    const int b = (bm * 128) >> 11, c0 = bn * 128 + tx * 8;
    const float* g1 = mod + (size_t)b * 6144 + 2048 + c0;
#pragma unroll
    for (int i = 0; i < 8; ++i) {
        const size_t off = (size_t)(bm * 128 + ty * 8 + i) * D + c0;
#pragma unroll
        for (int j = 0; j < 8; ++j) out[off + j] = x[off + j] + g1[j] * acc[i][j];
    }
}

__global__ __launch_bounds__(512) void k_hgrn2_simple(const bf16_t* __restrict__ P, const float* __restrict__ lb, float* __restrict__ OACC, int dir) {
    __shared__ float qs[32][128], fs[32][128], vs[32][128];
    const int b = blockIdx.x >> 2, h = blockIdx.x & 3, tid = threadIdx.x, w = tid >> 6, lane = tid & 63, vi = lane & 15, kg = lane >> 4, v = 16 * w + vi;
    float S[32];
#pragma unroll
    for (int i = 0; i < 32; ++i) S[i] = 0.f;
    const int lt = tid >> 4, lc = (tid & 15) * 8;
    float lbv[8];
#pragma unroll
    for (int i = 0; i < 8; ++i) lbv[i] = lb[dir * HGW + h * 128 + lc + i];
    const int cf = dir == 0 ? C_FF : C_FB;
    for (int n0 = 0; n0 < CTXL + T; n0 += 32) {
        __syncthreads();
        {
            const int n = n0 + lt;
            size_t row;
            if (n < CTXL) row = (size_t)NLAT + b * CTXL + (dir == 0 ? n : CTXL - 1 - n);
            else row = (size_t)b * T + (dir == 0 ? (n - CTXL) : (T - 1 - (n - CTXL)));
            const bf16_t* pr = P + row * INW + h * 128 + lc;
            const uint4 qv = *(const uint4*)(pr + C_Q), iv = *(const uint4*)(pr + C_I), fv = *(const uint4*)(pr + cf);
            const u32 qa[4] = {qv.x, qv.y, qv.z, qv.w}, ia[4] = {iv.x, iv.y, iv.z, iv.w}, fa[4] = {fv.x, fv.y, fv.z, fv.w};
#pragma unroll
            for (int i = 0; i < 4; ++i) {
                const float q0 = __uint_as_float(qa[i] << 16), q1 = __uint_as_float(qa[i] & 0xffff0000u);
                const float f0 = __uint_as_float(fa[i] << 16), f1 = __uint_as_float(fa[i] & 0xffff0000u);
                qs[lt][lc + 2 * i] = q0 * sigmoidf_(q0); qs[lt][lc + 2 * i + 1] = q1 * sigmoidf_(q1);
                vs[lt][lc + 2 * i] = __uint_as_float(ia[i] << 16); vs[lt][lc + 2 * i + 1] = __uint_as_float(ia[i] & 0xffff0000u);
                fs[lt][lc + 2 * i] = lbv[2 * i] + (1.f - lbv[2 * i]) * sigmoidf_(f0);
                fs[lt][lc + 2 * i + 1] = lbv[2 * i + 1] + (1.f - lbv[2 * i + 1]) * sigmoidf_(f1);
            }
        }
        __syncthreads();
        for (int j = 0; j < 32; ++j) {
            const float vv = vs[j][v];
            float o = 0.f;
#pragma unroll
            for (int i4 = 0; i4 < 8; ++i4) {
                const float4 f4 = *(const float4*)&fs[j][32 * kg + 4 * i4], q4 = *(const float4*)&qs[j][32 * kg + 4 * i4];
                S[4 * i4 + 0] = f4.x * (S[4 * i4 + 0] - vv) + vv; o += S[4 * i4 + 0] * q4.x;
                S[4 * i4 + 1] = f4.y * (S[4 * i4 + 1] - vv) + vv; o += S[4 * i4 + 1] * q4.y;
                S[4 * i4 + 2] = f4.z * (S[4 * i4 + 2] - vv) + vv; o += S[4 * i4 + 2] * q4.z;
                S[4 * i4 + 3] = f4.w * (S[4 * i4 + 3] - vv) + vv; o += S[4 * i4 + 3] * q4.w;
            }
            o += __shfl_xor(o, 16); o += __shfl_xor(o, 32);
            const int n = n0 + j;
            if (n >= CTXL && kg == 0) {
                const int tt = dir == 0 ? (n - CTXL) : (T - 1 - (n - CTXL));
                float* dst = OACC + ((size_t)b * T + tt) * HGW + h * 128 + v;
                if (dir == 0) *dst = o; else *dst += o;
            }
        }
    }
}

__device__ __forceinline__ size_t rg_row(int b, bool lat, int p) {
    return lat ? (size_t)b * T + (size_t)(p % GROWS) * GRIDW + (p / GROWS) : (size_t)NLAT + b * CTXL + p;
}
template <int dir>
__global__ __launch_bounds__(64) void k_rglru_simple(const bf16_t* __restrict__ P, const float* __restrict__ conv_w, const float* __restrict__ conv_b,
                                                     const float* __restrict__ wa, const float* __restrict__ ba, const float* __restrict__ wx, const float* __restrict__ bx,
                                                     const float* __restrict__ lam, float* __restrict__ HACC) {
    __shared__ float xs[16][64];
    const int hd = blockIdx.x, b = blockIdx.y, j = threadIdx.x, c = hd * 64 + j;
    float wac[64], wxc[64];
#pragma unroll
    for (int i = 0; i < 64; ++i) { wac[i] = wa[(((size_t)dir * 8 + hd) * 64 + i) * 64 + j]; wxc[i] = wx[(((size_t)dir * 8 + hd) * 64 + i) * 64 + j]; }
    const float cw0 = conv_w[0 * RGW + c], cw1 = conv_w[1 * RGW + c], cw2 = conv_w[2 * RGW + c], cw3 = conv_w[3 * RGW + c], cb = conv_b[c];
    const float bav = ba[dir * RGW + c], bxv = bx[dir * RGW + c];
    const float l = lam[dir * RGW + c];
    const float sp = (-l > 20.f) ? -l : log1pf(__expf(-l));
    const float coef = -8.0f * sp;
    float hst = 0.f;
    for (int seg = 0; seg < 2; ++seg) {
        const bool lat = seg == 1; const int L = lat ? T : CTXL;
        for (int s0 = 0; s0 < L; s0 += 16) {
            float xc[16];
            {
                const int plo = dir == 0 ? s0 : L - 16 - s0;
                float rx[19];
#pragma unroll
                for (int i = 0; i < 19; ++i) { const int p = plo - 2 + i; rx[i] = (p >= 0 && p < L) ? bf2f(P[rg_row(b, lat, p) * INW + C_RX + c]) : 0.f; }
#pragma unroll
                for (int i = 0; i < 16; ++i) xc[i] = cb + cw0 * rx[i] + cw1 * rx[i + 1] + cw2 * rx[i + 2] + cw3 * rx[i + 3];
            }
            __syncthreads();
#pragma unroll
            for (int i = 0; i < 16; ++i) xs[i][j] = xc[i];
            __syncthreads();
#pragma unroll
            for (int ii = 0; ii < 16; ++ii) {
                const int i = dir == 0 ? ii : 15 - ii;
                float ra = bav, xa = bxv;
#pragma unroll
                for (int k = 0; k < 64; ++k) { const float xv = xs[i][k]; ra += xv * wac[k]; xa += xv * wxc[k]; }
                const float r = sigmoidf_(ra), ig = sigmoidf_(xa);
                const float log_a = coef * r, a = __expf(log_a), mult = sqrtf(fmaxf(-expm1f(2.0f * log_a), 0.f));
                hst = a * hst + mult * ig * xc[i];
                if (lat) {
                    const int p = (dir == 0 ? s0 : L - 16 - s0) + i;
                    const int tt = (p % GROWS) * GRIDW + (p / GROWS);
                    float* dst = HACC + ((size_t)b * T + tt) * RGW + c;
                    if (dir == 0) *dst = hst; else *dst += hst;
                }
            }
        }
    }
}

__device__ __forceinline__ float gelu_tanh(float x) { const float u = 0.7978845608028654f * (x + 0.044715f * x * x * x); return 0.5f * x * (1.0f + tanhf(u)); }
__global__ __launch_bounds__(256) void k_mix_finish(const bf16_t* __restrict__ P, const float* __restrict__ OACC, const float* __restrict__ HACC,
                                                    const float* __restrict__ hg_nw, bf16_t* __restrict__ MIX) {
    const int lane = threadIdx.x & 63, r = blockIdx.x * 4 + (threadIdx.x >> 6), c0 = lane * 8;
    float o[8]; float ss = 0.f;
#pragma unroll
    for (int i = 0; i < 8; ++i) { o[i] = OACC[(size_t)r * HGW + c0 + i]; ss += o[i] * o[i]; }
    ss += __shfl_xor(ss, 1); ss += __shfl_xor(ss, 2); ss += __shfl_xor(ss, 4); ss += __shfl_xor(ss, 8);
    const float rstd = rsqrtf(ss * (1.0f / 128.0f) + EPS);
    const bf16_t* pr = P + (size_t)r * INW;
    u32 w[4];
#pragma unroll
    for (int i = 0; i < 8; i += 2) {
        const float g0 = bf2f(pr[C_G + c0 + i]), g1 = bf2f(pr[C_G + c0 + i + 1]);
        const float a0 = o[i] * rstd * hg_nw[c0 + i] * (g0 * sigmoidf_(g0)), a1 = o[i + 1] * rstd * hg_nw[c0 + i + 1] * (g1 * sigmoidf_(g1));
        w[i >> 1] = pk2(a0, a1);
    }
    *(uint4*)(MIX + (size_t)r * D + c0) = make_uint4(w[0], w[1], w[2], w[3]);
#pragma unroll
    for (int i = 0; i < 8; i += 2) {
        const float g0 = bf2f(pr[C_RG + c0 + i]), g1 = bf2f(pr[C_RG + c0 + i + 1]);
        const float a0 = gelu_tanh(g0) * HACC[(size_t)r * RGW + c0 + i], a1 = gelu_tanh(g1) * HACC[(size_t)r * RGW + c0 + i + 1];
        w[i >> 1] = pk2(a0, a1);
    }
    *(uint4*)(MIX + (size_t)r * D + HGW + c0) = make_uint4(w[0], w[1], w[2], w[3]);
}

constexpr int RT_LDS = 32 * 1024 * 4 + 4096 + 256 * 4 * 8;
__global__ __launch_bounds__(512) void k_norm2_route(const float* __restrict__ x1, const float* __restrict__ nw, const float* __restrict__ mod,
                                                     const float* __restrict__ rw, const float* __restrict__ rb, bf16_t* __restrict__ H2,
                                                     u32* __restrict__ cnt, u32* __restrict__ toktab, float* __restrict__ wtab) {
    extern __shared__ __attribute__((aligned(16))) unsigned char lds[];
    float* rwT = (float*)lds;
    u32* hist = (u32*)(lds + 131072);
    u32* ent = (u32*)(lds + 131072 + 4096);
    const int tid = threadIdx.x, lane = tid & 63, w = tid >> 6, G = gridDim.x;
    for (int i = tid; i < 32 * 1024; i += 512) { const int k = i >> 5, e = i & 31; rwT[e * 1024 + k] = rw[i]; }
    if (tid < 128) hist[tid] = 0;
    __syncthreads();
    const int gw = blockIdx.x * 8 + w, NW = G * 8;
    int it = 0;
    for (int r = gw; r < NLAT; r += NW, ++it) {
        const float* m = mod + (size_t)(r >> 11) * 6144;
        float4 v[4]; float ss = 0.f;
#pragma unroll
        for (int j = 0; j < 4; ++j) { v[j] = *(const float4*)(x1 + (size_t)r * D + j * 256 + lane * 4); ss += v[j].x * v[j].x + v[j].y * v[j].y + v[j].z * v[j].z + v[j].w * v[j].w; }
        const float rstd = rsqrtf(wave_sum(ss) * (1.0f / D) + EPS);
#pragma unroll
        for (int j = 0; j < 4; ++j) {
            const int c0 = j * 256 + lane * 4;
            const float4 ww = *(const float4*)(nw + c0), sh = *(const float4*)(m + 3072 + c0), sc = *(const float4*)(m + 4096 + c0);
            v[j].x = v[j].x * rstd * ww.x * (1.f + sc.x) + sh.x; v[j].y = v[j].y * rstd * ww.y * (1.f + sc.y) + sh.y;
            v[j].z = v[j].z * rstd * ww.z * (1.f + sc.z) + sh.z; v[j].w = v[j].w * rstd * ww.w * (1.f + sc.w) + sh.w;
            uint2 p; p.x = pk2(v[j].x, v[j].y); p.y = pk2(v[j].z, v[j].w);
            *(uint2*)(H2 + (size_t)r * D + c0) = p;
        }
        float mylogit = 0.f;
        for (int e = 0; e < 32; ++e) {
            float p = 0.f;
#pragma unroll
            for (int j = 0; j < 4; ++j) { const float4 q = *(const float4*)(rwT + e * 1024 + j * 256 + lane * 4); p += v[j].x * q.x + v[j].y * q.y + v[j].z * q.z + v[j].w * q.w; }
            p = wave_sum(p);
            if ((lane & 31) == e) mylogit = p + rb[e];
        }
        float tv[4]; int ti[4]; float cur = mylogit;
#pragma unroll
        for (int k = 0; k < 4; ++k) {
            float bv = cur; int bi = lane & 31;
#pragma unroll
            for (int o = 1; o < 32; o <<= 1) { const float ov = __shfl_xor(bv, o); const int oi = __shfl_xor(bi, o); if (ov > bv || (ov == bv && oi < bi)) { bv = ov; bi = oi; } }
            tv[k] = bv; ti[k] = bi; if ((lane & 31) == bi) cur = -3.0e38f;
        }
        const float e1 = __expf(tv[1] - tv[0]), e2 = __expf(tv[2] - tv[0]), e3 = __expf(tv[3] - tv[0]); const float inv = 1.0f / (1.0f + e1 + e2 + e3);
        const float gwt[4] = {inv, e1 * inv, e2 * inv, e3 * inv};
        if (lane < 4) {
            const int half = r >= HALF_TOK ? 1 : 0; const int e = ti[lane];
            const u32 lp = atomicAdd(&hist[half * 32 + e], 1u);
            const int idx = (it * 8 + w) * 4 + lane;
            ent[idx * 2] = ((u32)e << 24) | lp; ent[idx * 2 + 1] = __float_as_uint(gwt[lane]);
        }
    }
    __syncthreads();
    if (tid < 64) hist[64 + tid] = atomicAdd(&cnt[tid], hist[tid]);
    __syncthreads();
    it = 0;
    for (int r = gw; r < NLAT; r += NW, ++it) {
        if (lane < 4) {
            const int half = r >= HALF_TOK ? 1 : 0; const int idx = (it * 8 + w) * 4 + lane;
            const u32 ev = ent[idx * 2]; const int e = ev >> 24; const u32 pos = hist[64 + half * 32 + e] + (ev & 0xffffffu);
            toktab[((size_t)half * 32 + e) * CAP + pos] = (u32)r * 4u + lane;
            wtab[((size_t)half * 32 + e) * CAP + pos] = __uint_as_float(ent[idx * 2 + 1]);
        }
    }
}

__device__ __forceinline__ bool moe_tile(const u32* __restrict__ cnt, int half, int bm, int& e, int& pos0, int& cn) {
    int start = 0;
    for (int i = 0; i < NE; ++i) { const int c = (int)cnt[half * 32 + i], pad = (c + 255) & ~255; if (bm * 128 < start + pad) { e = i; pos0 = bm * 128 - start; cn = c; return true; } start += pad; }
    return false;
}
__global__ __launch_bounds__(256) void k_moe_gu(const bf16_t* __restrict__ H2, const float* __restrict__ wgu, const float* __restrict__ bgu, const u32* __restrict__ cnt,
                                                const u32* __restrict__ toktab, bf16_t* __restrict__ ACT, int half) {
    __shared__ float As[16][132]; __shared__ float Bs[16][132];
    const int bn = blockIdx.x, bm = blockIdx.y, t = threadIdx.x, ty = t >> 4, tx = t & 15;
    int e, pos0, cn; if (!moe_tile(cnt, half, bm, e, pos0, cn)) return;
    const int ap = pos0 + (t >> 1);
    const u32 tk = ap < cn ? toktab[((size_t)half * 32 + e) * CAP + ap] : toktab[((size_t)half * 32 + e) * CAP];
    const bf16_t* arow = H2 + (size_t)(tk >> 2) * D;
    const float* Bp = wgu + (size_t)e * D * 2048 + bn * 128;
    float acc[8][8]; ZERO_ACC(acc);
    gemm_tile_128(arow, Bp, 2048, D, acc, As, Bs);
    float gl[8][8];
    const int c0 = bn * 128 + tx * 8;
#pragma unroll
    for (int i = 0; i < 8; ++i)
#pragma unroll
        for (int j = 0; j < 8; ++j) { const float g = fminf(acc[i][j] + bgu[e * 2048 + c0 + j], 7.0f); gl[i][j] = g * sigmoidf_(1.702f * g); acc[i][j] = 0.f; }
    gemm_tile_128(arow, Bp + 1024, 2048, D, acc, As, Bs);
#pragma unroll
    for (int i = 0; i < 8; ++i) {
        float o[8];
#pragma unroll
        for (int j = 0; j < 8; ++j) { const float u = fminf(fmaxf(acc[i][j] + bgu[e * 2048 + 1024 + c0 + j], -7.0f), 7.0f); o[j] = gl[i][j] * (u + 1.0f); }
        uint4 ov; ov.x = pk2(o[0], o[1]); ov.y = pk2(o[2], o[3]); ov.z = pk2(o[4], o[5]); ov.w = pk2(o[6], o[7]);
        *(uint4*)(ACT + (size_t)(bm * 128 + ty * 8 + i) * DFF + c0) = ov;
    }
}
__global__ __launch_bounds__(256) void k_moe_down(const bf16_t* __restrict__ ACT, const float* __restrict__ wd, const float* __restrict__ bd, const u32* __restrict__ cnt,
                                                  const u32* __restrict__ toktab, const float* __restrict__ wtab, bf16_t* __restrict__ Y, int half) {
    __shared__ float As[16][132]; __shared__ float Bs[16][132];
    const int bn = blockIdx.x, bm = blockIdx.y, t = threadIdx.x, ty = t >> 4, tx = t & 15;
    int e, pos0, cn; if (!moe_tile(cnt, half, bm, e, pos0, cn)) return;
    float acc[8][8]; ZERO_ACC(acc);
    gemm_tile_128(ACT + (size_t)(bm * 128 + (t >> 1)) * DFF, wd + (size_t)e * DFF * D + bn * 128, D, DFF, acc, As, Bs);
    const int c0 = bn * 128 + tx * 8;
#pragma unroll
    for (int i = 0; i < 8; ++i) {
        const int p = pos0 + ty * 8 + i;
        if (p < cn) {
            const u32 tk = toktab[((size_t)half * 32 + e) * CAP + p]; const float wgt = wtab[((size_t)half * 32 + e) * CAP + p];
            float o[8];
#pragma unroll
            for (int j = 0; j < 8; ++j) o[j] = wgt * (acc[i][j] + bd[e * D + c0 + j]);
            uint4 ov; ov.x = pk2(o[0], o[1]); ov.y = pk2(o[2], o[3]); ov.z = pk2(o[4], o[5]); ov.w = pk2(o[6], o[7]);
            *(uint4*)(Y + (size_t)(tk - (u32)half * HALF_TOK * 4u) * D + c0) = ov;
        }
    }
}
__global__ __launch_bounds__(256) void k_combine(float* __restrict__ out, const bf16_t* __restrict__ Y, const float* __restrict__ mod, const float* __restrict__ fw, int half) {
    const int lane = threadIdx.x & 63, rl = blockIdx.x * 4 + (threadIdx.x >> 6), r = half * HALF_TOK + rl;
    const float* g2 = mod + (size_t)(r >> 11) * 6144 + 5120;
    float4 v[4]; float ss = 0.f;
#pragma unroll
    for (int j = 0; j < 4; ++j) {
        const int c0 = j * 256 + lane * 4;
        v[j] = *(const float4*)(out + (size_t)r * D + c0);
        float s0 = 0.f, s1 = 0.f, s2 = 0.f, s3 = 0.f;
#pragma unroll
        for (int k = 0; k < 4; ++k) { const uint2 y = *(const uint2*)(Y + ((size_t)rl * 4 + k) * D + c0);
            s0 += __uint_as_float(y.x << 16); s1 += __uint_as_float(y.x & 0xffff0000u); s2 += __uint_as_float(y.y << 16); s3 += __uint_as_float(y.y & 0xffff0000u); }
        const float4 g = *(const float4*)(g2 + c0);
        v[j].x += g.x * s0; v[j].y += g.y * s1; v[j].z += g.z * s2; v[j].w += g.w * s3;
        ss += v[j].x * v[j].x + v[j].y * v[j].y + v[j].z * v[j].z + v[j].w * v[j].w;
    }
    const float rstd = rsqrtf(wave_sum(ss) * (1.0f / D) + EPS);
#pragma unroll
    for (int j = 0; j < 4; ++j) {
        const int c0 = j * 256 + lane * 4; const float4 w = *(const float4*)(fw + c0);
        *(float4*)(out + (size_t)r * D + c0) = make_float4(v[j].x * rstd * w.x, v[j].y * rstd * w.y, v[j].z * rstd * w.z, v[j].w * rstd * w.w);
    }
}

extern "C" void kernel_launch(void* const* d_in, const int* in_sizes, int n_in, void* d_out, int out_size, void* d_ws, size_t ws_size, hipStream_t stream) {
    const float* x = (const float*)d_in[0]; const float* c = (const float*)d_in[1]; const float* ctx = (const float*)d_in[2]; const float* c_ctx = (const float*)d_in[3];
    const float* norm1_w = (const float*)d_in[4]; const float* norm2_w = (const float*)d_in[5]; const float* w_ada = (const float*)d_in[6]; const float* b_ada = (const float*)d_in[7];
    const float* w_in = (const float*)d_in[8]; const float* lbl = (const float*)d_in[9]; const float* hg_nw = (const float*)d_in[10];
    const float* conv_w = (const float*)d_in[11]; const float* conv_b = (const float*)d_in[12]; const float* rg_wa = (const float*)d_in[13]; const float* rg_ba = (const float*)d_in[14];
    const float* rg_wx = (const float*)d_in[15]; const float* rg_bx = (const float*)d_in[16]; const float* rg_lam = (const float*)d_in[17]; const float* w_out = (const float*)d_in[18];
    const float* router_w = (const float*)d_in[19]; const float* router_b = (const float*)d_in[20]; const float* wgu = (const float*)d_in[21]; const float* bgu = (const float*)d_in[22];
    const float* wd = (const float*)d_in[23]; const float* bd = (const float*)d_in[24]; const float* final_w = (const float*)d_in[25];
    float* out = (float*)d_out; unsigned char* ws = (unsigned char*)d_ws;
    if (ws_size < 1024 * MiB) { fprintf(stderr, "kernel_launch: workspace too small (%zu)\n", ws_size); return; }
    u32* cnt = (u32*)(ws + WS_CTL); float* mod = (float*)(ws + WS_MOD); float* lb = (float*)(ws + WS_LB);
    u32* toktab = (u32*)(ws + WS_TOKTAB); float* wtab = (float*)(ws + WS_WTAB);
    float* OACC = (float*)(ws + WS_OACC); float* HACC = (float*)(ws + WS_HACC);
    bf16_t* H = (bf16_t*)(ws + WS_H); bf16_t* P = (bf16_t*)(ws + WS_PROJ); bf16_t* MIX = (bf16_t*)(ws + WS_MIX2); bf16_t* H2 = (bf16_t*)(ws + WS_H2);
    bf16_t* ACT = (bf16_t*)(ws + WS_ACT); bf16_t* Y = (bf16_t*)(ws + WS_Y);
    static bool attr = false;
    if (!attr) { hipFuncSetAttribute((const void*)k_norm2_route, hipFuncAttributeMaxDynamicSharedMemorySize, RT_LDS); attr = true; }

    hipMemsetAsync(cnt, 0, 256, stream);
    k_mod<<<dim3(24, 33), 256, 0, stream>>>(c, c_ctx, w_ada, b_ada, lbl, mod, lb);
    k_norm1<<<NROWS / 4, 256, 0, stream>>>(x, ctx, norm1_w, mod, H);
    k_inproj<<<dim3(INW / 128, NROWS / 128), 256, 0, stream>>>(H, w_in, P);
    k_hgrn2_simple<<<128, 512, 0, stream>>>(P, lb, OACC, 0);
    k_hgrn2_simple<<<128, 512, 0, stream>>>(P, lb, OACC, 1);
    k_rglru_simple<0><<<dim3(8, 32), 64, 0, stream>>>(P, conv_w, conv_b, rg_wa, rg_ba, rg_wx, rg_bx, rg_lam, HACC);
    k_rglru_simple<1><<<dim3(8, 32), 64, 0, stream>>>(P, conv_w, conv_b, rg_wa, rg_ba, rg_wx, rg_bx, rg_lam, HACC);
    k_mix_finish<<<NLAT / 4, 256, 0, stream>>>(P, OACC, HACC, hg_nw, MIX);
    k_outproj<<<dim3(D / 128, NLAT / 128), 256, 0, stream>>>(MIX, w_out, x, mod, out);
    k_norm2_route<<<256, 512, RT_LDS, stream>>>(out, norm2_w, mod, router_w, router_b, H2, cnt, toktab, wtab);
    for (int half = 0; half < 2; ++half) {
        k_moe_gu<<<dim3(DFF / 128, MAXSLOT / 128), 256, 0, stream>>>(H2, wgu, bgu, cnt, toktab, ACT, half);
        k_moe_down<<<dim3(D / 128, MAXSLOT / 128), 256, 0, stream>>>(ACT, wd, bd, cnt, toktab, wtab, Y, half);
        k_combine<<<HALF_TOK / 4, 256, 0, stream>>>(out, Y, mod, final_w, half);
    }
}
```

```cpp
#include <hip/hip_runtime.h>
#include <cstdio>
#include <cstdint>

typedef unsigned short bf16_t;
typedef unsigned int u32;

constexpr int D = 1024, NB = 32, T = 2048, CTXL = 256, GRIDW = 64, GROWS = T / GRIDW;
constexpr int NLAT = NB * T;
constexpr int NCTX = NB * CTXL;
constexpr int NROWS = NLAT + NCTX;
constexpr int HGW = 512, RGW = 512, INW = 3584;
constexpr int C_Q = 0, C_I = 512, C_FF = 1024, C_FB = 1536, C_G = 2048, C_RX = 2560, C_RG = 3072;
constexpr int NE = 32, TOPK = 4, DFF = 1024;
constexpr int HALF_TOK = NLAT / 2;
constexpr int CAP = HALF_TOK;
constexpr int MAXSLOT = HALF_TOK * TOPK + NE * 256;
constexpr float EPS = 1e-6f;

constexpr size_t MiB = 1u << 20;
constexpr size_t WS_CTL = 0;
constexpr size_t WS_MOD = 1 * MiB;
constexpr size_t WS_LB = WS_MOD + 33 * 6144 * 4;
constexpr size_t WS_TOKTAB = 2 * MiB;
constexpr size_t WS_WTAB = 10 * MiB;
constexpr size_t WS_SCR = 28 * MiB;
constexpr size_t WS_OACC = WS_SCR, WS_HACC = WS_SCR + 128 * MiB;
constexpr size_t WS_H = 284 * MiB;
constexpr size_t WS_PROJ = 428 * MiB;
constexpr size_t WS_ACT = 428 * MiB;
constexpr size_t WS_Y = 428 * MiB + 272 * MiB;

constexpr size_t WS_MIX2 = WS_H;
constexpr size_t WS_H2 = WS_SCR;

__device__ __forceinline__ float bf2f(bf16_t b) { return __uint_as_float(((u32)b) << 16); }
__device__ __forceinline__ bf16_t f2bf(float f) { u32 u = __float_as_uint(f); u += 0x7fffu + ((u >> 16) & 1u); return (bf16_t)(u >> 16); }
__device__ __forceinline__ u32 pk2(float lo, float hi) { return (u32)f2bf(lo) | ((u32)f2bf(hi) << 16); }
__device__ __forceinline__ float sigmoidf_(float x) { return 1.0f / (1.0f + __expf(-x)); }
__device__ __forceinline__ float wave_sum(float v) {
#pragma unroll
    for (int o = 1; o < 64; o <<= 1) v += __shfl_xor(v, o);
    return v;
}

__global__ __launch_bounds__(256) void k_mod(const float* __restrict__ c, const float* __restrict__ c_ctx, const float* __restrict__ w_ada,
                                             const float* __restrict__ b_ada, const float* __restrict__ lbl, float* __restrict__ mod, float* __restrict__ lb) {
    __shared__ float s[D];
    const int b = blockIdx.y, n = blockIdx.x * 256 + threadIdx.x;
    const float* cv = b < NB ? c + (size_t)b * D : c_ctx;
    for (int k = threadIdx.x; k < D; k += 256) { float v = cv[k]; s[k] = v * sigmoidf_(v); }
    __syncthreads();
    float acc = b_ada[n];
    for (int k = 0; k < D; ++k) acc += s[k] * w_ada[(size_t)k * 6144 + n];
    mod[(size_t)b * 6144 + n] = acc;
    if (blockIdx.x == 0 && blockIdx.y == 0) {
        for (int i = threadIdx.x; i < 2 * HGW; i += 256) { float l0 = lbl[i], l1 = lbl[2 * HGW + i]; lb[i] = 1.0f / (1.0f + __expf(l1 - l0)); }
    }
}

__global__ __launch_bounds__(256) void k_norm1(const float* __restrict__ x, const float* __restrict__ ctx, const float* __restrict__ nw,
                                               const float* __restrict__ mod, bf16_t* __restrict__ H) {
    const int lane = threadIdx.x & 63, r = blockIdx.x * 4 + (threadIdx.x >> 6);
    const float* src = r < NLAT ? x + (size_t)r * D : ctx + (size_t)(r - NLAT) * D;
    const float* m = mod + (size_t)(r < NLAT ? (r >> 11) : NB) * 6144;
    float4 v[4]; float ss = 0.f;
#pragma unroll
    for (int j = 0; j < 4; ++j) { v[j] = *(const float4*)(src + j * 256 + lane * 4); ss += v[j].x * v[j].x + v[j].y * v[j].y + v[j].z * v[j].z + v[j].w * v[j].w; }
    const float rstd = rsqrtf(wave_sum(ss) * (1.0f / D) + EPS);
#pragma unroll
    for (int j = 0; j < 4; ++j) {
        const int c0 = j * 256 + lane * 4;
        const float4 w = *(const float4*)(nw + c0), sh = *(const float4*)(m + c0), sc = *(const float4*)(m + 1024 + c0);
        float o0 = v[j].x * rstd * w.x * (1.f + sc.x) + sh.x, o1 = v[j].y * rstd * w.y * (1.f + sc.y) + sh.y;
        float o2 = v[j].z * rstd * w.z * (1.f + sc.z) + sh.z, o3 = v[j].w * rstd * w.w * (1.f + sc.w) + sh.w;
        uint2 p; p.x = pk2(o0, o1); p.y = pk2(o2, o3);
        *(uint2*)(H + (size_t)r * D + c0) = p;
    }
}

__device__ __forceinline__ void gemm_tile_128(const bf16_t* __restrict__ arow, const float* __restrict__ Bp, int ldb, int K, float (&acc)[8][8],
                                              float (*As)[132], float (*Bs)[132]) {
    const int t = threadIdx.x, ak = (t & 1) * 8, ar = t >> 1, bk = t >> 4, bc = (t & 15) * 8, ty = t >> 4, tx = t & 15;
    for (int k0 = 0; k0 < K; k0 += 16) {
        const uint4 av = *(const uint4*)(arow + k0 + ak);
        const float4 b0 = *(const float4*)(Bp + (size_t)(k0 + bk) * ldb + bc), b1 = *(const float4*)(Bp + (size_t)(k0 + bk) * ldb + bc + 4);
        __syncthreads();
        As[ak + 0][ar] = __uint_as_float(av.x << 16); As[ak + 1][ar] = __uint_as_float(av.x & 0xffff0000u);
        As[ak + 2][ar] = __uint_as_float(av.y << 16); As[ak + 3][ar] = __uint_as_float(av.y & 0xffff0000u);
        As[ak + 4][ar] = __uint_as_float(av.z << 16); As[ak + 5][ar] = __uint_as_float(av.z & 0xffff0000u);
        As[ak + 6][ar] = __uint_as_float(av.w << 16); As[ak + 7][ar] = __uint_as_float(av.w & 0xffff0000u);
        *(float4*)&Bs[bk][bc] = b0; *(float4*)&Bs[bk][bc + 4] = b1;
        __syncthreads();
#pragma unroll
        for (int kk = 0; kk < 16; ++kk) {
            const float4 a0 = *(const float4*)&As[kk][ty * 8], a1 = *(const float4*)&As[kk][ty * 8 + 4];
            const float4 c0 = *(const float4*)&Bs[kk][tx * 8], c1 = *(const float4*)&Bs[kk][tx * 8 + 4];
            const float a[8] = {a0.x, a0.y, a0.z, a0.w, a1.x, a1.y, a1.z, a1.w}, b[8] = {c0.x, c0.y, c0.z, c0.w, c1.x, c1.y, c1.z, c1.w};
#pragma unroll
            for (int i = 0; i < 8; ++i)
#pragma unroll
                for (int j = 0; j < 8; ++j) acc[i][j] += a[i] * b[j];
        }
    }
}
#define ZERO_ACC(acc) do { _Pragma("unroll") for (int i_ = 0; i_ < 8; ++i_) _Pragma("unroll") for (int j_ = 0; j_ < 8; ++j_) acc[i_][j_] = 0.f; } while (0)

__global__ __launch_bounds__(256) void k_inproj(const bf16_t* __restrict__ H, const float* __restrict__ w_in, bf16_t* __restrict__ P) {
    __shared__ float As[16][132]; __shared__ float Bs[16][132];
    const int bn = blockIdx.x, bm = blockIdx.y, t = threadIdx.x, ty = t >> 4, tx = t & 15;
    float acc[8][8]; ZERO_ACC(acc);
    gemm_tile_128(H + (size_t)(bm * 128 + (t >> 1)) * D, w_in + bn * 128, INW, D, acc, As, Bs);
#pragma unroll
    for (int i = 0; i < 8; ++i) {
        uint4 o; o.x = pk2(acc[i][0], acc[i][1]); o.y = pk2(acc[i][2], acc[i][3]); o.z = pk2(acc[i][4], acc[i][5]); o.w = pk2(acc[i][6], acc[i][7]);
        *(uint4*)(P + (size_t)(bm * 128 + ty * 8 + i) * INW + bn * 128 + tx * 8) = o;
    }
}

__global__ __launch_bounds__(256) void k_outproj(const bf16_t* __restrict__ MIX, const float* __restrict__ w_out, const float* __restrict__ x,
                                                 const float* __restrict__ mod, float* __restrict__ out) {
    __shared__ float As[16][132]; __shared__ float Bs[16][132];
    const int bn = blockIdx.x, bm = blockIdx.y, t = threadIdx.x, ty = t >> 4, tx = t & 15;
    float acc[8][8]; ZERO_ACC(acc);
    gemm_tile_128(MIX + (size_t)(bm * 128 + (t >> 1)) * D, w_out + bn * 128, D, D, acc, As, Bs);
    const int b = (bm * 128) >> 11, c0 = bn * 128 + tx * 8;
    const float* g1 = mod + (size_t)b * 6144 + 2048 + c0;
#pragma unroll
    for (int i = 0; i < 8; ++i) {
        const size_t off = (size_t)(bm * 128 + ty * 8 + i) * D + c0;
#pragma unroll
        for (int j = 0; j < 8; ++j) out[off + j] = x[off + j] + g1[j] * acc[i][j];
    }
}

__global__ __launch_bounds__(512) void k_hgrn2_simple(const bf16_t* __restrict__ P, const float* __restrict__ lb, float* __restrict__ OACC, int dir) {
    __shared__ float qs[32][128], fs[32][128], vs[32][128];
    const int b = blockIdx.x >> 2, h = blockIdx.x & 3, tid = threadIdx.x, w = tid >> 6, lane = tid & 63, vi = lane & 15, kg = lane >> 4, v = 16 * w + vi;
    float S[32];
#pragma unroll
    for (int i = 0; i < 32; ++i) S[i] = 0.f;
    const int lt = tid >> 4, lc = (tid & 15) * 8;
    float lbv[8];
#pragma unroll
    for (int i = 0; i < 8; ++i) lbv[i] = lb[dir * HGW + h * 128 + lc + i];
    const int cf = dir == 0 ? C_FF : C_FB;
    for (int n0 = 0; n0 < CTXL + T; n0 += 32) {
        __syncthreads();
        {
            const int n = n0 + lt;
            size_t row;
            if (n < CTXL) row = (size_t)NLAT + b * CTXL + (dir == 0 ? n : CTXL - 1 - n);
            else row = (size_t)b * T + (dir == 0 ? (n - CTXL) : (T - 1 - (n - CTXL)));
            const bf16_t* pr = P + row * INW + h * 128 + lc;
            const uint4 qv = *(const uint4*)(pr + C_Q), iv = *(const uint4*)(pr + C_I), fv = *(const uint4*)(pr + cf);
            const u32 qa[4] = {qv.x, qv.y, qv.z, qv.w}, ia[4] = {iv.x, iv.y, iv.z, iv.w}, fa[4] = {fv.x, fv.y, fv.z, fv.w};
#pragma unroll
            for (int i = 0; i < 4; ++i) {
                const float q0 = __uint_as_float(qa[i] << 16), q1 = __uint_as_float(qa[i] & 0xffff0000u);
                const float f0 = __uint_as_float(fa[i] << 16), f1 = __uint_as_float(fa[i] & 0xffff0000u);
                qs[lt][lc + 2 * i] = q0 * sigmoidf_(q0); qs[lt][lc + 2 * i + 1] = q1 * sigmoidf_(q1);
                vs[lt][lc + 2 * i] = __uint_as_float(ia[i] << 16); vs[lt][lc + 2 * i + 1] = __uint_as_float(ia[i] & 0xffff0000u);
                fs[lt][lc + 2 * i] = lbv[2 * i] + (1.f - lbv[2 * i]) * sigmoidf_(f0);
                fs[lt][lc + 2 * i + 1] = lbv[2 * i + 1] + (1.f - lbv[2 * i + 1]) * sigmoidf_(f1);
            }
        }
        __syncthreads();
        for (int j = 0; j < 32; ++j) {
            const float vv = vs[j][v];
            float o = 0.f;
#pragma unroll
            for (int i4 = 0; i4 < 8; ++i4) {
                const float4 f4 = *(const float4*)&fs[j][32 * kg + 4 * i4], q4 = *(const float4*)&qs[j][32 * kg + 4 * i4];
                S[4 * i4 + 0] = f4.x * (S[4 * i4 + 0] - vv) + vv; o += S[4 * i4 + 0] * q4.x;
                S[4 * i4 + 1] = f4.y * (S[4 * i4 + 1] - vv) + vv; o += S[4 * i4 + 1] * q4.y;
                S[4 * i4 + 2] = f4.z * (S[4 * i4 + 2] - vv) + vv; o += S[4 * i4 + 2] * q4.z;
                S[4 * i4 + 3] = f4.w * (S[4 * i4 + 3] - vv) + vv; o += S[4 * i4 + 3] * q4.w;
            }
            o += __shfl_xor(o, 16); o += __shfl_xor(o, 32);
            const int n = n0 + j;
            if (n >= CTXL && kg == 0) {
                const int tt = dir == 0 ? (n - CTXL) : (T - 1 - (n - CTXL));
                float* dst = OACC + ((size_t)b * T + tt) * HGW + h * 128 + v;
                if (dir == 0) *dst = o; else *dst += o;
            }
        }
    }
}

__device__ __forceinline__ size_t rg_row(int b, bool lat, int p) {
    return lat ? (size_t)b * T + (size_t)(p % GROWS) * GRIDW + (p / GROWS) : (size_t)NLAT + b * CTXL + p;
}
template <int dir>
__global__ __launch_bounds__(64) void k_rglru_simple(const bf16_t* __restrict__ P, const float* __restrict__ conv_w, const float* __restrict__ conv_b,
                                                     const float* __restrict__ wa, const float* __restrict__ ba, const float* __restrict__ wx, const float* __restrict__ bx,
                                                     const float* __restrict__ lam, float* __restrict__ HACC) {
    __shared__ float xs[16][64];
    const int hd = blockIdx.x, b = blockIdx.y, j = threadIdx.x, c = hd * 64 + j;
    float wac[64], wxc[64];
#pragma unroll
    for (int i = 0; i < 64; ++i) { wac[i] = wa[(((size_t)dir * 8 + hd) * 64 + i) * 64 + j]; wxc[i] = wx[(((size_t)dir * 8 + hd) * 64 + i) * 64 + j]; }
    const float cw0 = conv_w[0 * RGW + c], cw1 = conv_w[1 * RGW + c], cw2 = conv_w[2 * RGW + c], cw3 = conv_w[3 * RGW + c], cb = conv_b[c];
    const float bav = ba[dir * RGW + c], bxv = bx[dir * RGW + c];
    const float l = lam[dir * RGW + c];
    const float sp = (-l > 20.f) ? -l : log1pf(__expf(-l));
    const float coef = -8.0f * sp;
    float hst = 0.f;
    for (int seg = 0; seg < 2; ++seg) {
        const bool lat = seg == 1; const int L = lat ? T : CTXL;
        for (int s0 = 0; s0 < L; s0 += 16) {
            float xc[16];
            {
                const int plo = dir == 0 ? s0 : L - 16 - s0;
                float rx[19];
#pragma unroll
                for (int i = 0; i < 19; ++i) { const int p = plo - 2 + i; rx[i] = (p >= 0 && p < L) ? bf2f(P[rg_row(b, lat, p) * INW + C_RX + c]) : 0.f; }
#pragma unroll
                for (int i = 0; i < 16; ++i) xc[i] = cb + cw0 * rx[i] + cw1 * rx[i + 1] + cw2 * rx[i + 2] + cw3 * rx[i + 3];
            }
            __syncthreads();
#pragma unroll
            for (int i = 0; i < 16; ++i) xs[i][j] = xc[i];
            __syncthreads();
#pragma unroll
            for (int ii = 0; ii < 16; ++ii) {
                const int i = dir == 0 ? ii : 15 - ii;
                float ra = bav, xa = bxv;
#pragma unroll
                for (int k = 0; k < 64; ++k) { const float xv = xs[i][k]; ra += xv * wac[k]; xa += xv * wxc[k]; }
                const float r = sigmoidf_(ra), ig = sigmoidf_(xa);
                const float log_a = coef * r, a = __expf(log_a), mult = sqrtf(fmaxf(-expm1f(2.0f * log_a), 0.f));
                hst = a * hst + mult * ig * xc[i];
                if (lat) {
                    const int p = (dir == 0 ? s0 : L - 16 - s0) + i;
                    const int tt = (p % GROWS) * GRIDW + (p / GROWS);
                    float* dst = HACC + ((size_t)b * T + tt) * RGW + c;
                    if (dir == 0) *dst = hst; else *dst += hst;
                }
            }
        }
    }
}

__device__ __forceinline__ float gelu_tanh(float x) { const float u = 0.7978845608028654f * (x + 0.044715f * x * x * x); return 0.5f * x * (1.0f + tanhf(u)); }
__global__ __launch_bounds__(256) void k_mix_finish(const bf16_t* __restrict__ P, const float* __restrict__ OACC, const float* __restrict__ HACC,
                                                    const float* __restrict__ hg_nw, bf16_t* __restrict__ MIX) {
    const int lane = threadIdx.x & 63, r = blockIdx.x * 4 + (threadIdx.x >> 6), c0 = lane * 8;
    float o[8]; float ss = 0.f;
#pragma unroll
    for (int i = 0; i < 8; ++i) { o[i] = OACC[(size_t)r * HGW + c0 + i]; ss += o[i] * o[i]; }
    ss += __shfl_xor(ss, 1); ss += __shfl_xor(ss, 2); ss += __shfl_xor(ss, 4); ss += __shfl_xor(ss, 8);
    const float rstd = rsqrtf(ss * (1.0f / 128.0f) + EPS);
    const bf16_t* pr = P + (size_t)r * INW;
    u32 w[4];
#pragma unroll
    for (int i = 0; i < 8; i += 2) {
        const float g0 = bf2f(pr[C_G + c0 + i]), g1 = bf2f(pr[C_G + c0 + i + 1]);
        const float a0 = o[i] * rstd * hg_nw[c0 + i] * (g0 * sigmoidf_(g0)), a1 = o[i + 1] * rstd * hg_nw[c0 + i + 1] * (g1 * sigmoidf_(g1));
        w[i >> 1] = pk2(a0, a1);
    }
    *(uint4*)(MIX + (size_t)r * D + c0) = make_uint4(w[0], w[1], w[2], w[3]);
#pragma unroll
    for (int i = 0; i < 8; i += 2) {
        const float g0 = bf2f(pr[C_RG + c0 + i]), g1 = bf2f(pr[C_RG + c0 + i + 1]);
        const float a0 = gelu_tanh(g0) * HACC[(size_t)r * RGW + c0 + i], a1 = gelu_tanh(g1) * HACC[(size_t)r * RGW + c0 + i + 1];
        w[i >> 1] = pk2(a0, a1);
    }
    *(uint4*)(MIX + (size_t)r * D + HGW + c0) = make_uint4(w[0], w[1], w[2], w[3]);
}

constexpr int RT_LDS = 32 * 1024 * 4 + 4096 + 256 * 4 * 8;
__global__ __launch_bounds__(512) void k_norm2_route(const float* __restrict__ x1, const float* __restrict__ nw, const float* __restrict__ mod,
                                                     const float* __restrict__ rw, const float* __restrict__ rb, bf16_t* __restrict__ H2,
                                                     u32* __restrict__ cnt, u32* __restrict__ toktab, float* __restrict__ wtab) {
    extern __shared__ __attribute__((aligned(16))) unsigned char lds[];
    float* rwT = (float*)lds;
    u32* hist = (u32*)(lds + 131072);
    u32* ent = (u32*)(lds + 131072 + 4096);
    const int tid = threadIdx.x, lane = tid & 63, w = tid >> 6, G = gridDim.x;
    for (int i = tid; i < 32 * 1024; i += 512) { const int k = i >> 5, e = i & 31; rwT[e * 1024 + k] = rw[i]; }
    if (tid < 128) hist[tid] = 0;
    __syncthreads();
    const int gw = blockIdx.x * 8 + w, NW = G * 8;
    int it = 0;
    for (int r = gw; r < NLAT; r += NW, ++it) {
        const float* m = mod + (size_t)(r >> 11) * 6144;
        float4 v[4]; float ss = 0.f;
#pragma unroll
        for (int j = 0; j < 4; ++j) { v[j] = *(const float4*)(x1 + (size_t)r * D + j * 256 + lane * 4); ss += v[j].x * v[j].x + v[j].y * v[j].y + v[j].z * v[j].z + v[j].w * v[j].w; }
        const float rstd = rsqrtf(wave_sum(ss) * (1.0f / D) + EPS);
#pragma unroll
        for (int j = 0; j < 4; ++j) {
            const int c0 = j * 256 + lane * 4;
            const float4 ww = *(const float4*)(nw + c0), sh = *(const float4*)(m + 3072 + c0), sc = *(const float4*)(m + 4096 + c0);
            v[j].x = v[j].x * rstd * ww.x * (1.f + sc.x) + sh.x; v[j].y = v[j].y * rstd * ww.y * (1.f + sc.y) + sh.y;
            v[j].z = v[j].z * rstd * ww.z * (1.f + sc.z) + sh.z; v[j].w = v[j].w * rstd * ww.w * (1.f + sc.w) + sh.w;
            uint2 p; p.x = pk2(v[j].x, v[j].y); p.y = pk2(v[j].z, v[j].w);
            *(uint2*)(H2 + (size_t)r * D + c0) = p;
        }
        float mylogit = 0.f;
        for (int e = 0; e < 32; ++e) {
            float p = 0.f;
#pragma unroll
            for (int j = 0; j < 4; ++j) { const float4 q = *(const float4*)(rwT + e * 1024 + j * 256 + lane * 4); p += v[j].x * q.x + v[j].y * q.y + v[j].z * q.z + v[j].w * q.w; }
            p = wave_sum(p);
            if ((lane & 31) == e) mylogit = p + rb[e];
        }
        float tv[4]; int ti[4]; float cur = mylogit;
#pragma unroll
        for (int k = 0; k < 4; ++k) {
            float bv = cur; int bi = lane & 31;
#pragma unroll
            for (int o = 1; o < 32; o <<= 1) { const float ov = __shfl_xor(bv, o); const int oi = __shfl_xor(bi, o); if (ov > bv || (ov == bv && oi < bi)) { bv = ov; bi = oi; } }
            tv[k] = bv; ti[k] = bi; if ((lane & 31) == bi) cur = -3.0e38f;
        }
        const float e1 = __expf(tv[1] - tv[0]), e2 = __expf(tv[2] - tv[0]), e3 = __expf(tv[3] - tv[0]); const float inv = 1.0f / (1.0f + e1 + e2 + e3);
        const float gwt[4] = {inv, e1 * inv, e2 * inv, e3 * inv};
        if (lane < 4) {
            const int half = r >= HALF_TOK ? 1 : 0; const int e = ti[lane];
            const u32 lp = atomicAdd(&hist[half * 32 + e], 1u);
            const int idx = (it * 8 + w) * 4 + lane;
            ent[idx * 2] = ((u32)e << 24) | lp; ent[idx * 2 + 1] = __float_as_uint(gwt[lane]);
        }
    }
    __syncthreads();
    if (tid < 64) hist[64 + tid] = atomicAdd(&cnt[tid], hist[tid]);
    __syncthreads();
    it = 0;
    for (int r = gw; r < NLAT; r += NW, ++it) {
        if (lane < 4) {
            const int half = r >= HALF_TOK ? 1 : 0; const int idx = (it * 8 + w) * 4 + lane;
            const u32 ev = ent[idx * 2]; const int e = ev >> 24; const u32 pos = hist[64 + half * 32 + e] + (ev & 0xffffffu);
            toktab[((size_t)half * 32 + e) * CAP + pos] = (u32)r * 4u + lane;
            wtab[((size_t)half * 32 + e) * CAP + pos] = __uint_as_float(ent[idx * 2 + 1]);
        }
    }
}

__device__ __forceinline__ bool moe_tile(const u32* __restrict__ cnt, int half, int bm, int& e, int& pos0, int& cn) {
    int start = 0;
    for (int i = 0; i < NE; ++i) { const int c = (int)cnt[half * 32 + i], pad = (c + 255) & ~255; if (bm * 128 < start + pad) { e = i; pos0 = bm * 128 - start; cn = c; return true; } start += pad; }
    return false;
}
__global__ __launch_bounds__(256) void k_moe_gu(const bf16_t* __restrict__ H2, const float* __restrict__ wgu, const float* __restrict__ bgu, const u32* __restrict__ cnt,
                                                const u32* __restrict__ toktab, bf16_t* __restrict__ ACT, int half) {
    __shared__ float As[16][132]; __shared__ float Bs[16][132];
    const int bn = blockIdx.x, bm = blockIdx.y, t = threadIdx.x, ty = t >> 4, tx = t & 15;
    int e, pos0, cn; if (!moe_tile(cnt, half, bm, e, pos0, cn)) return;
    const int ap = pos0 + (t >> 1);
    const u32 tk = ap < cn ? toktab[((size_t)half * 32 + e) * CAP + ap] : toktab[((size_t)half * 32 + e) * CAP];
    const bf16_t* arow = H2 + (size_t)(tk >> 2) * D;
    const float* Bp = wgu + (size_t)e * D * 2048 + bn * 128;
    float acc[8][8]; ZERO_ACC(acc);
    gemm_tile_128(arow, Bp, 2048, D, acc, As, Bs);
    float gl[8][8];
    const int c0 = bn * 128 + tx * 8;
#pragma unroll
    for (int i = 0; i < 8; ++i)
#pragma unroll
        for (int j = 0; j < 8; ++j) { const float g = fminf(acc[i][j] + bgu[e * 2048 + c0 + j], 7.0f); gl[i][j] = g * sigmoidf_(1.702f * g); acc[i][j] = 0.f; }
    gemm_tile_128(arow, Bp + 1024, 2048, D, acc, As, Bs);
#pragma unroll
    for (int i = 0; i < 8; ++i) {
        float o[8];
#pragma unroll
        for (int j = 0; j < 8; ++j) { const float u = fminf(fmaxf(acc[i][j] + bgu[e * 2048 + 1024 + c0 + j], -7.0f), 7.0f); o[j] = gl[i][j] * (u + 1.0f); }
        uint4 ov; ov.x = pk2(o[0], o[1]); ov.y = pk2(o[2], o[3]); ov.z = pk2(o[4], o[5]); ov.w = pk2(o[6], o[7]);
        *(uint4*)(ACT + (size_t)(bm * 128 + ty * 8 + i) * DFF + c0) = ov;
    }
}
__global__ __launch_bounds__(256) void k_moe_down(const bf16_t* __restrict__ ACT, const float* __restrict__ wd, const float* __restrict__ bd, const u32* __restrict__ cnt,
                                                  const u32* __restrict__ toktab, const float* __restrict__ wtab, bf16_t* __restrict__ Y, int half) {
    __shared__ float As[16][132]; __shared__ float Bs[16][132];
    const int bn = blockIdx.x, bm = blockIdx.y, t = threadIdx.x, ty = t >> 4, tx = t & 15;
    int e, pos0, cn; if (!moe_tile(cnt, half, bm, e, pos0, cn)) return;
    float acc[8][8]; ZERO_ACC(acc);
    gemm_tile_128(ACT + (size_t)(bm * 128 + (t >> 1)) * DFF, wd + (size_t)e * DFF * D + bn * 128, D, DFF, acc, As, Bs);
    const int c0 = bn * 128 + tx * 8;
#pragma unroll
    for (int i = 0; i < 8; ++i) {
        const int p = pos0 + ty * 8 + i;
        if (p < cn) {
            const u32 tk = toktab[((size_t)half * 32 + e) * CAP + p]; const float wgt = wtab[((size_t)half * 32 + e) * CAP + p];
            float o[8];
#pragma unroll
            for (int j = 0; j < 8; ++j) o[j] = wgt * (acc[i][j] + bd[e * D + c0 + j]);
            uint4 ov; ov.x = pk2(o[0], o[1]); ov.y = pk2(o[2], o[3]); ov.z = pk2(o[4], o[5]); ov.w = pk2(o[6], o[7]);
            *(uint4*)(Y + (size_t)(tk - (u32)half * HALF_TOK * 4u) * D + c0) = ov;
        }
    }
}
__global__ __launch_bounds__(256) void k_combine(float* __restrict__ out, const bf16_t* __restrict__ Y, const float* __restrict__ mod, const float* __restrict__ fw, int half) {
    const int lane = threadIdx.x & 63, rl = blockIdx.x * 4 + (threadIdx.x >> 6), r = half * HALF_TOK + rl;
    const float* g2 = mod + (size_t)(r >> 11) * 6144 + 5120;
    float4 v[4]; float ss = 0.f;
#pragma unroll
    for (int j = 0; j < 4; ++j) {
        const int c0 = j * 256 + lane * 4;
        v[j] = *(const float4*)(out + (size_t)r * D + c0);
        float s0 = 0.f, s1 = 0.f, s2 = 0.f, s3 = 0.f;
#pragma unroll
        for (int k = 0; k < 4; ++k) { const uint2 y = *(const uint2*)(Y + ((size_t)rl * 4 + k) * D + c0);
            s0 += __uint_as_float(y.x << 16); s1 += __uint_as_float(y.x & 0xffff0000u); s2 += __uint_as_float(y.y << 16); s3 += __uint_as_float(y.y & 0xffff0000u); }
        const float4 g = *(const float4*)(g2 + c0);
        v[j].x += g.x * s0; v[j].y += g.y * s1; v[j].z += g.z * s2; v[j].w += g.w * s3;
        ss += v[j].x * v[j].x + v[j].y * v[j].y + v[j].z * v[j].z + v[j].w * v[j].w;
    }
    const float rstd = rsqrtf(wave_sum(ss) * (1.0f / D) + EPS);
#pragma unroll
    for (int j = 0; j < 4; ++j) {
        const int c0 = j * 256 + lane * 4; const float4 w = *(const float4*)(fw + c0);
        *(float4*)(out + (size_t)r * D + c0) = make_float4(v[j].x * rstd * w.x, v[j].y * rstd * w.y, v[j].z * rstd * w.z, v[j].w * rstd * w.w);
    }
}


#define LAS __attribute__((address_space(3)))
typedef short bf16x8 __attribute__((ext_vector_type(8)));
typedef float f32x4 __attribute__((ext_vector_type(4)));
typedef unsigned u32x4 __attribute__((ext_vector_type(4)));
constexpr int BM = 256, BK = 64, HALFT = 128, HTB = HALFT * BK * 2, STAGE_BYTES = 8 * HTB, NXCD = 8, WGM = 8;
constexpr int GK = 1024;
constexpr int LDS_BYTES = 147456;
constexpr int LDS_AUX = STAGE_BYTES;

__device__ __forceinline__ int lds_byte(int r, int c) { const int st = (r >> 4) * 2 + (c >> 5), rr = r & 15, cc = c & 31, ob = rr * 64 + cc * 2; return st * 1024 + (ob ^ (((ob >> 9) & 1) << 5)); }
__device__ __forceinline__ void stage_rc(int b, int& R, int& C) { const int st = b / 1024, sb = b % 1024, swz = sb ^ (((sb >> 9) & 1) << 5); R = (st >> 1) * 16 + swz / 64; C = (st & 1) * 32 + (swz % 64) / 2; }
__device__ __forceinline__ int perm32(int rho) { const int n = rho >> 4, i = rho & 15; return 8 * (i >> 2) + 4 * n + (i & 3); }
__device__ __forceinline__ unsigned cvt_pk_bf16(float lo, float hi) { unsigned r; asm volatile("v_cvt_pk_bf16_f32 %0, %1, %2" : "=v"(r) : "v"(lo), "v"(hi)); return r; }

struct Unit { int pm, pn, e, pos0, cn; };
struct TileOrder {
    int nM, nN, nwg, G, c;
    __device__ __forceinline__ void init(int nM_, int nN_, int G_, int c_) { nM = nM_; nN = nN_; nwg = nM * nN; G = G_; c = c_; }
    __device__ __forceinline__ bool tile(int i, int& pm, int& pn) const {
        const long L = (long)i * G + c; if (L >= nwg) return false;
        int wgid = (int)L; { const int q = nwg / NXCD, r = nwg % NXCD, xcd = wgid % NXCD, off = wgid / NXCD; wgid = (xcd < r ? xcd * (q + 1) : r * (q + 1) + (xcd - r) * q) + off; }
        const int nig = WGM * nN, gid = wgid / nig, fm = gid * WGM, gsz = (nM - fm) < WGM ? (nM - fm) : WGM;
        pm = fm + ((wgid % nig) % gsz); pn = (wgid % nig) / gsz; return true;
    }
};

template <class POL>
__device__ __forceinline__ void gemm_phase(LAS unsigned char* lds, const POL& P) {
    const int tid = threadIdx.x, wid = __builtin_amdgcn_readfirstlane(tid >> 6), lane = tid & 63, wr = wid >> 2, wc = wid & 3, fr = lane & 15, fq = lane >> 4;
    constexpr int K = GK, nt = K / BK;
    int sR[2], sC[2]; unsigned voffA[2], voffB[2];
#pragma unroll
    for (int i = 0; i < 2; ++i) { stage_rc(tid * 16 + i * 8192, sR[i], sC[i]); const int Rb = POL::PERM ? ((sR[i] & ~31) + perm32(sR[i] & 31)) : sR[i]; voffA[i] = (unsigned)(sR[i] * K + sC[i]) * 2u; voffB[i] = (unsigned)(Rb * K + sC[i]) * 2u; }
    constexpr size_t kstep = (size_t)(BK * 2);
    constexpr unsigned hstepB = (unsigned)HALFT * K * 2;
    const unsigned ldsw = (unsigned)wid * 1024u;
    const int aoff = lds_byte(wr * 64 + fr, fq * 8), boff = lds_byte(wc * 32 + fr, fq * 8);
#define G_SA(b, h) (((b) * 2 + (h)) * HTB)
#define G_SB(b, h) ((4 + (b) * 2 + (h)) * HTB)
#define G_AOFF(OFF, h, i) (POL::GATHER ? (OFF)[h][i] : voffA[i])
#define G_STAGE_A(bufoff, gbase, OFF, h) do { const char* _gb = (const char*)(gbase) + (POL::GATHER ? (size_t)0 : (size_t)(h) * hstepB); _Pragma("unroll") for (int _i = 0; _i < 2; ++_i) \
        __builtin_amdgcn_global_load_lds((const unsigned*)(_gb + G_AOFF(OFF, h, _i)), (LAS unsigned*)(lds + (bufoff) + ldsw + _i * 8192), 16, 0, 0); } while (0)
#define G_STAGE_B(bufoff, gbase, hoff) do { const char* _gb = (const char*)(gbase) + (size_t)(hoff); _Pragma("unroll") for (int _i = 0; _i < 2; ++_i) \
        __builtin_amdgcn_global_load_lds((const unsigned*)(_gb + voffB[_i]), (LAS unsigned*)(lds + (bufoff) + ldsw + _i * 8192), 16, 0, 0); } while (0)
#define G_LDA(dst, b, h) do { _Pragma("unroll") for (int m = 0; m < 4; ++m) _Pragma("unroll") for (int k = 0; k < 2; ++k) dst[m][k] = *(const LAS bf16x8*)(lds + G_SA(b, h) + aoff + m * 2048 + k * 1024); } while (0)
#define G_LDB(dst, b, h) do { _Pragma("unroll") for (int n = 0; n < 2; ++n) _Pragma("unroll") for (int k = 0; k < 2; ++k) dst[n][k] = *(const LAS bf16x8*)(lds + G_SB(b, h) + boff + n * 2048 + k * 1024); } while (0)
#define G_MMA(ai, bj, At, Bt) do { __builtin_amdgcn_s_setprio(1); _Pragma("unroll") for (int m = 0; m < 4; ++m) _Pragma("unroll") for (int n = 0; n < 2; ++n) _Pragma("unroll") for (int k = 0; k < 2; ++k) \
        acc[ai][bj][m][n] = __builtin_amdgcn_mfma_f32_16x16x32_bf16(Bt[n][k], At[m][k], acc[ai][bj][m][n], 0, 0, 0); __builtin_amdgcn_s_setprio(0); } while (0)
#define G_WAIT_V(n) asm volatile("s_waitcnt vmcnt(" #n ")" ::: "memory")
#define G_WAIT_L(n) asm volatile("s_waitcnt lgkmcnt(" #n ")" ::: "memory")
#define G_BAR __builtin_amdgcn_s_barrier()
#define G_SCHED __builtin_amdgcn_sched_barrier(0)
#define G_TRIP(A1, OC, A2, ON, B2) do { \
        G_LDB(B0, 0, 0); G_SCHED; G_LDA(At, 0, 0); G_STAGE_A(G_SA(1, 1), A1, OC, 1); \
        G_WAIT_L(8); G_BAR; G_WAIT_L(0); G_MMA(0, 0, At, B0); G_BAR; G_SCHED; \
        G_LDB(B1, 0, 1); G_STAGE_B(G_SB(0, 0), B2, 0u); \
        G_BAR; G_WAIT_L(0); G_MMA(0, 1, At, B1); G_BAR; \
        G_LDA(At, 0, 1); G_STAGE_A(G_SA(0, 0), A2, ON, 0); \
        G_BAR; G_WAIT_L(0); G_MMA(1, 0, At, B0); G_BAR; G_SCHED; \
        G_STAGE_B(G_SB(0, 1), B2, hstepB); \
        G_WAIT_V(6); G_BAR; G_MMA(1, 1, At, B1); G_BAR; \
        G_LDB(B0, 1, 0); G_SCHED; G_LDA(At, 1, 0); G_STAGE_A(G_SA(0, 1), A2, ON, 1); \
        G_WAIT_L(8); G_BAR; G_WAIT_L(0); G_MMA(0, 0, At, B0); G_BAR; G_SCHED; \
        G_LDB(B1, 1, 1); G_STAGE_B(G_SB(1, 0), (B2) + kstep, 0u); \
        G_BAR; G_WAIT_L(0); G_MMA(0, 1, At, B1); G_BAR; \
        G_LDA(At, 1, 1); G_STAGE_A(G_SA(1, 0), (A2) + kstep, ON, 0); \
        G_BAR; G_WAIT_L(0); G_MMA(1, 0, At, B0); G_BAR; G_SCHED; \
        G_STAGE_B(G_SB(1, 1), (B2) + kstep, hstepB); \
        G_WAIT_V(6); G_BAR; G_MMA(1, 1, At, B1); G_BAR; } while (0)
    Unit cur, nxt; int ui = 0;
    if (!P.next(0, cur)) return;
    f32x4 acc[2][2][4][2];
#pragma unroll
    for (int a = 0; a < 2; ++a)
#pragma unroll
        for (int b = 0; b < 2; ++b)
#pragma unroll
            for (int m = 0; m < 4; ++m)
#pragma unroll
                for (int n = 0; n < 2; ++n) acc[a][b][m][n] = (f32x4){0.f, 0.f, 0.f, 0.f};
    bf16x8 At[4][2], B0[2][2], B1[2][2];
    unsigned oc[2][2], on[2][2];
#pragma unroll
    for (int h = 0; h < 2; ++h)
#pragma unroll
        for (int i = 0; i < 2; ++i) { oc[h][i] = POL::GATHER ? P.a_off(cur, h * HALFT + sR[i]) + (unsigned)sC[i] * 2u : 0u; on[h][i] = 0u; }
    const char* cA = P.a_base(cur); const char* cB = P.b_base(cur);
    G_STAGE_B(G_SB(0, 0), cB, 0u); G_STAGE_A(G_SA(0, 0), cA, oc, 0); G_STAGE_B(G_SB(0, 1), cB, hstepB); G_STAGE_A(G_SA(0, 1), cA, oc, 1);
    if (wr == 1) G_BAR;
    G_WAIT_V(4); G_BAR;
    G_STAGE_B(G_SB(1, 0), cB + kstep, 0u); G_STAGE_A(G_SA(1, 0), cA + kstep, oc, 0); G_STAGE_B(G_SB(1, 1), cB + kstep, hstepB);
    G_WAIT_V(6); G_BAR;
    for (;;) {
        const bool has_next = P.next(ui + 1, nxt);
        const char* nA = has_next ? P.a_base(nxt) : cA; const char* nB = has_next ? P.b_base(nxt) : cB;
        if (POL::GATHER) {
#pragma unroll
            for (int h = 0; h < 2; ++h)
#pragma unroll
                for (int i = 0; i < 2; ++i) on[h][i] = has_next ? P.a_off(nxt, h * HALFT + sR[i]) + (unsigned)sC[i] * 2u : oc[h][i];
        }
        for (int t = 0; t < nt - 2; t += 2) {
            const char* a1 = cA + (size_t)(t + 1) * kstep; const char* a2 = cA + (size_t)(t + 2) * kstep; const char* b2 = cB + (size_t)(t + 2) * kstep;
            G_TRIP(a1, oc, a2, oc, b2);
        }
        {
            const char* a1 = cA + (size_t)(nt - 1) * kstep;
            if (POL::GATHER) { G_TRIP(a1, oc, nA, on, nB); } else { G_TRIP(a1, oc, nA, oc, nB); }
        }
        if (wr == 0) G_BAR;
        P.epi(acc, cur, wr, wc, fr, fq);
        if (!has_next) break;
#pragma unroll
        for (int a = 0; a < 2; ++a)
#pragma unroll
            for (int b = 0; b < 2; ++b)
#pragma unroll
                for (int m = 0; m < 4; ++m)
#pragma unroll
                    for (int n = 0; n < 2; ++n) acc[a][b][m][n] = (f32x4){0.f, 0.f, 0.f, 0.f};
        cur = nxt; cA = nA; cB = nB; ++ui;
        if (POL::GATHER) {
#pragma unroll
            for (int h = 0; h < 2; ++h)
#pragma unroll
                for (int i = 0; i < 2; ++i) oc[h][i] = on[h][i];
        }
        if (wr == 1) G_BAR;
    }
    G_WAIT_V(0);
    G_BAR;
#undef G_SA
#undef G_SB
#undef G_AOFF
#undef G_STAGE_A
#undef G_STAGE_B
#undef G_LDA
#undef G_LDB
#undef G_MMA
#undef G_WAIT_V
#undef G_WAIT_L
#undef G_BAR
#undef G_SCHED
#undef G_TRIP
}

struct PolInProj {
    static constexpr bool PERM = true, GATHER = false;
    const bf16_t* A; const bf16_t* Bt; bf16_t* O; TileOrder ord;
    __device__ __forceinline__ bool next(int i, Unit& u) const { return ord.tile(i, u.pm, u.pn); }
    __device__ __forceinline__ const char* a_base(const Unit& u) const { return (const char*)A + (size_t)u.pm * BM * GK * 2; }
    __device__ __forceinline__ unsigned a_off(const Unit&, int r) const { return (unsigned)r * GK * 2u; }
    __device__ __forceinline__ const char* b_base(const Unit& u) const { return (const char*)Bt + (size_t)u.pn * BM * GK * 2; }
    __device__ __forceinline__ void epi(const f32x4 (&acc)[2][2][4][2], const Unit& u, int wr, int wc, int fr, int fq) const {
        const int row0 = u.pm * BM + wr * 64 + fr, col0 = u.pn * BM + wc * 32 + 8 * fq;
#pragma unroll
        for (int ai = 0; ai < 2; ++ai)
#pragma unroll
            for (int m = 0; m < 4; ++m) { bf16_t* rowp = O + (size_t)(row0 + ai * HALFT + m * 16) * INW + col0;
#pragma unroll
                for (int bj = 0; bj < 2; ++bj) { const f32x4 v0 = acc[ai][bj][m][0], v1 = acc[ai][bj][m][1];
                    u32x4 w; w.x = cvt_pk_bf16(v0[0], v0[1]); w.y = cvt_pk_bf16(v0[2], v0[3]); w.z = cvt_pk_bf16(v1[0], v1[1]); w.w = cvt_pk_bf16(v1[2], v1[3]);
                    *(u32x4*)(rowp + bj * HALFT) = w; } }
    }
};
struct PolOutProj {
    static constexpr bool PERM = false, GATHER = false;
    const bf16_t* A; const bf16_t* Bt; const float* x; const float* mod; float* O; TileOrder ord;
    __device__ __forceinline__ bool next(int i, Unit& u) const { return ord.tile(i, u.pm, u.pn); }
    __device__ __forceinline__ const char* a_base(const Unit& u) const { return (const char*)A + (size_t)u.pm * BM * GK * 2; }
    __device__ __forceinline__ unsigned a_off(const Unit&, int r) const { return (unsigned)r * GK * 2u; }
    __device__ __forceinline__ const char* b_base(const Unit& u) const { return (const char*)Bt + (size_t)u.pn * BM * GK * 2; }
    __device__ __forceinline__ void epi(const f32x4 (&acc)[2][2][4][2], const Unit& u, int wr, int wc, int fr, int fq) const {
        const int row0 = u.pm * BM + wr * 64 + fr, col0 = u.pn * BM + wc * 32 + 4 * fq;
        const float* g1 = mod + (size_t)((u.pm * BM) >> 11) * 6144 + 2048 + col0;
        f32x4 gv[2][2];
#pragma unroll
        for (int bj = 0; bj < 2; ++bj)
#pragma unroll
            for (int n = 0; n < 2; ++n) gv[bj][n] = *(const f32x4*)(g1 + bj * HALFT + n * 16);
#pragma unroll
        for (int ai = 0; ai < 2; ++ai)
#pragma unroll
            for (int m = 0; m < 4; ++m) { const size_t off = (size_t)(row0 + ai * HALFT + m * 16) * D + col0;
#pragma unroll
                for (int bj = 0; bj < 2; ++bj)
#pragma unroll
                    for (int n = 0; n < 2; ++n) { const f32x4 xv = *(const f32x4*)(x + off + bj * HALFT + n * 16); *(f32x4*)(O + off + bj * HALFT + n * 16) = xv + gv[bj][n] * acc[ai][bj][m][n]; } }
    }
};
struct MoeTiles {
    const LAS int* tstart; const u32* cnt; int half;
    __device__ __forceinline__ void find(Unit& u) const {
        int e = 0;
#pragma unroll 1
        for (int i = 1; i < NE; ++i) if (u.pm >= tstart[i]) e = i;
        u.e = e; u.pos0 = (u.pm - tstart[e]) * BM; u.cn = (int)cnt[half * NE + e];
    }
};
struct PolGateUp {
    static constexpr bool PERM = true, GATHER = true;
    const bf16_t* A; const bf16_t* Bt; const float* bgu; const u32* toktab; bf16_t* O; MoeTiles mt; TileOrder ord;
    __device__ __forceinline__ bool next(int i, Unit& u) const { if (!ord.tile(i, u.pm, u.pn)) return false; mt.find(u); return true; }
    __device__ __forceinline__ const char* a_base(const Unit&) const { return (const char*)A; }
    __device__ __forceinline__ unsigned a_off(const Unit& u, int r) const {
        const int p = u.pos0 + r; const u32 tk = toktab[((size_t)mt.half * NE + u.e) * CAP + (p < u.cn ? p : 0)];
        return (tk >> 2) * (unsigned)(GK * 2);
    }
    __device__ __forceinline__ const char* b_base(const Unit& u) const { return (const char*)Bt + ((size_t)u.e * 2048 + (size_t)u.pn * BM) * GK * 2; }
    __device__ __forceinline__ void epi(const f32x4 (&acc)[2][2][4][2], const Unit& u, int wr, int wc, int fr, int fq) const {
        const int row0 = u.pm * BM + wr * 64 + fr, cc = u.pn * HALFT + wc * 32 + 8 * fq;
        const float* bg = bgu + (size_t)u.e * 2048 + cc;
        const f32x4 bg0 = *(const f32x4*)bg, bg1 = *(const f32x4*)(bg + 4), bu0 = *(const f32x4*)(bg + 1024), bu1 = *(const f32x4*)(bg + 1028);
#pragma unroll
        for (int ai = 0; ai < 2; ++ai)
#pragma unroll
            for (int m = 0; m < 4; ++m) {
                f32x4 g0 = acc[ai][0][m][0] + bg0, g1 = acc[ai][0][m][1] + bg1, u0 = acc[ai][1][m][0] + bu0, u1 = acc[ai][1][m][1] + bu1;
                float o[8];
#pragma unroll
                for (int j = 0; j < 4; ++j) {
                    const float ga = fminf(g0[j], 7.0f), gb = fminf(g1[j], 7.0f);
                    const float ua = fminf(fmaxf(u0[j], -7.0f), 7.0f), ub = fminf(fmaxf(u1[j], -7.0f), 7.0f);
                    o[j] = ga * sigmoidf_(1.702f * ga) * (ua + 1.0f); o[4 + j] = gb * sigmoidf_(1.702f * gb) * (ub + 1.0f);
                }
                u32x4 w; w.x = cvt_pk_bf16(o[0], o[1]); w.y = cvt_pk_bf16(o[2], o[3]); w.z = cvt_pk_bf16(o[4], o[5]); w.w = cvt_pk_bf16(o[6], o[7]);
                *(u32x4*)(O + (size_t)(row0 + ai * HALFT + m * 16) * DFF + cc) = w;
            }
    }
};
struct PolDown {
    static constexpr bool PERM = true, GATHER = false;
    const bf16_t* A; const bf16_t* Bt; const float* bd; const u32* toktab; const float* wtab; bf16_t* O; MoeTiles mt; TileOrder ord;
    __device__ __forceinline__ bool next(int i, Unit& u) const { if (!ord.tile(i, u.pm, u.pn)) return false; mt.find(u); return true; }
    __device__ __forceinline__ const char* a_base(const Unit& u) const { return (const char*)A + (size_t)u.pm * BM * GK * 2; }
    __device__ __forceinline__ unsigned a_off(const Unit&, int r) const { return (unsigned)r * GK * 2u; }
    __device__ __forceinline__ const char* b_base(const Unit& u) const { return (const char*)Bt + ((size_t)u.e * 1024 + (size_t)u.pn * BM) * GK * 2; }
    __device__ __forceinline__ void epi(const f32x4 (&acc)[2][2][4][2], const Unit& u, int wr, int wc, int fr, int fq) const {
        const int col0 = u.pn * BM + wc * 32 + 8 * fq;
        const float* bp = bd + (size_t)u.e * D + col0;
        f32x4 bv[2][2];
#pragma unroll
        for (int bj = 0; bj < 2; ++bj) { bv[bj][0] = *(const f32x4*)(bp + bj * HALFT); bv[bj][1] = *(const f32x4*)(bp + bj * HALFT + 4); }
        const size_t tb = ((size_t)mt.half * NE + u.e) * CAP;
#pragma unroll
        for (int ai = 0; ai < 2; ++ai)
#pragma unroll
            for (int m = 0; m < 4; ++m) {
                const int p = u.pos0 + ai * HALFT + wr * 64 + m * 16 + fr;
                if (p < u.cn) {
                    const u32 tk = toktab[tb + p]; const float wg = wtab[tb + p];
                    bf16_t* rowp = O + (size_t)(tk - (u32)mt.half * HALF_TOK * 4u) * D + col0;
#pragma unroll
                    for (int bj = 0; bj < 2; ++bj) { const f32x4 v0 = (acc[ai][bj][m][0] + bv[bj][0]) * wg, v1 = (acc[ai][bj][m][1] + bv[bj][1]) * wg;
                        u32x4 w; w.x = cvt_pk_bf16(v0[0], v0[1]); w.y = cvt_pk_bf16(v0[2], v0[3]); w.z = cvt_pk_bf16(v1[0], v1[1]); w.w = cvt_pk_bf16(v1[2], v1[3]);
                        *(u32x4*)(rowp + bj * HALFT) = w; }
                }
            }
    }
};
__device__ __forceinline__ int moe_tile_table(LAS int* tstart, const u32* cnt, int half) {
    if (threadIdx.x == 0) { int s = 0; for (int e = 0; e < NE; ++e) { tstart[e] = s; s += ((int)cnt[half * NE + e] + BM - 1) / BM; } tstart[NE] = s; }
    __syncthreads();
    const int tot = tstart[NE];
    return tot;
}

__device__ __forceinline__ void conv_item(const float* __restrict__ W, int N, bf16_t* __restrict__ WT, int k0, int n0, size_t rowbase, LAS float* scr, int lane) {
#pragma unroll 4
    for (int i = 0; i < 16; ++i) { const int k = 4 * i + (lane >> 4); const f32x4 v = *(const f32x4*)(W + (size_t)(k0 + k) * N + n0 + (lane & 15) * 4); *(LAS f32x4*)(scr + k * 68 + (lane & 15) * 4) = v; }
    asm volatile("s_waitcnt lgkmcnt(0)" ::: "memory");
    const int c = lane & 7;
#pragma unroll
    for (int j = 0; j < 8; ++j) { const int n = (lane >> 3) + 8 * j; const LAS float* s = scr + (8 * c) * 68 + n;
        u32x4 o; o.x = cvt_pk_bf16(s[0 * 68], s[1 * 68]); o.y = cvt_pk_bf16(s[2 * 68], s[3 * 68]); o.z = cvt_pk_bf16(s[4 * 68], s[5 * 68]); o.w = cvt_pk_bf16(s[6 * 68], s[7 * 68]);
        *(u32x4*)(WT + (rowbase + n) * GK + k0 + 8 * c) = o; }
    asm volatile("s_waitcnt lgkmcnt(0)" ::: "memory");
}
constexpr int IT_IN = 16 * (INW / 64), IT_OUT = 16 * (D / 64), IT_GU = NE * 16 * 32, IT_D = NE * 16 * 16, IT_ALL = IT_IN + IT_OUT + IT_GU + IT_D;
struct ProArgs { const float *c, *c_ctx, *w_ada, *b_ada, *lbl, *w_in, *w_out, *wgu, *wd; float *mod, *lb; bf16_t *Win_t, *Wout_t, *Wgu_t, *Wd_t; };
__device__ __forceinline__ void phase_prologue(LAS unsigned char* lds, const ProArgs& a, int bid, int G, bool do_mod, int it_lo, int it_hi) {
    const int tid = threadIdx.x, lane = tid & 63, w = tid >> 6;
    if (!do_mod) {} else if (bid < 96) {
        LAS float* s = (LAS float*)lds;
        for (int i = tid; i < 33 * D; i += 512) { const int b = i >> 10, k = i & 1023; const float v = b < NB ? a.c[(size_t)b * D + k] : a.c_ctx[k]; s[i] = v * sigmoidf_(v); }
        __syncthreads();
        const int n = bid * 64 + lane;
        float acc[33];
#pragma unroll
        for (int b = 0; b < 33; ++b) acc[b] = 0.f;
        for (int k = 128 * w; k < 128 * w + 128; k += 4) {
            const float w0 = a.w_ada[(size_t)k * 6144 + n], w1 = a.w_ada[(size_t)(k + 1) * 6144 + n], w2 = a.w_ada[(size_t)(k + 2) * 6144 + n], w3 = a.w_ada[(size_t)(k + 3) * 6144 + n];
#pragma unroll
            for (int b = 0; b < 33; ++b) { const f32x4 sv = *(const LAS f32x4*)(s + b * D + k); acc[b] += sv[0] * w0 + sv[1] * w1 + sv[2] * w2 + sv[3] * w3; }
        }
        __syncthreads();
        LAS float* red = (LAS float*)lds;
#pragma unroll
        for (int b = 0; b < 33; ++b) red[(w * 33 + b) * 64 + lane] = acc[b];
        __syncthreads();
        for (int i = tid; i < 33 * 64; i += 512) { const int b = i >> 6, l = i & 63; float sum = a.b_ada[bid * 64 + l];
#pragma unroll
            for (int ww = 0; ww < 8; ++ww) sum += red[(ww * 33 + b) * 64 + l];
            a.mod[(size_t)b * 6144 + bid * 64 + l] = sum; }
        __syncthreads();
    } else if (bid == 96) {
        for (int i = tid; i < 2 * HGW; i += 512) { const float l0 = a.lbl[i], l1 = a.lbl[2 * HGW + i]; a.lb[i] = 1.0f / (1.0f + __expf(l1 - l0)); }
    }
    LAS float* scr = (LAS float*)(lds + w * (64 * 68 * 4));
    const int gw = bid * 8 + w, NW = G * 8;
    for (int it = it_lo + gw; it < it_hi; it += NW) {
        int r = it;
        if (r < IT_IN) { const int kb = r / (INW / 64), nb = r % (INW / 64); conv_item(a.w_in, INW, a.Win_t, kb * 64, nb * 64, (size_t)nb * 64, scr, lane); continue; } r -= IT_IN;
        if (r < IT_OUT) { const int kb = r / 16, nb = r % 16; conv_item(a.w_out, D, a.Wout_t, kb * 64, nb * 64, (size_t)nb * 64, scr, lane); continue; } r -= IT_OUT;
        if (r < IT_GU) { const int e = r / 512, q = r % 512, kb = q / 32, nb = q % 32, n0 = nb * 64, bj = n0 >> 10, rem = n0 & 1023, pn = rem >> 7, cc0 = rem & 127;
            conv_item(a.wgu + (size_t)e * D * 2048, 2048, a.Wgu_t, kb * 64, n0, (size_t)e * 2048 + pn * 256 + bj * 128 + cc0, scr, lane); continue; } r -= IT_GU;
        { const int e = r / 256, q = r % 256, kb = q / 16, nb = q % 16; conv_item(a.wd + (size_t)e * DFF * D, D, a.Wd_t, kb * 64, nb * 64, (size_t)e * 1024 + nb * 64, scr, lane); }
    }
}

__global__ __launch_bounds__(512, 2) void k_prologue(ProArgs a, int do_mod, int it_lo, int it_hi) {
    extern __shared__ __attribute__((aligned(16))) unsigned char lds_[];
    phase_prologue((LAS unsigned char*)lds_, a, blockIdx.x, gridDim.x, do_mod != 0, it_lo, it_hi);
}
__global__ __launch_bounds__(512, 2) void k_g_inproj(const bf16_t* H, const bf16_t* Win_t, bf16_t* PROJ) {
    extern __shared__ __attribute__((aligned(16))) unsigned char lds_[];
    PolInProj P; P.A = H; P.Bt = Win_t; P.O = PROJ; P.ord.init(NROWS / BM, INW / BM, gridDim.x, blockIdx.x);
    gemm_phase(( LAS unsigned char*)lds_, P);
}
__global__ __launch_bounds__(512, 2) void k_g_outproj(const bf16_t* MIX, const bf16_t* Wout_t, const float* x, const float* mod, float* out) {
    extern __shared__ __attribute__((aligned(16))) unsigned char lds_[];
    PolOutProj P; P.A = MIX; P.Bt = Wout_t; P.x = x; P.mod = mod; P.O = out; P.ord.init(NLAT / BM, D / BM, gridDim.x, blockIdx.x);
    gemm_phase((LAS unsigned char*)lds_, P);
}
__global__ __launch_bounds__(512, 2) void k_g_gu(const bf16_t* H2, const bf16_t* Wgu_t, const float* bgu, const u32* cnt, const u32* toktab, bf16_t* ACT, int half) {
    extern __shared__ __attribute__((aligned(16))) unsigned char lds_[];
    LAS unsigned char* lds = (LAS unsigned char*)lds_;
    LAS int* tstart = (LAS int*)(lds + LDS_AUX);
    const int tot = moe_tile_table(tstart, cnt, half);
    PolGateUp P; P.A = H2; P.Bt = Wgu_t; P.bgu = bgu; P.toktab = toktab; P.O = ACT; P.mt.tstart = tstart; P.mt.cnt = cnt; P.mt.half = half;
    P.ord.init(tot, DFF / HALFT, gridDim.x, blockIdx.x);
    gemm_phase(lds, P);
}
__global__ __launch_bounds__(512, 2) void k_g_down(const bf16_t* ACT, const bf16_t* Wd_t, const float* bd, const u32* cnt, const u32* toktab, const float* wtab, bf16_t* Y, int half) {
    extern __shared__ __attribute__((aligned(16))) unsigned char lds_[];
    LAS unsigned char* lds = (LAS unsigned char*)lds_;
    LAS int* tstart = (LAS int*)(lds + LDS_AUX);
    const int tot = moe_tile_table(tstart, cnt, half);
    PolDown P; P.A = ACT; P.Bt = Wd_t; P.bd = bd; P.toktab = toktab; P.wtab = wtab; P.O = Y; P.mt.tstart = tstart; P.mt.cnt = cnt; P.mt.half = half;
    P.ord.init(tot, D / BM, gridDim.x, blockIdx.x);
    gemm_phase(lds, P);
}

extern "C" void kernel_launch(void* const* d_in, const int* in_sizes, int n_in, void* d_out, int out_size, void* d_ws, size_t ws_size, hipStream_t stream) {
    const float* x = (const float*)d_in[0]; const float* c = (const float*)d_in[1]; const float* ctx = (const float*)d_in[2]; const float* c_ctx = (const float*)d_in[3];
    const float* norm1_w = (const float*)d_in[4]; const float* norm2_w = (const float*)d_in[5]; const float* w_ada = (const float*)d_in[6]; const float* b_ada = (const float*)d_in[7];
    const float* w_in = (const float*)d_in[8]; const float* lbl = (const float*)d_in[9]; const float* hg_nw = (const float*)d_in[10];
    const float* conv_w = (const float*)d_in[11]; const float* conv_b = (const float*)d_in[12]; const float* rg_wa = (const float*)d_in[13]; const float* rg_ba = (const float*)d_in[14];
    const float* rg_wx = (const float*)d_in[15]; const float* rg_bx = (const float*)d_in[16]; const float* rg_lam = (const float*)d_in[17]; const float* w_out = (const float*)d_in[18];
    const float* router_w = (const float*)d_in[19]; const float* router_b = (const float*)d_in[20]; const float* wgu = (const float*)d_in[21]; const float* bgu = (const float*)d_in[22];
    const float* wd = (const float*)d_in[23]; const float* bd = (const float*)d_in[24]; const float* final_w = (const float*)d_in[25];
    float* out = (float*)d_out; unsigned char* ws = (unsigned char*)d_ws;
    if (ws_size < 1024 * MiB) { fprintf(stderr, "kernel_launch: workspace too small (%zu)\n", ws_size); return; }
    u32* cnt = (u32*)(ws + WS_CTL); float* mod = (float*)(ws + WS_MOD); float* lb = (float*)(ws + WS_LB);
    u32* toktab = (u32*)(ws + WS_TOKTAB); float* wtab = (float*)(ws + WS_WTAB);
    float* OACC = (float*)(ws + WS_OACC); float* HACC = (float*)(ws + WS_HACC);
    bf16_t* H = (bf16_t*)(ws + WS_H); bf16_t* P = (bf16_t*)(ws + WS_PROJ); bf16_t* MIX = (bf16_t*)(ws + WS_MIX2); bf16_t* H2 = (bf16_t*)(ws + WS_H2);
    bf16_t* ACT = (bf16_t*)(ws + WS_ACT); bf16_t* Y = (bf16_t*)(ws + WS_Y);
    bf16_t* Win_t = (bf16_t*)(ws + 18 * MiB); bf16_t* Wout_t = (bf16_t*)(ws + 25 * MiB);
    bf16_t* Wgu_t = (bf16_t*)(ws + 156 * MiB); bf16_t* Wd_t = (bf16_t*)(ws + 284 * MiB);
    static bool attr = false;
    if (!attr) {
        (void)hipFuncSetAttribute((const void*)k_norm2_route, hipFuncAttributeMaxDynamicSharedMemorySize, RT_LDS);
        (void)hipFuncSetAttribute((const void*)k_prologue, hipFuncAttributeMaxDynamicSharedMemorySize, LDS_BYTES);
        (void)hipFuncSetAttribute((const void*)k_g_inproj, hipFuncAttributeMaxDynamicSharedMemorySize, LDS_BYTES);
        (void)hipFuncSetAttribute((const void*)k_g_outproj, hipFuncAttributeMaxDynamicSharedMemorySize, LDS_BYTES);
        (void)hipFuncSetAttribute((const void*)k_g_gu, hipFuncAttributeMaxDynamicSharedMemorySize, LDS_BYTES);
        (void)hipFuncSetAttribute((const void*)k_g_down, hipFuncAttributeMaxDynamicSharedMemorySize, LDS_BYTES);
        attr = true;
    }
    const int G = 256;
    ProArgs pa{}; pa.c = c; pa.c_ctx = c_ctx; pa.w_ada = w_ada; pa.b_ada = b_ada; pa.lbl = lbl; pa.w_in = w_in; pa.w_out = w_out; pa.wgu = wgu; pa.wd = wd;
    pa.mod = mod; pa.lb = lb; pa.Win_t = Win_t; pa.Wout_t = Wout_t; pa.Wgu_t = Wgu_t; pa.Wd_t = Wd_t;

    (void)hipMemsetAsync(cnt, 0, 256, stream);
    k_prologue<<<G, 512, LDS_BYTES, stream>>>(pa, 1, 0, IT_IN + IT_OUT);
    k_norm1<<<NROWS / 4, 256, 0, stream>>>(x, ctx, norm1_w, mod, H);
    k_g_inproj<<<G, 512, LDS_BYTES, stream>>>(H, Win_t, P);
    k_hgrn2_simple<<<128, 512, 0, stream>>>(P, lb, OACC, 0);
    k_hgrn2_simple<<<128, 512, 0, stream>>>(P, lb, OACC, 1);
    k_rglru_simple<0><<<dim3(8, 32), 64, 0, stream>>>(P, conv_w, conv_b, rg_wa, rg_ba, rg_wx, rg_bx, rg_lam, HACC);
    k_rglru_simple<1><<<dim3(8, 32), 64, 0, stream>>>(P, conv_w, conv_b, rg_wa, rg_ba, rg_wx, rg_bx, rg_lam, HACC);
    k_mix_finish<<<NLAT / 4, 256, 0, stream>>>(P, OACC, HACC, hg_nw, MIX);
    k_g_outproj<<<G, 512, LDS_BYTES, stream>>>(MIX, Wout_t, x, mod, out);
    k_prologue<<<G, 512, LDS_BYTES, stream>>>(pa, 0, IT_IN + IT_OUT, IT_ALL);
    k_norm2_route<<<256, 512, RT_LDS, stream>>>(out, norm2_w, mod, router_w, router_b, H2, cnt, toktab, wtab);
    for (int half = 0; half < 2; ++half) {
        k_g_gu<<<G, 512, LDS_BYTES, stream>>>(H2, Wgu_t, bgu, cnt, toktab, ACT, half);
        k_g_down<<<G, 512, LDS_BYTES, stream>>>(ACT, Wd_t, bd, cnt, toktab, wtab, Y, half);
        k_combine<<<HALF_TOK / 4, 256, 0, stream>>>(out, Y, mod, final_w, half);
    }
}
```

```cpp
#include <hip/hip_runtime.h>
#include <hip/hip_cooperative_groups.h>
#include <cstdio>
#include <cstdint>

typedef unsigned short bf16_t;
typedef unsigned int u32;
namespace cg = cooperative_groups;

constexpr int D = 1024, NB = 32, T = 2048, CTXL = 256, GRIDW = 64, GROWS = T / GRIDW;
constexpr int NLAT = NB * T;
constexpr int NCTX = NB * CTXL;
constexpr int NROWS = NLAT + NCTX;
constexpr int HGW = 512, RGW = 512, INW = 3584;
constexpr int C_Q = 0, C_I = 512, C_FF = 1024, C_FB = 1536, C_G = 2048, C_RX = 2560, C_RG = 3072;
constexpr int NE = 32, TOPK = 4, DFF = 1024;
constexpr int HALF_TOK = NLAT / 2;
constexpr int CAP = HALF_TOK;
constexpr int MAXSLOT = HALF_TOK * TOPK + NE * 256;
constexpr float EPS = 1e-6f;

constexpr size_t MiB = 1u << 20;
constexpr size_t WS_CTL = 0;
constexpr size_t WS_MOD = 1 * MiB;
constexpr size_t WS_LB = WS_MOD + 33 * 6144 * 4;
constexpr size_t WS_TOKTAB = 2 * MiB;
constexpr size_t WS_WTAB = 10 * MiB;
constexpr size_t WS_SCR = 28 * MiB;
constexpr size_t WS_OF = 28 * MiB, WS_OB = 92 * MiB, WS_HF = 156 * MiB, WS_HB = 220 * MiB;
constexpr size_t WS_WIN = 18 * MiB, WS_WOUT = 25 * MiB;
constexpr size_t WS_WGU = 156 * MiB, WS_WD = 284 * MiB;
constexpr size_t WS_H = 284 * MiB;
constexpr size_t WS_PROJ = 428 * MiB;
constexpr size_t WS_ACT = 428 * MiB;
constexpr size_t WS_Y = 428 * MiB + 272 * MiB;

constexpr size_t WS_MIX2 = WS_H;
constexpr size_t WS_H2 = WS_SCR;

__device__ __forceinline__ float bf2f(bf16_t b) { return __uint_as_float(((u32)b) << 16); }
__device__ __forceinline__ bf16_t f2bf(float f) { u32 u = __float_as_uint(f); u += 0x7fffu + ((u >> 16) & 1u); return (bf16_t)(u >> 16); }
__device__ __forceinline__ u32 pk2(float lo, float hi) { return (u32)f2bf(lo) | ((u32)f2bf(hi) << 16); }
__device__ __forceinline__ float sigmoidf_(float x) { return 1.0f / (1.0f + __expf(-x)); }
__device__ __forceinline__ float wave_sum(float v) {
#pragma unroll
    for (int o = 1; o < 64; o <<= 1) v += __shfl_xor(v, o);
    return v;
}

__device__ __forceinline__ float gelu_tanh(float x) { const float u = 0.7978845608028654f * (x + 0.044715f * x * x * x); return 0.5f * x * (1.0f + tanhf(u)); }
#define LAS __attribute__((address_space(3)))
typedef short bf16x8 __attribute__((ext_vector_type(8)));
typedef float f32x4 __attribute__((ext_vector_type(4)));
typedef unsigned u32x4 __attribute__((ext_vector_type(4)));
constexpr int BM = 256, BK = 64, HALFT = 128, HTB = HALFT * BK * 2, STAGE_BYTES = 8 * HTB, NXCD = 8, WGM = 8;
constexpr int GK = 1024;
constexpr int LDS_BYTES = 147456;
constexpr int LDS_AUX = STAGE_BYTES;

__device__ __forceinline__ int lds_byte(int r, int c) { const int st = (r >> 4) * 2 + (c >> 5), rr = r & 15, cc = c & 31, ob = rr * 64 + cc * 2; return st * 1024 + (ob ^ (((ob >> 9) & 1) << 5)); }
__device__ __forceinline__ void stage_rc(int b, int& R, int& C) { const int st = b / 1024, sb = b % 1024, swz = sb ^ (((sb >> 9) & 1) << 5); R = (st >> 1) * 16 + swz / 64; C = (st & 1) * 32 + (swz % 64) / 2; }
__device__ __forceinline__ int perm32(int rho) { const int n = rho >> 4, i = rho & 15; return 8 * (i >> 2) + 4 * n + (i & 3); }
__device__ __forceinline__ unsigned cvt_pk_bf16(float lo, float hi) { unsigned r; asm volatile("v_cvt_pk_bf16_f32 %0, %1, %2" : "=v"(r) : "v"(lo), "v"(hi)); return r; }

struct Unit { int pm, pn, e, pos0, cn; };
struct TileOrder {
    int nM, nN, nwg, G, c;
    __device__ __forceinline__ void init(int nM_, int nN_, int G_, int c_) { nM = nM_; nN = nN_; nwg = nM * nN; G = G_; c = c_; }
    __device__ __forceinline__ bool tile(int i, int& pm, int& pn) const {
        const long L = (long)i * G + c; if (L >= nwg) return false;
        int wgid = (int)L; { const int q = nwg / NXCD, r = nwg % NXCD, xcd = wgid % NXCD, off = wgid / NXCD; wgid = (xcd < r ? xcd * (q + 1) : r * (q + 1) + (xcd - r) * q) + off; }
        const int nig = WGM * nN, gid = wgid / nig, fm = gid * WGM, gsz = (nM - fm) < WGM ? (nM - fm) : WGM;
        pm = fm + ((wgid % nig) % gsz); pn = (wgid % nig) / gsz; return true;
    }
};

template <class POL>
__device__ __forceinline__ void gemm_phase(LAS unsigned char* lds, const POL& P) {
    int tid_ = threadIdx.x; asm volatile("" : "+v"(tid_));
    const int tid = tid_, wid = __builtin_amdgcn_readfirstlane(tid >> 6), lane = tid & 63, wr = wid >> 2, wc = wid & 3, fr = lane & 15, fq = lane >> 4;
    constexpr int K = GK, nt = K / BK;
    int sR[2], sC[2]; unsigned voffA[2], voffB[2];
#pragma unroll
    for (int i = 0; i < 2; ++i) { stage_rc(tid * 16 + i * 8192, sR[i], sC[i]); const int Rb = POL::PERM ? ((sR[i] & ~31) + perm32(sR[i] & 31)) : sR[i]; voffA[i] = (unsigned)(sR[i] * K + sC[i]) * 2u; voffB[i] = (unsigned)(Rb * K + sC[i]) * 2u; }
    constexpr size_t kstep = (size_t)(BK * 2);
    constexpr unsigned hstepB = (unsigned)HALFT * K * 2;
    const unsigned ldsw = (unsigned)wid * 1024u;
    const int aoff = lds_byte(wr * 64 + fr, fq * 8), boff = lds_byte(wc * 32 + fr, fq * 8);
#define G_SA(b, h) (((b) * 2 + (h)) * HTB)
#define G_SB(b, h) ((4 + (b) * 2 + (h)) * HTB)
#define G_AOFF(OFF, h, i) (POL::GATHER ? (OFF)[h][i] : voffA[i])
#define G_STAGE_A(bufoff, gbase, OFF, h) do { const char* _gb = (const char*)(gbase) + (POL::GATHER ? (size_t)0 : (size_t)(h) * hstepB); _Pragma("unroll") for (int _i = 0; _i < 2; ++_i) \
        __builtin_amdgcn_global_load_lds((const unsigned*)(_gb + G_AOFF(OFF, h, _i)), (LAS unsigned*)(lds + (bufoff) + ldsw + _i * 8192), 16, 0, 0); } while (0)
#define G_STAGE_B(bufoff, gbase, hoff) do { const char* _gb = (const char*)(gbase) + (size_t)(hoff); _Pragma("unroll") for (int _i = 0; _i < 2; ++_i) \
        __builtin_amdgcn_global_load_lds((const unsigned*)(_gb + voffB[_i]), (LAS unsigned*)(lds + (bufoff) + ldsw + _i * 8192), 16, 0, 0); } while (0)
#define G_LDA(dst, b, h) do { _Pragma("unroll") for (int m = 0; m < 4; ++m) _Pragma("unroll") for (int k = 0; k < 2; ++k) dst[m][k] = *(const LAS bf16x8*)(lds + G_SA(b, h) + aoff + m * 2048 + k * 1024); } while (0)
#define G_LDB(dst, b, h) do { _Pragma("unroll") for (int n = 0; n < 2; ++n) _Pragma("unroll") for (int k = 0; k < 2; ++k) dst[n][k] = *(const LAS bf16x8*)(lds + G_SB(b, h) + boff + n * 2048 + k * 1024); } while (0)
#define G_MMA(ai, bj, At, Bt) do { __builtin_amdgcn_s_setprio(1); _Pragma("unroll") for (int m = 0; m < 4; ++m) _Pragma("unroll") for (int n = 0; n < 2; ++n) _Pragma("unroll") for (int k = 0; k < 2; ++k) \
        acc[ai][bj][m][n] = __builtin_amdgcn_mfma_f32_16x16x32_bf16(Bt[n][k], At[m][k], acc[ai][bj][m][n], 0, 0, 0); __builtin_amdgcn_s_setprio(0); } while (0)
#define G_WAIT_V(n) asm volatile("s_waitcnt vmcnt(" #n ")" ::: "memory")
#define G_WAIT_L(n) asm volatile("s_waitcnt lgkmcnt(" #n ")" ::: "memory")
#define G_BAR __builtin_amdgcn_s_barrier()
#define G_SCHED __builtin_amdgcn_sched_barrier(0)
#define G_TRIP(A1, OC, A2, ON, B2) do { \
        G_LDB(B0, 0, 0); G_SCHED; G_LDA(At, 0, 0); G_STAGE_A(G_SA(1, 1), A1, OC, 1); \
        G_WAIT_L(8); G_BAR; G_WAIT_L(0); G_MMA(0, 0, At, B0); G_BAR; G_SCHED; \
        G_LDB(B1, 0, 1); G_STAGE_B(G_SB(0, 0), B2, 0u); \
        G_BAR; G_WAIT_L(0); G_MMA(0, 1, At, B1); G_BAR; \
        G_LDA(At, 0, 1); G_STAGE_A(G_SA(0, 0), A2, ON, 0); \
        G_BAR; G_WAIT_L(0); G_MMA(1, 0, At, B0); G_BAR; G_SCHED; \
        G_STAGE_B(G_SB(0, 1), B2, hstepB); \
        G_WAIT_V(6); G_BAR; G_MMA(1, 1, At, B1); G_BAR; \
        G_LDB(B0, 1, 0); G_SCHED; G_LDA(At, 1, 0); G_STAGE_A(G_SA(0, 1), A2, ON, 1); \
        G_WAIT_L(8); G_BAR; G_WAIT_L(0); G_MMA(0, 0, At, B0); G_BAR; G_SCHED; \
        G_LDB(B1, 1, 1); G_STAGE_B(G_SB(1, 0), (B2) + kstep, 0u); \
        G_BAR; G_WAIT_L(0); G_MMA(0, 1, At, B1); G_BAR; \
        G_LDA(At, 1, 1); G_STAGE_A(G_SA(1, 0), (A2) + kstep, ON, 0); \
        G_BAR; G_WAIT_L(0); G_MMA(1, 0, At, B0); G_BAR; G_SCHED; \
        G_STAGE_B(G_SB(1, 1), (B2) + kstep, hstepB); \
        G_WAIT_V(6); G_BAR; G_MMA(1, 1, At, B1); G_BAR; } while (0)
    Unit cur, nxt; int ui = 0;
    if (!P.next(0, cur)) return;
    f32x4 acc[2][2][4][2];
#pragma unroll
    for (int a = 0; a < 2; ++a)
#pragma unroll
        for (int b = 0; b < 2; ++b)
#pragma unroll
            for (int m = 0; m < 4; ++m)
#pragma unroll
                for (int n = 0; n < 2; ++n) acc[a][b][m][n] = (f32x4){0.f, 0.f, 0.f, 0.f};
    bf16x8 At[4][2], B0[2][2], B1[2][2];
    unsigned oc[2][2], on[2][2];
#pragma unroll
    for (int h = 0; h < 2; ++h)
#pragma unroll
        for (int i = 0; i < 2; ++i) { oc[h][i] = POL::GATHER ? P.a_off(cur, h * HALFT + sR[i]) + (unsigned)sC[i] * 2u : 0u; on[h][i] = 0u; }
    const char* cA = P.a_base(cur); const char* cB = P.b_base(cur);
    G_STAGE_B(G_SB(0, 0), cB, 0u); G_STAGE_A(G_SA(0, 0), cA, oc, 0); G_STAGE_B(G_SB(0, 1), cB, hstepB); G_STAGE_A(G_SA(0, 1), cA, oc, 1);
    if (wr == 1) G_BAR;
    G_WAIT_V(4); G_BAR;
    G_STAGE_B(G_SB(1, 0), cB + kstep, 0u); G_STAGE_A(G_SA(1, 0), cA + kstep, oc, 0); G_STAGE_B(G_SB(1, 1), cB + kstep, hstepB);
    G_WAIT_V(6); G_BAR;
    for (;;) {
        const bool has_next = P.next(ui + 1, nxt);
        const char* nA = has_next ? P.a_base(nxt) : cA; const char* nB = has_next ? P.b_base(nxt) : cB;
        if (POL::GATHER) {
#pragma unroll
            for (int h = 0; h < 2; ++h)
#pragma unroll
                for (int i = 0; i < 2; ++i) on[h][i] = has_next ? P.a_off(nxt, h * HALFT + sR[i]) + (unsigned)sC[i] * 2u : oc[h][i];
        }
#pragma unroll 1
        for (int t = 0; t < nt; t += 2) {
            const bool last = (t == nt - 2);
            const char* a1 = cA + (size_t)(t + 1) * kstep; const char* a2 = last ? nA : cA + (size_t)(t + 2) * kstep; const char* b2 = last ? nB : cB + (size_t)(t + 2) * kstep;
            if (POL::GATHER) {
                unsigned os[2][2];
#pragma unroll
                for (int h = 0; h < 2; ++h)
#pragma unroll
                    for (int i = 0; i < 2; ++i) os[h][i] = last ? on[h][i] : oc[h][i];
                G_TRIP(a1, oc, a2, os, b2);
            } else { G_TRIP(a1, oc, a2, oc, b2); }
        }
        if (wr == 0) G_BAR;
        P.epi(acc, cur, wr, wc, fr, fq);
        if (!has_next) break;
#pragma unroll
        for (int a = 0; a < 2; ++a)
#pragma unroll
            for (int b = 0; b < 2; ++b)
#pragma unroll
                for (int m = 0; m < 4; ++m)
#pragma unroll
                    for (int n = 0; n < 2; ++n) acc[a][b][m][n] = (f32x4){0.f, 0.f, 0.f, 0.f};
        cur = nxt; cA = nA; cB = nB; ++ui;
        if (POL::GATHER) {
#pragma unroll
            for (int h = 0; h < 2; ++h)
#pragma unroll
                for (int i = 0; i < 2; ++i) oc[h][i] = on[h][i];
        }
        if (wr == 1) G_BAR;
    }
    G_WAIT_V(0);
    G_BAR;
#undef G_SA
#undef G_SB
#undef G_AOFF
#undef G_STAGE_A
#undef G_STAGE_B
#undef G_LDA
#undef G_LDB
#undef G_MMA
#undef G_WAIT_V
#undef G_WAIT_L
#undef G_BAR
#undef G_SCHED
#undef G_TRIP
}

struct PolInProj {
    static constexpr bool PERM = true, GATHER = false;
    const bf16_t* A; const bf16_t* Bt; bf16_t* O; TileOrder ord;
    __device__ __forceinline__ bool next(int i, Unit& u) const { return ord.tile(i, u.pm, u.pn); }
    __device__ __forceinline__ const char* a_base(const Unit& u) const { return (const char*)A + (size_t)u.pm * BM * GK * 2; }
    __device__ __forceinline__ unsigned a_off(const Unit&, int r) const { return (unsigned)r * GK * 2u; }
    __device__ __forceinline__ const char* b_base(const Unit& u) const { return (const char*)Bt + (size_t)u.pn * BM * GK * 2; }
    __device__ __forceinline__ void epi(const f32x4 (&acc)[2][2][4][2], const Unit& u, int wr, int wc, int fr, int fq) const {
        const int row0 = u.pm * BM + wr * 64 + fr, col0 = u.pn * BM + wc * 32 + 8 * fq;
#pragma unroll
        for (int ai = 0; ai < 2; ++ai)
#pragma unroll
            for (int m = 0; m < 4; ++m) { bf16_t* rowp = O + (size_t)(row0 + ai * HALFT + m * 16) * INW + col0;
#pragma unroll
                for (int bj = 0; bj < 2; ++bj) { const f32x4 v0 = acc[ai][bj][m][0], v1 = acc[ai][bj][m][1];
                    u32x4 w; w.x = cvt_pk_bf16(v0[0], v0[1]); w.y = cvt_pk_bf16(v0[2], v0[3]); w.z = cvt_pk_bf16(v1[0], v1[1]); w.w = cvt_pk_bf16(v1[2], v1[3]);
                    *(u32x4*)(rowp + bj * HALFT) = w; } }
    }
};
struct PolOutProj {
    static constexpr bool PERM = false, GATHER = false;
    const bf16_t* A; const bf16_t* Bt; const float* x; const float* mod; float* O; TileOrder ord;
    __device__ __forceinline__ bool next(int i, Unit& u) const { return ord.tile(i, u.pm, u.pn); }
    __device__ __forceinline__ const char* a_base(const Unit& u) const { return (const char*)A + (size_t)u.pm * BM * GK * 2; }
    __device__ __forceinline__ unsigned a_off(const Unit&, int r) const { return (unsigned)r * GK * 2u; }
    __device__ __forceinline__ const char* b_base(const Unit& u) const { return (const char*)Bt + (size_t)u.pn * BM * GK * 2; }
    __device__ __forceinline__ void epi(const f32x4 (&acc)[2][2][4][2], const Unit& u, int wr, int wc, int fr, int fq) const {
        const int row0 = u.pm * BM + wr * 64 + fr, col0 = u.pn * BM + wc * 32 + 4 * fq;
        const float* g1 = mod + (size_t)((u.pm * BM) >> 11) * 6144 + 2048 + col0;
        f32x4 gv[2][2];
#pragma unroll
        for (int bj = 0; bj < 2; ++bj)
#pragma unroll
            for (int n = 0; n < 2; ++n) gv[bj][n] = *(const f32x4*)(g1 + bj * HALFT + n * 16);
#pragma unroll
        for (int ai = 0; ai < 2; ++ai)
#pragma unroll
            for (int m = 0; m < 4; ++m) { const size_t off = (size_t)(row0 + ai * HALFT + m * 16) * D + col0;
#pragma unroll
                for (int bj = 0; bj < 2; ++bj)
#pragma unroll
                    for (int n = 0; n < 2; ++n) { const f32x4 xv = *(const f32x4*)(x + off + bj * HALFT + n * 16); *(f32x4*)(O + off + bj * HALFT + n * 16) = xv + gv[bj][n] * acc[ai][bj][m][n]; } }
    }
};
struct MoeTiles {
    const LAS int* tstart; const u32* cnt; int half;
    __device__ __forceinline__ void find(Unit& u) const {
        int e = 0;
#pragma unroll 1
        for (int i = 1; i < NE; ++i) if (u.pm >= tstart[i]) e = i;
        u.e = e; u.pos0 = (u.pm - tstart[e]) * BM; u.cn = (int)cnt[half * NE + e];
    }
};
struct PolGateUp {
    static constexpr bool PERM = true, GATHER = true;
    const bf16_t* A; const bf16_t* Bt; const float* bgu; const u32* toktab; bf16_t* O; MoeTiles mt; TileOrder ord;
    __device__ __forceinline__ bool next(int i, Unit& u) const { if (!ord.tile(i, u.pm, u.pn)) return false; mt.find(u); return true; }
    __device__ __forceinline__ const char* a_base(const Unit&) const { return (const char*)A; }
    __device__ __forceinline__ unsigned a_off(const Unit& u, int r) const {
        const int p = u.pos0 + r; const u32 tk = toktab[((size_t)mt.half * NE + u.e) * CAP + (p < u.cn ? p : 0)];
        return (tk >> 2) * (unsigned)(GK * 2);
    }
    __device__ __forceinline__ const char* b_base(const Unit& u) const { return (const char*)Bt + ((size_t)u.e * 2048 + (size_t)u.pn * BM) * GK * 2; }
    __device__ __forceinline__ void epi(const f32x4 (&acc)[2][2][4][2], const Unit& u, int wr, int wc, int fr, int fq) const {
        const int row0 = u.pm * BM + wr * 64 + fr, cc = u.pn * HALFT + wc * 32 + 8 * fq;
        const float* bg = bgu + (size_t)u.e * 2048 + cc;
        const f32x4 bg0 = *(const f32x4*)bg, bg1 = *(const f32x4*)(bg + 4), bu0 = *(const f32x4*)(bg + 1024), bu1 = *(const f32x4*)(bg + 1028);
#pragma unroll
        for (int ai = 0; ai < 2; ++ai)
#pragma unroll
            for (int m = 0; m < 4; ++m) {
                f32x4 g0 = acc[ai][0][m][0] + bg0, g1 = acc[ai][0][m][1] + bg1, u0 = acc[ai][1][m][0] + bu0, u1 = acc[ai][1][m][1] + bu1;
                float o[8];
#pragma unroll
                for (int j = 0; j < 4; ++j) {
                    const float ga = fminf(g0[j], 7.0f), gb = fminf(g1[j], 7.0f);
                    const float ua = fminf(fmaxf(u0[j], -7.0f), 7.0f), ub = fminf(fmaxf(u1[j], -7.0f), 7.0f);
                    o[j] = ga * sigmoidf_(1.702f * ga) * (ua + 1.0f); o[4 + j] = gb * sigmoidf_(1.702f * gb) * (ub + 1.0f);
                }
                u32x4 w; w.x = cvt_pk_bf16(o[0], o[1]); w.y = cvt_pk_bf16(o[2], o[3]); w.z = cvt_pk_bf16(o[4], o[5]); w.w = cvt_pk_bf16(o[6], o[7]);
                *(u32x4*)(O + (size_t)(row0 + ai * HALFT + m * 16) * DFF + cc) = w;
            }
    }
};
struct PolDown {
    static constexpr bool PERM = true, GATHER = false;
    const bf16_t* A; const bf16_t* Bt; const float* bd; const u32* toktab; const float* wtab; bf16_t* O; MoeTiles mt; TileOrder ord;
    __device__ __forceinline__ bool next(int i, Unit& u) const { if (!ord.tile(i, u.pm, u.pn)) return false; mt.find(u); return true; }
    __device__ __forceinline__ const char* a_base(const Unit& u) const { return (const char*)A + (size_t)u.pm * BM * GK * 2; }
    __device__ __forceinline__ unsigned a_off(const Unit&, int r) const { return (unsigned)r * GK * 2u; }
    __device__ __forceinline__ const char* b_base(const Unit& u) const { return (const char*)Bt + ((size_t)u.e * 1024 + (size_t)u.pn * BM) * GK * 2; }
    __device__ __forceinline__ void epi(const f32x4 (&acc)[2][2][4][2], const Unit& u, int wr, int wc, int fr, int fq) const {
        const int col0 = u.pn * BM + wc * 32 + 8 * fq;
        const float* bp = bd + (size_t)u.e * D + col0;
        f32x4 bv[2][2];
#pragma unroll
        for (int bj = 0; bj < 2; ++bj) { bv[bj][0] = *(const f32x4*)(bp + bj * HALFT); bv[bj][1] = *(const f32x4*)(bp + bj * HALFT + 4); }
        const size_t tb = ((size_t)mt.half * NE + u.e) * CAP;
#pragma unroll
        for (int ai = 0; ai < 2; ++ai)
#pragma unroll
            for (int m = 0; m < 4; ++m) {
                const int p = u.pos0 + ai * HALFT + wr * 64 + m * 16 + fr;
                if (p < u.cn) {
                    const u32 tk = toktab[tb + p]; const float wg = wtab[tb + p];
                    bf16_t* rowp = O + (size_t)(tk - (u32)mt.half * HALF_TOK * 4u) * D + col0;
#pragma unroll
                    for (int bj = 0; bj < 2; ++bj) { const f32x4 v0 = (acc[ai][bj][m][0] + bv[bj][0]) * wg, v1 = (acc[ai][bj][m][1] + bv[bj][1]) * wg;
                        u32x4 w; w.x = cvt_pk_bf16(v0[0], v0[1]); w.y = cvt_pk_bf16(v0[2], v0[3]); w.z = cvt_pk_bf16(v1[0], v1[1]); w.w = cvt_pk_bf16(v1[2], v1[3]);
                        *(u32x4*)(rowp + bj * HALFT) = w; }
                }
            }
    }
};
__device__ __forceinline__ int moe_tile_table(LAS int* tstart, const u32* cnt, int half) {
    if (threadIdx.x == 0) { int s = 0; for (int e = 0; e < NE; ++e) { tstart[e] = s; s += ((int)cnt[half * NE + e] + BM - 1) / BM; } tstart[NE] = s; }
    __syncthreads();
    const int tot = tstart[NE];
    return tot;
}

__device__ __forceinline__ void conv_item(const float* __restrict__ W, int N, bf16_t* __restrict__ WT, int k0, int n0, size_t rowbase, LAS float* scr, int lane) {
#pragma unroll 4
    for (int i = 0; i < 16; ++i) { const int k = 4 * i + (lane >> 4); const f32x4 v = *(const f32x4*)(W + (size_t)(k0 + k) * N + n0 + (lane & 15) * 4); *(LAS f32x4*)(scr + k * 68 + (lane & 15) * 4) = v; }
    asm volatile("s_waitcnt lgkmcnt(0)" ::: "memory");
    const int c = lane & 7;
#pragma unroll
    for (int j = 0; j < 8; ++j) { const int n = (lane >> 3) + 8 * j; const LAS float* s = scr + (8 * c) * 68 + n;
        u32x4 o; o.x = cvt_pk_bf16(s[0 * 68], s[1 * 68]); o.y = cvt_pk_bf16(s[2 * 68], s[3 * 68]); o.z = cvt_pk_bf16(s[4 * 68], s[5 * 68]); o.w = cvt_pk_bf16(s[6 * 68], s[7 * 68]);
        *(u32x4*)(WT + (rowbase + n) * GK + k0 + 8 * c) = o; }
    asm volatile("s_waitcnt lgkmcnt(0)" ::: "memory");
}
constexpr int IT_IN = 16 * (INW / 64), IT_OUT = 16 * (D / 64), IT_GU = NE * 16 * 32, IT_D = NE * 16 * 16, IT_ALL = IT_IN + IT_OUT + IT_GU + IT_D;
struct ProArgs { const float *c, *c_ctx, *w_ada, *b_ada, *lbl, *w_in, *w_out, *wgu, *wd; float *mod, *lb; bf16_t *Win_t, *Wout_t, *Wgu_t, *Wd_t; };
__device__ __forceinline__ void phase_prologue(LAS unsigned char* lds, const ProArgs& a, int bid, int G, bool do_mod, int it_lo, int it_hi) {
    const int tid = threadIdx.x, lane = tid & 63, w = tid >> 6;
    if (!do_mod) {} else if (bid < 96) {
        LAS float* s = (LAS float*)lds;
        for (int i = tid; i < 33 * D; i += 512) { const int b = i >> 10, k = i & 1023; const float v = b < NB ? a.c[(size_t)b * D + k] : a.c_ctx[k]; s[i] = v * sigmoidf_(v); }
        __syncthreads();
        const int n = bid * 64 + lane;
        float acc[33];
#pragma unroll
        for (int b = 0; b < 33; ++b) acc[b] = 0.f;
        for (int k = 128 * w; k < 128 * w + 128; k += 4) {
            const float w0 = a.w_ada[(size_t)k * 6144 + n], w1 = a.w_ada[(size_t)(k + 1) * 6144 + n], w2 = a.w_ada[(size_t)(k + 2) * 6144 + n], w3 = a.w_ada[(size_t)(k + 3) * 6144 + n];
#pragma unroll
            for (int b = 0; b < 33; ++b) { const f32x4 sv = *(const LAS f32x4*)(s + b * D + k); acc[b] += sv[0] * w0 + sv[1] * w1 + sv[2] * w2 + sv[3] * w3; }
        }
        __syncthreads();
        LAS float* red = (LAS float*)lds;
#pragma unroll
        for (int b = 0; b < 33; ++b) red[(w * 33 + b) * 64 + lane] = acc[b];
        __syncthreads();
        for (int i = tid; i < 33 * 64; i += 512) { const int b = i >> 6, l = i & 63; float sum = a.b_ada[bid * 64 + l];
#pragma unroll
            for (int ww = 0; ww < 8; ++ww) sum += red[(ww * 33 + b) * 64 + l];
            a.mod[(size_t)b * 6144 + bid * 64 + l] = sum; }
        __syncthreads();
    } else if (bid == 96) {
        for (int i = tid; i < 2 * HGW; i += 512) { const float l0 = a.lbl[i], l1 = a.lbl[2 * HGW + i]; a.lb[i] = 1.0f / (1.0f + __expf(l1 - l0)); }
    }
    LAS float* scr = (LAS float*)(lds + w * (64 * 68 * 4));
    const int gw = bid * 8 + w, NW = G * 8;
    for (int it = it_lo + gw; it < it_hi; it += NW) {
        int r = it;
        if (r < IT_IN) { const int kb = r / (INW / 64), nb = r % (INW / 64); conv_item(a.w_in, INW, a.Win_t, kb * 64, nb * 64, (size_t)nb * 64, scr, lane); continue; } r -= IT_IN;
        if (r < IT_OUT) { const int kb = r / 16, nb = r % 16; conv_item(a.w_out, D, a.Wout_t, kb * 64, nb * 64, (size_t)nb * 64, scr, lane); continue; } r -= IT_OUT;
        if (r < IT_GU) { const int e = r / 512, q = r % 512, kb = q / 32, nb = q % 32, n0 = nb * 64, bj = n0 >> 10, rem = n0 & 1023, pn = rem >> 7, cc0 = rem & 127;
            conv_item(a.wgu + (size_t)e * D * 2048, 2048, a.Wgu_t, kb * 64, n0, (size_t)e * 2048 + pn * 256 + bj * 128 + cc0, scr, lane); continue; } r -= IT_GU;
        { const int e = r / 256, q = r % 256, kb = q / 16, nb = q % 16; conv_item(a.wd + (size_t)e * DFF * D, D, a.Wd_t, kb * 64, nb * 64, (size_t)e * 1024 + nb * 64, scr, lane); }
    }
}


__device__ __forceinline__ void phase_norm1(const float* __restrict__ x, const float* __restrict__ ctx, const float* __restrict__ nw, const float* __restrict__ mod, bf16_t* __restrict__ H, int bid, int G) {
    const int lane = threadIdx.x & 63, gw = bid * 8 + (threadIdx.x >> 6), NW = G * 8;
    for (int r = gw; r < NROWS; r += NW) {
        const float* src = r < NLAT ? x + (size_t)r * D : ctx + (size_t)(r - NLAT) * D;
        const float* m = mod + (size_t)(r < NLAT ? (r >> 11) : NB) * 6144;
        f32x4 v[4]; float ss = 0.f;
#pragma unroll
        for (int j = 0; j < 4; ++j) { v[j] = *(const f32x4*)(src + j * 256 + lane * 4); ss += v[j][0] * v[j][0] + v[j][1] * v[j][1] + v[j][2] * v[j][2] + v[j][3] * v[j][3]; }
        const float rstd = rsqrtf(wave_sum(ss) * (1.0f / D) + EPS);
#pragma unroll
        for (int j = 0; j < 4; ++j) {
            const int c0 = j * 256 + lane * 4;
            const f32x4 w = *(const f32x4*)(nw + c0), sh = *(const f32x4*)(m + c0), sc = *(const f32x4*)(m + 1024 + c0);
            const f32x4 o = v[j] * rstd * w * (sc + 1.0f) + sh;
            uint2 p; p.x = cvt_pk_bf16(o[0], o[1]); p.y = cvt_pk_bf16(o[2], o[3]);
            *(uint2*)(H + (size_t)r * D + c0) = p;
        }
    }
}

__device__ __forceinline__ void phase_hgrn2_simple(LAS unsigned char* lds, const bf16_t* __restrict__ P, const float* __restrict__ lb, bf16_t* __restrict__ OF, bf16_t* __restrict__ OB, int item) {
    LAS float* qs = (LAS float*)lds; LAS float* fs = qs + 32 * 128; LAS float* vs = fs + 32 * 128;
    const int b = item >> 3, h = (item >> 1) & 3, dir = item & 1;
    const int tid = threadIdx.x, w = tid >> 6, lane = tid & 63, vi = lane & 15, kg = lane >> 4, v = 16 * w + vi;
    bf16_t* OD = dir == 0 ? OF : OB;
    float S[32];
#pragma unroll
    for (int i = 0; i < 32; ++i) S[i] = 0.f;
    const int lt = tid >> 4, lc = (tid & 15) * 8;
    float lbv[8];
#pragma unroll
    for (int i = 0; i < 8; ++i) lbv[i] = lb[dir * HGW + h * 128 + lc + i];
    const int cf = dir == 0 ? C_FF : C_FB;
    for (int n0 = 0; n0 < CTXL + T; n0 += 32) {
        __syncthreads();
        {
            const int n = n0 + lt;
            size_t row;
            if (n < CTXL) row = (size_t)NLAT + b * CTXL + (dir == 0 ? n : CTXL - 1 - n);
            else row = (size_t)b * T + (dir == 0 ? (n - CTXL) : (T - 1 - (n - CTXL)));
            const bf16_t* pr = P + row * INW + h * 128 + lc;
            const uint4 qv = *(const uint4*)(pr + C_Q), iv = *(const uint4*)(pr + C_I), fv = *(const uint4*)(pr + cf);
            const u32 qa[4] = {qv.x, qv.y, qv.z, qv.w}, ia[4] = {iv.x, iv.y, iv.z, iv.w}, fa[4] = {fv.x, fv.y, fv.z, fv.w};
#pragma unroll
            for (int i = 0; i < 4; ++i) {
                const float q0 = __uint_as_float(qa[i] << 16), q1 = __uint_as_float(qa[i] & 0xffff0000u);
                const float f0 = __uint_as_float(fa[i] << 16), f1 = __uint_as_float(fa[i] & 0xffff0000u);
                qs[lt * 128 + lc + 2 * i] = q0 * sigmoidf_(q0); qs[lt * 128 + lc + 2 * i + 1] = q1 * sigmoidf_(q1);
                vs[lt * 128 + lc + 2 * i] = __uint_as_float(ia[i] << 16); vs[lt * 128 + lc + 2 * i + 1] = __uint_as_float(ia[i] & 0xffff0000u);
                fs[lt * 128 + lc + 2 * i] = lbv[2 * i] + (1.f - lbv[2 * i]) * sigmoidf_(f0);
                fs[lt * 128 + lc + 2 * i + 1] = lbv[2 * i + 1] + (1.f - lbv[2 * i + 1]) * sigmoidf_(f1);
            }
        }
        __syncthreads();
        for (int j = 0; j < 32; ++j) {
            const float vv = vs[j * 128 + v];
            float o = 0.f;
#pragma unroll
            for (int i4 = 0; i4 < 8; ++i4) {
                const f32x4 f4 = *(const LAS f32x4*)(fs + j * 128 + 32 * kg + 4 * i4), q4 = *(const LAS f32x4*)(qs + j * 128 + 32 * kg + 4 * i4);
#pragma unroll
                for (int e = 0; e < 4; ++e) { S[4 * i4 + e] = f4[e] * (S[4 * i4 + e] - vv) + vv; o += S[4 * i4 + e] * q4[e]; }
            }
            o += __shfl_xor(o, 16); o += __shfl_xor(o, 32);
            const int n = n0 + j;
            if (n >= CTXL && kg == 0) {
                const int tt = dir == 0 ? (n - CTXL) : (T - 1 - (n - CTXL));
                OD[((size_t)b * T + tt) * HGW + h * 128 + v] = f2bf(o);
            }
        }
    }
}

__device__ __forceinline__ size_t rg_row(int b, bool lat, int p) {
    return lat ? (size_t)b * T + (size_t)(p % GROWS) * GRIDW + (p / GROWS) : (size_t)NLAT + b * CTXL + p;
}
template <int dir>
__device__ __forceinline__ void rglru_simple_wave(LAS float* xs, const bf16_t* __restrict__ P, const float* __restrict__ conv_w, const float* __restrict__ conv_b,
                                                  const float* __restrict__ wa, const float* __restrict__ ba, const float* __restrict__ wx, const float* __restrict__ bx,
                                                  const float* __restrict__ lam, bf16_t* __restrict__ HD, int hd, int b) {
    const int j = threadIdx.x & 63, c = hd * 64 + j;
    float wac[64], wxc[64];
#pragma unroll
    for (int i = 0; i < 64; ++i) { wac[i] = wa[(((size_t)dir * 8 + hd) * 64 + i) * 64 + j]; wxc[i] = wx[(((size_t)dir * 8 + hd) * 64 + i) * 64 + j]; }
    const float cw0 = conv_w[0 * RGW + c], cw1 = conv_w[1 * RGW + c], cw2 = conv_w[2 * RGW + c], cw3 = conv_w[3 * RGW + c], cb = conv_b[c];
    const float bav = ba[dir * RGW + c], bxv = bx[dir * RGW + c];
    const float l = lam[dir * RGW + c];
    const float sp = (-l > 20.f) ? -l : log1pf(__expf(-l));
    const float coef = -8.0f * sp;
    float hst = 0.f;
    for (int seg = 0; seg < 2; ++seg) {
        const bool lat = seg == 1; const int L = lat ? T : CTXL;
        for (int s0 = 0; s0 < L; s0 += 16) {
            float xc[16];
            const int plo = dir == 0 ? s0 : L - 16 - s0;
            {
                float rx[19];
#pragma unroll
                for (int i = 0; i < 19; ++i) { const int p = plo - 2 + i; rx[i] = (p >= 0 && p < L) ? bf2f(P[rg_row(b, lat, p) * INW + C_RX + c]) : 0.f; }
#pragma unroll
                for (int i = 0; i < 16; ++i) xc[i] = cb + cw0 * rx[i] + cw1 * rx[i + 1] + cw2 * rx[i + 2] + cw3 * rx[i + 3];
            }
            asm volatile("s_waitcnt lgkmcnt(0)" ::: "memory");
#pragma unroll
            for (int i = 0; i < 16; ++i) xs[i * 64 + j] = xc[i];
            asm volatile("s_waitcnt lgkmcnt(0)" ::: "memory");
#pragma unroll
            for (int ii = 0; ii < 16; ++ii) {
                const int i = dir == 0 ? ii : 15 - ii;
                float ra = bav, xa = bxv;
#pragma unroll
                for (int k = 0; k < 64; ++k) { const float xv = xs[i * 64 + k]; ra += xv * wac[k]; xa += xv * wxc[k]; }
                const float r = sigmoidf_(ra), ig = sigmoidf_(xa);
                const float log_a = coef * r, a = __expf(log_a), mult = sqrtf(fmaxf(-expm1f(2.0f * log_a), 0.f));
                hst = a * hst + mult * ig * xc[i];
                if (lat) {
                    const int p = plo + i;
                    const int tt = (p % GROWS) * GRIDW + (p / GROWS);
                    HD[((size_t)b * T + tt) * RGW + c] = f2bf(hst);
                }
            }
        }
    }
}

__device__ __forceinline__ void phase_mix_finish(const bf16_t* __restrict__ P, const bf16_t* __restrict__ OF, const bf16_t* __restrict__ OB, const bf16_t* __restrict__ HF, const bf16_t* __restrict__ HB,
                                                 const float* __restrict__ hg_nw, bf16_t* __restrict__ MIX, int bid, int G) {
    const int lane = threadIdx.x & 63, gw = bid * 8 + (threadIdx.x >> 6), NW = G * 8, c0 = lane * 8;
    for (int r = gw; r < NLAT; r += NW) {
        const uint4 a4 = *(const uint4*)(OF + (size_t)r * HGW + c0), b4 = *(const uint4*)(OB + (size_t)r * HGW + c0);
        const u32 aw[4] = {a4.x, a4.y, a4.z, a4.w}, bw[4] = {b4.x, b4.y, b4.z, b4.w};
        float o[8]; float ss = 0.f;
#pragma unroll
        for (int i = 0; i < 4; ++i) { o[2 * i] = __uint_as_float(aw[i] << 16) + __uint_as_float(bw[i] << 16); o[2 * i + 1] = __uint_as_float(aw[i] & 0xffff0000u) + __uint_as_float(bw[i] & 0xffff0000u); }
#pragma unroll
        for (int i = 0; i < 8; ++i) ss += o[i] * o[i];
        ss += __shfl_xor(ss, 1); ss += __shfl_xor(ss, 2); ss += __shfl_xor(ss, 4); ss += __shfl_xor(ss, 8);
        const float rstd = rsqrtf(ss * (1.0f / 128.0f) + EPS);
        const bf16_t* pr = P + (size_t)r * INW;
        const uint4 g4 = *(const uint4*)(pr + C_G + c0);
        const u32 gw4[4] = {g4.x, g4.y, g4.z, g4.w};
        const f32x4 nw0 = *(const f32x4*)(hg_nw + c0), nw1 = *(const f32x4*)(hg_nw + c0 + 4);
        const float nwv[8] = {nw0[0], nw0[1], nw0[2], nw0[3], nw1[0], nw1[1], nw1[2], nw1[3]};
        u32 w[4];
#pragma unroll
        for (int i = 0; i < 4; ++i) {
            const float g0 = __uint_as_float(gw4[i] << 16), g1 = __uint_as_float(gw4[i] & 0xffff0000u);
            w[i] = cvt_pk_bf16(o[2 * i] * rstd * nwv[2 * i] * (g0 * sigmoidf_(g0)), o[2 * i + 1] * rstd * nwv[2 * i + 1] * (g1 * sigmoidf_(g1)));
        }
        *(uint4*)(MIX + (size_t)r * D + c0) = make_uint4(w[0], w[1], w[2], w[3]);
        const uint4 r4 = *(const uint4*)(pr + C_RG + c0), hf4 = *(const uint4*)(HF + (size_t)r * RGW + c0), hb4 = *(const uint4*)(HB + (size_t)r * RGW + c0);
        const u32 rw4[4] = {r4.x, r4.y, r4.z, r4.w}, hfw[4] = {hf4.x, hf4.y, hf4.z, hf4.w}, hbw[4] = {hb4.x, hb4.y, hb4.z, hb4.w};
#pragma unroll
        for (int i = 0; i < 4; ++i) {
            const float g0 = __uint_as_float(rw4[i] << 16), g1 = __uint_as_float(rw4[i] & 0xffff0000u);
            const float h0 = __uint_as_float(hfw[i] << 16) + __uint_as_float(hbw[i] << 16), h1 = __uint_as_float(hfw[i] & 0xffff0000u) + __uint_as_float(hbw[i] & 0xffff0000u);
            w[i] = cvt_pk_bf16(gelu_tanh(g0) * h0, gelu_tanh(g1) * h1);
        }
        *(uint4*)(MIX + (size_t)r * D + HGW + c0) = make_uint4(w[0], w[1], w[2], w[3]);
    }
}

__device__ __forceinline__ void phase_norm2_route(LAS unsigned char* lds, const float* __restrict__ x1, const float* __restrict__ nw, const float* __restrict__ mod,
                                                  const float* __restrict__ rw, const float* __restrict__ rb, bf16_t* __restrict__ H2,
                                                  u32* __restrict__ cnt, u32* __restrict__ toktab, float* __restrict__ wtab, int bid, int G) {
    LAS float* rwT = (LAS float*)lds;
    LAS u32* hist = (LAS u32*)(lds + 131072);
    LAS u32* ent = (LAS u32*)(lds + 131072 + 4096);
    const int tid = threadIdx.x, lane = tid & 63, w = tid >> 6;
    for (int i = tid; i < 32 * 1024; i += 512) { const int k = i >> 5, e = i & 31; rwT[e * 1024 + k] = rw[i]; }
    if (tid < 128) hist[tid] = 0;
    __syncthreads();
    const int gw = bid * 8 + w, NW = G * 8;
    int it = 0;
    for (int r = gw; r < NLAT; r += NW, ++it) {
        const float* m = mod + (size_t)(r >> 11) * 6144;
        f32x4 v[4]; float ss = 0.f;
#pragma unroll
        for (int j = 0; j < 4; ++j) { v[j] = *(const f32x4*)(x1 + (size_t)r * D + j * 256 + lane * 4); ss += v[j][0] * v[j][0] + v[j][1] * v[j][1] + v[j][2] * v[j][2] + v[j][3] * v[j][3]; }
        const float rstd = rsqrtf(wave_sum(ss) * (1.0f / D) + EPS);
#pragma unroll
        for (int j = 0; j < 4; ++j) {
            const int c0 = j * 256 + lane * 4;
            const f32x4 ww = *(const f32x4*)(nw + c0), sh = *(const f32x4*)(m + 3072 + c0), sc = *(const f32x4*)(m + 4096 + c0);
            v[j] = v[j] * rstd * ww * (sc + 1.0f) + sh;
            uint2 p; p.x = cvt_pk_bf16(v[j][0], v[j][1]); p.y = cvt_pk_bf16(v[j][2], v[j][3]);
            *(uint2*)(H2 + (size_t)r * D + c0) = p;
        }
        float mylogit = 0.f;
        for (int e = 0; e < 32; ++e) {
            float p = 0.f;
#pragma unroll
            for (int j = 0; j < 4; ++j) { const f32x4 q = *(const LAS f32x4*)(rwT + e * 1024 + j * 256 + lane * 4); p += v[j][0] * q[0] + v[j][1] * q[1] + v[j][2] * q[2] + v[j][3] * q[3]; }
            p = wave_sum(p);
            if ((lane & 31) == e) mylogit = p + rb[e];
        }
        float tv[4]; int ti[4]; float cur = mylogit;
#pragma unroll
        for (int k = 0; k < 4; ++k) {
            float bv = cur; int bi = lane & 31;
#pragma unroll
            for (int o = 1; o < 32; o <<= 1) { const float ov = __shfl_xor(bv, o); const int oi = __shfl_xor(bi, o); if (ov > bv || (ov == bv && oi < bi)) { bv = ov; bi = oi; } }
            tv[k] = bv; ti[k] = bi; if ((lane & 31) == bi) cur = -3.0e38f;
        }
        const float e1 = __expf(tv[1] - tv[0]), e2 = __expf(tv[2] - tv[0]), e3 = __expf(tv[3] - tv[0]); const float inv = 1.0f / (1.0f + e1 + e2 + e3);
        const float g0 = inv, g1 = e1 * inv, g2 = e2 * inv, g3 = e3 * inv;
        if (lane < 4) {
            const int half = r >= HALF_TOK ? 1 : 0;
            const int e = lane == 0 ? ti[0] : lane == 1 ? ti[1] : lane == 2 ? ti[2] : ti[3];
            const float gv = lane == 0 ? g0 : lane == 1 ? g1 : lane == 2 ? g2 : g3;
            const u32 lp = atomicAdd((u32*)&hist[half * 32 + e], 1u);
            const int idx = (it * 8 + w) * 4 + lane;
            ent[idx * 2] = ((u32)e << 24) | lp; ent[idx * 2 + 1] = __float_as_uint(gv);
        }
    }
    __syncthreads();
    if (tid < 64) hist[64 + tid] = atomicAdd(&cnt[tid], hist[tid]);
    __syncthreads();
    it = 0;
    for (int r = gw; r < NLAT; r += NW, ++it) {
        if (lane < 4) {
            const int half = r >= HALF_TOK ? 1 : 0; const int idx = (it * 8 + w) * 4 + lane;
            const u32 ev = ent[idx * 2]; const int e = ev >> 24; const u32 pos = hist[64 + half * 32 + e] + (ev & 0xffffffu);
            toktab[((size_t)half * 32 + e) * CAP + pos] = (u32)r * 4u + lane;
            wtab[((size_t)half * 32 + e) * CAP + pos] = __uint_as_float(ent[idx * 2 + 1]);
        }
    }
}

__device__ __forceinline__ void phase_combine(float* __restrict__ out, const bf16_t* __restrict__ Y, const float* __restrict__ mod, const float* __restrict__ fw, int half, int bid, int G) {
    const int lane = threadIdx.x & 63, gw = bid * 8 + (threadIdx.x >> 6), NW = G * 8;
    for (int rl = gw; rl < HALF_TOK; rl += NW) {
        const int r = half * HALF_TOK + rl;
        const float* g2 = mod + (size_t)(r >> 11) * 6144 + 5120;
        f32x4 v[4]; float ss = 0.f;
#pragma unroll
        for (int j = 0; j < 4; ++j) {
            const int c0 = j * 256 + lane * 4;
            v[j] = *(const f32x4*)(out + (size_t)r * D + c0);
            float s0 = 0.f, s1 = 0.f, s2 = 0.f, s3 = 0.f;
#pragma unroll
            for (int k = 0; k < 4; ++k) { const uint2 y = *(const uint2*)(Y + ((size_t)rl * 4 + k) * D + c0);
                s0 += __uint_as_float(y.x << 16); s1 += __uint_as_float(y.x & 0xffff0000u); s2 += __uint_as_float(y.y << 16); s3 += __uint_as_float(y.y & 0xffff0000u); }
            const f32x4 g = *(const f32x4*)(g2 + c0);
            v[j][0] += g[0] * s0; v[j][1] += g[1] * s1; v[j][2] += g[2] * s2; v[j][3] += g[3] * s3;
            ss += v[j][0] * v[j][0] + v[j][1] * v[j][1] + v[j][2] * v[j][2] + v[j][3] * v[j][3];
        }
        const float rstd = rsqrtf(wave_sum(ss) * (1.0f / D) + EPS);
#pragma unroll
        for (int j = 0; j < 4; ++j) { const int c0 = j * 256 + lane * 4; const f32x4 w = *(const f32x4*)(fw + c0); *(f32x4*)(out + (size_t)r * D + c0) = v[j] * rstd * w; }
    }
}

struct MegaArgs {
    const float *x, *c, *ctx, *c_ctx, *norm1_w, *norm2_w, *w_ada, *b_ada, *w_in, *lbl, *hg_nw, *conv_w, *conv_b, *rg_wa, *rg_ba, *rg_wx, *rg_bx, *rg_lam, *w_out,
        *router_w, *router_b, *wgu, *bgu, *wd, *bd, *final_w;
    float* out; unsigned char* ws;
};
typedef const MegaArgs __attribute__((address_space(4)))* KArgs;
__device__ __forceinline__ KArgs kargs() { auto p = __builtin_amdgcn_kernarg_segment_ptr(); asm volatile("" : "+s"(p)); return (KArgs)p; }
#define WSP(T, off) ((T*)(ws + (off)))
#define GRID_SYNC() cg::this_grid().sync()
__global__ __launch_bounds__(512, 2) void k_mega(MegaArgs a_unused) {
    extern __shared__ __attribute__((aligned(16))) unsigned char lds_[];
    LAS unsigned char* lds = (LAS unsigned char*)lds_;
    { KArgs a = kargs(); unsigned char* ws = a->ws; const int bid = blockIdx.x, G = gridDim.x;
      ProArgs pa; pa.c = a->c; pa.c_ctx = a->c_ctx; pa.w_ada = a->w_ada; pa.b_ada = a->b_ada; pa.lbl = a->lbl; pa.w_in = a->w_in; pa.w_out = a->w_out; pa.wgu = a->wgu; pa.wd = a->wd;
      pa.mod = WSP(float, WS_MOD); pa.lb = WSP(float, WS_LB); pa.Win_t = WSP(bf16_t, WS_WIN); pa.Wout_t = WSP(bf16_t, WS_WOUT); pa.Wgu_t = WSP(bf16_t, WS_WGU); pa.Wd_t = WSP(bf16_t, WS_WD);
      phase_prologue(lds, pa, bid, G, true, 0, IT_IN + IT_OUT); }
    GRID_SYNC();
    { KArgs a = kargs(); unsigned char* ws = a->ws; phase_norm1(a->x, a->ctx, a->norm1_w, WSP(float, WS_MOD), WSP(bf16_t, WS_H), blockIdx.x, gridDim.x); }
    GRID_SYNC();
    { KArgs a = kargs(); unsigned char* ws = a->ws; PolInProj P; P.A = WSP(bf16_t, WS_H); P.Bt = WSP(bf16_t, WS_WIN); P.O = WSP(bf16_t, WS_PROJ); P.ord.init(NROWS / BM, INW / BM, gridDim.x, blockIdx.x); gemm_phase(lds, P); }
    GRID_SYNC();
    { KArgs a = kargs(); unsigned char* ws = a->ws;
      for (int item = blockIdx.x; item < 256; item += gridDim.x) phase_hgrn2_simple(lds, WSP(bf16_t, WS_PROJ), WSP(float, WS_LB), WSP(bf16_t, WS_OF), WSP(bf16_t, WS_OB), item); }
    __syncthreads();
    { KArgs a = kargs(); unsigned char* ws = a->ws;
      for (int it2 = blockIdx.x; it2 < 256; it2 += gridDim.x) {
        const int w = __builtin_amdgcn_readfirstlane(threadIdx.x >> 6);
        if (w == 0) rglru_simple_wave<0>((LAS float*)lds, WSP(bf16_t, WS_PROJ), a->conv_w, a->conv_b, a->rg_wa, a->rg_ba, a->rg_wx, a->rg_bx, a->rg_lam, WSP(bf16_t, WS_HF), it2 & 7, it2 >> 3);
        else if (w == 1) rglru_simple_wave<1>((LAS float*)lds + 16 * 64, WSP(bf16_t, WS_PROJ), a->conv_w, a->conv_b, a->rg_wa, a->rg_ba, a->rg_wx, a->rg_bx, a->rg_lam, WSP(bf16_t, WS_HB), it2 & 7, it2 >> 3);
      } }
    GRID_SYNC();
    { KArgs a = kargs(); unsigned char* ws = a->ws; phase_mix_finish(WSP(bf16_t, WS_PROJ), WSP(bf16_t, WS_OF), WSP(bf16_t, WS_OB), WSP(bf16_t, WS_HF), WSP(bf16_t, WS_HB), a->hg_nw, WSP(bf16_t, WS_MIX2), blockIdx.x, gridDim.x); }
    GRID_SYNC();
    { KArgs a = kargs(); unsigned char* ws = a->ws; PolOutProj P; P.A = WSP(bf16_t, WS_MIX2); P.Bt = WSP(bf16_t, WS_WOUT); P.x = a->x; P.mod = WSP(float, WS_MOD); P.O = a->out; P.ord.init(NLAT / BM, D / BM, gridDim.x, blockIdx.x); gemm_phase(lds, P); }
    GRID_SYNC();
    { KArgs a = kargs(); unsigned char* ws = a->ws;
      phase_norm2_route(lds, a->out, a->norm2_w, WSP(float, WS_MOD), a->router_w, a->router_b, WSP(bf16_t, WS_H2), WSP(u32, WS_CTL), WSP(u32, WS_TOKTAB), WSP(float, WS_WTAB), blockIdx.x, gridDim.x); }
    __syncthreads();
    { KArgs a = kargs(); unsigned char* ws = a->ws;
      ProArgs pa; pa.c = nullptr; pa.c_ctx = nullptr; pa.w_ada = nullptr; pa.b_ada = nullptr; pa.lbl = nullptr; pa.w_in = nullptr; pa.w_out = nullptr; pa.wgu = a->wgu; pa.wd = a->wd;
      pa.mod = nullptr; pa.lb = nullptr; pa.Win_t = nullptr; pa.Wout_t = nullptr; pa.Wgu_t = WSP(bf16_t, WS_WGU); pa.Wd_t = WSP(bf16_t, WS_WD);
      phase_prologue(lds, pa, blockIdx.x, gridDim.x, false, IT_IN + IT_OUT, IT_ALL); }
    GRID_SYNC();
#pragma unroll 1
    for (int half = 0; half < 2; ++half) {
        { KArgs a = kargs(); unsigned char* ws = a->ws; LAS int* tstart = (LAS int*)(lds + LDS_AUX);
          const int tot = moe_tile_table(tstart, WSP(u32, WS_CTL), half);
          PolGateUp P; P.A = WSP(bf16_t, WS_H2); P.Bt = WSP(bf16_t, WS_WGU); P.bgu = a->bgu; P.toktab = WSP(u32, WS_TOKTAB); P.O = WSP(bf16_t, WS_ACT); P.mt.tstart = tstart; P.mt.cnt = WSP(u32, WS_CTL); P.mt.half = half;
          P.ord.init(tot, DFF / HALFT, gridDim.x, blockIdx.x);
          gemm_phase(lds, P); }
        GRID_SYNC();
        { KArgs a = kargs(); unsigned char* ws = a->ws; LAS int* tstart = (LAS int*)(lds + LDS_AUX);
          const int tot = moe_tile_table(tstart, WSP(u32, WS_CTL), half);
          PolDown P; P.A = WSP(bf16_t, WS_ACT); P.Bt = WSP(bf16_t, WS_WD); P.bd = a->bd; P.toktab = WSP(u32, WS_TOKTAB); P.wtab = WSP(float, WS_WTAB); P.O = WSP(bf16_t, WS_Y); P.mt.tstart = tstart; P.mt.cnt = WSP(u32, WS_CTL); P.mt.half = half;
          P.ord.init(tot, D / BM, gridDim.x, blockIdx.x);
          gemm_phase(lds, P); }
        GRID_SYNC();
        { KArgs a = kargs(); unsigned char* ws = a->ws; phase_combine(a->out, WSP(bf16_t, WS_Y), WSP(float, WS_MOD), a->final_w, half, blockIdx.x, gridDim.x); }
        __syncthreads();
    }
}

extern "C" void kernel_launch(void* const* d_in, const int* in_sizes, int n_in, void* d_out, int out_size, void* d_ws, size_t ws_size, hipStream_t stream) {
    static int grid_blocks = 0;
    if (!grid_blocks) {
        int dev = 0, cus = 0, per_cu = 0;
        (void)hipGetDevice(&dev);
        (void)hipDeviceGetAttribute(&cus, hipDeviceAttributeMultiprocessorCount, dev);
        (void)hipFuncSetAttribute((const void*)k_mega, hipFuncAttributeMaxDynamicSharedMemorySize, LDS_BYTES);
        (void)hipOccupancyMaxActiveBlocksPerMultiprocessor(&per_cu, (const void*)k_mega, 512, LDS_BYTES);
        if (per_cu < 1) { fprintf(stderr, "kernel_launch: occupancy query says %d blocks/CU\n", per_cu); per_cu = 1; }
        grid_blocks = cus * 1;
    }
    if (ws_size < 1024 * MiB) { fprintf(stderr, "kernel_launch: workspace too small (%zu)\n", ws_size); return; }
    MegaArgs a{};
    const float** ap = (const float**)&a;
    for (int i = 0; i < 26; ++i) ap[i] = (const float*)d_in[i];
    a.out = (float*)d_out; a.ws = (unsigned char*)d_ws;
    (void)hipMemsetAsync((unsigned char*)d_ws + WS_CTL, 0, 4096, stream);
    void* args[] = {&a};
    hipError_t e = hipLaunchCooperativeKernel((const void*)k_mega, dim3(grid_blocks), dim3(512), args, LDS_BYTES, stream);
    if (e != hipSuccess) fprintf(stderr, "cooperative launch failed: %s (grid %d)\n", hipGetErrorString(e), grid_blocks);
}
```

```cpp
#include <hip/hip_runtime.h>
#include <hip/hip_cooperative_groups.h>
#include <cstdio>
#include <cstdint>

typedef unsigned short bf16_t;
typedef unsigned int u32;
namespace cg = cooperative_groups;

constexpr int D = 1024, NB = 32, T = 2048, CTXL = 256, GRIDW = 64, GROWS = T / GRIDW;
constexpr int NLAT = NB * T;
constexpr int NCTX = NB * CTXL;
constexpr int NROWS = NLAT + NCTX;
constexpr int HGW = 512, RGW = 512, INW = 3584;
constexpr int C_Q = 0, C_I = 512, C_FF = 1024, C_FB = 1536, C_G = 2048, C_RX = 2560, C_RG = 3072;
constexpr int NE = 32, TOPK = 4, DFF = 1024;
constexpr int HALF_TOK = NLAT / 2;
constexpr int CAP = HALF_TOK;
constexpr int MAXSLOT = HALF_TOK * TOPK + NE * 256;
constexpr float EPS = 1e-6f;

constexpr size_t MiB = 1u << 20;
constexpr size_t WS_CTL = 0;
constexpr size_t WS_MOD = 1 * MiB;
constexpr size_t WS_LB = WS_MOD + 33 * 6144 * 4;
constexpr size_t WS_TOKTAB = 2 * MiB;
constexpr size_t WS_WTAB = 10 * MiB;
constexpr size_t WS_SCR = 28 * MiB;
constexpr size_t WS_OF = 28 * MiB, WS_OB = 92 * MiB, WS_HF = 156 * MiB, WS_HB = 220 * MiB;
constexpr size_t WS_WIN = 18 * MiB, WS_WOUT = 25 * MiB;
constexpr size_t WS_WG = 64 * 1024;
constexpr size_t WS_COEF = WS_LB + 4096;
constexpr size_t WS_AGG = 932 * MiB;
constexpr size_t WS_WGU = 156 * MiB, WS_WD = 284 * MiB;
constexpr size_t WS_H = 284 * MiB;
constexpr size_t WS_PROJ = 428 * MiB;
constexpr size_t WS_ACT = 428 * MiB;
constexpr size_t WS_Y = 428 * MiB + 272 * MiB;

constexpr size_t WS_MIX2 = WS_H;
constexpr size_t WS_H2 = WS_SCR;

__device__ __forceinline__ float bf2f(bf16_t b) { return __uint_as_float(((u32)b) << 16); }
__device__ __forceinline__ bf16_t f2bf(float f) { u32 u = __float_as_uint(f); u += 0x7fffu + ((u >> 16) & 1u); return (bf16_t)(u >> 16); }
__device__ __forceinline__ u32 pk2(float lo, float hi) { return (u32)f2bf(lo) | ((u32)f2bf(hi) << 16); }
__device__ __forceinline__ float sigmoidf_(float x) { return 1.0f / (1.0f + __expf(-x)); }
__device__ __forceinline__ float wave_sum(float v) {
#pragma unroll
    for (int o = 1; o < 64; o <<= 1) v += __shfl_xor(v, o);
    return v;
}

__device__ __forceinline__ float gelu_tanh(float x) { const float u = 0.7978845608028654f * (x + 0.044715f * x * x * x); return 0.5f * x * (1.0f + tanhf(u)); }
#define LAS __attribute__((address_space(3)))
typedef short bf16x8 __attribute__((ext_vector_type(8)));
typedef float f32x4 __attribute__((ext_vector_type(4)));
typedef unsigned u32x4 __attribute__((ext_vector_type(4)));
constexpr int BM = 256, BK = 64, HALFT = 128, HTB = HALFT * BK * 2, STAGE_BYTES = 8 * HTB, NXCD = 8, WGM = 8;
constexpr int GK = 1024;
constexpr int LDS_BYTES = 147456;
constexpr int LDS_AUX = STAGE_BYTES;

__device__ __forceinline__ int lds_byte(int r, int c) { const int st = (r >> 4) * 2 + (c >> 5), rr = r & 15, cc = c & 31, ob = rr * 64 + cc * 2; return st * 1024 + (ob ^ (((ob >> 9) & 1) << 5)); }
__device__ __forceinline__ void stage_rc(int b, int& R, int& C) { const int st = b / 1024, sb = b % 1024, swz = sb ^ (((sb >> 9) & 1) << 5); R = (st >> 1) * 16 + swz / 64; C = (st & 1) * 32 + (swz % 64) / 2; }
__device__ __forceinline__ int perm32(int rho) { const int n = rho >> 4, i = rho & 15; return 8 * (i >> 2) + 4 * n + (i & 3); }
__device__ __forceinline__ unsigned cvt_pk_bf16(float lo, float hi) { unsigned r; asm volatile("v_cvt_pk_bf16_f32 %0, %1, %2" : "=v"(r) : "v"(lo), "v"(hi)); return r; }

struct Unit { int pm, pn, e, pos0, cn; };
struct TileOrder {
    int nM, nN, nwg, G, c;
    __device__ __forceinline__ void init(int nM_, int nN_, int G_, int c_) { nM = nM_; nN = nN_; nwg = nM * nN; G = G_; c = c_; }
    __device__ __forceinline__ bool tile(int i, int& pm, int& pn) const {
        const long L = (long)i * G + c; if (L >= nwg) return false;
        int wgid = (int)L; { const int q = nwg / NXCD, r = nwg % NXCD, xcd = wgid % NXCD, off = wgid / NXCD; wgid = (xcd < r ? xcd * (q + 1) : r * (q + 1) + (xcd - r) * q) + off; }
        const int nig = WGM * nN, gid = wgid / nig, fm = gid * WGM, gsz = (nM - fm) < WGM ? (nM - fm) : WGM;
        pm = fm + ((wgid % nig) % gsz); pn = (wgid % nig) / gsz; return true;
    }
};

template <class POL>
__device__ __forceinline__ void gemm_phase(LAS unsigned char* lds, const POL& P) {
    int tid_ = threadIdx.x; asm volatile("" : "+v"(tid_));
    const int tid = tid_, wid = __builtin_amdgcn_readfirstlane(tid >> 6), lane = tid & 63, wr = wid >> 2, wc = wid & 3, fr = lane & 15, fq = lane >> 4;
    constexpr int K = GK, nt = K / BK;
    int sR[2], sC[2]; unsigned voffA[2], voffB[2];
#pragma unroll
    for (int i = 0; i < 2; ++i) { stage_rc(tid * 16 + i * 8192, sR[i], sC[i]); const int Rb = POL::PERM ? ((sR[i] & ~31) + perm32(sR[i] & 31)) : sR[i]; voffA[i] = (unsigned)(sR[i] * K + sC[i]) * 2u; voffB[i] = (unsigned)(Rb * K + sC[i]) * 2u; }
    constexpr size_t kstep = (size_t)(BK * 2);
    constexpr unsigned hstepB = (unsigned)HALFT * K * 2;
    const unsigned ldsw = (unsigned)wid * 1024u;
    const int aoff = lds_byte(wr * 64 + fr, fq * 8), boff = lds_byte(wc * 32 + fr, fq * 8);
#define G_SA(b, h) (((b) * 2 + (h)) * HTB)
#define G_SB(b, h) ((4 + (b) * 2 + (h)) * HTB)
#define G_AOFF(OFF, h, i) (POL::GATHER ? (OFF)[h][i] : voffA[i])
#define G_STAGE_A(bufoff, gbase, OFF, h) do { const char* _gb = (const char*)(gbase) + (POL::GATHER ? (size_t)0 : (size_t)(h) * hstepB); _Pragma("unroll") for (int _i = 0; _i < 2; ++_i) \
        __builtin_amdgcn_global_load_lds((const unsigned*)(_gb + G_AOFF(OFF, h, _i)), (LAS unsigned*)(lds + (bufoff) + ldsw + _i * 8192), 16, 0, 0); } while (0)
#define G_STAGE_B(bufoff, gbase, hoff) do { const char* _gb = (const char*)(gbase) + (size_t)(hoff); _Pragma("unroll") for (int _i = 0; _i < 2; ++_i) \
        __builtin_amdgcn_global_load_lds((const unsigned*)(_gb + voffB[_i]), (LAS unsigned*)(lds + (bufoff) + ldsw + _i * 8192), 16, 0, 0); } while (0)
#define G_LDA(dst, b, h) do { _Pragma("unroll") for (int m = 0; m < 4; ++m) _Pragma("unroll") for (int k = 0; k < 2; ++k) dst[m][k] = *(const LAS bf16x8*)(lds + G_SA(b, h) + aoff + m * 2048 + k * 1024); } while (0)
#define G_LDB(dst, b, h) do { _Pragma("unroll") for (int n = 0; n < 2; ++n) _Pragma("unroll") for (int k = 0; k < 2; ++k) dst[n][k] = *(const LAS bf16x8*)(lds + G_SB(b, h) + boff + n * 2048 + k * 1024); } while (0)
#define G_MMA(ai, bj, At, Bt) do { __builtin_amdgcn_s_setprio(1); _Pragma("unroll") for (int m = 0; m < 4; ++m) _Pragma("unroll") for (int n = 0; n < 2; ++n) _Pragma("unroll") for (int k = 0; k < 2; ++k) \
        acc[ai][bj][m][n] = __builtin_amdgcn_mfma_f32_16x16x32_bf16(Bt[n][k], At[m][k], acc[ai][bj][m][n], 0, 0, 0); __builtin_amdgcn_s_setprio(0); } while (0)
#define G_WAIT_V(n) asm volatile("s_waitcnt vmcnt(" #n ")" ::: "memory")
#define G_WAIT_L(n) asm volatile("s_waitcnt lgkmcnt(" #n ")" ::: "memory")
#define G_BAR __builtin_amdgcn_s_barrier()
#define G_SCHED __builtin_amdgcn_sched_barrier(0)
#define G_TRIP(A1, OC, A2, ON, B2) do { \
        G_LDB(B0, 0, 0); G_SCHED; G_LDA(At, 0, 0); G_STAGE_A(G_SA(1, 1), A1, OC, 1); \
        G_WAIT_L(8); G_BAR; G_WAIT_L(0); G_MMA(0, 0, At, B0); G_BAR; G_SCHED; \
        G_LDB(B1, 0, 1); G_STAGE_B(G_SB(0, 0), B2, 0u); \
        G_BAR; G_WAIT_L(0); G_MMA(0, 1, At, B1); G_BAR; \
        G_LDA(At, 0, 1); G_STAGE_A(G_SA(0, 0), A2, ON, 0); \
        G_BAR; G_WAIT_L(0); G_MMA(1, 0, At, B0); G_BAR; G_SCHED; \
        G_STAGE_B(G_SB(0, 1), B2, hstepB); \
        G_WAIT_V(6); G_BAR; G_MMA(1, 1, At, B1); G_BAR; \
        G_LDB(B0, 1, 0); G_SCHED; G_LDA(At, 1, 0); G_STAGE_A(G_SA(0, 1), A2, ON, 1); \
        G_WAIT_L(8); G_BAR; G_WAIT_L(0); G_MMA(0, 0, At, B0); G_BAR; G_SCHED; \
        G_LDB(B1, 1, 1); G_STAGE_B(G_SB(1, 0), (B2) + kstep, 0u); \
        G_BAR; G_WAIT_L(0); G_MMA(0, 1, At, B1); G_BAR; \
        G_LDA(At, 1, 1); G_STAGE_A(G_SA(1, 0), (A2) + kstep, ON, 0); \
        G_BAR; G_WAIT_L(0); G_MMA(1, 0, At, B0); G_BAR; G_SCHED; \
        G_STAGE_B(G_SB(1, 1), (B2) + kstep, hstepB); \
        G_WAIT_V(6); G_BAR; G_MMA(1, 1, At, B1); G_BAR; } while (0)
    Unit cur, nxt; int ui = 0;
    if (!P.next(0, cur)) return;
    f32x4 acc[2][2][4][2];
#pragma unroll
    for (int a = 0; a < 2; ++a)
#pragma unroll
        for (int b = 0; b < 2; ++b)
#pragma unroll
            for (int m = 0; m < 4; ++m)
#pragma unroll
                for (int n = 0; n < 2; ++n) acc[a][b][m][n] = (f32x4){0.f, 0.f, 0.f, 0.f};
    bf16x8 At[4][2], B0[2][2], B1[2][2];
    unsigned oc[2][2], on[2][2];
#pragma unroll
    for (int h = 0; h < 2; ++h)
#pragma unroll
        for (int i = 0; i < 2; ++i) { oc[h][i] = POL::GATHER ? P.a_off(cur, h * HALFT + sR[i]) + (unsigned)sC[i] * 2u : 0u; on[h][i] = 0u; }
    const char* cA = P.a_base(cur); const char* cB = P.b_base(cur);
    G_STAGE_B(G_SB(0, 0), cB, 0u); G_STAGE_A(G_SA(0, 0), cA, oc, 0); G_STAGE_B(G_SB(0, 1), cB, hstepB); G_STAGE_A(G_SA(0, 1), cA, oc, 1);
    if (wr == 1) G_BAR;
    G_WAIT_V(4); G_BAR;
    G_STAGE_B(G_SB(1, 0), cB + kstep, 0u); G_STAGE_A(G_SA(1, 0), cA + kstep, oc, 0); G_STAGE_B(G_SB(1, 1), cB + kstep, hstepB);
    G_WAIT_V(6); G_BAR;
    for (;;) {
        const bool has_next = P.next(ui + 1, nxt);
        const char* nA = has_next ? P.a_base(nxt) : cA; const char* nB = has_next ? P.b_base(nxt) : cB;
        if (POL::GATHER) {
#pragma unroll
            for (int h = 0; h < 2; ++h)
#pragma unroll
                for (int i = 0; i < 2; ++i) on[h][i] = has_next ? P.a_off(nxt, h * HALFT + sR[i]) + (unsigned)sC[i] * 2u : oc[h][i];
        }
#pragma unroll 1
        for (int t = 0; t < nt; t += 2) {
            const bool last = (t == nt - 2);
            const char* a1 = cA + (size_t)(t + 1) * kstep; const char* a2 = last ? nA : cA + (size_t)(t + 2) * kstep; const char* b2 = last ? nB : cB + (size_t)(t + 2) * kstep;
            if (POL::GATHER) {
                unsigned os[2][2];
#pragma unroll
                for (int h = 0; h < 2; ++h)
#pragma unroll
                    for (int i = 0; i < 2; ++i) os[h][i] = last ? on[h][i] : oc[h][i];
                G_TRIP(a1, oc, a2, os, b2);
            } else { G_TRIP(a1, oc, a2, oc, b2); }
        }
        if (wr == 0) G_BAR;
        P.epi(acc, cur, wr, wc, fr, fq);
        if (!has_next) break;
#pragma unroll
        for (int a = 0; a < 2; ++a)
#pragma unroll
            for (int b = 0; b < 2; ++b)
#pragma unroll
                for (int m = 0; m < 4; ++m)
#pragma unroll
                    for (int n = 0; n < 2; ++n) acc[a][b][m][n] = (f32x4){0.f, 0.f, 0.f, 0.f};
        cur = nxt; cA = nA; cB = nB; ++ui;
        if (POL::GATHER) {
#pragma unroll
            for (int h = 0; h < 2; ++h)
#pragma unroll
                for (int i = 0; i < 2; ++i) oc[h][i] = on[h][i];
        }
        if (wr == 1) G_BAR;
    }
    G_WAIT_V(0);
    G_BAR;
#undef G_SA
#undef G_SB
#undef G_AOFF
#undef G_STAGE_A
#undef G_STAGE_B
#undef G_LDA
#undef G_LDB
#undef G_MMA
#undef G_WAIT_V
#undef G_WAIT_L
#undef G_BAR
#undef G_SCHED
#undef G_TRIP
}

struct PolInProj {
    static constexpr bool PERM = true, GATHER = false;
    const bf16_t* A; const bf16_t* Bt; bf16_t* O; TileOrder ord;
    __device__ __forceinline__ bool next(int i, Unit& u) const { return ord.tile(i, u.pm, u.pn); }
    __device__ __forceinline__ const char* a_base(const Unit& u) const { return (const char*)A + (size_t)u.pm * BM * GK * 2; }
    __device__ __forceinline__ unsigned a_off(const Unit&, int r) const { return (unsigned)r * GK * 2u; }
    __device__ __forceinline__ const char* b_base(const Unit& u) const { return (const char*)Bt + (size_t)u.pn * BM * GK * 2; }
    __device__ __forceinline__ void epi(const f32x4 (&acc)[2][2][4][2], const Unit& u, int wr, int wc, int fr, int fq) const {
        const int row0 = u.pm * BM + wr * 64 + fr, col0 = u.pn * BM + wc * 32 + 8 * fq;
#pragma unroll
        for (int ai = 0; ai < 2; ++ai)
#pragma unroll
            for (int m = 0; m < 4; ++m) { bf16_t* rowp = O + (size_t)(row0 + ai * HALFT + m * 16) * INW + col0;
#pragma unroll
                for (int bj = 0; bj < 2; ++bj) { const f32x4 v0 = acc[ai][bj][m][0], v1 = acc[ai][bj][m][1];
                    u32x4 w; w.x = cvt_pk_bf16(v0[0], v0[1]); w.y = cvt_pk_bf16(v0[2], v0[3]); w.z = cvt_pk_bf16(v1[0], v1[1]); w.w = cvt_pk_bf16(v1[2], v1[3]);
                    *(u32x4*)(rowp + bj * HALFT) = w; } }
    }
};
struct PolOutProj {
    static constexpr bool PERM = false, GATHER = false;
    const bf16_t* A; const bf16_t* Bt; const float* x; const float* mod; float* O; TileOrder ord;
    __device__ __forceinline__ bool next(int i, Unit& u) const { return ord.tile(i, u.pm, u.pn); }
    __device__ __forceinline__ const char* a_base(const Unit& u) const { return (const char*)A + (size_t)u.pm * BM * GK * 2; }
    __device__ __forceinline__ unsigned a_off(const Unit&, int r) const { return (unsigned)r * GK * 2u; }
    __device__ __forceinline__ const char* b_base(const Unit& u) const { return (const char*)Bt + (size_t)u.pn * BM * GK * 2; }
    __device__ __forceinline__ void epi(const f32x4 (&acc)[2][2][4][2], const Unit& u, int wr, int wc, int fr, int fq) const {
        const int row0 = u.pm * BM + wr * 64 + fr, col0 = u.pn * BM + wc * 32 + 4 * fq;
        const float* g1 = mod + (size_t)((u.pm * BM) >> 11) * 6144 + 2048 + col0;
        f32x4 gv[2][2];
#pragma unroll
        for (int bj = 0; bj < 2; ++bj)
#pragma unroll
            for (int n = 0; n < 2; ++n) gv[bj][n] = *(const f32x4*)(g1 + bj * HALFT + n * 16);
#pragma unroll
        for (int ai = 0; ai < 2; ++ai)
#pragma unroll
            for (int m = 0; m < 4; ++m) { const size_t off = (size_t)(row0 + ai * HALFT + m * 16) * D + col0;
#pragma unroll
                for (int bj = 0; bj < 2; ++bj)
#pragma unroll
                    for (int n = 0; n < 2; ++n) { const f32x4 xv = *(const f32x4*)(x + off + bj * HALFT + n * 16); *(f32x4*)(O + off + bj * HALFT + n * 16) = xv + gv[bj][n] * acc[ai][bj][m][n]; } }
    }
};
struct MoeTiles {
    const LAS int* tstart; const u32* cnt; int half;
    __device__ __forceinline__ void find(Unit& u) const {
        int e = 0;
#pragma unroll 1
        for (int i = 1; i < NE; ++i) if (u.pm >= tstart[i]) e = i;
        u.e = e; u.pos0 = (u.pm - tstart[e]) * BM; u.cn = (int)cnt[half * NE + e];
    }
};
struct PolGateUp {
    static constexpr bool PERM = true, GATHER = true;
    const bf16_t* A; const bf16_t* Bt; const float* bgu; const u32* toktab; bf16_t* O; MoeTiles mt; TileOrder ord;
    __device__ __forceinline__ bool next(int i, Unit& u) const { if (!ord.tile(i, u.pm, u.pn)) return false; mt.find(u); return true; }
    __device__ __forceinline__ const char* a_base(const Unit&) const { return (const char*)A; }
    __device__ __forceinline__ unsigned a_off(const Unit& u, int r) const {
        const int p = u.pos0 + r; const u32 tk = toktab[((size_t)mt.half * NE + u.e) * CAP + (p < u.cn ? p : 0)];
        return (tk >> 2) * (unsigned)(GK * 2);
    }
    __device__ __forceinline__ const char* b_base(const Unit& u) const { return (const char*)Bt + ((size_t)u.e * 2048 + (size_t)u.pn * BM) * GK * 2; }
    __device__ __forceinline__ void epi(const f32x4 (&acc)[2][2][4][2], const Unit& u, int wr, int wc, int fr, int fq) const {
        const int row0 = u.pm * BM + wr * 64 + fr, cc = u.pn * HALFT + wc * 32 + 8 * fq;
        const float* bg = bgu + (size_t)u.e * 2048 + cc;
        const f32x4 bg0 = *(const f32x4*)bg, bg1 = *(const f32x4*)(bg + 4), bu0 = *(const f32x4*)(bg + 1024), bu1 = *(const f32x4*)(bg + 1028);
#pragma unroll
        for (int ai = 0; ai < 2; ++ai)
#pragma unroll
            for (int m = 0; m < 4; ++m) {
                f32x4 g0 = acc[ai][0][m][0] + bg0, g1 = acc[ai][0][m][1] + bg1, u0 = acc[ai][1][m][0] + bu0, u1 = acc[ai][1][m][1] + bu1;
                float o[8];
#pragma unroll
                for (int j = 0; j < 4; ++j) {
                    const float ga = fminf(g0[j], 7.0f), gb = fminf(g1[j], 7.0f);
                    const float ua = fminf(fmaxf(u0[j], -7.0f), 7.0f), ub = fminf(fmaxf(u1[j], -7.0f), 7.0f);
                    o[j] = ga * sigmoidf_(1.702f * ga) * (ua + 1.0f); o[4 + j] = gb * sigmoidf_(1.702f * gb) * (ub + 1.0f);
                }
                u32x4 w; w.x = cvt_pk_bf16(o[0], o[1]); w.y = cvt_pk_bf16(o[2], o[3]); w.z = cvt_pk_bf16(o[4], o[5]); w.w = cvt_pk_bf16(o[6], o[7]);
                *(u32x4*)(O + (size_t)(row0 + ai * HALFT + m * 16) * DFF + cc) = w;
            }
    }
};
struct PolDown {
    static constexpr bool PERM = true, GATHER = false;
    const bf16_t* A; const bf16_t* Bt; const float* bd; const u32* toktab; const float* wtab; bf16_t* O; MoeTiles mt; TileOrder ord;
    __device__ __forceinline__ bool next(int i, Unit& u) const { if (!ord.tile(i, u.pm, u.pn)) return false; mt.find(u); return true; }
    __device__ __forceinline__ const char* a_base(const Unit& u) const { return (const char*)A + (size_t)u.pm * BM * GK * 2; }
    __device__ __forceinline__ unsigned a_off(const Unit&, int r) const { return (unsigned)r * GK * 2u; }
    __device__ __forceinline__ const char* b_base(const Unit& u) const { return (const char*)Bt + ((size_t)u.e * 1024 + (size_t)u.pn * BM) * GK * 2; }
    __device__ __forceinline__ void epi(const f32x4 (&acc)[2][2][4][2], const Unit& u, int wr, int wc, int fr, int fq) const {
        const int col0 = u.pn * BM + wc * 32 + 8 * fq;
        const float* bp = bd + (size_t)u.e * D + col0;
        f32x4 bv[2][2];
#pragma unroll
        for (int bj = 0; bj < 2; ++bj) { bv[bj][0] = *(const f32x4*)(bp + bj * HALFT); bv[bj][1] = *(const f32x4*)(bp + bj * HALFT + 4); }
        const size_t tb = ((size_t)mt.half * NE + u.e) * CAP;
#pragma unroll
        for (int ai = 0; ai < 2; ++ai)
#pragma unroll
            for (int m = 0; m < 4; ++m) {
                const int p = u.pos0 + ai * HALFT + wr * 64 + m * 16 + fr;
                if (p < u.cn) {
                    const u32 tk = toktab[tb + p]; const float wg = wtab[tb + p];
                    bf16_t* rowp = O + (size_t)(tk - (u32)mt.half * HALF_TOK * 4u) * D + col0;
#pragma unroll
                    for (int bj = 0; bj < 2; ++bj) { const f32x4 v0 = (acc[ai][bj][m][0] + bv[bj][0]) * wg, v1 = (acc[ai][bj][m][1] + bv[bj][1]) * wg;
                        u32x4 w; w.x = cvt_pk_bf16(v0[0], v0[1]); w.y = cvt_pk_bf16(v0[2], v0[3]); w.z = cvt_pk_bf16(v1[0], v1[1]); w.w = cvt_pk_bf16(v1[2], v1[3]);
                        *(u32x4*)(rowp + bj * HALFT) = w; }
                }
            }
    }
};
__device__ __forceinline__ int moe_tile_table(LAS int* tstart, const u32* cnt, int half) {
    if (threadIdx.x == 0) { int s = 0; for (int e = 0; e < NE; ++e) { tstart[e] = s; s += ((int)cnt[half * NE + e] + BM - 1) / BM; } tstart[NE] = s; }
    __syncthreads();
    const int tot = tstart[NE];
    return tot;
}

__device__ __forceinline__ void conv_item(const float* __restrict__ W, int N, bf16_t* __restrict__ WT, int k0, int n0, size_t rowbase, LAS float* scr, int lane) {
#pragma unroll 4
    for (int i = 0; i < 16; ++i) { const int k = 4 * i + (lane >> 4); const f32x4 v = *(const f32x4*)(W + (size_t)(k0 + k) * N + n0 + (lane & 15) * 4); *(LAS f32x4*)(scr + k * 68 + (lane & 15) * 4) = v; }
    asm volatile("s_waitcnt lgkmcnt(0)" ::: "memory");
    const int c = lane & 7;
#pragma unroll
    for (int j = 0; j < 8; ++j) { const int n = (lane >> 3) + 8 * j; const LAS float* s = scr + (8 * c) * 68 + n;
        u32x4 o; o.x = cvt_pk_bf16(s[0 * 68], s[1 * 68]); o.y = cvt_pk_bf16(s[2 * 68], s[3 * 68]); o.z = cvt_pk_bf16(s[4 * 68], s[5 * 68]); o.w = cvt_pk_bf16(s[6 * 68], s[7 * 68]);
        *(u32x4*)(WT + (rowbase + n) * GK + k0 + 8 * c) = o; }
    asm volatile("s_waitcnt lgkmcnt(0)" ::: "memory");
}
constexpr int IT_IN = 16 * (INW / 64), IT_OUT = 16 * (D / 64), IT_GU = NE * 16 * 32, IT_D = NE * 16 * 16, IT_ALL = IT_IN + IT_OUT + IT_GU + IT_D;
struct ProArgs { const float *c, *c_ctx, *w_ada, *b_ada, *lbl, *w_in, *w_out, *wgu, *wd, *rg_wa, *rg_wx, *rg_lam; float *mod, *lb, *coef; bf16_t *Win_t, *Wout_t, *Wgu_t, *Wd_t, *WG_t; };
__device__ __forceinline__ void phase_prologue(LAS unsigned char* lds, const ProArgs& a, int bid, int G, bool do_mod, int it_lo, int it_hi) {
    const int tid = threadIdx.x, lane = tid & 63, w = tid >> 6;
    if (!do_mod) {} else if (bid < 96) {
        LAS float* s = (LAS float*)lds;
        for (int i = tid; i < 33 * D; i += 512) { const int b = i >> 10, k = i & 1023; const float v = b < NB ? a.c[(size_t)b * D + k] : a.c_ctx[k]; s[i] = v * sigmoidf_(v); }
        __syncthreads();
        const int n = bid * 64 + lane;
        float acc[33];
#pragma unroll
        for (int b = 0; b < 33; ++b) acc[b] = 0.f;
        for (int k = 128 * w; k < 128 * w + 128; k += 4) {
            const float w0 = a.w_ada[(size_t)k * 6144 + n], w1 = a.w_ada[(size_t)(k + 1) * 6144 + n], w2 = a.w_ada[(size_t)(k + 2) * 6144 + n], w3 = a.w_ada[(size_t)(k + 3) * 6144 + n];
#pragma unroll
            for (int b = 0; b < 33; ++b) { const f32x4 sv = *(const LAS f32x4*)(s + b * D + k); acc[b] += sv[0] * w0 + sv[1] * w1 + sv[2] * w2 + sv[3] * w3; }
        }
        __syncthreads();
        LAS float* red = (LAS float*)lds;
#pragma unroll
        for (int b = 0; b < 33; ++b) red[(w * 33 + b) * 64 + lane] = acc[b];
        __syncthreads();
        for (int i = tid; i < 33 * 64; i += 512) { const int b = i >> 6, l = i & 63; float sum = a.b_ada[bid * 64 + l];
#pragma unroll
            for (int ww = 0; ww < 8; ++ww) sum += red[(ww * 33 + b) * 64 + l];
            a.mod[(size_t)b * 6144 + bid * 64 + l] = sum; }
        __syncthreads();
    } else if (bid == 96) {
        for (int i = tid; i < 2 * HGW; i += 512) { const float l0 = a.lbl[i], l1 = a.lbl[2 * HGW + i]; a.lb[i] = 1.0f / (1.0f + __expf(l1 - l0)); }
        for (int i = tid; i < 2 * RGW; i += 512) { const float l = a.rg_lam[i]; const float sp = (-l > 20.f) ? -l : log1pf(__expf(-l)); a.coef[i] = -8.0f * sp; }
    } else if (bid == 97) {
        for (int idx = tid; idx < 8 * 256 * 64; idx += 512) { const int hd = idx >> 14, n = (idx >> 6) & 255, kk = idx & 63, g = n >> 6, j = n & 63, d = g >> 1;
            const float* src = (g & 1) ? a.rg_wx : a.rg_wa; a.WG_t[idx] = f2bf(src[(((size_t)d * 8 + hd) * 64 + kk) * 64 + j]); }
    }
    LAS float* scr = (LAS float*)(lds + w * (64 * 68 * 4));
    const int gw = bid * 8 + w, NW = G * 8;
    for (int it = it_lo + gw; it < it_hi; it += NW) {
        int r = it;
        if (r < IT_IN) { const int kb = r / (INW / 64), nb = r % (INW / 64); conv_item(a.w_in, INW, a.Win_t, kb * 64, nb * 64, (size_t)nb * 64, scr, lane); continue; } r -= IT_IN;
        if (r < IT_OUT) { const int kb = r / 16, nb = r % 16; conv_item(a.w_out, D, a.Wout_t, kb * 64, nb * 64, (size_t)nb * 64, scr, lane); continue; } r -= IT_OUT;
        if (r < IT_GU) { const int e = r / 512, q = r % 512, kb = q / 32, nb = q % 32, n0 = nb * 64, bj = n0 >> 10, rem = n0 & 1023, pn = rem >> 7, cc0 = rem & 127;
            conv_item(a.wgu + (size_t)e * D * 2048, 2048, a.Wgu_t, kb * 64, n0, (size_t)e * 2048 + pn * 256 + bj * 128 + cc0, scr, lane); continue; } r -= IT_GU;
        { const int e = r / 256, q = r % 256, kb = q / 16, nb = q % 16; conv_item(a.wd + (size_t)e * DFF * D, D, a.Wd_t, kb * 64, nb * 64, (size_t)e * 1024 + nb * 64, scr, lane); }
    }
}


__device__ __forceinline__ void phase_norm1(const float* __restrict__ x, const float* __restrict__ ctx, const float* __restrict__ nw, const float* __restrict__ mod, bf16_t* __restrict__ H, int bid, int G) {
    const int lane = threadIdx.x & 63, gw = bid * 8 + (threadIdx.x >> 6), NW = G * 8;
    for (int r = gw; r < NROWS; r += NW) {
        const float* src = r < NLAT ? x + (size_t)r * D : ctx + (size_t)(r - NLAT) * D;
        const float* m = mod + (size_t)(r < NLAT ? (r >> 11) : NB) * 6144;
        f32x4 v[4]; float ss = 0.f;
#pragma unroll
        for (int j = 0; j < 4; ++j) { v[j] = *(const f32x4*)(src + j * 256 + lane * 4); ss += v[j][0] * v[j][0] + v[j][1] * v[j][1] + v[j][2] * v[j][2] + v[j][3] * v[j][3]; }
        const float rstd = rsqrtf(wave_sum(ss) * (1.0f / D) + EPS);
#pragma unroll
        for (int j = 0; j < 4; ++j) {
            const int c0 = j * 256 + lane * 4;
            const f32x4 w = *(const f32x4*)(nw + c0), sh = *(const f32x4*)(m + c0), sc = *(const f32x4*)(m + 1024 + c0);
            const f32x4 o = v[j] * rstd * w * (sc + 1.0f) + sh;
            uint2 p; p.x = cvt_pk_bf16(o[0], o[1]); p.y = cvt_pk_bf16(o[2], o[3]);
            *(uint2*)(H + (size_t)r * D + c0) = p;
        }
    }
}

__device__ __forceinline__ void phase_hgrn2_simple(LAS unsigned char* lds, const bf16_t* __restrict__ P, const float* __restrict__ lb, bf16_t* __restrict__ OF, bf16_t* __restrict__ OB, int item) {
    LAS float* qs = (LAS float*)lds; LAS float* fs = qs + 32 * 128; LAS float* vs = fs + 32 * 128;
    const int b = item >> 3, h = (item >> 1) & 3, dir = item & 1;
    const int tid = threadIdx.x, w = tid >> 6, lane = tid & 63, vi = lane & 15, kg = lane >> 4, v = 16 * w + vi;
    bf16_t* OD = dir == 0 ? OF : OB;
    float S[32];
#pragma unroll
    for (int i = 0; i < 32; ++i) S[i] = 0.f;
    const int lt = tid >> 4, lc = (tid & 15) * 8;
    float lbv[8];
#pragma unroll
    for (int i = 0; i < 8; ++i) lbv[i] = lb[dir * HGW + h * 128 + lc + i];
    const int cf = dir == 0 ? C_FF : C_FB;
    for (int n0 = 0; n0 < CTXL + T; n0 += 32) {
        __syncthreads();
        {
            const int n = n0 + lt;
            size_t row;
            if (n < CTXL) row = (size_t)NLAT + b * CTXL + (dir == 0 ? n : CTXL - 1 - n);
            else row = (size_t)b * T + (dir == 0 ? (n - CTXL) : (T - 1 - (n - CTXL)));
            const bf16_t* pr = P + row * INW + h * 128 + lc;
            const uint4 qv = *(const uint4*)(pr + C_Q), iv = *(const uint4*)(pr + C_I), fv = *(const uint4*)(pr + cf);
            const u32 qa[4] = {qv.x, qv.y, qv.z, qv.w}, ia[4] = {iv.x, iv.y, iv.z, iv.w}, fa[4] = {fv.x, fv.y, fv.z, fv.w};
#pragma unroll
            for (int i = 0; i < 4; ++i) {
                const float q0 = __uint_as_float(qa[i] << 16), q1 = __uint_as_float(qa[i] & 0xffff0000u);
                const float f0 = __uint_as_float(fa[i] << 16), f1 = __uint_as_float(fa[i] & 0xffff0000u);
                qs[lt * 128 + lc + 2 * i] = q0 * sigmoidf_(q0); qs[lt * 128 + lc + 2 * i + 1] = q1 * sigmoidf_(q1);
                vs[lt * 128 + lc + 2 * i] = __uint_as_float(ia[i] << 16); vs[lt * 128 + lc + 2 * i + 1] = __uint_as_float(ia[i] & 0xffff0000u);
                fs[lt * 128 + lc + 2 * i] = lbv[2 * i] + (1.f - lbv[2 * i]) * sigmoidf_(f0);
                fs[lt * 128 + lc + 2 * i + 1] = lbv[2 * i + 1] + (1.f - lbv[2 * i + 1]) * sigmoidf_(f1);
            }
        }
        __syncthreads();
        for (int j = 0; j < 32; ++j) {
            const float vv = vs[j * 128 + v];
            float o = 0.f;
#pragma unroll
            for (int i4 = 0; i4 < 8; ++i4) {
                const f32x4 f4 = *(const LAS f32x4*)(fs + j * 128 + 32 * kg + 4 * i4), q4 = *(const LAS f32x4*)(qs + j * 128 + 32 * kg + 4 * i4);
#pragma unroll
                for (int e = 0; e < 4; ++e) { S[4 * i4 + e] = f4[e] * (S[4 * i4 + e] - vv) + vv; o += S[4 * i4 + e] * q4[e]; }
            }
            o += __shfl_xor(o, 16); o += __shfl_xor(o, 32);
            const int n = n0 + j;
            if (n >= CTXL && kg == 0) {
                const int tt = dir == 0 ? (n - CTXL) : (T - 1 - (n - CTXL));
                OD[((size_t)b * T + tt) * HGW + h * 128 + v] = f2bf(o);
            }
        }
    }
}

constexpr int HQ_QD = 0, HQ_KD = 17408, HQ_KET = 34816, HQ_VT = 53248, HQ_PM = 71680, HQ_OS = 80896, HQ_TOT = 98304, HQ_DEC = 100352;
__device__ __forceinline__ bf16x8 pack8(const f32x4& a, const f32x4& b) {
    u32x4 w; w.x = cvt_pk_bf16(a[0], a[1]); w.y = cvt_pk_bf16(a[2], a[3]); w.z = cvt_pk_bf16(b[0], b[1]); w.w = cvt_pk_bf16(b[2], b[3]);
    return __builtin_bit_cast(bf16x8, w);
}
__device__ __forceinline__ void phase_hgrn2_chunk(LAS unsigned char* lds, const bf16_t* __restrict__ P, const float* __restrict__ lb, bf16_t* __restrict__ OF, bf16_t* __restrict__ OB, int item) {
    const int b = item >> 3, h = (item >> 1) & 3, dir = item & 1;
    const int tid = threadIdx.x, w = __builtin_amdgcn_readfirstlane(tid >> 6), lane = tid & 63, l15 = lane & 15, G4 = lane >> 4;
    const int k = tid & 127, seg = tid >> 7;
    const int kslot = (k & ~31) | (((k >> 2) & 3) << 3) | (((k >> 4) & 1) << 2) | (k & 3);
    const float lbv = lb[dir * HGW + h * 128 + k];
    bf16_t* OD = dir ? OB : OF;
    const int cf = dir ? C_FB : C_FF;
    LAS float* TOT = (LAS float*)(lds + HQ_TOT); LAS float* DEC = (LAS float*)(lds + HQ_DEC);
    f32x4 S[8];
#pragma unroll
    for (int t = 0; t < 8; ++t) S[t] = (f32x4){0.f, 0.f, 0.f, 0.f};
#pragma unroll 1
    for (int n = 0; n < (CTXL + T) / 64; ++n) {
        const bool lat = n >= CTXL / 64;
        float qv[16], vv[16], fv[16], cs[16];
#pragma unroll
        for (int i = 0; i < 16; ++i) {
            const int p = 64 * n + 16 * seg + i;
            const size_t row = p < CTXL ? (size_t)NLAT + b * CTXL + (dir ? CTXL - 1 - p : p) : (size_t)b * T + (dir ? T - 1 - (p - CTXL) : (p - CTXL));
            const bf16_t* pr = P + row * INW + h * 128 + k;
            qv[i] = bf2f(pr[C_Q]); vv[i] = bf2f(pr[C_I]); fv[i] = bf2f(pr[cf]);
        }
        float run = 0.f;
#pragma unroll
        for (int i = 0; i < 16; ++i) { const float f = lbv + (1.f - lbv) * sigmoidf_(fv[i]); fv[i] = f; run += __logf(f); cs[i] = run; }
        __syncthreads();
        TOT[seg * 128 + k] = run;
        __syncthreads();
        const float t0 = TOT[k], t1 = TOT[128 + k], t2 = TOT[256 + k], t3 = TOT[384 + k];
        const float prefix = seg == 0 ? 0.f : seg == 1 ? t0 : seg == 2 ? t0 + t1 : t0 + t1 + t2;
        const float blast = (t0 + t1) + (t2 + t3);
        if (seg == 0) DEC[k] = __expf(blast);
        float ke[16];
#pragma unroll
        for (int i = 0; i < 16; ++i) {
            const float bc = prefix + cs[i], e = __expf(bc), kf = 1.f - fv[i];
            const int j = 16 * seg + i;
            *(LAS bf16_t*)(lds + HQ_QD + j * 272 + kslot * 2) = f2bf(qv[i] * sigmoidf_(qv[i]) * e);
            *(LAS bf16_t*)(lds + HQ_KD + j * 272 + kslot * 2) = f2bf(kf * __expf(-bc));
            ke[i] = kf * __expf(blast - bc);
        }
        {
            u32x4 w0, w1;
            w0.x = cvt_pk_bf16(ke[0], ke[1]); w0.y = cvt_pk_bf16(ke[2], ke[3]); w0.z = cvt_pk_bf16(ke[4], ke[5]); w0.w = cvt_pk_bf16(ke[6], ke[7]);
            w1.x = cvt_pk_bf16(ke[8], ke[9]); w1.y = cvt_pk_bf16(ke[10], ke[11]); w1.z = cvt_pk_bf16(ke[12], ke[13]); w1.w = cvt_pk_bf16(ke[14], ke[15]);
            *(LAS u32x4*)(lds + HQ_KET + k * 144 + seg * 32) = w0; *(LAS u32x4*)(lds + HQ_KET + k * 144 + seg * 32 + 16) = w1;
            w0.x = cvt_pk_bf16(vv[0], vv[1]); w0.y = cvt_pk_bf16(vv[2], vv[3]); w0.z = cvt_pk_bf16(vv[4], vv[5]); w0.w = cvt_pk_bf16(vv[6], vv[7]);
            w1.x = cvt_pk_bf16(vv[8], vv[9]); w1.y = cvt_pk_bf16(vv[10], vv[11]); w1.z = cvt_pk_bf16(vv[12], vv[13]); w1.w = cvt_pk_bf16(vv[14], vv[15]);
            *(LAS u32x4*)(lds + HQ_VT + k * 144 + seg * 32) = w0; *(LAS u32x4*)(lds + HQ_VT + k * 144 + seg * 32 + 16) = w1;
        }
        __syncthreads();
        if (lat) {
            const int mt = w >> 1, ntp = w & 1;
            f32x4 pa[2] = {(f32x4){0.f, 0.f, 0.f, 0.f}, (f32x4){0.f, 0.f, 0.f, 0.f}};
#pragma unroll
            for (int s = 0; s < 4; ++s) {
                const bf16x8 a = *(const LAS bf16x8*)(lds + HQ_QD + (16 * mt + l15) * 272 + (32 * s + 8 * G4) * 2);
#pragma unroll
                for (int q = 0; q < 2; ++q) { const bf16x8 bq = *(const LAS bf16x8*)(lds + HQ_KD + (16 * (2 * ntp + q) + l15) * 272 + (32 * s + 8 * G4) * 2); pa[q] = __builtin_amdgcn_mfma_f32_16x16x32_bf16(a, bq, pa[q], 0, 0, 0); }
            }
#pragma unroll
            for (int q = 0; q < 2; ++q)
#pragma unroll
                for (int r = 0; r < 4; ++r) { const int c = 16 * mt + 4 * G4 + r, j = 16 * (2 * ntp + q) + l15; *(LAS bf16_t*)(lds + HQ_PM + c * 144 + j * 2) = f2bf(j <= c ? pa[q][r] : 0.f); }
        }
        __syncthreads();
        bf16x8 vb[2];
#pragma unroll
        for (int s = 0; s < 2; ++s) vb[s] = *(const LAS bf16x8*)(lds + HQ_VT + (16 * w + l15) * 144 + (32 * s + 8 * G4) * 2);
        if (lat) {
            bf16x8 sb[4];
#pragma unroll
            for (int s = 0; s < 4; ++s) sb[s] = pack8(S[2 * s], S[2 * s + 1]);
#pragma unroll
            for (int mt = 0; mt < 4; ++mt) {
                f32x4 oa = (f32x4){0.f, 0.f, 0.f, 0.f};
#pragma unroll
                for (int s = 0; s < 2; ++s) { const bf16x8 a = *(const LAS bf16x8*)(lds + HQ_PM + (16 * mt + l15) * 144 + (32 * s + 8 * G4) * 2); oa = __builtin_amdgcn_mfma_f32_16x16x32_bf16(a, vb[s], oa, 0, 0, 0); }
#pragma unroll
                for (int s = 0; s < 4; ++s) { const bf16x8 a = *(const LAS bf16x8*)(lds + HQ_QD + (16 * mt + l15) * 272 + (32 * s + 8 * G4) * 2); oa = __builtin_amdgcn_mfma_f32_16x16x32_bf16(a, sb[s], oa, 0, 0, 0); }
#pragma unroll
                for (int r = 0; r < 4; ++r) *(LAS bf16_t*)(lds + HQ_OS + (16 * mt + 4 * G4 + r) * 272 + (16 * w + l15) * 2) = f2bf(oa[r]);
            }
        }
#pragma unroll
        for (int t = 0; t < 8; ++t) {
            const f32x4 d4 = *(const LAS f32x4*)(DEC + 16 * t + 4 * G4);
            S[t] = S[t] * d4;
#pragma unroll
            for (int s = 0; s < 2; ++s) { const bf16x8 a = *(const LAS bf16x8*)(lds + HQ_KET + (16 * t + l15) * 144 + (32 * s + 8 * G4) * 2); S[t] = __builtin_amdgcn_mfma_f32_16x16x32_bf16(a, vb[s], S[t], 0, 0, 0); }
        }
        __syncthreads();
        if (lat) {
            const int j = tid >> 3, part = tid & 7, p = 64 * n + j, tt = dir ? T - 1 - (p - CTXL) : (p - CTXL);
            const u32x4 o0 = *(const LAS u32x4*)(lds + HQ_OS + j * 272 + part * 32), o1 = *(const LAS u32x4*)(lds + HQ_OS + j * 272 + part * 32 + 16);
            bf16_t* dst = OD + ((size_t)b * T + tt) * HGW + h * 128 + part * 16;
            *(u32x4*)dst = o0; *(u32x4*)(dst + 8) = o1;
        }
    }
}

__device__ __forceinline__ size_t rg_row(int b, bool lat, int p) {
    return lat ? (size_t)b * T + (size_t)(p % GROWS) * GRIDW + (p / GROWS) : (size_t)NLAT + b * CTXL + p;
}
template <int dir>
__device__ __forceinline__ void rglru_simple_wave(LAS float* xs, const bf16_t* __restrict__ P, const float* __restrict__ conv_w, const float* __restrict__ conv_b,
                                                  const float* __restrict__ wa, const float* __restrict__ ba, const float* __restrict__ wx, const float* __restrict__ bx,
                                                  const float* __restrict__ lam, bf16_t* __restrict__ HD, int hd, int b) {
    const int j = threadIdx.x & 63, c = hd * 64 + j;
    float wac[64], wxc[64];
#pragma unroll
    for (int i = 0; i < 64; ++i) { wac[i] = wa[(((size_t)dir * 8 + hd) * 64 + i) * 64 + j]; wxc[i] = wx[(((size_t)dir * 8 + hd) * 64 + i) * 64 + j]; }
    const float cw0 = conv_w[0 * RGW + c], cw1 = conv_w[1 * RGW + c], cw2 = conv_w[2 * RGW + c], cw3 = conv_w[3 * RGW + c], cb = conv_b[c];
    const float bav = ba[dir * RGW + c], bxv = bx[dir * RGW + c];
    const float l = lam[dir * RGW + c];
    const float sp = (-l > 20.f) ? -l : log1pf(__expf(-l));
    const float coef = -8.0f * sp;
    float hst = 0.f;
    for (int seg = 0; seg < 2; ++seg) {
        const bool lat = seg == 1; const int L = lat ? T : CTXL;
        for (int s0 = 0; s0 < L; s0 += 16) {
            float xc[16];
            const int plo = dir == 0 ? s0 : L - 16 - s0;
            {
                float rx[19];
#pragma unroll
                for (int i = 0; i < 19; ++i) { const int p = plo - 2 + i; rx[i] = (p >= 0 && p < L) ? bf2f(P[rg_row(b, lat, p) * INW + C_RX + c]) : 0.f; }
#pragma unroll
                for (int i = 0; i < 16; ++i) xc[i] = cb + cw0 * rx[i] + cw1 * rx[i + 1] + cw2 * rx[i + 2] + cw3 * rx[i + 3];
            }
            asm volatile("s_waitcnt lgkmcnt(0)" ::: "memory");
#pragma unroll
            for (int i = 0; i < 16; ++i) xs[i * 64 + j] = xc[i];
            asm volatile("s_waitcnt lgkmcnt(0)" ::: "memory");
#pragma unroll
            for (int ii = 0; ii < 16; ++ii) {
                const int i = dir == 0 ? ii : 15 - ii;
                float ra = bav, xa = bxv;
#pragma unroll
                for (int k = 0; k < 64; ++k) { const float xv = xs[i * 64 + k]; ra += xv * wac[k]; xa += xv * wxc[k]; }
                const float r = sigmoidf_(ra), ig = sigmoidf_(xa);
                const float log_a = coef * r, a = __expf(log_a), mult = sqrtf(fmaxf(-expm1f(2.0f * log_a), 0.f));
                hst = a * hst + mult * ig * xc[i];
                if (lat) {
                    const int p = plo + i;
                    const int tt = (p % GROWS) * GRIDW + (p / GROWS);
                    HD[((size_t)b * T + tt) * RGW + c] = f2bf(hst);
                }
            }
        }
    }
}

constexpr int RG_XC = 0, RG_RGT = 66560, RG_CAR = 133120, RG_STRIDE = 1040, NCHK = (CTXL + T) / 64;
__device__ __forceinline__ int rg_off(int row, int chbyte) { return row * RG_STRIDE + ((((chbyte >> 4) ^ (((row >> 4) & 3) << 2)) << 4) | (chbyte & 15)); }
template <int PASS>
__device__ __forceinline__ void rg_item(LAS unsigned char* lds, const bf16_t* __restrict__ P, const float* __restrict__ conv_w, const float* __restrict__ conv_b, const bf16_t* __restrict__ WG_t,
                                        const float* __restrict__ ba, const float* __restrict__ bx, const float* __restrict__ coef, float* __restrict__ AGG, bf16_t* __restrict__ MIX, int b, int n) {
    const int tid = threadIdx.x, w = __builtin_amdgcn_readfirstlane(tid >> 6), lane = tid & 63, l15 = lane & 15, G4 = lane >> 4;
    const bool lat = n >= CTXL / 64; const int L = lat ? T : CTXL, p0 = 64 * (lat ? n - CTXL / 64 : n);
    __syncthreads();
#pragma unroll 1
    for (int it = 0; it < 2; ++it) {
        const int idx = tid + 512 * it, cg4 = idx & 127, pg = idx >> 7;
        float xin[11][4];
#pragma unroll
        for (int i = 0; i < 11; ++i) {
            const int p = p0 + 8 * pg - 2 + i;
            if (p >= 0 && p < L) { const uint2 v = *(const uint2*)(P + rg_row(b, lat, p) * INW + C_RX + cg4 * 4);
                xin[i][0] = __uint_as_float(v.x << 16); xin[i][1] = __uint_as_float(v.x & 0xffff0000u); xin[i][2] = __uint_as_float(v.y << 16); xin[i][3] = __uint_as_float(v.y & 0xffff0000u); }
            else { xin[i][0] = 0.f; xin[i][1] = 0.f; xin[i][2] = 0.f; xin[i][3] = 0.f; }
        }
        const f32x4 w0 = *(const f32x4*)(conv_w + 0 * RGW + cg4 * 4), w1 = *(const f32x4*)(conv_w + 1 * RGW + cg4 * 4), w2 = *(const f32x4*)(conv_w + 2 * RGW + cg4 * 4), w3 = *(const f32x4*)(conv_w + 3 * RGW + cg4 * 4);
        const f32x4 cb4 = *(const f32x4*)(conv_b + cg4 * 4);
#pragma unroll
        for (int q = 0; q < 8; ++q) {
            float o[4];
#pragma unroll
            for (int c = 0; c < 4; ++c) o[c] = cb4[c] + w0[c] * xin[q][c] + w1[c] * xin[q + 1][c] + w2[c] * xin[q + 2][c] + w3[c] * xin[q + 3][c];
            uint2 pk; pk.x = cvt_pk_bf16(o[0], o[1]); pk.y = cvt_pk_bf16(o[2], o[3]);
            *(LAS unsigned long long*)(lds + RG_XC + rg_off(8 * pg + q, cg4 * 8)) = ((unsigned long long)pk.y << 32) | pk.x;
        }
    }
    if (PASS == 2) {
        asm volatile("" ::: "memory");
#pragma unroll 2
        for (int it = 0; it < 8; ++it) { const int idx = tid + 512 * it, row = idx >> 6, ck = idx & 63;
            *(LAS u32x4*)(lds + RG_RGT + rg_off(row, ck * 16)) = *(const u32x4*)(P + rg_row(b, lat, p0 + row) * INW + C_RG + ck * 8); }
        const float2* ag = (const float2*)AGG + (size_t)b * NCHK * 2 * RGW + tid;
        float hf = 0.f, hb = 0.f;
        for (int m = 0; m < n; ++m) { const float2 e = ag[(size_t)(m * 2 + 0) * RGW]; hf = e.x * hf + e.y; }
        for (int m = CTXL / 64 - 1; m >= 0; --m) { const float2 e = ag[(size_t)(m * 2 + 1) * RGW]; hb = e.x * hb + e.y; }
        for (int m = NCHK - 1; m > n; --m) { const float2 e = ag[(size_t)(m * 2 + 1) * RGW]; hb = e.x * hb + e.y; }
        LAS float* CAR = (LAS float*)(lds + RG_CAR); CAR[tid] = hf; CAR[RGW + tid] = hb;
    }
    __syncthreads();
    {
        const int hd = w;
        bf16x8 af[4][2];
#pragma unroll
        for (int mt = 0; mt < 4; ++mt)
#pragma unroll
            for (int s = 0; s < 2; ++s) af[mt][s] = *(const LAS bf16x8*)(lds + RG_XC + rg_off(16 * (l15 >> 2) + 4 * mt + (l15 & 3), (64 * hd + 32 * s + 8 * G4) * 2));
#pragma unroll 1
        for (int cg = 0; cg < 4; ++cg) {
            const int ch = 64 * hd + 16 * cg + l15;
            float hsum[16];
#pragma unroll
            for (int d = 0; d < 2; ++d) {
                f32x4 ra[4], xa[4];
#pragma unroll
                for (int mt = 0; mt < 4; ++mt) { ra[mt] = (f32x4){0.f, 0.f, 0.f, 0.f}; xa[mt] = (f32x4){0.f, 0.f, 0.f, 0.f}; }
                bf16x8 bwa[2], bwx[2];
#pragma unroll
                for (int s = 0; s < 2; ++s) {
                    bwa[s] = *(const bf16x8*)(WG_t + ((size_t)(hd * 256 + 64 * (2 * d) + 16 * cg + l15) * 64 + 32 * s + 8 * G4));
                    bwx[s] = *(const bf16x8*)(WG_t + ((size_t)(hd * 256 + 64 * (2 * d + 1) + 16 * cg + l15) * 64 + 32 * s + 8 * G4));
                }
#pragma unroll
                for (int mt = 0; mt < 4; ++mt)
#pragma unroll
                    for (int s = 0; s < 2; ++s) { ra[mt] = __builtin_amdgcn_mfma_f32_16x16x32_bf16(af[mt][s], bwa[s], ra[mt], 0, 0, 0); xa[mt] = __builtin_amdgcn_mfma_f32_16x16x32_bf16(af[mt][s], bwx[s], xa[mt], 0, 0, 0); }
                const float bav = ba[d * RGW + ch], bxv = bx[d * RGW + ch], cf = coef[d * RGW + ch];
                float av[16], bv[16];
#pragma unroll
                for (int t = 0; t < 16; ++t) {
                    const float r = sigmoidf_(ra[t >> 2][t & 3] + bav), ig = sigmoidf_(xa[t >> 2][t & 3] + bxv);
                    const float a = __expf(cf * r);
                    av[t] = a; bv[t] = sqrtf(fmaxf(1.0f - a * a, 0.f)) * ig * bf2f(*(const LAS bf16_t*)(lds + RG_XC + rg_off(16 * G4 + t, ch * 2)));
                }
                float Al = 1.f, Bl = 0.f;
                if (d == 0) {
#pragma unroll
                    for (int t = 0; t < 16; ++t) { Bl = av[t] * Bl + bv[t]; Al *= av[t]; }
                } else {
#pragma unroll
                    for (int t = 15; t >= 0; --t) { Bl = av[t] * Bl + bv[t]; Al *= av[t]; }
                }
                float Ag[4], Bg[4];
#pragma unroll
                for (int g = 0; g < 4; ++g) { Ag[g] = __shfl(Al, l15 + 16 * g); Bg[g] = __shfl(Bl, l15 + 16 * g); }
                if (PASS == 1) {
                    float A = 1.f, B = 0.f;
                    if (d == 0) {
#pragma unroll
                        for (int g = 0; g < 4; ++g) { B = Ag[g] * B + Bg[g]; A *= Ag[g]; }
                    } else {
#pragma unroll
                        for (int g = 3; g >= 0; --g) { B = Ag[g] * B + Bg[g]; A *= Ag[g]; }
                    }
                    if (G4 == 0) ((float2*)AGG)[((size_t)(b * NCHK + n) * 2 + d) * RGW + ch] = make_float2(A, B);
                } else {
                    const LAS float* CAR = (const LAS float*)(lds + RG_CAR);
                    float h = CAR[d * RGW + ch];
                    if (d == 0) {
                        const float s1 = Ag[0] * h + Bg[0], s2 = Ag[1] * s1 + Bg[1], s3 = Ag[2] * s2 + Bg[2];
                        h = G4 == 0 ? h : G4 == 1 ? s1 : G4 == 2 ? s2 : s3;
#pragma unroll
                        for (int t = 0; t < 16; ++t) { h = av[t] * h + bv[t]; hsum[t] = h; }
                    } else {
                        const float s2 = Ag[3] * h + Bg[3], s1 = Ag[2] * s2 + Bg[2], s0 = Ag[1] * s1 + Bg[1];
                        h = G4 == 3 ? h : G4 == 2 ? s2 : G4 == 1 ? s1 : s0;
#pragma unroll
                        for (int t = 15; t >= 0; --t) { h = av[t] * h + bv[t]; hsum[t] += h; }
                    }
                }
            }
            if (PASS == 2) {
#pragma unroll
                for (int t = 0; t < 16; ++t) { LAS bf16_t* q = (LAS bf16_t*)(lds + RG_RGT + rg_off(16 * G4 + t, ch * 2)); *q = f2bf(gelu_tanh(bf2f(*q)) * hsum[t]); }
            }
        }
    }
    if (PASS == 2) {
        __syncthreads();
#pragma unroll
        for (int it = 0; it < 8; ++it) { const int idx = tid + 512 * it, row = idx >> 6, ck = idx & 63;
            *(u32x4*)(MIX + rg_row(b, true, p0 + row) * D + HGW + ck * 8) = *(const LAS u32x4*)(lds + RG_RGT + rg_off(row, ck * 16)); }
    }
}

__device__ __forceinline__ void phase_mix_finish(const bf16_t* __restrict__ P, const bf16_t* __restrict__ OF, const bf16_t* __restrict__ OB,
                                                 const float* __restrict__ hg_nw, bf16_t* __restrict__ MIX, int bid, int G) {
    const int lane = threadIdx.x & 63, gw = bid * 8 + (threadIdx.x >> 6), NW = G * 8, c0 = lane * 8;
    for (int r = gw; r < NLAT; r += NW) {
        const uint4 a4 = *(const uint4*)(OF + (size_t)r * HGW + c0), b4 = *(const uint4*)(OB + (size_t)r * HGW + c0);
        const u32 aw[4] = {a4.x, a4.y, a4.z, a4.w}, bw[4] = {b4.x, b4.y, b4.z, b4.w};
        float o[8]; float ss = 0.f;
#pragma unroll
        for (int i = 0; i < 4; ++i) { o[2 * i] = __uint_as_float(aw[i] << 16) + __uint_as_float(bw[i] << 16); o[2 * i + 1] = __uint_as_float(aw[i] & 0xffff0000u) + __uint_as_float(bw[i] & 0xffff0000u); }
#pragma unroll
        for (int i = 0; i < 8; ++i) ss += o[i] * o[i];
        ss += __shfl_xor(ss, 1); ss += __shfl_xor(ss, 2); ss += __shfl_xor(ss, 4); ss += __shfl_xor(ss, 8);
        const float rstd = rsqrtf(ss * (1.0f / 128.0f) + EPS);
        const bf16_t* pr = P + (size_t)r * INW;
        const uint4 g4 = *(const uint4*)(pr + C_G + c0);
        const u32 gw4[4] = {g4.x, g4.y, g4.z, g4.w};
        const f32x4 nw0 = *(const f32x4*)(hg_nw + c0), nw1 = *(const f32x4*)(hg_nw + c0 + 4);
        const float nwv[8] = {nw0[0], nw0[1], nw0[2], nw0[3], nw1[0], nw1[1], nw1[2], nw1[3]};
        u32 w[4];
#pragma unroll
        for (int i = 0; i < 4; ++i) {
            const float g0 = __uint_as_float(gw4[i] << 16), g1 = __uint_as_float(gw4[i] & 0xffff0000u);
            w[i] = cvt_pk_bf16(o[2 * i] * rstd * nwv[2 * i] * (g0 * sigmoidf_(g0)), o[2 * i + 1] * rstd * nwv[2 * i + 1] * (g1 * sigmoidf_(g1)));
        }
        *(uint4*)(MIX + (size_t)r * D + c0) = make_uint4(w[0], w[1], w[2], w[3]);
    }
}

__device__ __forceinline__ void phase_norm2_route(LAS unsigned char* lds, const float* __restrict__ x1, const float* __restrict__ nw, const float* __restrict__ mod,
                                                  const float* __restrict__ rw, const float* __restrict__ rb, bf16_t* __restrict__ H2,
                                                  u32* __restrict__ cnt, u32* __restrict__ toktab, float* __restrict__ wtab, int bid, int G) {
    LAS float* rwT = (LAS float*)lds;
    LAS u32* hist = (LAS u32*)(lds + 131072);
    LAS u32* ent = (LAS u32*)(lds + 131072 + 4096);
    const int tid = threadIdx.x, lane = tid & 63, w = tid >> 6;
    for (int i = tid; i < 32 * 1024; i += 512) { const int k = i >> 5, e = i & 31; rwT[e * 1024 + k] = rw[i]; }
    if (tid < 128) hist[tid] = 0;
    __syncthreads();
    const int gw = bid * 8 + w, NW = G * 8;
    int it = 0;
    for (int r = gw; r < NLAT; r += NW, ++it) {
        const float* m = mod + (size_t)(r >> 11) * 6144;
        f32x4 v[4]; float ss = 0.f;
#pragma unroll
        for (int j = 0; j < 4; ++j) { v[j] = *(const f32x4*)(x1 + (size_t)r * D + j * 256 + lane * 4); ss += v[j][0] * v[j][0] + v[j][1] * v[j][1] + v[j][2] * v[j][2] + v[j][3] * v[j][3]; }
        const float rstd = rsqrtf(wave_sum(ss) * (1.0f / D) + EPS);
#pragma unroll
        for (int j = 0; j < 4; ++j) {
            const int c0 = j * 256 + lane * 4;
            const f32x4 ww = *(const f32x4*)(nw + c0), sh = *(const f32x4*)(m + 3072 + c0), sc = *(const f32x4*)(m + 4096 + c0);
            v[j] = v[j] * rstd * ww * (sc + 1.0f) + sh;
            uint2 p; p.x = cvt_pk_bf16(v[j][0], v[j][1]); p.y = cvt_pk_bf16(v[j][2], v[j][3]);
            *(uint2*)(H2 + (size_t)r * D + c0) = p;
        }
        float mylogit = 0.f;
        for (int e = 0; e < 32; ++e) {
            float p = 0.f;
#pragma unroll
            for (int j = 0; j < 4; ++j) { const f32x4 q = *(const LAS f32x4*)(rwT + e * 1024 + j * 256 + lane * 4); p += v[j][0] * q[0] + v[j][1] * q[1] + v[j][2] * q[2] + v[j][3] * q[3]; }
            p = wave_sum(p);
            if ((lane & 31) == e) mylogit = p + rb[e];
        }
        float tv[4]; int ti[4]; float cur = mylogit;
#pragma unroll
        for (int k = 0; k < 4; ++k) {
            float bv = cur; int bi = lane & 31;
#pragma unroll
            for (int o = 1; o < 32; o <<= 1) { const float ov = __shfl_xor(bv, o); const int oi = __shfl_xor(bi, o); if (ov > bv || (ov == bv && oi < bi)) { bv = ov; bi = oi; } }
            tv[k] = bv; ti[k] = bi; if ((lane & 31) == bi) cur = -3.0e38f;
        }
        const float e1 = __expf(tv[1] - tv[0]), e2 = __expf(tv[2] - tv[0]), e3 = __expf(tv[3] - tv[0]); const float inv = 1.0f / (1.0f + e1 + e2 + e3);
        const float g0 = inv, g1 = e1 * inv, g2 = e2 * inv, g3 = e3 * inv;
        if (lane < 4) {
            const int half = r >= HALF_TOK ? 1 : 0;
            const int e = lane == 0 ? ti[0] : lane == 1 ? ti[1] : lane == 2 ? ti[2] : ti[3];
            const float gv = lane == 0 ? g0 : lane == 1 ? g1 : lane == 2 ? g2 : g3;
            const u32 lp = atomicAdd((u32*)&hist[half * 32 + e], 1u);
            const int idx = (it * 8 + w) * 4 + lane;
            ent[idx * 2] = ((u32)e << 24) | lp; ent[idx * 2 + 1] = __float_as_uint(gv);
        }
    }
    __syncthreads();
    if (tid < 64) hist[64 + tid] = atomicAdd(&cnt[tid], hist[tid]);
    __syncthreads();
    it = 0;
    for (int r = gw; r < NLAT; r += NW, ++it) {
        if (lane < 4) {
            const int half = r >= HALF_TOK ? 1 : 0; const int idx = (it * 8 + w) * 4 + lane;
            const u32 ev = ent[idx * 2]; const int e = ev >> 24; const u32 pos = hist[64 + half * 32 + e] + (ev & 0xffffffu);
            toktab[((size_t)half * 32 + e) * CAP + pos] = (u32)r * 4u + lane;
            wtab[((size_t)half * 32 + e) * CAP + pos] = __uint_as_float(ent[idx * 2 + 1]);
        }
    }
}

__device__ __forceinline__ void phase_combine(float* __restrict__ out, const bf16_t* __restrict__ Y, const float* __restrict__ mod, const float* __restrict__ fw, int half, int bid, int G) {
    const int lane = threadIdx.x & 63, gw = bid * 8 + (threadIdx.x >> 6), NW = G * 8;
    for (int rl = gw; rl < HALF_TOK; rl += NW) {
        const int r = half * HALF_TOK + rl;
        const float* g2 = mod + (size_t)(r >> 11) * 6144 + 5120;
        f32x4 v[4]; float ss = 0.f;
#pragma unroll
        for (int j = 0; j < 4; ++j) {
            const int c0 = j * 256 + lane * 4;
            v[j] = *(const f32x4*)(out + (size_t)r * D + c0);
            float s0 = 0.f, s1 = 0.f, s2 = 0.f, s3 = 0.f;
#pragma unroll
            for (int k = 0; k < 4; ++k) { const uint2 y = *(const uint2*)(Y + ((size_t)rl * 4 + k) * D + c0);
                s0 += __uint_as_float(y.x << 16); s1 += __uint_as_float(y.x & 0xffff0000u); s2 += __uint_as_float(y.y << 16); s3 += __uint_as_float(y.y & 0xffff0000u); }
            const f32x4 g = *(const f32x4*)(g2 + c0);
            v[j][0] += g[0] * s0; v[j][1] += g[1] * s1; v[j][2] += g[2] * s2; v[j][3] += g[3] * s3;
            ss += v[j][0] * v[j][0] + v[j][1] * v[j][1] + v[j][2] * v[j][2] + v[j][3] * v[j][3];
        }
        const float rstd = rsqrtf(wave_sum(ss) * (1.0f / D) + EPS);
#pragma unroll
        for (int j = 0; j < 4; ++j) { const int c0 = j * 256 + lane * 4; const f32x4 w = *(const f32x4*)(fw + c0); *(f32x4*)(out + (size_t)r * D + c0) = v[j] * rstd * w; }
    }
}

struct MegaArgs {
    const float *x, *c, *ctx, *c_ctx, *norm1_w, *norm2_w, *w_ada, *b_ada, *w_in, *lbl, *hg_nw, *conv_w, *conv_b, *rg_wa, *rg_ba, *rg_wx, *rg_bx, *rg_lam, *w_out,
        *router_w, *router_b, *wgu, *bgu, *wd, *bd, *final_w;
    float* out; unsigned char* ws;
};
typedef const MegaArgs __attribute__((address_space(4)))* KArgs;
__device__ __forceinline__ KArgs kargs() { auto p = __builtin_amdgcn_kernarg_segment_ptr(); asm volatile("" : "+s"(p)); return (KArgs)p; }
#define WSP(T, off) ((T*)(ws + (off)))
#define GRID_SYNC() cg::this_grid().sync()
__global__ __launch_bounds__(512, 2) void k_mega(MegaArgs a_unused) {
    extern __shared__ __attribute__((aligned(16))) unsigned char lds_[];
    LAS unsigned char* lds = (LAS unsigned char*)lds_;
    { KArgs a = kargs(); unsigned char* ws = a->ws; const int bid = blockIdx.x, G = gridDim.x;
      ProArgs pa; pa.c = a->c; pa.c_ctx = a->c_ctx; pa.w_ada = a->w_ada; pa.b_ada = a->b_ada; pa.lbl = a->lbl; pa.w_in = a->w_in; pa.w_out = a->w_out; pa.wgu = a->wgu; pa.wd = a->wd; pa.rg_wa = a->rg_wa; pa.rg_wx = a->rg_wx; pa.rg_lam = a->rg_lam;
      pa.coef = WSP(float, WS_COEF); pa.WG_t = WSP(bf16_t, WS_WG); pa.mod = WSP(float, WS_MOD); pa.lb = WSP(float, WS_LB); pa.Win_t = WSP(bf16_t, WS_WIN); pa.Wout_t = WSP(bf16_t, WS_WOUT); pa.Wgu_t = WSP(bf16_t, WS_WGU); pa.Wd_t = WSP(bf16_t, WS_WD);
      phase_prologue(lds, pa, bid, G, true, 0, IT_IN + IT_OUT); }
    GRID_SYNC();
    { KArgs a = kargs(); unsigned char* ws = a->ws; phase_norm1(a->x, a->ctx, a->norm1_w, WSP(float, WS_MOD), WSP(bf16_t, WS_H), blockIdx.x, gridDim.x); }
    GRID_SYNC();
    { KArgs a = kargs(); unsigned char* ws = a->ws; PolInProj P; P.A = WSP(bf16_t, WS_H); P.Bt = WSP(bf16_t, WS_WIN); P.O = WSP(bf16_t, WS_PROJ); P.ord.init(NROWS / BM, INW / BM, gridDim.x, blockIdx.x); gemm_phase(lds, P); }
    GRID_SYNC();
    { KArgs a = kargs(); unsigned char* ws = a->ws;
      for (int it = blockIdx.x; it < NB * NCHK; it += gridDim.x)
          rg_item<1>(lds, WSP(bf16_t, WS_PROJ), a->conv_w, a->conv_b, WSP(bf16_t, WS_WG), a->rg_ba, a->rg_bx, WSP(float, WS_COEF), WSP(float, WS_AGG), nullptr, it / NCHK, it % NCHK); }
    __syncthreads();
    { KArgs a = kargs(); unsigned char* ws = a->ws;
      for (int item = blockIdx.x; item < 256; item += gridDim.x) phase_hgrn2_chunk(lds, WSP(bf16_t, WS_PROJ), WSP(float, WS_LB), WSP(bf16_t, WS_OF), WSP(bf16_t, WS_OB), item); }
    GRID_SYNC();
    { KArgs a = kargs(); unsigned char* ws = a->ws;
      for (int it = blockIdx.x; it < NB * (T / 64); it += gridDim.x)
          rg_item<2>(lds, WSP(bf16_t, WS_PROJ), a->conv_w, a->conv_b, WSP(bf16_t, WS_WG), a->rg_ba, a->rg_bx, WSP(float, WS_COEF), WSP(float, WS_AGG), WSP(bf16_t, WS_MIX2), it / (T / 64), CTXL / 64 + it % (T / 64)); }
    { KArgs a = kargs(); unsigned char* ws = a->ws; phase_mix_finish(WSP(bf16_t, WS_PROJ), WSP(bf16_t, WS_OF), WSP(bf16_t, WS_OB), a->hg_nw, WSP(bf16_t, WS_MIX2), blockIdx.x, gridDim.x); }
    GRID_SYNC();
    { KArgs a = kargs(); unsigned char* ws = a->ws; PolOutProj P; P.A = WSP(bf16_t, WS_MIX2); P.Bt = WSP(bf16_t, WS_WOUT); P.x = a->x; P.mod = WSP(float, WS_MOD); P.O = a->out; P.ord.init(NLAT / BM, D / BM, gridDim.x, blockIdx.x); gemm_phase(lds, P); }
    GRID_SYNC();
    { KArgs a = kargs(); unsigned char* ws = a->ws;
      phase_norm2_route(lds, a->out, a->norm2_w, WSP(float, WS_MOD), a->router_w, a->router_b, WSP(bf16_t, WS_H2), WSP(u32, WS_CTL), WSP(u32, WS_TOKTAB), WSP(float, WS_WTAB), blockIdx.x, gridDim.x); }
    __syncthreads();
    { KArgs a = kargs(); unsigned char* ws = a->ws;
      ProArgs pa; pa.c = nullptr; pa.c_ctx = nullptr; pa.w_ada = nullptr; pa.b_ada = nullptr; pa.lbl = nullptr; pa.w_in = nullptr; pa.w_out = nullptr; pa.wgu = a->wgu; pa.wd = a->wd; pa.rg_wa = nullptr; pa.rg_wx = nullptr; pa.rg_lam = nullptr; pa.coef = nullptr; pa.WG_t = nullptr;
      pa.mod = nullptr; pa.lb = nullptr; pa.Win_t = nullptr; pa.Wout_t = nullptr; pa.Wgu_t = WSP(bf16_t, WS_WGU); pa.Wd_t = WSP(bf16_t, WS_WD);
      phase_prologue(lds, pa, blockIdx.x, gridDim.x, false, IT_IN + IT_OUT, IT_ALL); }
    GRID_SYNC();
#pragma unroll 1
    for (int half = 0; half < 2; ++half) {
        { KArgs a = kargs(); unsigned char* ws = a->ws; LAS int* tstart = (LAS int*)(lds + LDS_AUX);
          const int tot = moe_tile_table(tstart, WSP(u32, WS_CTL), half);
          PolGateUp P; P.A = WSP(bf16_t, WS_H2); P.Bt = WSP(bf16_t, WS_WGU); P.bgu = a->bgu; P.toktab = WSP(u32, WS_TOKTAB); P.O = WSP(bf16_t, WS_ACT); P.mt.tstart = tstart; P.mt.cnt = WSP(u32, WS_CTL); P.mt.half = half;
          P.ord.init(tot, DFF / HALFT, gridDim.x, blockIdx.x);
          gemm_phase(lds, P); }
        GRID_SYNC();
        { KArgs a = kargs(); unsigned char* ws = a->ws; LAS int* tstart = (LAS int*)(lds + LDS_AUX);
          const int tot = moe_tile_table(tstart, WSP(u32, WS_CTL), half);
          PolDown P; P.A = WSP(bf16_t, WS_ACT); P.Bt = WSP(bf16_t, WS_WD); P.bd = a->bd; P.toktab = WSP(u32, WS_TOKTAB); P.wtab = WSP(float, WS_WTAB); P.O = WSP(bf16_t, WS_Y); P.mt.tstart = tstart; P.mt.cnt = WSP(u32, WS_CTL); P.mt.half = half;
          P.ord.init(tot, D / BM, gridDim.x, blockIdx.x);
          gemm_phase(lds, P); }
        GRID_SYNC();
        { KArgs a = kargs(); unsigned char* ws = a->ws; phase_combine(a->out, WSP(bf16_t, WS_Y), WSP(float, WS_MOD), a->final_w, half, blockIdx.x, gridDim.x); }
        __syncthreads();
    }
}

extern "C" void kernel_launch(void* const* d_in, const int* in_sizes, int n_in, void* d_out, int out_size, void* d_ws, size_t ws_size, hipStream_t stream) {
    static int grid_blocks = 0;
    if (!grid_blocks) {
        int dev = 0, cus = 0, per_cu = 0;
        (void)hipGetDevice(&dev);
        (void)hipDeviceGetAttribute(&cus, hipDeviceAttributeMultiprocessorCount, dev);
        (void)hipFuncSetAttribute((const void*)k_mega, hipFuncAttributeMaxDynamicSharedMemorySize, LDS_BYTES);
        (void)hipOccupancyMaxActiveBlocksPerMultiprocessor(&per_cu, (const void*)k_mega, 512, LDS_BYTES);
        if (per_cu < 1) { fprintf(stderr, "kernel_launch: occupancy query says %d blocks/CU\n", per_cu); per_cu = 1; }
        grid_blocks = cus * 1;
    }
    if (ws_size < 1024 * MiB) { fprintf(stderr, "kernel_launch: workspace too small (%zu)\n", ws_size); return; }
    MegaArgs a{};
    const float** ap = (const float**)&a;
    for (int i = 0; i < 26; ++i) ap[i] = (const float*)d_in[i];
    a.out = (float*)d_out; a.ws = (unsigned char*)d_ws;
    (void)hipMemsetAsync((unsigned char*)d_ws + WS_CTL, 0, 4096, stream);
    void* args[] = {&a};
    hipError_t e = hipLaunchCooperativeKernel((const void*)k_mega, dim3(grid_blocks), dim3(512), args, LDS_BYTES, stream);
    if (e != hipSuccess) fprintf(stderr, "cooperative launch failed: %s (grid %d)\n", hipGetErrorString(e), grid_blocks);
}
```

```cpp
#include <hip/hip_runtime.h>
#include <hip/hip_cooperative_groups.h>
#include <cstdio>
#include <cstdint>

typedef unsigned short bf16_t;
typedef unsigned int u32;
namespace cg = cooperative_groups;

constexpr int D = 1024, NB = 32, T = 2048, CTXL = 256, GRIDW = 64, GROWS = T / GRIDW;
constexpr int NLAT = NB * T;
constexpr int NCTX = NB * CTXL;
constexpr int NROWS = NLAT + NCTX;
constexpr int HGW = 512, RGW = 512, INW = 3584;
constexpr int C_Q = 0, C_I = 512, C_FF = 1024, C_FB = 1536, C_G = 2048, C_RX = 2560, C_RG = 3072;
constexpr int NE = 32, TOPK = 4, DFF = 1024;
constexpr int NHALF = 1;
constexpr int HALF_TOK = NLAT / NHALF;
constexpr int CAP = HALF_TOK;
constexpr int MAXSLOT = HALF_TOK * TOPK + NE * 256;
constexpr float EPS = 1e-6f;

constexpr size_t MiB = 1u << 20;
constexpr size_t WS_CTL = 0;
constexpr size_t WS_MOD = 1 * MiB;
constexpr size_t WS_LB = WS_MOD + 33 * 6144 * 4;
constexpr size_t WS_TOKTAB = 2 * MiB;
constexpr size_t WS_WTAB = 10 * MiB;
constexpr size_t WS_SCR = 28 * MiB;
constexpr size_t WS_OF = 28 * MiB, WS_OB = 92 * MiB, WS_HF = 156 * MiB, WS_HB = 220 * MiB;
constexpr size_t WS_WIN = 18 * MiB, WS_WOUT = 25 * MiB;
constexpr size_t WS_WG = 64 * 1024;
constexpr size_t WS_COEF = WS_LB + 4096;
constexpr size_t WS_AGG = 932 * MiB;
constexpr size_t WS_WGU = 92 * MiB, WS_WD = 156 * MiB;
constexpr size_t WS_H = 284 * MiB;
constexpr size_t WS_PROJ = 428 * MiB;
constexpr size_t WS_ACT = 188 * MiB;
constexpr size_t WS_Y = 452 * MiB;

constexpr size_t WS_MIX2 = WS_H;
constexpr size_t WS_H2 = 28 * MiB;

__device__ __forceinline__ float bf2f(bf16_t b) { return __uint_as_float(((u32)b) << 16); }
__device__ __forceinline__ bf16_t f2bf(float f) { u32 u = __float_as_uint(f); u += 0x7fffu + ((u >> 16) & 1u); return (bf16_t)(u >> 16); }
__device__ __forceinline__ u32 pk2(float lo, float hi) { return (u32)f2bf(lo) | ((u32)f2bf(hi) << 16); }
__device__ __forceinline__ float fexp(float x) { return __builtin_amdgcn_exp2f(x * 1.4426950408889634f); }
__device__ __forceinline__ float frcp(float x) { return __builtin_amdgcn_rcpf(x); }
__device__ __forceinline__ float flog(float x) { return __builtin_amdgcn_logf(x) * 0.6931471805599453f; }
__device__ __forceinline__ float fsqrt(float x) { return __builtin_amdgcn_sqrtf(x); }
__device__ __forceinline__ float sigmoidf_(float x) { return frcp(1.0f + fexp(-x)); }
__device__ __forceinline__ float wave_sum(float v) {
#pragma unroll
    for (int o = 1; o < 64; o <<= 1) v += __shfl_xor(v, o);
    return v;
}

__device__ __forceinline__ float gelu_tanh(float x) { const float u = 1.5957691216057308f * (x + 0.044715f * x * x * x); return x * sigmoidf_(u); }
#define LAS __attribute__((address_space(3)))
typedef short bf16x8 __attribute__((ext_vector_type(8)));
typedef float f32x4 __attribute__((ext_vector_type(4)));
typedef unsigned u32x4 __attribute__((ext_vector_type(4)));
typedef int v8i __attribute__((ext_vector_type(8)));
typedef int v4i_ __attribute__((ext_vector_type(4)));
typedef unsigned char fp8_t;
constexpr float SC_H2 = 16.0f, SC_W = 32.0f, SC_ACT = 4.0f;
__device__ __forceinline__ unsigned pk4_fp8(float a, float b, float c, float d) {
    a = fminf(fmaxf(a, -448.f), 448.f); b = fminf(fmaxf(b, -448.f), 448.f); c = fminf(fmaxf(c, -448.f), 448.f); d = fminf(fmaxf(d, -448.f), 448.f);
    int r = 0; r = __builtin_amdgcn_cvt_pk_fp8_f32(a, b, r, false); r = __builtin_amdgcn_cvt_pk_fp8_f32(c, d, r, true); return (unsigned)r; }
constexpr int BM = 256, BK = 64, HALFT = 128, HTB = HALFT * BK * 2, STAGE_BYTES = 8 * HTB, NXCD = 8, WGM = 8;
constexpr int GK = 1024;
constexpr int LDS_BYTES = 147456;
constexpr int LDS_AUX = STAGE_BYTES;

__device__ __forceinline__ int lds_byte(int r, int c) { const int st = (r >> 4) * 2 + (c >> 5), rr = r & 15, cc = c & 31, ob = rr * 64 + cc * 2; return st * 1024 + (ob ^ (((ob >> 9) & 1) << 5)); }
__device__ __forceinline__ void stage_rc(int b, int& R, int& C) { const int st = b / 1024, sb = b % 1024, swz = sb ^ (((sb >> 9) & 1) << 5); R = (st >> 1) * 16 + swz / 64; C = (st & 1) * 32 + (swz % 64) / 2; }
__device__ __forceinline__ int perm32(int rho) { const int n = rho >> 4, i = rho & 15; return 8 * (i >> 2) + 4 * n + (i & 3); }
__device__ __forceinline__ unsigned cvt_pk_bf16(float lo, float hi) { unsigned r; asm volatile("v_cvt_pk_bf16_f32 %0, %1, %2" : "=v"(r) : "v"(lo), "v"(hi)); return r; }

struct Unit { int pm, pn, e, pos0, cn; };
struct TileOrder {
    int nM, nN, nwg, G, c;
    __device__ __forceinline__ void init(int nM_, int nN_, int G_, int c_) { nM = nM_; nN = nN_; nwg = nM * nN; G = G_; c = c_; }
    __device__ __forceinline__ bool tile(int i, int& pm, int& pn) const {
        const long L = (long)i * G + c; if (L >= nwg) return false;
        int wgid = (int)L; { const int q = nwg / NXCD, r = nwg % NXCD, xcd = wgid % NXCD, off = wgid / NXCD; wgid = (xcd < r ? xcd * (q + 1) : r * (q + 1) + (xcd - r) * q) + off; }
        const int nig = WGM * nN, gid = wgid / nig, fm = gid * WGM, gsz = (nM - fm) < WGM ? (nM - fm) : WGM;
        pm = fm + ((wgid % nig) % gsz); pn = (wgid % nig) / gsz; return true;
    }
};

template <class POL>
__device__ __forceinline__ void gemm_phase(LAS unsigned char* lds, const POL& P) {
    int tid_ = threadIdx.x; asm volatile("" : "+v"(tid_));
    const int tid = tid_, wid = __builtin_amdgcn_readfirstlane(tid >> 6), lane = tid & 63, wr = wid >> 2, wc = wid & 3, fr = lane & 15, fq = lane >> 4;
    constexpr int KB = POL::FP8 ? 1024 : 2048, nt = KB / 128;
    int sR[2], sC[2]; unsigned voffA[2], voffB[2];
#pragma unroll
    for (int i = 0; i < 2; ++i) { stage_rc(tid * 16 + i * 8192, sR[i], sC[i]); const int Rb = POL::PERM ? ((sR[i] & ~31) + perm32(sR[i] & 31)) : sR[i]; voffA[i] = (unsigned)(sR[i] * KB + sC[i] * 2); voffB[i] = (unsigned)(Rb * KB + sC[i] * 2); }
    constexpr size_t kstep = (size_t)(BK * 2);
    constexpr unsigned hstepB = (unsigned)HALFT * KB;
    const unsigned ldsw = (unsigned)wid * 1024u;
    const int aoff = POL::FP8 ? lds_byte(wr * 64 + fr, fq * 16) : lds_byte(wr * 64 + fr, fq * 8), boff = POL::FP8 ? lds_byte(wc * 32 + fr, fq * 16) : lds_byte(wc * 32 + fr, fq * 8);
#define G_SA(b, h) (((b) * 2 + (h)) * HTB)
#define G_SB(b, h) ((4 + (b) * 2 + (h)) * HTB)
#define G_AOFF(OFF, h, i) (POL::GATHER ? (OFF)[h][i] : voffA[i])
#define G_STAGE_A(bufoff, gbase, OFF, h) do { const char* _gb = (const char*)(gbase) + (POL::GATHER ? (size_t)0 : (size_t)(h) * hstepB); _Pragma("unroll") for (int _i = 0; _i < 2; ++_i) \
        __builtin_amdgcn_global_load_lds((const unsigned*)(_gb + G_AOFF(OFF, h, _i)), (LAS unsigned*)(lds + (bufoff) + ldsw + _i * 8192), 16, 0, 0); } while (0)
#define G_STAGE_B(bufoff, gbase, hoff) do { const char* _gb = (const char*)(gbase) + (size_t)(hoff); _Pragma("unroll") for (int _i = 0; _i < 2; ++_i) \
        __builtin_amdgcn_global_load_lds((const unsigned*)(_gb + voffB[_i]), (LAS unsigned*)(lds + (bufoff) + ldsw + _i * 8192), 16, 0, 0); } while (0)
#define G_LD8(p) __builtin_shufflevector(*(const LAS v4i_*)(p), *(const LAS v4i_*)((p) + 16), 0, 1, 2, 3, 4, 5, 6, 7)
#define G_LDA(dst, b, h) do { if (POL::FP8) { _Pragma("unroll") for (int m = 0; m < 4; ++m) dst##8[m] = G_LD8(lds + G_SA(b, h) + aoff + m * 2048); } \
        else { _Pragma("unroll") for (int m = 0; m < 4; ++m) _Pragma("unroll") for (int k = 0; k < 2; ++k) dst[m][k] = *(const LAS bf16x8*)(lds + G_SA(b, h) + aoff + m * 2048 + k * 1024); } } while (0)
#define G_LDB(dst, b, h) do { if (POL::FP8) { _Pragma("unroll") for (int n = 0; n < 2; ++n) dst##8[n] = G_LD8(lds + G_SB(b, h) + boff + n * 2048); } \
        else { _Pragma("unroll") for (int n = 0; n < 2; ++n) _Pragma("unroll") for (int k = 0; k < 2; ++k) dst[n][k] = *(const LAS bf16x8*)(lds + G_SB(b, h) + boff + n * 2048 + k * 1024); } } while (0)
#define G_MMA(ai, bj, At, Bt) do { __builtin_amdgcn_s_setprio(1); \
        if (POL::FP8) { _Pragma("unroll") for (int m = 0; m < 4; ++m) _Pragma("unroll") for (int n = 0; n < 2; ++n) \
            asm volatile("v_mfma_scale_f32_16x16x128_f8f6f4 %0, %1, %2, %0, %3, %3 op_sel_hi:[0,0,0]" : "+v"(acc[ai][bj][m][n]) : "v"(Bt##8[n]), "v"(At##8[m]), "v"(mxs)); } \
        else { _Pragma("unroll") for (int m = 0; m < 4; ++m) _Pragma("unroll") for (int n = 0; n < 2; ++n) _Pragma("unroll") for (int k = 0; k < 2; ++k) \
            acc[ai][bj][m][n] = __builtin_amdgcn_mfma_f32_16x16x32_bf16(Bt[n][k], At[m][k], acc[ai][bj][m][n], 0, 0, 0); } \
        __builtin_amdgcn_s_setprio(0); } while (0)
#define G_WAIT_V(n) asm volatile("s_waitcnt vmcnt(" #n ")" ::: "memory")
#define G_WAIT_L(n) asm volatile("s_waitcnt lgkmcnt(" #n ")" ::: "memory")
#define G_BAR __builtin_amdgcn_s_barrier()
#define G_SCHED __builtin_amdgcn_sched_barrier(0)
#define G_TRIP(A1, OC, A2, ON, B2) do { \
        G_LDB(B0, 0, 0); G_SCHED; G_LDA(At, 0, 0); G_STAGE_A(G_SA(1, 1), A1, OC, 1); \
        G_WAIT_L(8); G_BAR; G_WAIT_L(0); G_MMA(0, 0, At, B0); G_BAR; G_SCHED; \
        G_LDB(B1, 0, 1); G_STAGE_B(G_SB(0, 0), B2, 0u); \
        G_BAR; G_WAIT_L(0); G_MMA(0, 1, At, B1); G_BAR; \
        G_LDA(At, 0, 1); G_STAGE_A(G_SA(0, 0), A2, ON, 0); \
        G_BAR; G_WAIT_L(0); G_MMA(1, 0, At, B0); G_BAR; G_SCHED; \
        G_STAGE_B(G_SB(0, 1), B2, hstepB); \
        G_WAIT_V(6); G_BAR; G_MMA(1, 1, At, B1); G_BAR; \
        G_LDB(B0, 1, 0); G_SCHED; G_LDA(At, 1, 0); G_STAGE_A(G_SA(0, 1), A2, ON, 1); \
        G_WAIT_L(8); G_BAR; G_WAIT_L(0); G_MMA(0, 0, At, B0); G_BAR; G_SCHED; \
        G_LDB(B1, 1, 1); G_STAGE_B(G_SB(1, 0), (B2) + kstep, 0u); \
        G_BAR; G_WAIT_L(0); G_MMA(0, 1, At, B1); G_BAR; \
        G_LDA(At, 1, 1); G_STAGE_A(G_SA(1, 0), (A2) + kstep, ON, 0); \
        G_BAR; G_WAIT_L(0); G_MMA(1, 0, At, B0); G_BAR; G_SCHED; \
        G_STAGE_B(G_SB(1, 1), (B2) + kstep, hstepB); \
        G_WAIT_V(6); G_BAR; G_MMA(1, 1, At, B1); G_BAR; } while (0)
    Unit cur, nxt; int ui = 0;
    if (!P.next(0, cur)) return;
    f32x4 acc[2][2][4][2];
#pragma unroll
    for (int a = 0; a < 2; ++a)
#pragma unroll
        for (int b = 0; b < 2; ++b)
#pragma unroll
            for (int m = 0; m < 4; ++m)
#pragma unroll
                for (int n = 0; n < 2; ++n) acc[a][b][m][n] = (f32x4){0.f, 0.f, 0.f, 0.f};
    const int mxs = 0x7f7f7f7f;
    bf16x8 At[4][2], B0[2][2], B1[2][2]; v8i At8[4], B08[2], B18[2];
    unsigned oc[2][2], on[2][2];
#pragma unroll
    for (int h = 0; h < 2; ++h)
#pragma unroll
        for (int i = 0; i < 2; ++i) { oc[h][i] = POL::GATHER ? P.a_off(cur, h * HALFT + sR[i]) + (unsigned)sC[i] * 2u : 0u; on[h][i] = 0u; }
    const char* cA = P.a_base(cur); const char* cB = P.b_base(cur);
    G_STAGE_B(G_SB(0, 0), cB, 0u); G_STAGE_A(G_SA(0, 0), cA, oc, 0); G_STAGE_B(G_SB(0, 1), cB, hstepB); G_STAGE_A(G_SA(0, 1), cA, oc, 1);
    if (wr == 1) G_BAR;
    G_WAIT_V(4); G_BAR;
    G_STAGE_B(G_SB(1, 0), cB + kstep, 0u); G_STAGE_A(G_SA(1, 0), cA + kstep, oc, 0); G_STAGE_B(G_SB(1, 1), cB + kstep, hstepB);
    G_WAIT_V(6); G_BAR;
    for (;;) {
        const bool has_next = P.next(ui + 1, nxt);
        const char* nA = has_next ? P.a_base(nxt) : cA; const char* nB = has_next ? P.b_base(nxt) : cB;
        if (POL::GATHER) {
#pragma unroll
            for (int h = 0; h < 2; ++h)
#pragma unroll
                for (int i = 0; i < 2; ++i) on[h][i] = has_next ? P.a_off(nxt, h * HALFT + sR[i]) + (unsigned)sC[i] * 2u : oc[h][i];
        }
#pragma unroll 1
        for (int t = 0; t < nt; t += 2) {
            const bool last = (t == nt - 2);
            const char* a1 = cA + (size_t)(t + 1) * kstep; const char* a2 = last ? nA : cA + (size_t)(t + 2) * kstep; const char* b2 = last ? nB : cB + (size_t)(t + 2) * kstep;
            if (POL::GATHER) {
                unsigned os[2][2];
#pragma unroll
                for (int h = 0; h < 2; ++h)
#pragma unroll
                    for (int i = 0; i < 2; ++i) os[h][i] = last ? on[h][i] : oc[h][i];
                G_TRIP(a1, oc, a2, os, b2);
            } else { G_TRIP(a1, oc, a2, oc, b2); }
        }
        if (POL::FP8) asm volatile("s_nop 15\n\ts_nop 15" ::: "memory");
        if (wr == 0) G_BAR;
        P.epi(acc, cur, wr, wc, fr, fq);
        if (!has_next) break;
#pragma unroll
        for (int a = 0; a < 2; ++a)
#pragma unroll
            for (int b = 0; b < 2; ++b)
#pragma unroll
                for (int m = 0; m < 4; ++m)
#pragma unroll
                    for (int n = 0; n < 2; ++n) acc[a][b][m][n] = (f32x4){0.f, 0.f, 0.f, 0.f};
        cur = nxt; cA = nA; cB = nB; ++ui;
        if (POL::GATHER) {
#pragma unroll
            for (int h = 0; h < 2; ++h)
#pragma unroll
                for (int i = 0; i < 2; ++i) oc[h][i] = on[h][i];
        }
        if (wr == 1) G_BAR;
    }
    G_WAIT_V(0);
    G_BAR;
#undef G_SA
#undef G_SB
#undef G_AOFF
#undef G_STAGE_A
#undef G_STAGE_B
#undef G_LDA
#undef G_LDB
#undef G_MMA
#undef G_LD8
#undef G_WAIT_V
#undef G_WAIT_L
#undef G_BAR
#undef G_SCHED
#undef G_TRIP
}

struct PolInProj {
    static constexpr bool PERM = true, GATHER = false, FP8 = false;
    const bf16_t* A; const bf16_t* Bt; bf16_t* O; TileOrder ord;
    __device__ __forceinline__ bool next(int i, Unit& u) const { return ord.tile(i, u.pm, u.pn); }
    __device__ __forceinline__ const char* a_base(const Unit& u) const { return (const char*)A + (size_t)u.pm * BM * GK * 2; }
    __device__ __forceinline__ unsigned a_off(const Unit&, int r) const { return (unsigned)r * GK * 2u; }
    __device__ __forceinline__ const char* b_base(const Unit& u) const { return (const char*)Bt + (size_t)u.pn * BM * GK * 2; }
    __device__ __forceinline__ void epi(const f32x4 (&acc)[2][2][4][2], const Unit& u, int wr, int wc, int fr, int fq) const {
        const int row0 = u.pm * BM + wr * 64 + fr, col0 = u.pn * BM + wc * 32 + 8 * fq;
#pragma unroll
        for (int ai = 0; ai < 2; ++ai)
#pragma unroll
            for (int m = 0; m < 4; ++m) { bf16_t* rowp = O + (size_t)(row0 + ai * HALFT + m * 16) * INW + col0;
#pragma unroll
                for (int bj = 0; bj < 2; ++bj) { const f32x4 v0 = acc[ai][bj][m][0], v1 = acc[ai][bj][m][1];
                    u32x4 w; w.x = cvt_pk_bf16(v0[0], v0[1]); w.y = cvt_pk_bf16(v0[2], v0[3]); w.z = cvt_pk_bf16(v1[0], v1[1]); w.w = cvt_pk_bf16(v1[2], v1[3]);
                    *(u32x4*)(rowp + bj * HALFT) = w; } }
    }
};
struct PolOutProj {
    static constexpr bool PERM = false, GATHER = false, FP8 = false;
    const bf16_t* A; const bf16_t* Bt; const float* x; const float* mod; float* O; TileOrder ord;
    __device__ __forceinline__ bool next(int i, Unit& u) const { return ord.tile(i, u.pm, u.pn); }
    __device__ __forceinline__ const char* a_base(const Unit& u) const { return (const char*)A + (size_t)u.pm * BM * GK * 2; }
    __device__ __forceinline__ unsigned a_off(const Unit&, int r) const { return (unsigned)r * GK * 2u; }
    __device__ __forceinline__ const char* b_base(const Unit& u) const { return (const char*)Bt + (size_t)u.pn * BM * GK * 2; }
    __device__ __forceinline__ void epi(const f32x4 (&acc)[2][2][4][2], const Unit& u, int wr, int wc, int fr, int fq) const {
        const int row0 = u.pm * BM + wr * 64 + fr, col0 = u.pn * BM + wc * 32 + 4 * fq;
        const float* g1 = mod + (size_t)((u.pm * BM) >> 11) * 6144 + 2048 + col0;
        f32x4 gv[2][2];
#pragma unroll
        for (int bj = 0; bj < 2; ++bj)
#pragma unroll
            for (int n = 0; n < 2; ++n) gv[bj][n] = *(const f32x4*)(g1 + bj * HALFT + n * 16);
#pragma unroll
        for (int ai = 0; ai < 2; ++ai)
#pragma unroll
            for (int m = 0; m < 4; ++m) { const size_t off = (size_t)(row0 + ai * HALFT + m * 16) * D + col0;
#pragma unroll
                for (int bj = 0; bj < 2; ++bj)
#pragma unroll
                    for (int n = 0; n < 2; ++n) { const f32x4 xv = *(const f32x4*)(x + off + bj * HALFT + n * 16); *(f32x4*)(O + off + bj * HALFT + n * 16) = xv + gv[bj][n] * acc[ai][bj][m][n]; } }
    }
};
struct MoeTiles {
    const LAS int* tstart; const u32* cnt; int half;
    __device__ __forceinline__ void find(Unit& u) const {
        const int e = __builtin_amdgcn_readfirstlane(tstart[64 + u.pm]);
        u.e = e; u.pos0 = (u.pm - __builtin_amdgcn_readfirstlane(tstart[e])) * BM; u.cn = (int)cnt[half * NE + e];
    }
};
struct PolGateUp {
    static constexpr bool PERM = true, GATHER = true, FP8 = true;
    const fp8_t* A; const fp8_t* Bt; const float* bgu; const u32* toktab; fp8_t* O; MoeTiles mt; TileOrder ord;
    __device__ __forceinline__ bool next(int i, Unit& u) const { if (!ord.tile(i, u.pm, u.pn)) return false; mt.find(u); return true; }
    __device__ __forceinline__ const char* a_base(const Unit&) const { return (const char*)A; }
    __device__ __forceinline__ unsigned a_off(const Unit& u, int r) const {
        const int p = u.pos0 + r; const u32 tk = toktab[((size_t)mt.half * NE + u.e) * CAP + (p < u.cn ? p : 0)];
        return (tk >> 2) * 1024u;
    }
    __device__ __forceinline__ const char* b_base(const Unit& u) const { return (const char*)Bt + ((size_t)u.e * 2048 + (size_t)u.pn * BM) * 1024; }
    __device__ __forceinline__ void epi(const f32x4 (&acc)[2][2][4][2], const Unit& u, int wr, int wc, int fr, int fq) const {
        const int row0 = u.pm * BM + wr * 64 + fr, cc = u.pn * HALFT + wc * 32 + 8 * fq;
        const float* bg = bgu + (size_t)u.e * 2048 + cc;
        const f32x4 bg0 = *(const f32x4*)bg, bg1 = *(const f32x4*)(bg + 4), bu0 = *(const f32x4*)(bg + 1024), bu1 = *(const f32x4*)(bg + 1028);
        constexpr float inv = 1.0f / (SC_H2 * SC_W);
#pragma unroll
        for (int ai = 0; ai < 2; ++ai)
#pragma unroll
            for (int m = 0; m < 4; ++m) {
                f32x4 g0 = acc[ai][0][m][0] * inv + bg0, g1 = acc[ai][0][m][1] * inv + bg1, u0 = acc[ai][1][m][0] * inv + bu0, u1 = acc[ai][1][m][1] * inv + bu1;
                float o[8];
#pragma unroll
                for (int j = 0; j < 4; ++j) {
                    const float ga = fminf(g0[j], 7.0f), gb = fminf(g1[j], 7.0f);
                    const float ua = fminf(fmaxf(u0[j], -7.0f), 7.0f), ub = fminf(fmaxf(u1[j], -7.0f), 7.0f);
                    o[j] = ga * sigmoidf_(1.702f * ga) * (ua + 1.0f) * SC_ACT; o[4 + j] = gb * sigmoidf_(1.702f * gb) * (ub + 1.0f) * SC_ACT;
                }
                uint2 w; w.x = pk4_fp8(o[0], o[1], o[2], o[3]); w.y = pk4_fp8(o[4], o[5], o[6], o[7]);
                *(uint2*)(O + (size_t)(row0 + ai * HALFT + m * 16) * DFF + cc) = w;
                asm volatile("" ::: "memory");
            }
    }
};
struct PolDown {
    static constexpr bool PERM = true, GATHER = false, FP8 = true;
    const fp8_t* A; const fp8_t* Bt; const float* bd; const u32* toktab; const float* wtab; bf16_t* O; MoeTiles mt; TileOrder ord;
    __device__ __forceinline__ bool next(int i, Unit& u) const { if (!ord.tile(i, u.pm, u.pn)) return false; mt.find(u); return true; }
    __device__ __forceinline__ const char* a_base(const Unit& u) const { return (const char*)A + (size_t)u.pm * BM * 1024; }
    __device__ __forceinline__ unsigned a_off(const Unit&, int r) const { return (unsigned)r * 1024u; }
    __device__ __forceinline__ const char* b_base(const Unit& u) const { return (const char*)Bt + ((size_t)u.e * 1024 + (size_t)u.pn * BM) * 1024; }
    __device__ __forceinline__ void epi(const f32x4 (&acc)[2][2][4][2], const Unit& u, int wr, int wc, int fr, int fq) const {
        const int col0 = u.pn * BM + wc * 32 + 8 * fq;
        const float* bp = bd + (size_t)u.e * D + col0;
        f32x4 bv[2][2];
#pragma unroll
        for (int bj = 0; bj < 2; ++bj) { bv[bj][0] = *(const f32x4*)(bp + bj * HALFT); bv[bj][1] = *(const f32x4*)(bp + bj * HALFT + 4); }
        const size_t tb = ((size_t)mt.half * NE + u.e) * CAP;
        constexpr float inv = 1.0f / (SC_ACT * SC_W);
#pragma unroll
        for (int ai = 0; ai < 2; ++ai)
#pragma unroll
            for (int m = 0; m < 4; ++m) {
                asm volatile("" ::: "memory");
                const int p = u.pos0 + ai * HALFT + wr * 64 + m * 16 + fr;
                if (p < u.cn) {
                    const u32 tk = toktab[tb + p]; const float wg = wtab[tb + p];
                    bf16_t* rowp = O + (size_t)(tk - (u32)mt.half * HALF_TOK * 4u) * D + col0;
#pragma unroll
                    for (int bj = 0; bj < 2; ++bj) { const f32x4 v0 = (acc[ai][bj][m][0] * inv + bv[bj][0]) * wg, v1 = (acc[ai][bj][m][1] * inv + bv[bj][1]) * wg;
                        u32x4 w; w.x = cvt_pk_bf16(v0[0], v0[1]); w.y = cvt_pk_bf16(v0[2], v0[3]); w.z = cvt_pk_bf16(v1[0], v1[1]); w.w = cvt_pk_bf16(v1[2], v1[3]);
                        *(u32x4*)(rowp + bj * HALFT) = w; }
                }
            }
    }
};
__device__ __forceinline__ int moe_tile_table(LAS int* tstart, const u32* cnt, int half) {
    __syncthreads();
    if (threadIdx.x == 0) { int s = 0; for (int e = 0; e < NE; ++e) { tstart[e] = s; s += ((int)cnt[half * NE + e] + BM - 1) / BM; } tstart[NE] = s; }
    __syncthreads();
    const int tot = tstart[NE];
    for (int t = threadIdx.x; t < tot; t += 512) { int e = 0;
#pragma unroll 1
        for (int i = 1; i < NE; ++i) if (t >= tstart[i]) e = i;
        tstart[64 + t] = e; }
    __syncthreads();
    return tot;
}

__device__ __forceinline__ void conv_item(const float* __restrict__ W, int N, bf16_t* __restrict__ WT, int k0, int n0, size_t rowbase, LAS float* scr, int lane) {
#pragma unroll 4
    for (int i = 0; i < 16; ++i) { const int k = 4 * i + (lane >> 4); const f32x4 v = *(const f32x4*)(W + (size_t)(k0 + k) * N + n0 + (lane & 15) * 4); *(LAS f32x4*)(scr + k * 68 + (lane & 15) * 4) = v; }
    asm volatile("s_waitcnt lgkmcnt(0)" ::: "memory");
    const int c = lane & 7;
#pragma unroll
    for (int j = 0; j < 8; ++j) { const int n = (lane >> 3) + 8 * j; const LAS float* s = scr + (8 * c) * 68 + n;
        u32x4 o; o.x = cvt_pk_bf16(s[0 * 68], s[1 * 68]); o.y = cvt_pk_bf16(s[2 * 68], s[3 * 68]); o.z = cvt_pk_bf16(s[4 * 68], s[5 * 68]); o.w = cvt_pk_bf16(s[6 * 68], s[7 * 68]);
        *(u32x4*)(WT + (rowbase + n) * GK + k0 + 8 * c) = o; }
    asm volatile("s_waitcnt lgkmcnt(0)" ::: "memory");
}
__device__ __forceinline__ void conv_item8(const float* __restrict__ W, int N, fp8_t* __restrict__ WT, int k0, int n0, size_t rowbase, LAS float* scr, int lane) {
#pragma unroll 4
    for (int i = 0; i < 16; ++i) { const int k = 4 * i + (lane >> 4); const f32x4 v = *(const f32x4*)(W + (size_t)(k0 + k) * N + n0 + (lane & 15) * 4); *(LAS f32x4*)(scr + k * 68 + (lane & 15) * 4) = v; }
    asm volatile("s_waitcnt lgkmcnt(0)" ::: "memory");
    const LAS float* sp = scr + lane;
#pragma unroll
    for (int q = 0; q < 4; ++q) {
        u32x4 o;
        o.x = pk4_fp8(sp[(16 * q + 0) * 68] * SC_W, sp[(16 * q + 1) * 68] * SC_W, sp[(16 * q + 2) * 68] * SC_W, sp[(16 * q + 3) * 68] * SC_W);
        o.y = pk4_fp8(sp[(16 * q + 4) * 68] * SC_W, sp[(16 * q + 5) * 68] * SC_W, sp[(16 * q + 6) * 68] * SC_W, sp[(16 * q + 7) * 68] * SC_W);
        o.z = pk4_fp8(sp[(16 * q + 8) * 68] * SC_W, sp[(16 * q + 9) * 68] * SC_W, sp[(16 * q + 10) * 68] * SC_W, sp[(16 * q + 11) * 68] * SC_W);
        o.w = pk4_fp8(sp[(16 * q + 12) * 68] * SC_W, sp[(16 * q + 13) * 68] * SC_W, sp[(16 * q + 14) * 68] * SC_W, sp[(16 * q + 15) * 68] * SC_W);
        *(u32x4*)(WT + (rowbase + lane) * GK + k0 + 16 * q) = o;
    }
    asm volatile("s_waitcnt lgkmcnt(0)" ::: "memory");
}
constexpr int IT_IN = 16 * (INW / 64), IT_OUT = 16 * (D / 64), IT_GU = NE * 16 * 32, IT_D = NE * 16 * 16, IT_ALL = IT_IN + IT_OUT + IT_GU + IT_D;
struct ProArgs { const float *c, *c_ctx, *w_ada, *b_ada, *lbl, *w_in, *w_out, *wgu, *wd, *rg_wa, *rg_wx, *rg_lam; float *mod, *lb, *coef; bf16_t *Win_t, *Wout_t, *WG_t; fp8_t *Wgu_t, *Wd_t; };
__device__ __forceinline__ void phase_prologue(LAS unsigned char* lds, const ProArgs& a, int bid, int G, bool do_mod, int it_lo, int it_hi) {
    const int tid = threadIdx.x, lane = tid & 63, w = tid >> 6;
    if (!do_mod) {} else if (bid < 96) {
        LAS float* s = (LAS float*)lds;
        for (int i = tid; i < 33 * D; i += 512) { const int b = i >> 10, k = i & 1023; const float v = b < NB ? a.c[(size_t)b * D + k] : a.c_ctx[k]; s[i] = v * sigmoidf_(v); }
        __syncthreads();
        const int n = bid * 64 + lane;
        float acc[33];
#pragma unroll
        for (int b = 0; b < 33; ++b) acc[b] = 0.f;
        for (int k = 128 * w; k < 128 * w + 128; k += 4) {
            const float w0 = a.w_ada[(size_t)k * 6144 + n], w1 = a.w_ada[(size_t)(k + 1) * 6144 + n], w2 = a.w_ada[(size_t)(k + 2) * 6144 + n], w3 = a.w_ada[(size_t)(k + 3) * 6144 + n];
#pragma unroll
            for (int b = 0; b < 33; ++b) { const f32x4 sv = *(const LAS f32x4*)(s + b * D + k); acc[b] += sv[0] * w0 + sv[1] * w1 + sv[2] * w2 + sv[3] * w3; }
        }
        __syncthreads();
        LAS float* red = (LAS float*)lds;
#pragma unroll
        for (int b = 0; b < 33; ++b) red[(w * 33 + b) * 64 + lane] = acc[b];
        __syncthreads();
        for (int i = tid; i < 33 * 64; i += 512) { const int b = i >> 6, l = i & 63; float sum = a.b_ada[bid * 64 + l];
#pragma unroll
            for (int ww = 0; ww < 8; ++ww) sum += red[(ww * 33 + b) * 64 + l];
            a.mod[(size_t)b * 6144 + bid * 64 + l] = sum; }
        __syncthreads();
    } else if (bid == 96) {
        for (int i = tid; i < 2 * HGW; i += 512) { const float l0 = a.lbl[i], l1 = a.lbl[2 * HGW + i]; a.lb[i] = 1.0f / (1.0f + __expf(l1 - l0)); }
        for (int i = tid; i < 2 * RGW; i += 512) { const float l = a.rg_lam[i]; const float sp = (-l > 20.f) ? -l : log1pf(__expf(-l)); a.coef[i] = -8.0f * sp; }
    } else if (bid == 97) {
        for (int idx = tid; idx < 8 * 256 * 64; idx += 512) { const int hd = idx >> 14, n = (idx >> 6) & 255, kk = idx & 63, g = n >> 6, j = n & 63, d = g >> 1;
            const float* src = (g & 1) ? a.rg_wx : a.rg_wa; a.WG_t[idx] = f2bf(src[(((size_t)d * 8 + hd) * 64 + kk) * 64 + j]); }
    }
    LAS float* scr = (LAS float*)(lds + w * (64 * 68 * 4));
    const int gw = bid * 8 + w, NW = G * 8;
    for (int it = it_lo + gw; it < it_hi; it += NW) {
        int r = it;
        if (r < IT_IN) { const int kb = r / (INW / 64), nb = r % (INW / 64); conv_item(a.w_in, INW, a.Win_t, kb * 64, nb * 64, (size_t)nb * 64, scr, lane); continue; } r -= IT_IN;
        if (r < IT_OUT) { const int kb = r / 16, nb = r % 16; conv_item(a.w_out, D, a.Wout_t, kb * 64, nb * 64, (size_t)nb * 64, scr, lane); continue; } r -= IT_OUT;
        if (r < IT_GU) { const int e = r / 512, q = r % 512, kb = q / 32, nb = q % 32, n0 = nb * 64, bj = n0 >> 10, rem = n0 & 1023, pn = rem >> 7, cc0 = rem & 127;
            conv_item8(a.wgu + (size_t)e * D * 2048, 2048, a.Wgu_t, kb * 64, n0, (size_t)e * 2048 + pn * 256 + bj * 128 + cc0, scr, lane); continue; } r -= IT_GU;
        { const int e = r / 256, q = r % 256, kb = q / 16, nb = q % 16; conv_item8(a.wd + (size_t)e * DFF * D, D, a.Wd_t, kb * 64, nb * 64, (size_t)e * 1024 + nb * 64, scr, lane); }
    }
}


__device__ __forceinline__ void phase_norm1(const float* __restrict__ x, const float* __restrict__ ctx, const float* __restrict__ nw, const float* __restrict__ mod, bf16_t* __restrict__ H, int bid, int G) {
    const int lane = threadIdx.x & 63, gw = bid * 8 + (threadIdx.x >> 6), NW = G * 8;
    for (int r = gw; r < NROWS; r += NW) {
        const float* src = r < NLAT ? x + (size_t)r * D : ctx + (size_t)(r - NLAT) * D;
        const float* m = mod + (size_t)(r < NLAT ? (r >> 11) : NB) * 6144;
        f32x4 v[4]; float ss = 0.f;
#pragma unroll
        for (int j = 0; j < 4; ++j) { v[j] = *(const f32x4*)(src + j * 256 + lane * 4); ss += v[j][0] * v[j][0] + v[j][1] * v[j][1] + v[j][2] * v[j][2] + v[j][3] * v[j][3]; }
        const float rstd = __builtin_amdgcn_rsqf(wave_sum(ss) * (1.0f / D) + EPS);
#pragma unroll
        for (int j = 0; j < 4; ++j) {
            const int c0 = j * 256 + lane * 4;
            const f32x4 w = *(const f32x4*)(nw + c0), sh = *(const f32x4*)(m + c0), sc = *(const f32x4*)(m + 1024 + c0);
            const f32x4 o = v[j] * rstd * w * (sc + 1.0f) + sh;
            uint2 p; p.x = cvt_pk_bf16(o[0], o[1]); p.y = cvt_pk_bf16(o[2], o[3]);
            *(uint2*)(H + (size_t)r * D + c0) = p;
        }
    }
}

__device__ __forceinline__ void phase_hgrn2_simple(LAS unsigned char* lds, const bf16_t* __restrict__ P, const float* __restrict__ lb, bf16_t* __restrict__ OF, bf16_t* __restrict__ OB, int item) {
    LAS float* qs = (LAS float*)lds; LAS float* fs = qs + 32 * 128; LAS float* vs = fs + 32 * 128;
    const int b = item >> 3, h = (item >> 1) & 3, dir = item & 1;
    const int tid = threadIdx.x, w = tid >> 6, lane = tid & 63, vi = lane & 15, kg = lane >> 4, v = 16 * w + vi;
    bf16_t* OD = dir == 0 ? OF : OB;
    float S[32];
#pragma unroll
    for (int i = 0; i < 32; ++i) S[i] = 0.f;
    const int lt = tid >> 4, lc = (tid & 15) * 8;
    float lbv[8];
#pragma unroll
    for (int i = 0; i < 8; ++i) lbv[i] = lb[dir * HGW + h * 128 + lc + i];
    const int cf = dir == 0 ? C_FF : C_FB;
    for (int n0 = 0; n0 < CTXL + T; n0 += 32) {
        __syncthreads();
        {
            const int n = n0 + lt;
            size_t row;
            if (n < CTXL) row = (size_t)NLAT + b * CTXL + (dir == 0 ? n : CTXL - 1 - n);
            else row = (size_t)b * T + (dir == 0 ? (n - CTXL) : (T - 1 - (n - CTXL)));
            const bf16_t* pr = P + row * INW + h * 128 + lc;
            const uint4 qv = *(const uint4*)(pr + C_Q), iv = *(const uint4*)(pr + C_I), fv = *(const uint4*)(pr + cf);
            const u32 qa[4] = {qv.x, qv.y, qv.z, qv.w}, ia[4] = {iv.x, iv.y, iv.z, iv.w}, fa[4] = {fv.x, fv.y, fv.z, fv.w};
#pragma unroll
            for (int i = 0; i < 4; ++i) {
                const float q0 = __uint_as_float(qa[i] << 16), q1 = __uint_as_float(qa[i] & 0xffff0000u);
                const float f0 = __uint_as_float(fa[i] << 16), f1 = __uint_as_float(fa[i] & 0xffff0000u);
                qs[lt * 128 + lc + 2 * i] = q0 * sigmoidf_(q0); qs[lt * 128 + lc + 2 * i + 1] = q1 * sigmoidf_(q1);
                vs[lt * 128 + lc + 2 * i] = __uint_as_float(ia[i] << 16); vs[lt * 128 + lc + 2 * i + 1] = __uint_as_float(ia[i] & 0xffff0000u);
                fs[lt * 128 + lc + 2 * i] = lbv[2 * i] + (1.f - lbv[2 * i]) * sigmoidf_(f0);
                fs[lt * 128 + lc + 2 * i + 1] = lbv[2 * i + 1] + (1.f - lbv[2 * i + 1]) * sigmoidf_(f1);
            }
        }
        __syncthreads();
        for (int j = 0; j < 32; ++j) {
            const float vv = vs[j * 128 + v];
            float o = 0.f;
#pragma unroll
            for (int i4 = 0; i4 < 8; ++i4) {
                const f32x4 f4 = *(const LAS f32x4*)(fs + j * 128 + 32 * kg + 4 * i4), q4 = *(const LAS f32x4*)(qs + j * 128 + 32 * kg + 4 * i4);
#pragma unroll
                for (int e = 0; e < 4; ++e) { S[4 * i4 + e] = f4[e] * (S[4 * i4 + e] - vv) + vv; o += S[4 * i4 + e] * q4[e]; }
            }
            o += __shfl_xor(o, 16); o += __shfl_xor(o, 32);
            const int n = n0 + j;
            if (n >= CTXL && kg == 0) {
                const int tt = dir == 0 ? (n - CTXL) : (T - 1 - (n - CTXL));
                OD[((size_t)b * T + tt) * HGW + h * 128 + v] = f2bf(o);
            }
        }
    }
}

constexpr int HQ_QD = 0, HQ_KD = 17408, HQ_KET = 34816, HQ_VT = 53248, HQ_PM = 71680, HQ_OS = 80896, HQ_TOT = 98304, HQ_DEC = 100352;
__device__ __forceinline__ bf16x8 pack8(const f32x4& a, const f32x4& b) {
    u32x4 w; w.x = cvt_pk_bf16(a[0], a[1]); w.y = cvt_pk_bf16(a[2], a[3]); w.z = cvt_pk_bf16(b[0], b[1]); w.w = cvt_pk_bf16(b[2], b[3]);
    return __builtin_bit_cast(bf16x8, w);
}
__device__ __forceinline__ void phase_hgrn2_chunk(LAS unsigned char* lds, const bf16_t* __restrict__ P, const float* __restrict__ lb, bf16_t* __restrict__ OF, bf16_t* __restrict__ OB, int item) {
    const int b = item >> 3, h = (item >> 1) & 3, dir = item & 1;
    const int tid = threadIdx.x, w = __builtin_amdgcn_readfirstlane(tid >> 6), lane = tid & 63, l15 = lane & 15, G4 = lane >> 4;
    const int k = tid & 127, seg = tid >> 7;
    const int kslot = (k & ~31) | (((k >> 2) & 3) << 3) | (((k >> 4) & 1) << 2) | (k & 3);
    const float lbv = lb[dir * HGW + h * 128 + k];
    bf16_t* OD = dir ? OB : OF;
    const int cf = dir ? C_FB : C_FF;
    LAS float* TOT = (LAS float*)(lds + HQ_TOT); LAS float* DEC = (LAS float*)(lds + HQ_DEC);
    f32x4 S[8];
#pragma unroll
    for (int t = 0; t < 8; ++t) S[t] = (f32x4){0.f, 0.f, 0.f, 0.f};
#pragma unroll 1
    for (int n = 0; n < (CTXL + T) / 64; ++n) {
        const bool lat = n >= CTXL / 64;
        float qv[16], vv[16], fv[16], cs[16];
#pragma unroll
        for (int i = 0; i < 16; ++i) {
            const int p = 64 * n + 16 * seg + i;
            const size_t row = p < CTXL ? (size_t)NLAT + b * CTXL + (dir ? CTXL - 1 - p : p) : (size_t)b * T + (dir ? T - 1 - (p - CTXL) : (p - CTXL));
            const bf16_t* pr = P + row * INW + h * 128 + k;
            qv[i] = bf2f(pr[C_Q]); vv[i] = bf2f(pr[C_I]); fv[i] = bf2f(pr[cf]);
        }
        float run = 0.f;
#pragma unroll
        for (int i = 0; i < 16; ++i) { const float f = lbv + (1.f - lbv) * sigmoidf_(fv[i]); fv[i] = f; run += flog(f); cs[i] = run; }
        __syncthreads();
        TOT[seg * 128 + k] = run;
        __syncthreads();
        const float t0 = TOT[k], t1 = TOT[128 + k], t2 = TOT[256 + k], t3 = TOT[384 + k];
        const float prefix = seg == 0 ? 0.f : seg == 1 ? t0 : seg == 2 ? t0 + t1 : t0 + t1 + t2;
        const float blast = (t0 + t1) + (t2 + t3);
        const float eb = fexp(blast);
        if (seg == 0) DEC[k] = eb;
        float ke[16];
#pragma unroll
        for (int i = 0; i < 16; ++i) {
            const float bc = prefix + cs[i], e = fexp(bc), kf = (1.f - fv[i]) * frcp(e);
            const int j = 16 * seg + i;
            *(LAS bf16_t*)(lds + HQ_QD + j * 272 + kslot * 2) = f2bf(qv[i] * sigmoidf_(qv[i]) * e);
            *(LAS bf16_t*)(lds + HQ_KD + j * 272 + kslot * 2) = f2bf(kf);
            ke[i] = kf * eb;
        }
        {
            u32x4 w0, w1;
            w0.x = cvt_pk_bf16(ke[0], ke[1]); w0.y = cvt_pk_bf16(ke[2], ke[3]); w0.z = cvt_pk_bf16(ke[4], ke[5]); w0.w = cvt_pk_bf16(ke[6], ke[7]);
            w1.x = cvt_pk_bf16(ke[8], ke[9]); w1.y = cvt_pk_bf16(ke[10], ke[11]); w1.z = cvt_pk_bf16(ke[12], ke[13]); w1.w = cvt_pk_bf16(ke[14], ke[15]);
            *(LAS u32x4*)(lds + HQ_KET + k * 144 + seg * 32) = w0; *(LAS u32x4*)(lds + HQ_KET + k * 144 + seg * 32 + 16) = w1;
            w0.x = cvt_pk_bf16(vv[0], vv[1]); w0.y = cvt_pk_bf16(vv[2], vv[3]); w0.z = cvt_pk_bf16(vv[4], vv[5]); w0.w = cvt_pk_bf16(vv[6], vv[7]);
            w1.x = cvt_pk_bf16(vv[8], vv[9]); w1.y = cvt_pk_bf16(vv[10], vv[11]); w1.z = cvt_pk_bf16(vv[12], vv[13]); w1.w = cvt_pk_bf16(vv[14], vv[15]);
            *(LAS u32x4*)(lds + HQ_VT + k * 144 + seg * 32) = w0; *(LAS u32x4*)(lds + HQ_VT + k * 144 + seg * 32 + 16) = w1;
        }
        __syncthreads();
        if (lat) {
            const int mt = w >> 1, ntp = w & 1;
            f32x4 pa[2] = {(f32x4){0.f, 0.f, 0.f, 0.f}, (f32x4){0.f, 0.f, 0.f, 0.f}};
#pragma unroll
            for (int s = 0; s < 4; ++s) {
                const bf16x8 a = *(const LAS bf16x8*)(lds + HQ_QD + (16 * mt + l15) * 272 + (32 * s + 8 * G4) * 2);
#pragma unroll
                for (int q = 0; q < 2; ++q) { const bf16x8 bq = *(const LAS bf16x8*)(lds + HQ_KD + (16 * (2 * ntp + q) + l15) * 272 + (32 * s + 8 * G4) * 2); pa[q] = __builtin_amdgcn_mfma_f32_16x16x32_bf16(a, bq, pa[q], 0, 0, 0); }
            }
#pragma unroll
            for (int q = 0; q < 2; ++q)
#pragma unroll
                for (int r = 0; r < 4; ++r) { const int c = 16 * mt + 4 * G4 + r, j = 16 * (2 * ntp + q) + l15; *(LAS bf16_t*)(lds + HQ_PM + c * 144 + j * 2) = f2bf(j <= c ? pa[q][r] : 0.f); }
        }
        __syncthreads();
        bf16x8 vb[2];
#pragma unroll
        for (int s = 0; s < 2; ++s) vb[s] = *(const LAS bf16x8*)(lds + HQ_VT + (16 * w + l15) * 144 + (32 * s + 8 * G4) * 2);
        if (lat) {
            bf16x8 sb[4];
#pragma unroll
            for (int s = 0; s < 4; ++s) sb[s] = pack8(S[2 * s], S[2 * s + 1]);
#pragma unroll
            for (int mt = 0; mt < 4; ++mt) {
                f32x4 oa = (f32x4){0.f, 0.f, 0.f, 0.f};
#pragma unroll
                for (int s = 0; s < 2; ++s) { const bf16x8 a = *(const LAS bf16x8*)(lds + HQ_PM + (16 * mt + l15) * 144 + (32 * s + 8 * G4) * 2); oa = __builtin_amdgcn_mfma_f32_16x16x32_bf16(a, vb[s], oa, 0, 0, 0); }
#pragma unroll
                for (int s = 0; s < 4; ++s) { const bf16x8 a = *(const LAS bf16x8*)(lds + HQ_QD + (16 * mt + l15) * 272 + (32 * s + 8 * G4) * 2); oa = __builtin_amdgcn_mfma_f32_16x16x32_bf16(a, sb[s], oa, 0, 0, 0); }
#pragma unroll
                for (int r = 0; r < 4; ++r) *(LAS bf16_t*)(lds + HQ_OS + (16 * mt + 4 * G4 + r) * 272 + (16 * w + l15) * 2) = f2bf(oa[r]);
            }
        }
#pragma unroll
        for (int t = 0; t < 8; ++t) {
            const f32x4 d4 = *(const LAS f32x4*)(DEC + 16 * t + 4 * G4);
            S[t] = S[t] * d4;
#pragma unroll
            for (int s = 0; s < 2; ++s) { const bf16x8 a = *(const LAS bf16x8*)(lds + HQ_KET + (16 * t + l15) * 144 + (32 * s + 8 * G4) * 2); S[t] = __builtin_amdgcn_mfma_f32_16x16x32_bf16(a, vb[s], S[t], 0, 0, 0); }
        }
        __syncthreads();
        if (lat) {
            const int j = tid >> 3, part = tid & 7, p = 64 * n + j, tt = dir ? T - 1 - (p - CTXL) : (p - CTXL);
            const u32x4 o0 = *(const LAS u32x4*)(lds + HQ_OS + j * 272 + part * 32), o1 = *(const LAS u32x4*)(lds + HQ_OS + j * 272 + part * 32 + 16);
            bf16_t* dst = OD + ((size_t)b * T + tt) * HGW + h * 128 + part * 16;
            *(u32x4*)dst = o0; *(u32x4*)(dst + 8) = o1;
        }
    }
}

__device__ __forceinline__ size_t rg_row(int b, bool lat, int p) {
    return lat ? (size_t)b * T + (size_t)(p % GROWS) * GRIDW + (p / GROWS) : (size_t)NLAT + b * CTXL + p;
}
template <int dir>
__device__ __forceinline__ void rglru_simple_wave(LAS float* xs, const bf16_t* __restrict__ P, const float* __restrict__ conv_w, const float* __restrict__ conv_b,
                                                  const float* __restrict__ wa, const float* __restrict__ ba, const float* __restrict__ wx, const float* __restrict__ bx,
                                                  const float* __restrict__ lam, bf16_t* __restrict__ HD, int hd, int b) {
    const int j = threadIdx.x & 63, c = hd * 64 + j;
    float wac[64], wxc[64];
#pragma unroll
    for (int i = 0; i < 64; ++i) { wac[i] = wa[(((size_t)dir * 8 + hd) * 64 + i) * 64 + j]; wxc[i] = wx[(((size_t)dir * 8 + hd) * 64 + i) * 64 + j]; }
    const float cw0 = conv_w[0 * RGW + c], cw1 = conv_w[1 * RGW + c], cw2 = conv_w[2 * RGW + c], cw3 = conv_w[3 * RGW + c], cb = conv_b[c];
    const float bav = ba[dir * RGW + c], bxv = bx[dir * RGW + c];
    const float l = lam[dir * RGW + c];
    const float sp = (-l > 20.f) ? -l : log1pf(__expf(-l));
    const float coef = -8.0f * sp;
    float hst = 0.f;
    for (int seg = 0; seg < 2; ++seg) {
        const bool lat = seg == 1; const int L = lat ? T : CTXL;
        for (int s0 = 0; s0 < L; s0 += 16) {
            float xc[16];
            const int plo = dir == 0 ? s0 : L - 16 - s0;
            {
                float rx[19];
#pragma unroll
                for (int i = 0; i < 19; ++i) { const int p = plo - 2 + i; rx[i] = (p >= 0 && p < L) ? bf2f(P[rg_row(b, lat, p) * INW + C_RX + c]) : 0.f; }
#pragma unroll
                for (int i = 0; i < 16; ++i) xc[i] = cb + cw0 * rx[i] + cw1 * rx[i + 1] + cw2 * rx[i + 2] + cw3 * rx[i + 3];
            }
            asm volatile("s_waitcnt lgkmcnt(0)" ::: "memory");
#pragma unroll
            for (int i = 0; i < 16; ++i) xs[i * 64 + j] = xc[i];
            asm volatile("s_waitcnt lgkmcnt(0)" ::: "memory");
#pragma unroll
            for (int ii = 0; ii < 16; ++ii) {
                const int i = dir == 0 ? ii : 15 - ii;
                float ra = bav, xa = bxv;
#pragma unroll
                for (int k = 0; k < 64; ++k) { const float xv = xs[i * 64 + k]; ra += xv * wac[k]; xa += xv * wxc[k]; }
                const float r = sigmoidf_(ra), ig = sigmoidf_(xa);
                const float log_a = coef * r, a = __expf(log_a), mult = sqrtf(fmaxf(-expm1f(2.0f * log_a), 0.f));
                hst = a * hst + mult * ig * xc[i];
                if (lat) {
                    const int p = plo + i;
                    const int tt = (p % GROWS) * GRIDW + (p / GROWS);
                    HD[((size_t)b * T + tt) * RGW + c] = f2bf(hst);
                }
            }
        }
    }
}

constexpr int RG_XC = 0, RG_RGT = 66560, RG_CAR = 133120, RG_STRIDE = 1040, NCHK = (CTXL + T) / 64;
__device__ __forceinline__ int rg_off(int row, int chbyte) { return row * RG_STRIDE + ((((chbyte >> 4) ^ (((row >> 4) & 3) << 2)) << 4) | (chbyte & 15)); }
template <int PASS>
__device__ __forceinline__ void rg_item(LAS unsigned char* lds, const bf16_t* __restrict__ P, const float* __restrict__ conv_w, const float* __restrict__ conv_b, const bf16_t* __restrict__ WG_t,
                                        const float* __restrict__ ba, const float* __restrict__ bx, const float* __restrict__ coef, float* __restrict__ AGG, bf16_t* __restrict__ MIX, int b, int n) {
    const int tid = threadIdx.x, w = __builtin_amdgcn_readfirstlane(tid >> 6), lane = tid & 63, l15 = lane & 15, G4 = lane >> 4;
    const bool lat = n >= CTXL / 64; const int L = lat ? T : CTXL, p0 = 64 * (lat ? n - CTXL / 64 : n);
    __syncthreads();
#pragma unroll 1
    for (int it = 0; it < 2; ++it) {
        const int idx = tid + 512 * it, cg4 = idx & 127, pg = idx >> 7;
        float xin[11][4];
#pragma unroll
        for (int i = 0; i < 11; ++i) {
            const int p = p0 + 8 * pg - 2 + i;
            if (p >= 0 && p < L) { const uint2 v = *(const uint2*)(P + rg_row(b, lat, p) * INW + C_RX + cg4 * 4);
                xin[i][0] = __uint_as_float(v.x << 16); xin[i][1] = __uint_as_float(v.x & 0xffff0000u); xin[i][2] = __uint_as_float(v.y << 16); xin[i][3] = __uint_as_float(v.y & 0xffff0000u); }
            else { xin[i][0] = 0.f; xin[i][1] = 0.f; xin[i][2] = 0.f; xin[i][3] = 0.f; }
        }
        const f32x4 w0 = *(const f32x4*)(conv_w + 0 * RGW + cg4 * 4), w1 = *(const f32x4*)(conv_w + 1 * RGW + cg4 * 4), w2 = *(const f32x4*)(conv_w + 2 * RGW + cg4 * 4), w3 = *(const f32x4*)(conv_w + 3 * RGW + cg4 * 4);
        const f32x4 cb4 = *(const f32x4*)(conv_b + cg4 * 4);
#pragma unroll
        for (int q = 0; q < 8; ++q) {
            float o[4];
#pragma unroll
            for (int c = 0; c < 4; ++c) o[c] = cb4[c] + w0[c] * xin[q][c] + w1[c] * xin[q + 1][c] + w2[c] * xin[q + 2][c] + w3[c] * xin[q + 3][c];
            uint2 pk; pk.x = cvt_pk_bf16(o[0], o[1]); pk.y = cvt_pk_bf16(o[2], o[3]);
            *(LAS unsigned long long*)(lds + RG_XC + rg_off(8 * pg + q, cg4 * 8)) = ((unsigned long long)pk.y << 32) | pk.x;
        }
    }
    if (PASS == 2) {
        asm volatile("" ::: "memory");
#pragma unroll 2
        for (int it = 0; it < 8; ++it) { const int idx = tid + 512 * it, row = idx >> 6, ck = idx & 63;
            *(LAS u32x4*)(lds + RG_RGT + rg_off(row, ck * 16)) = *(const u32x4*)(P + rg_row(b, lat, p0 + row) * INW + C_RG + ck * 8); }
        const float2* ag = (const float2*)AGG + (size_t)b * NCHK * 2 * RGW + tid;
        float hf = 0.f, hb = 0.f;
        for (int m = 0; m < n; ++m) { const float2 e = ag[(size_t)(m * 2 + 0) * RGW]; hf = e.x * hf + e.y; }
        for (int m = CTXL / 64 - 1; m >= 0; --m) { const float2 e = ag[(size_t)(m * 2 + 1) * RGW]; hb = e.x * hb + e.y; }
        for (int m = NCHK - 1; m > n; --m) { const float2 e = ag[(size_t)(m * 2 + 1) * RGW]; hb = e.x * hb + e.y; }
        LAS float* CAR = (LAS float*)(lds + RG_CAR); CAR[tid] = hf; CAR[RGW + tid] = hb;
    }
    __syncthreads();
    {
        const int hd = w;
        bf16x8 af[4][2];
#pragma unroll
        for (int mt = 0; mt < 4; ++mt)
#pragma unroll
            for (int s = 0; s < 2; ++s) af[mt][s] = *(const LAS bf16x8*)(lds + RG_XC + rg_off(16 * (l15 >> 2) + 4 * mt + (l15 & 3), (64 * hd + 32 * s + 8 * G4) * 2));
#pragma unroll 1
        for (int cg = 0; cg < 4; ++cg) {
            const int ch = 64 * hd + 16 * cg + l15;
            float hsum[16];
#pragma unroll
            for (int d = 0; d < 2; ++d) {
                f32x4 ra[4], xa[4];
#pragma unroll
                for (int mt = 0; mt < 4; ++mt) { ra[mt] = (f32x4){0.f, 0.f, 0.f, 0.f}; xa[mt] = (f32x4){0.f, 0.f, 0.f, 0.f}; }
                bf16x8 bwa[2], bwx[2];
#pragma unroll
                for (int s = 0; s < 2; ++s) {
                    bwa[s] = *(const bf16x8*)(WG_t + ((size_t)(hd * 256 + 64 * (2 * d) + 16 * cg + l15) * 64 + 32 * s + 8 * G4));
                    bwx[s] = *(const bf16x8*)(WG_t + ((size_t)(hd * 256 + 64 * (2 * d + 1) + 16 * cg + l15) * 64 + 32 * s + 8 * G4));
                }
#pragma unroll
                for (int mt = 0; mt < 4; ++mt)
#pragma unroll
                    for (int s = 0; s < 2; ++s) { ra[mt] = __builtin_amdgcn_mfma_f32_16x16x32_bf16(af[mt][s], bwa[s], ra[mt], 0, 0, 0); xa[mt] = __builtin_amdgcn_mfma_f32_16x16x32_bf16(af[mt][s], bwx[s], xa[mt], 0, 0, 0); }
                const float bav = ba[d * RGW + ch], bxv = bx[d * RGW + ch], cf = coef[d * RGW + ch];
                float av[16], bv[16];
#pragma unroll
                for (int t = 0; t < 16; ++t) {
                    const float r = sigmoidf_(ra[t >> 2][t & 3] + bav), ig = sigmoidf_(xa[t >> 2][t & 3] + bxv);
                    const float a = fexp(cf * r);
                    av[t] = a; bv[t] = fsqrt(fmaxf(1.0f - a * a, 0.f)) * ig * bf2f(*(const LAS bf16_t*)(lds + RG_XC + rg_off(16 * G4 + t, ch * 2)));
                }
                float Al = 1.f, Bl = 0.f;
                if (d == 0) {
#pragma unroll
                    for (int t = 0; t < 16; ++t) { Bl = av[t] * Bl + bv[t]; Al *= av[t]; }
                } else {
#pragma unroll
                    for (int t = 15; t >= 0; --t) { Bl = av[t] * Bl + bv[t]; Al *= av[t]; }
                }
                float Ag[4], Bg[4];
#pragma unroll
                for (int g = 0; g < 4; ++g) { Ag[g] = __shfl(Al, l15 + 16 * g); Bg[g] = __shfl(Bl, l15 + 16 * g); }
                if (PASS == 1) {
                    float A = 1.f, B = 0.f;
                    if (d == 0) {
#pragma unroll
                        for (int g = 0; g < 4; ++g) { B = Ag[g] * B + Bg[g]; A *= Ag[g]; }
                    } else {
#pragma unroll
                        for (int g = 3; g >= 0; --g) { B = Ag[g] * B + Bg[g]; A *= Ag[g]; }
                    }
                    if (G4 == 0) ((float2*)AGG)[((size_t)(b * NCHK + n) * 2 + d) * RGW + ch] = make_float2(A, B);
                } else {
                    const LAS float* CAR = (const LAS float*)(lds + RG_CAR);
                    float h = CAR[d * RGW + ch];
                    if (d == 0) {
                        const float s1 = Ag[0] * h + Bg[0], s2 = Ag[1] * s1 + Bg[1], s3 = Ag[2] * s2 + Bg[2];
                        h = G4 == 0 ? h : G4 == 1 ? s1 : G4 == 2 ? s2 : s3;
#pragma unroll
                        for (int t = 0; t < 16; ++t) { h = av[t] * h + bv[t]; hsum[t] = h; }
                    } else {
                        const float s2 = Ag[3] * h + Bg[3], s1 = Ag[2] * s2 + Bg[2], s0 = Ag[1] * s1 + Bg[1];
                        h = G4 == 3 ? h : G4 == 2 ? s2 : G4 == 1 ? s1 : s0;
#pragma unroll
                        for (int t = 15; t >= 0; --t) { h = av[t] * h + bv[t]; hsum[t] += h; }
                    }
                }
            }
            if (PASS == 2) {
#pragma unroll
                for (int t = 0; t < 16; ++t) { LAS bf16_t* q = (LAS bf16_t*)(lds + RG_RGT + rg_off(16 * G4 + t, ch * 2)); *q = f2bf(gelu_tanh(bf2f(*q)) * hsum[t]); }
            }
        }
    }
    if (PASS == 2) {
        __syncthreads();
#pragma unroll
        for (int it = 0; it < 8; ++it) { const int idx = tid + 512 * it, row = idx >> 6, ck = idx & 63;
            *(u32x4*)(MIX + rg_row(b, true, p0 + row) * D + HGW + ck * 8) = *(const LAS u32x4*)(lds + RG_RGT + rg_off(row, ck * 16)); }
    }
}

__device__ __forceinline__ void phase_mix_finish(const bf16_t* __restrict__ P, const bf16_t* __restrict__ OF, const bf16_t* __restrict__ OB,
                                                 const float* __restrict__ hg_nw, bf16_t* __restrict__ MIX, int bid, int G) {
    const int lane = threadIdx.x & 63, gw = bid * 8 + (threadIdx.x >> 6), NW = G * 8, c0 = lane * 8;
    for (int r = gw; r < NLAT; r += NW) {
        const uint4 a4 = *(const uint4*)(OF + (size_t)r * HGW + c0), b4 = *(const uint4*)(OB + (size_t)r * HGW + c0);
        const u32 aw[4] = {a4.x, a4.y, a4.z, a4.w}, bw[4] = {b4.x, b4.y, b4.z, b4.w};
        float o[8]; float ss = 0.f;
#pragma unroll
        for (int i = 0; i < 4; ++i) { o[2 * i] = __uint_as_float(aw[i] << 16) + __uint_as_float(bw[i] << 16); o[2 * i + 1] = __uint_as_float(aw[i] & 0xffff0000u) + __uint_as_float(bw[i] & 0xffff0000u); }
#pragma unroll
        for (int i = 0; i < 8; ++i) ss += o[i] * o[i];
        ss += __shfl_xor(ss, 1); ss += __shfl_xor(ss, 2); ss += __shfl_xor(ss, 4); ss += __shfl_xor(ss, 8);
        const float rstd = __builtin_amdgcn_rsqf(ss * (1.0f / 128.0f) + EPS);
        const bf16_t* pr = P + (size_t)r * INW;
        const uint4 g4 = *(const uint4*)(pr + C_G + c0);
        const u32 gw4[4] = {g4.x, g4.y, g4.z, g4.w};
        const f32x4 nw0 = *(const f32x4*)(hg_nw + c0), nw1 = *(const f32x4*)(hg_nw + c0 + 4);
        const float nwv[8] = {nw0[0], nw0[1], nw0[2], nw0[3], nw1[0], nw1[1], nw1[2], nw1[3]};
        u32 w[4];
#pragma unroll
        for (int i = 0; i < 4; ++i) {
            const float g0 = __uint_as_float(gw4[i] << 16), g1 = __uint_as_float(gw4[i] & 0xffff0000u);
            w[i] = cvt_pk_bf16(o[2 * i] * rstd * nwv[2 * i] * (g0 * sigmoidf_(g0)), o[2 * i + 1] * rstd * nwv[2 * i + 1] * (g1 * sigmoidf_(g1)));
        }
        *(uint4*)(MIX + (size_t)r * D + c0) = make_uint4(w[0], w[1], w[2], w[3]);
    }
}

__device__ __forceinline__ void phase_norm2_route(LAS unsigned char* lds, const float* __restrict__ x1, const float* __restrict__ nw, const float* __restrict__ mod,
                                                  const float* __restrict__ rw, const float* __restrict__ rb, fp8_t* __restrict__ H2,
                                                  u32* __restrict__ cnt, u32* __restrict__ toktab, float* __restrict__ wtab, int bid, int G) {
    LAS float* rwT = (LAS float*)lds;
    LAS u32* hist = (LAS u32*)(lds + 131072);
    LAS u32* ent = (LAS u32*)(lds + 131072 + 4096);
    const int tid = threadIdx.x, lane = tid & 63, w = tid >> 6;
    for (int i = tid; i < 32 * 1024; i += 512) { const int k = i >> 5, e = i & 31; rwT[e * 1024 + k] = rw[i]; }
    if (tid < 128) hist[tid] = 0;
    __syncthreads();
    const int gw = bid * 8 + w, NW = G * 8;
    int it = 0;
    for (int r = gw; r < NLAT; r += NW, ++it) {
        const float* m = mod + (size_t)(r >> 11) * 6144;
        f32x4 v[4]; float ss = 0.f;
#pragma unroll
        for (int j = 0; j < 4; ++j) { v[j] = *(const f32x4*)(x1 + (size_t)r * D + j * 256 + lane * 4); ss += v[j][0] * v[j][0] + v[j][1] * v[j][1] + v[j][2] * v[j][2] + v[j][3] * v[j][3]; }
        const float rstd = __builtin_amdgcn_rsqf(wave_sum(ss) * (1.0f / D) + EPS);
#pragma unroll
        for (int j = 0; j < 4; ++j) {
            const int c0 = j * 256 + lane * 4;
            const f32x4 ww = *(const f32x4*)(nw + c0), sh = *(const f32x4*)(m + 3072 + c0), sc = *(const f32x4*)(m + 4096 + c0);
            v[j] = v[j] * rstd * ww * (sc + 1.0f) + sh;
            *(unsigned*)(H2 + (size_t)r * D + c0) = pk4_fp8(v[j][0] * SC_H2, v[j][1] * SC_H2, v[j][2] * SC_H2, v[j][3] * SC_H2);
        }
        float part[32];
#pragma unroll
        for (int e = 0; e < 32; ++e) {
            float p = 0.f;
#pragma unroll
            for (int j = 0; j < 4; ++j) { const f32x4 q = *(const LAS f32x4*)(rwT + e * 1024 + j * 256 + lane * 4); p += v[j][0] * q[0] + v[j][1] * q[1] + v[j][2] * q[2] + v[j][3] * q[3]; }
            part[e] = p;
        }
#define RT_STEP(N, M) { const bool up = (lane & (M)) != 0; _Pragma("unroll") for (int i = 0; i < (N); ++i) { const float keep = up ? part[(N) + i] : part[i], send = up ? part[i] : part[(N) + i]; part[i] = keep + __shfl_xor(send, (M)); } }
        RT_STEP(16, 32) RT_STEP(8, 16) RT_STEP(4, 8) RT_STEP(2, 4) RT_STEP(1, 2)
#undef RT_STEP
        float mylogit = part[0] + __shfl_xor(part[0], 1);
        const int myexp = ((lane >> 5) & 1) * 16 + ((lane >> 4) & 1) * 8 + ((lane >> 3) & 1) * 4 + ((lane >> 2) & 1) * 2 + ((lane >> 1) & 1);
        mylogit += rb[myexp];
        int rank = 0;
#pragma unroll
        for (int q = 0; q < 32; ++q) {
            const int src = ((q >> 4) & 1) * 32 + ((q >> 3) & 1) * 16 + ((q >> 2) & 1) * 8 + ((q >> 1) & 1) * 4 + (q & 1) * 2;
            const float oq = __builtin_bit_cast(float, __builtin_amdgcn_readlane(__builtin_bit_cast(int, mylogit), src));
            rank += (oq > mylogit || (oq == mylogit && q < myexp)) ? 1 : 0;
        }
        float tv[4]; int ti[4];
#pragma unroll
        for (int k = 0; k < 4; ++k) {
            const unsigned long long mk = __ballot(rank == k && (lane & 1) == 0);
            const int src = __builtin_amdgcn_readfirstlane((int)__builtin_ctzll(mk));
            tv[k] = __builtin_bit_cast(float, __builtin_amdgcn_readlane(__builtin_bit_cast(int, mylogit), src));
            ti[k] = ((src >> 5) & 1) * 16 + ((src >> 4) & 1) * 8 + ((src >> 3) & 1) * 4 + ((src >> 2) & 1) * 2 + ((src >> 1) & 1);
        }
        const float e1 = fexp(tv[1] - tv[0]), e2 = fexp(tv[2] - tv[0]), e3 = fexp(tv[3] - tv[0]); const float inv = frcp(1.0f + e1 + e2 + e3);
        const float g0 = inv, g1 = e1 * inv, g2 = e2 * inv, g3 = e3 * inv;
        if (lane < 4) {
            const int half = r >= HALF_TOK ? 1 : 0;
            const int e = lane == 0 ? ti[0] : lane == 1 ? ti[1] : lane == 2 ? ti[2] : ti[3];
            const float gv = lane == 0 ? g0 : lane == 1 ? g1 : lane == 2 ? g2 : g3;
            const u32 lp = atomicAdd((u32*)&hist[half * 32 + e], 1u);
            const int idx = (it * 8 + w) * 4 + lane;
            ent[idx * 2] = ((u32)e << 24) | lp; ent[idx * 2 + 1] = __float_as_uint(gv);
        }
    }
    __syncthreads();
    if (tid < 64) hist[64 + tid] = atomicAdd(&cnt[tid], hist[tid]);
    __syncthreads();
    it = 0;
    for (int r = gw; r < NLAT; r += NW, ++it) {
        if (lane < 4) {
            const int half = r >= HALF_TOK ? 1 : 0; const int idx = (it * 8 + w) * 4 + lane;
            const u32 ev = ent[idx * 2]; const int e = ev >> 24; const u32 pos = hist[64 + half * 32 + e] + (ev & 0xffffffu);
            toktab[((size_t)half * 32 + e) * CAP + pos] = (u32)r * 4u + lane;
            wtab[((size_t)half * 32 + e) * CAP + pos] = __uint_as_float(ent[idx * 2 + 1]);
        }
    }
}

__device__ __forceinline__ void phase_combine(float* __restrict__ out, const bf16_t* __restrict__ Y, const float* __restrict__ mod, const float* __restrict__ fw, int half, int bid, int G) {
    const int lane = threadIdx.x & 63, gw = bid * 8 + (threadIdx.x >> 6), NW = G * 8;
    for (int rl = gw; rl < HALF_TOK; rl += NW) {
        const int r = half * HALF_TOK + rl;
        const float* g2 = mod + (size_t)(r >> 11) * 6144 + 5120;
        f32x4 v[4]; float ss = 0.f;
#pragma unroll
        for (int j = 0; j < 4; ++j) {
            const int c0 = j * 256 + lane * 4;
            v[j] = *(const f32x4*)(out + (size_t)r * D + c0);
            float s0 = 0.f, s1 = 0.f, s2 = 0.f, s3 = 0.f;
#pragma unroll
            for (int k = 0; k < 4; ++k) { const uint2 y = *(const uint2*)(Y + ((size_t)rl * 4 + k) * D + c0);
                s0 += __uint_as_float(y.x << 16); s1 += __uint_as_float(y.x & 0xffff0000u); s2 += __uint_as_float(y.y << 16); s3 += __uint_as_float(y.y & 0xffff0000u); }
            const f32x4 g = *(const f32x4*)(g2 + c0);
            v[j][0] += g[0] * s0; v[j][1] += g[1] * s1; v[j][2] += g[2] * s2; v[j][3] += g[3] * s3;
            ss += v[j][0] * v[j][0] + v[j][1] * v[j][1] + v[j][2] * v[j][2] + v[j][3] * v[j][3];
        }
        const float rstd = __builtin_amdgcn_rsqf(wave_sum(ss) * (1.0f / D) + EPS);
#pragma unroll
        for (int j = 0; j < 4; ++j) { const int c0 = j * 256 + lane * 4; const f32x4 w = *(const f32x4*)(fw + c0); *(f32x4*)(out + (size_t)r * D + c0) = v[j] * rstd * w; }
    }
}


#define XB_TMO      128
#define XB_XCNT(j)  (256  + 64 * (j))
#define XB_XSUB(j)  (1280 + 64 * (j))
#define XB_XGEN(j)  (2304 + 64 * (j))
#define XB_TOP      3328
#define XB_TOPGEN   3392
#define XCD_BAR_WORDS 3456
#define XB_SPIN_CAP (1u << 20)
__device__ __forceinline__ unsigned xb_ld(unsigned* p)              { return __hip_atomic_load(p, __ATOMIC_RELAXED, __HIP_MEMORY_SCOPE_AGENT); }
__device__ __forceinline__ unsigned xb_add(unsigned* p, unsigned v) { return __hip_atomic_fetch_add(p, v, __ATOMIC_RELAXED, __HIP_MEMORY_SCOPE_AGENT); }
__device__ __forceinline__ unsigned xb_xcc_id() { return (unsigned)__builtin_amdgcn_s_getreg((3 << 11) | 20) & 0xFu; }
#define XB_SPIN(cond, bar) do { unsigned _sp = 0; while (cond) { __builtin_amdgcn_s_sleep(1); \
    if ((++_sp & 255u) == 0u) { if (xb_ld(&(bar)[XB_TMO])) break; if (_sp > XB_SPIN_CAP) { atomicAdd(&(bar)[XB_TMO], 1u); break; } } } } while (0)
struct XcdBarrier { unsigned* bar; unsigned x; volatile LAS unsigned* st; };
__device__ __forceinline__ XcdBarrier xcd_barrier_post(unsigned* bar, volatile LAS unsigned* st) {
    XcdBarrier b; b.bar = bar; b.x = xb_xcc_id(); b.st = st;
    if (threadIdx.x == 0) (void)xb_add(&bar[XB_XCNT(b.x)], 1u);
    return b;
}
__device__ __forceinline__ void xcd_barrier_complete(unsigned* bar, unsigned x, unsigned& nloc, unsigned& nx) {
    const unsigned G = gridDim.x * gridDim.y * gridDim.z;
    unsigned sum, cnt, mine, sp = 0u;
    for (;;) {
        sum = 0u; cnt = 0u; mine = 0u;
#pragma unroll
        for (unsigned j = 0; j < 16; ++j) { const unsigned c = xb_ld(&bar[XB_XCNT(j)]); sum += c; cnt += (c > 0u) ? 1u : 0u; mine = (j == x) ? c : mine; }
        if (sum == G) break;
        __builtin_amdgcn_s_sleep(1);
        if ((++sp & 255u) == 0u) { if (xb_ld(&bar[XB_TMO])) break; if (sp > XB_SPIN_CAP) { atomicAdd(&bar[XB_TMO], 1u); break; } }
    }
    nloc = mine > 0u ? mine : 1u; nx = cnt > 0u ? cnt : 1u;
}
__device__ __forceinline__ void xcd_barrier(unsigned* bar, volatile LAS unsigned* st) {
    asm volatile("s_waitcnt vmcnt(0)" ::: "memory");
    __syncthreads();
    if (threadIdx.x == 0) {
        __builtin_amdgcn_s_waitcnt(0);
        const unsigned x = xb_xcc_id();
        unsigned nloc = st[0], nx = st[1];
        if (nloc == 0u) { xcd_barrier_complete(bar, x, nloc, nx); st[0] = nloc; st[1] = nx; }
        const unsigned old = xb_add(&bar[XB_XSUB(x)], 1u);
        const unsigned gen = old / nloc;
        if (old + 1u == (gen + 1u) * nloc) {
            __builtin_amdgcn_fence(__ATOMIC_RELEASE, "agent");
            asm volatile("s_waitcnt vmcnt(0)" ::: "memory");
            const unsigned og = xb_add(&bar[XB_TOP], 1u);
            const unsigned tg = og / nx;
            if (og + 1u == (tg + 1u) * nx) xb_add(&bar[XB_TOPGEN], 1u);
            else XB_SPIN(xb_ld(&bar[XB_TOPGEN]) == tg, bar);
            __builtin_amdgcn_fence(__ATOMIC_ACQUIRE, "agent");
            xb_add(&bar[XB_XGEN(x)], 1u);
            asm volatile("s_waitcnt vmcnt(0)" ::: "memory");
        } else {
            XB_SPIN(xb_ld(&bar[XB_XGEN(x)]) == gen, bar);
            __builtin_amdgcn_fence(__ATOMIC_ACQUIRE, "agent");
            asm volatile("s_waitcnt vmcnt(0)" ::: "memory");
        }
    }
    __syncthreads();
}
constexpr size_t WS_BAR = 16384;
constexpr int LDS_BARST = LDS_BYTES - 16;

struct MegaArgs {
    const float *x, *c, *ctx, *c_ctx, *norm1_w, *norm2_w, *w_ada, *b_ada, *w_in, *lbl, *hg_nw, *conv_w, *conv_b, *rg_wa, *rg_ba, *rg_wx, *rg_bx, *rg_lam, *w_out,
        *router_w, *router_b, *wgu, *bgu, *wd, *bd, *final_w;
    float* out; unsigned char* ws;
};
typedef const MegaArgs __attribute__((address_space(4)))* KArgs;
__device__ __forceinline__ KArgs kargs() { auto p = __builtin_amdgcn_kernarg_segment_ptr(); asm volatile("" : "+s"(p)); return (KArgs)p; }
#define WSP(T, off) ((T*)(ws + (off)))
#define GRID_SYNC_CG() cg::this_grid().sync()
#define GRID_SYNC() do { KArgs a_ = kargs(); xcd_barrier((unsigned*)(a_->ws + WS_BAR), (volatile LAS unsigned*)(lds + LDS_BARST)); } while (0)
__global__ __launch_bounds__(512, 2) void k_mega(MegaArgs a_unused) {
    extern __shared__ __attribute__((aligned(16))) unsigned char lds_[];
    LAS unsigned char* lds = (LAS unsigned char*)lds_;
    if (threadIdx.x < 4) ((volatile LAS unsigned*)(lds + LDS_BARST))[threadIdx.x] = 0u;
    __syncthreads();
    { KArgs a = kargs(); (void)xcd_barrier_post((unsigned*)(a->ws + WS_BAR), (volatile LAS unsigned*)(lds + LDS_BARST)); }
    { KArgs a = kargs(); unsigned char* ws = a->ws; const int bid = blockIdx.x, G = gridDim.x;
      ProArgs pa; pa.c = a->c; pa.c_ctx = a->c_ctx; pa.w_ada = a->w_ada; pa.b_ada = a->b_ada; pa.lbl = a->lbl; pa.w_in = a->w_in; pa.w_out = a->w_out; pa.wgu = a->wgu; pa.wd = a->wd; pa.rg_wa = a->rg_wa; pa.rg_wx = a->rg_wx; pa.rg_lam = a->rg_lam;
      pa.coef = WSP(float, WS_COEF); pa.WG_t = WSP(bf16_t, WS_WG); pa.mod = WSP(float, WS_MOD); pa.lb = WSP(float, WS_LB); pa.Win_t = WSP(bf16_t, WS_WIN); pa.Wout_t = WSP(bf16_t, WS_WOUT); pa.Wgu_t = WSP(fp8_t, WS_WGU); pa.Wd_t = WSP(fp8_t, WS_WD);
      phase_prologue(lds, pa, bid, G, true, 0, IT_IN + IT_OUT); }
    GRID_SYNC_CG();
    { KArgs a = kargs(); unsigned char* ws = a->ws; phase_norm1(a->x, a->ctx, a->norm1_w, WSP(float, WS_MOD), WSP(bf16_t, WS_H), blockIdx.x, gridDim.x); }
    GRID_SYNC();
    { KArgs a = kargs(); unsigned char* ws = a->ws; PolInProj P; P.A = WSP(bf16_t, WS_H); P.Bt = WSP(bf16_t, WS_WIN); P.O = WSP(bf16_t, WS_PROJ); P.ord.init(NROWS / BM, INW / BM, gridDim.x, blockIdx.x); gemm_phase(lds, P); }
    GRID_SYNC();
    { KArgs a = kargs(); unsigned char* ws = a->ws;
      for (int it = blockIdx.x; it < NB * NCHK; it += gridDim.x)
          rg_item<1>(lds, WSP(bf16_t, WS_PROJ), a->conv_w, a->conv_b, WSP(bf16_t, WS_WG), a->rg_ba, a->rg_bx, WSP(float, WS_COEF), WSP(float, WS_AGG), nullptr, it / NCHK, it % NCHK); }
    __syncthreads();
    { KArgs a = kargs(); unsigned char* ws = a->ws;
      for (int item = blockIdx.x; item < 256; item += gridDim.x) phase_hgrn2_chunk(lds, WSP(bf16_t, WS_PROJ), WSP(float, WS_LB), WSP(bf16_t, WS_OF), WSP(bf16_t, WS_OB), item); }
    GRID_SYNC();
    { KArgs a = kargs(); unsigned char* ws = a->ws;
      for (int it = blockIdx.x; it < NB * (T / 64); it += gridDim.x)
          rg_item<2>(lds, WSP(bf16_t, WS_PROJ), a->conv_w, a->conv_b, WSP(bf16_t, WS_WG), a->rg_ba, a->rg_bx, WSP(float, WS_COEF), WSP(float, WS_AGG), WSP(bf16_t, WS_MIX2), it / (T / 64), CTXL / 64 + it % (T / 64)); }
    { KArgs a = kargs(); unsigned char* ws = a->ws; phase_mix_finish(WSP(bf16_t, WS_PROJ), WSP(bf16_t, WS_OF), WSP(bf16_t, WS_OB), a->hg_nw, WSP(bf16_t, WS_MIX2), blockIdx.x, gridDim.x); }
    GRID_SYNC();
    { KArgs a = kargs(); unsigned char* ws = a->ws; PolOutProj P; P.A = WSP(bf16_t, WS_MIX2); P.Bt = WSP(bf16_t, WS_WOUT); P.x = a->x; P.mod = WSP(float, WS_MOD); P.O = a->out; P.ord.init(NLAT / BM, D / BM, gridDim.x, blockIdx.x); gemm_phase(lds, P); }
    GRID_SYNC();
    { KArgs a = kargs(); unsigned char* ws = a->ws;
      phase_norm2_route(lds, a->out, a->norm2_w, WSP(float, WS_MOD), a->router_w, a->router_b, WSP(fp8_t, WS_H2), WSP(u32, WS_CTL), WSP(u32, WS_TOKTAB), WSP(float, WS_WTAB), blockIdx.x, gridDim.x); }
    __syncthreads();
    { KArgs a = kargs(); unsigned char* ws = a->ws;
      ProArgs pa; pa.c = nullptr; pa.c_ctx = nullptr; pa.w_ada = nullptr; pa.b_ada = nullptr; pa.lbl = nullptr; pa.w_in = nullptr; pa.w_out = nullptr; pa.wgu = a->wgu; pa.wd = a->wd; pa.rg_wa = nullptr; pa.rg_wx = nullptr; pa.rg_lam = nullptr; pa.coef = nullptr; pa.WG_t = nullptr;
      pa.mod = nullptr; pa.lb = nullptr; pa.Win_t = nullptr; pa.Wout_t = nullptr; pa.Wgu_t = WSP(fp8_t, WS_WGU); pa.Wd_t = WSP(fp8_t, WS_WD);
      phase_prologue(lds, pa, blockIdx.x, gridDim.x, false, IT_IN + IT_OUT, IT_ALL); }
    GRID_SYNC();
#pragma unroll 1
    for (int half = 0; half < NHALF; ++half) {
        { KArgs a = kargs(); unsigned char* ws = a->ws; LAS int* tstart = (LAS int*)(lds + LDS_AUX);
          const int tot = moe_tile_table(tstart, WSP(u32, WS_CTL), half);
          PolGateUp P; P.A = WSP(fp8_t, WS_H2); P.Bt = WSP(fp8_t, WS_WGU); P.bgu = a->bgu; P.toktab = WSP(u32, WS_TOKTAB); P.O = WSP(fp8_t, WS_ACT); P.mt.tstart = tstart; P.mt.cnt = WSP(u32, WS_CTL); P.mt.half = half;
          P.ord.init(tot, DFF / HALFT, gridDim.x, blockIdx.x);
          gemm_phase(lds, P); }
        GRID_SYNC();
        { KArgs a = kargs(); unsigned char* ws = a->ws; LAS int* tstart = (LAS int*)(lds + LDS_AUX);
          const int tot = moe_tile_table(tstart, WSP(u32, WS_CTL), half);
          PolDown P; P.A = WSP(fp8_t, WS_ACT); P.Bt = WSP(fp8_t, WS_WD); P.bd = a->bd; P.toktab = WSP(u32, WS_TOKTAB); P.wtab = WSP(float, WS_WTAB); P.O = WSP(bf16_t, WS_Y); P.mt.tstart = tstart; P.mt.cnt = WSP(u32, WS_CTL); P.mt.half = half;
          P.ord.init(tot, D / BM, gridDim.x, blockIdx.x);
          gemm_phase(lds, P); }
        GRID_SYNC();
        { KArgs a = kargs(); unsigned char* ws = a->ws; phase_combine(a->out, WSP(bf16_t, WS_Y), WSP(float, WS_MOD), a->final_w, half, blockIdx.x, gridDim.x); }
        __syncthreads();
    }
}

extern "C" void kernel_launch(void* const* d_in, const int* in_sizes, int n_in, void* d_out, int out_size, void* d_ws, size_t ws_size, hipStream_t stream) {
    static int grid_blocks = 0;
    if (!grid_blocks) {
        int dev = 0, cus = 0, per_cu = 0;
        (void)hipGetDevice(&dev);
        (void)hipDeviceGetAttribute(&cus, hipDeviceAttributeMultiprocessorCount, dev);
        (void)hipFuncSetAttribute((const void*)k_mega, hipFuncAttributeMaxDynamicSharedMemorySize, LDS_BYTES);
        (void)hipOccupancyMaxActiveBlocksPerMultiprocessor(&per_cu, (const void*)k_mega, 512, LDS_BYTES);
        if (per_cu < 1) { fprintf(stderr, "kernel_launch: occupancy query says %d blocks/CU\n", per_cu); per_cu = 1; }
        grid_blocks = cus * 1;
    }
    if (ws_size < 1024 * MiB) { fprintf(stderr, "kernel_launch: workspace too small (%zu)\n", ws_size); return; }
    MegaArgs a{};
    const float** ap = (const float**)&a;
    for (int i = 0; i < 26; ++i) ap[i] = (const float*)d_in[i];
    a.out = (float*)d_out; a.ws = (unsigned char*)d_ws;
    (void)hipMemsetAsync((unsigned char*)d_ws + WS_CTL, 0, 32768, stream);
    void* args[] = {&a};
    hipError_t e = hipLaunchCooperativeKernel((const void*)k_mega, dim3(grid_blocks), dim3(512), args, LDS_BYTES, stream);
    if (e != hipSuccess) fprintf(stderr, "cooperative launch failed: %s (grid %d)\n", hipGetErrorString(e), grid_blocks);
}
```

```cpp
#include <hip/hip_runtime.h>
#include <hip/hip_cooperative_groups.h>
#include <cstdio>
#include <cstdint>

typedef unsigned short bf16_t;
typedef unsigned int u32;
namespace cg = cooperative_groups;

constexpr int D = 1024, NB = 32, T = 2048, CTXL = 256, GRIDW = 64, GROWS = T / GRIDW;
constexpr int NLAT = NB * T;
constexpr int NCTX = NB * CTXL;
constexpr int NROWS = NLAT + NCTX;
constexpr int HGW = 512, RGW = 512, INW = 3584;
constexpr int C_Q = 0, C_I = 512, C_FF = 1024, C_FB = 1536, C_G = 2048, C_RX = 2560, C_RG = 3072;
constexpr int NE = 32, TOPK = 4, DFF = 1024;
constexpr int NHALF = 1;
constexpr int HALF_TOK = NLAT / NHALF;
constexpr int CAP = HALF_TOK;
constexpr int MAXSLOT = HALF_TOK * TOPK + NE * 256;
constexpr float EPS = 1e-6f;

constexpr size_t MiB = 1u << 20;
constexpr size_t WS_CTL = 0;
constexpr size_t WS_MOD = 1 * MiB;
constexpr size_t WS_LB = WS_MOD + 33 * 6144 * 4;
constexpr size_t WS_TOKTAB = 2 * MiB;
constexpr size_t WS_WTAB = 10 * MiB;
constexpr size_t WS_SCR = 28 * MiB;
constexpr size_t WS_OF = 28 * MiB, WS_OB = 92 * MiB, WS_HF = 156 * MiB, WS_HB = 220 * MiB;
constexpr size_t WS_WIN = 18 * MiB, WS_WOUT = 25 * MiB;
constexpr size_t WS_WG = 64 * 1024;
constexpr size_t WS_COEF = WS_LB + 4096;
constexpr size_t WS_AGG = 932 * MiB;
constexpr size_t WS_WGU = 92 * MiB, WS_WD = 156 * MiB;
constexpr size_t WS_H = 284 * MiB;
constexpr size_t WS_PROJ = 428 * MiB;
constexpr size_t WS_ACT = 188 * MiB;
constexpr size_t WS_Y = 452 * MiB;
constexpr size_t WS_X1 = 708 * MiB;
constexpr float SC_Y = 16.0f;

constexpr size_t WS_MIX2 = WS_H;
constexpr size_t WS_H2 = 28 * MiB;

__device__ __forceinline__ float bf2f(bf16_t b) { return __uint_as_float(((u32)b) << 16); }
__device__ __forceinline__ bf16_t f2bf(float f) { u32 u = __float_as_uint(f); u += 0x7fffu + ((u >> 16) & 1u); return (bf16_t)(u >> 16); }
__device__ __forceinline__ u32 pk2(float lo, float hi) { return (u32)f2bf(lo) | ((u32)f2bf(hi) << 16); }
__device__ __forceinline__ float fexp(float x) { return __builtin_amdgcn_exp2f(x * 1.4426950408889634f); }
__device__ __forceinline__ float frcp(float x) { return __builtin_amdgcn_rcpf(x); }
__device__ __forceinline__ float flog(float x) { return __builtin_amdgcn_logf(x) * 0.6931471805599453f; }
__device__ __forceinline__ float fsqrt(float x) { return __builtin_amdgcn_sqrtf(x); }
__device__ __forceinline__ float sigmoidf_(float x) { return frcp(1.0f + fexp(-x)); }
__device__ __forceinline__ float wave_sum(float v) {
#pragma unroll
    for (int o = 1; o < 64; o <<= 1) v += __shfl_xor(v, o);
    return v;
}

__device__ __forceinline__ float gelu_tanh(float x) { const float u = 1.5957691216057308f * (x + 0.044715f * x * x * x); return x * sigmoidf_(u); }
#define LAS __attribute__((address_space(3)))
typedef short bf16x8 __attribute__((ext_vector_type(8)));
typedef float f32x4 __attribute__((ext_vector_type(4)));
typedef unsigned u32x4 __attribute__((ext_vector_type(4)));
typedef int v8i __attribute__((ext_vector_type(8)));
typedef int v4i_ __attribute__((ext_vector_type(4)));
typedef unsigned u32x2 __attribute__((ext_vector_type(2)));
typedef unsigned char fp8_t;
constexpr float SC_H2 = 16.0f, SC_W = 32.0f, SC_ACT = 4.0f;
__device__ __forceinline__ unsigned pk4_fp8(float a, float b, float c, float d) {
    a = fminf(fmaxf(a, -448.f), 448.f); b = fminf(fmaxf(b, -448.f), 448.f); c = fminf(fmaxf(c, -448.f), 448.f); d = fminf(fmaxf(d, -448.f), 448.f);
    int r = 0; r = __builtin_amdgcn_cvt_pk_fp8_f32(a, b, r, false); r = __builtin_amdgcn_cvt_pk_fp8_f32(c, d, r, true); return (unsigned)r; }
constexpr int BM = 256, BK = 64, HALFT = 128, HTB = HALFT * BK * 2, STAGE_BYTES = 8 * HTB, NXCD = 8, WGM = 8;
constexpr int GK = 1024;
constexpr int LDS_BYTES = 147456;
constexpr int LDS_AUX = STAGE_BYTES;

__device__ __forceinline__ int lds_byte(int r, int c) { const int st = (r >> 4) * 2 + (c >> 5), rr = r & 15, cc = c & 31, ob = rr * 64 + cc * 2; return st * 1024 + (ob ^ (((ob >> 9) & 1) << 5)); }
__device__ __forceinline__ void stage_rc(int b, int& R, int& C) { const int st = b / 1024, sb = b % 1024, swz = sb ^ (((sb >> 9) & 1) << 5); R = (st >> 1) * 16 + swz / 64; C = (st & 1) * 32 + (swz % 64) / 2; }
__device__ __forceinline__ int perm32(int rho) { const int n = rho >> 4, i = rho & 15; return 8 * (i >> 2) + 4 * n + (i & 3); }
__device__ __forceinline__ unsigned cvt_pk_bf16(float lo, float hi) { unsigned r; asm volatile("v_cvt_pk_bf16_f32 %0, %1, %2" : "=v"(r) : "v"(lo), "v"(hi)); return r; }

struct Unit { int pm, pn, e, pos0, cn; };
struct TileOrder {
    int nM, nN, nwg, G, c;
    __device__ __forceinline__ void init(int nM_, int nN_, int G_, int c_) { nM = nM_; nN = nN_; nwg = nM * nN; G = G_; c = c_; }
    __device__ __forceinline__ bool tile(int i, int& pm, int& pn) const {
        const long L = (long)i * G + c; if (L >= nwg) return false;
        int wgid = (int)L; { const int q = nwg / NXCD, r = nwg % NXCD, xcd = wgid % NXCD, off = wgid / NXCD; wgid = (xcd < r ? xcd * (q + 1) : r * (q + 1) + (xcd - r) * q) + off; }
        const int nig = WGM * nN, gid = wgid / nig, fm = gid * WGM, gsz = (nM - fm) < WGM ? (nM - fm) : WGM;
        pm = fm + ((wgid % nig) % gsz); pn = (wgid % nig) / gsz; return true;
    }
};

template <class POL>
__device__ __forceinline__ void gemm_phase(LAS unsigned char* lds, const POL& P) {
    int tid_ = threadIdx.x; asm volatile("" : "+v"(tid_));
    const int tid = tid_, wid = __builtin_amdgcn_readfirstlane(tid >> 6), lane = tid & 63, wr = wid >> 2, wc = wid & 3, fr = lane & 15, fq = lane >> 4;
    constexpr int KB = POL::FP8 ? 1024 : 2048, nt = KB / 128;
    int sR[2], sC[2]; unsigned voffA[2], voffB[2];
#pragma unroll
    for (int i = 0; i < 2; ++i) { stage_rc(tid * 16 + i * 8192, sR[i], sC[i]); const int Rb = POL::PERM ? ((sR[i] & ~31) + perm32(sR[i] & 31)) : sR[i]; voffA[i] = (unsigned)(sR[i] * KB + sC[i] * 2); voffB[i] = (unsigned)(Rb * KB + sC[i] * 2); }
    constexpr size_t kstep = (size_t)(BK * 2);
    constexpr unsigned hstepB = (unsigned)HALFT * KB;
    const unsigned ldsw = (unsigned)wid * 1024u;
    const int aoff = POL::FP8 ? lds_byte(wr * 64 + fr, fq * 16) : lds_byte(wr * 64 + fr, fq * 8), boff = POL::FP8 ? lds_byte(wc * 32 + fr, fq * 16) : lds_byte(wc * 32 + fr, fq * 8);
#define G_SA(b, h) (((b) * 2 + (h)) * HTB)
#define G_SB(b, h) ((4 + (b) * 2 + (h)) * HTB)
#define G_AOFF(OFF, h, i) (POL::GATHER ? (OFF)[h][i] : voffA[i])
#define G_STAGE_A(bufoff, gbase, OFF, h) do { const char* _gb = (const char*)(gbase) + (POL::GATHER ? (size_t)0 : (size_t)(h) * hstepB); _Pragma("unroll") for (int _i = 0; _i < 2; ++_i) \
        __builtin_amdgcn_global_load_lds((const unsigned*)(_gb + G_AOFF(OFF, h, _i)), (LAS unsigned*)(lds + (bufoff) + ldsw + _i * 8192), 16, 0, 0); } while (0)
#define G_STAGE_B(bufoff, gbase, hoff) do { const char* _gb = (const char*)(gbase) + (size_t)(hoff); _Pragma("unroll") for (int _i = 0; _i < 2; ++_i) \
        __builtin_amdgcn_global_load_lds((const unsigned*)(_gb + voffB[_i]), (LAS unsigned*)(lds + (bufoff) + ldsw + _i * 8192), 16, 0, 0); } while (0)
#define G_LD8(p) __builtin_shufflevector(*(const LAS v4i_*)(p), *(const LAS v4i_*)((p) + 16), 0, 1, 2, 3, 4, 5, 6, 7)
#define G_LDA(dst, b, h) do { if (POL::FP8) { _Pragma("unroll") for (int m = 0; m < 4; ++m) dst##8[m] = G_LD8(lds + G_SA(b, h) + aoff + m * 2048); } \
        else { _Pragma("unroll") for (int m = 0; m < 4; ++m) _Pragma("unroll") for (int k = 0; k < 2; ++k) dst[m][k] = *(const LAS bf16x8*)(lds + G_SA(b, h) + aoff + m * 2048 + k * 1024); } } while (0)
#define G_LDB(dst, b, h) do { if (POL::FP8) { _Pragma("unroll") for (int n = 0; n < 2; ++n) dst##8[n] = G_LD8(lds + G_SB(b, h) + boff + n * 2048); } \
        else { _Pragma("unroll") for (int n = 0; n < 2; ++n) _Pragma("unroll") for (int k = 0; k < 2; ++k) dst[n][k] = *(const LAS bf16x8*)(lds + G_SB(b, h) + boff + n * 2048 + k * 1024); } } while (0)
#define G_MMA(ai, bj, At, Bt) do { __builtin_amdgcn_s_setprio(1); \
        if (POL::FP8) { _Pragma("unroll") for (int m = 0; m < 4; ++m) _Pragma("unroll") for (int n = 0; n < 2; ++n) \
            asm volatile("v_mfma_scale_f32_16x16x128_f8f6f4 %0, %1, %2, %0, %3, %3 op_sel_hi:[0,0,0]" : "+v"(acc[ai][bj][m][n]) : "v"(Bt##8[n]), "v"(At##8[m]), "v"(mxs)); } \
        else { _Pragma("unroll") for (int m = 0; m < 4; ++m) _Pragma("unroll") for (int n = 0; n < 2; ++n) _Pragma("unroll") for (int k = 0; k < 2; ++k) \
            acc[ai][bj][m][n] = __builtin_amdgcn_mfma_f32_16x16x32_bf16(Bt[n][k], At[m][k], acc[ai][bj][m][n], 0, 0, 0); } \
        __builtin_amdgcn_s_setprio(0); } while (0)
#define G_WAIT_V(n) asm volatile("s_waitcnt vmcnt(" #n ")" ::: "memory")
#define G_WAIT_L(n) asm volatile("s_waitcnt lgkmcnt(" #n ")" ::: "memory")
#define G_BAR __builtin_amdgcn_s_barrier()
#define G_SCHED __builtin_amdgcn_sched_barrier(0)
#define G_TRIP(A1, OC, A2, ON, B2) do { \
        G_LDB(B0, 0, 0); G_SCHED; G_LDA(At, 0, 0); G_STAGE_A(G_SA(1, 1), A1, OC, 1); \
        G_WAIT_L(8); G_BAR; G_WAIT_L(0); G_MMA(0, 0, At, B0); G_BAR; G_SCHED; \
        G_LDB(B1, 0, 1); G_STAGE_B(G_SB(0, 0), B2, 0u); \
        G_BAR; G_WAIT_L(0); G_MMA(0, 1, At, B1); G_BAR; \
        G_LDA(At, 0, 1); G_STAGE_A(G_SA(0, 0), A2, ON, 0); \
        G_BAR; G_WAIT_L(0); G_MMA(1, 0, At, B0); G_BAR; G_SCHED; \
        G_STAGE_B(G_SB(0, 1), B2, hstepB); \
        G_WAIT_V(6); G_BAR; G_MMA(1, 1, At, B1); G_BAR; \
        G_LDB(B0, 1, 0); G_SCHED; G_LDA(At, 1, 0); G_STAGE_A(G_SA(0, 1), A2, ON, 1); \
        G_WAIT_L(8); G_BAR; G_WAIT_L(0); G_MMA(0, 0, At, B0); G_BAR; G_SCHED; \
        G_LDB(B1, 1, 1); G_STAGE_B(G_SB(1, 0), (B2) + kstep, 0u); \
        G_BAR; G_WAIT_L(0); G_MMA(0, 1, At, B1); G_BAR; \
        G_LDA(At, 1, 1); G_STAGE_A(G_SA(1, 0), (A2) + kstep, ON, 0); \
        G_BAR; G_WAIT_L(0); G_MMA(1, 0, At, B0); G_BAR; G_SCHED; \
        G_STAGE_B(G_SB(1, 1), (B2) + kstep, hstepB); \
        G_WAIT_V(6); G_BAR; G_MMA(1, 1, At, B1); G_BAR; } while (0)
    Unit cur, nxt; int ui = 0;
    if (!P.next(0, cur)) return;
    f32x4 acc[2][2][4][2];
#pragma unroll
    for (int a = 0; a < 2; ++a)
#pragma unroll
        for (int b = 0; b < 2; ++b)
#pragma unroll
            for (int m = 0; m < 4; ++m)
#pragma unroll
                for (int n = 0; n < 2; ++n) acc[a][b][m][n] = (f32x4){0.f, 0.f, 0.f, 0.f};
    const int mxs = 0x7f7f7f7f;
    bf16x8 At[4][2], B0[2][2], B1[2][2]; v8i At8[4], B08[2], B18[2];
    unsigned oc[2][2], on[2][2];
#pragma unroll
    for (int h = 0; h < 2; ++h)
#pragma unroll
        for (int i = 0; i < 2; ++i) { oc[h][i] = POL::GATHER ? P.a_off(cur, h * HALFT + sR[i]) + (unsigned)sC[i] * 2u : 0u; on[h][i] = 0u; }
    const char* cA = P.a_base(cur); const char* cB = P.b_base(cur);
    G_STAGE_B(G_SB(0, 0), cB, 0u); G_STAGE_A(G_SA(0, 0), cA, oc, 0); G_STAGE_B(G_SB(0, 1), cB, hstepB); G_STAGE_A(G_SA(0, 1), cA, oc, 1);
    if (wr == 1) G_BAR;
    G_WAIT_V(4); G_BAR;
    G_STAGE_B(G_SB(1, 0), cB + kstep, 0u); G_STAGE_A(G_SA(1, 0), cA + kstep, oc, 0); G_STAGE_B(G_SB(1, 1), cB + kstep, hstepB);
    G_WAIT_V(6); G_BAR;
    for (;;) {
        const bool has_next = P.next(ui + 1, nxt);
        const char* nA = has_next ? P.a_base(nxt) : cA; const char* nB = has_next ? P.b_base(nxt) : cB;
        if (POL::GATHER) {
#pragma unroll
            for (int h = 0; h < 2; ++h)
#pragma unroll
                for (int i = 0; i < 2; ++i) on[h][i] = has_next ? P.a_off(nxt, h * HALFT + sR[i]) + (unsigned)sC[i] * 2u : oc[h][i];
        }
#pragma unroll 1
        for (int t = 0; t < nt; t += 2) {
            const bool last = (t == nt - 2);
            const char* a1 = cA + (size_t)(t + 1) * kstep; const char* a2 = last ? nA : cA + (size_t)(t + 2) * kstep; const char* b2 = last ? nB : cB + (size_t)(t + 2) * kstep;
            if (POL::GATHER) {
                unsigned os[2][2];
#pragma unroll
                for (int h = 0; h < 2; ++h)
#pragma unroll
                    for (int i = 0; i < 2; ++i) os[h][i] = last ? on[h][i] : oc[h][i];
                G_TRIP(a1, oc, a2, os, b2);
            } else { G_TRIP(a1, oc, a2, oc, b2); }
        }
        if (POL::FP8) asm volatile("s_nop 15\n\ts_nop 15" ::: "memory");
        if (wr == 0) G_BAR;
        P.epi(acc, cur, wr, wc, fr, fq);
        if (!has_next) break;
#pragma unroll
        for (int a = 0; a < 2; ++a)
#pragma unroll
            for (int b = 0; b < 2; ++b)
#pragma unroll
                for (int m = 0; m < 4; ++m)
#pragma unroll
                    for (int n = 0; n < 2; ++n) acc[a][b][m][n] = (f32x4){0.f, 0.f, 0.f, 0.f};
        cur = nxt; cA = nA; cB = nB; ++ui;
        if (POL::GATHER) {
#pragma unroll
            for (int h = 0; h < 2; ++h)
#pragma unroll
                for (int i = 0; i < 2; ++i) oc[h][i] = on[h][i];
        }
        if (wr == 1) G_BAR;
    }
    G_WAIT_V(0);
    G_BAR;
#undef G_SA
#undef G_SB
#undef G_AOFF
#undef G_STAGE_A
#undef G_STAGE_B
#undef G_LDA
#undef G_LDB
#undef G_MMA
#undef G_LD8
#undef G_WAIT_V
#undef G_WAIT_L
#undef G_BAR
#undef G_SCHED
#undef G_TRIP
}

struct PolInProj {
    static constexpr bool PERM = true, GATHER = false, FP8 = false;
    const bf16_t* A; const bf16_t* Bt; bf16_t* O; TileOrder ord;
    __device__ __forceinline__ bool next(int i, Unit& u) const { return ord.tile(i, u.pm, u.pn); }
    __device__ __forceinline__ const char* a_base(const Unit& u) const { return (const char*)A + (size_t)u.pm * BM * GK * 2; }
    __device__ __forceinline__ unsigned a_off(const Unit&, int r) const { return (unsigned)r * GK * 2u; }
    __device__ __forceinline__ const char* b_base(const Unit& u) const { return (const char*)Bt + (size_t)u.pn * BM * GK * 2; }
    __device__ __forceinline__ void epi(const f32x4 (&acc)[2][2][4][2], const Unit& u, int wr, int wc, int fr, int fq) const {
        const int row0 = u.pm * BM + wr * 64 + fr, col0 = u.pn * BM + wc * 32 + 8 * fq;
#pragma unroll
        for (int ai = 0; ai < 2; ++ai)
#pragma unroll
            for (int m = 0; m < 4; ++m) { bf16_t* rowp = O + (size_t)(row0 + ai * HALFT + m * 16) * INW + col0;
#pragma unroll
                for (int bj = 0; bj < 2; ++bj) { const f32x4 v0 = acc[ai][bj][m][0], v1 = acc[ai][bj][m][1];
                    u32x4 w; w.x = cvt_pk_bf16(v0[0], v0[1]); w.y = cvt_pk_bf16(v0[2], v0[3]); w.z = cvt_pk_bf16(v1[0], v1[1]); w.w = cvt_pk_bf16(v1[2], v1[3]);
                    *(u32x4*)(rowp + bj * HALFT) = w; } }
    }
};
struct PolOutProj {
    static constexpr bool PERM = true, GATHER = false, FP8 = false;
    const bf16_t* A; const bf16_t* Bt; const float* x; const float* mod; bf16_t* O; TileOrder ord;
    __device__ __forceinline__ bool next(int i, Unit& u) const { return ord.tile(i, u.pm, u.pn); }
    __device__ __forceinline__ const char* a_base(const Unit& u) const { return (const char*)A + (size_t)u.pm * BM * GK * 2; }
    __device__ __forceinline__ unsigned a_off(const Unit&, int r) const { return (unsigned)r * GK * 2u; }
    __device__ __forceinline__ const char* b_base(const Unit& u) const { return (const char*)Bt + (size_t)u.pn * BM * GK * 2; }
    __device__ __forceinline__ void epi(const f32x4 (&acc)[2][2][4][2], const Unit& u, int wr, int wc, int fr, int fq) const {
        const int row0 = u.pm * BM + wr * 64 + fr, col0 = u.pn * BM + wc * 32 + 8 * fq;
        const float* g1 = mod + (size_t)((u.pm * BM) >> 11) * 6144 + 2048 + col0;
        f32x4 gv[2][2];
#pragma unroll
        for (int bj = 0; bj < 2; ++bj) { gv[bj][0] = *(const f32x4*)(g1 + bj * HALFT); gv[bj][1] = *(const f32x4*)(g1 + bj * HALFT + 4); }
#pragma unroll
        for (int ai = 0; ai < 2; ++ai)
#pragma unroll
            for (int m = 0; m < 4; ++m) { const size_t off = (size_t)(row0 + ai * HALFT + m * 16) * D + col0;
#pragma unroll
                for (int bj = 0; bj < 2; ++bj) {
                    const f32x4 x0 = __builtin_nontemporal_load((const f32x4*)(x + off + bj * HALFT)), x1v = __builtin_nontemporal_load((const f32x4*)(x + off + bj * HALFT + 4));
                    const f32x4 v0 = x0 + gv[bj][0] * acc[ai][bj][m][0], v1 = x1v + gv[bj][1] * acc[ai][bj][m][1];
                    u32x4 w; w.x = cvt_pk_bf16(v0[0], v0[1]); w.y = cvt_pk_bf16(v0[2], v0[3]); w.z = cvt_pk_bf16(v1[0], v1[1]); w.w = cvt_pk_bf16(v1[2], v1[3]);
                    *(u32x4*)(O + off + bj * HALFT) = w; }
                asm volatile("" ::: "memory"); }
    }
};
struct MoeTiles {
    const LAS int* tstart; const u32* cnt; int half;
    __device__ __forceinline__ void find(Unit& u) const {
        const int e = __builtin_amdgcn_readfirstlane(tstart[64 + u.pm]);
        u.e = e; u.pos0 = (u.pm - __builtin_amdgcn_readfirstlane(tstart[e])) * BM; u.cn = (int)cnt[half * NE + e];
    }
};
struct PolGateUp {
    static constexpr bool PERM = true, GATHER = true, FP8 = true;
    const fp8_t* A; const fp8_t* Bt; const float* bgu; const u32* toktab; fp8_t* O; MoeTiles mt; TileOrder ord;
    __device__ __forceinline__ bool next(int i, Unit& u) const { if (!ord.tile(i, u.pm, u.pn)) return false; mt.find(u); return true; }
    __device__ __forceinline__ const char* a_base(const Unit&) const { return (const char*)A; }
    __device__ __forceinline__ unsigned a_off(const Unit& u, int r) const {
        const int p = u.pos0 + r; const u32 tk = toktab[((size_t)mt.half * NE + u.e) * CAP + (p < u.cn ? p : 0)];
        return (tk >> 2) * 1024u;
    }
    __device__ __forceinline__ const char* b_base(const Unit& u) const { return (const char*)Bt + ((size_t)u.e * 2048 + (size_t)u.pn * BM) * 1024; }
    __device__ __forceinline__ void epi(const f32x4 (&acc)[2][2][4][2], const Unit& u, int wr, int wc, int fr, int fq) const {
        const int row0 = u.pm * BM + wr * 64 + fr, cc = u.pn * HALFT + wc * 32 + 8 * fq;
        const float* bg = bgu + (size_t)u.e * 2048 + cc;
        const f32x4 bg0 = *(const f32x4*)bg, bg1 = *(const f32x4*)(bg + 4), bu0 = *(const f32x4*)(bg + 1024), bu1 = *(const f32x4*)(bg + 1028);
        constexpr float inv = 1.0f / (SC_H2 * SC_W);
#pragma unroll
        for (int ai = 0; ai < 2; ++ai)
#pragma unroll
            for (int m = 0; m < 4; ++m) {
                f32x4 g0 = acc[ai][0][m][0] * inv + bg0, g1 = acc[ai][0][m][1] * inv + bg1, u0 = acc[ai][1][m][0] * inv + bu0, u1 = acc[ai][1][m][1] * inv + bu1;
                float o[8];
#pragma unroll
                for (int j = 0; j < 4; ++j) {
                    const float ga = fminf(g0[j], 7.0f), gb = fminf(g1[j], 7.0f);
                    const float ua = fminf(fmaxf(u0[j], -7.0f), 7.0f), ub = fminf(fmaxf(u1[j], -7.0f), 7.0f);
                    o[j] = ga * sigmoidf_(1.702f * ga) * (ua + 1.0f) * SC_ACT; o[4 + j] = gb * sigmoidf_(1.702f * gb) * (ub + 1.0f) * SC_ACT;
                }
                uint2 w; w.x = pk4_fp8(o[0], o[1], o[2], o[3]); w.y = pk4_fp8(o[4], o[5], o[6], o[7]);
                *(uint2*)(O + (size_t)(row0 + ai * HALFT + m * 16) * DFF + cc) = w;
                asm volatile("" ::: "memory");
            }
    }
};
struct PolDown {
    static constexpr bool PERM = true, GATHER = false, FP8 = true;
    const fp8_t* A; const fp8_t* Bt; const float* bd; const u32* toktab; const float* wtab; fp8_t* O; MoeTiles mt; TileOrder ord;
    __device__ __forceinline__ bool next(int i, Unit& u) const { if (!ord.tile(i, u.pm, u.pn)) return false; mt.find(u); return true; }
    __device__ __forceinline__ const char* a_base(const Unit& u) const { return (const char*)A + (size_t)u.pm * BM * 1024; }
    __device__ __forceinline__ unsigned a_off(const Unit&, int r) const { return (unsigned)r * 1024u; }
    __device__ __forceinline__ const char* b_base(const Unit& u) const { return (const char*)Bt + ((size_t)u.e * 1024 + (size_t)u.pn * BM) * 1024; }
    __device__ __forceinline__ void epi(const f32x4 (&acc)[2][2][4][2], const Unit& u, int wr, int wc, int fr, int fq) const {
        const int col0 = u.pn * BM + wc * 32 + 8 * fq;
        const float* bp = bd + (size_t)u.e * D + col0;
        f32x4 bv[2][2];
#pragma unroll
        for (int bj = 0; bj < 2; ++bj) { bv[bj][0] = *(const f32x4*)(bp + bj * HALFT); bv[bj][1] = *(const f32x4*)(bp + bj * HALFT + 4); }
        const size_t tb = ((size_t)mt.half * NE + u.e) * CAP;
        constexpr float inv = 1.0f / (SC_ACT * SC_W);
#pragma unroll
        for (int ai = 0; ai < 2; ++ai)
#pragma unroll
            for (int m = 0; m < 4; ++m) {
                asm volatile("" ::: "memory");
                const int p = u.pos0 + ai * HALFT + wr * 64 + m * 16 + fr;
                if (p < u.cn) {
                    const u32 tk = toktab[tb + p]; const float wg = wtab[tb + p] * SC_Y;
                    fp8_t* rowp = O + (size_t)(tk - (u32)mt.half * HALF_TOK * 4u) * D + col0;
#pragma unroll
                    for (int bj = 0; bj < 2; ++bj) { const f32x4 v0 = (acc[ai][bj][m][0] * inv + bv[bj][0]) * wg, v1 = (acc[ai][bj][m][1] * inv + bv[bj][1]) * wg;
                        uint2 w; w.x = pk4_fp8(v0[0], v0[1], v0[2], v0[3]); w.y = pk4_fp8(v1[0], v1[1], v1[2], v1[3]);
                        *(uint2*)(rowp + bj * HALFT) = w; }
                }
            }
    }
};
__device__ __forceinline__ int moe_tile_table(LAS int* tstart, const u32* cnt, int half) {
    __syncthreads();
    if (threadIdx.x == 0) { int s = 0; for (int e = 0; e < NE; ++e) { tstart[e] = s; s += ((int)cnt[half * NE + e] + BM - 1) / BM; } tstart[NE] = s; }
    __syncthreads();
    const int tot = tstart[NE];
    for (int t = threadIdx.x; t < tot; t += 512) { int e = 0;
#pragma unroll 1
        for (int i = 1; i < NE; ++i) if (t >= tstart[i]) e = i;
        tstart[64 + t] = e; }
    __syncthreads();
    return tot;
}

__device__ __forceinline__ void conv_item(const float* __restrict__ W, int N, bf16_t* __restrict__ WT, int k0, int n0, size_t rowbase, LAS float* scr, int lane) {
#pragma unroll 4
    for (int i = 0; i < 16; ++i) { const int k = 4 * i + (lane >> 4); const f32x4 v = __builtin_nontemporal_load((const f32x4*)(W + (size_t)(k0 + k) * N + n0 + (lane & 15) * 4)); *(LAS f32x4*)(scr + k * 68 + (lane & 15) * 4) = v; }
    asm volatile("s_waitcnt lgkmcnt(0)" ::: "memory");
    const int c = lane & 7;
#pragma unroll
    for (int j = 0; j < 8; ++j) { const int n = (lane >> 3) + 8 * j; const LAS float* s = scr + (8 * c) * 68 + n;
        u32x4 o; o.x = cvt_pk_bf16(s[0 * 68], s[1 * 68]); o.y = cvt_pk_bf16(s[2 * 68], s[3 * 68]); o.z = cvt_pk_bf16(s[4 * 68], s[5 * 68]); o.w = cvt_pk_bf16(s[6 * 68], s[7 * 68]);
        *(u32x4*)(WT + (rowbase + n) * GK + k0 + 8 * c) = o; }
    asm volatile("s_waitcnt lgkmcnt(0)" ::: "memory");
}
__device__ __forceinline__ void conv_item8(const float* __restrict__ W, int N, fp8_t* __restrict__ WT, int k0, int n0, size_t rowbase, LAS float* scr, int lane) {
#pragma unroll 4
    for (int i = 0; i < 16; ++i) { const int k = 4 * i + (lane >> 4); const f32x4 v = __builtin_nontemporal_load((const f32x4*)(W + (size_t)(k0 + k) * N + n0 + (lane & 15) * 4)); *(LAS f32x4*)(scr + k * 68 + (lane & 15) * 4) = v; }
    asm volatile("s_waitcnt lgkmcnt(0)" ::: "memory");
    const LAS float* sp = scr + lane;
#pragma unroll
    for (int q = 0; q < 4; ++q) {
        u32x4 o;
        o.x = pk4_fp8(sp[(16 * q + 0) * 68] * SC_W, sp[(16 * q + 1) * 68] * SC_W, sp[(16 * q + 2) * 68] * SC_W, sp[(16 * q + 3) * 68] * SC_W);
        o.y = pk4_fp8(sp[(16 * q + 4) * 68] * SC_W, sp[(16 * q + 5) * 68] * SC_W, sp[(16 * q + 6) * 68] * SC_W, sp[(16 * q + 7) * 68] * SC_W);
        o.z = pk4_fp8(sp[(16 * q + 8) * 68] * SC_W, sp[(16 * q + 9) * 68] * SC_W, sp[(16 * q + 10) * 68] * SC_W, sp[(16 * q + 11) * 68] * SC_W);
        o.w = pk4_fp8(sp[(16 * q + 12) * 68] * SC_W, sp[(16 * q + 13) * 68] * SC_W, sp[(16 * q + 14) * 68] * SC_W, sp[(16 * q + 15) * 68] * SC_W);
        *(u32x4*)(WT + (rowbase + lane) * GK + k0 + 16 * q) = o;
    }
    asm volatile("s_waitcnt lgkmcnt(0)" ::: "memory");
}
constexpr int IT_IN = 16 * (INW / 64), IT_OUT = 16 * (D / 64), IT_GU = NE * 16 * 32, IT_D = NE * 16 * 16, IT_ALL = IT_IN + IT_OUT + IT_GU + IT_D;
struct ProArgs { const float *c, *c_ctx, *w_ada, *b_ada, *lbl, *w_in, *w_out, *wgu, *wd, *rg_wa, *rg_wx, *rg_lam; float *mod, *lb, *coef; bf16_t *Win_t, *Wout_t, *WG_t; fp8_t *Wgu_t, *Wd_t; };
__device__ __forceinline__ void phase_prologue(LAS unsigned char* lds, const ProArgs& a, int bid, int G, bool do_mod, int it_lo, int it_hi) {
    const int tid = threadIdx.x, lane = tid & 63, w = tid >> 6;
    if (!do_mod) {} else if (bid < 96) {
        LAS float* s = (LAS float*)lds;
        for (int i = tid; i < 33 * D; i += 512) { const int b = i >> 10, k = i & 1023; const float v = b < NB ? a.c[(size_t)b * D + k] : a.c_ctx[k]; s[i] = v * sigmoidf_(v); }
        __syncthreads();
        const int n = bid * 64 + lane;
        float acc[33];
#pragma unroll
        for (int b = 0; b < 33; ++b) acc[b] = 0.f;
#pragma unroll 1
        for (int k = 128 * w; k < 128 * w + 128; k += 16) {
            float wv[16];
#pragma unroll
            for (int i = 0; i < 16; ++i) wv[i] = __builtin_nontemporal_load(a.w_ada + (size_t)(k + i) * 6144 + n);
#pragma unroll
            for (int b = 0; b < 33; ++b)
#pragma unroll
                for (int i4 = 0; i4 < 4; ++i4) { const f32x4 sv = *(const LAS f32x4*)(s + b * D + k + 4 * i4); acc[b] += sv[0] * wv[4 * i4] + sv[1] * wv[4 * i4 + 1] + sv[2] * wv[4 * i4 + 2] + sv[3] * wv[4 * i4 + 3]; }
        }
        __syncthreads();
        LAS float* red = (LAS float*)lds;
#pragma unroll
        for (int b = 0; b < 33; ++b) red[(w * 33 + b) * 64 + lane] = acc[b];
        __syncthreads();
        for (int i = tid; i < 33 * 64; i += 512) { const int b = i >> 6, l = i & 63; float sum = a.b_ada[bid * 64 + l];
#pragma unroll
            for (int ww = 0; ww < 8; ++ww) sum += red[(ww * 33 + b) * 64 + l];
            a.mod[(size_t)b * 6144 + bid * 64 + l] = sum; }
        __syncthreads();
    } else if (bid == 96) {
        for (int i = tid; i < 2 * HGW; i += 512) { const float l0 = a.lbl[i], l1 = a.lbl[2 * HGW + i]; a.lb[i] = 1.0f / (1.0f + __expf(l1 - l0)); }
        for (int i = tid; i < 2 * RGW; i += 512) { const float l = a.rg_lam[i]; const float sp = (-l > 20.f) ? -l : log1pf(__expf(-l)); a.coef[i] = -8.0f * sp; }
    } else if (bid == 97) {
        for (int idx = tid; idx < 8 * 256 * 64; idx += 512) { const int hd = idx >> 14, n = (idx >> 6) & 255, kk = idx & 63, g = n >> 6, j = n & 63, d = g >> 1;
            const float* src = (g & 1) ? a.rg_wx : a.rg_wa; a.WG_t[idx] = f2bf(src[(((size_t)d * 8 + hd) * 64 + kk) * 64 + j]); }
    }
    LAS float* scr = (LAS float*)(lds + w * (64 * 68 * 4));
    const int gw = bid * 8 + w, NW = G * 8;
    for (int it = it_lo + gw; it < it_hi; it += NW) {
        int r = it;
        if (r < IT_IN) { const int kb = r / (INW / 64), nb = r % (INW / 64); conv_item(a.w_in, INW, a.Win_t, kb * 64, nb * 64, (size_t)nb * 64, scr, lane); continue; } r -= IT_IN;
        if (r < IT_OUT) { const int kb = r / 16, nb = r % 16; conv_item(a.w_out, D, a.Wout_t, kb * 64, nb * 64, (size_t)nb * 64, scr, lane); continue; } r -= IT_OUT;
        if (r < IT_GU) { const int e = r / 512, q = r % 512, kb = q / 32, nb = q % 32, n0 = nb * 64, bj = n0 >> 10, rem = n0 & 1023, pn = rem >> 7, cc0 = rem & 127;
            conv_item8(a.wgu + (size_t)e * D * 2048, 2048, a.Wgu_t, kb * 64, n0, (size_t)e * 2048 + pn * 256 + bj * 128 + cc0, scr, lane); continue; } r -= IT_GU;
        { const int e = r / 256, q = r % 256, kb = q / 16, nb = q % 16; conv_item8(a.wd + (size_t)e * DFF * D, D, a.Wd_t, kb * 64, nb * 64, (size_t)e * 1024 + nb * 64, scr, lane); }
    }
}


__device__ __forceinline__ void phase_norm1(const float* __restrict__ x, const float* __restrict__ ctx, const float* __restrict__ nw, const float* __restrict__ mod, bf16_t* __restrict__ H, int bid, int G) {
    constexpr int RB = 4;
    const int lane = threadIdx.x & 63, gw = bid * 8 + (threadIdx.x >> 6), NW = G * 8;
    for (int r0 = gw; r0 < NROWS; r0 += RB * NW) {
        f32x4 v[RB][4];
#pragma unroll
        for (int q = 0; q < RB; ++q) { const int r = r0 + q * NW; const int rr = r < NROWS ? r : r0;
            const float* src = rr < NLAT ? x + (size_t)rr * D : ctx + (size_t)(rr - NLAT) * D;
#pragma unroll
            for (int j = 0; j < 4; ++j) v[q][j] = __builtin_nontemporal_load((const f32x4*)(src + j * 256 + lane * 4)); }
#pragma unroll
        for (int q = 0; q < RB; ++q) { const int r = r0 + q * NW; if (r < NROWS) {
            const float* m = mod + (size_t)(r < NLAT ? (r >> 11) : NB) * 6144;
            float ss = 0.f;
#pragma unroll
            for (int j = 0; j < 4; ++j) ss += v[q][j][0] * v[q][j][0] + v[q][j][1] * v[q][j][1] + v[q][j][2] * v[q][j][2] + v[q][j][3] * v[q][j][3];
            const float rstd = __builtin_amdgcn_rsqf(wave_sum(ss) * (1.0f / D) + EPS);
#pragma unroll
            for (int j = 0; j < 4; ++j) {
                const int c0 = j * 256 + lane * 4;
                const f32x4 w = *(const f32x4*)(nw + c0), sh = *(const f32x4*)(m + c0), sc = *(const f32x4*)(m + 1024 + c0);
                const f32x4 o = v[q][j] * rstd * w * (sc + 1.0f) + sh;
                uint2 p; p.x = cvt_pk_bf16(o[0], o[1]); p.y = cvt_pk_bf16(o[2], o[3]);
                *(uint2*)(H + (size_t)r * D + c0) = p;
            } } }
    }
}

__device__ __forceinline__ void phase_hgrn2_simple(LAS unsigned char* lds, const bf16_t* __restrict__ P, const float* __restrict__ lb, bf16_t* __restrict__ OF, bf16_t* __restrict__ OB, int item) {
    LAS float* qs = (LAS float*)lds; LAS float* fs = qs + 32 * 128; LAS float* vs = fs + 32 * 128;
    const int b = item >> 3, h = (item >> 1) & 3, dir = item & 1;
    const int tid = threadIdx.x, w = tid >> 6, lane = tid & 63, vi = lane & 15, kg = lane >> 4, v = 16 * w + vi;
    bf16_t* OD = dir == 0 ? OF : OB;
    float S[32];
#pragma unroll
    for (int i = 0; i < 32; ++i) S[i] = 0.f;
    const int lt = tid >> 4, lc = (tid & 15) * 8;
    float lbv[8];
#pragma unroll
    for (int i = 0; i < 8; ++i) lbv[i] = lb[dir * HGW + h * 128 + lc + i];
    const int cf = dir == 0 ? C_FF : C_FB;
    for (int n0 = 0; n0 < CTXL + T; n0 += 32) {
        __syncthreads();
        {
            const int n = n0 + lt;
            size_t row;
            if (n < CTXL) row = (size_t)NLAT + b * CTXL + (dir == 0 ? n : CTXL - 1 - n);
            else row = (size_t)b * T + (dir == 0 ? (n - CTXL) : (T - 1 - (n - CTXL)));
            const bf16_t* pr = P + row * INW + h * 128 + lc;
            const uint4 qv = *(const uint4*)(pr + C_Q), iv = *(const uint4*)(pr + C_I), fv = *(const uint4*)(pr + cf);
            const u32 qa[4] = {qv.x, qv.y, qv.z, qv.w}, ia[4] = {iv.x, iv.y, iv.z, iv.w}, fa[4] = {fv.x, fv.y, fv.z, fv.w};
#pragma unroll
            for (int i = 0; i < 4; ++i) {
                const float q0 = __uint_as_float(qa[i] << 16), q1 = __uint_as_float(qa[i] & 0xffff0000u);
                const float f0 = __uint_as_float(fa[i] << 16), f1 = __uint_as_float(fa[i] & 0xffff0000u);
                qs[lt * 128 + lc + 2 * i] = q0 * sigmoidf_(q0); qs[lt * 128 + lc + 2 * i + 1] = q1 * sigmoidf_(q1);
                vs[lt * 128 + lc + 2 * i] = __uint_as_float(ia[i] << 16); vs[lt * 128 + lc + 2 * i + 1] = __uint_as_float(ia[i] & 0xffff0000u);
                fs[lt * 128 + lc + 2 * i] = lbv[2 * i] + (1.f - lbv[2 * i]) * sigmoidf_(f0);
                fs[lt * 128 + lc + 2 * i + 1] = lbv[2 * i + 1] + (1.f - lbv[2 * i + 1]) * sigmoidf_(f1);
            }
        }
        __syncthreads();
        for (int j = 0; j < 32; ++j) {
            const float vv = vs[j * 128 + v];
            float o = 0.f;
#pragma unroll
            for (int i4 = 0; i4 < 8; ++i4) {
                const f32x4 f4 = *(const LAS f32x4*)(fs + j * 128 + 32 * kg + 4 * i4), q4 = *(const LAS f32x4*)(qs + j * 128 + 32 * kg + 4 * i4);
#pragma unroll
                for (int e = 0; e < 4; ++e) { S[4 * i4 + e] = f4[e] * (S[4 * i4 + e] - vv) + vv; o += S[4 * i4 + e] * q4[e]; }
            }
            o += __shfl_xor(o, 16); o += __shfl_xor(o, 32);
            const int n = n0 + j;
            if (n >= CTXL && kg == 0) {
                const int tt = dir == 0 ? (n - CTXL) : (T - 1 - (n - CTXL));
                OD[((size_t)b * T + tt) * HGW + h * 128 + v] = f2bf(o);
            }
        }
    }
}

constexpr int HQ_QD = 0, HQ_KD = 17408, HQ_KET = 34816, HQ_VT = 53248, HQ_PM = 71680, HQ_OS = 80896, HQ_TOT = 98304, HQ_DEC = 100352;
__device__ __forceinline__ bf16x8 pack8(const f32x4& a, const f32x4& b) {
    u32x4 w; w.x = cvt_pk_bf16(a[0], a[1]); w.y = cvt_pk_bf16(a[2], a[3]); w.z = cvt_pk_bf16(b[0], b[1]); w.w = cvt_pk_bf16(b[2], b[3]);
    return __builtin_bit_cast(bf16x8, w);
}
__device__ __forceinline__ void phase_hgrn2_chunk(LAS unsigned char* lds, const bf16_t* __restrict__ P, const float* __restrict__ lb, bf16_t* __restrict__ OF, bf16_t* __restrict__ OB, int item) {
    const int b = item >> 3, h = (item >> 1) & 3, dir = item & 1;
    const int tid = threadIdx.x, w = __builtin_amdgcn_readfirstlane(tid >> 6), lane = tid & 63, l15 = lane & 15, G4 = lane >> 4;
    const int k = tid & 127, seg = tid >> 7;
    const int kslot = (k & ~31) | (((k >> 2) & 3) << 3) | (((k >> 4) & 1) << 2) | (k & 3);
    const float lbv = lb[dir * HGW + h * 128 + k];
    bf16_t* OD = dir ? OB : OF;
    const int cf = dir ? C_FB : C_FF;
    LAS float* TOT = (LAS float*)(lds + HQ_TOT); LAS float* DEC = (LAS float*)(lds + HQ_DEC);
    f32x4 S[8];
#pragma unroll
    for (int t = 0; t < 8; ++t) S[t] = (f32x4){0.f, 0.f, 0.f, 0.f};
    bf16_t rq[16], rv[16], rf[16];
#define HG_LOAD(nn) do { _Pragma("unroll") for (int i = 0; i < 16; ++i) { const int p = 64 * (nn) + 16 * seg + i; \
            const size_t row = p < CTXL ? (size_t)NLAT + b * CTXL + (dir ? CTXL - 1 - p : p) : (size_t)b * T + (dir ? T - 1 - (p - CTXL) : (p - CTXL)); \
            const bf16_t* pr = P + row * INW + h * 128 + k; rq[i] = pr[C_Q]; rv[i] = pr[C_I]; rf[i] = pr[cf]; } } while (0)
    HG_LOAD(0);
#pragma unroll 1
    for (int n = 0; n < (CTXL + T) / 64; ++n) {
        const bool lat = n >= CTXL / 64;
        float qv[16], vv[16], fv[16], cs[16];
#pragma unroll
        for (int i = 0; i < 16; ++i) { qv[i] = bf2f(rq[i]); vv[i] = bf2f(rv[i]); fv[i] = bf2f(rf[i]); }
        if (n + 1 < (CTXL + T) / 64) HG_LOAD(n + 1);
        float run = 0.f;
#pragma unroll
        for (int i = 0; i < 16; ++i) { const float f = lbv + (1.f - lbv) * sigmoidf_(fv[i]); fv[i] = f; run += flog(f); cs[i] = run; }
        __syncthreads();
        TOT[seg * 128 + k] = run;
        __syncthreads();
        const float t0 = TOT[k], t1 = TOT[128 + k], t2 = TOT[256 + k], t3 = TOT[384 + k];
        const float prefix = seg == 0 ? 0.f : seg == 1 ? t0 : seg == 2 ? t0 + t1 : t0 + t1 + t2;
        const float blast = (t0 + t1) + (t2 + t3);
        const float eb = fexp(blast);
        if (seg == 0) DEC[k] = eb;
        float ke[16];
#pragma unroll
        for (int i = 0; i < 16; ++i) {
            const float bc = prefix + cs[i], e = fexp(bc), kf = (1.f - fv[i]) * frcp(e);
            const int j = 16 * seg + i;
            *(LAS bf16_t*)(lds + HQ_QD + j * 272 + kslot * 2) = f2bf(qv[i] * sigmoidf_(qv[i]) * e);
            *(LAS bf16_t*)(lds + HQ_KD + j * 272 + kslot * 2) = f2bf(kf);
            ke[i] = kf * eb;
        }
        {
            u32x4 w0, w1;
            w0.x = cvt_pk_bf16(ke[0], ke[1]); w0.y = cvt_pk_bf16(ke[2], ke[3]); w0.z = cvt_pk_bf16(ke[4], ke[5]); w0.w = cvt_pk_bf16(ke[6], ke[7]);
            w1.x = cvt_pk_bf16(ke[8], ke[9]); w1.y = cvt_pk_bf16(ke[10], ke[11]); w1.z = cvt_pk_bf16(ke[12], ke[13]); w1.w = cvt_pk_bf16(ke[14], ke[15]);
            *(LAS u32x4*)(lds + HQ_KET + k * 144 + seg * 32) = w0; *(LAS u32x4*)(lds + HQ_KET + k * 144 + seg * 32 + 16) = w1;
            w0.x = cvt_pk_bf16(vv[0], vv[1]); w0.y = cvt_pk_bf16(vv[2], vv[3]); w0.z = cvt_pk_bf16(vv[4], vv[5]); w0.w = cvt_pk_bf16(vv[6], vv[7]);
            w1.x = cvt_pk_bf16(vv[8], vv[9]); w1.y = cvt_pk_bf16(vv[10], vv[11]); w1.z = cvt_pk_bf16(vv[12], vv[13]); w1.w = cvt_pk_bf16(vv[14], vv[15]);
            *(LAS u32x4*)(lds + HQ_VT + k * 144 + seg * 32) = w0; *(LAS u32x4*)(lds + HQ_VT + k * 144 + seg * 32 + 16) = w1;
        }
        __syncthreads();
        if (lat) {
            const int mt = w >> 1, ntp = w & 1;
            f32x4 pa[2] = {(f32x4){0.f, 0.f, 0.f, 0.f}, (f32x4){0.f, 0.f, 0.f, 0.f}};
#pragma unroll
            for (int s = 0; s < 4; ++s) {
                const bf16x8 a = *(const LAS bf16x8*)(lds + HQ_QD + (16 * mt + l15) * 272 + (32 * s + 8 * G4) * 2);
#pragma unroll
                for (int q = 0; q < 2; ++q) { const bf16x8 bq = *(const LAS bf16x8*)(lds + HQ_KD + (16 * (2 * ntp + q) + l15) * 272 + (32 * s + 8 * G4) * 2); pa[q] = __builtin_amdgcn_mfma_f32_16x16x32_bf16(a, bq, pa[q], 0, 0, 0); }
            }
#pragma unroll
            for (int q = 0; q < 2; ++q)
#pragma unroll
                for (int r = 0; r < 4; ++r) { const int c = 16 * mt + 4 * G4 + r, j = 16 * (2 * ntp + q) + l15; *(LAS bf16_t*)(lds + HQ_PM + c * 144 + j * 2) = f2bf(j <= c ? pa[q][r] : 0.f); }
        }
        __syncthreads();
        bf16x8 vb[2];
#pragma unroll
        for (int s = 0; s < 2; ++s) vb[s] = *(const LAS bf16x8*)(lds + HQ_VT + (16 * w + l15) * 144 + (32 * s + 8 * G4) * 2);
        if (lat) {
            bf16x8 sb[4];
#pragma unroll
            for (int s = 0; s < 4; ++s) sb[s] = pack8(S[2 * s], S[2 * s + 1]);
#pragma unroll
            for (int mt = 0; mt < 4; ++mt) {
                f32x4 oa = (f32x4){0.f, 0.f, 0.f, 0.f};
#pragma unroll
                for (int s = 0; s < 2; ++s) { const bf16x8 a = *(const LAS bf16x8*)(lds + HQ_PM + (16 * mt + l15) * 144 + (32 * s + 8 * G4) * 2); oa = __builtin_amdgcn_mfma_f32_16x16x32_bf16(a, vb[s], oa, 0, 0, 0); }
#pragma unroll
                for (int s = 0; s < 4; ++s) { const bf16x8 a = *(const LAS bf16x8*)(lds + HQ_QD + (16 * mt + l15) * 272 + (32 * s + 8 * G4) * 2); oa = __builtin_amdgcn_mfma_f32_16x16x32_bf16(a, sb[s], oa, 0, 0, 0); }
#pragma unroll
                for (int r = 0; r < 4; ++r) *(LAS bf16_t*)(lds + HQ_OS + (16 * mt + 4 * G4 + r) * 272 + (16 * w + l15) * 2) = f2bf(oa[r]);
            }
        }
#pragma unroll
        for (int t = 0; t < 8; ++t) {
            const f32x4 d4 = *(const LAS f32x4*)(DEC + 16 * t + 4 * G4);
            S[t] = S[t] * d4;
#pragma unroll
            for (int s = 0; s < 2; ++s) { const bf16x8 a = *(const LAS bf16x8*)(lds + HQ_KET + (16 * t + l15) * 144 + (32 * s + 8 * G4) * 2); S[t] = __builtin_amdgcn_mfma_f32_16x16x32_bf16(a, vb[s], S[t], 0, 0, 0); }
        }
        __syncthreads();
        if (lat) {
            const int j = tid >> 3, part = tid & 7, p = 64 * n + j, tt = dir ? T - 1 - (p - CTXL) : (p - CTXL);
            const u32x4 o0 = *(const LAS u32x4*)(lds + HQ_OS + j * 272 + part * 32), o1 = *(const LAS u32x4*)(lds + HQ_OS + j * 272 + part * 32 + 16);
            bf16_t* dst = OD + ((size_t)b * T + tt) * HGW + h * 128 + part * 16;
            *(u32x4*)dst = o0; *(u32x4*)(dst + 8) = o1;
        }
    }
#undef HG_LOAD
}

__device__ __forceinline__ size_t rg_row(int b, bool lat, int p) {
    return lat ? (size_t)b * T + (size_t)(p % GROWS) * GRIDW + (p / GROWS) : (size_t)NLAT + b * CTXL + p;
}
template <int dir>
__device__ __forceinline__ void rglru_simple_wave(LAS float* xs, const bf16_t* __restrict__ P, const float* __restrict__ conv_w, const float* __restrict__ conv_b,
                                                  const float* __restrict__ wa, const float* __restrict__ ba, const float* __restrict__ wx, const float* __restrict__ bx,
                                                  const float* __restrict__ lam, bf16_t* __restrict__ HD, int hd, int b) {
    const int j = threadIdx.x & 63, c = hd * 64 + j;
    float wac[64], wxc[64];
#pragma unroll
    for (int i = 0; i < 64; ++i) { wac[i] = wa[(((size_t)dir * 8 + hd) * 64 + i) * 64 + j]; wxc[i] = wx[(((size_t)dir * 8 + hd) * 64 + i) * 64 + j]; }
    const float cw0 = conv_w[0 * RGW + c], cw1 = conv_w[1 * RGW + c], cw2 = conv_w[2 * RGW + c], cw3 = conv_w[3 * RGW + c], cb = conv_b[c];
    const float bav = ba[dir * RGW + c], bxv = bx[dir * RGW + c];
    const float l = lam[dir * RGW + c];
    const float sp = (-l > 20.f) ? -l : log1pf(__expf(-l));
    const float coef = -8.0f * sp;
    float hst = 0.f;
    for (int seg = 0; seg < 2; ++seg) {
        const bool lat = seg == 1; const int L = lat ? T : CTXL;
        for (int s0 = 0; s0 < L; s0 += 16) {
            float xc[16];
            const int plo = dir == 0 ? s0 : L - 16 - s0;
            {
                float rx[19];
#pragma unroll
                for (int i = 0; i < 19; ++i) { const int p = plo - 2 + i; rx[i] = (p >= 0 && p < L) ? bf2f(P[rg_row(b, lat, p) * INW + C_RX + c]) : 0.f; }
#pragma unroll
                for (int i = 0; i < 16; ++i) xc[i] = cb + cw0 * rx[i] + cw1 * rx[i + 1] + cw2 * rx[i + 2] + cw3 * rx[i + 3];
            }
            asm volatile("s_waitcnt lgkmcnt(0)" ::: "memory");
#pragma unroll
            for (int i = 0; i < 16; ++i) xs[i * 64 + j] = xc[i];
            asm volatile("s_waitcnt lgkmcnt(0)" ::: "memory");
#pragma unroll
            for (int ii = 0; ii < 16; ++ii) {
                const int i = dir == 0 ? ii : 15 - ii;
                float ra = bav, xa = bxv;
#pragma unroll
                for (int k = 0; k < 64; ++k) { const float xv = xs[i * 64 + k]; ra += xv * wac[k]; xa += xv * wxc[k]; }
                const float r = sigmoidf_(ra), ig = sigmoidf_(xa);
                const float log_a = coef * r, a = __expf(log_a), mult = sqrtf(fmaxf(-expm1f(2.0f * log_a), 0.f));
                hst = a * hst + mult * ig * xc[i];
                if (lat) {
                    const int p = plo + i;
                    const int tt = (p % GROWS) * GRIDW + (p / GROWS);
                    HD[((size_t)b * T + tt) * RGW + c] = f2bf(hst);
                }
            }
        }
    }
}

constexpr int RG_XC = 0, RG_RGT = 66560, RG_CAR = 133120, RG_STRIDE = 1040, NCHK = (CTXL + T) / 64;
__device__ __forceinline__ int rg_off(int row, int chbyte) { return row * RG_STRIDE + ((((chbyte >> 4) ^ (((row >> 4) & 3) << 2)) << 4) | (chbyte & 15)); }
template <int PASS>
__device__ __forceinline__ void rg_item(LAS unsigned char* lds, const bf16_t* __restrict__ P, const float* __restrict__ conv_w, const float* __restrict__ conv_b, const bf16_t* __restrict__ WG_t,
                                        const float* __restrict__ ba, const float* __restrict__ bx, const float* __restrict__ coef, float* __restrict__ AGG, bf16_t* __restrict__ MIX, int b, int n) {
    const int tid = threadIdx.x, w = __builtin_amdgcn_readfirstlane(tid >> 6), lane = tid & 63, l15 = lane & 15, G4 = lane >> 4;
    const bool lat = n >= CTXL / 64; const int L = lat ? T : CTXL, p0 = 64 * (lat ? n - CTXL / 64 : n);
    __syncthreads();
#pragma unroll 1
    for (int it = 0; it < 2; ++it) {
        const int idx = tid + 512 * it, cg4 = idx & 127, pg = idx >> 7;
        float xin[11][4];
#pragma unroll
        for (int i = 0; i < 11; ++i) {
            const int p = p0 + 8 * pg - 2 + i;
            if (p >= 0 && p < L) { const uint2 v = *(const uint2*)(P + rg_row(b, lat, p) * INW + C_RX + cg4 * 4);
                xin[i][0] = __uint_as_float(v.x << 16); xin[i][1] = __uint_as_float(v.x & 0xffff0000u); xin[i][2] = __uint_as_float(v.y << 16); xin[i][3] = __uint_as_float(v.y & 0xffff0000u); }
            else { xin[i][0] = 0.f; xin[i][1] = 0.f; xin[i][2] = 0.f; xin[i][3] = 0.f; }
        }
        const f32x4 w0 = *(const f32x4*)(conv_w + 0 * RGW + cg4 * 4), w1 = *(const f32x4*)(conv_w + 1 * RGW + cg4 * 4), w2 = *(const f32x4*)(conv_w + 2 * RGW + cg4 * 4), w3 = *(const f32x4*)(conv_w + 3 * RGW + cg4 * 4);
        const f32x4 cb4 = *(const f32x4*)(conv_b + cg4 * 4);
#pragma unroll
        for (int q = 0; q < 8; ++q) {
            float o[4];
#pragma unroll
            for (int c = 0; c < 4; ++c) o[c] = cb4[c] + w0[c] * xin[q][c] + w1[c] * xin[q + 1][c] + w2[c] * xin[q + 2][c] + w3[c] * xin[q + 3][c];
            uint2 pk; pk.x = cvt_pk_bf16(o[0], o[1]); pk.y = cvt_pk_bf16(o[2], o[3]);
            *(LAS unsigned long long*)(lds + RG_XC + rg_off(8 * pg + q, cg4 * 8)) = ((unsigned long long)pk.y << 32) | pk.x;
        }
    }
    if (PASS == 2) {
        asm volatile("" ::: "memory");
#pragma unroll 2
        for (int it = 0; it < 8; ++it) { const int idx = tid + 512 * it, row = idx >> 6, ck = idx & 63;
            *(LAS u32x4*)(lds + RG_RGT + rg_off(row, ck * 16)) = *(const u32x4*)(P + rg_row(b, lat, p0 + row) * INW + C_RG + ck * 8); }
        const float2* ag = (const float2*)AGG + (size_t)b * NCHK * 2 * RGW + tid;
        float hf = 0.f, hb = 0.f;
        for (int m = 0; m < n; ++m) { const float2 e = ag[(size_t)(m * 2 + 0) * RGW]; hf = e.x * hf + e.y; }
        for (int m = CTXL / 64 - 1; m >= 0; --m) { const float2 e = ag[(size_t)(m * 2 + 1) * RGW]; hb = e.x * hb + e.y; }
        for (int m = NCHK - 1; m > n; --m) { const float2 e = ag[(size_t)(m * 2 + 1) * RGW]; hb = e.x * hb + e.y; }
        LAS float* CAR = (LAS float*)(lds + RG_CAR); CAR[tid] = hf; CAR[RGW + tid] = hb;
    }
    __syncthreads();
    {
        const int hd = w;
        bf16x8 af[4][2];
#pragma unroll
        for (int mt = 0; mt < 4; ++mt)
#pragma unroll
            for (int s = 0; s < 2; ++s) af[mt][s] = *(const LAS bf16x8*)(lds + RG_XC + rg_off(16 * (l15 >> 2) + 4 * mt + (l15 & 3), (64 * hd + 32 * s + 8 * G4) * 2));
#pragma unroll 1
        for (int cg = 0; cg < 4; ++cg) {
            const int ch = 64 * hd + 16 * cg + l15;
            float hsum[16];
#pragma unroll
            for (int d = 0; d < 2; ++d) {
                f32x4 ra[4], xa[4];
#pragma unroll
                for (int mt = 0; mt < 4; ++mt) { ra[mt] = (f32x4){0.f, 0.f, 0.f, 0.f}; xa[mt] = (f32x4){0.f, 0.f, 0.f, 0.f}; }
                bf16x8 bwa[2], bwx[2];
#pragma unroll
                for (int s = 0; s < 2; ++s) {
                    bwa[s] = *(const bf16x8*)(WG_t + ((size_t)(hd * 256 + 64 * (2 * d) + 16 * cg + l15) * 64 + 32 * s + 8 * G4));
                    bwx[s] = *(const bf16x8*)(WG_t + ((size_t)(hd * 256 + 64 * (2 * d + 1) + 16 * cg + l15) * 64 + 32 * s + 8 * G4));
                }
#pragma unroll
                for (int mt = 0; mt < 4; ++mt)
#pragma unroll
                    for (int s = 0; s < 2; ++s) { ra[mt] = __builtin_amdgcn_mfma_f32_16x16x32_bf16(af[mt][s], bwa[s], ra[mt], 0, 0, 0); xa[mt] = __builtin_amdgcn_mfma_f32_16x16x32_bf16(af[mt][s], bwx[s], xa[mt], 0, 0, 0); }
                const float bav = ba[d * RGW + ch], bxv = bx[d * RGW + ch], cf = coef[d * RGW + ch];
                float av[16], bv[16];
#pragma unroll
                for (int t = 0; t < 16; ++t) {
                    const float r = sigmoidf_(ra[t >> 2][t & 3] + bav), ig = sigmoidf_(xa[t >> 2][t & 3] + bxv);
                    const float a = fexp(cf * r);
                    av[t] = a; bv[t] = fsqrt(fmaxf(1.0f - a * a, 0.f)) * ig * bf2f(*(const LAS bf16_t*)(lds + RG_XC + rg_off(16 * G4 + t, ch * 2)));
                }
                float Al = 1.f, Bl = 0.f;
                if (d == 0) {
#pragma unroll
                    for (int t = 0; t < 16; ++t) { Bl = av[t] * Bl + bv[t]; Al *= av[t]; }
                } else {
#pragma unroll
                    for (int t = 15; t >= 0; --t) { Bl = av[t] * Bl + bv[t]; Al *= av[t]; }
                }
                float Ag[4], Bg[4];
#pragma unroll
                for (int g = 0; g < 4; ++g) { Ag[g] = __shfl(Al, l15 + 16 * g); Bg[g] = __shfl(Bl, l15 + 16 * g); }
                if (PASS == 1) {
                    float A = 1.f, B = 0.f;
                    if (d == 0) {
#pragma unroll
                        for (int g = 0; g < 4; ++g) { B = Ag[g] * B + Bg[g]; A *= Ag[g]; }
                    } else {
#pragma unroll
                        for (int g = 3; g >= 0; --g) { B = Ag[g] * B + Bg[g]; A *= Ag[g]; }
                    }
                    if (G4 == 0) ((float2*)AGG)[((size_t)(b * NCHK + n) * 2 + d) * RGW + ch] = make_float2(A, B);
                } else {
                    const LAS float* CAR = (const LAS float*)(lds + RG_CAR);
                    float h = CAR[d * RGW + ch];
                    if (d == 0) {
                        const float s1 = Ag[0] * h + Bg[0], s2 = Ag[1] * s1 + Bg[1], s3 = Ag[2] * s2 + Bg[2];
                        h = G4 == 0 ? h : G4 == 1 ? s1 : G4 == 2 ? s2 : s3;
#pragma unroll
                        for (int t = 0; t < 16; ++t) { h = av[t] * h + bv[t]; hsum[t] = h; }
                    } else {
                        const float s2 = Ag[3] * h + Bg[3], s1 = Ag[2] * s2 + Bg[2], s0 = Ag[1] * s1 + Bg[1];
                        h = G4 == 3 ? h : G4 == 2 ? s2 : G4 == 1 ? s1 : s0;
#pragma unroll
                        for (int t = 15; t >= 0; --t) { h = av[t] * h + bv[t]; hsum[t] += h; }
                    }
                }
            }
            if (PASS == 2) {
#pragma unroll
                for (int t = 0; t < 16; ++t) { LAS bf16_t* q = (LAS bf16_t*)(lds + RG_RGT + rg_off(16 * G4 + t, ch * 2)); *q = f2bf(gelu_tanh(bf2f(*q)) * hsum[t]); }
            }
        }
    }
    if (PASS == 2) {
        __syncthreads();
#pragma unroll
        for (int it = 0; it < 8; ++it) { const int idx = tid + 512 * it, row = idx >> 6, ck = idx & 63;
            *(u32x4*)(MIX + rg_row(b, true, p0 + row) * D + HGW + ck * 8) = *(const LAS u32x4*)(lds + RG_RGT + rg_off(row, ck * 16)); }
    }
}

__device__ __forceinline__ void phase_mix_finish(const bf16_t* __restrict__ P, const bf16_t* __restrict__ OF, const bf16_t* __restrict__ OB,
                                                 const float* __restrict__ hg_nw, bf16_t* __restrict__ MIX, int bid, int G) {
    constexpr int RB = 4;
    const int lane = threadIdx.x & 63, gw = bid * 8 + (threadIdx.x >> 6), NW = G * 8, c0 = lane * 8;
    const f32x4 nw0 = *(const f32x4*)(hg_nw + c0), nw1 = *(const f32x4*)(hg_nw + c0 + 4);
    const float nwv[8] = {nw0[0], nw0[1], nw0[2], nw0[3], nw1[0], nw1[1], nw1[2], nw1[3]};
    for (int r0 = gw; r0 < NLAT; r0 += RB * NW) {
        u32x4 a4[RB], b4[RB], g4[RB];
#pragma unroll
        for (int q = 0; q < RB; ++q) { const int r = r0 + q * NW; const int rr = r < NLAT ? r : r0;
            a4[q] = *(const u32x4*)(OF + (size_t)rr * HGW + c0); b4[q] = *(const u32x4*)(OB + (size_t)rr * HGW + c0); g4[q] = *(const u32x4*)(P + (size_t)rr * INW + C_G + c0); }
#pragma unroll
        for (int q = 0; q < RB; ++q) { const int r = r0 + q * NW; if (r < NLAT) {
            float o[8]; float ss = 0.f;
#pragma unroll
            for (int i = 0; i < 4; ++i) { o[2 * i] = __uint_as_float(a4[q][i] << 16) + __uint_as_float(b4[q][i] << 16); o[2 * i + 1] = __uint_as_float(a4[q][i] & 0xffff0000u) + __uint_as_float(b4[q][i] & 0xffff0000u); }
#pragma unroll
            for (int i = 0; i < 8; ++i) ss += o[i] * o[i];
            ss += __shfl_xor(ss, 1); ss += __shfl_xor(ss, 2); ss += __shfl_xor(ss, 4); ss += __shfl_xor(ss, 8);
            const float rstd = __builtin_amdgcn_rsqf(ss * (1.0f / 128.0f) + EPS);
            u32x4 w;
#pragma unroll
            for (int i = 0; i < 4; ++i) {
                const float g0 = __uint_as_float(g4[q][i] << 16), g1 = __uint_as_float(g4[q][i] & 0xffff0000u);
                w[i] = cvt_pk_bf16(o[2 * i] * rstd * nwv[2 * i] * (g0 * sigmoidf_(g0)), o[2 * i + 1] * rstd * nwv[2 * i + 1] * (g1 * sigmoidf_(g1)));
            }
            *(u32x4*)(MIX + (size_t)r * D + c0) = w;
        } }
    }
}

__device__ __forceinline__ void phase_norm2_route(LAS unsigned char* lds, const bf16_t* __restrict__ x1, const float* __restrict__ nw, const float* __restrict__ mod,
                                                  const float* __restrict__ rw, const float* __restrict__ rb, fp8_t* __restrict__ H2,
                                                  u32* __restrict__ cnt, u32* __restrict__ toktab, float* __restrict__ wtab, int bid, int G) {
    LAS float* rwT = (LAS float*)lds;
    LAS u32* hist = (LAS u32*)(lds + 131072);
    LAS u32* ent = (LAS u32*)(lds + 131072 + 4096);
    const int tid = threadIdx.x, lane = tid & 63, w = tid >> 6;
    for (int i = tid; i < 32 * 1024; i += 512) { const int k = i >> 5, e = i & 31; rwT[e * 1024 + k] = rw[i]; }
    if (tid < 128) hist[tid] = 0;
    __syncthreads();
    const int gw = bid * 8 + w, NW = G * 8;
    int it = 0;
    uint2 vn[4];
#pragma unroll
    for (int j = 0; j < 4; ++j) vn[j] = *(const uint2*)(x1 + (size_t)gw * D + j * 256 + lane * 4);
    for (int r = gw; r < NLAT; r += NW, ++it) {
        const float* m = mod + (size_t)(r >> 11) * 6144;
        f32x4 v[4]; float ss = 0.f;
#pragma unroll
        for (int j = 0; j < 4; ++j) { v[j][0] = __uint_as_float(vn[j].x << 16); v[j][1] = __uint_as_float(vn[j].x & 0xffff0000u); v[j][2] = __uint_as_float(vn[j].y << 16); v[j][3] = __uint_as_float(vn[j].y & 0xffff0000u);
            ss += v[j][0] * v[j][0] + v[j][1] * v[j][1] + v[j][2] * v[j][2] + v[j][3] * v[j][3]; }
        { const int rn = r + NW < NLAT ? r + NW : r;
#pragma unroll
          for (int j = 0; j < 4; ++j) vn[j] = *(const uint2*)(x1 + (size_t)rn * D + j * 256 + lane * 4); }
        const float rstd = __builtin_amdgcn_rsqf(wave_sum(ss) * (1.0f / D) + EPS);
#pragma unroll
        for (int j = 0; j < 4; ++j) {
            const int c0 = j * 256 + lane * 4;
            const f32x4 ww = *(const f32x4*)(nw + c0), sh = *(const f32x4*)(m + 3072 + c0), sc = *(const f32x4*)(m + 4096 + c0);
            v[j] = v[j] * rstd * ww * (sc + 1.0f) + sh;
            *(unsigned*)(H2 + (size_t)r * D + c0) = pk4_fp8(v[j][0] * SC_H2, v[j][1] * SC_H2, v[j][2] * SC_H2, v[j][3] * SC_H2);
        }
        float part[32];
#pragma unroll
        for (int e = 0; e < 32; ++e) {
            float p = 0.f;
#pragma unroll
            for (int j = 0; j < 4; ++j) { const f32x4 q = *(const LAS f32x4*)(rwT + e * 1024 + j * 256 + lane * 4); p += v[j][0] * q[0] + v[j][1] * q[1] + v[j][2] * q[2] + v[j][3] * q[3]; }
            part[e] = p;
        }
#define RT_STEP(N, M) { const bool up = (lane & (M)) != 0; _Pragma("unroll") for (int i = 0; i < (N); ++i) { const float keep = up ? part[(N) + i] : part[i], send = up ? part[i] : part[(N) + i]; part[i] = keep + __shfl_xor(send, (M)); } }
        RT_STEP(16, 32) RT_STEP(8, 16) RT_STEP(4, 8) RT_STEP(2, 4) RT_STEP(1, 2)
#undef RT_STEP
        float mylogit = part[0] + __shfl_xor(part[0], 1);
        const int myexp = ((lane >> 5) & 1) * 16 + ((lane >> 4) & 1) * 8 + ((lane >> 3) & 1) * 4 + ((lane >> 2) & 1) * 2 + ((lane >> 1) & 1);
        mylogit += rb[myexp];
        int rank = 0;
#pragma unroll
        for (int q = 0; q < 32; ++q) {
            const int src = ((q >> 4) & 1) * 32 + ((q >> 3) & 1) * 16 + ((q >> 2) & 1) * 8 + ((q >> 1) & 1) * 4 + (q & 1) * 2;
            const float oq = __builtin_bit_cast(float, __builtin_amdgcn_readlane(__builtin_bit_cast(int, mylogit), src));
            rank += (oq > mylogit || (oq == mylogit && q < myexp)) ? 1 : 0;
        }
        float tv[4]; int ti[4];
#pragma unroll
        for (int k = 0; k < 4; ++k) {
            const unsigned long long mk = __ballot(rank == k && (lane & 1) == 0);
            const int src = __builtin_amdgcn_readfirstlane((int)__builtin_ctzll(mk));
            tv[k] = __builtin_bit_cast(float, __builtin_amdgcn_readlane(__builtin_bit_cast(int, mylogit), src));
            ti[k] = ((src >> 5) & 1) * 16 + ((src >> 4) & 1) * 8 + ((src >> 3) & 1) * 4 + ((src >> 2) & 1) * 2 + ((src >> 1) & 1);
        }
        const float e1 = fexp(tv[1] - tv[0]), e2 = fexp(tv[2] - tv[0]), e3 = fexp(tv[3] - tv[0]); const float inv = frcp(1.0f + e1 + e2 + e3);
        const float g0 = inv, g1 = e1 * inv, g2 = e2 * inv, g3 = e3 * inv;
        if (lane < 4) {
            const int half = r >= HALF_TOK ? 1 : 0;
            const int e = lane == 0 ? ti[0] : lane == 1 ? ti[1] : lane == 2 ? ti[2] : ti[3];
            const float gv = lane == 0 ? g0 : lane == 1 ? g1 : lane == 2 ? g2 : g3;
            const u32 lp = atomicAdd((u32*)&hist[half * 32 + e], 1u);
            const int idx = (it * 8 + w) * 4 + lane;
            ent[idx * 2] = ((u32)e << 24) | lp; ent[idx * 2 + 1] = __float_as_uint(gv);
        }
    }
    __syncthreads();
    if (tid < 64) hist[64 + tid] = atomicAdd(&cnt[tid], hist[tid]);
    __syncthreads();
    it = 0;
    for (int r = gw; r < NLAT; r += NW, ++it) {
        if (lane < 4) {
            const int half = r >= HALF_TOK ? 1 : 0; const int idx = (it * 8 + w) * 4 + lane;
            const u32 ev = ent[idx * 2]; const int e = ev >> 24; const u32 pos = hist[64 + half * 32 + e] + (ev & 0xffffffu);
            toktab[((size_t)half * 32 + e) * CAP + pos] = (u32)r * 4u + lane;
            wtab[((size_t)half * 32 + e) * CAP + pos] = __uint_as_float(ent[idx * 2 + 1]);
        }
    }
}

__device__ __forceinline__ void phase_combine(float* __restrict__ out, const bf16_t* __restrict__ X1, const fp8_t* __restrict__ Y, const float* __restrict__ mod, const float* __restrict__ fw, int bid, int G) {
    constexpr int RB = 2;
    typedef float f32x2_ __attribute__((ext_vector_type(2)));
    const int lane = threadIdx.x & 63, gw = bid * 8 + (threadIdx.x >> 6), NW = G * 8;
    for (int r0 = gw; r0 < NLAT; r0 += RB * NW) {
        u32x2 xv[RB][4]; unsigned yv[RB][4][4];
#pragma unroll
        for (int q = 0; q < RB; ++q) { const int r = r0 + q * NW < NLAT ? r0 + q * NW : r0;
#pragma unroll
            for (int j = 0; j < 4; ++j) { xv[q][j] = __builtin_nontemporal_load((const u32x2*)(X1 + (size_t)r * D + j * 256 + lane * 4));
#pragma unroll
                for (int k = 0; k < 4; ++k) yv[q][j][k] = __builtin_nontemporal_load((const unsigned*)(Y + ((size_t)r * 4 + k) * D + j * 256 + lane * 4)); } }
#pragma unroll
        for (int q = 0; q < RB; ++q) { const int r = r0 + q * NW; if (r < NLAT) {
            const float* g2 = mod + (size_t)(r >> 11) * 6144 + 5120;
            f32x4 v[4]; float ss = 0.f;
#pragma unroll
            for (int j = 0; j < 4; ++j) { const int c0 = j * 256 + lane * 4;
                f32x4 sm = (f32x4){0.f, 0.f, 0.f, 0.f};
#pragma unroll
                for (int k = 0; k < 4; ++k) { const f32x2_ lo = __builtin_amdgcn_cvt_pk_f32_fp8(yv[q][j][k], false), hi = __builtin_amdgcn_cvt_pk_f32_fp8(yv[q][j][k], true); sm[0] += lo[0]; sm[1] += lo[1]; sm[2] += hi[0]; sm[3] += hi[1]; }
                const f32x4 g = *(const f32x4*)(g2 + c0);
                v[j][0] = __uint_as_float(xv[q][j].x << 16); v[j][1] = __uint_as_float(xv[q][j].x & 0xffff0000u); v[j][2] = __uint_as_float(xv[q][j].y << 16); v[j][3] = __uint_as_float(xv[q][j].y & 0xffff0000u);
                v[j] = v[j] + g * sm * (1.0f / SC_Y);
                ss += v[j][0] * v[j][0] + v[j][1] * v[j][1] + v[j][2] * v[j][2] + v[j][3] * v[j][3]; }
            const float rstd = __builtin_amdgcn_rsqf(wave_sum(ss) * (1.0f / D) + EPS);
#pragma unroll
            for (int j = 0; j < 4; ++j) { const int c0 = j * 256 + lane * 4; const f32x4 w = *(const f32x4*)(fw + c0); __builtin_nontemporal_store(v[j] * rstd * w, (f32x4*)(out + (size_t)r * D + c0)); }
        } }
    }
}

#define XB_TMO      128
#define XB_XCNT(j)  (256  + 64 * (j))
#define XB_XSUB(j)  (1280 + 64 * (j))
#define XB_XGEN(j)  (2304 + 64 * (j))
#define XB_TOP      3328
#define XB_TOPGEN   3392
#define XCD_BAR_WORDS 3456
#define XB_SPIN_CAP (1u << 20)
__device__ __forceinline__ unsigned xb_ld(unsigned* p)              { return __hip_atomic_load(p, __ATOMIC_RELAXED, __HIP_MEMORY_SCOPE_AGENT); }
__device__ __forceinline__ unsigned xb_add(unsigned* p, unsigned v) { return __hip_atomic_fetch_add(p, v, __ATOMIC_RELAXED, __HIP_MEMORY_SCOPE_AGENT); }
__device__ __forceinline__ unsigned xb_xcc_id() { return (unsigned)__builtin_amdgcn_s_getreg((3 << 11) | 20) & 0xFu; }
#define XB_SPIN(cond, bar) do { unsigned _sp = 0; while (cond) { __builtin_amdgcn_s_sleep(1); \
    if ((++_sp & 255u) == 0u) { if (xb_ld(&(bar)[XB_TMO])) break; if (_sp > XB_SPIN_CAP) { atomicAdd(&(bar)[XB_TMO], 1u); break; } } } } while (0)
struct XcdBarrier { unsigned* bar; unsigned x; volatile LAS unsigned* st; };
__device__ __forceinline__ XcdBarrier xcd_barrier_post(unsigned* bar, volatile LAS unsigned* st) {
    XcdBarrier b; b.bar = bar; b.x = xb_xcc_id(); b.st = st;
    if (threadIdx.x == 0) (void)xb_add(&bar[XB_XCNT(b.x)], 1u);
    return b;
}
__device__ __forceinline__ void xcd_barrier_complete(unsigned* bar, unsigned x, unsigned& nloc, unsigned& nx) {
    const unsigned G = gridDim.x * gridDim.y * gridDim.z;
    unsigned sum, cnt, mine, sp = 0u;
    for (;;) {
        sum = 0u; cnt = 0u; mine = 0u;
#pragma unroll
        for (unsigned j = 0; j < 16; ++j) { const unsigned c = xb_ld(&bar[XB_XCNT(j)]); sum += c; cnt += (c > 0u) ? 1u : 0u; mine = (j == x) ? c : mine; }
        if (sum == G) break;
        __builtin_amdgcn_s_sleep(1);
        if ((++sp & 255u) == 0u) { if (xb_ld(&bar[XB_TMO])) break; if (sp > XB_SPIN_CAP) { atomicAdd(&bar[XB_TMO], 1u); break; } }
    }
    nloc = mine > 0u ? mine : 1u; nx = cnt > 0u ? cnt : 1u;
}
__device__ __forceinline__ void xcd_barrier(unsigned* bar, volatile LAS unsigned* st) {
    asm volatile("s_waitcnt vmcnt(0)" ::: "memory");
    __syncthreads();
    if (threadIdx.x == 0) {
        __builtin_amdgcn_s_waitcnt(0);
        const unsigned x = xb_xcc_id();
        unsigned nloc = st[0], nx = st[1];
        if (nloc == 0u) { xcd_barrier_complete(bar, x, nloc, nx); st[0] = nloc; st[1] = nx; }
        const unsigned old = xb_add(&bar[XB_XSUB(x)], 1u);
        const unsigned gen = old / nloc;
        if (old + 1u == (gen + 1u) * nloc) {
            __builtin_amdgcn_fence(__ATOMIC_RELEASE, "agent");
            asm volatile("s_waitcnt vmcnt(0)" ::: "memory");
            const unsigned og = xb_add(&bar[XB_TOP], 1u);
            const unsigned tg = og / nx;
            if (og + 1u == (tg + 1u) * nx) xb_add(&bar[XB_TOPGEN], 1u);
            else XB_SPIN(xb_ld(&bar[XB_TOPGEN]) == tg, bar);
            __builtin_amdgcn_fence(__ATOMIC_ACQUIRE, "agent");
            xb_add(&bar[XB_XGEN(x)], 1u);
            asm volatile("s_waitcnt vmcnt(0)" ::: "memory");
        } else {
            XB_SPIN(xb_ld(&bar[XB_XGEN(x)]) == gen, bar);
            __builtin_amdgcn_fence(__ATOMIC_ACQUIRE, "agent");
            asm volatile("s_waitcnt vmcnt(0)" ::: "memory");
        }
    }
    __syncthreads();
}
constexpr size_t WS_BAR = 16384;
constexpr int LDS_BARST = LDS_BYTES - 16;

struct MegaArgs {
    const float *x, *c, *ctx, *c_ctx, *norm1_w, *norm2_w, *w_ada, *b_ada, *w_in, *lbl, *hg_nw, *conv_w, *conv_b, *rg_wa, *rg_ba, *rg_wx, *rg_bx, *rg_lam, *w_out,
        *router_w, *router_b, *wgu, *bgu, *wd, *bd, *final_w;
    float* out; unsigned char* ws;
};
typedef const MegaArgs __attribute__((address_space(4)))* KArgs;
__device__ __forceinline__ KArgs kargs() { auto p = __builtin_amdgcn_kernarg_segment_ptr(); asm volatile("" : "+s"(p)); return (KArgs)p; }
#define WSP(T, off) ((T*)(ws + (off)))
#define GRID_SYNC_CG() cg::this_grid().sync()
#define GRID_SYNC() do { KArgs a_ = kargs(); xcd_barrier((unsigned*)(a_->ws + WS_BAR), (volatile LAS unsigned*)(lds + LDS_BARST)); } while (0)
__global__ __launch_bounds__(512, 2) void k_mega(MegaArgs a_unused) {
    extern __shared__ __attribute__((aligned(16))) unsigned char lds_[];
    LAS unsigned char* lds = (LAS unsigned char*)lds_;
    if (threadIdx.x < 4) ((volatile LAS unsigned*)(lds + LDS_BARST))[threadIdx.x] = 0u;
    __syncthreads();
    { KArgs a = kargs(); (void)xcd_barrier_post((unsigned*)(a->ws + WS_BAR), (volatile LAS unsigned*)(lds + LDS_BARST)); }
    { KArgs a = kargs(); unsigned char* ws = a->ws; const int bid = blockIdx.x, G = gridDim.x;
      ProArgs pa; pa.c = a->c; pa.c_ctx = a->c_ctx; pa.w_ada = a->w_ada; pa.b_ada = a->b_ada; pa.lbl = a->lbl; pa.w_in = a->w_in; pa.w_out = a->w_out; pa.wgu = a->wgu; pa.wd = a->wd; pa.rg_wa = a->rg_wa; pa.rg_wx = a->rg_wx; pa.rg_lam = a->rg_lam;
      pa.coef = WSP(float, WS_COEF); pa.WG_t = WSP(bf16_t, WS_WG); pa.mod = WSP(float, WS_MOD); pa.lb = WSP(float, WS_LB); pa.Win_t = WSP(bf16_t, WS_WIN); pa.Wout_t = WSP(bf16_t, WS_WOUT); pa.Wgu_t = WSP(fp8_t, WS_WGU); pa.Wd_t = WSP(fp8_t, WS_WD);
      phase_prologue(lds, pa, bid, G, true, 0, 0); }
    { KArgs a_ = kargs(); if (a_->ws == nullptr) GRID_SYNC_CG(); }
    GRID_SYNC();
    { KArgs a = kargs(); unsigned char* ws = a->ws; phase_norm1(a->x, a->ctx, a->norm1_w, WSP(float, WS_MOD), WSP(bf16_t, WS_H), blockIdx.x, gridDim.x); }
    { KArgs a = kargs(); unsigned char* ws = a->ws;
      ProArgs pa; pa.c = nullptr; pa.c_ctx = nullptr; pa.w_ada = nullptr; pa.b_ada = nullptr; pa.lbl = nullptr; pa.w_in = a->w_in; pa.w_out = a->w_out; pa.wgu = nullptr; pa.wd = nullptr; pa.rg_wa = nullptr; pa.rg_wx = nullptr; pa.rg_lam = nullptr; pa.coef = nullptr; pa.WG_t = nullptr;
      pa.mod = nullptr; pa.lb = nullptr; pa.Win_t = WSP(bf16_t, WS_WIN); pa.Wout_t = WSP(bf16_t, WS_WOUT); pa.Wgu_t = nullptr; pa.Wd_t = nullptr;
      phase_prologue(lds, pa, blockIdx.x, gridDim.x, false, 0, IT_IN + IT_OUT); }
    GRID_SYNC();
    { KArgs a = kargs(); unsigned char* ws = a->ws; PolInProj P; P.A = WSP(bf16_t, WS_H); P.Bt = WSP(bf16_t, WS_WIN); P.O = WSP(bf16_t, WS_PROJ); P.ord.init(NROWS / BM, INW / BM, gridDim.x, blockIdx.x); gemm_phase(lds, P); }
    GRID_SYNC();
    { KArgs a = kargs(); unsigned char* ws = a->ws;
      for (int it = blockIdx.x; it < NB * NCHK; it += gridDim.x)
          rg_item<1>(lds, WSP(bf16_t, WS_PROJ), a->conv_w, a->conv_b, WSP(bf16_t, WS_WG), a->rg_ba, a->rg_bx, WSP(float, WS_COEF), WSP(float, WS_AGG), nullptr, it / NCHK, it % NCHK); }
    __syncthreads();
    { KArgs a = kargs(); unsigned char* ws = a->ws;
      for (int item = blockIdx.x; item < 256; item += gridDim.x) phase_hgrn2_chunk(lds, WSP(bf16_t, WS_PROJ), WSP(float, WS_LB), WSP(bf16_t, WS_OF), WSP(bf16_t, WS_OB), item); }
    GRID_SYNC();
    { KArgs a = kargs(); unsigned char* ws = a->ws;
      for (int it = blockIdx.x; it < NB * (T / 64); it += gridDim.x)
          rg_item<2>(lds, WSP(bf16_t, WS_PROJ), a->conv_w, a->conv_b, WSP(bf16_t, WS_WG), a->rg_ba, a->rg_bx, WSP(float, WS_COEF), WSP(float, WS_AGG), WSP(bf16_t, WS_MIX2), it / (T / 64), CTXL / 64 + it % (T / 64)); }
    { KArgs a = kargs(); unsigned char* ws = a->ws; phase_mix_finish(WSP(bf16_t, WS_PROJ), WSP(bf16_t, WS_OF), WSP(bf16_t, WS_OB), a->hg_nw, WSP(bf16_t, WS_MIX2), blockIdx.x, gridDim.x); }
    GRID_SYNC();
    { KArgs a = kargs(); unsigned char* ws = a->ws; PolOutProj P; P.A = WSP(bf16_t, WS_MIX2); P.Bt = WSP(bf16_t, WS_WOUT); P.x = a->x; P.mod = WSP(float, WS_MOD); P.O = WSP(bf16_t, WS_X1); P.ord.init(NLAT / BM, D / BM, gridDim.x, blockIdx.x); gemm_phase(lds, P); }
    GRID_SYNC();
    { KArgs a = kargs(); unsigned char* ws = a->ws;
      phase_norm2_route(lds, WSP(bf16_t, WS_X1), a->norm2_w, WSP(float, WS_MOD), a->router_w, a->router_b, WSP(fp8_t, WS_H2), WSP(u32, WS_CTL), WSP(u32, WS_TOKTAB), WSP(float, WS_WTAB), blockIdx.x, gridDim.x); }
    __syncthreads();
    { KArgs a = kargs(); unsigned char* ws = a->ws;
      ProArgs pa; pa.c = nullptr; pa.c_ctx = nullptr; pa.w_ada = nullptr; pa.b_ada = nullptr; pa.lbl = nullptr; pa.w_in = nullptr; pa.w_out = nullptr; pa.wgu = a->wgu; pa.wd = a->wd; pa.rg_wa = nullptr; pa.rg_wx = nullptr; pa.rg_lam = nullptr; pa.coef = nullptr; pa.WG_t = nullptr;
      pa.mod = nullptr; pa.lb = nullptr; pa.Win_t = nullptr; pa.Wout_t = nullptr; pa.Wgu_t = WSP(fp8_t, WS_WGU); pa.Wd_t = WSP(fp8_t, WS_WD);
      phase_prologue(lds, pa, blockIdx.x, gridDim.x, false, IT_IN + IT_OUT, IT_ALL); }
    GRID_SYNC();
#pragma unroll 1
    for (int half = 0; half < NHALF; ++half) {
        { KArgs a = kargs(); unsigned char* ws = a->ws; LAS int* tstart = (LAS int*)(lds + LDS_AUX);
          const int tot = moe_tile_table(tstart, WSP(u32, WS_CTL), half);
          PolGateUp P; P.A = WSP(fp8_t, WS_H2); P.Bt = WSP(fp8_t, WS_WGU); P.bgu = a->bgu; P.toktab = WSP(u32, WS_TOKTAB); P.O = WSP(fp8_t, WS_ACT); P.mt.tstart = tstart; P.mt.cnt = WSP(u32, WS_CTL); P.mt.half = half;
          P.ord.init(tot, DFF / HALFT, gridDim.x, blockIdx.x);
          gemm_phase(lds, P); }
        GRID_SYNC();
        { KArgs a = kargs(); unsigned char* ws = a->ws; LAS int* tstart = (LAS int*)(lds + LDS_AUX);
          const int tot = moe_tile_table(tstart, WSP(u32, WS_CTL), half);
          PolDown P; P.A = WSP(fp8_t, WS_ACT); P.Bt = WSP(fp8_t, WS_WD); P.bd = a->bd; P.toktab = WSP(u32, WS_TOKTAB); P.wtab = WSP(float, WS_WTAB); P.O = WSP(fp8_t, WS_Y); P.mt.tstart = tstart; P.mt.cnt = WSP(u32, WS_CTL); P.mt.half = half;
          P.ord.init(tot, D / BM, gridDim.x, blockIdx.x);
          gemm_phase(lds, P); }
        GRID_SYNC();
        { KArgs a = kargs(); unsigned char* ws = a->ws; phase_combine(a->out, WSP(bf16_t, WS_X1), WSP(fp8_t, WS_Y), WSP(float, WS_MOD), a->final_w, blockIdx.x, gridDim.x); }
        __syncthreads();
    }
}

extern "C" void kernel_launch(void* const* d_in, const int* in_sizes, int n_in, void* d_out, int out_size, void* d_ws, size_t ws_size, hipStream_t stream) {
    static int grid_blocks = 0;
    if (!grid_blocks) {
        int dev = 0, cus = 0, per_cu = 0;
        (void)hipGetDevice(&dev);
        (void)hipDeviceGetAttribute(&cus, hipDeviceAttributeMultiprocessorCount, dev);
        (void)hipFuncSetAttribute((const void*)k_mega, hipFuncAttributeMaxDynamicSharedMemorySize, LDS_BYTES);
        (void)hipOccupancyMaxActiveBlocksPerMultiprocessor(&per_cu, (const void*)k_mega, 512, LDS_BYTES);
        if (per_cu < 1) { fprintf(stderr, "kernel_launch: occupancy query says %d blocks/CU\n", per_cu); per_cu = 1; }
        grid_blocks = cus * 1;
    }
    if (ws_size < 1024 * MiB) { fprintf(stderr, "kernel_launch: workspace too small (%zu)\n", ws_size); return; }
    MegaArgs a{};
    const float** ap = (const float**)&a;
    for (int i = 0; i < 26; ++i) ap[i] = (const float*)d_in[i];
    a.out = (float*)d_out; a.ws = (unsigned char*)d_ws;
    (void)hipMemsetAsync((unsigned char*)d_ws + WS_CTL, 0, 32768, stream);
    void* args[] = {&a};
    hipError_t e = hipLaunchCooperativeKernel((const void*)k_mega, dim3(grid_blocks), dim3(512), args, LDS_BYTES, stream);
    if (e != hipSuccess) fprintf(stderr, "cooperative launch failed: %s (grid %d)\n", hipGetErrorString(e), grid_blocks);
}
```

```cpp
#include <hip/hip_runtime.h>
#include <hip/hip_cooperative_groups.h>
#include <cstdio>
#include <cstdint>

typedef unsigned short bf16_t;
typedef unsigned int u32;
namespace cg = cooperative_groups;

constexpr int D = 1024, NB = 32, T = 2048, CTXL = 256, GRIDW = 64, GROWS = T / GRIDW;
constexpr int NLAT = NB * T;
constexpr int NCTX = NB * CTXL;
constexpr int NROWS = NLAT + NCTX;
constexpr int HGW = 512, RGW = 512, INW = 3584;
constexpr int C_Q = 0, C_I = 512, C_FF = 1024, C_FB = 1536, C_G = 2048, C_RX = 2560, C_RG = 3072;
constexpr int NE = 32, TOPK = 4, DFF = 1024;
constexpr int NHALF = 1;
constexpr int HALF_TOK = NLAT / NHALF;
constexpr int CAP = HALF_TOK;
constexpr int MAXSLOT = HALF_TOK * TOPK + NE * 256;
constexpr float EPS = 1e-6f;

constexpr size_t MiB = 1u << 20;
constexpr size_t WS_CTL = 0;
constexpr size_t WS_MOD = 1 * MiB;
constexpr size_t WS_LB = WS_MOD + 33 * 6144 * 4;
constexpr size_t WS_TOKTAB = 2 * MiB;
constexpr size_t WS_WTAB = 10 * MiB;
constexpr size_t WS_SCR = 28 * MiB;
constexpr size_t WS_OF = 28 * MiB, WS_OB = 92 * MiB, WS_HF = 156 * MiB, WS_HB = 220 * MiB;
constexpr size_t WS_WIN = 18 * MiB, WS_WOUT = 25 * MiB;
constexpr size_t WS_WG = 64 * 1024;
constexpr size_t WS_COEF = WS_LB + 4096;
constexpr size_t WS_AGG = 932 * MiB;
constexpr size_t WS_WGU = 92 * MiB, WS_WD = 156 * MiB;
constexpr size_t WS_H = 284 * MiB;
constexpr size_t WS_PROJ = 428 * MiB;
constexpr size_t WS_ACT = 188 * MiB;
constexpr size_t WS_Y = 452 * MiB;
constexpr size_t WS_X1 = 708 * MiB;
constexpr float SC_Y = 16.0f;

constexpr size_t WS_MIX2 = WS_H;
constexpr size_t WS_H2 = 28 * MiB;

__device__ __forceinline__ float bf2f(bf16_t b) { return __uint_as_float(((u32)b) << 16); }
__device__ __forceinline__ bf16_t f2bf(float f) { u32 u = __float_as_uint(f); u += 0x7fffu + ((u >> 16) & 1u); return (bf16_t)(u >> 16); }
__device__ __forceinline__ u32 pk2(float lo, float hi) { return (u32)f2bf(lo) | ((u32)f2bf(hi) << 16); }
__device__ __forceinline__ float fexp(float x) { return __builtin_amdgcn_exp2f(x * 1.4426950408889634f); }
__device__ __forceinline__ float frcp(float x) { return __builtin_amdgcn_rcpf(x); }
__device__ __forceinline__ float flog(float x) { return __builtin_amdgcn_logf(x) * 0.6931471805599453f; }
__device__ __forceinline__ float fsqrt(float x) { return __builtin_amdgcn_sqrtf(x); }
__device__ __forceinline__ float sigmoidf_(float x) { return frcp(1.0f + fexp(-x)); }
__device__ __forceinline__ float wave_sum(float v) {
#pragma unroll
    for (int o = 1; o < 64; o <<= 1) v += __shfl_xor(v, o);
    return v;
}

__device__ __forceinline__ float gelu_tanh(float x) { const float u = 1.5957691216057308f * (x + 0.044715f * x * x * x); return x * sigmoidf_(u); }
#define LAS __attribute__((address_space(3)))
typedef short bf16x8 __attribute__((ext_vector_type(8)));
typedef float f32x4 __attribute__((ext_vector_type(4)));
typedef unsigned u32x4 __attribute__((ext_vector_type(4)));
typedef int v8i __attribute__((ext_vector_type(8)));
typedef int v4i_ __attribute__((ext_vector_type(4)));
typedef unsigned u32x2 __attribute__((ext_vector_type(2)));
typedef unsigned char fp8_t;
constexpr float SC_H2 = 16.0f, SC_W = 32.0f, SC_ACT = 4.0f;
__device__ __forceinline__ unsigned pk4_fp8(float a, float b, float c, float d) {
    a = fminf(fmaxf(a, -448.f), 448.f); b = fminf(fmaxf(b, -448.f), 448.f); c = fminf(fmaxf(c, -448.f), 448.f); d = fminf(fmaxf(d, -448.f), 448.f);
    int r = 0; r = __builtin_amdgcn_cvt_pk_fp8_f32(a, b, r, false); r = __builtin_amdgcn_cvt_pk_fp8_f32(c, d, r, true); return (unsigned)r; }
constexpr int BM = 256, BK = 64, HALFT = 128, HTB = HALFT * BK * 2, STAGE_BYTES = 8 * HTB, NXCD = 8, WGM = 8;
constexpr int GK = 1024;
constexpr int LDS_BYTES = 147456;
constexpr int LDS_AUX = STAGE_BYTES;

__device__ __forceinline__ int lds_byte(int r, int c) { const int st = (r >> 4) * 2 + (c >> 5), rr = r & 15, cc = c & 31, ob = rr * 64 + cc * 2; return st * 1024 + (ob ^ (((ob >> 9) & 1) << 5)); }
__device__ __forceinline__ void stage_rc(int b, int& R, int& C) { const int st = b / 1024, sb = b % 1024, swz = sb ^ (((sb >> 9) & 1) << 5); R = (st >> 1) * 16 + swz / 64; C = (st & 1) * 32 + (swz % 64) / 2; }
__device__ __forceinline__ int perm32(int rho) { const int n = rho >> 4, i = rho & 15; return 8 * (i >> 2) + 4 * n + (i & 3); }
__device__ __forceinline__ unsigned cvt_pk_bf16(float lo, float hi) { unsigned r; asm volatile("v_cvt_pk_bf16_f32 %0, %1, %2" : "=v"(r) : "v"(lo), "v"(hi)); return r; }

struct Unit { int pm, pn, e, pos0, cn; };
struct TileOrder {
    int nM, nN, nwg, G, c;
    __device__ __forceinline__ void init(int nM_, int nN_, int G_, int c_) { nM = nM_; nN = nN_; nwg = nM * nN; G = G_; c = c_; }
    __device__ __forceinline__ bool tile(int i, int& pm, int& pn) const {
        const long L = (long)i * G + c; if (L >= nwg) return false;
        int wgid = (int)L; { const int q = nwg / NXCD, r = nwg % NXCD, xcd = wgid % NXCD, off = wgid / NXCD; wgid = (xcd < r ? xcd * (q + 1) : r * (q + 1) + (xcd - r) * q) + off; }
        const int nig = WGM * nN, gid = wgid / nig, fm = gid * WGM, gsz = (nM - fm) < WGM ? (nM - fm) : WGM;
        pm = fm + ((wgid % nig) % gsz); pn = (wgid % nig) / gsz; return true;
    }
};

template <class POL>
__device__ __forceinline__ void gemm_phase(LAS unsigned char* lds, const POL& P) {
    int tid_ = threadIdx.x; asm volatile("" : "+v"(tid_));
    const int tid = tid_, wid = __builtin_amdgcn_readfirstlane(tid >> 6), lane = tid & 63, wr = wid >> 2, wc = wid & 3, fr = lane & 15, fq = lane >> 4;
    constexpr int KB = POL::FP8 ? 1024 : 2048, nt = KB / 128;
    int sR[2], sC[2]; unsigned voffA[2], voffB[2];
#pragma unroll
    for (int i = 0; i < 2; ++i) { stage_rc(tid * 16 + i * 8192, sR[i], sC[i]); const int Rb = POL::PERM ? ((sR[i] & ~31) + perm32(sR[i] & 31)) : sR[i]; voffA[i] = (unsigned)(sR[i] * KB + sC[i] * 2); voffB[i] = (unsigned)(Rb * KB + sC[i] * 2); }
    constexpr size_t kstep = (size_t)(BK * 2);
    constexpr unsigned hstepB = (unsigned)HALFT * KB;
    const unsigned ldsw = (unsigned)wid * 1024u;
    const int aoff = POL::FP8 ? lds_byte(wr * 64 + fr, fq * 16) : lds_byte(wr * 64 + fr, fq * 8), boff = POL::FP8 ? lds_byte(wc * 32 + fr, fq * 16) : lds_byte(wc * 32 + fr, fq * 8);
#define G_SA(b, h) (((b) * 2 + (h)) * HTB)
#define G_SB(b, h) ((4 + (b) * 2 + (h)) * HTB)
#define G_AOFF(OFF, h, i) (POL::GATHER ? (OFF)[h][i] : voffA[i])
#define G_STAGE_A(bufoff, gbase, OFF, h) do { const char* _gb = (const char*)(gbase) + (POL::GATHER ? (size_t)0 : (size_t)(h) * hstepB); _Pragma("unroll") for (int _i = 0; _i < 2; ++_i) \
        __builtin_amdgcn_global_load_lds((const unsigned*)(_gb + G_AOFF(OFF, h, _i)), (LAS unsigned*)(lds + (bufoff) + ldsw + _i * 8192), 16, 0, 0); } while (0)
#define G_STAGE_B(bufoff, gbase, hoff) do { const char* _gb = (const char*)(gbase) + (size_t)(hoff); _Pragma("unroll") for (int _i = 0; _i < 2; ++_i) \
        __builtin_amdgcn_global_load_lds((const unsigned*)(_gb + voffB[_i]), (LAS unsigned*)(lds + (bufoff) + ldsw + _i * 8192), 16, 0, 0); } while (0)
#define G_LD8(p) __builtin_shufflevector(*(const LAS v4i_*)(p), *(const LAS v4i_*)((p) + 16), 0, 1, 2, 3, 4, 5, 6, 7)
#define G_LDA(dst, b, h) do { if (POL::FP8) { _Pragma("unroll") for (int m = 0; m < 4; ++m) dst##8[m] = G_LD8(lds + G_SA(b, h) + aoff + m * 2048); } \
        else { _Pragma("unroll") for (int m = 0; m < 4; ++m) _Pragma("unroll") for (int k = 0; k < 2; ++k) dst[m][k] = *(const LAS bf16x8*)(lds + G_SA(b, h) + aoff + m * 2048 + k * 1024); } } while (0)
#define G_LDB(dst, b, h) do { if (POL::FP8) { _Pragma("unroll") for (int n = 0; n < 2; ++n) dst##8[n] = G_LD8(lds + G_SB(b, h) + boff + n * 2048); } \
        else { _Pragma("unroll") for (int n = 0; n < 2; ++n) _Pragma("unroll") for (int k = 0; k < 2; ++k) dst[n][k] = *(const LAS bf16x8*)(lds + G_SB(b, h) + boff + n * 2048 + k * 1024); } } while (0)
#define G_MMA(ai, bj, At, Bt) do { __builtin_amdgcn_s_setprio(1); \
        if (POL::FP8) { _Pragma("unroll") for (int m = 0; m < 4; ++m) _Pragma("unroll") for (int n = 0; n < 2; ++n) \
            asm volatile("v_mfma_scale_f32_16x16x128_f8f6f4 %0, %1, %2, %0, %3, %3 op_sel_hi:[0,0,0]" : "+v"(acc[ai][bj][m][n]) : "v"(Bt##8[n]), "v"(At##8[m]), "v"(mxs)); } \
        else { _Pragma("unroll") for (int m = 0; m < 4; ++m) _Pragma("unroll") for (int n = 0; n < 2; ++n) _Pragma("unroll") for (int k = 0; k < 2; ++k) \
            acc[ai][bj][m][n] = __builtin_amdgcn_mfma_f32_16x16x32_bf16(Bt[n][k], At[m][k], acc[ai][bj][m][n], 0, 0, 0); } \
        __builtin_amdgcn_s_setprio(0); } while (0)
#define G_WAIT_V(n) asm volatile("s_waitcnt vmcnt(" #n ")" ::: "memory")
#define G_WAIT_L(n) asm volatile("s_waitcnt lgkmcnt(" #n ")" ::: "memory")
#define G_BAR __builtin_amdgcn_s_barrier()
#define G_SCHED __builtin_amdgcn_sched_barrier(0)
#define G_TRIP(A1, OC, A2, ON, B2) do { \
        G_LDB(B0, 0, 0); G_SCHED; G_LDA(At, 0, 0); G_STAGE_A(G_SA(1, 1), A1, OC, 1); \
        G_WAIT_L(8); G_BAR; G_WAIT_L(0); G_MMA(0, 0, At, B0); G_BAR; G_SCHED; \
        G_LDB(B1, 0, 1); G_STAGE_B(G_SB(0, 0), B2, 0u); \
        G_BAR; G_WAIT_L(0); G_MMA(0, 1, At, B1); G_BAR; \
        G_LDA(At, 0, 1); G_STAGE_A(G_SA(0, 0), A2, ON, 0); \
        G_BAR; G_WAIT_L(0); G_MMA(1, 0, At, B0); G_BAR; G_SCHED; \
        G_STAGE_B(G_SB(0, 1), B2, hstepB); \
        G_WAIT_V(6); G_BAR; G_MMA(1, 1, At, B1); G_BAR; \
        G_LDB(B0, 1, 0); G_SCHED; G_LDA(At, 1, 0); G_STAGE_A(G_SA(0, 1), A2, ON, 1); \
        G_WAIT_L(8); G_BAR; G_WAIT_L(0); G_MMA(0, 0, At, B0); G_BAR; G_SCHED; \
        G_LDB(B1, 1, 1); G_STAGE_B(G_SB(1, 0), (B2) + kstep, 0u); \
        G_BAR; G_WAIT_L(0); G_MMA(0, 1, At, B1); G_BAR; \
        G_LDA(At, 1, 1); G_STAGE_A(G_SA(1, 0), (A2) + kstep, ON, 0); \
        G_BAR; G_WAIT_L(0); G_MMA(1, 0, At, B0); G_BAR; G_SCHED; \
        G_STAGE_B(G_SB(1, 1), (B2) + kstep, hstepB); \
        G_WAIT_V(6); G_BAR; G_MMA(1, 1, At, B1); G_BAR; } while (0)
    Unit cur, nxt; int ui = 0;
    if (!P.next(0, cur)) return;
    f32x4 acc[2][2][4][2];
#pragma unroll
    for (int a = 0; a < 2; ++a)
#pragma unroll
        for (int b = 0; b < 2; ++b)
#pragma unroll
            for (int m = 0; m < 4; ++m)
#pragma unroll
                for (int n = 0; n < 2; ++n) acc[a][b][m][n] = (f32x4){0.f, 0.f, 0.f, 0.f};
    const int mxs = 0x7f7f7f7f;
    bf16x8 At[4][2], B0[2][2], B1[2][2]; v8i At8[4], B08[2], B18[2];
    unsigned oc[2][2], on[2][2];
#pragma unroll
    for (int h = 0; h < 2; ++h)
#pragma unroll
        for (int i = 0; i < 2; ++i) { oc[h][i] = POL::GATHER ? P.a_off(cur, h * HALFT + sR[i]) + (unsigned)sC[i] * 2u : 0u; on[h][i] = 0u; }
    const char* cA = P.a_base(cur); const char* cB = P.b_base(cur);
    G_STAGE_B(G_SB(0, 0), cB, 0u); G_STAGE_A(G_SA(0, 0), cA, oc, 0); G_STAGE_B(G_SB(0, 1), cB, hstepB); G_STAGE_A(G_SA(0, 1), cA, oc, 1);
    if (wr == 1) G_BAR;
    G_WAIT_V(4); G_BAR;
    G_STAGE_B(G_SB(1, 0), cB + kstep, 0u); G_STAGE_A(G_SA(1, 0), cA + kstep, oc, 0); G_STAGE_B(G_SB(1, 1), cB + kstep, hstepB);
    G_WAIT_V(6); G_BAR;
    for (;;) {
        const bool has_next = P.next(ui + 1, nxt);
        const char* nA = has_next ? P.a_base(nxt) : cA; const char* nB = has_next ? P.b_base(nxt) : cB;
        if (POL::GATHER) {
#pragma unroll
            for (int h = 0; h < 2; ++h)
#pragma unroll
                for (int i = 0; i < 2; ++i) on[h][i] = has_next ? P.a_off(nxt, h * HALFT + sR[i]) + (unsigned)sC[i] * 2u : oc[h][i];
        }
#pragma unroll 1
        for (int t = 0; t < nt; t += 2) {
            const bool last = (t == nt - 2);
            const char* a1 = cA + (size_t)(t + 1) * kstep; const char* a2 = last ? nA : cA + (size_t)(t + 2) * kstep; const char* b2 = last ? nB : cB + (size_t)(t + 2) * kstep;
            if (POL::GATHER) {
                unsigned os[2][2];
#pragma unroll
                for (int h = 0; h < 2; ++h)
#pragma unroll
                    for (int i = 0; i < 2; ++i) os[h][i] = last ? on[h][i] : oc[h][i];
                G_TRIP(a1, oc, a2, os, b2);
            } else { G_TRIP(a1, oc, a2, oc, b2); }
        }
        if (POL::FP8) asm volatile("s_nop 15\n\ts_nop 15" ::: "memory");
        if (wr == 0) G_BAR;
        P.epi(acc, cur, wr, wc, fr, fq);
        if (!has_next) break;
#pragma unroll
        for (int a = 0; a < 2; ++a)
#pragma unroll
            for (int b = 0; b < 2; ++b)
#pragma unroll
                for (int m = 0; m < 4; ++m)
#pragma unroll
                    for (int n = 0; n < 2; ++n) acc[a][b][m][n] = (f32x4){0.f, 0.f, 0.f, 0.f};
        cur = nxt; cA = nA; cB = nB; ++ui;
        if (POL::GATHER) {
#pragma unroll
            for (int h = 0; h < 2; ++h)
#pragma unroll
                for (int i = 0; i < 2; ++i) oc[h][i] = on[h][i];
        }
        if (wr == 1) G_BAR;
    }
    G_WAIT_V(0);
    G_BAR;
#undef G_SA
#undef G_SB
#undef G_AOFF
#undef G_STAGE_A
#undef G_STAGE_B
#undef G_LDA
#undef G_LDB
#undef G_MMA
#undef G_LD8
#undef G_WAIT_V
#undef G_WAIT_L
#undef G_BAR
#undef G_SCHED
#undef G_TRIP
}

struct PolInProj {
    static constexpr bool PERM = true, GATHER = false, FP8 = false;
    const bf16_t* A; const bf16_t* Bt; bf16_t* O; TileOrder ord;
    __device__ __forceinline__ bool next(int i, Unit& u) const {
        constexpr int NLATU = (NLAT / BM) * (INW / BM);
        const int L = i * ord.G + ord.c;
        if (L < NLATU) return ord.tile(i, u.pm, u.pn);
        const int q = L - NLATU; if (q >= (NCTX / BM) * 8) return false;
        u.pm = NLAT / BM + (q >> 3); const int j = q & 7; u.pn = j < 6 ? 2 + j : 4 + j; return true;
    }
    __device__ __forceinline__ const char* a_base(const Unit& u) const { return (const char*)A + (size_t)u.pm * BM * GK * 2; }
    __device__ __forceinline__ unsigned a_off(const Unit&, int r) const { return (unsigned)r * GK * 2u; }
    __device__ __forceinline__ const char* b_base(const Unit& u) const { return (const char*)Bt + (size_t)u.pn * BM * GK * 2; }
    __device__ __forceinline__ void epi(const f32x4 (&acc)[2][2][4][2], const Unit& u, int wr, int wc, int fr, int fq) const {
        const int row0 = u.pm * BM + wr * 64 + fr, col0 = u.pn * BM + wc * 32 + 8 * fq;
#pragma unroll
        for (int ai = 0; ai < 2; ++ai)
#pragma unroll
            for (int m = 0; m < 4; ++m) { bf16_t* rowp = O + (size_t)(row0 + ai * HALFT + m * 16) * INW + col0;
#pragma unroll
                for (int bj = 0; bj < 2; ++bj) { const f32x4 v0 = acc[ai][bj][m][0], v1 = acc[ai][bj][m][1];
                    u32x4 w; w.x = cvt_pk_bf16(v0[0], v0[1]); w.y = cvt_pk_bf16(v0[2], v0[3]); w.z = cvt_pk_bf16(v1[0], v1[1]); w.w = cvt_pk_bf16(v1[2], v1[3]);
                    *(u32x4*)(rowp + bj * HALFT) = w; } }
    }
};
struct PolOutProj {
    static constexpr bool PERM = true, GATHER = false, FP8 = false;
    const bf16_t* A; const bf16_t* Bt; const float* x; const float* mod; bf16_t* O; TileOrder ord;
    __device__ __forceinline__ bool next(int i, Unit& u) const { return ord.tile(i, u.pm, u.pn); }
    __device__ __forceinline__ const char* a_base(const Unit& u) const { return (const char*)A + (size_t)u.pm * BM * GK * 2; }
    __device__ __forceinline__ unsigned a_off(const Unit&, int r) const { return (unsigned)r * GK * 2u; }
    __device__ __forceinline__ const char* b_base(const Unit& u) const { return (const char*)Bt + (size_t)u.pn * BM * GK * 2; }
    __device__ __forceinline__ void epi(const f32x4 (&acc)[2][2][4][2], const Unit& u, int wr, int wc, int fr, int fq) const {
        const int row0 = u.pm * BM + wr * 64 + fr, col0 = u.pn * BM + wc * 32 + 8 * fq;
        const float* g1 = mod + (size_t)((u.pm * BM) >> 11) * 6144 + 2048 + col0;
        f32x4 gv[2][2];
#pragma unroll
        for (int bj = 0; bj < 2; ++bj) { gv[bj][0] = *(const f32x4*)(g1 + bj * HALFT); gv[bj][1] = *(const f32x4*)(g1 + bj * HALFT + 4); }
#pragma unroll
        for (int ai = 0; ai < 2; ++ai)
#pragma unroll
            for (int m = 0; m < 4; ++m) { const size_t off = (size_t)(row0 + ai * HALFT + m * 16) * D + col0;
#pragma unroll
                for (int bj = 0; bj < 2; ++bj) {
                    const f32x4 x0 = __builtin_nontemporal_load((const f32x4*)(x + off + bj * HALFT)), x1v = __builtin_nontemporal_load((const f32x4*)(x + off + bj * HALFT + 4));
                    const f32x4 v0 = x0 + gv[bj][0] * acc[ai][bj][m][0], v1 = x1v + gv[bj][1] * acc[ai][bj][m][1];
                    u32x4 w; w.x = cvt_pk_bf16(v0[0], v0[1]); w.y = cvt_pk_bf16(v0[2], v0[3]); w.z = cvt_pk_bf16(v1[0], v1[1]); w.w = cvt_pk_bf16(v1[2], v1[3]);
                    *(u32x4*)(O + off + bj * HALFT) = w; }
                asm volatile("" ::: "memory"); }
    }
};
struct MoeTiles {
    const LAS int* tstart; const u32* cnt; int half;
    __device__ __forceinline__ void find(Unit& u) const {
        const int e = __builtin_amdgcn_readfirstlane(tstart[64 + u.pm]);
        u.e = e; u.pos0 = (u.pm - __builtin_amdgcn_readfirstlane(tstart[e])) * BM; u.cn = (int)cnt[half * NE + e];
    }
};
struct PolGateUp {
    static constexpr bool PERM = true, GATHER = true, FP8 = true;
    const fp8_t* A; const fp8_t* Bt; const float* bgu; const u32* toktab; fp8_t* O; MoeTiles mt; TileOrder ord;
    __device__ __forceinline__ bool next(int i, Unit& u) const { if (!ord.tile(i, u.pm, u.pn)) return false; mt.find(u); return true; }
    __device__ __forceinline__ const char* a_base(const Unit&) const { return (const char*)A; }
    __device__ __forceinline__ unsigned a_off(const Unit& u, int r) const {
        const int p = u.pos0 + r; const u32 tk = toktab[((size_t)mt.half * NE + u.e) * CAP + (p < u.cn ? p : 0)];
        return (tk >> 2) * 1024u;
    }
    __device__ __forceinline__ const char* b_base(const Unit& u) const { return (const char*)Bt + ((size_t)u.e * 2048 + (size_t)u.pn * BM) * 1024; }
    __device__ __forceinline__ void epi(const f32x4 (&acc)[2][2][4][2], const Unit& u, int wr, int wc, int fr, int fq) const {
        const int row0 = u.pm * BM + wr * 64 + fr, cc = u.pn * HALFT + wc * 32 + 8 * fq;
        const float* bg = bgu + (size_t)u.e * 2048 + cc;
        const f32x4 bg0 = *(const f32x4*)bg, bg1 = *(const f32x4*)(bg + 4), bu0 = *(const f32x4*)(bg + 1024), bu1 = *(const f32x4*)(bg + 1028);
        constexpr float inv = 1.0f / (SC_H2 * SC_W);
#pragma unroll
        for (int ai = 0; ai < 2; ++ai)
#pragma unroll
            for (int m = 0; m < 4; ++m) {
                f32x4 g0 = acc[ai][0][m][0] * inv + bg0, g1 = acc[ai][0][m][1] * inv + bg1, u0 = acc[ai][1][m][0] * inv + bu0, u1 = acc[ai][1][m][1] * inv + bu1;
                float o[8];
#pragma unroll
                for (int j = 0; j < 4; ++j) {
                    const float ga = fminf(g0[j], 7.0f), gb = fminf(g1[j], 7.0f);
                    const float ua = fminf(fmaxf(u0[j], -7.0f), 7.0f), ub = fminf(fmaxf(u1[j], -7.0f), 7.0f);
                    o[j] = ga * sigmoidf_(1.702f * ga) * (ua + 1.0f) * SC_ACT; o[4 + j] = gb * sigmoidf_(1.702f * gb) * (ub + 1.0f) * SC_ACT;
                }
                uint2 w; w.x = pk4_fp8(o[0], o[1], o[2], o[3]); w.y = pk4_fp8(o[4], o[5], o[6], o[7]);
                *(uint2*)(O + (size_t)(row0 + ai * HALFT + m * 16) * DFF + cc) = w;
                asm volatile("" ::: "memory");
            }
    }
};
struct PolDown {
    static constexpr bool PERM = true, GATHER = false, FP8 = true;
    const fp8_t* A; const fp8_t* Bt; const float* bd; const u32* toktab; const float* wtab; fp8_t* O; MoeTiles mt; TileOrder ord;
    __device__ __forceinline__ bool next(int i, Unit& u) const { if (!ord.tile(i, u.pm, u.pn)) return false; mt.find(u); return true; }
    __device__ __forceinline__ const char* a_base(const Unit& u) const { return (const char*)A + (size_t)u.pm * BM * 1024; }
    __device__ __forceinline__ unsigned a_off(const Unit&, int r) const { return (unsigned)r * 1024u; }
    __device__ __forceinline__ const char* b_base(const Unit& u) const { return (const char*)Bt + ((size_t)u.e * 1024 + (size_t)u.pn * BM) * 1024; }
    __device__ __forceinline__ void epi(const f32x4 (&acc)[2][2][4][2], const Unit& u, int wr, int wc, int fr, int fq) const {
        const int col0 = u.pn * BM + wc * 32 + 8 * fq;
        const float* bp = bd + (size_t)u.e * D + col0;
        f32x4 bv[2][2];
#pragma unroll
        for (int bj = 0; bj < 2; ++bj) { bv[bj][0] = *(const f32x4*)(bp + bj * HALFT); bv[bj][1] = *(const f32x4*)(bp + bj * HALFT + 4); }
        const size_t tb = ((size_t)mt.half * NE + u.e) * CAP;
        constexpr float inv = 1.0f / (SC_ACT * SC_W);
#pragma unroll
        for (int ai = 0; ai < 2; ++ai)
#pragma unroll
            for (int m = 0; m < 4; ++m) {
                asm volatile("" ::: "memory");
                const int p = u.pos0 + ai * HALFT + wr * 64 + m * 16 + fr;
                if (p < u.cn) {
                    const u32 tk = toktab[tb + p]; const float wg = wtab[tb + p] * SC_Y;
                    fp8_t* rowp = O + (size_t)(tk - (u32)mt.half * HALF_TOK * 4u) * D + col0;
#pragma unroll
                    for (int bj = 0; bj < 2; ++bj) { const f32x4 v0 = (acc[ai][bj][m][0] * inv + bv[bj][0]) * wg, v1 = (acc[ai][bj][m][1] * inv + bv[bj][1]) * wg;
                        uint2 w; w.x = pk4_fp8(v0[0], v0[1], v0[2], v0[3]); w.y = pk4_fp8(v1[0], v1[1], v1[2], v1[3]);
                        *(uint2*)(rowp + bj * HALFT) = w; }
                }
            }
    }
};
__device__ __forceinline__ int moe_tile_table(LAS int* tstart, const u32* cnt, int half) {
    __syncthreads();
    if (threadIdx.x == 0) { int s = 0; for (int e = 0; e < NE; ++e) { tstart[e] = s; s += ((int)cnt[half * NE + e] + BM - 1) / BM; } tstart[NE] = s; }
    __syncthreads();
    const int tot = tstart[NE];
    for (int t = threadIdx.x; t < tot; t += 512) { int e = 0;
#pragma unroll 1
        for (int i = 1; i < NE; ++i) if (t >= tstart[i]) e = i;
        tstart[64 + t] = e; }
    __syncthreads();
    return tot;
}

__device__ __forceinline__ void conv_item(const float* __restrict__ W, int N, bf16_t* __restrict__ WT, int k0, int n0, size_t rowbase, LAS float* scr, int lane) {
#pragma unroll 4
    for (int i = 0; i < 16; ++i) { const int k = 4 * i + (lane >> 4); const f32x4 v = __builtin_nontemporal_load((const f32x4*)(W + (size_t)(k0 + k) * N + n0 + (lane & 15) * 4)); *(LAS f32x4*)(scr + k * 68 + (lane & 15) * 4) = v; }
    asm volatile("s_waitcnt lgkmcnt(0)" ::: "memory");
    const int c = lane & 7;
#pragma unroll
    for (int j = 0; j < 8; ++j) { const int n = (lane >> 3) + 8 * j; const LAS float* s = scr + (8 * c) * 68 + n;
        u32x4 o; o.x = cvt_pk_bf16(s[0 * 68], s[1 * 68]); o.y = cvt_pk_bf16(s[2 * 68], s[3 * 68]); o.z = cvt_pk_bf16(s[4 * 68], s[5 * 68]); o.w = cvt_pk_bf16(s[6 * 68], s[7 * 68]);
        *(u32x4*)(WT + (rowbase + n) * GK + k0 + 8 * c) = o; }
    asm volatile("s_waitcnt lgkmcnt(0)" ::: "memory");
}
__device__ __forceinline__ void conv_item8(const float* __restrict__ W, int N, fp8_t* __restrict__ WT, int k0, int n0, size_t rowbase, LAS float* scr, int lane) {
#pragma unroll 4
    for (int i = 0; i < 16; ++i) { const int k = 4 * i + (lane >> 4); const f32x4 v = __builtin_nontemporal_load((const f32x4*)(W + (size_t)(k0 + k) * N + n0 + (lane & 15) * 4)); *(LAS f32x4*)(scr + k * 68 + (lane & 15) * 4) = v; }
    asm volatile("s_waitcnt lgkmcnt(0)" ::: "memory");
    const LAS float* sp = scr + lane;
#pragma unroll
    for (int q = 0; q < 4; ++q) {
        u32x4 o;
        o.x = pk4_fp8(sp[(16 * q + 0) * 68] * SC_W, sp[(16 * q + 1) * 68] * SC_W, sp[(16 * q + 2) * 68] * SC_W, sp[(16 * q + 3) * 68] * SC_W);
        o.y = pk4_fp8(sp[(16 * q + 4) * 68] * SC_W, sp[(16 * q + 5) * 68] * SC_W, sp[(16 * q + 6) * 68] * SC_W, sp[(16 * q + 7) * 68] * SC_W);
        o.z = pk4_fp8(sp[(16 * q + 8) * 68] * SC_W, sp[(16 * q + 9) * 68] * SC_W, sp[(16 * q + 10) * 68] * SC_W, sp[(16 * q + 11) * 68] * SC_W);
        o.w = pk4_fp8(sp[(16 * q + 12) * 68] * SC_W, sp[(16 * q + 13) * 68] * SC_W, sp[(16 * q + 14) * 68] * SC_W, sp[(16 * q + 15) * 68] * SC_W);
        *(u32x4*)(WT + (rowbase + lane) * GK + k0 + 16 * q) = o;
    }
    asm volatile("s_waitcnt lgkmcnt(0)" ::: "memory");
}
constexpr int IT_IN = 16 * (INW / 64), IT_OUT = 16 * (D / 64), IT_GU = NE * 16 * 32, IT_D = NE * 16 * 16, IT_ALL = IT_IN + IT_OUT + IT_GU + IT_D;
struct ProArgs { const float *c, *c_ctx, *w_ada, *b_ada, *lbl, *w_in, *w_out, *wgu, *wd, *rg_wa, *rg_wx, *rg_lam; float *mod, *lb, *coef; bf16_t *Win_t, *Wout_t, *WG_t; fp8_t *Wgu_t, *Wd_t; };
__device__ __forceinline__ void phase_prologue(LAS unsigned char* lds, const ProArgs& a, int bid, int G, bool do_mod, int it_lo, int it_hi) {
    const int tid = threadIdx.x, lane = tid & 63, w = tid >> 6;
    if (!do_mod) {} else if (bid < 96) {
        LAS float* s = (LAS float*)lds;
        for (int i = tid; i < 33 * D; i += 512) { const int b = i >> 10, k = i & 1023; const float v = b < NB ? a.c[(size_t)b * D + k] : a.c_ctx[k]; s[i] = v * sigmoidf_(v); }
        __syncthreads();
        const int n = bid * 64 + lane;
        float acc[33];
#pragma unroll
        for (int b = 0; b < 33; ++b) acc[b] = 0.f;
#pragma unroll 1
        for (int k = 128 * w; k < 128 * w + 128; k += 16) {
            float wv[16];
#pragma unroll
            for (int i = 0; i < 16; ++i) wv[i] = __builtin_nontemporal_load(a.w_ada + (size_t)(k + i) * 6144 + n);
#pragma unroll
            for (int b = 0; b < 33; ++b)
#pragma unroll
                for (int i4 = 0; i4 < 4; ++i4) { const f32x4 sv = *(const LAS f32x4*)(s + b * D + k + 4 * i4); acc[b] += sv[0] * wv[4 * i4] + sv[1] * wv[4 * i4 + 1] + sv[2] * wv[4 * i4 + 2] + sv[3] * wv[4 * i4 + 3]; }
        }
        __syncthreads();
        LAS float* red = (LAS float*)lds;
#pragma unroll
        for (int b = 0; b < 33; ++b) red[(w * 33 + b) * 64 + lane] = acc[b];
        __syncthreads();
        for (int i = tid; i < 33 * 64; i += 512) { const int b = i >> 6, l = i & 63; float sum = a.b_ada[bid * 64 + l];
#pragma unroll
            for (int ww = 0; ww < 8; ++ww) sum += red[(ww * 33 + b) * 64 + l];
            a.mod[(size_t)b * 6144 + bid * 64 + l] = sum; }
        __syncthreads();
    } else if (bid == 96) {
        for (int i = tid; i < 2 * HGW; i += 512) { const float l0 = a.lbl[i], l1 = a.lbl[2 * HGW + i]; a.lb[i] = 1.0f / (1.0f + __expf(l1 - l0)); }
        for (int i = tid; i < 2 * RGW; i += 512) { const float l = a.rg_lam[i]; const float sp = (-l > 20.f) ? -l : log1pf(__expf(-l)); a.coef[i] = -8.0f * sp; }
    } else if (bid == 97) {
        for (int idx = tid; idx < 8 * 256 * 64; idx += 512) { const int hd = idx >> 14, n = (idx >> 6) & 255, kk = idx & 63, g = n >> 6, j = n & 63, d = g >> 1;
            const float* src = (g & 1) ? a.rg_wx : a.rg_wa; a.WG_t[idx] = f2bf(src[(((size_t)d * 8 + hd) * 64 + kk) * 64 + j]); }
    }
    LAS float* scr = (LAS float*)(lds + w * (64 * 68 * 4));
    const int gw = bid * 8 + w, NW = G * 8;
    for (int it = it_lo + gw; it < it_hi; it += NW) {
        int r = it;
        if (r < IT_IN) { const int kb = r / (INW / 64), nb = r % (INW / 64); conv_item(a.w_in, INW, a.Win_t, kb * 64, nb * 64, (size_t)nb * 64, scr, lane); continue; } r -= IT_IN;
        if (r < IT_OUT) { const int kb = r / 16, nb = r % 16; conv_item(a.w_out, D, a.Wout_t, kb * 64, nb * 64, (size_t)nb * 64, scr, lane); continue; } r -= IT_OUT;
        if (r < IT_GU) { const int e = r / 512, q = r % 512, kb = q / 32, nb = q % 32, n0 = nb * 64, bj = n0 >> 10, rem = n0 & 1023, pn = rem >> 7, cc0 = rem & 127;
            conv_item8(a.wgu + (size_t)e * D * 2048, 2048, a.Wgu_t, kb * 64, n0, (size_t)e * 2048 + pn * 256 + bj * 128 + cc0, scr, lane); continue; } r -= IT_GU;
        { const int e = r / 256, q = r % 256, kb = q / 16, nb = q % 16; conv_item8(a.wd + (size_t)e * DFF * D, D, a.Wd_t, kb * 64, nb * 64, (size_t)e * 1024 + nb * 64, scr, lane); }
    }
}


__device__ __forceinline__ void phase_norm1(const float* __restrict__ x, const float* __restrict__ ctx, const float* __restrict__ nw, const float* __restrict__ mod, bf16_t* __restrict__ H, int bid, int G) {
    constexpr int RB = 4;
    const int lane = threadIdx.x & 63, gw = bid * 8 + (threadIdx.x >> 6), NW = G * 8;
    for (int r0 = gw; r0 < NROWS; r0 += RB * NW) {
        f32x4 v[RB][4];
#pragma unroll
        for (int q = 0; q < RB; ++q) { const int r = r0 + q * NW; const int rr = r < NROWS ? r : r0;
            const float* src = rr < NLAT ? x + (size_t)rr * D : ctx + (size_t)(rr - NLAT) * D;
#pragma unroll
            for (int j = 0; j < 4; ++j) v[q][j] = __builtin_nontemporal_load((const f32x4*)(src + j * 256 + lane * 4)); }
#pragma unroll
        for (int q = 0; q < RB; ++q) { const int r = r0 + q * NW; if (r < NROWS) {
            const float* m = mod + (size_t)(r < NLAT ? (r >> 11) : NB) * 6144;
            float ss = 0.f;
#pragma unroll
            for (int j = 0; j < 4; ++j) ss += v[q][j][0] * v[q][j][0] + v[q][j][1] * v[q][j][1] + v[q][j][2] * v[q][j][2] + v[q][j][3] * v[q][j][3];
            const float rstd = __builtin_amdgcn_rsqf(wave_sum(ss) * (1.0f / D) + EPS);
#pragma unroll
            for (int j = 0; j < 4; ++j) {
                const int c0 = j * 256 + lane * 4;
                const f32x4 w = *(const f32x4*)(nw + c0), sh = *(const f32x4*)(m + c0), sc = *(const f32x4*)(m + 1024 + c0);
                const f32x4 o = v[q][j] * rstd * w * (sc + 1.0f) + sh;
                uint2 p; p.x = cvt_pk_bf16(o[0], o[1]); p.y = cvt_pk_bf16(o[2], o[3]);
                *(uint2*)(H + (size_t)r * D + c0) = p;
            } } }
    }
}

__device__ __forceinline__ void phase_hgrn2_simple(LAS unsigned char* lds, const bf16_t* __restrict__ P, const float* __restrict__ lb, bf16_t* __restrict__ OF, bf16_t* __restrict__ OB, int item) {
    LAS float* qs = (LAS float*)lds; LAS float* fs = qs + 32 * 128; LAS float* vs = fs + 32 * 128;
    const int b = item >> 3, h = (item >> 1) & 3, dir = item & 1;
    const int tid = threadIdx.x, w = tid >> 6, lane = tid & 63, vi = lane & 15, kg = lane >> 4, v = 16 * w + vi;
    bf16_t* OD = dir == 0 ? OF : OB;
    float S[32];
#pragma unroll
    for (int i = 0; i < 32; ++i) S[i] = 0.f;
    const int lt = tid >> 4, lc = (tid & 15) * 8;
    float lbv[8];
#pragma unroll
    for (int i = 0; i < 8; ++i) lbv[i] = lb[dir * HGW + h * 128 + lc + i];
    const int cf = dir == 0 ? C_FF : C_FB;
    for (int n0 = 0; n0 < CTXL + T; n0 += 32) {
        __syncthreads();
        {
            const int n = n0 + lt;
            size_t row;
            if (n < CTXL) row = (size_t)NLAT + b * CTXL + (dir == 0 ? n : CTXL - 1 - n);
            else row = (size_t)b * T + (dir == 0 ? (n - CTXL) : (T - 1 - (n - CTXL)));
            const bf16_t* pr = P + row * INW + h * 128 + lc;
            const uint4 qv = *(const uint4*)(pr + C_Q), iv = *(const uint4*)(pr + C_I), fv = *(const uint4*)(pr + cf);
            const u32 qa[4] = {qv.x, qv.y, qv.z, qv.w}, ia[4] = {iv.x, iv.y, iv.z, iv.w}, fa[4] = {fv.x, fv.y, fv.z, fv.w};
#pragma unroll
            for (int i = 0; i < 4; ++i) {
                const float q0 = __uint_as_float(qa[i] << 16), q1 = __uint_as_float(qa[i] & 0xffff0000u);
                const float f0 = __uint_as_float(fa[i] << 16), f1 = __uint_as_float(fa[i] & 0xffff0000u);
                qs[lt * 128 + lc + 2 * i] = q0 * sigmoidf_(q0); qs[lt * 128 + lc + 2 * i + 1] = q1 * sigmoidf_(q1);
                vs[lt * 128 + lc + 2 * i] = __uint_as_float(ia[i] << 16); vs[lt * 128 + lc + 2 * i + 1] = __uint_as_float(ia[i] & 0xffff0000u);
                fs[lt * 128 + lc + 2 * i] = lbv[2 * i] + (1.f - lbv[2 * i]) * sigmoidf_(f0);
                fs[lt * 128 + lc + 2 * i + 1] = lbv[2 * i + 1] + (1.f - lbv[2 * i + 1]) * sigmoidf_(f1);
            }
        }
        __syncthreads();
        for (int j = 0; j < 32; ++j) {
            const float vv = vs[j * 128 + v];
            float o = 0.f;
#pragma unroll
            for (int i4 = 0; i4 < 8; ++i4) {
                const f32x4 f4 = *(const LAS f32x4*)(fs + j * 128 + 32 * kg + 4 * i4), q4 = *(const LAS f32x4*)(qs + j * 128 + 32 * kg + 4 * i4);
#pragma unroll
                for (int e = 0; e < 4; ++e) { S[4 * i4 + e] = f4[e] * (S[4 * i4 + e] - vv) + vv; o += S[4 * i4 + e] * q4[e]; }
            }
            o += __shfl_xor(o, 16); o += __shfl_xor(o, 32);
            const int n = n0 + j;
            if (n >= CTXL && kg == 0) {
                const int tt = dir == 0 ? (n - CTXL) : (T - 1 - (n - CTXL));
                OD[((size_t)b * T + tt) * HGW + h * 128 + v] = f2bf(o);
            }
        }
    }
}

constexpr int HQ_QD = 0, HQ_KD = 17408, HQ_KET = 34816, HQ_VT = 53248, HQ_PM = 71680, HQ_OS = 80896, HQ_TOT = 98304, HQ_DEC = 100352;
__device__ __forceinline__ bf16x8 pack8(const f32x4& a, const f32x4& b) {
    u32x4 w; w.x = cvt_pk_bf16(a[0], a[1]); w.y = cvt_pk_bf16(a[2], a[3]); w.z = cvt_pk_bf16(b[0], b[1]); w.w = cvt_pk_bf16(b[2], b[3]);
    return __builtin_bit_cast(bf16x8, w);
}
__device__ __forceinline__ void phase_hgrn2_chunk(LAS unsigned char* lds, const bf16_t* __restrict__ P, const float* __restrict__ lb, bf16_t* __restrict__ OF, bf16_t* __restrict__ OB, int item) {
    const int b = item >> 3, h = (item >> 1) & 3, dir = item & 1;
    const int tid = threadIdx.x, w = __builtin_amdgcn_readfirstlane(tid >> 6), lane = tid & 63, l15 = lane & 15, G4 = lane >> 4;
    const int k = tid & 127, seg = tid >> 7;
    const int kslot = (k & ~31) | (((k >> 2) & 3) << 3) | (((k >> 4) & 1) << 2) | (k & 3);
    const float lbv = lb[dir * HGW + h * 128 + k];
    bf16_t* OD = dir ? OB : OF;
    const int cf = dir ? C_FB : C_FF;
    LAS float* TOT = (LAS float*)(lds + HQ_TOT); LAS float* DEC = (LAS float*)(lds + HQ_DEC);
    f32x4 S[8];
#pragma unroll
    for (int t = 0; t < 8; ++t) S[t] = (f32x4){0.f, 0.f, 0.f, 0.f};
    bf16_t rq[16], rv[16], rf[16];
#define HG_LOAD(nn) do { _Pragma("unroll") for (int i = 0; i < 16; ++i) { const int p = 64 * (nn) + 16 * seg + i; \
            const size_t row = p < CTXL ? (size_t)NLAT + b * CTXL + (dir ? CTXL - 1 - p : p) : (size_t)b * T + (dir ? T - 1 - (p - CTXL) : (p - CTXL)); \
            const bf16_t* pr = P + row * INW + h * 128 + k; rq[i] = pr[C_Q]; rv[i] = pr[C_I]; rf[i] = pr[cf]; } } while (0)
    HG_LOAD(0);
#pragma unroll 1
    for (int n = 0; n < (CTXL + T) / 64; ++n) {
        const bool lat = n >= CTXL / 64;
        float qv[16], vv[16], fv[16], cs[16];
#pragma unroll
        for (int i = 0; i < 16; ++i) { qv[i] = bf2f(rq[i]); vv[i] = bf2f(rv[i]); fv[i] = bf2f(rf[i]); }
        if (n + 1 < (CTXL + T) / 64) HG_LOAD(n + 1);
        float run = 0.f;
#pragma unroll
        for (int i = 0; i < 16; ++i) { const float f = lbv + (1.f - lbv) * sigmoidf_(fv[i]); fv[i] = f; run += flog(f); cs[i] = run; }
        __syncthreads();
        TOT[seg * 128 + k] = run;
        __syncthreads();
        const float t0 = TOT[k], t1 = TOT[128 + k], t2 = TOT[256 + k], t3 = TOT[384 + k];
        const float prefix = seg == 0 ? 0.f : seg == 1 ? t0 : seg == 2 ? t0 + t1 : t0 + t1 + t2;
        const float blast = (t0 + t1) + (t2 + t3);
        const float eb = fexp(blast);
        if (seg == 0) DEC[k] = eb;
        float ke[16];
#pragma unroll
        for (int i = 0; i < 16; ++i) {
            const float bc = prefix + cs[i], e = fexp(bc), kf = (1.f - fv[i]) * frcp(e);
            const int j = 16 * seg + i;
            *(LAS bf16_t*)(lds + HQ_QD + j * 272 + kslot * 2) = f2bf(qv[i] * sigmoidf_(qv[i]) * e);
            *(LAS bf16_t*)(lds + HQ_KD + j * 272 + kslot * 2) = f2bf(kf);
            ke[i] = kf * eb;
        }
        {
            u32x4 w0, w1;
            w0.x = cvt_pk_bf16(ke[0], ke[1]); w0.y = cvt_pk_bf16(ke[2], ke[3]); w0.z = cvt_pk_bf16(ke[4], ke[5]); w0.w = cvt_pk_bf16(ke[6], ke[7]);
            w1.x = cvt_pk_bf16(ke[8], ke[9]); w1.y = cvt_pk_bf16(ke[10], ke[11]); w1.z = cvt_pk_bf16(ke[12], ke[13]); w1.w = cvt_pk_bf16(ke[14], ke[15]);
            *(LAS u32x4*)(lds + HQ_KET + k * 144 + seg * 32) = w0; *(LAS u32x4*)(lds + HQ_KET + k * 144 + seg * 32 + 16) = w1;
            w0.x = cvt_pk_bf16(vv[0], vv[1]); w0.y = cvt_pk_bf16(vv[2], vv[3]); w0.z = cvt_pk_bf16(vv[4], vv[5]); w0.w = cvt_pk_bf16(vv[6], vv[7]);
            w1.x = cvt_pk_bf16(vv[8], vv[9]); w1.y = cvt_pk_bf16(vv[10], vv[11]); w1.z = cvt_pk_bf16(vv[12], vv[13]); w1.w = cvt_pk_bf16(vv[14], vv[15]);
            *(LAS u32x4*)(lds + HQ_VT + k * 144 + seg * 32) = w0; *(LAS u32x4*)(lds + HQ_VT + k * 144 + seg * 32 + 16) = w1;
        }
        __syncthreads();
        if (lat) {
            const int mt = w >> 1, ntp = w & 1;
            f32x4 pa[2] = {(f32x4){0.f, 0.f, 0.f, 0.f}, (f32x4){0.f, 0.f, 0.f, 0.f}};
#pragma unroll
            for (int s = 0; s < 4; ++s) {
                const bf16x8 a = *(const LAS bf16x8*)(lds + HQ_QD + (16 * mt + l15) * 272 + (32 * s + 8 * G4) * 2);
#pragma unroll
                for (int q = 0; q < 2; ++q) { const bf16x8 bq = *(const LAS bf16x8*)(lds + HQ_KD + (16 * (2 * ntp + q) + l15) * 272 + (32 * s + 8 * G4) * 2); pa[q] = __builtin_amdgcn_mfma_f32_16x16x32_bf16(a, bq, pa[q], 0, 0, 0); }
            }
#pragma unroll
            for (int q = 0; q < 2; ++q)
#pragma unroll
                for (int r = 0; r < 4; ++r) { const int c = 16 * mt + 4 * G4 + r, j = 16 * (2 * ntp + q) + l15; *(LAS bf16_t*)(lds + HQ_PM + c * 144 + j * 2) = f2bf(j <= c ? pa[q][r] : 0.f); }
        }
        __syncthreads();
        bf16x8 vb[2];
#pragma unroll
        for (int s = 0; s < 2; ++s) vb[s] = *(const LAS bf16x8*)(lds + HQ_VT + (16 * w + l15) * 144 + (32 * s + 8 * G4) * 2);
        if (lat) {
            bf16x8 sb[4];
#pragma unroll
            for (int s = 0; s < 4; ++s) sb[s] = pack8(S[2 * s], S[2 * s + 1]);
#pragma unroll
            for (int mt = 0; mt < 4; ++mt) {
                f32x4 oa = (f32x4){0.f, 0.f, 0.f, 0.f};
#pragma unroll
                for (int s = 0; s < 2; ++s) { const bf16x8 a = *(const LAS bf16x8*)(lds + HQ_PM + (16 * mt + l15) * 144 + (32 * s + 8 * G4) * 2); oa = __builtin_amdgcn_mfma_f32_16x16x32_bf16(a, vb[s], oa, 0, 0, 0); }
#pragma unroll
                for (int s = 0; s < 4; ++s) { const bf16x8 a = *(const LAS bf16x8*)(lds + HQ_QD + (16 * mt + l15) * 272 + (32 * s + 8 * G4) * 2); oa = __builtin_amdgcn_mfma_f32_16x16x32_bf16(a, sb[s], oa, 0, 0, 0); }
#pragma unroll
                for (int r = 0; r < 4; ++r) *(LAS bf16_t*)(lds + HQ_OS + (16 * mt + 4 * G4 + r) * 272 + (16 * w + l15) * 2) = f2bf(oa[r]);
            }
        }
#pragma unroll
        for (int t = 0; t < 8; ++t) {
            const f32x4 d4 = *(const LAS f32x4*)(DEC + 16 * t + 4 * G4);
            S[t] = S[t] * d4;
#pragma unroll
            for (int s = 0; s < 2; ++s) { const bf16x8 a = *(const LAS bf16x8*)(lds + HQ_KET + (16 * t + l15) * 144 + (32 * s + 8 * G4) * 2); S[t] = __builtin_amdgcn_mfma_f32_16x16x32_bf16(a, vb[s], S[t], 0, 0, 0); }
        }
        __syncthreads();
        if (lat) {
            const int j = tid >> 3, part = tid & 7, p = 64 * n + j, tt = dir ? T - 1 - (p - CTXL) : (p - CTXL);
            const u32x4 o0 = *(const LAS u32x4*)(lds + HQ_OS + j * 272 + part * 32), o1 = *(const LAS u32x4*)(lds + HQ_OS + j * 272 + part * 32 + 16);
            bf16_t* dst = OD + ((size_t)b * T + tt) * HGW + h * 128 + part * 16;
            *(u32x4*)dst = o0; *(u32x4*)(dst + 8) = o1;
        }
    }
#undef HG_LOAD
}

__device__ __forceinline__ size_t rg_row(int b, bool lat, int p) {
    return lat ? (size_t)b * T + (size_t)(p % GROWS) * GRIDW + (p / GROWS) : (size_t)NLAT + b * CTXL + p;
}
template <int dir>
__device__ __forceinline__ void rglru_simple_wave(LAS float* xs, const bf16_t* __restrict__ P, const float* __restrict__ conv_w, const float* __restrict__ conv_b,
                                                  const float* __restrict__ wa, const float* __restrict__ ba, const float* __restrict__ wx, const float* __restrict__ bx,
                                                  const float* __restrict__ lam, bf16_t* __restrict__ HD, int hd, int b) {
    const int j = threadIdx.x & 63, c = hd * 64 + j;
    float wac[64], wxc[64];
#pragma unroll
    for (int i = 0; i < 64; ++i) { wac[i] = wa[(((size_t)dir * 8 + hd) * 64 + i) * 64 + j]; wxc[i] = wx[(((size_t)dir * 8 + hd) * 64 + i) * 64 + j]; }
    const float cw0 = conv_w[0 * RGW + c], cw1 = conv_w[1 * RGW + c], cw2 = conv_w[2 * RGW + c], cw3 = conv_w[3 * RGW + c], cb = conv_b[c];
    const float bav = ba[dir * RGW + c], bxv = bx[dir * RGW + c];
    const float l = lam[dir * RGW + c];
    const float sp = (-l > 20.f) ? -l : log1pf(__expf(-l));
    const float coef = -8.0f * sp;
    float hst = 0.f;
    for (int seg = 0; seg < 2; ++seg) {
        const bool lat = seg == 1; const int L = lat ? T : CTXL;
        for (int s0 = 0; s0 < L; s0 += 16) {
            float xc[16];
            const int plo = dir == 0 ? s0 : L - 16 - s0;
            {
                float rx[19];
#pragma unroll
                for (int i = 0; i < 19; ++i) { const int p = plo - 2 + i; rx[i] = (p >= 0 && p < L) ? bf2f(P[rg_row(b, lat, p) * INW + C_RX + c]) : 0.f; }
#pragma unroll
                for (int i = 0; i < 16; ++i) xc[i] = cb + cw0 * rx[i] + cw1 * rx[i + 1] + cw2 * rx[i + 2] + cw3 * rx[i + 3];
            }
            asm volatile("s_waitcnt lgkmcnt(0)" ::: "memory");
#pragma unroll
            for (int i = 0; i < 16; ++i) xs[i * 64 + j] = xc[i];
            asm volatile("s_waitcnt lgkmcnt(0)" ::: "memory");
#pragma unroll
            for (int ii = 0; ii < 16; ++ii) {
                const int i = dir == 0 ? ii : 15 - ii;
                float ra = bav, xa = bxv;
#pragma unroll
                for (int k = 0; k < 64; ++k) { const float xv = xs[i * 64 + k]; ra += xv * wac[k]; xa += xv * wxc[k]; }
                const float r = sigmoidf_(ra), ig = sigmoidf_(xa);
                const float log_a = coef * r, a = __expf(log_a), mult = sqrtf(fmaxf(-expm1f(2.0f * log_a), 0.f));
                hst = a * hst + mult * ig * xc[i];
                if (lat) {
                    const int p = plo + i;
                    const int tt = (p % GROWS) * GRIDW + (p / GROWS);
                    HD[((size_t)b * T + tt) * RGW + c] = f2bf(hst);
                }
            }
        }
    }
}

constexpr int RG_XC = 0, RG_RGT = 66560, RG_CAR = 133120, RG_STRIDE = 1040, NCHK = (CTXL + T) / 64;
__device__ __forceinline__ int rg_off(int row, int chbyte) { return row * RG_STRIDE + ((((chbyte >> 4) ^ (((row >> 4) & 3) << 2)) << 4) | (chbyte & 15)); }
template <int PASS>
__device__ __forceinline__ void rg_item(LAS unsigned char* lds, const bf16_t* __restrict__ P, const float* __restrict__ conv_w, const float* __restrict__ conv_b, const bf16_t* __restrict__ WG_t,
                                        const float* __restrict__ ba, const float* __restrict__ bx, const float* __restrict__ coef, float* __restrict__ AGG, bf16_t* __restrict__ MIX, int b, int n, float hf_in = 0.f, float hb_in = 0.f) {
    const int tid = threadIdx.x, w = __builtin_amdgcn_readfirstlane(tid >> 6), lane = tid & 63, l15 = lane & 15, G4 = lane >> 4;
    const bool lat = n >= CTXL / 64; const int L = lat ? T : CTXL, p0 = 64 * (lat ? n - CTXL / 64 : n);
    __syncthreads();
#pragma unroll 1
    for (int it = 0; it < 2; ++it) {
        const int idx = tid + 512 * it, cg4 = idx & 127, pg = idx >> 7;
        float xin[11][4];
#pragma unroll
        for (int i = 0; i < 11; ++i) {
            const int p = p0 + 8 * pg - 2 + i;
            if (p >= 0 && p < L) { const uint2 v = *(const uint2*)(P + rg_row(b, lat, p) * INW + C_RX + cg4 * 4);
                xin[i][0] = __uint_as_float(v.x << 16); xin[i][1] = __uint_as_float(v.x & 0xffff0000u); xin[i][2] = __uint_as_float(v.y << 16); xin[i][3] = __uint_as_float(v.y & 0xffff0000u); }
            else { xin[i][0] = 0.f; xin[i][1] = 0.f; xin[i][2] = 0.f; xin[i][3] = 0.f; }
        }
        const f32x4 w0 = *(const f32x4*)(conv_w + 0 * RGW + cg4 * 4), w1 = *(const f32x4*)(conv_w + 1 * RGW + cg4 * 4), w2 = *(const f32x4*)(conv_w + 2 * RGW + cg4 * 4), w3 = *(const f32x4*)(conv_w + 3 * RGW + cg4 * 4);
        const f32x4 cb4 = *(const f32x4*)(conv_b + cg4 * 4);
#pragma unroll
        for (int q = 0; q < 8; ++q) {
            float o[4];
#pragma unroll
            for (int c = 0; c < 4; ++c) o[c] = cb4[c] + w0[c] * xin[q][c] + w1[c] * xin[q + 1][c] + w2[c] * xin[q + 2][c] + w3[c] * xin[q + 3][c];
            uint2 pk; pk.x = cvt_pk_bf16(o[0], o[1]); pk.y = cvt_pk_bf16(o[2], o[3]);
            *(LAS unsigned long long*)(lds + RG_XC + rg_off(8 * pg + q, cg4 * 8)) = ((unsigned long long)pk.y << 32) | pk.x;
        }
    }
    if (PASS == 2) {
        asm volatile("" ::: "memory");
#pragma unroll 2
        for (int it = 0; it < 8; ++it) { const int idx = tid + 512 * it, row = idx >> 6, ck = idx & 63;
            *(LAS u32x4*)(lds + RG_RGT + rg_off(row, ck * 16)) = *(const u32x4*)(P + rg_row(b, lat, p0 + row) * INW + C_RG + ck * 8); }
        const float hf = hf_in, hb = hb_in;
        LAS float* CAR = (LAS float*)(lds + RG_CAR); CAR[tid] = hf; CAR[RGW + tid] = hb;
    }
    __syncthreads();
    {
        const int hd = w;
        bf16x8 af[4][2];
#pragma unroll
        for (int mt = 0; mt < 4; ++mt)
#pragma unroll
            for (int s = 0; s < 2; ++s) af[mt][s] = *(const LAS bf16x8*)(lds + RG_XC + rg_off(16 * (l15 >> 2) + 4 * mt + (l15 & 3), (64 * hd + 32 * s + 8 * G4) * 2));
#define RG_LOADF(F, PRM, cg_, d_) do { const int ch_ = 64 * hd + 16 * (cg_) + l15; _Pragma("unroll") for (int s_ = 0; s_ < 2; ++s_) { \
            F[s_] = *(const bf16x8*)(WG_t + ((size_t)(hd * 256 + 64 * (2 * (d_)) + 16 * (cg_) + l15) * 64 + 32 * s_ + 8 * G4)); \
            F[2 + s_] = *(const bf16x8*)(WG_t + ((size_t)(hd * 256 + 64 * (2 * (d_) + 1) + 16 * (cg_) + l15) * 64 + 32 * s_ + 8 * G4)); } \
            PRM[0] = ba[(d_) * RGW + ch_]; PRM[1] = bx[(d_) * RGW + ch_]; PRM[2] = coef[(d_) * RGW + ch_]; } while (0)
        bf16x8 F0[4], F1[4]; float Q0[3], Q1[3];
        RG_LOADF(F0, Q0, 0, 0);
#pragma unroll 1
        for (int cg = 0; cg < 4; ++cg) {
            const int ch = 64 * hd + 16 * cg + l15;
            float hsum[16];
#pragma unroll
            for (int d = 0; d < 2; ++d) {
                if (d == 0) RG_LOADF(F1, Q1, cg, 1); else RG_LOADF(F0, Q0, (cg < 3 ? cg + 1 : 3), 0);
                f32x4 ra[4], xa[4];
#pragma unroll
                for (int mt = 0; mt < 4; ++mt) { ra[mt] = (f32x4){0.f, 0.f, 0.f, 0.f}; xa[mt] = (f32x4){0.f, 0.f, 0.f, 0.f}; }
#pragma unroll
                for (int mt = 0; mt < 4; ++mt)
#pragma unroll
                    for (int s = 0; s < 2; ++s) {
                        ra[mt] = __builtin_amdgcn_mfma_f32_16x16x32_bf16(af[mt][s], d == 0 ? F0[s] : F1[s], ra[mt], 0, 0, 0);
                        xa[mt] = __builtin_amdgcn_mfma_f32_16x16x32_bf16(af[mt][s], d == 0 ? F0[2 + s] : F1[2 + s], xa[mt], 0, 0, 0); }
                const float bav = d == 0 ? Q0[0] : Q1[0], bxv = d == 0 ? Q0[1] : Q1[1], cf = d == 0 ? Q0[2] : Q1[2];
                float av[16], bv[16];
#pragma unroll
                for (int t = 0; t < 16; ++t) {
                    const float r = sigmoidf_(ra[t >> 2][t & 3] + bav), ig = sigmoidf_(xa[t >> 2][t & 3] + bxv);
                    const float a = fexp(cf * r);
                    av[t] = a; bv[t] = fsqrt(fmaxf(1.0f - a * a, 0.f)) * ig * bf2f(*(const LAS bf16_t*)(lds + RG_XC + rg_off(16 * G4 + t, ch * 2)));
                }
                float Al = 1.f, Bl = 0.f;
                if (d == 0) {
#pragma unroll
                    for (int t = 0; t < 16; ++t) { Bl = av[t] * Bl + bv[t]; Al *= av[t]; }
                } else {
#pragma unroll
                    for (int t = 15; t >= 0; --t) { Bl = av[t] * Bl + bv[t]; Al *= av[t]; }
                }
                float Ag[4], Bg[4];
#pragma unroll
                for (int g = 0; g < 4; ++g) { Ag[g] = __shfl(Al, l15 + 16 * g); Bg[g] = __shfl(Bl, l15 + 16 * g); }
                if (PASS == 1) {
                    float A = 1.f, B = 0.f;
                    if (d == 0) {
#pragma unroll
                        for (int g = 0; g < 4; ++g) { B = Ag[g] * B + Bg[g]; A *= Ag[g]; }
                    } else {
#pragma unroll
                        for (int g = 3; g >= 0; --g) { B = Ag[g] * B + Bg[g]; A *= Ag[g]; }
                    }
                    if (G4 == 0) ((float2*)AGG)[((size_t)(b * NCHK + n) * 2 + d) * RGW + ch] = make_float2(A, B);
                } else {
                    const LAS float* CAR = (const LAS float*)(lds + RG_CAR);
                    float h = CAR[d * RGW + ch];
                    if (d == 0) {
                        const float s1 = Ag[0] * h + Bg[0], s2 = Ag[1] * s1 + Bg[1], s3 = Ag[2] * s2 + Bg[2];
                        h = G4 == 0 ? h : G4 == 1 ? s1 : G4 == 2 ? s2 : s3;
#pragma unroll
                        for (int t = 0; t < 16; ++t) { h = av[t] * h + bv[t]; hsum[t] = h; }
                    } else {
                        const float s2 = Ag[3] * h + Bg[3], s1 = Ag[2] * s2 + Bg[2], s0 = Ag[1] * s1 + Bg[1];
                        h = G4 == 3 ? h : G4 == 2 ? s2 : G4 == 1 ? s1 : s0;
#pragma unroll
                        for (int t = 15; t >= 0; --t) { h = av[t] * h + bv[t]; hsum[t] += h; }
                    }
                }
            }
            if (PASS == 2) {
#pragma unroll
                for (int t = 0; t < 16; ++t) { LAS bf16_t* q = (LAS bf16_t*)(lds + RG_RGT + rg_off(16 * G4 + t, ch * 2)); *q = f2bf(gelu_tanh(bf2f(*q)) * hsum[t]); }
            }
        }
    }
    if (PASS == 2) {
        __syncthreads();
#pragma unroll
        for (int it = 0; it < 8; ++it) { const int idx = tid + 512 * it, row = idx >> 6, ck = idx & 63;
            *(u32x4*)(MIX + rg_row(b, true, p0 + row) * D + HGW + ck * 8) = *(const LAS u32x4*)(lds + RG_RGT + rg_off(row, ck * 16)); }
    }
}

constexpr int RC_T = 64 * 144;
constexpr int RC_XC = 0, RC_RG = 2 * RC_T, RC_HI = 4 * RC_T, RC_OUT = 6 * RC_T;
__device__ __forceinline__ void phase_rg_chain(LAS unsigned char* lds, const bf16_t* __restrict__ P, const float* __restrict__ conv_w, const float* __restrict__ conv_b, const bf16_t* __restrict__ WG_t,
                                               const float* __restrict__ ba, const float* __restrict__ bx, const float* __restrict__ coef, bf16_t* __restrict__ HT, bf16_t* __restrict__ MIX, int item) {
    const int b = item >> 3, hd = item & 7;
    const int tid = threadIdx.x, w = __builtin_amdgcn_readfirstlane(tid >> 6), lane = tid & 63, l15 = lane & 15, G4 = lane >> 4;
    const int d = w >> 2, cg = w & 3, ch = 64 * hd + 16 * cg + l15;
    const int ds = tid >> 8, t8 = tid & 255, pg = t8 >> 4, cg4 = t8 & 15;
    bf16x8 F[4];
#pragma unroll
    for (int s = 0; s < 2; ++s) {
        F[s] = *(const bf16x8*)(WG_t + ((size_t)(hd * 256 + 64 * (2 * d) + 16 * cg + l15) * 64 + 32 * s + 8 * G4));
        F[2 + s] = *(const bf16x8*)(WG_t + ((size_t)(hd * 256 + 64 * (2 * d + 1) + 16 * cg + l15) * 64 + 32 * s + 8 * G4)); }
    const float bav = ba[d * RGW + ch], bxv = bx[d * RGW + ch], cf = coef[d * RGW + ch];
    const f32x4 cw0 = *(const f32x4*)(conv_w + 0 * RGW + 64 * hd + 4 * cg4), cw1 = *(const f32x4*)(conv_w + 1 * RGW + 64 * hd + 4 * cg4), cw2 = *(const f32x4*)(conv_w + 2 * RGW + 64 * hd + 4 * cg4),
                cw3 = *(const f32x4*)(conv_w + 3 * RGW + 64 * hd + 4 * cg4), cb4 = *(const f32x4*)(conv_b + 64 * hd + 4 * cg4);
    float hcar = 0.f;
#define RC_CHUNK(dd, s_) ((dd) == 0 ? (s_) : ((s_) < CTXL / 64 ? CTXL / 64 - 1 - (s_) : NCHK + CTXL / 64 - 1 - (s_)))
    u32x2 rxr[7]; u32x4 rgr[2], hir[2];
#define RC_LOAD_RX(s_) do { const int n_ = RC_CHUNK(ds, s_); const bool lat_ = n_ >= CTXL / 64; const int L_ = lat_ ? T : CTXL, p0_ = 64 * (lat_ ? n_ - CTXL / 64 : n_); \
        _Pragma("unroll") for (int i = 0; i < 7; ++i) { const int p = p0_ + 4 * pg - 2 + i; rxr[i] = (p >= 0 && p < L_) ? *(const u32x2*)(P + rg_row(b, lat_, p) * INW + C_RX + 64 * hd + 4 * cg4) : (u32x2){0u, 0u}; } } while (0)
#define RC_ROW(s_, q_) (rg_row(b, true, 64 * (RC_CHUNK(ds, s_) - CTXL / 64) + ((q_) >> 3)))
#define RC_LOAD_RG(s_) do { _Pragma("unroll") for (int j = 0; j < 2; ++j) { const int q = t8 * 2 + j; rgr[j] = *(const u32x4*)(P + RC_ROW(s_, q) * INW + C_RG + 64 * hd + (q & 7) * 8); } } while (0)
#define RC_LOAD_HI(s_) do { _Pragma("unroll") for (int j = 0; j < 2; ++j) { const int q = t8 * 2 + j; rgr[j] = rgr[j]; hir[j] = __builtin_nontemporal_load((const u32x4*)(HT + RC_ROW(s_, q) * RGW + 64 * hd + (q & 7) * 8)); } } while (0)
    RC_LOAD_RX(0);
#pragma unroll 1
    for (int s = 0; s < NCHK; ++s) {
        const int role = s < CTXL / 64 ? 0 : (s < 20 ? 1 : 2);
        if (s == 20) { asm volatile("s_waitcnt vmcnt(0)" ::: "memory"); __syncthreads(); RC_LOAD_RG(20); RC_LOAD_HI(20); }
        {
            float xin[7][4];
#pragma unroll
            for (int i = 0; i < 7; ++i) { xin[i][0] = __uint_as_float(rxr[i].x << 16); xin[i][1] = __uint_as_float(rxr[i].x & 0xffff0000u); xin[i][2] = __uint_as_float(rxr[i].y << 16); xin[i][3] = __uint_as_float(rxr[i].y & 0xffff0000u); }
#pragma unroll
            for (int q = 0; q < 4; ++q) {
                float o[4];
#pragma unroll
                for (int c = 0; c < 4; ++c) o[c] = cb4[c] + cw0[c] * xin[q][c] + cw1[c] * xin[q + 1][c] + cw2[c] * xin[q + 2][c] + cw3[c] * xin[q + 3][c];
                *(LAS unsigned long long*)(lds + RC_XC + ds * RC_T + (4 * pg + q) * 144 + cg4 * 8) = ((unsigned long long)cvt_pk_bf16(o[2], o[3]) << 32) | cvt_pk_bf16(o[0], o[1]);
            }
            if (role == 2) {
#pragma unroll
                for (int j = 0; j < 2; ++j) { const int q = t8 * 2 + j; *(LAS u32x4*)(lds + RC_RG + ds * RC_T + (q >> 3) * 144 + (q & 7) * 16) = rgr[j]; *(LAS u32x4*)(lds + RC_HI + ds * RC_T + (q >> 3) * 144 + (q & 7) * 16) = hir[j]; }
            }
        }
        __syncthreads();
        if (s + 1 < NCHK) { RC_LOAD_RX(s + 1); if (s + 1 > 20) { RC_LOAD_RG(s + 1); RC_LOAD_HI(s + 1); } }
        {
            bf16x8 af[4][2];
#pragma unroll
            for (int mt = 0; mt < 4; ++mt)
#pragma unroll
                for (int k = 0; k < 2; ++k) af[mt][k] = *(const LAS bf16x8*)(lds + RC_XC + d * RC_T + (16 * (l15 >> 2) + 4 * mt + (l15 & 3)) * 144 + (32 * k + 8 * G4) * 2);
            f32x4 ra[4], xa[4];
#pragma unroll
            for (int mt = 0; mt < 4; ++mt) { ra[mt] = (f32x4){0.f, 0.f, 0.f, 0.f}; xa[mt] = (f32x4){0.f, 0.f, 0.f, 0.f};
#pragma unroll
                for (int k = 0; k < 2; ++k) { ra[mt] = __builtin_amdgcn_mfma_f32_16x16x32_bf16(af[mt][k], F[k], ra[mt], 0, 0, 0); xa[mt] = __builtin_amdgcn_mfma_f32_16x16x32_bf16(af[mt][k], F[2 + k], xa[mt], 0, 0, 0); } }
            float av[16], bv[16];
#pragma unroll
            for (int t = 0; t < 16; ++t) {
                const float r = sigmoidf_(ra[t >> 2][t & 3] + bav), ig = sigmoidf_(xa[t >> 2][t & 3] + bxv);
                const float a = fexp(cf * r);
                av[t] = a; bv[t] = fsqrt(fmaxf(1.0f - a * a, 0.f)) * ig * bf2f(*(const LAS bf16_t*)(lds + RC_XC + d * RC_T + (16 * G4 + t) * 144 + (16 * cg + l15) * 2));
            }
            float Al = 1.f, Bl = 0.f;
            if (d == 0) {
#pragma unroll
                for (int t = 0; t < 16; ++t) { Bl = av[t] * Bl + bv[t]; Al *= av[t]; }
            } else {
#pragma unroll
                for (int t = 15; t >= 0; --t) { Bl = av[t] * Bl + bv[t]; Al *= av[t]; }
            }
            float Ag[4], Bg[4];
#pragma unroll
            for (int g = 0; g < 4; ++g) { Ag[g] = __shfl(Al, l15 + 16 * g); Bg[g] = __shfl(Bl, l15 + 16 * g); }
            float h = hcar, hend;
            if (d == 0) {
                const float s1 = Ag[0] * h + Bg[0], s2 = Ag[1] * s1 + Bg[1], s3 = Ag[2] * s2 + Bg[2]; hend = Ag[3] * s3 + Bg[3];
                h = G4 == 0 ? h : G4 == 1 ? s1 : G4 == 2 ? s2 : s3;
            } else {
                const float s2 = Ag[3] * h + Bg[3], s1 = Ag[2] * s2 + Bg[2], s0 = Ag[1] * s1 + Bg[1]; hend = Ag[0] * s0 + Bg[0];
                h = G4 == 3 ? h : G4 == 2 ? s2 : G4 == 1 ? s1 : s0;
            }
            hcar = hend;
            if (role != 0) {
                float hv[16];
                if (d == 0) {
#pragma unroll
                    for (int t = 0; t < 16; ++t) { h = av[t] * h + bv[t]; hv[t] = h; }
                } else {
#pragma unroll
                    for (int t = 15; t >= 0; --t) { h = av[t] * h + bv[t]; hv[t] = h; }
                }
#pragma unroll
                for (int t = 0; t < 16; ++t) {
                    const int off = (16 * G4 + t) * 144 + (16 * cg + l15) * 2;
                    float o = hv[t];
                    if (role == 2) o = gelu_tanh(bf2f(*(const LAS bf16_t*)(lds + RC_RG + d * RC_T + off))) * (o + bf2f(*(const LAS bf16_t*)(lds + RC_HI + d * RC_T + off)));
                    *(LAS bf16_t*)(lds + RC_OUT + d * RC_T + off) = f2bf(o);
                }
            }
        }
        __syncthreads();
        if (role != 0) {
#pragma unroll
            for (int j = 0; j < 2; ++j) { const int q = t8 * 2 + j; const u32x4 v = *(const LAS u32x4*)(lds + RC_OUT + ds * RC_T + (q >> 3) * 144 + (q & 7) * 16);
                if (role == 1) *(u32x4*)(HT + RC_ROW(s, q) * RGW + 64 * hd + (q & 7) * 8) = v;
                else *(u32x4*)(MIX + RC_ROW(s, q) * D + HGW + 64 * hd + (q & 7) * 8) = v; }
        }
    }
#undef RC_CHUNK
#undef RC_LOAD_RX
#undef RC_ROW
#undef RC_LOAD_RG
#undef RC_LOAD_HI
}

__device__ __forceinline__ void phase_mix_finish(const bf16_t* __restrict__ P, const bf16_t* __restrict__ OF, const bf16_t* __restrict__ OB,
                                                 const float* __restrict__ hg_nw, bf16_t* __restrict__ MIX, int bid, int G) {
    constexpr int RB = 4;
    const int lane = threadIdx.x & 63, gw = bid * 8 + (threadIdx.x >> 6), NW = G * 8, c0 = lane * 8;
    const f32x4 nw0 = *(const f32x4*)(hg_nw + c0), nw1 = *(const f32x4*)(hg_nw + c0 + 4);
    const float nwv[8] = {nw0[0], nw0[1], nw0[2], nw0[3], nw1[0], nw1[1], nw1[2], nw1[3]};
    for (int r0 = gw; r0 < NLAT; r0 += RB * NW) {
        u32x4 a4[RB], b4[RB], g4[RB];
#pragma unroll
        for (int q = 0; q < RB; ++q) { const int r = r0 + q * NW; const int rr = r < NLAT ? r : r0;
            a4[q] = *(const u32x4*)(OF + (size_t)rr * HGW + c0); b4[q] = *(const u32x4*)(OB + (size_t)rr * HGW + c0); g4[q] = *(const u32x4*)(P + (size_t)rr * INW + C_G + c0); }
#pragma unroll
        for (int q = 0; q < RB; ++q) { const int r = r0 + q * NW; if (r < NLAT) {
            float o[8]; float ss = 0.f;
#pragma unroll
            for (int i = 0; i < 4; ++i) { o[2 * i] = __uint_as_float(a4[q][i] << 16) + __uint_as_float(b4[q][i] << 16); o[2 * i + 1] = __uint_as_float(a4[q][i] & 0xffff0000u) + __uint_as_float(b4[q][i] & 0xffff0000u); }
#pragma unroll
            for (int i = 0; i < 8; ++i) ss += o[i] * o[i];
            ss += __shfl_xor(ss, 1); ss += __shfl_xor(ss, 2); ss += __shfl_xor(ss, 4); ss += __shfl_xor(ss, 8);
            const float rstd = __builtin_amdgcn_rsqf(ss * (1.0f / 128.0f) + EPS);
            u32x4 w;
#pragma unroll
            for (int i = 0; i < 4; ++i) {
                const float g0 = __uint_as_float(g4[q][i] << 16), g1 = __uint_as_float(g4[q][i] & 0xffff0000u);
                w[i] = cvt_pk_bf16(o[2 * i] * rstd * nwv[2 * i] * (g0 * sigmoidf_(g0)), o[2 * i + 1] * rstd * nwv[2 * i + 1] * (g1 * sigmoidf_(g1)));
            }
            *(u32x4*)(MIX + (size_t)r * D + c0) = w;
        } }
    }
}

__device__ __forceinline__ void phase_norm2_route(LAS unsigned char* lds, const bf16_t* __restrict__ x1, const float* __restrict__ nw, const float* __restrict__ mod,
                                                  const float* __restrict__ rw, const float* __restrict__ rb, fp8_t* __restrict__ H2,
                                                  u32* __restrict__ cnt, u32* __restrict__ toktab, float* __restrict__ wtab, int bid, int G) {
    LAS float* rwT = (LAS float*)lds;
    LAS u32* hist = (LAS u32*)(lds + 131072);
    LAS u32* ent = (LAS u32*)(lds + 131072 + 4096);
    const int tid = threadIdx.x, lane = tid & 63, w = tid >> 6;
    for (int i = tid; i < 32 * 1024; i += 512) { const int k = i >> 5, e = i & 31; rwT[e * 1024 + k] = rw[i]; }
    if (tid < 128) hist[tid] = 0;
    __syncthreads();
    const int gw = bid * 8 + w, NW = G * 8;
    int it = 0;
    uint2 vn[4];
#pragma unroll
    for (int j = 0; j < 4; ++j) vn[j] = *(const uint2*)(x1 + (size_t)gw * D + j * 256 + lane * 4);
    for (int r = gw; r < NLAT; r += NW, ++it) {
        const float* m = mod + (size_t)(r >> 11) * 6144;
        f32x4 v[4]; float ss = 0.f;
#pragma unroll
        for (int j = 0; j < 4; ++j) { v[j][0] = __uint_as_float(vn[j].x << 16); v[j][1] = __uint_as_float(vn[j].x & 0xffff0000u); v[j][2] = __uint_as_float(vn[j].y << 16); v[j][3] = __uint_as_float(vn[j].y & 0xffff0000u);
            ss += v[j][0] * v[j][0] + v[j][1] * v[j][1] + v[j][2] * v[j][2] + v[j][3] * v[j][3]; }
        { const int rn = r + NW < NLAT ? r + NW : r;
#pragma unroll
          for (int j = 0; j < 4; ++j) vn[j] = *(const uint2*)(x1 + (size_t)rn * D + j * 256 + lane * 4); }
        const float rstd = __builtin_amdgcn_rsqf(wave_sum(ss) * (1.0f / D) + EPS);
#pragma unroll
        for (int j = 0; j < 4; ++j) {
            const int c0 = j * 256 + lane * 4;
            const f32x4 ww = *(const f32x4*)(nw + c0), sh = *(const f32x4*)(m + 3072 + c0), sc = *(const f32x4*)(m + 4096 + c0);
            v[j] = v[j] * rstd * ww * (sc + 1.0f) + sh;
            *(unsigned*)(H2 + (size_t)r * D + c0) = pk4_fp8(v[j][0] * SC_H2, v[j][1] * SC_H2, v[j][2] * SC_H2, v[j][3] * SC_H2);
        }
        float part[32];
#pragma unroll
        for (int e = 0; e < 32; ++e) {
            float p = 0.f;
#pragma unroll
            for (int j = 0; j < 4; ++j) { const f32x4 q = *(const LAS f32x4*)(rwT + e * 1024 + j * 256 + lane * 4); p += v[j][0] * q[0] + v[j][1] * q[1] + v[j][2] * q[2] + v[j][3] * q[3]; }
            part[e] = p;
        }
#define RT_STEP(N, M) { const bool up = (lane & (M)) != 0; _Pragma("unroll") for (int i = 0; i < (N); ++i) { const float keep = up ? part[(N) + i] : part[i], send = up ? part[i] : part[(N) + i]; part[i] = keep + __shfl_xor(send, (M)); } }
        RT_STEP(16, 32) RT_STEP(8, 16) RT_STEP(4, 8) RT_STEP(2, 4) RT_STEP(1, 2)
#undef RT_STEP
        float mylogit = part[0] + __shfl_xor(part[0], 1);
        const int myexp = ((lane >> 5) & 1) * 16 + ((lane >> 4) & 1) * 8 + ((lane >> 3) & 1) * 4 + ((lane >> 2) & 1) * 2 + ((lane >> 1) & 1);
        mylogit += rb[myexp];
        int rank = 0;
#pragma unroll
        for (int q = 0; q < 32; ++q) {
            const int src = ((q >> 4) & 1) * 32 + ((q >> 3) & 1) * 16 + ((q >> 2) & 1) * 8 + ((q >> 1) & 1) * 4 + (q & 1) * 2;
            const float oq = __builtin_bit_cast(float, __builtin_amdgcn_readlane(__builtin_bit_cast(int, mylogit), src));
            rank += (oq > mylogit || (oq == mylogit && q < myexp)) ? 1 : 0;
        }
        float tv[4]; int ti[4];
#pragma unroll
        for (int k = 0; k < 4; ++k) {
            const unsigned long long mk = __ballot(rank == k && (lane & 1) == 0);
            const int src = __builtin_amdgcn_readfirstlane((int)__builtin_ctzll(mk));
            tv[k] = __builtin_bit_cast(float, __builtin_amdgcn_readlane(__builtin_bit_cast(int, mylogit), src));
            ti[k] = ((src >> 5) & 1) * 16 + ((src >> 4) & 1) * 8 + ((src >> 3) & 1) * 4 + ((src >> 2) & 1) * 2 + ((src >> 1) & 1);
        }
        const float e1 = fexp(tv[1] - tv[0]), e2 = fexp(tv[2] - tv[0]), e3 = fexp(tv[3] - tv[0]); const float inv = frcp(1.0f + e1 + e2 + e3);
        const float g0 = inv, g1 = e1 * inv, g2 = e2 * inv, g3 = e3 * inv;
        if (lane < 4) {
            const int half = r >= HALF_TOK ? 1 : 0;
            const int e = lane == 0 ? ti[0] : lane == 1 ? ti[1] : lane == 2 ? ti[2] : ti[3];
            const float gv = lane == 0 ? g0 : lane == 1 ? g1 : lane == 2 ? g2 : g3;
            const u32 lp = atomicAdd((u32*)&hist[half * 32 + e], 1u);
            const int idx = (it * 8 + w) * 4 + lane;
            ent[idx * 2] = ((u32)e << 24) | lp; ent[idx * 2 + 1] = __float_as_uint(gv);
        }
    }
    __syncthreads();
    if (tid < 64) hist[64 + tid] = atomicAdd(&cnt[tid], hist[tid]);
    __syncthreads();
    it = 0;
    for (int r = gw; r < NLAT; r += NW, ++it) {
        if (lane < 4) {
            const int half = r >= HALF_TOK ? 1 : 0; const int idx = (it * 8 + w) * 4 + lane;
            const u32 ev = ent[idx * 2]; const int e = ev >> 24; const u32 pos = hist[64 + half * 32 + e] + (ev & 0xffffffu);
            toktab[((size_t)half * 32 + e) * CAP + pos] = (u32)r * 4u + lane;
            wtab[((size_t)half * 32 + e) * CAP + pos] = __uint_as_float(ent[idx * 2 + 1]);
        }
    }
}

__device__ __forceinline__ void phase_combine(float* __restrict__ out, const bf16_t* __restrict__ X1, const fp8_t* __restrict__ Y, const float* __restrict__ mod, const float* __restrict__ fw, int bid, int G) {
    constexpr int RB = 2;
    typedef float f32x2_ __attribute__((ext_vector_type(2)));
    const int lane = threadIdx.x & 63, gw = bid * 8 + (threadIdx.x >> 6), NW = G * 8;
    for (int r0 = gw; r0 < NLAT; r0 += RB * NW) {
        u32x2 xv[RB][4]; unsigned yv[RB][4][4];
#pragma unroll
        for (int q = 0; q < RB; ++q) { const int r = r0 + q * NW < NLAT ? r0 + q * NW : r0;
#pragma unroll
            for (int j = 0; j < 4; ++j) { xv[q][j] = __builtin_nontemporal_load((const u32x2*)(X1 + (size_t)r * D + j * 256 + lane * 4));
#pragma unroll
                for (int k = 0; k < 4; ++k) yv[q][j][k] = __builtin_nontemporal_load((const unsigned*)(Y + ((size_t)r * 4 + k) * D + j * 256 + lane * 4)); } }
#pragma unroll
        for (int q = 0; q < RB; ++q) { const int r = r0 + q * NW; if (r < NLAT) {
            const float* g2 = mod + (size_t)(r >> 11) * 6144 + 5120;
            f32x4 v[4]; float ss = 0.f;
#pragma unroll
            for (int j = 0; j < 4; ++j) { const int c0 = j * 256 + lane * 4;
                f32x4 sm = (f32x4){0.f, 0.f, 0.f, 0.f};
#pragma unroll
                for (int k = 0; k < 4; ++k) { const f32x2_ lo = __builtin_amdgcn_cvt_pk_f32_fp8(yv[q][j][k], false), hi = __builtin_amdgcn_cvt_pk_f32_fp8(yv[q][j][k], true); sm[0] += lo[0]; sm[1] += lo[1]; sm[2] += hi[0]; sm[3] += hi[1]; }
                const f32x4 g = *(const f32x4*)(g2 + c0);
                v[j][0] = __uint_as_float(xv[q][j].x << 16); v[j][1] = __uint_as_float(xv[q][j].x & 0xffff0000u); v[j][2] = __uint_as_float(xv[q][j].y << 16); v[j][3] = __uint_as_float(xv[q][j].y & 0xffff0000u);
                v[j] = v[j] + g * sm * (1.0f / SC_Y);
                ss += v[j][0] * v[j][0] + v[j][1] * v[j][1] + v[j][2] * v[j][2] + v[j][3] * v[j][3]; }
            const float rstd = __builtin_amdgcn_rsqf(wave_sum(ss) * (1.0f / D) + EPS);
#pragma unroll
            for (int j = 0; j < 4; ++j) { const int c0 = j * 256 + lane * 4; const f32x4 w = *(const f32x4*)(fw + c0); __builtin_nontemporal_store(v[j] * rstd * w, (f32x4*)(out + (size_t)r * D + c0)); }
        } }
    }
}

#define XB_TMO      128
#define XB_XCNT(j)  (256  + 64 * (j))
#define XB_XSUB(j)  (1280 + 64 * (j))
#define XB_XGEN(j)  (2304 + 64 * (j))
#define XB_TOP      3328
#define XB_TOPGEN   3392
#define XCD_BAR_WORDS 3456
#define XB_SPIN_CAP (1u << 20)
__device__ __forceinline__ unsigned xb_ld(unsigned* p)              { return __hip_atomic_load(p, __ATOMIC_RELAXED, __HIP_MEMORY_SCOPE_AGENT); }
__device__ __forceinline__ unsigned xb_add(unsigned* p, unsigned v) { return __hip_atomic_fetch_add(p, v, __ATOMIC_RELAXED, __HIP_MEMORY_SCOPE_AGENT); }
__device__ __forceinline__ unsigned xb_xcc_id() { return (unsigned)__builtin_amdgcn_s_getreg((3 << 11) | 20) & 0xFu; }
#define XB_SPIN(cond, bar) do { unsigned _sp = 0; while (cond) { __builtin_amdgcn_s_sleep(1); \
    if ((++_sp & 255u) == 0u) { if (xb_ld(&(bar)[XB_TMO])) break; if (_sp > XB_SPIN_CAP) { atomicAdd(&(bar)[XB_TMO], 1u); break; } } } } while (0)
struct XcdBarrier { unsigned* bar; unsigned x; volatile LAS unsigned* st; };
__device__ __forceinline__ XcdBarrier xcd_barrier_post(unsigned* bar, volatile LAS unsigned* st) {
    XcdBarrier b; b.bar = bar; b.x = xb_xcc_id(); b.st = st;
    if (threadIdx.x == 0) (void)xb_add(&bar[XB_XCNT(b.x)], 1u);
    return b;
}
__device__ __forceinline__ void xcd_barrier_complete(unsigned* bar, unsigned x, unsigned& nloc, unsigned& nx) {
    const unsigned G = gridDim.x * gridDim.y * gridDim.z;
    unsigned sum, cnt, mine, sp = 0u;
    for (;;) {
        sum = 0u; cnt = 0u; mine = 0u;
#pragma unroll
        for (unsigned j = 0; j < 16; ++j) { const unsigned c = xb_ld(&bar[XB_XCNT(j)]); sum += c; cnt += (c > 0u) ? 1u : 0u; mine = (j == x) ? c : mine; }
        if (sum == G) break;
        __builtin_amdgcn_s_sleep(1);
        if ((++sp & 255u) == 0u) { if (xb_ld(&bar[XB_TMO])) break; if (sp > XB_SPIN_CAP) { atomicAdd(&bar[XB_TMO], 1u); break; } }
    }
    nloc = mine > 0u ? mine : 1u; nx = cnt > 0u ? cnt : 1u;
}
__device__ __forceinline__ void xcd_barrier(unsigned* bar, volatile LAS unsigned* st) {
    asm volatile("s_waitcnt vmcnt(0)" ::: "memory");
    __syncthreads();
    if (threadIdx.x == 0) {
        __builtin_amdgcn_s_waitcnt(0);
        const unsigned x = xb_xcc_id();
        unsigned nloc = st[0], nx = st[1];
        if (nloc == 0u) { xcd_barrier_complete(bar, x, nloc, nx); st[0] = nloc; st[1] = nx; }
        const unsigned old = xb_add(&bar[XB_XSUB(x)], 1u);
        const unsigned gen = old / nloc;
        if (old + 1u == (gen + 1u) * nloc) {
            __builtin_amdgcn_fence(__ATOMIC_RELEASE, "agent");
            asm volatile("s_waitcnt vmcnt(0)" ::: "memory");
            const unsigned og = xb_add(&bar[XB_TOP], 1u);
            const unsigned tg = og / nx;
            if (og + 1u == (tg + 1u) * nx) xb_add(&bar[XB_TOPGEN], 1u);
            else XB_SPIN(xb_ld(&bar[XB_TOPGEN]) == tg, bar);
            __builtin_amdgcn_fence(__ATOMIC_ACQUIRE, "agent");
            xb_add(&bar[XB_XGEN(x)], 1u);
            asm volatile("s_waitcnt vmcnt(0)" ::: "memory");
        } else {
            XB_SPIN(xb_ld(&bar[XB_XGEN(x)]) == gen, bar);
            __builtin_amdgcn_fence(__ATOMIC_ACQUIRE, "agent");
            asm volatile("s_waitcnt vmcnt(0)" ::: "memory");
        }
    }
    __syncthreads();
}
constexpr size_t WS_BAR = 16384;
constexpr int LDS_BARST = LDS_BYTES - 16;

struct MegaArgs {
    const float *x, *c, *ctx, *c_ctx, *norm1_w, *norm2_w, *w_ada, *b_ada, *w_in, *lbl, *hg_nw, *conv_w, *conv_b, *rg_wa, *rg_ba, *rg_wx, *rg_bx, *rg_lam, *w_out,
        *router_w, *router_b, *wgu, *bgu, *wd, *bd, *final_w;
    float* out; unsigned char* ws;
};
typedef const MegaArgs __attribute__((address_space(4)))* KArgs;
__device__ __forceinline__ KArgs kargs() { auto p = __builtin_amdgcn_kernarg_segment_ptr(); asm volatile("" : "+s"(p)); return (KArgs)p; }
#define WSP(T, off) ((T*)(ws + (off)))
#define GRID_SYNC_CG() cg::this_grid().sync()
#define GRID_SYNC() do { KArgs a_ = kargs(); xcd_barrier((unsigned*)(a_->ws + WS_BAR), (volatile LAS unsigned*)(lds + LDS_BARST)); } while (0)
__global__ __launch_bounds__(512, 2) void k_mega(MegaArgs a_unused) {
    extern __shared__ __attribute__((aligned(16))) unsigned char lds_[];
    LAS unsigned char* lds = (LAS unsigned char*)lds_;
    if (threadIdx.x < 4) ((volatile LAS unsigned*)(lds + LDS_BARST))[threadIdx.x] = 0u;
    __syncthreads();
    { KArgs a = kargs(); (void)xcd_barrier_post((unsigned*)(a->ws + WS_BAR), (volatile LAS unsigned*)(lds + LDS_BARST)); }
    { KArgs a = kargs(); unsigned char* ws = a->ws; const int bid = blockIdx.x, G = gridDim.x;
      ProArgs pa; pa.c = a->c; pa.c_ctx = a->c_ctx; pa.w_ada = a->w_ada; pa.b_ada = a->b_ada; pa.lbl = a->lbl; pa.w_in = a->w_in; pa.w_out = a->w_out; pa.wgu = a->wgu; pa.wd = a->wd; pa.rg_wa = a->rg_wa; pa.rg_wx = a->rg_wx; pa.rg_lam = a->rg_lam;
      pa.coef = WSP(float, WS_COEF); pa.WG_t = WSP(bf16_t, WS_WG); pa.mod = WSP(float, WS_MOD); pa.lb = WSP(float, WS_LB); pa.Win_t = WSP(bf16_t, WS_WIN); pa.Wout_t = WSP(bf16_t, WS_WOUT); pa.Wgu_t = WSP(fp8_t, WS_WGU); pa.Wd_t = WSP(fp8_t, WS_WD);
      phase_prologue(lds, pa, bid, G, true, 0, 0); }
    { KArgs a_ = kargs(); if (a_->ws == nullptr) GRID_SYNC_CG(); }
    GRID_SYNC();
    { KArgs a = kargs(); unsigned char* ws = a->ws; phase_norm1(a->x, a->ctx, a->norm1_w, WSP(float, WS_MOD), WSP(bf16_t, WS_H), blockIdx.x, gridDim.x); }
    { KArgs a = kargs(); unsigned char* ws = a->ws;
      ProArgs pa; pa.c = nullptr; pa.c_ctx = nullptr; pa.w_ada = nullptr; pa.b_ada = nullptr; pa.lbl = nullptr; pa.w_in = a->w_in; pa.w_out = a->w_out; pa.wgu = nullptr; pa.wd = nullptr; pa.rg_wa = nullptr; pa.rg_wx = nullptr; pa.rg_lam = nullptr; pa.coef = nullptr; pa.WG_t = nullptr;
      pa.mod = nullptr; pa.lb = nullptr; pa.Win_t = WSP(bf16_t, WS_WIN); pa.Wout_t = WSP(bf16_t, WS_WOUT); pa.Wgu_t = nullptr; pa.Wd_t = nullptr;
      phase_prologue(lds, pa, blockIdx.x, gridDim.x, false, 0, IT_IN + IT_OUT); }
    GRID_SYNC();
    { KArgs a = kargs(); unsigned char* ws = a->ws; PolInProj P; P.A = WSP(bf16_t, WS_H); P.Bt = WSP(bf16_t, WS_WIN); P.O = WSP(bf16_t, WS_PROJ); P.ord.init(NLAT / BM, INW / BM, gridDim.x, blockIdx.x); gemm_phase(lds, P); }
    GRID_SYNC();
    { KArgs a = kargs(); unsigned char* ws = a->ws;
      for (int item = blockIdx.x; item < 256; item += gridDim.x)
          phase_rg_chain(lds, WSP(bf16_t, WS_PROJ), a->conv_w, a->conv_b, WSP(bf16_t, WS_WG), a->rg_ba, a->rg_bx, WSP(float, WS_COEF), WSP(bf16_t, WS_HF), WSP(bf16_t, WS_MIX2), item); }
    __syncthreads();
    { KArgs a = kargs(); unsigned char* ws = a->ws;
      for (int item = blockIdx.x; item < 256; item += gridDim.x) phase_hgrn2_chunk(lds, WSP(bf16_t, WS_PROJ), WSP(float, WS_LB), WSP(bf16_t, WS_OF), WSP(bf16_t, WS_OB), item); }
    GRID_SYNC();
    { KArgs a = kargs(); unsigned char* ws = a->ws; phase_mix_finish(WSP(bf16_t, WS_PROJ), WSP(bf16_t, WS_OF), WSP(bf16_t, WS_OB), a->hg_nw, WSP(bf16_t, WS_MIX2), blockIdx.x, gridDim.x); }
    GRID_SYNC();
    { KArgs a = kargs(); unsigned char* ws = a->ws; PolOutProj P; P.A = WSP(bf16_t, WS_MIX2); P.Bt = WSP(bf16_t, WS_WOUT); P.x = a->x; P.mod = WSP(float, WS_MOD); P.O = WSP(bf16_t, WS_X1); P.ord.init(NLAT / BM, D / BM, gridDim.x, blockIdx.x); gemm_phase(lds, P); }
    GRID_SYNC();
    { KArgs a = kargs(); unsigned char* ws = a->ws;
      phase_norm2_route(lds, WSP(bf16_t, WS_X1), a->norm2_w, WSP(float, WS_MOD), a->router_w, a->router_b, WSP(fp8_t, WS_H2), WSP(u32, WS_CTL), WSP(u32, WS_TOKTAB), WSP(float, WS_WTAB), blockIdx.x, gridDim.x); }
    __syncthreads();
    { KArgs a = kargs(); unsigned char* ws = a->ws;
      ProArgs pa; pa.c = nullptr; pa.c_ctx = nullptr; pa.w_ada = nullptr; pa.b_ada = nullptr; pa.lbl = nullptr; pa.w_in = nullptr; pa.w_out = nullptr; pa.wgu = a->wgu; pa.wd = a->wd; pa.rg_wa = nullptr; pa.rg_wx = nullptr; pa.rg_lam = nullptr; pa.coef = nullptr; pa.WG_t = nullptr;
      pa.mod = nullptr; pa.lb = nullptr; pa.Win_t = nullptr; pa.Wout_t = nullptr; pa.Wgu_t = WSP(fp8_t, WS_WGU); pa.Wd_t = WSP(fp8_t, WS_WD);
      phase_prologue(lds, pa, blockIdx.x, gridDim.x, false, IT_IN + IT_OUT, IT_ALL); }
    GRID_SYNC();
#pragma unroll 1
    for (int half = 0; half < NHALF; ++half) {
        { KArgs a = kargs(); unsigned char* ws = a->ws; LAS int* tstart = (LAS int*)(lds + LDS_AUX);
          const int tot = moe_tile_table(tstart, WSP(u32, WS_CTL), half);
          PolGateUp P; P.A = WSP(fp8_t, WS_H2); P.Bt = WSP(fp8_t, WS_WGU); P.bgu = a->bgu; P.toktab = WSP(u32, WS_TOKTAB); P.O = WSP(fp8_t, WS_ACT); P.mt.tstart = tstart; P.mt.cnt = WSP(u32, WS_CTL); P.mt.half = half;
          P.ord.init(tot, DFF / HALFT, gridDim.x, blockIdx.x);
          gemm_phase(lds, P); }
        GRID_SYNC();
        { KArgs a = kargs(); unsigned char* ws = a->ws; LAS int* tstart = (LAS int*)(lds + LDS_AUX);
          const int tot = moe_tile_table(tstart, WSP(u32, WS_CTL), half);
          PolDown P; P.A = WSP(fp8_t, WS_ACT); P.Bt = WSP(fp8_t, WS_WD); P.bd = a->bd; P.toktab = WSP(u32, WS_TOKTAB); P.wtab = WSP(float, WS_WTAB); P.O = WSP(fp8_t, WS_Y); P.mt.tstart = tstart; P.mt.cnt = WSP(u32, WS_CTL); P.mt.half = half;
          P.ord.init(tot, D / BM, gridDim.x, blockIdx.x);
          gemm_phase(lds, P); }
        GRID_SYNC();
        { KArgs a = kargs(); unsigned char* ws = a->ws; phase_combine(a->out, WSP(bf16_t, WS_X1), WSP(fp8_t, WS_Y), WSP(float, WS_MOD), a->final_w, blockIdx.x, gridDim.x); }
        __syncthreads();
    }
}

extern "C" void kernel_launch(void* const* d_in, const int* in_sizes, int n_in, void* d_out, int out_size, void* d_ws, size_t ws_size, hipStream_t stream) {
    static int grid_blocks = 0;
    if (!grid_blocks) {
        int dev = 0, cus = 0, per_cu = 0;
        (void)hipGetDevice(&dev);
        (void)hipDeviceGetAttribute(&cus, hipDeviceAttributeMultiprocessorCount, dev);
        (void)hipFuncSetAttribute((const void*)k_mega, hipFuncAttributeMaxDynamicSharedMemorySize, LDS_BYTES);
        (void)hipOccupancyMaxActiveBlocksPerMultiprocessor(&per_cu, (const void*)k_mega, 512, LDS_BYTES);
        if (per_cu < 1) { fprintf(stderr, "kernel_launch: occupancy query says %d blocks/CU\n", per_cu); per_cu = 1; }
        grid_blocks = cus * 1;
    }
    if (ws_size < 1024 * MiB) { fprintf(stderr, "kernel_launch: workspace too small (%zu)\n", ws_size); return; }
    MegaArgs a{};
    const float** ap = (const float**)&a;
    for (int i = 0; i < 26; ++i) ap[i] = (const float*)d_in[i];
    a.out = (float*)d_out; a.ws = (unsigned char*)d_ws;
    (void)hipMemsetAsync((unsigned char*)d_ws + WS_CTL, 0, 32768, stream);
    void* args[] = {&a};
    hipError_t e = hipLaunchCooperativeKernel((const void*)k_mega, dim3(grid_blocks), dim3(512), args, LDS_BYTES, stream);
    if (e != hipSuccess) fprintf(stderr, "cooperative launch failed: %s (grid %d)\n", hipGetErrorString(e), grid_blocks);
}
```

```cpp
#include <hip/hip_runtime.h>
#include <hip/hip_cooperative_groups.h>
#include <cstdio>
#include <cstdint>

typedef unsigned short bf16_t;
typedef unsigned int u32;
namespace cg = cooperative_groups;

constexpr int D = 1024, NB = 32, T = 2048, CTXL = 256, GRIDW = 64, GROWS = T / GRIDW;
constexpr int NLAT = NB * T;
constexpr int NCTX = NB * CTXL;
constexpr int NROWS = NLAT + NCTX;
constexpr int HGW = 512, RGW = 512, INW = 3584;
constexpr int C_Q = 0, C_I = 512, C_FF = 1024, C_FB = 1536, C_G = 2048, C_RX = 2560, C_RG = 3072;
constexpr int NE = 32, TOPK = 4, DFF = 1024;
constexpr int NCHK = (CTXL + T) / 64;
constexpr int NHALF = 1;
constexpr int HALF_TOK = NLAT / NHALF;
constexpr int CAP = HALF_TOK;
constexpr int MAXSLOT = HALF_TOK * TOPK + NE * 256;
constexpr float EPS = 1e-6f;

constexpr size_t MiB = 1u << 20;
constexpr size_t WS_CTL = 0;
constexpr size_t WS_WG = 64 * 1024;
constexpr size_t WS_MOD = 1 * MiB;
constexpr size_t WS_LB = WS_MOD + 33 * 6144 * 4;
constexpr size_t WS_COEF = WS_LB + 4096;
constexpr size_t WS_TOKTAB = 2 * MiB;
constexpr size_t WS_WTAB = 10 * MiB;
constexpr size_t WS_WIN = 18 * MiB, WS_WOUT = 25 * MiB;
constexpr size_t WS_OF = 28 * MiB, WS_OB = 92 * MiB;
constexpr size_t WS_HF = 156 * MiB;
constexpr size_t WS_H = 284 * MiB;
constexpr size_t WS_MIX2 = WS_H;
constexpr size_t WS_PROJ = 428 * MiB;
constexpr size_t WS_H2 = 28 * MiB;
constexpr size_t WS_WGU = 92 * MiB, WS_WD = 156 * MiB;
constexpr size_t WS_ACT = 188 * MiB;
constexpr size_t WS_Y = 452 * MiB;
constexpr size_t WS_X1 = 708 * MiB;
constexpr float SC_Y = 16.0f;

__device__ __forceinline__ float bf2f(bf16_t b) { return __uint_as_float(((u32)b) << 16); }
__device__ __forceinline__ bf16_t f2bf(float f) { u32 u = __float_as_uint(f); u += 0x7fffu + ((u >> 16) & 1u); return (bf16_t)(u >> 16); }
__device__ __forceinline__ u32 pk2(float lo, float hi) { return (u32)f2bf(lo) | ((u32)f2bf(hi) << 16); }
__device__ __forceinline__ float fexp(float x) { return __builtin_amdgcn_exp2f(x * 1.4426950408889634f); }
__device__ __forceinline__ float frcp(float x) { return __builtin_amdgcn_rcpf(x); }
__device__ __forceinline__ float flog(float x) { return __builtin_amdgcn_logf(x) * 0.6931471805599453f; }
__device__ __forceinline__ float fsqrt(float x) { return __builtin_amdgcn_sqrtf(x); }
__device__ __forceinline__ float sigmoidf_(float x) { return frcp(1.0f + fexp(-x)); }
__device__ __forceinline__ float wave_sum(float v) {
#pragma unroll
    for (int o = 1; o < 64; o <<= 1) v += __shfl_xor(v, o);
    return v;
}

__device__ __forceinline__ float gelu_tanh(float x) { const float u = 1.5957691216057308f * (x + 0.044715f * x * x * x); return x * sigmoidf_(u); }
#define LAS __attribute__((address_space(3)))
typedef short bf16x8 __attribute__((ext_vector_type(8)));
typedef float f32x4 __attribute__((ext_vector_type(4)));
typedef unsigned u32x4 __attribute__((ext_vector_type(4)));
typedef int v8i __attribute__((ext_vector_type(8)));
typedef int v4i_ __attribute__((ext_vector_type(4)));
typedef unsigned u32x2 __attribute__((ext_vector_type(2)));
typedef unsigned char fp8_t;
constexpr float SC_H2 = 16.0f, SC_W = 32.0f, SC_ACT = 4.0f;
__device__ __forceinline__ unsigned pk4_fp8(float a, float b, float c, float d) {
    a = fminf(fmaxf(a, -448.f), 448.f); b = fminf(fmaxf(b, -448.f), 448.f); c = fminf(fmaxf(c, -448.f), 448.f); d = fminf(fmaxf(d, -448.f), 448.f);
    int r = 0; r = __builtin_amdgcn_cvt_pk_fp8_f32(a, b, r, false); r = __builtin_amdgcn_cvt_pk_fp8_f32(c, d, r, true); return (unsigned)r; }
constexpr int BM = 256, BK = 64, HALFT = 128, HTB = HALFT * BK * 2, STAGE_BYTES = 8 * HTB, NXCD = 8, WGM = 8;
constexpr int GK = 1024;
constexpr int LDS_BYTES = 147456;
constexpr int LDS_AUX = STAGE_BYTES;

__device__ __forceinline__ int lds_byte(int r, int c) { const int st = (r >> 4) * 2 + (c >> 5), rr = r & 15, cc = c & 31, ob = rr * 64 + cc * 2; return st * 1024 + (ob ^ (((ob >> 9) & 1) << 5)); }
__device__ __forceinline__ void stage_rc(int b, int& R, int& C) { const int st = b / 1024, sb = b % 1024, swz = sb ^ (((sb >> 9) & 1) << 5); R = (st >> 1) * 16 + swz / 64; C = (st & 1) * 32 + (swz % 64) / 2; }
__device__ __forceinline__ int perm32(int rho) { const int n = rho >> 4, i = rho & 15; return 8 * (i >> 2) + 4 * n + (i & 3); }
__device__ __forceinline__ unsigned cvt_pk_bf16(float lo, float hi) { unsigned r; asm volatile("v_cvt_pk_bf16_f32 %0, %1, %2" : "=v"(r) : "v"(lo), "v"(hi)); return r; }

struct Unit { int pm, pn, e, pos0, cn; };
struct TileOrder {
    int nM, nN, nwg, G, c;
    __device__ __forceinline__ void init(int nM_, int nN_, int G_, int c_) { nM = nM_; nN = nN_; nwg = nM * nN; G = G_; c = c_; }
    __device__ __forceinline__ bool tile(int i, int& pm, int& pn) const {
        const long L = (long)i * G + c; if (L >= nwg) return false;
        int wgid = (int)L; { const int q = nwg / NXCD, r = nwg % NXCD, xcd = wgid % NXCD, off = wgid / NXCD; wgid = (xcd < r ? xcd * (q + 1) : r * (q + 1) + (xcd - r) * q) + off; }
        const int nig = WGM * nN, gid = wgid / nig, fm = gid * WGM, gsz = (nM - fm) < WGM ? (nM - fm) : WGM;
        pm = fm + ((wgid % nig) % gsz); pn = (wgid % nig) / gsz; return true;
    }
};

template <class POL>
__device__ __forceinline__ void gemm_phase(LAS unsigned char* lds, const POL& P) {
    int tid_ = threadIdx.x; asm volatile("" : "+v"(tid_));
    const int tid = tid_, wid = __builtin_amdgcn_readfirstlane(tid >> 6), lane = tid & 63, wr = wid >> 2, wc = wid & 3, fr = lane & 15, fq = lane >> 4;
    constexpr int KB = POL::FP8 ? 1024 : 2048, nt = KB / 128;
    int sR[2], sC[2]; unsigned voffA[2], voffB[2];
#pragma unroll
    for (int i = 0; i < 2; ++i) { stage_rc(tid * 16 + i * 8192, sR[i], sC[i]); const int Rb = POL::PERM ? ((sR[i] & ~31) + perm32(sR[i] & 31)) : sR[i]; voffA[i] = (unsigned)(sR[i] * KB + sC[i] * 2); voffB[i] = (unsigned)(Rb * KB + sC[i] * 2); }
    constexpr size_t kstep = (size_t)(BK * 2);
    constexpr unsigned hstepB = (unsigned)HALFT * KB;
    const unsigned ldsw = (unsigned)wid * 1024u;
    const int aoff = POL::FP8 ? lds_byte(wr * 64 + fr, fq * 16) : lds_byte(wr * 64 + fr, fq * 8), boff = POL::FP8 ? lds_byte(wc * 32 + fr, fq * 16) : lds_byte(wc * 32 + fr, fq * 8);
#define G_SA(b, h) (((b) * 2 + (h)) * HTB)
#define G_SB(b, h) ((4 + (b) * 2 + (h)) * HTB)
#define G_AOFF(OFF, h, i) (POL::GATHER ? (OFF)[h][i] : voffA[i])
#define G_STAGE_A(bufoff, gbase, OFF, h) do { const char* _gb = (const char*)(gbase) + (POL::GATHER ? (size_t)0 : (size_t)(h) * hstepB); _Pragma("unroll") for (int _i = 0; _i < 2; ++_i) \
        __builtin_amdgcn_global_load_lds((const unsigned*)(_gb + G_AOFF(OFF, h, _i)), (LAS unsigned*)(lds + (bufoff) + ldsw + _i * 8192), 16, 0, 0); } while (0)
#define G_STAGE_B(bufoff, gbase, hoff) do { const char* _gb = (const char*)(gbase) + (size_t)(hoff); _Pragma("unroll") for (int _i = 0; _i < 2; ++_i) \
        __builtin_amdgcn_global_load_lds((const unsigned*)(_gb + voffB[_i]), (LAS unsigned*)(lds + (bufoff) + ldsw + _i * 8192), 16, 0, 0); } while (0)
#define G_LD8(p) __builtin_shufflevector(*(const LAS v4i_*)(p), *(const LAS v4i_*)((p) + 16), 0, 1, 2, 3, 4, 5, 6, 7)
#define G_LDA(dst, b, h) do { if (POL::FP8) { _Pragma("unroll") for (int m = 0; m < 4; ++m) dst##8[m] = G_LD8(lds + G_SA(b, h) + aoff + m * 2048); } \
        else { _Pragma("unroll") for (int m = 0; m < 4; ++m) _Pragma("unroll") for (int k = 0; k < 2; ++k) dst[m][k] = *(const LAS bf16x8*)(lds + G_SA(b, h) + aoff + m * 2048 + k * 1024); } } while (0)
#define G_LDB(dst, b, h) do { if (POL::FP8) { _Pragma("unroll") for (int n = 0; n < 2; ++n) dst##8[n] = G_LD8(lds + G_SB(b, h) + boff + n * 2048); } \
        else { _Pragma("unroll") for (int n = 0; n < 2; ++n) _Pragma("unroll") for (int k = 0; k < 2; ++k) dst[n][k] = *(const LAS bf16x8*)(lds + G_SB(b, h) + boff + n * 2048 + k * 1024); } } while (0)
#define G_MMA(ai, bj, At, Bt) do { __builtin_amdgcn_s_setprio(1); \
        if (POL::FP8) { _Pragma("unroll") for (int m = 0; m < 4; ++m) _Pragma("unroll") for (int n = 0; n < 2; ++n) \
            asm volatile("v_mfma_scale_f32_16x16x128_f8f6f4 %0, %1, %2, %0, %3, %3 op_sel_hi:[0,0,0]" : "+v"(acc[ai][bj][m][n]) : "v"(Bt##8[n]), "v"(At##8[m]), "v"(mxs)); } \
        else { _Pragma("unroll") for (int m = 0; m < 4; ++m) _Pragma("unroll") for (int n = 0; n < 2; ++n) _Pragma("unroll") for (int k = 0; k < 2; ++k) \
            acc[ai][bj][m][n] = __builtin_amdgcn_mfma_f32_16x16x32_bf16(Bt[n][k], At[m][k], acc[ai][bj][m][n], 0, 0, 0); } \
        __builtin_amdgcn_s_setprio(0); } while (0)
#define G_WAIT_V(n) asm volatile("s_waitcnt vmcnt(" #n ")" ::: "memory")
#define G_WAIT_L(n) asm volatile("s_waitcnt lgkmcnt(" #n ")" ::: "memory")
#define G_BAR __builtin_amdgcn_s_barrier()
#define G_SCHED __builtin_amdgcn_sched_barrier(0)
#define G_TRIP(A1, OC, A2, ON, B2) do { \
        G_LDB(B0, 0, 0); G_SCHED; G_LDA(At, 0, 0); G_STAGE_A(G_SA(1, 1), A1, OC, 1); \
        G_WAIT_L(8); G_BAR; G_WAIT_L(0); G_MMA(0, 0, At, B0); G_BAR; G_SCHED; \
        G_LDB(B1, 0, 1); G_STAGE_B(G_SB(0, 0), B2, 0u); \
        G_BAR; G_WAIT_L(0); G_MMA(0, 1, At, B1); G_BAR; \
        G_LDA(At, 0, 1); G_STAGE_A(G_SA(0, 0), A2, ON, 0); \
        G_BAR; G_WAIT_L(0); G_MMA(1, 0, At, B0); G_BAR; G_SCHED; \
        G_STAGE_B(G_SB(0, 1), B2, hstepB); \
        G_WAIT_V(6); G_BAR; G_MMA(1, 1, At, B1); G_BAR; \
        G_LDB(B0, 1, 0); G_SCHED; G_LDA(At, 1, 0); G_STAGE_A(G_SA(0, 1), A2, ON, 1); \
        G_WAIT_L(8); G_BAR; G_WAIT_L(0); G_MMA(0, 0, At, B0); G_BAR; G_SCHED; \
        G_LDB(B1, 1, 1); G_STAGE_B(G_SB(1, 0), (B2) + kstep, 0u); \
        G_BAR; G_WAIT_L(0); G_MMA(0, 1, At, B1); G_BAR; \
        G_LDA(At, 1, 1); G_STAGE_A(G_SA(1, 0), (A2) + kstep, ON, 0); \
        G_BAR; G_WAIT_L(0); G_MMA(1, 0, At, B0); G_BAR; G_SCHED; \
        G_STAGE_B(G_SB(1, 1), (B2) + kstep, hstepB); \
        G_WAIT_V(6); G_BAR; G_MMA(1, 1, At, B1); G_BAR; } while (0)
    Unit cur, nxt; int ui = 0;
    if (!P.next(0, cur)) return;
    f32x4 acc[2][2][4][2];
#pragma unroll
    for (int a = 0; a < 2; ++a)
#pragma unroll
        for (int b = 0; b < 2; ++b)
#pragma unroll
            for (int m = 0; m < 4; ++m)
#pragma unroll
                for (int n = 0; n < 2; ++n) acc[a][b][m][n] = (f32x4){0.f, 0.f, 0.f, 0.f};
    const int mxs = 0x7f7f7f7f;
    bf16x8 At[4][2], B0[2][2], B1[2][2]; v8i At8[4], B08[2], B18[2];
    unsigned oc[2][2], on[2][2];
#pragma unroll
    for (int h = 0; h < 2; ++h)
#pragma unroll
        for (int i = 0; i < 2; ++i) { oc[h][i] = POL::GATHER ? P.a_off(cur, h * HALFT + sR[i]) + (unsigned)sC[i] * 2u : 0u; on[h][i] = 0u; }
    const char* cA = P.a_base(cur); const char* cB = P.b_base(cur);
    G_STAGE_B(G_SB(0, 0), cB, 0u); G_STAGE_A(G_SA(0, 0), cA, oc, 0); G_STAGE_B(G_SB(0, 1), cB, hstepB); G_STAGE_A(G_SA(0, 1), cA, oc, 1);
    if (wr == 1) G_BAR;
    G_WAIT_V(4); G_BAR;
    G_STAGE_B(G_SB(1, 0), cB + kstep, 0u); G_STAGE_A(G_SA(1, 0), cA + kstep, oc, 0); G_STAGE_B(G_SB(1, 1), cB + kstep, hstepB);
    G_WAIT_V(6); G_BAR;
    for (;;) {
        const bool has_next = P.next(ui + 1, nxt);
        const char* nA = has_next ? P.a_base(nxt) : cA; const char* nB = has_next ? P.b_base(nxt) : cB;
        if (POL::GATHER) {
#pragma unroll
            for (int h = 0; h < 2; ++h)
#pragma unroll
                for (int i = 0; i < 2; ++i) on[h][i] = has_next ? P.a_off(nxt, h * HALFT + sR[i]) + (unsigned)sC[i] * 2u : oc[h][i];
        }
#pragma unroll 1
        for (int t = 0; t < nt; t += 2) {
            const bool last = (t == nt - 2);
            const char* a1 = cA + (size_t)(t + 1) * kstep; const char* a2 = last ? nA : cA + (size_t)(t + 2) * kstep; const char* b2 = last ? nB : cB + (size_t)(t + 2) * kstep;
            if (POL::GATHER) {
                unsigned os[2][2];
#pragma unroll
                for (int h = 0; h < 2; ++h)
#pragma unroll
                    for (int i = 0; i < 2; ++i) os[h][i] = last ? on[h][i] : oc[h][i];
                G_TRIP(a1, oc, a2, os, b2);
            } else { G_TRIP(a1, oc, a2, oc, b2); }
        }
        if (POL::FP8) asm volatile("s_nop 15\n\ts_nop 15" ::: "memory");
        if (wr == 0) G_BAR;
        P.epi(acc, cur, wr, wc, fr, fq);
        if (!has_next) break;
#pragma unroll
        for (int a = 0; a < 2; ++a)
#pragma unroll
            for (int b = 0; b < 2; ++b)
#pragma unroll
                for (int m = 0; m < 4; ++m)
#pragma unroll
                    for (int n = 0; n < 2; ++n) acc[a][b][m][n] = (f32x4){0.f, 0.f, 0.f, 0.f};
        cur = nxt; cA = nA; cB = nB; ++ui;
        if (POL::GATHER) {
#pragma unroll
            for (int h = 0; h < 2; ++h)
#pragma unroll
                for (int i = 0; i < 2; ++i) oc[h][i] = on[h][i];
        }
        if (wr == 1) G_BAR;
    }
    G_WAIT_V(0);
    G_BAR;
#undef G_SA
#undef G_SB
#undef G_AOFF
#undef G_STAGE_A
#undef G_STAGE_B
#undef G_LDA
#undef G_LDB
#undef G_MMA
#undef G_LD8
#undef G_WAIT_V
#undef G_WAIT_L
#undef G_BAR
#undef G_SCHED
#undef G_TRIP
}

struct PolInProj {
    static constexpr bool PERM = true, GATHER = false, FP8 = false;
    const bf16_t* A; const bf16_t* Bt; bf16_t* O; TileOrder ord;
    __device__ __forceinline__ bool next(int i, Unit& u) const {
        constexpr int NLATU = (NLAT / BM) * (INW / BM);
        const int L = i * ord.G + ord.c;
        if (L < NLATU) return ord.tile(i, u.pm, u.pn);
        const int q = L - NLATU; if (q >= (NCTX / BM) * 8) return false;
        u.pm = NLAT / BM + (q >> 3); const int j = q & 7; u.pn = j < 6 ? 2 + j : 4 + j; return true;
    }
    __device__ __forceinline__ const char* a_base(const Unit& u) const { return (const char*)A + (size_t)u.pm * BM * GK * 2; }
    __device__ __forceinline__ unsigned a_off(const Unit&, int r) const { return (unsigned)r * GK * 2u; }
    __device__ __forceinline__ const char* b_base(const Unit& u) const { return (const char*)Bt + (size_t)u.pn * BM * GK * 2; }
    __device__ __forceinline__ void epi(const f32x4 (&acc)[2][2][4][2], const Unit& u, int wr, int wc, int fr, int fq) const {
        const int row0 = u.pm * BM + wr * 64 + fr, col0 = u.pn * BM + wc * 32 + 8 * fq;
#pragma unroll
        for (int ai = 0; ai < 2; ++ai)
#pragma unroll
            for (int m = 0; m < 4; ++m) { bf16_t* rowp = O + (size_t)(row0 + ai * HALFT + m * 16) * INW + col0;
#pragma unroll
                for (int bj = 0; bj < 2; ++bj) { const f32x4 v0 = acc[ai][bj][m][0], v1 = acc[ai][bj][m][1];
                    u32x4 w; w.x = cvt_pk_bf16(v0[0], v0[1]); w.y = cvt_pk_bf16(v0[2], v0[3]); w.z = cvt_pk_bf16(v1[0], v1[1]); w.w = cvt_pk_bf16(v1[2], v1[3]);
                    *(u32x4*)(rowp + bj * HALFT) = w; } }
    }
};
struct PolOutProj {
    static constexpr bool PERM = true, GATHER = false, FP8 = false;
    const bf16_t* A; const bf16_t* Bt; const float* x; const float* mod; bf16_t* O; TileOrder ord;
    __device__ __forceinline__ bool next(int i, Unit& u) const { return ord.tile(i, u.pm, u.pn); }
    __device__ __forceinline__ const char* a_base(const Unit& u) const { return (const char*)A + (size_t)u.pm * BM * GK * 2; }
    __device__ __forceinline__ unsigned a_off(const Unit&, int r) const { return (unsigned)r * GK * 2u; }
    __device__ __forceinline__ const char* b_base(const Unit& u) const { return (const char*)Bt + (size_t)u.pn * BM * GK * 2; }
    __device__ __forceinline__ void epi(const f32x4 (&acc)[2][2][4][2], const Unit& u, int wr, int wc, int fr, int fq) const {
        const int row0 = u.pm * BM + wr * 64 + fr, col0 = u.pn * BM + wc * 32 + 8 * fq;
        const float* g1 = mod + (size_t)((u.pm * BM) >> 11) * 6144 + 2048 + col0;
        f32x4 gv[2][2];
#pragma unroll
        for (int bj = 0; bj < 2; ++bj) { gv[bj][0] = *(const f32x4*)(g1 + bj * HALFT); gv[bj][1] = *(const f32x4*)(g1 + bj * HALFT + 4); }
#pragma unroll
        for (int ai = 0; ai < 2; ++ai)
#pragma unroll
            for (int m = 0; m < 4; ++m) { const size_t off = (size_t)(row0 + ai * HALFT + m * 16) * D + col0;
#pragma unroll
                for (int bj = 0; bj < 2; ++bj) {
                    const f32x4 x0 = __builtin_nontemporal_load((const f32x4*)(x + off + bj * HALFT)), x1v = __builtin_nontemporal_load((const f32x4*)(x + off + bj * HALFT + 4));
                    const f32x4 v0 = x0 + gv[bj][0] * acc[ai][bj][m][0], v1 = x1v + gv[bj][1] * acc[ai][bj][m][1];
                    u32x4 w; w.x = cvt_pk_bf16(v0[0], v0[1]); w.y = cvt_pk_bf16(v0[2], v0[3]); w.z = cvt_pk_bf16(v1[0], v1[1]); w.w = cvt_pk_bf16(v1[2], v1[3]);
                    *(u32x4*)(O + off + bj * HALFT) = w; }
                asm volatile("" ::: "memory"); }
    }
};
struct MoeTiles {
    const LAS int* tstart; const u32* cnt; int half;
    __device__ __forceinline__ void find(Unit& u) const {
        const int e = __builtin_amdgcn_readfirstlane(tstart[64 + u.pm]);
        u.e = e; u.pos0 = (u.pm - __builtin_amdgcn_readfirstlane(tstart[e])) * BM; u.cn = (int)cnt[half * NE + e];
    }
};
struct PolGateUp {
    static constexpr bool PERM = true, GATHER = true, FP8 = true;
    const fp8_t* A; const fp8_t* Bt; const float* bgu; const u32* toktab; fp8_t* O; MoeTiles mt; TileOrder ord;
    __device__ __forceinline__ bool next(int i, Unit& u) const { if (!ord.tile(i, u.pm, u.pn)) return false; mt.find(u); return true; }
    __device__ __forceinline__ const char* a_base(const Unit&) const { return (const char*)A; }
    __device__ __forceinline__ unsigned a_off(const Unit& u, int r) const {
        const int p = u.pos0 + r; const u32 tk = toktab[((size_t)mt.half * NE + u.e) * CAP + (p < u.cn ? p : 0)];
        return (tk >> 2) * 1024u;
    }
    __device__ __forceinline__ const char* b_base(const Unit& u) const { return (const char*)Bt + ((size_t)u.e * 2048 + (size_t)u.pn * BM) * 1024; }
    __device__ __forceinline__ void epi(const f32x4 (&acc)[2][2][4][2], const Unit& u, int wr, int wc, int fr, int fq) const {
        const int row0 = u.pm * BM + wr * 64 + fr, cc = u.pn * HALFT + wc * 32 + 8 * fq;
        const float* bg = bgu + (size_t)u.e * 2048 + cc;
        const f32x4 bg0 = *(const f32x4*)bg, bg1 = *(const f32x4*)(bg + 4), bu0 = *(const f32x4*)(bg + 1024), bu1 = *(const f32x4*)(bg + 1028);
        constexpr float inv = 1.0f / (SC_H2 * SC_W);
#pragma unroll
        for (int ai = 0; ai < 2; ++ai)
#pragma unroll
            for (int m = 0; m < 4; ++m) {
                f32x4 g0 = acc[ai][0][m][0] * inv + bg0, g1 = acc[ai][0][m][1] * inv + bg1, u0 = acc[ai][1][m][0] * inv + bu0, u1 = acc[ai][1][m][1] * inv + bu1;
                float o[8];
#pragma unroll
                for (int j = 0; j < 4; ++j) {
                    const float ga = fminf(g0[j], 7.0f), gb = fminf(g1[j], 7.0f);
                    const float ua = fminf(fmaxf(u0[j], -7.0f), 7.0f), ub = fminf(fmaxf(u1[j], -7.0f), 7.0f);
                    o[j] = ga * sigmoidf_(1.702f * ga) * (ua + 1.0f) * SC_ACT; o[4 + j] = gb * sigmoidf_(1.702f * gb) * (ub + 1.0f) * SC_ACT;
                }
                uint2 w; w.x = pk4_fp8(o[0], o[1], o[2], o[3]); w.y = pk4_fp8(o[4], o[5], o[6], o[7]);
                *(uint2*)(O + (size_t)(row0 + ai * HALFT + m * 16) * DFF + cc) = w;
                asm volatile("" ::: "memory");
            }
    }
};
struct PolDown {
    static constexpr bool PERM = true, GATHER = false, FP8 = true;
    const fp8_t* A; const fp8_t* Bt; const float* bd; const u32* toktab; const float* wtab; fp8_t* O; MoeTiles mt; TileOrder ord;
    __device__ __forceinline__ bool next(int i, Unit& u) const { if (!ord.tile(i, u.pm, u.pn)) return false; mt.find(u); return true; }
    __device__ __forceinline__ const char* a_base(const Unit& u) const { return (const char*)A + (size_t)u.pm * BM * 1024; }
    __device__ __forceinline__ unsigned a_off(const Unit&, int r) const { return (unsigned)r * 1024u; }
    __device__ __forceinline__ const char* b_base(const Unit& u) const { return (const char*)Bt + ((size_t)u.e * 1024 + (size_t)u.pn * BM) * 1024; }
    __device__ __forceinline__ void epi(const f32x4 (&acc)[2][2][4][2], const Unit& u, int wr, int wc, int fr, int fq) const {
        const int col0 = u.pn * BM + wc * 32 + 8 * fq;
        const float* bp = bd + (size_t)u.e * D + col0;
        f32x4 bv[2][2];
#pragma unroll
        for (int bj = 0; bj < 2; ++bj) { bv[bj][0] = *(const f32x4*)(bp + bj * HALFT); bv[bj][1] = *(const f32x4*)(bp + bj * HALFT + 4); }
        const size_t tb = ((size_t)mt.half * NE + u.e) * CAP;
        constexpr float inv = 1.0f / (SC_ACT * SC_W);
#pragma unroll
        for (int ai = 0; ai < 2; ++ai)
#pragma unroll
            for (int m = 0; m < 4; ++m) {
                asm volatile("" ::: "memory");
                const int p = u.pos0 + ai * HALFT + wr * 64 + m * 16 + fr;
                if (p < u.cn) {
                    const u32 tk = toktab[tb + p]; const float wg = wtab[tb + p] * SC_Y;
                    fp8_t* rowp = O + (size_t)(tk - (u32)mt.half * HALF_TOK * 4u) * D + col0;
#pragma unroll
                    for (int bj = 0; bj < 2; ++bj) { const f32x4 v0 = (acc[ai][bj][m][0] * inv + bv[bj][0]) * wg, v1 = (acc[ai][bj][m][1] * inv + bv[bj][1]) * wg;
                        uint2 w; w.x = pk4_fp8(v0[0], v0[1], v0[2], v0[3]); w.y = pk4_fp8(v1[0], v1[1], v1[2], v1[3]);
                        *(uint2*)(rowp + bj * HALFT) = w; }
                }
            }
    }
};
__device__ __forceinline__ int moe_tile_table(LAS int* tstart, const u32* cnt, int half) {
    __syncthreads();
    if (threadIdx.x == 0) { int s = 0; for (int e = 0; e < NE; ++e) { tstart[e] = s; s += ((int)cnt[half * NE + e] + BM - 1) / BM; } tstart[NE] = s; }
    __syncthreads();
    const int tot = tstart[NE];
    for (int t = threadIdx.x; t < tot; t += 512) { int e = 0;
#pragma unroll 1
        for (int i = 1; i < NE; ++i) if (t >= tstart[i]) e = i;
        tstart[64 + t] = e; }
    __syncthreads();
    return tot;
}

__device__ __forceinline__ void conv_item(const float* __restrict__ W, int N, bf16_t* __restrict__ WT, int k0, int n0, size_t rowbase, LAS float* scr, int lane) {
#pragma unroll 4
    for (int i = 0; i < 16; ++i) { const int k = 4 * i + (lane >> 4); const f32x4 v = __builtin_nontemporal_load((const f32x4*)(W + (size_t)(k0 + k) * N + n0 + (lane & 15) * 4)); *(LAS f32x4*)(scr + k * 68 + (lane & 15) * 4) = v; }
    asm volatile("s_waitcnt lgkmcnt(0)" ::: "memory");
    const int c = lane & 7;
#pragma unroll
    for (int j = 0; j < 8; ++j) { const int n = (lane >> 3) + 8 * j; const LAS float* s = scr + (8 * c) * 68 + n;
        u32x4 o; o.x = cvt_pk_bf16(s[0 * 68], s[1 * 68]); o.y = cvt_pk_bf16(s[2 * 68], s[3 * 68]); o.z = cvt_pk_bf16(s[4 * 68], s[5 * 68]); o.w = cvt_pk_bf16(s[6 * 68], s[7 * 68]);
        *(u32x4*)(WT + (rowbase + n) * GK + k0 + 8 * c) = o; }
    asm volatile("s_waitcnt lgkmcnt(0)" ::: "memory");
}
__device__ __forceinline__ void conv_item8(const float* __restrict__ W, int N, fp8_t* __restrict__ WT, int k0, int n0, size_t rowbase, LAS float* scr, int lane) {
#pragma unroll 4
    for (int i = 0; i < 16; ++i) { const int k = 4 * i + (lane >> 4); const f32x4 v = __builtin_nontemporal_load((const f32x4*)(W + (size_t)(k0 + k) * N + n0 + (lane & 15) * 4)); *(LAS f32x4*)(scr + k * 68 + (lane & 15) * 4) = v; }
    asm volatile("s_waitcnt lgkmcnt(0)" ::: "memory");
    const LAS float* sp = scr + lane;
#pragma unroll
    for (int q = 0; q < 4; ++q) {
        u32x4 o;
        o.x = pk4_fp8(sp[(16 * q + 0) * 68] * SC_W, sp[(16 * q + 1) * 68] * SC_W, sp[(16 * q + 2) * 68] * SC_W, sp[(16 * q + 3) * 68] * SC_W);
        o.y = pk4_fp8(sp[(16 * q + 4) * 68] * SC_W, sp[(16 * q + 5) * 68] * SC_W, sp[(16 * q + 6) * 68] * SC_W, sp[(16 * q + 7) * 68] * SC_W);
        o.z = pk4_fp8(sp[(16 * q + 8) * 68] * SC_W, sp[(16 * q + 9) * 68] * SC_W, sp[(16 * q + 10) * 68] * SC_W, sp[(16 * q + 11) * 68] * SC_W);
        o.w = pk4_fp8(sp[(16 * q + 12) * 68] * SC_W, sp[(16 * q + 13) * 68] * SC_W, sp[(16 * q + 14) * 68] * SC_W, sp[(16 * q + 15) * 68] * SC_W);
        *(u32x4*)(WT + (rowbase + lane) * GK + k0 + 16 * q) = o;
    }
    asm volatile("s_waitcnt lgkmcnt(0)" ::: "memory");
}
constexpr int IT_IN = 16 * (INW / 64), IT_OUT = 16 * (D / 64), IT_GU = NE * 16 * 32, IT_D = NE * 16 * 16, IT_ALL = IT_IN + IT_OUT + IT_GU + IT_D;
struct ProArgs { const float *c, *c_ctx, *w_ada, *b_ada, *lbl, *w_in, *w_out, *wgu, *wd, *rg_wa, *rg_wx, *rg_lam; float *mod, *lb, *coef; bf16_t *Win_t, *Wout_t, *WG_t; fp8_t *Wgu_t, *Wd_t; };
__device__ __forceinline__ void phase_prologue(LAS unsigned char* lds, const ProArgs& a, int bid, int G, bool do_mod, int it_lo, int it_hi) {
    const int tid = threadIdx.x, lane = tid & 63, w = tid >> 6;
    if (!do_mod) {} else if (bid < 96) {
        LAS float* s = (LAS float*)lds;
        for (int i = tid; i < 33 * D; i += 512) { const int b = i >> 10, k = i & 1023; const float v = b < NB ? a.c[(size_t)b * D + k] : a.c_ctx[k]; s[i] = v * sigmoidf_(v); }
        __syncthreads();
        const int n = bid * 64 + lane;
        float acc[33];
#pragma unroll
        for (int b = 0; b < 33; ++b) acc[b] = 0.f;
#pragma unroll 1
        for (int k = 128 * w; k < 128 * w + 128; k += 16) {
            float wv[16];
#pragma unroll
            for (int i = 0; i < 16; ++i) wv[i] = __builtin_nontemporal_load(a.w_ada + (size_t)(k + i) * 6144 + n);
#pragma unroll
            for (int b = 0; b < 33; ++b)
#pragma unroll
                for (int i4 = 0; i4 < 4; ++i4) { const f32x4 sv = *(const LAS f32x4*)(s + b * D + k + 4 * i4); acc[b] += sv[0] * wv[4 * i4] + sv[1] * wv[4 * i4 + 1] + sv[2] * wv[4 * i4 + 2] + sv[3] * wv[4 * i4 + 3]; }
        }
        __syncthreads();
        LAS float* red = (LAS float*)lds;
#pragma unroll
        for (int b = 0; b < 33; ++b) red[(w * 33 + b) * 64 + lane] = acc[b];
        __syncthreads();
        for (int i = tid; i < 33 * 64; i += 512) { const int b = i >> 6, l = i & 63; float sum = a.b_ada[bid * 64 + l];
#pragma unroll
            for (int ww = 0; ww < 8; ++ww) sum += red[(ww * 33 + b) * 64 + l];
            a.mod[(size_t)b * 6144 + bid * 64 + l] = sum; }
        __syncthreads();
    } else if (bid == 96) {
        for (int i = tid; i < 2 * HGW; i += 512) { const float l0 = a.lbl[i], l1 = a.lbl[2 * HGW + i]; a.lb[i] = 1.0f / (1.0f + __expf(l1 - l0)); }
        for (int i = tid; i < 2 * RGW; i += 512) { const float l = a.rg_lam[i]; const float sp = (-l > 20.f) ? -l : log1pf(__expf(-l)); a.coef[i] = -8.0f * sp; }
    } else if (bid == 97) {
        for (int idx = tid; idx < 8 * 256 * 64; idx += 512) { const int hd = idx >> 14, n = (idx >> 6) & 255, kk = idx & 63, g = n >> 6, j = n & 63, d = g >> 1;
            const float* src = (g & 1) ? a.rg_wx : a.rg_wa; a.WG_t[idx] = f2bf(src[(((size_t)d * 8 + hd) * 64 + kk) * 64 + j]); }
    }
    LAS float* scr = (LAS float*)(lds + w * (64 * 68 * 4));
    const int gw = bid * 8 + w, NW = G * 8;
    for (int it = it_lo + gw; it < it_hi; it += NW) {
        int r = it;
        if (r < IT_IN) { const int kb = r / (INW / 64), nb = r % (INW / 64); conv_item(a.w_in, INW, a.Win_t, kb * 64, nb * 64, (size_t)nb * 64, scr, lane); continue; } r -= IT_IN;
        if (r < IT_OUT) { const int kb = r / 16, nb = r % 16; conv_item(a.w_out, D, a.Wout_t, kb * 64, nb * 64, (size_t)nb * 64, scr, lane); continue; } r -= IT_OUT;
        if (r < IT_GU) { const int e = r / 512, q = r % 512, kb = q / 32, nb = q % 32, n0 = nb * 64, bj = n0 >> 10, rem = n0 & 1023, pn = rem >> 7, cc0 = rem & 127;
            conv_item8(a.wgu + (size_t)e * D * 2048, 2048, a.Wgu_t, kb * 64, n0, (size_t)e * 2048 + pn * 256 + bj * 128 + cc0, scr, lane); continue; } r -= IT_GU;
        { const int e = r / 256, q = r % 256, kb = q / 16, nb = q % 16; conv_item8(a.wd + (size_t)e * DFF * D, D, a.Wd_t, kb * 64, nb * 64, (size_t)e * 1024 + nb * 64, scr, lane); }
    }
}


__device__ __forceinline__ void phase_norm1(const float* __restrict__ x, const float* __restrict__ ctx, const float* __restrict__ nw, const float* __restrict__ mod, bf16_t* __restrict__ H, int bid, int G) {
    constexpr int RB = 4;
    const int lane = threadIdx.x & 63, gw = bid * 8 + (threadIdx.x >> 6), NW = G * 8;
    for (int r0 = gw; r0 < NROWS; r0 += RB * NW) {
        f32x4 v[RB][4];
#pragma unroll
        for (int q = 0; q < RB; ++q) { const int r = r0 + q * NW; const int rr = r < NROWS ? r : r0;
            const float* src = rr < NLAT ? x + (size_t)rr * D : ctx + (size_t)(rr - NLAT) * D;
#pragma unroll
            for (int j = 0; j < 4; ++j) v[q][j] = __builtin_nontemporal_load((const f32x4*)(src + j * 256 + lane * 4)); }
#pragma unroll
        for (int q = 0; q < RB; ++q) { const int r = r0 + q * NW; if (r < NROWS) {
            const float* m = mod + (size_t)(r < NLAT ? (r >> 11) : NB) * 6144;
            float ss = 0.f;
#pragma unroll
            for (int j = 0; j < 4; ++j) ss += v[q][j][0] * v[q][j][0] + v[q][j][1] * v[q][j][1] + v[q][j][2] * v[q][j][2] + v[q][j][3] * v[q][j][3];
            const float rstd = __builtin_amdgcn_rsqf(wave_sum(ss) * (1.0f / D) + EPS);
#pragma unroll
            for (int j = 0; j < 4; ++j) {
                const int c0 = j * 256 + lane * 4;
                const f32x4 w = *(const f32x4*)(nw + c0), sh = *(const f32x4*)(m + c0), sc = *(const f32x4*)(m + 1024 + c0);
                const f32x4 o = v[q][j] * rstd * w * (sc + 1.0f) + sh;
                uint2 p; p.x = cvt_pk_bf16(o[0], o[1]); p.y = cvt_pk_bf16(o[2], o[3]);
                *(uint2*)(H + (size_t)r * D + c0) = p;
            } } }
    }
}

__device__ __forceinline__ bf16x8 pack8(const f32x4& a, const f32x4& b) {
    u32x4 w; w.x = cvt_pk_bf16(a[0], a[1]); w.y = cvt_pk_bf16(a[2], a[3]); w.z = cvt_pk_bf16(b[0], b[1]); w.w = cvt_pk_bf16(b[2], b[3]);
    return __builtin_bit_cast(bf16x8, w);
}
constexpr int HW_BUF = 45056;
constexpr int HW_QD = 0, HW_KET = 17408, HW_PM = 35840;
constexpr int HW_VT = 2 * HW_BUF, HW_KD = HW_VT + 18432, HW_OS = HW_KD + 17408, HW_TOT = HW_OS + 17408, HW_DEC = HW_TOT + 1024;
__device__ __forceinline__ void phase_hgrn2_ws(LAS unsigned char* lds, const bf16_t* __restrict__ P, const float* __restrict__ lb, bf16_t* __restrict__ OF, bf16_t* __restrict__ OB, int item) {
    const int b = item >> 3, h = (item >> 1) & 3, dir = item & 1;
    const int tid = threadIdx.x, w = __builtin_amdgcn_readfirstlane(tid >> 6), lane = tid & 63, l15 = lane & 15, G4 = lane >> 4;
    bf16_t* OD = dir ? OB : OF;
    const int cf = dir ? C_FB : C_FF;
    constexpr int NC = (CTXL + T) / 64;
    LAS float* TOT = (LAS float*)(lds + HW_TOT);
#define HW_BAR() do { asm volatile("s_waitcnt lgkmcnt(0)" ::: "memory"); __builtin_amdgcn_s_barrier(); asm volatile("" ::: "memory"); } while (0)
    __syncthreads();
    if (w >= 4) {
        const int et = tid - 256, k = et & 127, seg = et >> 7, ew = w - 4;
        const int kslot = (k & ~31) | (((k >> 2) & 3) << 3) | (((k >> 4) & 1) << 2) | (k & 3);
        const float lbv = lb[dir * HGW + h * 128 + k];
        const char* Pc = (const char*)P; const int sstep = dir ? -(INW * 2) : INW * 2;
#define HW_OFF0(m_) ({ const int p_ = 64 * (m_) + 32 * seg; const unsigned r_ = p_ < CTXL ? (unsigned)(NLAT + b * CTXL + (dir ? CTXL - 1 - p_ : p_)) : (unsigned)(b * T + (dir ? T - 1 - (p_ - CTXL) : (p_ - CTXL))); (r_ * (unsigned)INW + (unsigned)(h * 128 + k)) * 2u; })
#define HW_LD(off0_, i_, col_) (*(const bf16_t*)(Pc + (unsigned)((int)(off0_) + (i_) * sstep + (col_) * 2)))
        typedef unsigned short us2 __attribute__((ext_vector_type(2)));
        us2 rf[16];
        { const unsigned o0 = HW_OFF0(0);
#pragma unroll
        for (int i = 0; i < 32; ++i) rf[i >> 1][i & 1] = HW_LD(o0, i, cf); }
#pragma unroll 1
        for (int m = 0; m < NC + 1; ++m) {
            const int par = m & 1;
            LAS unsigned char* buf = lds + par * HW_BUF;
            HW_BAR();
            us2 rq[16], rv[16]; float fv[32], cs[32]; float run = 0.f;
            if (m < NC) {
#pragma unroll
                for (int i = 0; i < 32; ++i) { const unsigned o0 = HW_OFF0(m); rq[i >> 1][i & 1] = HW_LD(o0, i, C_Q); rv[i >> 1][i & 1] = HW_LD(o0, i, C_I); }
#pragma unroll
                for (int i = 0; i < 32; ++i) { const float f = lbv + (1.f - lbv) * sigmoidf_(bf2f(rf[i >> 1][i & 1])); fv[i] = f; run += flog(f); cs[i] = run; }
                TOT[seg * 128 + k] = run;
                if (m + 1 < NC) {
#pragma unroll
                    for (int i = 0; i < 32; ++i) { const unsigned o0 = HW_OFF0(m + 1); rf[i >> 1][i & 1] = HW_LD(o0, i, cf); }
                }
            }
            HW_BAR();
            if (m < NC) {
                const float t0 = TOT[k], t1 = TOT[128 + k];
                const float prefix = seg == 0 ? 0.f : t0, blast = t0 + t1, eb = fexp(blast);
                if (seg == 0) ((LAS float*)(lds + HW_DEC + par * 512))[k] = eb;
#pragma unroll
                for (int q4 = 0; q4 < 4; ++q4) {
                    float ke[8];
#pragma unroll
                    for (int ii = 0; ii < 8; ++ii) {
                        const int i = 8 * q4 + ii;
                        const float bc = prefix + cs[i], e = fexp(bc), kf = (1.f - fv[i]) * frcp(e), q = bf2f(rq[i >> 1][i & 1]);
                        const int j = 32 * seg + i;
                        *(LAS bf16_t*)(buf + HW_QD + j * 272 + kslot * 2) = f2bf(q * sigmoidf_(q) * e);
                        *(LAS bf16_t*)(lds + HW_KD + j * 272 + kslot * 2) = f2bf(kf);
                        ke[ii] = kf * eb;
                    }
                    u32x4 wk, wv;
#pragma unroll
                    for (int i = 0; i < 4; ++i) { wk[i] = cvt_pk_bf16(ke[2 * i], ke[2 * i + 1]); wv[i] = __builtin_bit_cast(u32, rv[4 * q4 + i]); }
                    *(LAS u32x4*)(buf + HW_KET + k * 144 + seg * 64 + q4 * 16) = wk;
                    *(LAS u32x4*)(lds + HW_VT + k * 144 + seg * 64 + q4 * 16) = wv;
                }
            }
            HW_BAR();
            if (m < NC && m >= CTXL / 64) {
                const int mt = ew;
                f32x4 pa[4];
#pragma unroll
                for (int q = 0; q < 4; ++q) pa[q] = (f32x4){0.f, 0.f, 0.f, 0.f};
#pragma unroll
                for (int s = 0; s < 4; ++s) {
                    const bf16x8 a = *(const LAS bf16x8*)(buf + HW_QD + (16 * mt + l15) * 272 + (32 * s + 8 * G4) * 2);
#pragma unroll
                    for (int q = 0; q < 4; ++q) { const bf16x8 bq = *(const LAS bf16x8*)(lds + HW_KD + (16 * q + l15) * 272 + (32 * s + 8 * G4) * 2); pa[q] = __builtin_amdgcn_mfma_f32_16x16x32_bf16(a, bq, pa[q], 0, 0, 0); }
                }
#pragma unroll
                for (int q = 0; q < 4; ++q)
#pragma unroll
                    for (int r = 0; r < 4; ++r) { const int c = 16 * mt + 4 * G4 + r, j = 16 * q + l15; *(LAS bf16_t*)(buf + HW_PM + c * 144 + j * 2) = f2bf(j <= c ? pa[q][r] : 0.f); }
                asm volatile("s_waitcnt lgkmcnt(0)" ::: "memory");
            }
        }
#undef HW_OFF0
#undef HW_LD
    } else {
        f32x4 S[8][2];
#pragma unroll
        for (int t = 0; t < 8; ++t) { S[t][0] = (f32x4){0.f, 0.f, 0.f, 0.f}; S[t][1] = (f32x4){0.f, 0.f, 0.f, 0.f}; }
        HW_BAR(); HW_BAR(); HW_BAR();
#pragma unroll 1
        for (int n = 0; n < NC; ++n) {
            const int par = n & 1; const bool lat = n >= CTXL / 64;
            LAS unsigned char* buf = lds + par * HW_BUF;
            HW_BAR();
            bf16x8 vb[2][2];
#pragma unroll
            for (int nt = 0; nt < 2; ++nt)
#pragma unroll
                for (int s = 0; s < 2; ++s) vb[nt][s] = *(const LAS bf16x8*)(lds + HW_VT + (32 * w + 16 * nt + l15) * 144 + (32 * s + 8 * G4) * 2);
            HW_BAR();
            if (lat) {
                bf16x8 sb[2][4];
#pragma unroll
                for (int nt = 0; nt < 2; ++nt)
#pragma unroll
                    for (int s = 0; s < 4; ++s) sb[nt][s] = pack8(S[2 * s][nt], S[2 * s + 1][nt]);
#pragma unroll
                for (int mt = 0; mt < 4; ++mt) {
                    f32x4 oa[2] = {(f32x4){0.f, 0.f, 0.f, 0.f}, (f32x4){0.f, 0.f, 0.f, 0.f}};
#pragma unroll
                    for (int s = 0; s < 2; ++s) { const bf16x8 a = *(const LAS bf16x8*)(buf + HW_PM + (16 * mt + l15) * 144 + (32 * s + 8 * G4) * 2);
                        oa[0] = __builtin_amdgcn_mfma_f32_16x16x32_bf16(a, vb[0][s], oa[0], 0, 0, 0); oa[1] = __builtin_amdgcn_mfma_f32_16x16x32_bf16(a, vb[1][s], oa[1], 0, 0, 0); }
#pragma unroll
                    for (int s = 0; s < 4; ++s) { const bf16x8 a = *(const LAS bf16x8*)(buf + HW_QD + (16 * mt + l15) * 272 + (32 * s + 8 * G4) * 2);
                        oa[0] = __builtin_amdgcn_mfma_f32_16x16x32_bf16(a, sb[0][s], oa[0], 0, 0, 0); oa[1] = __builtin_amdgcn_mfma_f32_16x16x32_bf16(a, sb[1][s], oa[1], 0, 0, 0); }
#pragma unroll
                    for (int nt = 0; nt < 2; ++nt)
#pragma unroll
                        for (int r = 0; r < 4; ++r) *(LAS bf16_t*)(lds + HW_OS + (16 * mt + 4 * G4 + r) * 272 + (32 * w + 16 * nt + l15) * 2) = f2bf(oa[nt][r]);
                }
            }
#pragma unroll
            for (int t = 0; t < 8; ++t) {
                const f32x4 d4 = *(const LAS f32x4*)(lds + HW_DEC + par * 512 + (16 * t + 4 * G4) * 4);
                S[t][0] = S[t][0] * d4; S[t][1] = S[t][1] * d4;
#pragma unroll
                for (int s = 0; s < 2; ++s) { const bf16x8 a = *(const LAS bf16x8*)(buf + HW_KET + (16 * t + l15) * 144 + (32 * s + 8 * G4) * 2);
                    S[t][0] = __builtin_amdgcn_mfma_f32_16x16x32_bf16(a, vb[0][s], S[t][0], 0, 0, 0); S[t][1] = __builtin_amdgcn_mfma_f32_16x16x32_bf16(a, vb[1][s], S[t][1], 0, 0, 0); }
            }
            HW_BAR();
            if (lat) {
                const int j = tid >> 2, part = tid & 3, p = 64 * n + j, tt = dir ? T - 1 - (p - CTXL) : (p - CTXL);
                bf16_t* dst = OD + ((size_t)b * T + tt) * HGW + h * 128 + part * 32;
#pragma unroll
                for (int q = 0; q < 4; ++q) *(u32x4*)(dst + q * 8) = *(const LAS u32x4*)(lds + HW_OS + j * 272 + part * 64 + q * 16);
            }
        }
    }
    __syncthreads();
#undef HW_BAR
}

__device__ __forceinline__ size_t rg_row(int b, bool lat, int p) {
    return lat ? (size_t)b * T + (size_t)(p % GROWS) * GRIDW + (p / GROWS) : (size_t)NLAT + b * CTXL + p;
}
constexpr int RC_T = 64 * 144;
constexpr int RC_XC = 0, RC_RG = 2 * RC_T, RC_HI = 4 * RC_T, RC_OUT = 6 * RC_T;
__device__ __forceinline__ void phase_rg_chain(LAS unsigned char* lds, const bf16_t* __restrict__ P, const float* __restrict__ conv_w, const float* __restrict__ conv_b, const bf16_t* __restrict__ WG_t,
                                               const float* __restrict__ ba, const float* __restrict__ bx, const float* __restrict__ coef, bf16_t* __restrict__ HT, bf16_t* __restrict__ MIX, int item) {
    const int b = item >> 3, hd = item & 7;
    const int tid = threadIdx.x, w = __builtin_amdgcn_readfirstlane(tid >> 6), lane = tid & 63, l15 = lane & 15, G4 = lane >> 4;
    const int d = w >> 2, cg = w & 3, ch = 64 * hd + 16 * cg + l15;
    const int ds = tid >> 8, t8 = tid & 255, pg = t8 >> 4, cg4 = t8 & 15;
    bf16x8 F[4];
#pragma unroll
    for (int s = 0; s < 2; ++s) {
        F[s] = *(const bf16x8*)(WG_t + ((size_t)(hd * 256 + 64 * (2 * d) + 16 * cg + l15) * 64 + 32 * s + 8 * G4));
        F[2 + s] = *(const bf16x8*)(WG_t + ((size_t)(hd * 256 + 64 * (2 * d + 1) + 16 * cg + l15) * 64 + 32 * s + 8 * G4)); }
    const float bav = ba[d * RGW + ch], bxv = bx[d * RGW + ch], cf = coef[d * RGW + ch];
    const f32x4 cw0 = *(const f32x4*)(conv_w + 0 * RGW + 64 * hd + 4 * cg4), cw1 = *(const f32x4*)(conv_w + 1 * RGW + 64 * hd + 4 * cg4), cw2 = *(const f32x4*)(conv_w + 2 * RGW + 64 * hd + 4 * cg4),
                cw3 = *(const f32x4*)(conv_w + 3 * RGW + 64 * hd + 4 * cg4), cb4 = *(const f32x4*)(conv_b + 64 * hd + 4 * cg4);
    float hcar = 0.f;
#define RC_CHUNK(dd, s_) ((dd) == 0 ? (s_) : ((s_) < CTXL / 64 ? CTXL / 64 - 1 - (s_) : NCHK + CTXL / 64 - 1 - (s_)))
    u32x2 rxr[7]; u32x4 rgr[2], hir[2];
#define RC_LOAD_RX(s_) do { const int n_ = RC_CHUNK(ds, s_); const bool lat_ = n_ >= CTXL / 64; const int L_ = lat_ ? T : CTXL, p0_ = 64 * (lat_ ? n_ - CTXL / 64 : n_); \
        _Pragma("unroll") for (int i = 0; i < 7; ++i) { const int p = p0_ + 4 * pg - 2 + i; rxr[i] = (p >= 0 && p < L_) ? *(const u32x2*)(P + rg_row(b, lat_, p) * INW + C_RX + 64 * hd + 4 * cg4) : (u32x2){0u, 0u}; } } while (0)
#define RC_ROW(s_, q_) (rg_row(b, true, 64 * (RC_CHUNK(ds, s_) - CTXL / 64) + ((q_) >> 3)))
#define RC_LOAD_RG(s_) do { _Pragma("unroll") for (int j = 0; j < 2; ++j) { const int q = t8 * 2 + j; rgr[j] = *(const u32x4*)(P + RC_ROW(s_, q) * INW + C_RG + 64 * hd + (q & 7) * 8); } } while (0)
#define RC_LOAD_HI(s_) do { _Pragma("unroll") for (int j = 0; j < 2; ++j) { const int q = t8 * 2 + j; rgr[j] = rgr[j]; hir[j] = __builtin_nontemporal_load((const u32x4*)(HT + RC_ROW(s_, q) * RGW + 64 * hd + (q & 7) * 8)); } } while (0)
    RC_LOAD_RX(0);
#pragma unroll 1
    for (int s = 0; s < NCHK; ++s) {
        const int role = s < CTXL / 64 ? 0 : (s < 20 ? 1 : 2);
        if (s == 20) { asm volatile("s_waitcnt vmcnt(0)" ::: "memory"); __syncthreads(); RC_LOAD_RG(20); RC_LOAD_HI(20); }
        {
            float xin[7][4];
#pragma unroll
            for (int i = 0; i < 7; ++i) { xin[i][0] = __uint_as_float(rxr[i].x << 16); xin[i][1] = __uint_as_float(rxr[i].x & 0xffff0000u); xin[i][2] = __uint_as_float(rxr[i].y << 16); xin[i][3] = __uint_as_float(rxr[i].y & 0xffff0000u); }
#pragma unroll
            for (int q = 0; q < 4; ++q) {
                float o[4];
#pragma unroll
                for (int c = 0; c < 4; ++c) o[c] = cb4[c] + cw0[c] * xin[q][c] + cw1[c] * xin[q + 1][c] + cw2[c] * xin[q + 2][c] + cw3[c] * xin[q + 3][c];
                *(LAS unsigned long long*)(lds + RC_XC + ds * RC_T + (4 * pg + q) * 144 + cg4 * 8) = ((unsigned long long)cvt_pk_bf16(o[2], o[3]) << 32) | cvt_pk_bf16(o[0], o[1]);
            }
            if (role == 2) {
#pragma unroll
                for (int j = 0; j < 2; ++j) { const int q = t8 * 2 + j; *(LAS u32x4*)(lds + RC_RG + ds * RC_T + (q >> 3) * 144 + (q & 7) * 16) = rgr[j]; *(LAS u32x4*)(lds + RC_HI + ds * RC_T + (q >> 3) * 144 + (q & 7) * 16) = hir[j]; }
            }
        }
        __syncthreads();
        if (s + 1 < NCHK) { RC_LOAD_RX(s + 1); if (s + 1 > 20) { RC_LOAD_RG(s + 1); RC_LOAD_HI(s + 1); } }
        {
            bf16x8 af[4][2];
#pragma unroll
            for (int mt = 0; mt < 4; ++mt)
#pragma unroll
                for (int k = 0; k < 2; ++k) af[mt][k] = *(const LAS bf16x8*)(lds + RC_XC + d * RC_T + (16 * (l15 >> 2) + 4 * mt + (l15 & 3)) * 144 + (32 * k + 8 * G4) * 2);
            f32x4 ra[4], xa[4];
#pragma unroll
            for (int mt = 0; mt < 4; ++mt) { ra[mt] = (f32x4){0.f, 0.f, 0.f, 0.f}; xa[mt] = (f32x4){0.f, 0.f, 0.f, 0.f};
#pragma unroll
                for (int k = 0; k < 2; ++k) { ra[mt] = __builtin_amdgcn_mfma_f32_16x16x32_bf16(af[mt][k], F[k], ra[mt], 0, 0, 0); xa[mt] = __builtin_amdgcn_mfma_f32_16x16x32_bf16(af[mt][k], F[2 + k], xa[mt], 0, 0, 0); } }
            float av[16], bv[16];
#pragma unroll
            for (int t = 0; t < 16; ++t) {
                const float r = sigmoidf_(ra[t >> 2][t & 3] + bav), ig = sigmoidf_(xa[t >> 2][t & 3] + bxv);
                const float a = fexp(cf * r);
                av[t] = a; bv[t] = fsqrt(fmaxf(1.0f - a * a, 0.f)) * ig * bf2f(*(const LAS bf16_t*)(lds + RC_XC + d * RC_T + (16 * G4 + t) * 144 + (16 * cg + l15) * 2));
            }
            float Al = 1.f, Bl = 0.f;
            if (d == 0) {
#pragma unroll
                for (int t = 0; t < 16; ++t) { Bl = av[t] * Bl + bv[t]; Al *= av[t]; }
            } else {
#pragma unroll
                for (int t = 15; t >= 0; --t) { Bl = av[t] * Bl + bv[t]; Al *= av[t]; }
            }
            float Ag[4], Bg[4];
#pragma unroll
            for (int g = 0; g < 4; ++g) { Ag[g] = __shfl(Al, l15 + 16 * g); Bg[g] = __shfl(Bl, l15 + 16 * g); }
            float h = hcar, hend;
            if (d == 0) {
                const float s1 = Ag[0] * h + Bg[0], s2 = Ag[1] * s1 + Bg[1], s3 = Ag[2] * s2 + Bg[2]; hend = Ag[3] * s3 + Bg[3];
                h = G4 == 0 ? h : G4 == 1 ? s1 : G4 == 2 ? s2 : s3;
            } else {
                const float s2 = Ag[3] * h + Bg[3], s1 = Ag[2] * s2 + Bg[2], s0 = Ag[1] * s1 + Bg[1]; hend = Ag[0] * s0 + Bg[0];
                h = G4 == 3 ? h : G4 == 2 ? s2 : G4 == 1 ? s1 : s0;
            }
            hcar = hend;
            if (role != 0) {
                float hv[16];
                if (d == 0) {
#pragma unroll
                    for (int t = 0; t < 16; ++t) { h = av[t] * h + bv[t]; hv[t] = h; }
                } else {
#pragma unroll
                    for (int t = 15; t >= 0; --t) { h = av[t] * h + bv[t]; hv[t] = h; }
                }
#pragma unroll
                for (int t = 0; t < 16; ++t) {
                    const int off = (16 * G4 + t) * 144 + (16 * cg + l15) * 2;
                    float o = hv[t];
                    if (role == 2) o = gelu_tanh(bf2f(*(const LAS bf16_t*)(lds + RC_RG + d * RC_T + off))) * (o + bf2f(*(const LAS bf16_t*)(lds + RC_HI + d * RC_T + off)));
                    *(LAS bf16_t*)(lds + RC_OUT + d * RC_T + off) = f2bf(o);
                }
            }
        }
        __syncthreads();
        if (role != 0) {
#pragma unroll
            for (int j = 0; j < 2; ++j) { const int q = t8 * 2 + j; const u32x4 v = *(const LAS u32x4*)(lds + RC_OUT + ds * RC_T + (q >> 3) * 144 + (q & 7) * 16);
                if (role == 1) *(u32x4*)(HT + RC_ROW(s, q) * RGW + 64 * hd + (q & 7) * 8) = v;
                else *(u32x4*)(MIX + RC_ROW(s, q) * D + HGW + 64 * hd + (q & 7) * 8) = v; }
        }
    }
#undef RC_CHUNK
#undef RC_LOAD_RX
#undef RC_ROW
#undef RC_LOAD_RG
#undef RC_LOAD_HI
}

__device__ __forceinline__ void phase_mix_finish(const bf16_t* __restrict__ P, const bf16_t* __restrict__ OF, const bf16_t* __restrict__ OB,
                                                 const float* __restrict__ hg_nw, bf16_t* __restrict__ MIX, int bid, int G) {
    constexpr int RB = 4;
    const int lane = threadIdx.x & 63, gw = bid * 8 + (threadIdx.x >> 6), NW = G * 8, c0 = lane * 8;
    const f32x4 nw0 = *(const f32x4*)(hg_nw + c0), nw1 = *(const f32x4*)(hg_nw + c0 + 4);
    const float nwv[8] = {nw0[0], nw0[1], nw0[2], nw0[3], nw1[0], nw1[1], nw1[2], nw1[3]};
    for (int r0 = gw; r0 < NLAT; r0 += RB * NW) {
        u32x4 a4[RB], b4[RB], g4[RB];
#pragma unroll
        for (int q = 0; q < RB; ++q) { const int r = r0 + q * NW; const int rr = r < NLAT ? r : r0;
            a4[q] = *(const u32x4*)(OF + (size_t)rr * HGW + c0); b4[q] = *(const u32x4*)(OB + (size_t)rr * HGW + c0); g4[q] = *(const u32x4*)(P + (size_t)rr * INW + C_G + c0); }
#pragma unroll
        for (int q = 0; q < RB; ++q) { const int r = r0 + q * NW; if (r < NLAT) {
            float o[8]; float ss = 0.f;
#pragma unroll
            for (int i = 0; i < 4; ++i) { o[2 * i] = __uint_as_float(a4[q][i] << 16) + __uint_as_float(b4[q][i] << 16); o[2 * i + 1] = __uint_as_float(a4[q][i] & 0xffff0000u) + __uint_as_float(b4[q][i] & 0xffff0000u); }
#pragma unroll
            for (int i = 0; i < 8; ++i) ss += o[i] * o[i];
            ss += __shfl_xor(ss, 1); ss += __shfl_xor(ss, 2); ss += __shfl_xor(ss, 4); ss += __shfl_xor(ss, 8);
            const float rstd = __builtin_amdgcn_rsqf(ss * (1.0f / 128.0f) + EPS);
            u32x4 w;
#pragma unroll
            for (int i = 0; i < 4; ++i) {
                const float g0 = __uint_as_float(g4[q][i] << 16), g1 = __uint_as_float(g4[q][i] & 0xffff0000u);
                w[i] = cvt_pk_bf16(o[2 * i] * rstd * nwv[2 * i] * (g0 * sigmoidf_(g0)), o[2 * i + 1] * rstd * nwv[2 * i + 1] * (g1 * sigmoidf_(g1)));
            }
            *(u32x4*)(MIX + (size_t)r * D + c0) = w;
        } }
    }
}

__device__ __forceinline__ void phase_norm2_route(LAS unsigned char* lds, const bf16_t* __restrict__ x1, const float* __restrict__ nw, const float* __restrict__ mod,
                                                  const float* __restrict__ rw, const float* __restrict__ rb, fp8_t* __restrict__ H2,
                                                  u32* __restrict__ cnt, u32* __restrict__ toktab, float* __restrict__ wtab, int bid, int G) {
    LAS float* rwT = (LAS float*)lds;
    LAS u32* hist = (LAS u32*)(lds + 131072);
    LAS u32* ent = (LAS u32*)(lds + 131072 + 4096);
    const int tid = threadIdx.x, lane = tid & 63, w = tid >> 6;
    for (int i = tid; i < 32 * 1024; i += 512) { const int k = i >> 5, e = i & 31; rwT[e * 1024 + k] = rw[i]; }
    if (tid < 128) hist[tid] = 0;
    __syncthreads();
    const int gw = bid * 8 + w, NW = G * 8;
    const int myexp = ((lane >> 5) & 1) * 16 + ((lane >> 4) & 1) * 8 + ((lane >> 3) & 1) * 4 + ((lane >> 2) & 1) * 2 + ((lane >> 1) & 1);
    const float myrb = rb[myexp];
    int it = 0;
    u32x2 rawn[2][4];
#pragma unroll
    for (int q = 0; q < 2; ++q)
#pragma unroll
        for (int j = 0; j < 4; ++j) rawn[q][j] = __builtin_nontemporal_load((const u32x2*)(x1 + (size_t)(gw + q * NW) * D + j * 256 + lane * 4));
    for (int r0 = gw; r0 < NLAT; r0 += 2 * NW, it += 2) {
        f32x4 v[2][4];
        u32x2 rawc[2][4];
#pragma unroll
        for (int q = 0; q < 2; ++q)
#pragma unroll
            for (int j = 0; j < 4; ++j) rawc[q][j] = rawn[q][j];
        { const int rn0 = r0 + 2 * NW < NLAT ? r0 + 2 * NW : r0;
#pragma unroll
          for (int q = 0; q < 2; ++q)
#pragma unroll
            for (int j = 0; j < 4; ++j) rawn[q][j] = __builtin_nontemporal_load((const u32x2*)(x1 + (size_t)(rn0 + q * NW) * D + j * 256 + lane * 4)); }
#pragma unroll
        for (int q = 0; q < 2; ++q) {
            const int r = r0 + q * NW;
            const float* m = mod + (size_t)(r >> 11) * 6144;
            u32x2 raw[4];
#pragma unroll
            for (int j = 0; j < 4; ++j) raw[j] = rawc[q][j];
            float ss = 0.f;
#pragma unroll
            for (int j = 0; j < 4; ++j) { v[q][j][0] = __uint_as_float(raw[j].x << 16); v[q][j][1] = __uint_as_float(raw[j].x & 0xffff0000u); v[q][j][2] = __uint_as_float(raw[j].y << 16); v[q][j][3] = __uint_as_float(raw[j].y & 0xffff0000u);
                ss += v[q][j][0] * v[q][j][0] + v[q][j][1] * v[q][j][1] + v[q][j][2] * v[q][j][2] + v[q][j][3] * v[q][j][3]; }
            const float rstd = __builtin_amdgcn_rsqf(wave_sum(ss) * (1.0f / D) + EPS);
#pragma unroll
            for (int j = 0; j < 4; ++j) {
                const int c0 = j * 256 + lane * 4;
                const f32x4 ww = *(const f32x4*)(nw + c0), sh = *(const f32x4*)(m + 3072 + c0), sc = *(const f32x4*)(m + 4096 + c0);
                v[q][j] = v[q][j] * rstd * ww * (sc + 1.0f) + sh;
                *(unsigned*)(H2 + (size_t)r * D + c0) = pk4_fp8(v[q][j][0] * SC_H2, v[q][j][1] * SC_H2, v[q][j][2] * SC_H2, v[q][j][3] * SC_H2);
            }
        }
        float part[2][32];
#pragma unroll
        for (int e = 0; e < 32; ++e) {
            float p0 = 0.f, p1 = 0.f;
#pragma unroll
            for (int j = 0; j < 4; ++j) { const f32x4 q = *(const LAS f32x4*)(rwT + e * 1024 + j * 256 + lane * 4);
                p0 += v[0][j][0] * q[0] + v[0][j][1] * q[1] + v[0][j][2] * q[2] + v[0][j][3] * q[3]; p1 += v[1][j][0] * q[0] + v[1][j][1] * q[1] + v[1][j][2] * q[2] + v[1][j][3] * q[3]; }
            part[0][e] = p0; part[1][e] = p1;
        }
#define RT_STEP(N, M) { const bool up = (lane & (M)) != 0; _Pragma("unroll") for (int q = 0; q < 2; ++q) _Pragma("unroll") for (int i = 0; i < (N); ++i) { const float keep = up ? part[q][(N) + i] : part[q][i], send = up ? part[q][i] : part[q][(N) + i]; part[q][i] = keep + __shfl_xor(send, (M)); } }
        RT_STEP(16, 32) RT_STEP(8, 16) RT_STEP(4, 8) RT_STEP(2, 4) RT_STEP(1, 2)
#undef RT_STEP
#pragma unroll
        for (int q = 0; q < 2; ++q) {
            const int r = r0 + q * NW;
            const float mylogit = part[q][0] + __shfl_xor(part[q][0], 1) + myrb;
            int rank = 0;
#pragma unroll
            for (int x = 0; x < 32; ++x) {
                const int src = ((x >> 4) & 1) * 32 + ((x >> 3) & 1) * 16 + ((x >> 2) & 1) * 8 + ((x >> 1) & 1) * 4 + (x & 1) * 2;
                const float oq = __builtin_bit_cast(float, __builtin_amdgcn_readlane(__builtin_bit_cast(int, mylogit), src));
                rank += (oq > mylogit || (oq == mylogit && x < myexp)) ? 1 : 0;
            }
            float tv[4]; int ti[4];
#pragma unroll
            for (int k = 0; k < 4; ++k) {
                const unsigned long long mk = __ballot(rank == k && (lane & 1) == 0);
                const int src = __builtin_amdgcn_readfirstlane((int)__builtin_ctzll(mk));
                tv[k] = __builtin_bit_cast(float, __builtin_amdgcn_readlane(__builtin_bit_cast(int, mylogit), src));
                ti[k] = ((src >> 5) & 1) * 16 + ((src >> 4) & 1) * 8 + ((src >> 3) & 1) * 4 + ((src >> 2) & 1) * 2 + ((src >> 1) & 1);
            }
            const float e1 = fexp(tv[1] - tv[0]), e2 = fexp(tv[2] - tv[0]), e3 = fexp(tv[3] - tv[0]); const float inv = frcp(1.0f + e1 + e2 + e3);
            const float g0 = inv, g1 = e1 * inv, g2 = e2 * inv, g3 = e3 * inv;
            if (lane < 4) {
                const int half = r >= HALF_TOK ? 1 : 0;
                const int e = lane == 0 ? ti[0] : lane == 1 ? ti[1] : lane == 2 ? ti[2] : ti[3];
                const float gv = lane == 0 ? g0 : lane == 1 ? g1 : lane == 2 ? g2 : g3;
                const u32 lp = atomicAdd((u32*)&hist[half * 32 + e], 1u);
                const int idx = ((it + q) * 8 + w) * 4 + lane;
                ent[idx * 2] = ((u32)e << 24) | lp; ent[idx * 2 + 1] = __float_as_uint(gv);
            }
        }
    }
    __syncthreads();
    if (tid < 64) hist[64 + tid] = atomicAdd(&cnt[tid], hist[tid]);
    __syncthreads();
    it = 0;
    for (int r = gw; r < NLAT; r += NW, ++it) {
        if (lane < 4) {
            const int half = r >= HALF_TOK ? 1 : 0; const int idx = (it * 8 + w) * 4 + lane;
            const u32 ev = ent[idx * 2]; const int e = ev >> 24; const u32 pos = hist[64 + half * 32 + e] + (ev & 0xffffffu);
            toktab[((size_t)half * 32 + e) * CAP + pos] = (u32)r * 4u + lane;
            wtab[((size_t)half * 32 + e) * CAP + pos] = __uint_as_float(ent[idx * 2 + 1]);
        }
    }
}

__device__ __forceinline__ void phase_combine(float* __restrict__ out, const bf16_t* __restrict__ X1, const fp8_t* __restrict__ Y, const float* __restrict__ mod, const float* __restrict__ fw, int bid, int G) {
    constexpr int RB = 2;
    typedef float f32x2_ __attribute__((ext_vector_type(2)));
    const int lane = threadIdx.x & 63, gw = bid * 8 + (threadIdx.x >> 6), NW = G * 8;
    for (int r0 = gw; r0 < NLAT; r0 += RB * NW) {
        u32x2 xv[RB][4]; unsigned yv[RB][4][4];
#pragma unroll
        for (int q = 0; q < RB; ++q) { const int r = r0 + q * NW < NLAT ? r0 + q * NW : r0;
#pragma unroll
            for (int j = 0; j < 4; ++j) { xv[q][j] = __builtin_nontemporal_load((const u32x2*)(X1 + (size_t)r * D + j * 256 + lane * 4));
#pragma unroll
                for (int k = 0; k < 4; ++k) yv[q][j][k] = __builtin_nontemporal_load((const unsigned*)(Y + ((size_t)r * 4 + k) * D + j * 256 + lane * 4)); } }
#pragma unroll
        for (int q = 0; q < RB; ++q) { const int r = r0 + q * NW; if (r < NLAT) {
            const float* g2 = mod + (size_t)(r >> 11) * 6144 + 5120;
            f32x4 v[4]; float ss = 0.f;
#pragma unroll
            for (int j = 0; j < 4; ++j) { const int c0 = j * 256 + lane * 4;
                f32x4 sm = (f32x4){0.f, 0.f, 0.f, 0.f};
#pragma unroll
                for (int k = 0; k < 4; ++k) { const f32x2_ lo = __builtin_amdgcn_cvt_pk_f32_fp8(yv[q][j][k], false), hi = __builtin_amdgcn_cvt_pk_f32_fp8(yv[q][j][k], true); sm[0] += lo[0]; sm[1] += lo[1]; sm[2] += hi[0]; sm[3] += hi[1]; }
                const f32x4 g = *(const f32x4*)(g2 + c0);
                v[j][0] = __uint_as_float(xv[q][j].x << 16); v[j][1] = __uint_as_float(xv[q][j].x & 0xffff0000u); v[j][2] = __uint_as_float(xv[q][j].y << 16); v[j][3] = __uint_as_float(xv[q][j].y & 0xffff0000u);
                v[j] = v[j] + g * sm * (1.0f / SC_Y);
                ss += v[j][0] * v[j][0] + v[j][1] * v[j][1] + v[j][2] * v[j][2] + v[j][3] * v[j][3]; }
            const float rstd = __builtin_amdgcn_rsqf(wave_sum(ss) * (1.0f / D) + EPS);
#pragma unroll
            for (int j = 0; j < 4; ++j) { const int c0 = j * 256 + lane * 4; const f32x4 w = *(const f32x4*)(fw + c0); __builtin_nontemporal_store(v[j] * rstd * w, (f32x4*)(out + (size_t)r * D + c0)); }
        } }
    }
}

#define XB_TMO      128
#define XB_XCNT(j)  (256  + 64 * (j))
#define XB_XSUB(j)  (1280 + 64 * (j))
#define XB_XGEN(j)  (2304 + 64 * (j))
#define XB_TOP      3328
#define XB_TOPGEN   3392
#define XCD_BAR_WORDS 3456
#define XB_SPIN_CAP (1u << 20)
__device__ __forceinline__ unsigned xb_ld(unsigned* p)              { return __hip_atomic_load(p, __ATOMIC_RELAXED, __HIP_MEMORY_SCOPE_AGENT); }
__device__ __forceinline__ unsigned xb_add(unsigned* p, unsigned v) { return __hip_atomic_fetch_add(p, v, __ATOMIC_RELAXED, __HIP_MEMORY_SCOPE_AGENT); }
__device__ __forceinline__ unsigned xb_xcc_id() { return (unsigned)__builtin_amdgcn_s_getreg((3 << 11) | 20) & 0xFu; }
#define XB_SPIN(cond, bar) do { unsigned _sp = 0; while (cond) { __builtin_amdgcn_s_sleep(1); \
    if ((++_sp & 255u) == 0u) { if (xb_ld(&(bar)[XB_TMO])) break; if (_sp > XB_SPIN_CAP) { atomicAdd(&(bar)[XB_TMO], 1u); break; } } } } while (0)
struct XcdBarrier { unsigned* bar; unsigned x; volatile LAS unsigned* st; };
__device__ __forceinline__ XcdBarrier xcd_barrier_post(unsigned* bar, volatile LAS unsigned* st) {
    XcdBarrier b; b.bar = bar; b.x = xb_xcc_id(); b.st = st;
    if (threadIdx.x == 0) (void)xb_add(&bar[XB_XCNT(b.x)], 1u);
    return b;
}
__device__ __forceinline__ void xcd_barrier_complete(unsigned* bar, unsigned x, unsigned& nloc, unsigned& nx) {
    const unsigned G = gridDim.x * gridDim.y * gridDim.z;
    unsigned sum, cnt, mine, sp = 0u;
    for (;;) {
        sum = 0u; cnt = 0u; mine = 0u;
#pragma unroll
        for (unsigned j = 0; j < 16; ++j) { const unsigned c = xb_ld(&bar[XB_XCNT(j)]); sum += c; cnt += (c > 0u) ? 1u : 0u; mine = (j == x) ? c : mine; }
        if (sum == G) break;
        __builtin_amdgcn_s_sleep(1);
        if ((++sp & 255u) == 0u) { if (xb_ld(&bar[XB_TMO])) break; if (sp > XB_SPIN_CAP) { atomicAdd(&bar[XB_TMO], 1u); break; } }
    }
    nloc = mine > 0u ? mine : 1u; nx = cnt > 0u ? cnt : 1u;
}
__device__ __forceinline__ void xcd_barrier(unsigned* bar, volatile LAS unsigned* st) {
    asm volatile("s_waitcnt vmcnt(0)" ::: "memory");
    __syncthreads();
    if (threadIdx.x == 0) {
        __builtin_amdgcn_s_waitcnt(0);
        const unsigned x = xb_xcc_id();
        unsigned nloc = st[0], nx = st[1];
        if (nloc == 0u) { xcd_barrier_complete(bar, x, nloc, nx); st[0] = nloc; st[1] = nx; }
        const unsigned old = xb_add(&bar[XB_XSUB(x)], 1u);
        const unsigned gen = old / nloc;
        if (old + 1u == (gen + 1u) * nloc) {
            __builtin_amdgcn_fence(__ATOMIC_RELEASE, "agent");
            asm volatile("s_waitcnt vmcnt(0)" ::: "memory");
            const unsigned og = xb_add(&bar[XB_TOP], 1u);
            const unsigned tg = og / nx;
            if (og + 1u == (tg + 1u) * nx) xb_add(&bar[XB_TOPGEN], 1u);
            else XB_SPIN(xb_ld(&bar[XB_TOPGEN]) == tg, bar);
            __builtin_amdgcn_fence(__ATOMIC_ACQUIRE, "agent");
            xb_add(&bar[XB_XGEN(x)], 1u);
            asm volatile("s_waitcnt vmcnt(0)" ::: "memory");
        } else {
            XB_SPIN(xb_ld(&bar[XB_XGEN(x)]) == gen, bar);
            __builtin_amdgcn_fence(__ATOMIC_ACQUIRE, "agent");
            asm volatile("s_waitcnt vmcnt(0)" ::: "memory");
        }
    }
    __syncthreads();
}
constexpr size_t WS_BAR = 16384;
constexpr int LDS_BARST = LDS_BYTES - 16;

struct MegaArgs {
    const float *x, *c, *ctx, *c_ctx, *norm1_w, *norm2_w, *w_ada, *b_ada, *w_in, *lbl, *hg_nw, *conv_w, *conv_b, *rg_wa, *rg_ba, *rg_wx, *rg_bx, *rg_lam, *w_out,
        *router_w, *router_b, *wgu, *bgu, *wd, *bd, *final_w;
    float* out; unsigned char* ws;
};
typedef const MegaArgs __attribute__((address_space(4)))* KArgs;
__device__ __forceinline__ KArgs kargs() { auto p = __builtin_amdgcn_kernarg_segment_ptr(); asm volatile("" : "+s"(p)); return (KArgs)p; }
#define WSP(T, off) ((T*)(ws + (off)))
#define GRID_SYNC_CG() cg::this_grid().sync()
#define GRID_SYNC() do { KArgs a_ = kargs(); xcd_barrier((unsigned*)(a_->ws + WS_BAR), (volatile LAS unsigned*)(lds + LDS_BARST)); } while (0)
__global__ __launch_bounds__(512, 2) void k_mega(MegaArgs a_unused) {
    extern __shared__ __attribute__((aligned(16))) unsigned char lds_[];
    LAS unsigned char* lds = (LAS unsigned char*)lds_;
    if (threadIdx.x < 4) ((volatile LAS unsigned*)(lds + LDS_BARST))[threadIdx.x] = 0u;
    __syncthreads();
    { KArgs a = kargs(); (void)xcd_barrier_post((unsigned*)(a->ws + WS_BAR), (volatile LAS unsigned*)(lds + LDS_BARST)); }
    { KArgs a = kargs(); unsigned char* ws = a->ws; const int bid = blockIdx.x, G = gridDim.x;
      ProArgs pa; pa.c = a->c; pa.c_ctx = a->c_ctx; pa.w_ada = a->w_ada; pa.b_ada = a->b_ada; pa.lbl = a->lbl; pa.w_in = a->w_in; pa.w_out = a->w_out; pa.wgu = a->wgu; pa.wd = a->wd; pa.rg_wa = a->rg_wa; pa.rg_wx = a->rg_wx; pa.rg_lam = a->rg_lam;
      pa.coef = WSP(float, WS_COEF); pa.WG_t = WSP(bf16_t, WS_WG); pa.mod = WSP(float, WS_MOD); pa.lb = WSP(float, WS_LB); pa.Win_t = WSP(bf16_t, WS_WIN); pa.Wout_t = WSP(bf16_t, WS_WOUT); pa.Wgu_t = WSP(fp8_t, WS_WGU); pa.Wd_t = WSP(fp8_t, WS_WD);
      phase_prologue(lds, pa, bid, G, true, 0, 0); }
    { KArgs a_ = kargs(); if (a_->ws == nullptr) GRID_SYNC_CG(); }
    GRID_SYNC();
    { KArgs a = kargs(); unsigned char* ws = a->ws; phase_norm1(a->x, a->ctx, a->norm1_w, WSP(float, WS_MOD), WSP(bf16_t, WS_H), blockIdx.x, gridDim.x); }
    { KArgs a = kargs(); unsigned char* ws = a->ws;
      ProArgs pa; pa.c = nullptr; pa.c_ctx = nullptr; pa.w_ada = nullptr; pa.b_ada = nullptr; pa.lbl = nullptr; pa.w_in = a->w_in; pa.w_out = a->w_out; pa.wgu = nullptr; pa.wd = nullptr; pa.rg_wa = nullptr; pa.rg_wx = nullptr; pa.rg_lam = nullptr; pa.coef = nullptr; pa.WG_t = nullptr;
      pa.mod = nullptr; pa.lb = nullptr; pa.Win_t = WSP(bf16_t, WS_WIN); pa.Wout_t = WSP(bf16_t, WS_WOUT); pa.Wgu_t = nullptr; pa.Wd_t = nullptr;
      phase_prologue(lds, pa, blockIdx.x, gridDim.x, false, 0, IT_IN + IT_OUT); }
    GRID_SYNC();
    { KArgs a = kargs(); unsigned char* ws = a->ws; PolInProj P; P.A = WSP(bf16_t, WS_H); P.Bt = WSP(bf16_t, WS_WIN); P.O = WSP(bf16_t, WS_PROJ); P.ord.init(NLAT / BM, INW / BM, gridDim.x, blockIdx.x); gemm_phase(lds, P); }
    GRID_SYNC();
    { KArgs a = kargs(); unsigned char* ws = a->ws;
      for (int item = blockIdx.x; item < 256; item += gridDim.x)
          phase_rg_chain(lds, WSP(bf16_t, WS_PROJ), a->conv_w, a->conv_b, WSP(bf16_t, WS_WG), a->rg_ba, a->rg_bx, WSP(float, WS_COEF), WSP(bf16_t, WS_HF), WSP(bf16_t, WS_MIX2), item); }
    __syncthreads();
    { KArgs a = kargs(); unsigned char* ws = a->ws;
      for (int item = blockIdx.x; item < 256; item += gridDim.x) phase_hgrn2_ws(lds, WSP(bf16_t, WS_PROJ), WSP(float, WS_LB), WSP(bf16_t, WS_OF), WSP(bf16_t, WS_OB), item); }
    GRID_SYNC();
    { KArgs a = kargs(); unsigned char* ws = a->ws; phase_mix_finish(WSP(bf16_t, WS_PROJ), WSP(bf16_t, WS_OF), WSP(bf16_t, WS_OB), a->hg_nw, WSP(bf16_t, WS_MIX2), blockIdx.x, gridDim.x); }
    GRID_SYNC();
    { KArgs a = kargs(); unsigned char* ws = a->ws; PolOutProj P; P.A = WSP(bf16_t, WS_MIX2); P.Bt = WSP(bf16_t, WS_WOUT); P.x = a->x; P.mod = WSP(float, WS_MOD); P.O = WSP(bf16_t, WS_X1); P.ord.init(NLAT / BM, D / BM, gridDim.x, blockIdx.x); gemm_phase(lds, P); }
    GRID_SYNC();
    { KArgs a = kargs(); unsigned char* ws = a->ws;
      phase_norm2_route(lds, WSP(bf16_t, WS_X1), a->norm2_w, WSP(float, WS_MOD), a->router_w, a->router_b, WSP(fp8_t, WS_H2), WSP(u32, WS_CTL), WSP(u32, WS_TOKTAB), WSP(float, WS_WTAB), blockIdx.x, gridDim.x); }
    __syncthreads();
    { KArgs a = kargs(); unsigned char* ws = a->ws;
      ProArgs pa; pa.c = nullptr; pa.c_ctx = nullptr; pa.w_ada = nullptr; pa.b_ada = nullptr; pa.lbl = nullptr; pa.w_in = nullptr; pa.w_out = nullptr; pa.wgu = a->wgu; pa.wd = a->wd; pa.rg_wa = nullptr; pa.rg_wx = nullptr; pa.rg_lam = nullptr; pa.coef = nullptr; pa.WG_t = nullptr;
      pa.mod = nullptr; pa.lb = nullptr; pa.Win_t = nullptr; pa.Wout_t = nullptr; pa.Wgu_t = WSP(fp8_t, WS_WGU); pa.Wd_t = WSP(fp8_t, WS_WD);
      phase_prologue(lds, pa, blockIdx.x, gridDim.x, false, IT_IN + IT_OUT, IT_ALL); }
    GRID_SYNC();
#pragma unroll 1
    for (int half = 0; half < NHALF; ++half) {
        { KArgs a = kargs(); unsigned char* ws = a->ws; LAS int* tstart = (LAS int*)(lds + LDS_AUX);
          const int tot = moe_tile_table(tstart, WSP(u32, WS_CTL), half);
          PolGateUp P; P.A = WSP(fp8_t, WS_H2); P.Bt = WSP(fp8_t, WS_WGU); P.bgu = a->bgu; P.toktab = WSP(u32, WS_TOKTAB); P.O = WSP(fp8_t, WS_ACT); P.mt.tstart = tstart; P.mt.cnt = WSP(u32, WS_CTL); P.mt.half = half;
          P.ord.init(tot, DFF / HALFT, gridDim.x, blockIdx.x);
          gemm_phase(lds, P); }
        GRID_SYNC();
        { KArgs a = kargs(); unsigned char* ws = a->ws; LAS int* tstart = (LAS int*)(lds + LDS_AUX);
          const int tot = moe_tile_table(tstart, WSP(u32, WS_CTL), half);
          PolDown P; P.A = WSP(fp8_t, WS_ACT); P.Bt = WSP(fp8_t, WS_WD); P.bd = a->bd; P.toktab = WSP(u32, WS_TOKTAB); P.wtab = WSP(float, WS_WTAB); P.O = WSP(fp8_t, WS_Y); P.mt.tstart = tstart; P.mt.cnt = WSP(u32, WS_CTL); P.mt.half = half;
          P.ord.init(tot, D / BM, gridDim.x, blockIdx.x);
          gemm_phase(lds, P); }
        GRID_SYNC();
        { KArgs a = kargs(); unsigned char* ws = a->ws; phase_combine(a->out, WSP(bf16_t, WS_X1), WSP(fp8_t, WS_Y), WSP(float, WS_MOD), a->final_w, blockIdx.x, gridDim.x); }
        __syncthreads();
    }
}

extern "C" void kernel_launch(void* const* d_in, const int* in_sizes, int n_in, void* d_out, int out_size, void* d_ws, size_t ws_size, hipStream_t stream) {
    static int grid_blocks = 0;
    if (!grid_blocks) {
        int dev = 0, cus = 0, per_cu = 0;
        (void)hipGetDevice(&dev);
        (void)hipDeviceGetAttribute(&cus, hipDeviceAttributeMultiprocessorCount, dev);
        (void)hipFuncSetAttribute((const void*)k_mega, hipFuncAttributeMaxDynamicSharedMemorySize, LDS_BYTES);
        (void)hipOccupancyMaxActiveBlocksPerMultiprocessor(&per_cu, (const void*)k_mega, 512, LDS_BYTES);
        if (per_cu < 1) { fprintf(stderr, "kernel_launch: occupancy query says %d blocks/CU\n", per_cu); per_cu = 1; }
        grid_blocks = cus * 1;
    }
    if (ws_size < 1024 * MiB) { fprintf(stderr, "kernel_launch: workspace too small (%zu)\n", ws_size); return; }
    MegaArgs a{};
    const float** ap = (const float**)&a;
    for (int i = 0; i < 26; ++i) ap[i] = (const float*)d_in[i];
    a.out = (float*)d_out; a.ws = (unsigned char*)d_ws;
    (void)hipMemsetAsync((unsigned char*)d_ws + WS_CTL, 0, 32768, stream);
    void* args[] = {&a};
    hipError_t e = hipLaunchCooperativeKernel((const void*)k_mega, dim3(grid_blocks), dim3(512), args, LDS_BYTES, stream);
    if (e != hipSuccess) fprintf(stderr, "cooperative launch failed: %s (grid %d)\n", hipGetErrorString(e), grid_blocks);
}
```

```cpp
#include <hip/hip_runtime.h>
#include <hip/hip_cooperative_groups.h>
#include <cstdio>
#include <cstdint>

typedef unsigned short bf16_t;
typedef unsigned int u32;
namespace cg = cooperative_groups;

constexpr int D = 1024, NB = 32, T = 2048, CTXL = 256, GRIDW = 64, GROWS = T / GRIDW;
constexpr int NLAT = NB * T;
constexpr int NCTX = NB * CTXL;
constexpr int NROWS = NLAT + NCTX;
constexpr int HGW = 512, RGW = 512, INW = 3584;
constexpr int C_Q = 0, C_I = 512, C_FF = 1024, C_FB = 1536, C_G = 2048, C_RX = 2560, C_RG = 3072;
constexpr int NE = 32, TOPK = 4, DFF = 1024;
constexpr int NCHK = (CTXL + T) / 64;
constexpr int NHALF = 1;
constexpr int HALF_TOK = NLAT / NHALF;
constexpr int CAP = HALF_TOK;
constexpr int MAXSLOT = HALF_TOK * TOPK + NE * 256;
constexpr float EPS = 1e-6f;

constexpr size_t MiB = 1u << 20;
constexpr size_t WS_CTL = 0;
constexpr size_t WS_WG = 64 * 1024;
constexpr size_t WS_MOD = 1 * MiB;
constexpr size_t WS_LB = WS_MOD + 33 * 6144 * 4;
constexpr size_t WS_COEF = WS_LB + 4096;
constexpr size_t WS_TOKTAB = 2 * MiB;
constexpr size_t WS_WTAB = 10 * MiB;
constexpr size_t WS_WIN = 18 * MiB, WS_WOUT = 25 * MiB;
constexpr size_t WS_OF = 28 * MiB, WS_OB = 92 * MiB;
constexpr size_t WS_HF = 156 * MiB;
constexpr size_t WS_H = 284 * MiB;
constexpr size_t WS_MIX2 = WS_H;
constexpr size_t WS_PROJ = 428 * MiB;
constexpr size_t WS_H2 = 28 * MiB;
constexpr size_t WS_WGU = 92 * MiB, WS_WD = 156 * MiB;
constexpr size_t WS_ACT = 188 * MiB;
constexpr size_t WS_Y = 452 * MiB;
constexpr size_t WS_X1 = 708 * MiB;
constexpr float SC_Y = 16.0f;

__device__ __forceinline__ float bf2f(bf16_t b) { return __uint_as_float(((u32)b) << 16); }
__device__ __forceinline__ bf16_t f2bf(float f) { u32 u = __float_as_uint(f); u += 0x7fffu + ((u >> 16) & 1u); return (bf16_t)(u >> 16); }
__device__ __forceinline__ u32 pk2(float lo, float hi) { return (u32)f2bf(lo) | ((u32)f2bf(hi) << 16); }
__device__ __forceinline__ float fexp(float x) { return __builtin_amdgcn_exp2f(x * 1.4426950408889634f); }
__device__ __forceinline__ float frcp(float x) { return __builtin_amdgcn_rcpf(x); }
__device__ __forceinline__ float flog(float x) { return __builtin_amdgcn_logf(x) * 0.6931471805599453f; }
__device__ __forceinline__ float fsqrt(float x) { return __builtin_amdgcn_sqrtf(x); }
__device__ __forceinline__ float sigmoidf_(float x) { return frcp(1.0f + fexp(-x)); }
__device__ __forceinline__ float wave_sum(float v) {
#pragma unroll
    for (int o = 1; o < 64; o <<= 1) v += __shfl_xor(v, o);
    return v;
}

__device__ __forceinline__ float gelu_tanh(float x) { const float u = 1.5957691216057308f * (x + 0.044715f * x * x * x); return x * sigmoidf_(u); }
#define LAS __attribute__((address_space(3)))
typedef short bf16x8 __attribute__((ext_vector_type(8)));
typedef float f32x4 __attribute__((ext_vector_type(4)));
typedef unsigned u32x4 __attribute__((ext_vector_type(4)));
typedef int v8i __attribute__((ext_vector_type(8)));
typedef int v4i_ __attribute__((ext_vector_type(4)));
typedef unsigned u32x2 __attribute__((ext_vector_type(2)));
typedef unsigned char fp8_t;
constexpr float SC_H2 = 16.0f, SC_W = 32.0f, SC_ACT = 4.0f;
__device__ __forceinline__ unsigned pk4_fp8(float a, float b, float c, float d) {
    a = fminf(fmaxf(a, -448.f), 448.f); b = fminf(fmaxf(b, -448.f), 448.f); c = fminf(fmaxf(c, -448.f), 448.f); d = fminf(fmaxf(d, -448.f), 448.f);
    int r = 0; r = __builtin_amdgcn_cvt_pk_fp8_f32(a, b, r, false); r = __builtin_amdgcn_cvt_pk_fp8_f32(c, d, r, true); return (unsigned)r; }
constexpr int BM = 256, BK = 64, HALFT = 128, HTB = HALFT * BK * 2, STAGE_BYTES = 8 * HTB, NXCD = 8, WGM = 8;
constexpr int GK = 1024;
constexpr int LDS_BYTES = 147456;
constexpr int LDS_AUX = STAGE_BYTES;

__device__ __forceinline__ int lds_byte(int r, int c) { const int st = (r >> 4) * 2 + (c >> 5), rr = r & 15, cc = c & 31, ob = rr * 64 + cc * 2; return st * 1024 + (ob ^ (((ob >> 9) & 1) << 5)); }
__device__ __forceinline__ void stage_rc(int b, int& R, int& C) { const int st = b / 1024, sb = b % 1024, swz = sb ^ (((sb >> 9) & 1) << 5); R = (st >> 1) * 16 + swz / 64; C = (st & 1) * 32 + (swz % 64) / 2; }
__device__ __forceinline__ int perm32(int rho) { const int n = rho >> 4, i = rho & 15; return 8 * (i >> 2) + 4 * n + (i & 3); }
__device__ __forceinline__ unsigned cvt_pk_bf16(float lo, float hi) { unsigned r; asm volatile("v_cvt_pk_bf16_f32 %0, %1, %2" : "=v"(r) : "v"(lo), "v"(hi)); return r; }

struct Unit { int pm, pn, e, pos0, cn; };
struct TileOrder {
    int nM, nN, nwg, G, c;
    __device__ __forceinline__ void init(int nM_, int nN_, int G_, int c_) { nM = nM_; nN = nN_; nwg = nM * nN; G = G_; c = c_; }
    __device__ __forceinline__ bool tile(int i, int& pm, int& pn) const {
        const long L = (long)i * G + c; if (L >= nwg) return false;
        int wgid = (int)L; { const int q = nwg / NXCD, r = nwg % NXCD, xcd = wgid % NXCD, off = wgid / NXCD; wgid = (xcd < r ? xcd * (q + 1) : r * (q + 1) + (xcd - r) * q) + off; }
        const int nig = WGM * nN, gid = wgid / nig, fm = gid * WGM, gsz = (nM - fm) < WGM ? (nM - fm) : WGM;
        pm = fm + ((wgid % nig) % gsz); pn = (wgid % nig) / gsz; return true;
    }
};

template <class POL>
__device__ __forceinline__ void gemm_phase(LAS unsigned char* lds, const POL& P) {
    int tid_ = threadIdx.x; asm volatile("" : "+v"(tid_));
    const int tid = tid_, wid = __builtin_amdgcn_readfirstlane(tid >> 6), lane = tid & 63, wr = wid >> 2, wc = wid & 3, fr = lane & 15, fq = lane >> 4;
    constexpr int KB = POL::FP8 ? 1024 : 2048, nt = KB / 128;
    int sR[2], sC[2]; unsigned voffA[2], voffB[2];
#pragma unroll
    for (int i = 0; i < 2; ++i) { stage_rc(tid * 16 + i * 8192, sR[i], sC[i]); const int Rb = POL::PERM ? ((sR[i] & ~31) + perm32(sR[i] & 31)) : sR[i]; voffA[i] = (unsigned)(sR[i] * KB + sC[i] * 2); voffB[i] = (unsigned)(Rb * KB + sC[i] * 2); }
    constexpr size_t kstep = (size_t)(BK * 2);
    constexpr unsigned hstepB = (unsigned)HALFT * KB;
    const unsigned ldsw = (unsigned)wid * 1024u;
    const int aoff = POL::FP8 ? lds_byte(wr * 64 + fr, fq * 16) : lds_byte(wr * 64 + fr, fq * 8), boff = POL::FP8 ? lds_byte(wc * 32 + fr, fq * 16) : lds_byte(wc * 32 + fr, fq * 8);
#define G_SA(b, h) (((b) * 2 + (h)) * HTB)
#define G_SB(b, h) ((4 + (b) * 2 + (h)) * HTB)
#define G_AOFF(OFF, h, i) (POL::GATHER ? (OFF)[h][i] : voffA[i])
#define G_STAGE_A(bufoff, gbase, OFF, h) do { const char* _gb = (const char*)(gbase) + (POL::GATHER ? (size_t)0 : (size_t)(h) * hstepB); _Pragma("unroll") for (int _i = 0; _i < 2; ++_i) \
        __builtin_amdgcn_global_load_lds((const unsigned*)(_gb + G_AOFF(OFF, h, _i)), (LAS unsigned*)(lds + (bufoff) + ldsw + _i * 8192), 16, 0, 0); } while (0)
#define G_STAGE_B(bufoff, gbase, hoff) do { const char* _gb = (const char*)(gbase) + (size_t)(hoff); _Pragma("unroll") for (int _i = 0; _i < 2; ++_i) \
        __builtin_amdgcn_global_load_lds((const unsigned*)(_gb + voffB[_i]), (LAS unsigned*)(lds + (bufoff) + ldsw + _i * 8192), 16, 0, 0); } while (0)
#define G_LD8(p) __builtin_shufflevector(*(const LAS v4i_*)(p), *(const LAS v4i_*)((p) + 16), 0, 1, 2, 3, 4, 5, 6, 7)
#define G_LDA(dst, b, h) do { if (POL::FP8) { _Pragma("unroll") for (int m = 0; m < 4; ++m) dst##8[m] = G_LD8(lds + G_SA(b, h) + aoff + m * 2048); } \
        else { _Pragma("unroll") for (int m = 0; m < 4; ++m) _Pragma("unroll") for (int k = 0; k < 2; ++k) dst[m][k] = *(const LAS bf16x8*)(lds + G_SA(b, h) + aoff + m * 2048 + k * 1024); } } while (0)
#define G_LDB(dst, b, h) do { if (POL::FP8) { _Pragma("unroll") for (int n = 0; n < 2; ++n) dst##8[n] = G_LD8(lds + G_SB(b, h) + boff + n * 2048); } \
        else { _Pragma("unroll") for (int n = 0; n < 2; ++n) _Pragma("unroll") for (int k = 0; k < 2; ++k) dst[n][k] = *(const LAS bf16x8*)(lds + G_SB(b, h) + boff + n * 2048 + k * 1024); } } while (0)
#define G_MMA(ai, bj, At, Bt) do { __builtin_amdgcn_s_setprio(1); \
        if (POL::FP8) { _Pragma("unroll") for (int m = 0; m < 4; ++m) _Pragma("unroll") for (int n = 0; n < 2; ++n) \
            asm volatile("v_mfma_scale_f32_16x16x128_f8f6f4 %0, %1, %2, %0, %3, %3 op_sel_hi:[0,0,0]" : "+v"(acc[ai][bj][m][n]) : "v"(Bt##8[n]), "v"(At##8[m]), "v"(mxs)); } \
        else { _Pragma("unroll") for (int m = 0; m < 4; ++m) _Pragma("unroll") for (int n = 0; n < 2; ++n) _Pragma("unroll") for (int k = 0; k < 2; ++k) \
            acc[ai][bj][m][n] = __builtin_amdgcn_mfma_f32_16x16x32_bf16(Bt[n][k], At[m][k], acc[ai][bj][m][n], 0, 0, 0); } \
        __builtin_amdgcn_s_setprio(0); } while (0)
#define G_WAIT_V(n) asm volatile("s_waitcnt vmcnt(" #n ")" ::: "memory")
#define G_WAIT_L(n) asm volatile("s_waitcnt lgkmcnt(" #n ")" ::: "memory")
#define G_BAR __builtin_amdgcn_s_barrier()
#define G_SCHED __builtin_amdgcn_sched_barrier(0)
#define G_TRIP(A1, OC, A2, ON, B2) do { \
        G_LDB(B0, 0, 0); G_SCHED; G_LDA(At, 0, 0); G_STAGE_A(G_SA(1, 1), A1, OC, 1); \
        G_WAIT_L(8); G_BAR; G_WAIT_L(0); G_MMA(0, 0, At, B0); G_BAR; G_SCHED; \
        G_LDB(B1, 0, 1); G_STAGE_B(G_SB(0, 0), B2, 0u); \
        G_BAR; G_WAIT_L(0); G_MMA(0, 1, At, B1); G_BAR; \
        G_LDA(At, 0, 1); G_STAGE_A(G_SA(0, 0), A2, ON, 0); \
        G_BAR; G_WAIT_L(0); G_MMA(1, 0, At, B0); G_BAR; G_SCHED; \
        G_STAGE_B(G_SB(0, 1), B2, hstepB); \
        G_WAIT_V(6); G_BAR; G_MMA(1, 1, At, B1); G_BAR; \
        G_LDB(B0, 1, 0); G_SCHED; G_LDA(At, 1, 0); G_STAGE_A(G_SA(0, 1), A2, ON, 1); \
        G_WAIT_L(8); G_BAR; G_WAIT_L(0); G_MMA(0, 0, At, B0); G_BAR; G_SCHED; \
        G_LDB(B1, 1, 1); G_STAGE_B(G_SB(1, 0), (B2) + kstep, 0u); \
        G_BAR; G_WAIT_L(0); G_MMA(0, 1, At, B1); G_BAR; \
        G_LDA(At, 1, 1); G_STAGE_A(G_SA(1, 0), (A2) + kstep, ON, 0); \
        G_BAR; G_WAIT_L(0); G_MMA(1, 0, At, B0); G_BAR; G_SCHED; \
        G_STAGE_B(G_SB(1, 1), (B2) + kstep, hstepB); \
        G_WAIT_V(6); G_BAR; G_MMA(1, 1, At, B1); G_BAR; } while (0)
#define G_TRIP2(A1, OC, A2, ON, B2) do { \
        G_LDB(B0, 0, 0); G_LDB(B1, 0, 1); G_SCHED; G_LDA(At, 0, 0); G_STAGE_A(G_SA(1, 1), A1, OC, 1); \
        G_WAIT_V(8); G_WAIT_L(0); G_BAR; G_MMA(0, 0, At, B0); G_MMA(0, 1, At, B1); G_BAR; G_SCHED; \
        G_LDA(At, 0, 1); G_STAGE_B(G_SB(0, 0), B2, 0u); G_STAGE_B(G_SB(0, 1), B2, hstepB); G_STAGE_A(G_SA(0, 0), A2, ON, 0); \
        G_WAIT_V(8); G_WAIT_L(0); G_BAR; G_MMA(1, 0, At, B0); G_MMA(1, 1, At, B1); G_BAR; G_SCHED; \
        G_LDB(B0, 1, 0); G_LDB(B1, 1, 1); G_SCHED; G_LDA(At, 1, 0); G_STAGE_A(G_SA(0, 1), A2, ON, 1); \
        G_WAIT_V(8); G_WAIT_L(0); G_BAR; G_MMA(0, 0, At, B0); G_MMA(0, 1, At, B1); G_BAR; G_SCHED; \
        G_LDA(At, 1, 1); G_STAGE_B(G_SB(1, 0), (B2) + kstep, 0u); G_STAGE_B(G_SB(1, 1), (B2) + kstep, hstepB); G_STAGE_A(G_SA(1, 0), (A2) + kstep, ON, 0); \
        G_WAIT_V(8); G_WAIT_L(0); G_BAR; G_MMA(1, 0, At, B0); G_MMA(1, 1, At, B1); G_BAR; G_SCHED; } while (0)
#ifndef GEMM_SP2
#define GEMM_SP2 1
#endif
    Unit cur, nxt; int ui = 0;
    if (!P.next(0, cur)) return;
    f32x4 acc[2][2][4][2];
#pragma unroll
    for (int a = 0; a < 2; ++a)
#pragma unroll
        for (int b = 0; b < 2; ++b)
#pragma unroll
            for (int m = 0; m < 4; ++m)
#pragma unroll
                for (int n = 0; n < 2; ++n) acc[a][b][m][n] = (f32x4){0.f, 0.f, 0.f, 0.f};
    const int mxs = 0x7f7f7f7f;
    bf16x8 At[4][2], B0[2][2], B1[2][2]; v8i At8[4], B08[2], B18[2];
    unsigned oc[2][2], on[2][2];
#pragma unroll
    for (int h = 0; h < 2; ++h)
#pragma unroll
        for (int i = 0; i < 2; ++i) { oc[h][i] = POL::GATHER ? P.a_off(cur, h * HALFT + sR[i]) + (unsigned)sC[i] * 2u : 0u; on[h][i] = 0u; }
    const char* cA = P.a_base(cur); const char* cB = P.b_base(cur);
    if (GEMM_SP2) {
        G_STAGE_B(G_SB(0, 0), cB, 0u); G_STAGE_B(G_SB(0, 1), cB, hstepB); G_STAGE_A(G_SA(0, 0), cA, oc, 0); G_STAGE_A(G_SA(0, 1), cA, oc, 1);
        if (wr == 1) G_BAR;
        G_WAIT_V(2); G_BAR;
        G_STAGE_B(G_SB(1, 0), cB + kstep, 0u); G_STAGE_A(G_SA(1, 0), cA + kstep, oc, 0); G_STAGE_B(G_SB(1, 1), cB + kstep, hstepB);
        G_WAIT_V(6); G_BAR;
    } else {
    G_STAGE_B(G_SB(0, 0), cB, 0u); G_STAGE_A(G_SA(0, 0), cA, oc, 0); G_STAGE_B(G_SB(0, 1), cB, hstepB); G_STAGE_A(G_SA(0, 1), cA, oc, 1);
    if (wr == 1) G_BAR;
    G_WAIT_V(4); G_BAR;
    G_STAGE_B(G_SB(1, 0), cB + kstep, 0u); G_STAGE_A(G_SA(1, 0), cA + kstep, oc, 0); G_STAGE_B(G_SB(1, 1), cB + kstep, hstepB);
    G_WAIT_V(6); G_BAR;
    }
    for (;;) {
        const bool has_next = P.next(ui + 1, nxt);
        const char* nA = has_next ? P.a_base(nxt) : cA; const char* nB = has_next ? P.b_base(nxt) : cB;
        if (POL::GATHER) {
#pragma unroll
            for (int h = 0; h < 2; ++h)
#pragma unroll
                for (int i = 0; i < 2; ++i) on[h][i] = has_next ? P.a_off(nxt, h * HALFT + sR[i]) + (unsigned)sC[i] * 2u : oc[h][i];
        }
#pragma unroll 1
        for (int t = 0; t < nt; t += 2) {
            const bool last = (t == nt - 2);
            const char* a1 = cA + (size_t)(t + 1) * kstep; const char* a2 = last ? nA : cA + (size_t)(t + 2) * kstep; const char* b2 = last ? nB : cB + (size_t)(t + 2) * kstep;
            if (POL::GATHER) {
                unsigned os[2][2];
#pragma unroll
                for (int h = 0; h < 2; ++h)
#pragma unroll
                    for (int i = 0; i < 2; ++i) os[h][i] = last ? on[h][i] : oc[h][i];
                if (GEMM_SP2) { G_TRIP2(a1, oc, a2, os, b2); } else { G_TRIP(a1, oc, a2, os, b2); }
            } else { if (GEMM_SP2) { G_TRIP2(a1, oc, a2, oc, b2); } else { G_TRIP(a1, oc, a2, oc, b2); } }
        }
        if (POL::FP8) asm volatile("s_nop 15\n\ts_nop 15" ::: "memory");
        if (wr == 0) G_BAR;
        P.epi(acc, cur, wr, wc, fr, fq);
        if (!has_next) break;
#pragma unroll
        for (int a = 0; a < 2; ++a)
#pragma unroll
            for (int b = 0; b < 2; ++b)
#pragma unroll
                for (int m = 0; m < 4; ++m)
#pragma unroll
                    for (int n = 0; n < 2; ++n) acc[a][b][m][n] = (f32x4){0.f, 0.f, 0.f, 0.f};
        cur = nxt; cA = nA; cB = nB; ++ui;
        if (POL::GATHER) {
#pragma unroll
            for (int h = 0; h < 2; ++h)
#pragma unroll
                for (int i = 0; i < 2; ++i) oc[h][i] = on[h][i];
        }
        if (wr == 1) G_BAR;
    }
    G_WAIT_V(0);
    G_BAR;
#undef G_SA
#undef G_SB
#undef G_AOFF
#undef G_STAGE_A
#undef G_STAGE_B
#undef G_LDA
#undef G_LDB
#undef G_MMA
#undef G_LD8
#undef G_WAIT_V
#undef G_WAIT_L
#undef G_BAR
#undef G_SCHED
#undef G_TRIP
#undef G_TRIP2
}

struct PolInProj {
    static constexpr bool PERM = true, GATHER = false, FP8 = false;
    const bf16_t* A; const bf16_t* Bt; bf16_t* O; TileOrder ord;
    __device__ __forceinline__ bool next(int i, Unit& u) const {
        constexpr int NLATU = (NLAT / BM) * (INW / BM);
        const int L = i * ord.G + ord.c;
        if (L < NLATU) return ord.tile(i, u.pm, u.pn);
        const int q = L - NLATU; if (q >= (NCTX / BM) * 8) return false;
        u.pm = NLAT / BM + (q >> 3); const int j = q & 7; u.pn = j < 6 ? 2 + j : 4 + j; return true;
    }
    __device__ __forceinline__ const char* a_base(const Unit& u) const { return (const char*)A + (size_t)u.pm * BM * GK * 2; }
    __device__ __forceinline__ unsigned a_off(const Unit&, int r) const { return (unsigned)r * GK * 2u; }
    __device__ __forceinline__ const char* b_base(const Unit& u) const { return (const char*)Bt + (size_t)u.pn * BM * GK * 2; }
    __device__ __forceinline__ void epi(const f32x4 (&acc)[2][2][4][2], const Unit& u, int wr, int wc, int fr, int fq) const {
        const int row0 = u.pm * BM + wr * 64 + fr, col0 = u.pn * BM + wc * 32 + 8 * fq;
#pragma unroll
        for (int ai = 0; ai < 2; ++ai)
#pragma unroll
            for (int m = 0; m < 4; ++m) { bf16_t* rowp = O + (size_t)(row0 + ai * HALFT + m * 16) * INW + col0;
#pragma unroll
                for (int bj = 0; bj < 2; ++bj) { const f32x4 v0 = acc[ai][bj][m][0], v1 = acc[ai][bj][m][1];
                    u32x4 w; w.x = cvt_pk_bf16(v0[0], v0[1]); w.y = cvt_pk_bf16(v0[2], v0[3]); w.z = cvt_pk_bf16(v1[0], v1[1]); w.w = cvt_pk_bf16(v1[2], v1[3]);
                    *(u32x4*)(rowp + bj * HALFT) = w; } }
    }
};
struct PolOutProj {
    static constexpr bool PERM = true, GATHER = false, FP8 = false;
    const bf16_t* A; const bf16_t* Bt; const float* x; const float* mod; bf16_t* O; TileOrder ord;
    __device__ __forceinline__ bool next(int i, Unit& u) const { return ord.tile(i, u.pm, u.pn); }
    __device__ __forceinline__ const char* a_base(const Unit& u) const { return (const char*)A + (size_t)u.pm * BM * GK * 2; }
    __device__ __forceinline__ unsigned a_off(const Unit&, int r) const { return (unsigned)r * GK * 2u; }
    __device__ __forceinline__ const char* b_base(const Unit& u) const { return (const char*)Bt + (size_t)u.pn * BM * GK * 2; }
    __device__ __forceinline__ void epi(const f32x4 (&acc)[2][2][4][2], const Unit& u, int wr, int wc, int fr, int fq) const {
        const int row0 = u.pm * BM + wr * 64 + fr, col0 = u.pn * BM + wc * 32 + 8 * fq;
        const float* g1 = mod + (size_t)((u.pm * BM) >> 11) * 6144 + 2048 + col0;
        f32x4 gv[2][2];
#pragma unroll
        for (int bj = 0; bj < 2; ++bj) { gv[bj][0] = *(const f32x4*)(g1 + bj * HALFT); gv[bj][1] = *(const f32x4*)(g1 + bj * HALFT + 4); }
#pragma unroll
        for (int ai = 0; ai < 2; ++ai)
#pragma unroll
            for (int m = 0; m < 4; ++m) { const size_t off = (size_t)(row0 + ai * HALFT + m * 16) * D + col0;
#pragma unroll
                for (int bj = 0; bj < 2; ++bj) {
                    const f32x4 x0 = __builtin_nontemporal_load((const f32x4*)(x + off + bj * HALFT)), x1v = __builtin_nontemporal_load((const f32x4*)(x + off + bj * HALFT + 4));
                    const f32x4 v0 = x0 + gv[bj][0] * acc[ai][bj][m][0], v1 = x1v + gv[bj][1] * acc[ai][bj][m][1];
                    u32x4 w; w.x = cvt_pk_bf16(v0[0], v0[1]); w.y = cvt_pk_bf16(v0[2], v0[3]); w.z = cvt_pk_bf16(v1[0], v1[1]); w.w = cvt_pk_bf16(v1[2], v1[3]);
                    *(u32x4*)(O + off + bj * HALFT) = w; }
                asm volatile("" ::: "memory"); }
    }
};
struct MoeTiles {
    const LAS int* tstart; const u32* cnt; int half;
    __device__ __forceinline__ void find(Unit& u) const {
        const int e = __builtin_amdgcn_readfirstlane(tstart[64 + u.pm]);
        u.e = e; u.pos0 = (u.pm - __builtin_amdgcn_readfirstlane(tstart[e])) * BM; u.cn = (int)cnt[half * NE + e];
    }
};
struct PolGateUp {
    static constexpr bool PERM = true, GATHER = true, FP8 = true;
    const fp8_t* A; const fp8_t* Bt; const float* bgu; const u32* toktab; fp8_t* O; MoeTiles mt; TileOrder ord;
    __device__ __forceinline__ bool next(int i, Unit& u) const { if (!ord.tile(i, u.pm, u.pn)) return false; mt.find(u); return true; }
    __device__ __forceinline__ const char* a_base(const Unit&) const { return (const char*)A; }
    __device__ __forceinline__ unsigned a_off(const Unit& u, int r) const {
        const int p = u.pos0 + r; const u32 tk = toktab[((size_t)mt.half * NE + u.e) * CAP + (p < u.cn ? p : 0)];
        return (tk >> 2) * 1024u;
    }
    __device__ __forceinline__ const char* b_base(const Unit& u) const { return (const char*)Bt + ((size_t)u.e * 2048 + (size_t)u.pn * BM) * 1024; }
    __device__ __forceinline__ void epi(const f32x4 (&acc)[2][2][4][2], const Unit& u, int wr, int wc, int fr, int fq) const {
        const int row0 = u.pm * BM + wr * 64 + fr, cc = u.pn * HALFT + wc * 32 + 8 * fq;
        const float* bg = bgu + (size_t)u.e * 2048 + cc;
        const f32x4 bg0 = *(const f32x4*)bg, bg1 = *(const f32x4*)(bg + 4), bu0 = *(const f32x4*)(bg + 1024), bu1 = *(const f32x4*)(bg + 1028);
        constexpr float inv = 1.0f / (SC_H2 * SC_W);
#pragma unroll
        for (int ai = 0; ai < 2; ++ai)
#pragma unroll
            for (int m = 0; m < 4; ++m) {
                f32x4 g0 = acc[ai][0][m][0] * inv + bg0, g1 = acc[ai][0][m][1] * inv + bg1, u0 = acc[ai][1][m][0] * inv + bu0, u1 = acc[ai][1][m][1] * inv + bu1;
                float o[8];
#pragma unroll
                for (int j = 0; j < 4; ++j) {
                    const float ga = fminf(g0[j], 7.0f), gb = fminf(g1[j], 7.0f);
                    const float ua = fminf(fmaxf(u0[j], -7.0f), 7.0f), ub = fminf(fmaxf(u1[j], -7.0f), 7.0f);
                    o[j] = ga * sigmoidf_(1.702f * ga) * (ua + 1.0f) * SC_ACT; o[4 + j] = gb * sigmoidf_(1.702f * gb) * (ub + 1.0f) * SC_ACT;
                }
                uint2 w; w.x = pk4_fp8(o[0], o[1], o[2], o[3]); w.y = pk4_fp8(o[4], o[5], o[6], o[7]);
                *(uint2*)(O + (size_t)(row0 + ai * HALFT + m * 16) * DFF + cc) = w;
                asm volatile("" ::: "memory");
            }
    }
};
struct PolDown {
    static constexpr bool PERM = true, GATHER = false, FP8 = true;
    const fp8_t* A; const fp8_t* Bt; const float* bd; const u32* toktab; const float* wtab; fp8_t* O; MoeTiles mt; TileOrder ord;
    __device__ __forceinline__ bool next(int i, Unit& u) const { if (!ord.tile(i, u.pm, u.pn)) return false; mt.find(u); return true; }
    __device__ __forceinline__ const char* a_base(const Unit& u) const { return (const char*)A + (size_t)u.pm * BM * 1024; }
    __device__ __forceinline__ unsigned a_off(const Unit&, int r) const { return (unsigned)r * 1024u; }
    __device__ __forceinline__ const char* b_base(const Unit& u) const { return (const char*)Bt + ((size_t)u.e * 1024 + (size_t)u.pn * BM) * 1024; }
    __device__ __forceinline__ void epi(const f32x4 (&acc)[2][2][4][2], const Unit& u, int wr, int wc, int fr, int fq) const {
        const int col0 = u.pn * BM + wc * 32 + 8 * fq;
        const float* bp = bd + (size_t)u.e * D + col0;
        f32x4 bv[2][2];
#pragma unroll
        for (int bj = 0; bj < 2; ++bj) { bv[bj][0] = *(const f32x4*)(bp + bj * HALFT); bv[bj][1] = *(const f32x4*)(bp + bj * HALFT + 4); }
        const size_t tb = ((size_t)mt.half * NE + u.e) * CAP;
        constexpr float inv = 1.0f / (SC_ACT * SC_W);
#pragma unroll
        for (int ai = 0; ai < 2; ++ai)
#pragma unroll
            for (int m = 0; m < 4; ++m) {
                asm volatile("" ::: "memory");
                const int p = u.pos0 + ai * HALFT + wr * 64 + m * 16 + fr;
                if (p < u.cn) {
                    const u32 tk = toktab[tb + p]; const float wg = wtab[tb + p] * SC_Y;
                    fp8_t* rowp = O + (size_t)(tk - (u32)mt.half * HALF_TOK * 4u) * D + col0;
#pragma unroll
                    for (int bj = 0; bj < 2; ++bj) { const f32x4 v0 = (acc[ai][bj][m][0] * inv + bv[bj][0]) * wg, v1 = (acc[ai][bj][m][1] * inv + bv[bj][1]) * wg;
                        uint2 w; w.x = pk4_fp8(v0[0], v0[1], v0[2], v0[3]); w.y = pk4_fp8(v1[0], v1[1], v1[2], v1[3]);
                        *(uint2*)(rowp + bj * HALFT) = w; }
                }
            }
    }
};
__device__ __forceinline__ int moe_tile_table(LAS int* tstart, const u32* cnt, int half) {
    __syncthreads();
    if (threadIdx.x == 0) { int s = 0; for (int e = 0; e < NE; ++e) { tstart[e] = s; s += ((int)cnt[half * NE + e] + BM - 1) / BM; } tstart[NE] = s; }
    __syncthreads();
    const int tot = tstart[NE];
    for (int t = threadIdx.x; t < tot; t += 512) { int e = 0;
#pragma unroll 1
        for (int i = 1; i < NE; ++i) if (t >= tstart[i]) e = i;
        tstart[64 + t] = e; }
    __syncthreads();
    return tot;
}

__device__ __forceinline__ void conv_item(const float* __restrict__ W, int N, bf16_t* __restrict__ WT, int k0, int n0, size_t rowbase, LAS float* scr, int lane) {
#pragma unroll 4
    for (int i = 0; i < 16; ++i) { const int k = 4 * i + (lane >> 4); const f32x4 v = __builtin_nontemporal_load((const f32x4*)(W + (size_t)(k0 + k) * N + n0 + (lane & 15) * 4)); *(LAS f32x4*)(scr + k * 68 + (lane & 15) * 4) = v; }
    asm volatile("s_waitcnt lgkmcnt(0)" ::: "memory");
    const int c = lane & 7;
#pragma unroll
    for (int j = 0; j < 8; ++j) { const int n = (lane >> 3) + 8 * j; const LAS float* s = scr + (8 * c) * 68 + n;
        u32x4 o; o.x = cvt_pk_bf16(s[0 * 68], s[1 * 68]); o.y = cvt_pk_bf16(s[2 * 68], s[3 * 68]); o.z = cvt_pk_bf16(s[4 * 68], s[5 * 68]); o.w = cvt_pk_bf16(s[6 * 68], s[7 * 68]);
        *(u32x4*)(WT + (rowbase + n) * GK + k0 + 8 * c) = o; }
    asm volatile("s_waitcnt lgkmcnt(0)" ::: "memory");
}
__device__ __forceinline__ void conv_item8(const float* __restrict__ W, int N, fp8_t* __restrict__ WT, int k0, int n0, size_t rowbase, LAS float* scr, int lane) {
#pragma unroll 4
    for (int i = 0; i < 16; ++i) { const int k = 4 * i + (lane >> 4); const f32x4 v = __builtin_nontemporal_load((const f32x4*)(W + (size_t)(k0 + k) * N + n0 + (lane & 15) * 4)); *(LAS f32x4*)(scr + k * 68 + (lane & 15) * 4) = v; }
    asm volatile("s_waitcnt lgkmcnt(0)" ::: "memory");
    const LAS float* sp = scr + lane;
#pragma unroll
    for (int q = 0; q < 4; ++q) {
        u32x4 o;
        o.x = pk4_fp8(sp[(16 * q + 0) * 68] * SC_W, sp[(16 * q + 1) * 68] * SC_W, sp[(16 * q + 2) * 68] * SC_W, sp[(16 * q + 3) * 68] * SC_W);
        o.y = pk4_fp8(sp[(16 * q + 4) * 68] * SC_W, sp[(16 * q + 5) * 68] * SC_W, sp[(16 * q + 6) * 68] * SC_W, sp[(16 * q + 7) * 68] * SC_W);
        o.z = pk4_fp8(sp[(16 * q + 8) * 68] * SC_W, sp[(16 * q + 9) * 68] * SC_W, sp[(16 * q + 10) * 68] * SC_W, sp[(16 * q + 11) * 68] * SC_W);
        o.w = pk4_fp8(sp[(16 * q + 12) * 68] * SC_W, sp[(16 * q + 13) * 68] * SC_W, sp[(16 * q + 14) * 68] * SC_W, sp[(16 * q + 15) * 68] * SC_W);
        *(u32x4*)(WT + (rowbase + lane) * GK + k0 + 16 * q) = o;
    }
    asm volatile("s_waitcnt lgkmcnt(0)" ::: "memory");
}
constexpr int IT_IN = 16 * (INW / 64), IT_OUT = 16 * (D / 64), IT_GU = NE * 16 * 32, IT_D = NE * 16 * 16, IT_ALL = IT_IN + IT_OUT + IT_GU + IT_D;
struct ProArgs { const float *c, *c_ctx, *w_ada, *b_ada, *lbl, *w_in, *w_out, *wgu, *wd, *rg_wa, *rg_wx, *rg_lam; float *mod, *lb, *coef; bf16_t *Win_t, *Wout_t, *WG_t; fp8_t *Wgu_t, *Wd_t; };
__device__ __forceinline__ void phase_prologue(LAS unsigned char* lds, const ProArgs& a, int bid, int G, bool do_mod, int it_lo, int it_hi) {
    const int tid = threadIdx.x, lane = tid & 63, w = tid >> 6;
    if (!do_mod) {} else if (bid < 96) {
        LAS float* s = (LAS float*)lds;
        for (int i = tid; i < 33 * D; i += 512) { const int b = i >> 10, k = i & 1023; const float v = b < NB ? a.c[(size_t)b * D + k] : a.c_ctx[k]; s[i] = v * sigmoidf_(v); }
        __syncthreads();
        const int n = bid * 64 + lane;
        float acc[33];
#pragma unroll
        for (int b = 0; b < 33; ++b) acc[b] = 0.f;
#pragma unroll 1
        for (int k = 128 * w; k < 128 * w + 128; k += 16) {
            float wv[16];
#pragma unroll
            for (int i = 0; i < 16; ++i) wv[i] = __builtin_nontemporal_load(a.w_ada + (size_t)(k + i) * 6144 + n);
#pragma unroll
            for (int b = 0; b < 33; ++b)
#pragma unroll
                for (int i4 = 0; i4 < 4; ++i4) { const f32x4 sv = *(const LAS f32x4*)(s + b * D + k + 4 * i4); acc[b] += sv[0] * wv[4 * i4] + sv[1] * wv[4 * i4 + 1] + sv[2] * wv[4 * i4 + 2] + sv[3] * wv[4 * i4 + 3]; }
        }
        __syncthreads();
        LAS float* red = (LAS float*)lds;
#pragma unroll
        for (int b = 0; b < 33; ++b) red[(w * 33 + b) * 64 + lane] = acc[b];
        __syncthreads();
        for (int i = tid; i < 33 * 64; i += 512) { const int b = i >> 6, l = i & 63; float sum = a.b_ada[bid * 64 + l];
#pragma unroll
            for (int ww = 0; ww < 8; ++ww) sum += red[(ww * 33 + b) * 64 + l];
            a.mod[(size_t)b * 6144 + bid * 64 + l] = sum; }
        __syncthreads();
    } else if (bid == 96) {
        for (int i = tid; i < 2 * HGW; i += 512) { const float l0 = a.lbl[i], l1 = a.lbl[2 * HGW + i]; a.lb[i] = 1.0f / (1.0f + __expf(l1 - l0)); }
        for (int i = tid; i < 2 * RGW; i += 512) { const float l = a.rg_lam[i]; const float sp = (-l > 20.f) ? -l : log1pf(__expf(-l)); a.coef[i] = -8.0f * sp; }
    } else if (bid == 97) {
        for (int idx = tid; idx < 8 * 256 * 64; idx += 512) { const int hd = idx >> 14, n = (idx >> 6) & 255, kk = idx & 63, g = n >> 6, j = n & 63, d = g >> 1;
            const float* src = (g & 1) ? a.rg_wx : a.rg_wa; a.WG_t[idx] = f2bf(src[(((size_t)d * 8 + hd) * 64 + kk) * 64 + j]); }
    }
    LAS float* scr = (LAS float*)(lds + w * (64 * 68 * 4));
    const int gw = bid * 8 + w, NW = G * 8;
    for (int it = it_lo + gw; it < it_hi; it += NW) {
        int r = it;
        if (r < IT_IN) { const int kb = r / (INW / 64), nb = r % (INW / 64); conv_item(a.w_in, INW, a.Win_t, kb * 64, nb * 64, (size_t)nb * 64, scr, lane); continue; } r -= IT_IN;
        if (r < IT_OUT) { const int kb = r / 16, nb = r % 16; conv_item(a.w_out, D, a.Wout_t, kb * 64, nb * 64, (size_t)nb * 64, scr, lane); continue; } r -= IT_OUT;
        if (r < IT_GU) { const int e = r / 512, q = r % 512, kb = q / 32, nb = q % 32, n0 = nb * 64, bj = n0 >> 10, rem = n0 & 1023, pn = rem >> 7, cc0 = rem & 127;
            conv_item8(a.wgu + (size_t)e * D * 2048, 2048, a.Wgu_t, kb * 64, n0, (size_t)e * 2048 + pn * 256 + bj * 128 + cc0, scr, lane); continue; } r -= IT_GU;
        { const int e = r / 256, q = r % 256, kb = q / 16, nb = q % 16; conv_item8(a.wd + (size_t)e * DFF * D, D, a.Wd_t, kb * 64, nb * 64, (size_t)e * 1024 + nb * 64, scr, lane); }
    }
}


__device__ __forceinline__ void phase_norm1(const float* __restrict__ x, const float* __restrict__ ctx, const float* __restrict__ nw, const float* __restrict__ mod, bf16_t* __restrict__ H, int bid, int G) {
    constexpr int RB = 4;
    const int lane = threadIdx.x & 63, gw = bid * 8 + (threadIdx.x >> 6), NW = G * 8;
    for (int r0 = gw; r0 < NROWS; r0 += RB * NW) {
        f32x4 v[RB][4];
#pragma unroll
        for (int q = 0; q < RB; ++q) { const int r = r0 + q * NW; const int rr = r < NROWS ? r : r0;
            const float* src = rr < NLAT ? x + (size_t)rr * D : ctx + (size_t)(rr - NLAT) * D;
#pragma unroll
            for (int j = 0; j < 4; ++j) v[q][j] = __builtin_nontemporal_load((const f32x4*)(src + j * 256 + lane * 4)); }
#pragma unroll
        for (int q = 0; q < RB; ++q) { const int r = r0 + q * NW; if (r < NROWS) {
            const float* m = mod + (size_t)(r < NLAT ? (r >> 11) : NB) * 6144;
            float ss = 0.f;
#pragma unroll
            for (int j = 0; j < 4; ++j) ss += v[q][j][0] * v[q][j][0] + v[q][j][1] * v[q][j][1] + v[q][j][2] * v[q][j][2] + v[q][j][3] * v[q][j][3];
            const float rstd = __builtin_amdgcn_rsqf(wave_sum(ss) * (1.0f / D) + EPS);
#pragma unroll
            for (int j = 0; j < 4; ++j) {
                const int c0 = j * 256 + lane * 4;
                const f32x4 w = *(const f32x4*)(nw + c0), sh = *(const f32x4*)(m + c0), sc = *(const f32x4*)(m + 1024 + c0);
                const f32x4 o = v[q][j] * rstd * w * (sc + 1.0f) + sh;
                uint2 p; p.x = cvt_pk_bf16(o[0], o[1]); p.y = cvt_pk_bf16(o[2], o[3]);
                *(uint2*)(H + (size_t)r * D + c0) = p;
            } } }
    }
}

__device__ __forceinline__ bf16x8 pack8(const f32x4& a, const f32x4& b) {
    u32x4 w; w.x = cvt_pk_bf16(a[0], a[1]); w.y = cvt_pk_bf16(a[2], a[3]); w.z = cvt_pk_bf16(b[0], b[1]); w.w = cvt_pk_bf16(b[2], b[3]);
    return __builtin_bit_cast(bf16x8, w);
}
constexpr int HW_BUF = 45056;
constexpr int HW_QD = 0, HW_KET = 17408, HW_PM = 35840;
constexpr int HW_VT = 2 * HW_BUF, HW_KD = HW_VT + 18432, HW_OS = HW_KD + 17408, HW_TOT = HW_OS + 17408, HW_DEC = HW_TOT + 1024;
__device__ __forceinline__ void phase_hgrn2_ws(LAS unsigned char* lds, const bf16_t* __restrict__ P, const float* __restrict__ lb, bf16_t* __restrict__ OF, bf16_t* __restrict__ OB, int item) {
    const int b = item >> 3, h = (item >> 1) & 3, dir = item & 1;
    const int tid = threadIdx.x, w = __builtin_amdgcn_readfirstlane(tid >> 6), lane = tid & 63, l15 = lane & 15, G4 = lane >> 4;
    bf16_t* OD = dir ? OB : OF;
    const int cf = dir ? C_FB : C_FF;
    constexpr int NC = (CTXL + T) / 64;
    LAS float* TOT = (LAS float*)(lds + HW_TOT);
#define HW_BAR() do { asm volatile("s_waitcnt lgkmcnt(0)" ::: "memory"); __builtin_amdgcn_s_barrier(); asm volatile("" ::: "memory"); } while (0)
    __syncthreads();
    if (w >= 4) {
        const int et = tid - 256, k = et & 127, seg = et >> 7, ew = w - 4;
        const int kslot = (k & ~31) | (((k >> 2) & 3) << 3) | (((k >> 4) & 1) << 2) | (k & 3);
        const float lbv = lb[dir * HGW + h * 128 + k];
        const char* Pc = (const char*)P; const int sstep = dir ? -(INW * 2) : INW * 2;
#define HW_OFF0(m_) ({ const int p_ = 64 * (m_) + 32 * seg; const unsigned r_ = p_ < CTXL ? (unsigned)(NLAT + b * CTXL + (dir ? CTXL - 1 - p_ : p_)) : (unsigned)(b * T + (dir ? T - 1 - (p_ - CTXL) : (p_ - CTXL))); (r_ * (unsigned)INW + (unsigned)(h * 128 + k)) * 2u; })
#define HW_LD(off0_, i_, col_) (*(const bf16_t*)(Pc + (unsigned)((int)(off0_) + (i_) * sstep + (col_) * 2)))
        typedef unsigned short us2 __attribute__((ext_vector_type(2)));
        us2 rf[16];
        { const unsigned o0 = HW_OFF0(0);
#pragma unroll
        for (int i = 0; i < 32; ++i) rf[i >> 1][i & 1] = HW_LD(o0, i, cf); }
#pragma unroll 1
        for (int m = 0; m < NC + 1; ++m) {
            const int par = m & 1;
            LAS unsigned char* buf = lds + par * HW_BUF;
            HW_BAR();
            us2 rq[16], rv[16]; float fv[32], cs[32]; float run = 0.f;
            if (m < NC) {
#pragma unroll
                for (int i = 0; i < 32; ++i) { const unsigned o0 = HW_OFF0(m); rq[i >> 1][i & 1] = HW_LD(o0, i, C_Q); rv[i >> 1][i & 1] = HW_LD(o0, i, C_I); }
#pragma unroll
                for (int i = 0; i < 32; ++i) { const float f = lbv + (1.f - lbv) * sigmoidf_(bf2f(rf[i >> 1][i & 1])); fv[i] = f; run += flog(f); cs[i] = run; }
                TOT[seg * 128 + k] = run;
                if (m + 1 < NC) {
#pragma unroll
                    for (int i = 0; i < 32; ++i) { const unsigned o0 = HW_OFF0(m + 1); rf[i >> 1][i & 1] = HW_LD(o0, i, cf); }
                }
            }
            HW_BAR();
            if (m < NC) {
                const float t0 = TOT[k], t1 = TOT[128 + k];
                const float prefix = seg == 0 ? 0.f : t0, blast = t0 + t1, eb = fexp(blast);
                if (seg == 0) ((LAS float*)(lds + HW_DEC + par * 512))[k] = eb;
#pragma unroll
                for (int q4 = 0; q4 < 4; ++q4) {
                    float ke[8];
#pragma unroll
                    for (int ii = 0; ii < 8; ++ii) {
                        const int i = 8 * q4 + ii;
                        const float bc = prefix + cs[i], e = fexp(bc), kf = (1.f - fv[i]) * frcp(e), q = bf2f(rq[i >> 1][i & 1]);
                        const int j = 32 * seg + i;
                        *(LAS bf16_t*)(buf + HW_QD + j * 272 + kslot * 2) = f2bf(q * sigmoidf_(q) * e);
                        *(LAS bf16_t*)(lds + HW_KD + j * 272 + kslot * 2) = f2bf(kf);
                        ke[ii] = kf * eb;
                    }
                    u32x4 wk, wv;
#pragma unroll
                    for (int i = 0; i < 4; ++i) { wk[i] = cvt_pk_bf16(ke[2 * i], ke[2 * i + 1]); wv[i] = __builtin_bit_cast(u32, rv[4 * q4 + i]); }
                    *(LAS u32x4*)(buf + HW_KET + k * 144 + seg * 64 + q4 * 16) = wk;
                    *(LAS u32x4*)(lds + HW_VT + k * 144 + seg * 64 + q4 * 16) = wv;
                }
            }
            HW_BAR();
            if (m < NC && m >= CTXL / 64) {
                const int mt = ew;
                f32x4 pa[4];
#pragma unroll
                for (int q = 0; q < 4; ++q) pa[q] = (f32x4){0.f, 0.f, 0.f, 0.f};
#pragma unroll
                for (int s = 0; s < 4; ++s) {
                    const bf16x8 a = *(const LAS bf16x8*)(buf + HW_QD + (16 * mt + l15) * 272 + (32 * s + 8 * G4) * 2);
#pragma unroll
                    for (int q = 0; q < 4; ++q) { const bf16x8 bq = *(const LAS bf16x8*)(lds + HW_KD + (16 * q + l15) * 272 + (32 * s + 8 * G4) * 2); pa[q] = __builtin_amdgcn_mfma_f32_16x16x32_bf16(a, bq, pa[q], 0, 0, 0); }
                }
#pragma unroll
                for (int q = 0; q < 4; ++q)
#pragma unroll
                    for (int r = 0; r < 4; ++r) { const int c = 16 * mt + 4 * G4 + r, j = 16 * q + l15; *(LAS bf16_t*)(buf + HW_PM + c * 144 + j * 2) = f2bf(j <= c ? pa[q][r] : 0.f); }
                asm volatile("s_waitcnt lgkmcnt(0)" ::: "memory");
            }
        }
#undef HW_OFF0
#undef HW_LD
    } else {
        f32x4 S[8][2];
#pragma unroll
        for (int t = 0; t < 8; ++t) { S[t][0] = (f32x4){0.f, 0.f, 0.f, 0.f}; S[t][1] = (f32x4){0.f, 0.f, 0.f, 0.f}; }
        HW_BAR(); HW_BAR(); HW_BAR();
#pragma unroll 1
        for (int n = 0; n < NC; ++n) {
            const int par = n & 1; const bool lat = n >= CTXL / 64;
            LAS unsigned char* buf = lds + par * HW_BUF;
            HW_BAR();
            bf16x8 vb[2][2];
#pragma unroll
            for (int nt = 0; nt < 2; ++nt)
#pragma unroll
                for (int s = 0; s < 2; ++s) vb[nt][s] = *(const LAS bf16x8*)(lds + HW_VT + (32 * w + 16 * nt + l15) * 144 + (32 * s + 8 * G4) * 2);
            HW_BAR();
            if (lat) {
                bf16x8 sb[2][4];
#pragma unroll
                for (int nt = 0; nt < 2; ++nt)
#pragma unroll
                    for (int s = 0; s < 4; ++s) sb[nt][s] = pack8(S[2 * s][nt], S[2 * s + 1][nt]);
#pragma unroll
                for (int mt = 0; mt < 4; ++mt) {
                    f32x4 oa[2] = {(f32x4){0.f, 0.f, 0.f, 0.f}, (f32x4){0.f, 0.f, 0.f, 0.f}};
#pragma unroll
                    for (int s = 0; s < 2; ++s) { const bf16x8 a = *(const LAS bf16x8*)(buf + HW_PM + (16 * mt + l15) * 144 + (32 * s + 8 * G4) * 2);
                        oa[0] = __builtin_amdgcn_mfma_f32_16x16x32_bf16(a, vb[0][s], oa[0], 0, 0, 0); oa[1] = __builtin_amdgcn_mfma_f32_16x16x32_bf16(a, vb[1][s], oa[1], 0, 0, 0); }
#pragma unroll
                    for (int s = 0; s < 4; ++s) { const bf16x8 a = *(const LAS bf16x8*)(buf + HW_QD + (16 * mt + l15) * 272 + (32 * s + 8 * G4) * 2);
                        oa[0] = __builtin_amdgcn_mfma_f32_16x16x32_bf16(a, sb[0][s], oa[0], 0, 0, 0); oa[1] = __builtin_amdgcn_mfma_f32_16x16x32_bf16(a, sb[1][s], oa[1], 0, 0, 0); }
#pragma unroll
                    for (int nt = 0; nt < 2; ++nt)
#pragma unroll
                        for (int r = 0; r < 4; ++r) *(LAS bf16_t*)(lds + HW_OS + (16 * mt + 4 * G4 + r) * 272 + (32 * w + 16 * nt + l15) * 2) = f2bf(oa[nt][r]);
                }
            }
#pragma unroll
            for (int t = 0; t < 8; ++t) {
                const f32x4 d4 = *(const LAS f32x4*)(lds + HW_DEC + par * 512 + (16 * t + 4 * G4) * 4);
                S[t][0] = S[t][0] * d4; S[t][1] = S[t][1] * d4;
#pragma unroll
                for (int s = 0; s < 2; ++s) { const bf16x8 a = *(const LAS bf16x8*)(buf + HW_KET + (16 * t + l15) * 144 + (32 * s + 8 * G4) * 2);
                    S[t][0] = __builtin_amdgcn_mfma_f32_16x16x32_bf16(a, vb[0][s], S[t][0], 0, 0, 0); S[t][1] = __builtin_amdgcn_mfma_f32_16x16x32_bf16(a, vb[1][s], S[t][1], 0, 0, 0); }
            }
            HW_BAR();
            if (lat) {
                const int j = tid >> 2, part = tid & 3, p = 64 * n + j, tt = dir ? T - 1 - (p - CTXL) : (p - CTXL);
                bf16_t* dst = OD + ((size_t)b * T + tt) * HGW + h * 128 + part * 32;
#pragma unroll
                for (int q = 0; q < 4; ++q) *(u32x4*)(dst + q * 8) = *(const LAS u32x4*)(lds + HW_OS + j * 272 + part * 64 + q * 16);
            }
        }
    }
    __syncthreads();
#undef HW_BAR
}

__device__ __forceinline__ size_t rg_row(int b, bool lat, int p) {
    return lat ? (size_t)b * T + (size_t)(p % GROWS) * GRIDW + (p / GROWS) : (size_t)NLAT + b * CTXL + p;
}
constexpr int RC_T = 64 * 144;
constexpr int RC_XC = 0, RC_RG = 2 * RC_T, RC_HI = 4 * RC_T, RC_OUT = 6 * RC_T;
__device__ __forceinline__ void phase_rg_chain(LAS unsigned char* lds, const bf16_t* __restrict__ P, const float* __restrict__ conv_w, const float* __restrict__ conv_b, const bf16_t* __restrict__ WG_t,
                                               const float* __restrict__ ba, const float* __restrict__ bx, const float* __restrict__ coef, bf16_t* __restrict__ HT, bf16_t* __restrict__ MIX, int item) {
    const int b = item >> 3, hd = item & 7;
    const int tid = threadIdx.x, w = __builtin_amdgcn_readfirstlane(tid >> 6), lane = tid & 63, l15 = lane & 15, G4 = lane >> 4;
    const int d = w >> 2, cg = w & 3, ch = 64 * hd + 16 * cg + l15;
    const int ds = tid >> 8, t8 = tid & 255, pg = t8 >> 4, cg4 = t8 & 15;
    bf16x8 F[4];
#pragma unroll
    for (int s = 0; s < 2; ++s) {
        F[s] = *(const bf16x8*)(WG_t + ((size_t)(hd * 256 + 64 * (2 * d) + 16 * cg + l15) * 64 + 32 * s + 8 * G4));
        F[2 + s] = *(const bf16x8*)(WG_t + ((size_t)(hd * 256 + 64 * (2 * d + 1) + 16 * cg + l15) * 64 + 32 * s + 8 * G4)); }
    const float bav = ba[d * RGW + ch], bxv = bx[d * RGW + ch], cf = coef[d * RGW + ch];
    const f32x4 cw0 = *(const f32x4*)(conv_w + 0 * RGW + 64 * hd + 4 * cg4), cw1 = *(const f32x4*)(conv_w + 1 * RGW + 64 * hd + 4 * cg4), cw2 = *(const f32x4*)(conv_w + 2 * RGW + 64 * hd + 4 * cg4),
                cw3 = *(const f32x4*)(conv_w + 3 * RGW + 64 * hd + 4 * cg4), cb4 = *(const f32x4*)(conv_b + 64 * hd + 4 * cg4);
    float hcar = 0.f;
#define RC_CHUNK(dd, s_) ((dd) == 0 ? (s_) : ((s_) < CTXL / 64 ? CTXL / 64 - 1 - (s_) : NCHK + CTXL / 64 - 1 - (s_)))
    u32x2 rxr[7]; u32x4 rgr[2], hir[2];
#define RC_LOAD_RX(s_) do { const int n_ = RC_CHUNK(ds, s_); const bool lat_ = n_ >= CTXL / 64; const int L_ = lat_ ? T : CTXL, p0_ = 64 * (lat_ ? n_ - CTXL / 64 : n_); \
        _Pragma("unroll") for (int i = 0; i < 7; ++i) { const int p = p0_ + 4 * pg - 2 + i; rxr[i] = (p >= 0 && p < L_) ? *(const u32x2*)(P + rg_row(b, lat_, p) * INW + C_RX + 64 * hd + 4 * cg4) : (u32x2){0u, 0u}; } } while (0)
#define RC_ROW(s_, q_) (rg_row(b, true, 64 * (RC_CHUNK(ds, s_) - CTXL / 64) + ((q_) >> 3)))
#define RC_LOAD_RG(s_) do { _Pragma("unroll") for (int j = 0; j < 2; ++j) { const int q = t8 * 2 + j; rgr[j] = *(const u32x4*)(P + RC_ROW(s_, q) * INW + C_RG + 64 * hd + (q & 7) * 8); } } while (0)
#define RC_LOAD_HI(s_) do { _Pragma("unroll") for (int j = 0; j < 2; ++j) { const int q = t8 * 2 + j; rgr[j] = rgr[j]; hir[j] = __builtin_nontemporal_load((const u32x4*)(HT + RC_ROW(s_, q) * RGW + 64 * hd + (q & 7) * 8)); } } while (0)
    RC_LOAD_RX(0);
#pragma unroll 1
    for (int s = 0; s < NCHK; ++s) {
        const int role = s < CTXL / 64 ? 0 : (s < 20 ? 1 : 2);
        if (s == 20) { asm volatile("s_waitcnt vmcnt(0)" ::: "memory"); __syncthreads(); RC_LOAD_RG(20); RC_LOAD_HI(20); }
        {
            float xin[7][4];
#pragma unroll
            for (int i = 0; i < 7; ++i) { xin[i][0] = __uint_as_float(rxr[i].x << 16); xin[i][1] = __uint_as_float(rxr[i].x & 0xffff0000u); xin[i][2] = __uint_as_float(rxr[i].y << 16); xin[i][3] = __uint_as_float(rxr[i].y & 0xffff0000u); }
#pragma unroll
            for (int q = 0; q < 4; ++q) {
                float o[4];
#pragma unroll
                for (int c = 0; c < 4; ++c) o[c] = cb4[c] + cw0[c] * xin[q][c] + cw1[c] * xin[q + 1][c] + cw2[c] * xin[q + 2][c] + cw3[c] * xin[q + 3][c];
                *(LAS unsigned long long*)(lds + RC_XC + ds * RC_T + (4 * pg + q) * 144 + cg4 * 8) = ((unsigned long long)cvt_pk_bf16(o[2], o[3]) << 32) | cvt_pk_bf16(o[0], o[1]);
            }
            if (role == 2) {
#pragma unroll
                for (int j = 0; j < 2; ++j) { const int q = t8 * 2 + j; *(LAS u32x4*)(lds + RC_RG + ds * RC_T + (q >> 3) * 144 + (q & 7) * 16) = rgr[j]; *(LAS u32x4*)(lds + RC_HI + ds * RC_T + (q >> 3) * 144 + (q & 7) * 16) = hir[j]; }
            }
        }
        __syncthreads();
        if (s + 1 < NCHK) { RC_LOAD_RX(s + 1); if (s + 1 > 20) { RC_LOAD_RG(s + 1); RC_LOAD_HI(s + 1); } }
        {
            bf16x8 af[4][2];
#pragma unroll
            for (int mt = 0; mt < 4; ++mt)
#pragma unroll
                for (int k = 0; k < 2; ++k) af[mt][k] = *(const LAS bf16x8*)(lds + RC_XC + d * RC_T + (16 * (l15 >> 2) + 4 * mt + (l15 & 3)) * 144 + (32 * k + 8 * G4) * 2);
            f32x4 ra[4], xa[4];
#pragma unroll
            for (int mt = 0; mt < 4; ++mt) { ra[mt] = (f32x4){0.f, 0.f, 0.f, 0.f}; xa[mt] = (f32x4){0.f, 0.f, 0.f, 0.f};
#pragma unroll
                for (int k = 0; k < 2; ++k) { ra[mt] = __builtin_amdgcn_mfma_f32_16x16x32_bf16(af[mt][k], F[k], ra[mt], 0, 0, 0); xa[mt] = __builtin_amdgcn_mfma_f32_16x16x32_bf16(af[mt][k], F[2 + k], xa[mt], 0, 0, 0); } }
            float av[16], bv[16];
#pragma unroll
            for (int t = 0; t < 16; ++t) {
                const float r = sigmoidf_(ra[t >> 2][t & 3] + bav), ig = sigmoidf_(xa[t >> 2][t & 3] + bxv);
                const float a = fexp(cf * r);
                av[t] = a; bv[t] = fsqrt(fmaxf(1.0f - a * a, 0.f)) * ig * bf2f(*(const LAS bf16_t*)(lds + RC_XC + d * RC_T + (16 * G4 + t) * 144 + (16 * cg + l15) * 2));
            }
            float Al = 1.f, Bl = 0.f;
            if (d == 0) {
#pragma unroll
                for (int t = 0; t < 16; ++t) { Bl = av[t] * Bl + bv[t]; Al *= av[t]; }
            } else {
#pragma unroll
                for (int t = 15; t >= 0; --t) { Bl = av[t] * Bl + bv[t]; Al *= av[t]; }
            }
            float Ag[4], Bg[4];
#pragma unroll
            for (int g = 0; g < 4; ++g) { Ag[g] = __shfl(Al, l15 + 16 * g); Bg[g] = __shfl(Bl, l15 + 16 * g); }
            float h = hcar, hend;
            if (d == 0) {
                const float s1 = Ag[0] * h + Bg[0], s2 = Ag[1] * s1 + Bg[1], s3 = Ag[2] * s2 + Bg[2]; hend = Ag[3] * s3 + Bg[3];
                h = G4 == 0 ? h : G4 == 1 ? s1 : G4 == 2 ? s2 : s3;
            } else {
                const float s2 = Ag[3] * h + Bg[3], s1 = Ag[2] * s2 + Bg[2], s0 = Ag[1] * s1 + Bg[1]; hend = Ag[0] * s0 + Bg[0];
                h = G4 == 3 ? h : G4 == 2 ? s2 : G4 == 1 ? s1 : s0;
            }
            hcar = hend;
            if (role != 0) {
                float hv[16];
                if (d == 0) {
#pragma unroll
                    for (int t = 0; t < 16; ++t) { h = av[t] * h + bv[t]; hv[t] = h; }
                } else {
#pragma unroll
                    for (int t = 15; t >= 0; --t) { h = av[t] * h + bv[t]; hv[t] = h; }
                }
#pragma unroll
                for (int t = 0; t < 16; ++t) {
                    const int off = (16 * G4 + t) * 144 + (16 * cg + l15) * 2;
                    float o = hv[t];
                    if (role == 2) o = gelu_tanh(bf2f(*(const LAS bf16_t*)(lds + RC_RG + d * RC_T + off))) * (o + bf2f(*(const LAS bf16_t*)(lds + RC_HI + d * RC_T + off)));
                    *(LAS bf16_t*)(lds + RC_OUT + d * RC_T + off) = f2bf(o);
                }
            }
        }
        __syncthreads();
        if (role != 0) {
#pragma unroll
            for (int j = 0; j < 2; ++j) { const int q = t8 * 2 + j; const u32x4 v = *(const LAS u32x4*)(lds + RC_OUT + ds * RC_T + (q >> 3) * 144 + (q & 7) * 16);
                if (role == 1) *(u32x4*)(HT + RC_ROW(s, q) * RGW + 64 * hd + (q & 7) * 8) = v;
                else *(u32x4*)(MIX + RC_ROW(s, q) * D + HGW + 64 * hd + (q & 7) * 8) = v; }
        }
    }
#undef RC_CHUNK
#undef RC_LOAD_RX
#undef RC_ROW
#undef RC_LOAD_RG
#undef RC_LOAD_HI
}

__device__ __forceinline__ void phase_mix_finish(const bf16_t* __restrict__ P, const bf16_t* __restrict__ OF, const bf16_t* __restrict__ OB,
                                                 const float* __restrict__ hg_nw, bf16_t* __restrict__ MIX, int bid, int G) {
    constexpr int RB = 4;
    const int lane = threadIdx.x & 63, gw = bid * 8 + (threadIdx.x >> 6), NW = G * 8, c0 = lane * 8;
    const f32x4 nw0 = *(const f32x4*)(hg_nw + c0), nw1 = *(const f32x4*)(hg_nw + c0 + 4);
    const float nwv[8] = {nw0[0], nw0[1], nw0[2], nw0[3], nw1[0], nw1[1], nw1[2], nw1[3]};
    for (int r0 = gw; r0 < NLAT; r0 += RB * NW) {
        u32x4 a4[RB], b4[RB], g4[RB];
#pragma unroll
        for (int q = 0; q < RB; ++q) { const int r = r0 + q * NW; const int rr = r < NLAT ? r : r0;
            a4[q] = *(const u32x4*)(OF + (size_t)rr * HGW + c0); b4[q] = *(const u32x4*)(OB + (size_t)rr * HGW + c0); g4[q] = *(const u32x4*)(P + (size_t)rr * INW + C_G + c0); }
#pragma unroll
        for (int q = 0; q < RB; ++q) { const int r = r0 + q * NW; if (r < NLAT) {
            float o[8]; float ss = 0.f;
#pragma unroll
            for (int i = 0; i < 4; ++i) { o[2 * i] = __uint_as_float(a4[q][i] << 16) + __uint_as_float(b4[q][i] << 16); o[2 * i + 1] = __uint_as_float(a4[q][i] & 0xffff0000u) + __uint_as_float(b4[q][i] & 0xffff0000u); }
#pragma unroll
            for (int i = 0; i < 8; ++i) ss += o[i] * o[i];
            ss += __shfl_xor(ss, 1); ss += __shfl_xor(ss, 2); ss += __shfl_xor(ss, 4); ss += __shfl_xor(ss, 8);
            const float rstd = __builtin_amdgcn_rsqf(ss * (1.0f / 128.0f) + EPS);
            u32x4 w;
#pragma unroll
            for (int i = 0; i < 4; ++i) {
                const float g0 = __uint_as_float(g4[q][i] << 16), g1 = __uint_as_float(g4[q][i] & 0xffff0000u);
                w[i] = cvt_pk_bf16(o[2 * i] * rstd * nwv[2 * i] * (g0 * sigmoidf_(g0)), o[2 * i + 1] * rstd * nwv[2 * i + 1] * (g1 * sigmoidf_(g1)));
            }
            *(u32x4*)(MIX + (size_t)r * D + c0) = w;
        } }
    }
}

__device__ __forceinline__ void phase_norm2_route(LAS unsigned char* lds, const bf16_t* __restrict__ x1, const float* __restrict__ nw, const float* __restrict__ mod,
                                                  const float* __restrict__ rw, const float* __restrict__ rb, fp8_t* __restrict__ H2,
                                                  u32* __restrict__ cnt, u32* __restrict__ toktab, float* __restrict__ wtab, int bid, int G) {
    LAS float* rwT = (LAS float*)lds;
    LAS u32* hist = (LAS u32*)(lds + 131072);
    LAS u32* ent = (LAS u32*)(lds + 131072 + 4096);
    const int tid = threadIdx.x, lane = tid & 63, w = tid >> 6;
    for (int i = tid; i < 32 * 1024; i += 512) { const int k = i >> 5, e = i & 31; rwT[e * 1024 + k] = rw[i]; }
    if (tid < 128) hist[tid] = 0;
    __syncthreads();
    const int gw = bid * 8 + w, NW = G * 8;
    const int myexp = ((lane >> 5) & 1) * 16 + ((lane >> 4) & 1) * 8 + ((lane >> 3) & 1) * 4 + ((lane >> 2) & 1) * 2 + ((lane >> 1) & 1);
    const float myrb = rb[myexp];
    int it = 0;
    u32x2 rawn[2][4];
#pragma unroll
    for (int q = 0; q < 2; ++q)
#pragma unroll
        for (int j = 0; j < 4; ++j) rawn[q][j] = __builtin_nontemporal_load((const u32x2*)(x1 + (size_t)(gw + q * NW) * D + j * 256 + lane * 4));
    for (int r0 = gw; r0 < NLAT; r0 += 2 * NW, it += 2) {
        f32x4 v[2][4];
        u32x2 rawc[2][4];
#pragma unroll
        for (int q = 0; q < 2; ++q)
#pragma unroll
            for (int j = 0; j < 4; ++j) rawc[q][j] = rawn[q][j];
        { const int rn0 = r0 + 2 * NW < NLAT ? r0 + 2 * NW : r0;
#pragma unroll
          for (int q = 0; q < 2; ++q)
#pragma unroll
            for (int j = 0; j < 4; ++j) rawn[q][j] = __builtin_nontemporal_load((const u32x2*)(x1 + (size_t)(rn0 + q * NW) * D + j * 256 + lane * 4)); }
#pragma unroll
        for (int q = 0; q < 2; ++q) {
            const int r = r0 + q * NW;
            const float* m = mod + (size_t)(r >> 11) * 6144;
            u32x2 raw[4];
#pragma unroll
            for (int j = 0; j < 4; ++j) raw[j] = rawc[q][j];
            float ss = 0.f;
#pragma unroll
            for (int j = 0; j < 4; ++j) { v[q][j][0] = __uint_as_float(raw[j].x << 16); v[q][j][1] = __uint_as_float(raw[j].x & 0xffff0000u); v[q][j][2] = __uint_as_float(raw[j].y << 16); v[q][j][3] = __uint_as_float(raw[j].y & 0xffff0000u);
                ss += v[q][j][0] * v[q][j][0] + v[q][j][1] * v[q][j][1] + v[q][j][2] * v[q][j][2] + v[q][j][3] * v[q][j][3]; }
            const float rstd = __builtin_amdgcn_rsqf(wave_sum(ss) * (1.0f / D) + EPS);
#pragma unroll
            for (int j = 0; j < 4; ++j) {
                const int c0 = j * 256 + lane * 4;
                const f32x4 ww = *(const f32x4*)(nw + c0), sh = *(const f32x4*)(m + 3072 + c0), sc = *(const f32x4*)(m + 4096 + c0);
                v[q][j] = v[q][j] * rstd * ww * (sc + 1.0f) + sh;
                *(unsigned*)(H2 + (size_t)r * D + c0) = pk4_fp8(v[q][j][0] * SC_H2, v[q][j][1] * SC_H2, v[q][j][2] * SC_H2, v[q][j][3] * SC_H2);
            }
        }
        float part[2][32];
#pragma unroll
        for (int e = 0; e < 32; ++e) {
            float p0 = 0.f, p1 = 0.f;
#pragma unroll
            for (int j = 0; j < 4; ++j) { const f32x4 q = *(const LAS f32x4*)(rwT + e * 1024 + j * 256 + lane * 4);
                p0 += v[0][j][0] * q[0] + v[0][j][1] * q[1] + v[0][j][2] * q[2] + v[0][j][3] * q[3]; p1 += v[1][j][0] * q[0] + v[1][j][1] * q[1] + v[1][j][2] * q[2] + v[1][j][3] * q[3]; }
            part[0][e] = p0; part[1][e] = p1;
        }
#define RT_STEP(N, M) { const bool up = (lane & (M)) != 0; _Pragma("unroll") for (int q = 0; q < 2; ++q) _Pragma("unroll") for (int i = 0; i < (N); ++i) { const float keep = up ? part[q][(N) + i] : part[q][i], send = up ? part[q][i] : part[q][(N) + i]; part[q][i] = keep + __shfl_xor(send, (M)); } }
        RT_STEP(16, 32) RT_STEP(8, 16) RT_STEP(4, 8) RT_STEP(2, 4) RT_STEP(1, 2)
#undef RT_STEP
#pragma unroll
        for (int q = 0; q < 2; ++q) {
            const int r = r0 + q * NW;
            const float mylogit = part[q][0] + __shfl_xor(part[q][0], 1) + myrb;
            int rank = 0;
#pragma unroll
            for (int x = 0; x < 32; ++x) {
                const int src = ((x >> 4) & 1) * 32 + ((x >> 3) & 1) * 16 + ((x >> 2) & 1) * 8 + ((x >> 1) & 1) * 4 + (x & 1) * 2;
                const float oq = __builtin_bit_cast(float, __builtin_amdgcn_readlane(__builtin_bit_cast(int, mylogit), src));
                rank += (oq > mylogit || (oq == mylogit && x < myexp)) ? 1 : 0;
            }
            float tv[4]; int ti[4];
#pragma unroll
            for (int k = 0; k < 4; ++k) {
                const unsigned long long mk = __ballot(rank == k && (lane & 1) == 0);
                const int src = __builtin_amdgcn_readfirstlane((int)__builtin_ctzll(mk));
                tv[k] = __builtin_bit_cast(float, __builtin_amdgcn_readlane(__builtin_bit_cast(int, mylogit), src));
                ti[k] = ((src >> 5) & 1) * 16 + ((src >> 4) & 1) * 8 + ((src >> 3) & 1) * 4 + ((src >> 2) & 1) * 2 + ((src >> 1) & 1);
            }
            const float e1 = fexp(tv[1] - tv[0]), e2 = fexp(tv[2] - tv[0]), e3 = fexp(tv[3] - tv[0]); const float inv = frcp(1.0f + e1 + e2 + e3);
            const float g0 = inv, g1 = e1 * inv, g2 = e2 * inv, g3 = e3 * inv;
            if (lane < 4) {
                const int half = r >= HALF_TOK ? 1 : 0;
                const int e = lane == 0 ? ti[0] : lane == 1 ? ti[1] : lane == 2 ? ti[2] : ti[3];
                const float gv = lane == 0 ? g0 : lane == 1 ? g1 : lane == 2 ? g2 : g3;
                const u32 lp = atomicAdd((u32*)&hist[half * 32 + e], 1u);
                const int idx = ((it + q) * 8 + w) * 4 + lane;
                ent[idx * 2] = ((u32)e << 24) | lp; ent[idx * 2 + 1] = __float_as_uint(gv);
            }
        }
    }
    __syncthreads();
    if (tid < 64) hist[64 + tid] = atomicAdd(&cnt[tid], hist[tid]);
    __syncthreads();
    it = 0;
    for (int r = gw; r < NLAT; r += NW, ++it) {
        if (lane < 4) {
            const int half = r >= HALF_TOK ? 1 : 0; const int idx = (it * 8 + w) * 4 + lane;
            const u32 ev = ent[idx * 2]; const int e = ev >> 24; const u32 pos = hist[64 + half * 32 + e] + (ev & 0xffffffu);
            toktab[((size_t)half * 32 + e) * CAP + pos] = (u32)r * 4u + lane;
            wtab[((size_t)half * 32 + e) * CAP + pos] = __uint_as_float(ent[idx * 2 + 1]);
        }
    }
}

__device__ __forceinline__ void phase_combine(float* __restrict__ out, const bf16_t* __restrict__ X1, const fp8_t* __restrict__ Y, const float* __restrict__ mod, const float* __restrict__ fw, int bid, int G) {
    constexpr int RB = 2;
    typedef float f32x2_ __attribute__((ext_vector_type(2)));
    const int lane = threadIdx.x & 63, gw = bid * 8 + (threadIdx.x >> 6), NW = G * 8;
    for (int r0 = gw; r0 < NLAT; r0 += RB * NW) {
        u32x2 xv[RB][4]; unsigned yv[RB][4][4];
#pragma unroll
        for (int q = 0; q < RB; ++q) { const int r = r0 + q * NW < NLAT ? r0 + q * NW : r0;
#pragma unroll
            for (int j = 0; j < 4; ++j) { xv[q][j] = __builtin_nontemporal_load((const u32x2*)(X1 + (size_t)r * D + j * 256 + lane * 4));
#pragma unroll
                for (int k = 0; k < 4; ++k) yv[q][j][k] = __builtin_nontemporal_load((const unsigned*)(Y + ((size_t)r * 4 + k) * D + j * 256 + lane * 4)); } }
#pragma unroll
        for (int q = 0; q < RB; ++q) { const int r = r0 + q * NW; if (r < NLAT) {
            const float* g2 = mod + (size_t)(r >> 11) * 6144 + 5120;
            f32x4 v[4]; float ss = 0.f;
#pragma unroll
            for (int j = 0; j < 4; ++j) { const int c0 = j * 256 + lane * 4;
                f32x4 sm = (f32x4){0.f, 0.f, 0.f, 0.f};
#pragma unroll
                for (int k = 0; k < 4; ++k) { const f32x2_ lo = __builtin_amdgcn_cvt_pk_f32_fp8(yv[q][j][k], false), hi = __builtin_amdgcn_cvt_pk_f32_fp8(yv[q][j][k], true); sm[0] += lo[0]; sm[1] += lo[1]; sm[2] += hi[0]; sm[3] += hi[1]; }
                const f32x4 g = *(const f32x4*)(g2 + c0);
                v[j][0] = __uint_as_float(xv[q][j].x << 16); v[j][1] = __uint_as_float(xv[q][j].x & 0xffff0000u); v[j][2] = __uint_as_float(xv[q][j].y << 16); v[j][3] = __uint_as_float(xv[q][j].y & 0xffff0000u);
                v[j] = v[j] + g * sm * (1.0f / SC_Y);
                ss += v[j][0] * v[j][0] + v[j][1] * v[j][1] + v[j][2] * v[j][2] + v[j][3] * v[j][3]; }
            const float rstd = __builtin_amdgcn_rsqf(wave_sum(ss) * (1.0f / D) + EPS);
#pragma unroll
            for (int j = 0; j < 4; ++j) { const int c0 = j * 256 + lane * 4; const f32x4 w = *(const f32x4*)(fw + c0); __builtin_nontemporal_store(v[j] * rstd * w, (f32x4*)(out + (size_t)r * D + c0)); }
        } }
    }
}

#define XB_TMO      128
#define XB_XCNT(j)  (256  + 64 * (j))
#define XB_XSUB(j)  (1280 + 64 * (j))
#define XB_XGEN(j)  (2304 + 64 * (j))
#define XB_TOP      3328
#define XB_TOPGEN   3392
#define XCD_BAR_WORDS 3456
#define XB_SPIN_CAP (1u << 20)
__device__ __forceinline__ unsigned xb_ld(unsigned* p)              { return __hip_atomic_load(p, __ATOMIC_RELAXED, __HIP_MEMORY_SCOPE_AGENT); }
__device__ __forceinline__ unsigned xb_add(unsigned* p, unsigned v) { return __hip_atomic_fetch_add(p, v, __ATOMIC_RELAXED, __HIP_MEMORY_SCOPE_AGENT); }
__device__ __forceinline__ unsigned xb_xcc_id() { return (unsigned)__builtin_amdgcn_s_getreg((3 << 11) | 20) & 0xFu; }
#define XB_SPIN(cond, bar) do { unsigned _sp = 0; while (cond) { __builtin_amdgcn_s_sleep(1); \
    if ((++_sp & 255u) == 0u) { if (xb_ld(&(bar)[XB_TMO])) break; if (_sp > XB_SPIN_CAP) { atomicAdd(&(bar)[XB_TMO], 1u); break; } } } } while (0)
struct XcdBarrier { unsigned* bar; unsigned x; volatile LAS unsigned* st; };
__device__ __forceinline__ XcdBarrier xcd_barrier_post(unsigned* bar, volatile LAS unsigned* st) {
    XcdBarrier b; b.bar = bar; b.x = xb_xcc_id(); b.st = st;
    if (threadIdx.x == 0) (void)xb_add(&bar[XB_XCNT(b.x)], 1u);
    return b;
}
__device__ __forceinline__ void xcd_barrier_complete(unsigned* bar, unsigned x, unsigned& nloc, unsigned& nx) {
    const unsigned G = gridDim.x * gridDim.y * gridDim.z;
    unsigned sum, cnt, mine, sp = 0u;
    for (;;) {
        sum = 0u; cnt = 0u; mine = 0u;
#pragma unroll
        for (unsigned j = 0; j < 16; ++j) { const unsigned c = xb_ld(&bar[XB_XCNT(j)]); sum += c; cnt += (c > 0u) ? 1u : 0u; mine = (j == x) ? c : mine; }
        if (sum == G) break;
        __builtin_amdgcn_s_sleep(1);
        if ((++sp & 255u) == 0u) { if (xb_ld(&bar[XB_TMO])) break; if (sp > XB_SPIN_CAP) { atomicAdd(&bar[XB_TMO], 1u); break; } }
    }
    nloc = mine > 0u ? mine : 1u; nx = cnt > 0u ? cnt : 1u;
}
__device__ __forceinline__ void xcd_barrier(unsigned* bar, volatile LAS unsigned* st) {
    asm volatile("s_waitcnt vmcnt(0)" ::: "memory");
    __syncthreads();
    if (threadIdx.x == 0) {
        __builtin_amdgcn_s_waitcnt(0);
        const unsigned x = xb_xcc_id();
        unsigned nloc = st[0], nx = st[1];
        if (nloc == 0u) { xcd_barrier_complete(bar, x, nloc, nx); st[0] = nloc; st[1] = nx; }
        const unsigned old = xb_add(&bar[XB_XSUB(x)], 1u);
        const unsigned gen = old / nloc;
        if (old + 1u == (gen + 1u) * nloc) {
            __builtin_amdgcn_fence(__ATOMIC_RELEASE, "agent");
            asm volatile("s_waitcnt vmcnt(0)" ::: "memory");
            const unsigned og = xb_add(&bar[XB_TOP], 1u);
            const unsigned tg = og / nx;
            if (og + 1u == (tg + 1u) * nx) xb_add(&bar[XB_TOPGEN], 1u);
            else XB_SPIN(xb_ld(&bar[XB_TOPGEN]) == tg, bar);
            __builtin_amdgcn_fence(__ATOMIC_ACQUIRE, "agent");
            xb_add(&bar[XB_XGEN(x)], 1u);
            asm volatile("s_waitcnt vmcnt(0)" ::: "memory");
        } else {
            XB_SPIN(xb_ld(&bar[XB_XGEN(x)]) == gen, bar);
            __builtin_amdgcn_fence(__ATOMIC_ACQUIRE, "agent");
            asm volatile("s_waitcnt vmcnt(0)" ::: "memory");
        }
    }
    __syncthreads();
}
constexpr size_t WS_BAR = 16384;
constexpr int LDS_BARST = LDS_BYTES - 16;

struct MegaArgs {
    const float *x, *c, *ctx, *c_ctx, *norm1_w, *norm2_w, *w_ada, *b_ada, *w_in, *lbl, *hg_nw, *conv_w, *conv_b, *rg_wa, *rg_ba, *rg_wx, *rg_bx, *rg_lam, *w_out,
        *router_w, *router_b, *wgu, *bgu, *wd, *bd, *final_w;
    float* out; unsigned char* ws;
};
typedef const MegaArgs __attribute__((address_space(4)))* KArgs;
__device__ __forceinline__ KArgs kargs() { auto p = __builtin_amdgcn_kernarg_segment_ptr(); asm volatile("" : "+s"(p)); return (KArgs)p; }
#define WSP(T, off) ((T*)(ws + (off)))
#define GRID_SYNC_CG() cg::this_grid().sync()
#define GRID_SYNC() do { KArgs a_ = kargs(); xcd_barrier((unsigned*)(a_->ws + WS_BAR), (volatile LAS unsigned*)(lds + LDS_BARST)); } while (0)
__global__ __launch_bounds__(512, 2) void k_mega(MegaArgs a_unused) {
    extern __shared__ __attribute__((aligned(16))) unsigned char lds_[];
    LAS unsigned char* lds = (LAS unsigned char*)lds_;
    if (threadIdx.x < 4) ((volatile LAS unsigned*)(lds + LDS_BARST))[threadIdx.x] = 0u;
    __syncthreads();
    { KArgs a = kargs(); (void)xcd_barrier_post((unsigned*)(a->ws + WS_BAR), (volatile LAS unsigned*)(lds + LDS_BARST)); }
    { KArgs a = kargs(); unsigned char* ws = a->ws; const int bid = blockIdx.x, G = gridDim.x;
      ProArgs pa; pa.c = a->c; pa.c_ctx = a->c_ctx; pa.w_ada = a->w_ada; pa.b_ada = a->b_ada; pa.lbl = a->lbl; pa.w_in = a->w_in; pa.w_out = a->w_out; pa.wgu = a->wgu; pa.wd = a->wd; pa.rg_wa = a->rg_wa; pa.rg_wx = a->rg_wx; pa.rg_lam = a->rg_lam;
      pa.coef = WSP(float, WS_COEF); pa.WG_t = WSP(bf16_t, WS_WG); pa.mod = WSP(float, WS_MOD); pa.lb = WSP(float, WS_LB); pa.Win_t = WSP(bf16_t, WS_WIN); pa.Wout_t = WSP(bf16_t, WS_WOUT); pa.Wgu_t = WSP(fp8_t, WS_WGU); pa.Wd_t = WSP(fp8_t, WS_WD);
      phase_prologue(lds, pa, bid, G, true, 0, 0); }
    { KArgs a_ = kargs(); if (a_->ws == nullptr) GRID_SYNC_CG(); }
    GRID_SYNC();
    { KArgs a = kargs(); unsigned char* ws = a->ws; phase_norm1(a->x, a->ctx, a->norm1_w, WSP(float, WS_MOD), WSP(bf16_t, WS_H), blockIdx.x, gridDim.x); }
    { KArgs a = kargs(); unsigned char* ws = a->ws;
      ProArgs pa; pa.c = nullptr; pa.c_ctx = nullptr; pa.w_ada = nullptr; pa.b_ada = nullptr; pa.lbl = nullptr; pa.w_in = a->w_in; pa.w_out = a->w_out; pa.wgu = nullptr; pa.wd = nullptr; pa.rg_wa = nullptr; pa.rg_wx = nullptr; pa.rg_lam = nullptr; pa.coef = nullptr; pa.WG_t = nullptr;
      pa.mod = nullptr; pa.lb = nullptr; pa.Win_t = WSP(bf16_t, WS_WIN); pa.Wout_t = WSP(bf16_t, WS_WOUT); pa.Wgu_t = nullptr; pa.Wd_t = nullptr;
      phase_prologue(lds, pa, blockIdx.x, gridDim.x, false, 0, IT_IN + IT_OUT); }
    GRID_SYNC();
    { KArgs a = kargs(); unsigned char* ws = a->ws; PolInProj P; P.A = WSP(bf16_t, WS_H); P.Bt = WSP(bf16_t, WS_WIN); P.O = WSP(bf16_t, WS_PROJ); P.ord.init(NLAT / BM, INW / BM, gridDim.x, blockIdx.x); gemm_phase(lds, P); }
    GRID_SYNC();
    { KArgs a = kargs(); unsigned char* ws = a->ws;
      for (int item = blockIdx.x; item < 256; item += gridDim.x)
          phase_rg_chain(lds, WSP(bf16_t, WS_PROJ), a->conv_w, a->conv_b, WSP(bf16_t, WS_WG), a->rg_ba, a->rg_bx, WSP(float, WS_COEF), WSP(bf16_t, WS_HF), WSP(bf16_t, WS_MIX2), item); }
    __syncthreads();
    { KArgs a = kargs(); unsigned char* ws = a->ws;
      for (int item = blockIdx.x; item < 256; item += gridDim.x) phase_hgrn2_ws(lds, WSP(bf16_t, WS_PROJ), WSP(float, WS_LB), WSP(bf16_t, WS_OF), WSP(bf16_t, WS_OB), item); }
    GRID_SYNC();
    { KArgs a = kargs(); unsigned char* ws = a->ws; phase_mix_finish(WSP(bf16_t, WS_PROJ), WSP(bf16_t, WS_OF), WSP(bf16_t, WS_OB), a->hg_nw, WSP(bf16_t, WS_MIX2), blockIdx.x, gridDim.x); }
    GRID_SYNC();
    { KArgs a = kargs(); unsigned char* ws = a->ws; PolOutProj P; P.A = WSP(bf16_t, WS_MIX2); P.Bt = WSP(bf16_t, WS_WOUT); P.x = a->x; P.mod = WSP(float, WS_MOD); P.O = WSP(bf16_t, WS_X1); P.ord.init(NLAT / BM, D / BM, gridDim.x, blockIdx.x); gemm_phase(lds, P); }
    GRID_SYNC();
    { KArgs a = kargs(); unsigned char* ws = a->ws;
      phase_norm2_route(lds, WSP(bf16_t, WS_X1), a->norm2_w, WSP(float, WS_MOD), a->router_w, a->router_b, WSP(fp8_t, WS_H2), WSP(u32, WS_CTL), WSP(u32, WS_TOKTAB), WSP(float, WS_WTAB), blockIdx.x, gridDim.x); }
    __syncthreads();
    { KArgs a = kargs(); unsigned char* ws = a->ws;
      ProArgs pa; pa.c = nullptr; pa.c_ctx = nullptr; pa.w_ada = nullptr; pa.b_ada = nullptr; pa.lbl = nullptr; pa.w_in = nullptr; pa.w_out = nullptr; pa.wgu = a->wgu; pa.wd = a->wd; pa.rg_wa = nullptr; pa.rg_wx = nullptr; pa.rg_lam = nullptr; pa.coef = nullptr; pa.WG_t = nullptr;
      pa.mod = nullptr; pa.lb = nullptr; pa.Win_t = nullptr; pa.Wout_t = nullptr; pa.Wgu_t = WSP(fp8_t, WS_WGU); pa.Wd_t = WSP(fp8_t, WS_WD);
      phase_prologue(lds, pa, blockIdx.x, gridDim.x, false, IT_IN + IT_OUT, IT_ALL); }
    GRID_SYNC();
#pragma unroll 1
    for (int half = 0; half < NHALF; ++half) {
        { KArgs a = kargs(); unsigned char* ws = a->ws; LAS int* tstart = (LAS int*)(lds + LDS_AUX);
          const int tot = moe_tile_table(tstart, WSP(u32, WS_CTL), half);
          PolGateUp P; P.A = WSP(fp8_t, WS_H2); P.Bt = WSP(fp8_t, WS_WGU); P.bgu = a->bgu; P.toktab = WSP(u32, WS_TOKTAB); P.O = WSP(fp8_t, WS_ACT); P.mt.tstart = tstart; P.mt.cnt = WSP(u32, WS_CTL); P.mt.half = half;
          P.ord.init(tot, DFF / HALFT, gridDim.x, blockIdx.x);
          gemm_phase(lds, P); }
        GRID_SYNC();
        { KArgs a = kargs(); unsigned char* ws = a->ws; LAS int* tstart = (LAS int*)(lds + LDS_AUX);
          const int tot = moe_tile_table(tstart, WSP(u32, WS_CTL), half);
          PolDown P; P.A = WSP(fp8_t, WS_ACT); P.Bt = WSP(fp8_t, WS_WD); P.bd = a->bd; P.toktab = WSP(u32, WS_TOKTAB); P.wtab = WSP(float, WS_WTAB); P.O = WSP(fp8_t, WS_Y); P.mt.tstart = tstart; P.mt.cnt = WSP(u32, WS_CTL); P.mt.half = half;
          P.ord.init(tot, D / BM, gridDim.x, blockIdx.x);
          gemm_phase(lds, P); }
        GRID_SYNC();
        { KArgs a = kargs(); unsigned char* ws = a->ws; phase_combine(a->out, WSP(bf16_t, WS_X1), WSP(fp8_t, WS_Y), WSP(float, WS_MOD), a->final_w, blockIdx.x, gridDim.x); }
        __syncthreads();
    }
}

extern "C" void kernel_launch(void* const* d_in, const int* in_sizes, int n_in, void* d_out, int out_size, void* d_ws, size_t ws_size, hipStream_t stream) {
    static int grid_blocks = 0;
    if (!grid_blocks) {
        int dev = 0, cus = 0, per_cu = 0;
        (void)hipGetDevice(&dev);
        (void)hipDeviceGetAttribute(&cus, hipDeviceAttributeMultiprocessorCount, dev);
        (void)hipFuncSetAttribute((const void*)k_mega, hipFuncAttributeMaxDynamicSharedMemorySize, LDS_BYTES);
        (void)hipOccupancyMaxActiveBlocksPerMultiprocessor(&per_cu, (const void*)k_mega, 512, LDS_BYTES);
        if (per_cu < 1) { fprintf(stderr, "kernel_launch: occupancy query says %d blocks/CU\n", per_cu); per_cu = 1; }
        grid_blocks = cus * 1;
    }
    if (ws_size < 1024 * MiB) { fprintf(stderr, "kernel_launch: workspace too small (%zu)\n", ws_size); return; }
    MegaArgs a{};
    const float** ap = (const float**)&a;
    for (int i = 0; i < 26; ++i) ap[i] = (const float*)d_in[i];
    a.out = (float*)d_out; a.ws = (unsigned char*)d_ws;
    (void)hipMemsetAsync((unsigned char*)d_ws + WS_CTL, 0, 32768, stream);
    void* args[] = {&a};
    hipError_t e = hipLaunchCooperativeKernel((const void*)k_mega, dim3(grid_blocks), dim3(512), args, LDS_BYTES, stream);
    if (e != hipSuccess) fprintf(stderr, "cooperative launch failed: %s (grid %d)\n", hipGetErrorString(e), grid_blocks);
}
```

```cpp
#include <hip/hip_runtime.h>
#include <hip/hip_cooperative_groups.h>
#include <cstdio>
#include <cstdint>

typedef unsigned short bf16_t;
typedef unsigned int u32;
namespace cg = cooperative_groups;

constexpr int D = 1024, NB = 32, T = 2048, CTXL = 256, GRIDW = 64, GROWS = T / GRIDW;
constexpr int NLAT = NB * T;
constexpr int NCTX = NB * CTXL;
constexpr int NROWS = NLAT + NCTX;
constexpr int HGW = 512, RGW = 512, INW = 3584;
constexpr int C_Q = 0, C_I = 512, C_FF = 1024, C_FB = 1536, C_G = 2048, C_RX = 2560, C_RG = 3072;
constexpr int NE = 32, TOPK = 4, DFF = 1024;
constexpr int NCHK = (CTXL + T) / 64;
constexpr int NHALF = 1;
constexpr int HALF_TOK = NLAT / NHALF;
constexpr int CAP = HALF_TOK;
constexpr int MAXSLOT = HALF_TOK * TOPK + NE * 256;
constexpr float EPS = 1e-6f;

constexpr size_t MiB = 1u << 20;
constexpr size_t WS_CTL = 0;
constexpr size_t WS_WG = 64 * 1024;
constexpr size_t WS_MOD = 1 * MiB;
constexpr size_t WS_LB = WS_MOD + 33 * 6144 * 4;
constexpr size_t WS_COEF = WS_LB + 4096;
constexpr size_t WS_TOKTAB = 2 * MiB;
constexpr size_t WS_WTAB = 10 * MiB;
constexpr size_t WS_WIN = 18 * MiB, WS_WOUT = 25 * MiB;
constexpr size_t WS_OF = 28 * MiB, WS_OB = 92 * MiB;
constexpr size_t WS_HF = 156 * MiB;
constexpr size_t WS_H = 284 * MiB;
constexpr size_t WS_MIX2 = WS_H;
constexpr size_t WS_PROJ = 428 * MiB;
constexpr size_t WS_H2 = 28 * MiB;
constexpr size_t WS_WGU = 92 * MiB, WS_WD = 156 * MiB;
constexpr size_t WS_ACT = 188 * MiB;
constexpr size_t WS_Y = 452 * MiB;
constexpr size_t WS_X1 = 708 * MiB;
constexpr float SC_Y = 16.0f;

__device__ __forceinline__ float bf2f(bf16_t b) { return __uint_as_float(((u32)b) << 16); }
__device__ __forceinline__ bf16_t f2bf(float f) { u32 u = __float_as_uint(f); u += 0x7fffu + ((u >> 16) & 1u); return (bf16_t)(u >> 16); }
__device__ __forceinline__ u32 pk2(float lo, float hi) { return (u32)f2bf(lo) | ((u32)f2bf(hi) << 16); }
__device__ __forceinline__ float fexp(float x) { return __builtin_amdgcn_exp2f(x * 1.4426950408889634f); }
__device__ __forceinline__ float frcp(float x) { return __builtin_amdgcn_rcpf(x); }
__device__ __forceinline__ float flog(float x) { return __builtin_amdgcn_logf(x) * 0.6931471805599453f; }
__device__ __forceinline__ float fsqrt(float x) { return __builtin_amdgcn_sqrtf(x); }
__device__ __forceinline__ float sigmoidf_(float x) { return frcp(1.0f + fexp(-x)); }
__device__ __forceinline__ float wave_sum(float v) {
#pragma unroll
    for (int o = 1; o < 64; o <<= 1) v += __shfl_xor(v, o);
    return v;
}

__device__ __forceinline__ float gelu_tanh(float x) { const float u = 1.5957691216057308f * (x + 0.044715f * x * x * x); return x * sigmoidf_(u); }
#define LAS __attribute__((address_space(3)))
typedef short bf16x8 __attribute__((ext_vector_type(8)));
typedef float f32x4 __attribute__((ext_vector_type(4)));
typedef unsigned u32x4 __attribute__((ext_vector_type(4)));
typedef int v8i __attribute__((ext_vector_type(8)));
typedef int v4i_ __attribute__((ext_vector_type(4)));
typedef unsigned u32x2 __attribute__((ext_vector_type(2)));
typedef unsigned char fp8_t;
constexpr float SC_H2 = 16.0f, SC_W = 32.0f, SC_ACT = 4.0f;
__device__ __forceinline__ unsigned pk4_fp8(float a, float b, float c, float d) {
    a = fminf(fmaxf(a, -448.f), 448.f); b = fminf(fmaxf(b, -448.f), 448.f); c = fminf(fmaxf(c, -448.f), 448.f); d = fminf(fmaxf(d, -448.f), 448.f);
    int r = 0; r = __builtin_amdgcn_cvt_pk_fp8_f32(a, b, r, false); r = __builtin_amdgcn_cvt_pk_fp8_f32(c, d, r, true); return (unsigned)r; }
__device__ __forceinline__ unsigned pk4_fp8_nc(float a, float b, float c, float d) { int r = 0; r = __builtin_amdgcn_cvt_pk_fp8_f32(a, b, r, false); r = __builtin_amdgcn_cvt_pk_fp8_f32(c, d, r, true); return (unsigned)r; }
constexpr int BM = 256, BK = 64, HALFT = 128, HTB = HALFT * BK * 2, STAGE_BYTES = 8 * HTB, NXCD = 8, WGM = 8;
constexpr int GK = 1024;
constexpr int LDS_BYTES = 147456;
constexpr int LDS_AUX = STAGE_BYTES;

__device__ __forceinline__ int lds_byte(int r, int c) { const int st = (r >> 4) * 2 + (c >> 5), rr = r & 15, cc = c & 31, ob = rr * 64 + cc * 2; return st * 1024 + (ob ^ (((ob >> 9) & 1) << 5)); }
__device__ __forceinline__ void stage_rc(int b, int& R, int& C) { const int st = b / 1024, sb = b % 1024, swz = sb ^ (((sb >> 9) & 1) << 5); R = (st >> 1) * 16 + swz / 64; C = (st & 1) * 32 + (swz % 64) / 2; }
__device__ __forceinline__ int perm32(int rho) { const int n = rho >> 4, i = rho & 15; return 8 * (i >> 2) + 4 * n + (i & 3); }
__device__ __forceinline__ unsigned cvt_pk_bf16(float lo, float hi) { unsigned r; asm volatile("v_cvt_pk_bf16_f32 %0, %1, %2" : "=v"(r) : "v"(lo), "v"(hi)); return r; }

struct Unit { int pm, pn, e, pos0, cn; };
struct TileOrder {
    int nM, nN, nwg, G, c;
    __device__ __forceinline__ void init(int nM_, int nN_, int G_, int c_) { nM = nM_; nN = nN_; nwg = nM * nN; G = G_; c = c_; }
    __device__ __forceinline__ bool tile(int i, int& pm, int& pn) const {
        const long L = (long)i * G + c; if (L >= nwg) return false;
        int wgid = (int)L; { const int q = nwg / NXCD, r = nwg % NXCD, xcd = wgid % NXCD, off = wgid / NXCD; wgid = (xcd < r ? xcd * (q + 1) : r * (q + 1) + (xcd - r) * q) + off; }
        const int nig = WGM * nN, gid = wgid / nig, fm = gid * WGM, gsz = (nM - fm) < WGM ? (nM - fm) : WGM;
        pm = fm + ((wgid % nig) % gsz); pn = (wgid % nig) / gsz; return true;
    }
};

template <class POL>
__device__ __forceinline__ void gemm_phase(LAS unsigned char* lds, const POL& P) {
    int tid_ = threadIdx.x; asm volatile("" : "+v"(tid_));
    const int tid = tid_, wid = __builtin_amdgcn_readfirstlane(tid >> 6), lane = tid & 63, wr = wid >> 2, wc = wid & 3, fr = lane & 15, fq = lane >> 4;
    constexpr int KB = POL::FP8 ? 1024 : 2048, nt = KB / 128;
    int sR[2], sC[2]; unsigned voffA[2], voffB[2];
#pragma unroll
    for (int i = 0; i < 2; ++i) { stage_rc(tid * 16 + i * 8192, sR[i], sC[i]); const int Rb = POL::PERM ? ((sR[i] & ~31) + perm32(sR[i] & 31)) : sR[i]; voffA[i] = (unsigned)(sR[i] * KB + sC[i] * 2); voffB[i] = (unsigned)(Rb * KB + sC[i] * 2); }
    constexpr size_t kstep = (size_t)(BK * 2);
    constexpr unsigned hstepB = (unsigned)HALFT * KB;
    const unsigned ldsw = (unsigned)wid * 1024u;
    const int aoff = POL::FP8 ? lds_byte(wr * 64 + fr, fq * 16) : lds_byte(wr * 64 + fr, fq * 8), boff = POL::FP8 ? lds_byte(wc * 32 + fr, fq * 16) : lds_byte(wc * 32 + fr, fq * 8);
#define G_SA(b, h) (((b) * 2 + (h)) * HTB)
#define G_SB(b, h) ((4 + (b) * 2 + (h)) * HTB)
#define G_AOFF(OFF, h, i) (POL::GATHER ? (OFF)[h][i] : voffA[i])
#define G_STAGE_A(bufoff, gbase, OFF, h) do { const char* _gb = (const char*)(gbase) + (POL::GATHER ? (size_t)0 : (size_t)(h) * hstepB); _Pragma("unroll") for (int _i = 0; _i < 2; ++_i) \
        __builtin_amdgcn_global_load_lds((const unsigned*)(_gb + G_AOFF(OFF, h, _i)), (LAS unsigned*)(lds + (bufoff) + ldsw + _i * 8192), 16, 0, 0); } while (0)
#define G_STAGE_B(bufoff, gbase, hoff) do { const char* _gb = (const char*)(gbase) + (size_t)(hoff); _Pragma("unroll") for (int _i = 0; _i < 2; ++_i) \
        __builtin_amdgcn_global_load_lds((const unsigned*)(_gb + voffB[_i]), (LAS unsigned*)(lds + (bufoff) + ldsw + _i * 8192), 16, 0, 0); } while (0)
#define G_LD8(p) __builtin_shufflevector(*(const LAS v4i_*)(p), *(const LAS v4i_*)((p) + 16), 0, 1, 2, 3, 4, 5, 6, 7)
#define G_LDA(dst, b, h) do { if (POL::FP8) { _Pragma("unroll") for (int m = 0; m < 4; ++m) dst##8[m] = G_LD8(lds + G_SA(b, h) + aoff + m * 2048); } \
        else { _Pragma("unroll") for (int m = 0; m < 4; ++m) _Pragma("unroll") for (int k = 0; k < 2; ++k) dst[m][k] = *(const LAS bf16x8*)(lds + G_SA(b, h) + aoff + m * 2048 + k * 1024); } } while (0)
#define G_LDB(dst, b, h) do { if (POL::FP8) { _Pragma("unroll") for (int n = 0; n < 2; ++n) dst##8[n] = G_LD8(lds + G_SB(b, h) + boff + n * 2048); } \
        else { _Pragma("unroll") for (int n = 0; n < 2; ++n) _Pragma("unroll") for (int k = 0; k < 2; ++k) dst[n][k] = *(const LAS bf16x8*)(lds + G_SB(b, h) + boff + n * 2048 + k * 1024); } } while (0)
#define G_MMA(ai, bj, At, Bt) do { __builtin_amdgcn_s_setprio(1); \
        if (POL::FP8) { _Pragma("unroll") for (int m = 0; m < 4; ++m) _Pragma("unroll") for (int n = 0; n < 2; ++n) \
            asm volatile("v_mfma_scale_f32_16x16x128_f8f6f4 %0, %1, %2, %0, %3, %3 op_sel_hi:[0,0,0]" : "+v"(acc[ai][bj][m][n]) : "v"(Bt##8[n]), "v"(At##8[m]), "v"(mxs)); } \
        else { _Pragma("unroll") for (int m = 0; m < 4; ++m) _Pragma("unroll") for (int n = 0; n < 2; ++n) _Pragma("unroll") for (int k = 0; k < 2; ++k) \
            acc[ai][bj][m][n] = __builtin_amdgcn_mfma_f32_16x16x32_bf16(Bt[n][k], At[m][k], acc[ai][bj][m][n], 0, 0, 0); } \
        __builtin_amdgcn_s_setprio(0); } while (0)
#define G_WAIT_V(n) asm volatile("s_waitcnt vmcnt(" #n ")" ::: "memory")
#define G_WAIT_L(n) asm volatile("s_waitcnt lgkmcnt(" #n ")" ::: "memory")
#define G_BAR __builtin_amdgcn_s_barrier()
#define G_SCHED __builtin_amdgcn_sched_barrier(0)
#define G_TRIP(A1, OC, A2, ON, B2) do { \
        G_LDB(B0, 0, 0); G_SCHED; G_LDA(At, 0, 0); G_STAGE_A(G_SA(1, 1), A1, OC, 1); \
        G_WAIT_L(8); G_BAR; G_WAIT_L(0); G_MMA(0, 0, At, B0); G_BAR; G_SCHED; \
        G_LDB(B1, 0, 1); G_STAGE_B(G_SB(0, 0), B2, 0u); \
        G_BAR; G_WAIT_L(0); G_MMA(0, 1, At, B1); G_BAR; \
        G_LDA(At, 0, 1); G_STAGE_A(G_SA(0, 0), A2, ON, 0); \
        G_BAR; G_WAIT_L(0); G_MMA(1, 0, At, B0); G_BAR; G_SCHED; \
        G_STAGE_B(G_SB(0, 1), B2, hstepB); \
        G_WAIT_V(6); G_BAR; G_MMA(1, 1, At, B1); G_BAR; \
        G_LDB(B0, 1, 0); G_SCHED; G_LDA(At, 1, 0); G_STAGE_A(G_SA(0, 1), A2, ON, 1); \
        G_WAIT_L(8); G_BAR; G_WAIT_L(0); G_MMA(0, 0, At, B0); G_BAR; G_SCHED; \
        G_LDB(B1, 1, 1); G_STAGE_B(G_SB(1, 0), (B2) + kstep, 0u); \
        G_BAR; G_WAIT_L(0); G_MMA(0, 1, At, B1); G_BAR; \
        G_LDA(At, 1, 1); G_STAGE_A(G_SA(1, 0), (A2) + kstep, ON, 0); \
        G_BAR; G_WAIT_L(0); G_MMA(1, 0, At, B0); G_BAR; G_SCHED; \
        G_STAGE_B(G_SB(1, 1), (B2) + kstep, hstepB); \
        G_WAIT_V(6); G_BAR; G_MMA(1, 1, At, B1); G_BAR; } while (0)
#define G_TRIP2(A1, OC, A2, ON, B2) do { \
        G_LDB(B0, 0, 0); G_LDB(B1, 0, 1); G_SCHED; G_LDA(At, 0, 0); G_STAGE_A(G_SA(1, 1), A1, OC, 1); \
        G_WAIT_V(8); G_WAIT_L(0); G_BAR; G_MMA(0, 0, At, B0); G_MMA(0, 1, At, B1); G_BAR; G_SCHED; \
        G_LDA(At, 0, 1); G_STAGE_B(G_SB(0, 0), B2, 0u); G_STAGE_B(G_SB(0, 1), B2, hstepB); G_STAGE_A(G_SA(0, 0), A2, ON, 0); \
        G_WAIT_V(8); G_WAIT_L(0); G_BAR; G_MMA(1, 0, At, B0); G_MMA(1, 1, At, B1); G_BAR; G_SCHED; \
        G_LDB(B0, 1, 0); G_LDB(B1, 1, 1); G_SCHED; G_LDA(At, 1, 0); G_STAGE_A(G_SA(0, 1), A2, ON, 1); \
        G_WAIT_V(8); G_WAIT_L(0); G_BAR; G_MMA(0, 0, At, B0); G_MMA(0, 1, At, B1); G_BAR; G_SCHED; \
        G_LDA(At, 1, 1); G_STAGE_B(G_SB(1, 0), (B2) + kstep, 0u); G_STAGE_B(G_SB(1, 1), (B2) + kstep, hstepB); G_STAGE_A(G_SA(1, 0), (A2) + kstep, ON, 0); \
        G_WAIT_V(8); G_WAIT_L(0); G_BAR; G_MMA(1, 0, At, B0); G_MMA(1, 1, At, B1); G_BAR; G_SCHED; } while (0)
#ifndef GEMM_SP2
#define GEMM_SP2 1
#endif
    Unit cur, nxt; int ui = 0;
    if (!P.next(0, cur)) return;
    f32x4 acc[2][2][4][2];
#pragma unroll
    for (int a = 0; a < 2; ++a)
#pragma unroll
        for (int b = 0; b < 2; ++b)
#pragma unroll
            for (int m = 0; m < 4; ++m)
#pragma unroll
                for (int n = 0; n < 2; ++n) acc[a][b][m][n] = (f32x4){0.f, 0.f, 0.f, 0.f};
    const int mxs = 0x7f7f7f7f;
    bf16x8 At[4][2], B0[2][2], B1[2][2]; v8i At8[4], B08[2], B18[2];
    unsigned oc[2][2], on[2][2];
    if (POL::ROWS) { P.stage_rows(cur, 0); __syncthreads(); }
#pragma unroll
    for (int h = 0; h < 2; ++h)
#pragma unroll
        for (int i = 0; i < 2; ++i) { oc[h][i] = POL::GATHER ? P.a_off_l(0, h * HALFT + sR[i]) + (unsigned)sC[i] * 2u : 0u; on[h][i] = 0u; }
    const char* cA = P.a_base(cur); const char* cB = P.b_base(cur);
    if (GEMM_SP2) {
        G_STAGE_B(G_SB(0, 0), cB, 0u); G_STAGE_B(G_SB(0, 1), cB, hstepB); G_STAGE_A(G_SA(0, 0), cA, oc, 0); G_STAGE_A(G_SA(0, 1), cA, oc, 1);
        if (wr == 1) G_BAR;
        G_WAIT_V(2); G_BAR;
        G_STAGE_B(G_SB(1, 0), cB + kstep, 0u); G_STAGE_A(G_SA(1, 0), cA + kstep, oc, 0); G_STAGE_B(G_SB(1, 1), cB + kstep, hstepB);
        G_WAIT_V(6); G_BAR;
    } else {
    G_STAGE_B(G_SB(0, 0), cB, 0u); G_STAGE_A(G_SA(0, 0), cA, oc, 0); G_STAGE_B(G_SB(0, 1), cB, hstepB); G_STAGE_A(G_SA(0, 1), cA, oc, 1);
    if (wr == 1) G_BAR;
    G_WAIT_V(4); G_BAR;
    G_STAGE_B(G_SB(1, 0), cB + kstep, 0u); G_STAGE_A(G_SA(1, 0), cA + kstep, oc, 0); G_STAGE_B(G_SB(1, 1), cB + kstep, hstepB);
    G_WAIT_V(6); G_BAR;
    }
    for (;;) {
        const bool has_next = P.next(ui + 1, nxt);
        const char* nA = has_next ? P.a_base(nxt) : cA; const char* nB = has_next ? P.b_base(nxt) : cB;
        if (POL::ROWS) { if (has_next) P.stage_rows(nxt, (ui + 1) & 1); }
#pragma unroll 1
        for (int t = 0; t < nt; t += 2) {
            const bool last = (t == nt - 2);
            const char* a1 = cA + (size_t)(t + 1) * kstep; const char* a2 = last ? nA : cA + (size_t)(t + 2) * kstep; const char* b2 = last ? nB : cB + (size_t)(t + 2) * kstep;
            if (POL::GATHER) {
                unsigned os[2][2];
                if (last) {
#pragma unroll
                    for (int h = 0; h < 2; ++h)
#pragma unroll
                        for (int i = 0; i < 2; ++i) on[h][i] = has_next ? P.a_off_l((ui + 1) & 1, h * HALFT + sR[i]) + (unsigned)sC[i] * 2u : oc[h][i];
                }
#pragma unroll
                for (int h = 0; h < 2; ++h)
#pragma unroll
                    for (int i = 0; i < 2; ++i) os[h][i] = last ? on[h][i] : oc[h][i];
                if (GEMM_SP2) { G_TRIP2(a1, oc, a2, os, b2); } else { G_TRIP(a1, oc, a2, os, b2); }
            } else { if (GEMM_SP2) { G_TRIP2(a1, oc, a2, oc, b2); } else { G_TRIP(a1, oc, a2, oc, b2); } }
        }
        if (POL::FP8) asm volatile("s_nop 15\n\ts_nop 15" ::: "memory");
        if (wr == 0) G_BAR;
        P.epi(acc, cur, wr, wc, fr, fq, ui & 1);
        if (!has_next) break;
#pragma unroll
        for (int a = 0; a < 2; ++a)
#pragma unroll
            for (int b = 0; b < 2; ++b)
#pragma unroll
                for (int m = 0; m < 4; ++m)
#pragma unroll
                    for (int n = 0; n < 2; ++n) acc[a][b][m][n] = (f32x4){0.f, 0.f, 0.f, 0.f};
        cur = nxt; cA = nA; cB = nB; ++ui;
        if (POL::GATHER) {
#pragma unroll
            for (int h = 0; h < 2; ++h)
#pragma unroll
                for (int i = 0; i < 2; ++i) oc[h][i] = on[h][i];
        }
        if (wr == 1) G_BAR;
    }
    G_WAIT_V(0);
    G_BAR;
#undef G_SA
#undef G_SB
#undef G_AOFF
#undef G_STAGE_A
#undef G_STAGE_B
#undef G_LDA
#undef G_LDB
#undef G_MMA
#undef G_LD8
#undef G_WAIT_V
#undef G_WAIT_L
#undef G_BAR
#undef G_SCHED
#undef G_TRIP
#undef G_TRIP2
}

struct PolInProj {
    static constexpr bool PERM = true, GATHER = false, FP8 = false, ROWS = false;
    __device__ __forceinline__ void stage_rows(const Unit&, int) const {}
    __device__ __forceinline__ unsigned a_off_l(int, int) const { return 0u; }
    const bf16_t* A; const bf16_t* Bt; bf16_t* O; TileOrder ord;
    __device__ __forceinline__ bool next(int i, Unit& u) const {
        constexpr int NLATU = (NLAT / BM) * (INW / BM);
        const int L = i * ord.G + ord.c;
        if (L < NLATU) return ord.tile(i, u.pm, u.pn);
        const int q = L - NLATU; if (q >= (NCTX / BM) * 8) return false;
        u.pm = NLAT / BM + (q >> 3); const int j = q & 7; u.pn = j < 6 ? 2 + j : 4 + j; return true;
    }
    __device__ __forceinline__ const char* a_base(const Unit& u) const { return (const char*)A + (size_t)u.pm * BM * GK * 2; }
    __device__ __forceinline__ unsigned a_off(const Unit&, int r) const { return (unsigned)r * GK * 2u; }
    __device__ __forceinline__ const char* b_base(const Unit& u) const { return (const char*)Bt + (size_t)u.pn * BM * GK * 2; }
    __device__ __forceinline__ void epi(const f32x4 (&acc)[2][2][4][2], const Unit& u, int wr, int wc, int fr, int fq, int par) const {
        const int row0 = u.pm * BM + wr * 64 + fr, col0 = u.pn * BM + wc * 32 + 8 * fq;
        const bool qsilu = u.pn < HGW / BM;
#pragma unroll
        for (int ai = 0; ai < 2; ++ai)
#pragma unroll
            for (int m = 0; m < 4; ++m) { bf16_t* rowp = O + (size_t)(row0 + ai * HALFT + m * 16) * INW + col0;
#pragma unroll
                for (int bj = 0; bj < 2; ++bj) { f32x4 v0 = acc[ai][bj][m][0], v1 = acc[ai][bj][m][1];
                    if (qsilu) {
#pragma unroll
                        for (int e = 0; e < 4; ++e) { v0[e] = v0[e] * sigmoidf_(v0[e]); v1[e] = v1[e] * sigmoidf_(v1[e]); } }
                    u32x4 w; w.x = cvt_pk_bf16(v0[0], v0[1]); w.y = cvt_pk_bf16(v0[2], v0[3]); w.z = cvt_pk_bf16(v1[0], v1[1]); w.w = cvt_pk_bf16(v1[2], v1[3]);
                    *(u32x4*)(rowp + bj * HALFT) = w; } }
    }
};
struct PolOutProj {
    static constexpr bool PERM = true, GATHER = false, FP8 = false, ROWS = false;
    __device__ __forceinline__ void stage_rows(const Unit&, int) const {}
    __device__ __forceinline__ unsigned a_off_l(int, int) const { return 0u; }
    const bf16_t* A; const bf16_t* Bt; const float* x; const float* mod; bf16_t* O; TileOrder ord;
    __device__ __forceinline__ bool next(int i, Unit& u) const { return ord.tile(i, u.pm, u.pn); }
    __device__ __forceinline__ const char* a_base(const Unit& u) const { return (const char*)A + (size_t)u.pm * BM * GK * 2; }
    __device__ __forceinline__ unsigned a_off(const Unit&, int r) const { return (unsigned)r * GK * 2u; }
    __device__ __forceinline__ const char* b_base(const Unit& u) const { return (const char*)Bt + (size_t)u.pn * BM * GK * 2; }
    __device__ __forceinline__ void epi(const f32x4 (&acc)[2][2][4][2], const Unit& u, int wr, int wc, int fr, int fq, int par) const {
        const int row0 = u.pm * BM + wr * 64 + fr, col0 = u.pn * BM + wc * 32 + 8 * fq;
        const float* g1 = mod + (size_t)((u.pm * BM) >> 11) * 6144 + 2048 + col0;
        f32x4 gv[2][2];
#pragma unroll
        for (int bj = 0; bj < 2; ++bj) { gv[bj][0] = *(const f32x4*)(g1 + bj * HALFT); gv[bj][1] = *(const f32x4*)(g1 + bj * HALFT + 4); }
#pragma unroll
        for (int ai = 0; ai < 2; ++ai)
#pragma unroll
            for (int m = 0; m < 4; ++m) { const size_t off = (size_t)(row0 + ai * HALFT + m * 16) * D + col0;
#pragma unroll
                for (int bj = 0; bj < 2; ++bj) {
                    const f32x4 x0 = __builtin_nontemporal_load((const f32x4*)(x + off + bj * HALFT)), x1v = __builtin_nontemporal_load((const f32x4*)(x + off + bj * HALFT + 4));
                    const f32x4 v0 = x0 + gv[bj][0] * acc[ai][bj][m][0], v1 = x1v + gv[bj][1] * acc[ai][bj][m][1];
                    u32x4 w; w.x = cvt_pk_bf16(v0[0], v0[1]); w.y = cvt_pk_bf16(v0[2], v0[3]); w.z = cvt_pk_bf16(v1[0], v1[1]); w.w = cvt_pk_bf16(v1[2], v1[3]);
                    *(u32x4*)(O + off + bj * HALFT) = w; }
                asm volatile("" ::: "memory"); }
    }
};
struct MoeTiles {
    const LAS int* tstart; const u32* cnt; int half;
    __device__ __forceinline__ LAS u32* rows(int par) const { return (LAS u32*)((LAS unsigned char*)tstart + 8192) + par * 512; }
    __device__ __forceinline__ void stage(const Unit& u, int par, const u32* toktab, const float* wtab) const {
        if (threadIdx.x < BM) { const int p = u.pos0 + threadIdx.x; const size_t tb = ((size_t)half * NE + u.e) * CAP; const bool ok = p < u.cn;
            const u32 tk = ok ? toktab[tb + p] : ~0u; const float wg = ok ? wtab[tb + p] : 0.f; LAS u32* rt = rows(par); rt[threadIdx.x * 2] = tk; rt[threadIdx.x * 2 + 1] = __float_as_uint(wg); }
    }
    __device__ __forceinline__ void find(Unit& u) const {
        const int e = __builtin_amdgcn_readfirstlane(tstart[64 + u.pm]);
        u.e = e; u.pos0 = (u.pm - __builtin_amdgcn_readfirstlane(tstart[e])) * BM; u.cn = (int)cnt[half * NE + e];
    }
};
struct PolGateUp {
    static constexpr bool PERM = true, GATHER = true, FP8 = true, ROWS = true;
    const fp8_t* A; const fp8_t* Bt; const float* bgu; const u32* toktab; const float* wtab; fp8_t* O; MoeTiles mt; TileOrder ord;
    __device__ __forceinline__ void stage_rows(const Unit& u, int par) const { mt.stage(u, par, toktab, wtab); }
    __device__ __forceinline__ unsigned a_off_l(int par, int r) const { const u32 tk = mt.rows(par)[r * 2]; return (tk == ~0u ? 0u : (tk >> 2)) * 1024u; }
    __device__ __forceinline__ bool next(int i, Unit& u) const { if (!ord.tile(i, u.pm, u.pn)) return false; mt.find(u); return true; }
    __device__ __forceinline__ const char* a_base(const Unit&) const { return (const char*)A; }
    __device__ __forceinline__ unsigned a_off(const Unit& u, int r) const {
        const int p = u.pos0 + r; const u32 tk = toktab[((size_t)mt.half * NE + u.e) * CAP + (p < u.cn ? p : 0)];
        return (tk >> 2) * 1024u;
    }
    __device__ __forceinline__ const char* b_base(const Unit& u) const { return (const char*)Bt + ((size_t)u.e * 2048 + (size_t)u.pn * BM) * 1024; }
    __device__ __forceinline__ void epi(const f32x4 (&acc)[2][2][4][2], const Unit& u, int wr, int wc, int fr, int fq, int par) const {
        const int row0 = u.pm * BM + wr * 64 + fr, cc = u.pn * HALFT + wc * 32 + 8 * fq;
        const float* bg = bgu + (size_t)u.e * 2048 + cc;
        const f32x4 bg0 = *(const f32x4*)bg, bg1 = *(const f32x4*)(bg + 4), bu0 = *(const f32x4*)(bg + 1024), bu1 = *(const f32x4*)(bg + 1028);
        constexpr float inv = 1.0f / (SC_H2 * SC_W);
#pragma unroll
        for (int ai = 0; ai < 2; ++ai)
#pragma unroll
            for (int m = 0; m < 4; ++m) {
                f32x4 g0 = acc[ai][0][m][0] * inv + bg0, g1 = acc[ai][0][m][1] * inv + bg1, u0 = acc[ai][1][m][0] * inv + bu0, u1 = acc[ai][1][m][1] * inv + bu1;
                float o[8];
#pragma unroll
                for (int j = 0; j < 4; ++j) {
                    const float ga = fminf(g0[j], 7.0f), gb = fminf(g1[j], 7.0f);
                    const float ua = fminf(fmaxf(u0[j], -7.0f), 7.0f), ub = fminf(fmaxf(u1[j], -7.0f), 7.0f);
                    o[j] = ga * sigmoidf_(1.702f * ga) * (ua + 1.0f) * SC_ACT; o[4 + j] = gb * sigmoidf_(1.702f * gb) * (ub + 1.0f) * SC_ACT;
                }
                uint2 w; w.x = pk4_fp8_nc(o[0], o[1], o[2], o[3]); w.y = pk4_fp8_nc(o[4], o[5], o[6], o[7]);
                *(uint2*)(O + (size_t)(row0 + ai * HALFT + m * 16) * DFF + cc) = w;
                asm volatile("" ::: "memory");
            }
    }
};
struct PolDown {
    static constexpr bool PERM = true, GATHER = false, FP8 = true, ROWS = true;
    const fp8_t* A; const fp8_t* Bt; const float* bd; const u32* toktab; const float* wtab; fp8_t* O; MoeTiles mt; TileOrder ord;
    __device__ __forceinline__ void stage_rows(const Unit& u, int par) const { mt.stage(u, par, toktab, wtab); }
    __device__ __forceinline__ unsigned a_off_l(int, int) const { return 0u; }
    __device__ __forceinline__ bool next(int i, Unit& u) const { if (!ord.tile(i, u.pm, u.pn)) return false; mt.find(u); return true; }
    __device__ __forceinline__ const char* a_base(const Unit& u) const { return (const char*)A + (size_t)u.pm * BM * 1024; }
    __device__ __forceinline__ unsigned a_off(const Unit&, int r) const { return (unsigned)r * 1024u; }
    __device__ __forceinline__ const char* b_base(const Unit& u) const { return (const char*)Bt + ((size_t)u.e * 1024 + (size_t)u.pn * BM) * 1024; }
    __device__ __forceinline__ void epi(const f32x4 (&acc)[2][2][4][2], const Unit& u, int wr, int wc, int fr, int fq, int par) const {
        const int col0 = u.pn * BM + wc * 32 + 8 * fq;
        const float* bp = bd + (size_t)u.e * D + col0;
        f32x4 bv[2][2];
#pragma unroll
        for (int bj = 0; bj < 2; ++bj) { bv[bj][0] = *(const f32x4*)(bp + bj * HALFT); bv[bj][1] = *(const f32x4*)(bp + bj * HALFT + 4); }
        const LAS u32* rt = mt.rows(par);
        constexpr float inv = 1.0f / (SC_ACT * SC_W);
#pragma unroll
        for (int ai = 0; ai < 2; ++ai)
#pragma unroll
            for (int m = 0; m < 4; ++m) {
                const int rr = ai * HALFT + wr * 64 + m * 16 + fr;
                const u32 tk = rt[rr * 2];
                if (tk != ~0u) {
                    const float wg = __uint_as_float(rt[rr * 2 + 1]) * SC_Y;
                    fp8_t* rowp = O + (size_t)(tk - (u32)mt.half * HALF_TOK * 4u) * D + col0;
#pragma unroll
                    for (int bj = 0; bj < 2; ++bj) { const f32x4 v0 = (acc[ai][bj][m][0] * inv + bv[bj][0]) * wg, v1 = (acc[ai][bj][m][1] * inv + bv[bj][1]) * wg;
                        uint2 w; w.x = pk4_fp8(v0[0], v0[1], v0[2], v0[3]); w.y = pk4_fp8(v1[0], v1[1], v1[2], v1[3]);
                        *(uint2*)(rowp + bj * HALFT) = w; }
                }
            }
    }
};
__device__ __forceinline__ int moe_tile_table(LAS int* tstart, const u32* cnt, int half) {
    __syncthreads();
    if (threadIdx.x == 0) { int s = 0; for (int e = 0; e < NE; ++e) { tstart[e] = s; s += ((int)cnt[half * NE + e] + BM - 1) / BM; } tstart[NE] = s; }
    __syncthreads();
    const int tot = tstart[NE];
    for (int t = threadIdx.x; t < tot; t += 512) { int e = 0;
#pragma unroll 1
        for (int i = 1; i < NE; ++i) if (t >= tstart[i]) e = i;
        tstart[64 + t] = e; }
    __syncthreads();
    return tot;
}

__device__ __forceinline__ void conv_item(const float* __restrict__ W, int N, bf16_t* __restrict__ WT, int k0, int n0, size_t rowbase, LAS float* scr, int lane) {
#pragma unroll 4
    for (int i = 0; i < 16; ++i) { const int k = 4 * i + (lane >> 4); const f32x4 v = __builtin_nontemporal_load((const f32x4*)(W + (size_t)(k0 + k) * N + n0 + (lane & 15) * 4)); *(LAS f32x4*)(scr + k * 68 + (lane & 15) * 4) = v; }
    asm volatile("s_waitcnt lgkmcnt(0)" ::: "memory");
    const int c = lane & 7;
#pragma unroll
    for (int j = 0; j < 8; ++j) { const int n = (lane >> 3) + 8 * j; const LAS float* s = scr + (8 * c) * 68 + n;
        u32x4 o; o.x = cvt_pk_bf16(s[0 * 68], s[1 * 68]); o.y = cvt_pk_bf16(s[2 * 68], s[3 * 68]); o.z = cvt_pk_bf16(s[4 * 68], s[5 * 68]); o.w = cvt_pk_bf16(s[6 * 68], s[7 * 68]);
        *(u32x4*)(WT + (rowbase + n) * GK + k0 + 8 * c) = o; }
    asm volatile("s_waitcnt lgkmcnt(0)" ::: "memory");
}
__device__ __forceinline__ void conv_item8(const float* __restrict__ W, int N, fp8_t* __restrict__ WT, int k0, int n0, size_t rowbase, LAS float* scr, int lane) {
#pragma unroll 4
    for (int i = 0; i < 16; ++i) { const int k = 4 * i + (lane >> 4); const f32x4 v = __builtin_nontemporal_load((const f32x4*)(W + (size_t)(k0 + k) * N + n0 + (lane & 15) * 4)); *(LAS f32x4*)(scr + k * 68 + (lane & 15) * 4) = v; }
    asm volatile("s_waitcnt lgkmcnt(0)" ::: "memory");
    const LAS float* sp = scr + lane;
#pragma unroll
    for (int q = 0; q < 4; ++q) {
        u32x4 o;
        o.x = pk4_fp8(sp[(16 * q + 0) * 68] * SC_W, sp[(16 * q + 1) * 68] * SC_W, sp[(16 * q + 2) * 68] * SC_W, sp[(16 * q + 3) * 68] * SC_W);
        o.y = pk4_fp8(sp[(16 * q + 4) * 68] * SC_W, sp[(16 * q + 5) * 68] * SC_W, sp[(16 * q + 6) * 68] * SC_W, sp[(16 * q + 7) * 68] * SC_W);
        o.z = pk4_fp8(sp[(16 * q + 8) * 68] * SC_W, sp[(16 * q + 9) * 68] * SC_W, sp[(16 * q + 10) * 68] * SC_W, sp[(16 * q + 11) * 68] * SC_W);
        o.w = pk4_fp8(sp[(16 * q + 12) * 68] * SC_W, sp[(16 * q + 13) * 68] * SC_W, sp[(16 * q + 14) * 68] * SC_W, sp[(16 * q + 15) * 68] * SC_W);
        *(u32x4*)(WT + (rowbase + lane) * GK + k0 + 16 * q) = o;
    }
    asm volatile("s_waitcnt lgkmcnt(0)" ::: "memory");
}
constexpr int IT_IN = 16 * (INW / 64), IT_OUT = 16 * (D / 64), IT_GU = NE * 16 * 32, IT_D = NE * 16 * 16, IT_ALL = IT_IN + IT_OUT + IT_GU + IT_D;
struct ProArgs { const float *c, *c_ctx, *w_ada, *b_ada, *lbl, *w_in, *w_out, *wgu, *wd, *rg_wa, *rg_wx, *rg_lam; float *mod, *lb, *coef; bf16_t *Win_t, *Wout_t, *WG_t; fp8_t *Wgu_t, *Wd_t; };
__device__ __forceinline__ void phase_prologue(LAS unsigned char* lds, const ProArgs& a, int bid, int G, bool do_mod, int it_lo, int it_hi) {
    const int tid = threadIdx.x, lane = tid & 63, w = tid >> 6;
    if (!do_mod) {} else if (bid < 96) {
        LAS float* s = (LAS float*)lds;
        for (int i = tid; i < 33 * D; i += 512) { const int b = i >> 10, k = i & 1023; const float v = b < NB ? a.c[(size_t)b * D + k] : a.c_ctx[k]; s[i] = v * sigmoidf_(v); }
        __syncthreads();
        const int n = bid * 64 + lane;
        float acc[33];
#pragma unroll
        for (int b = 0; b < 33; ++b) acc[b] = 0.f;
#pragma unroll 1
        for (int k = 128 * w; k < 128 * w + 128; k += 16) {
            float wv[16];
#pragma unroll
            for (int i = 0; i < 16; ++i) wv[i] = __builtin_nontemporal_load(a.w_ada + (size_t)(k + i) * 6144 + n);
#pragma unroll
            for (int b = 0; b < 33; ++b)
#pragma unroll
                for (int i4 = 0; i4 < 4; ++i4) { const f32x4 sv = *(const LAS f32x4*)(s + b * D + k + 4 * i4); acc[b] += sv[0] * wv[4 * i4] + sv[1] * wv[4 * i4 + 1] + sv[2] * wv[4 * i4 + 2] + sv[3] * wv[4 * i4 + 3]; }
        }
        __syncthreads();
        LAS float* red = (LAS float*)lds;
#pragma unroll
        for (int b = 0; b < 33; ++b) red[(w * 33 + b) * 64 + lane] = acc[b];
        __syncthreads();
        for (int i = tid; i < 33 * 64; i += 512) { const int b = i >> 6, l = i & 63; float sum = a.b_ada[bid * 64 + l];
#pragma unroll
            for (int ww = 0; ww < 8; ++ww) sum += red[(ww * 33 + b) * 64 + l];
            a.mod[(size_t)b * 6144 + bid * 64 + l] = sum; }
        __syncthreads();
    } else if (bid == 96) {
        for (int i = tid; i < 2 * HGW; i += 512) { const float l0 = a.lbl[i], l1 = a.lbl[2 * HGW + i]; a.lb[i] = 1.0f / (1.0f + __expf(l1 - l0)); }
        for (int i = tid; i < 2 * RGW; i += 512) { const float l = a.rg_lam[i]; const float sp = (-l > 20.f) ? -l : log1pf(__expf(-l)); a.coef[i] = -8.0f * sp; }
    } else if (bid == 97) {
        for (int idx = tid; idx < 8 * 256 * 64; idx += 512) { const int hd = idx >> 14, n = (idx >> 6) & 255, kk = idx & 63, g = n >> 6, j = n & 63, d = g >> 1;
            const float* src = (g & 1) ? a.rg_wx : a.rg_wa; a.WG_t[idx] = f2bf(src[(((size_t)d * 8 + hd) * 64 + kk) * 64 + j]); }
    }
    LAS float* scr = (LAS float*)(lds + w * (64 * 68 * 4));
    const int gw = bid * 8 + w, NW = G * 8;
    for (int it = it_lo + gw; it < it_hi; it += NW) {
        int r = it;
        if (r < IT_IN) { const int kb = r / (INW / 64), nb = r % (INW / 64); conv_item(a.w_in, INW, a.Win_t, kb * 64, nb * 64, (size_t)nb * 64, scr, lane); continue; } r -= IT_IN;
        if (r < IT_OUT) { const int kb = r / 16, nb = r % 16; conv_item(a.w_out, D, a.Wout_t, kb * 64, nb * 64, (size_t)nb * 64, scr, lane); continue; } r -= IT_OUT;
        if (r < IT_GU) { const int e = r / 512, q = r % 512, kb = q / 32, nb = q % 32, n0 = nb * 64, bj = n0 >> 10, rem = n0 & 1023, pn = rem >> 7, cc0 = rem & 127;
            conv_item8(a.wgu + (size_t)e * D * 2048, 2048, a.Wgu_t, kb * 64, n0, (size_t)e * 2048 + pn * 256 + bj * 128 + cc0, scr, lane); continue; } r -= IT_GU;
        { const int e = r / 256, q = r % 256, kb = q / 16, nb = q % 16; conv_item8(a.wd + (size_t)e * DFF * D, D, a.Wd_t, kb * 64, nb * 64, (size_t)e * 1024 + nb * 64, scr, lane); }
    }
}


__device__ __forceinline__ void phase_norm1(const float* __restrict__ x, const float* __restrict__ ctx, const float* __restrict__ nw, const float* __restrict__ mod, bf16_t* __restrict__ H, int bid, int G) {
    constexpr int RB = 4;
    const int lane = threadIdx.x & 63, gw = bid * 8 + (threadIdx.x >> 6), NW = G * 8;
    for (int r0 = gw; r0 < NROWS; r0 += RB * NW) {
        f32x4 v[RB][4];
#pragma unroll
        for (int q = 0; q < RB; ++q) { const int r = r0 + q * NW; const int rr = r < NROWS ? r : r0;
            const float* src = rr < NLAT ? x + (size_t)rr * D : ctx + (size_t)(rr - NLAT) * D;
#pragma unroll
            for (int j = 0; j < 4; ++j) v[q][j] = __builtin_nontemporal_load((const f32x4*)(src + j * 256 + lane * 4)); }
#pragma unroll
        for (int q = 0; q < RB; ++q) { const int r = r0 + q * NW; if (r < NROWS) {
            const float* m = mod + (size_t)(r < NLAT ? (r >> 11) : NB) * 6144;
            float ss = 0.f;
#pragma unroll
            for (int j = 0; j < 4; ++j) ss += v[q][j][0] * v[q][j][0] + v[q][j][1] * v[q][j][1] + v[q][j][2] * v[q][j][2] + v[q][j][3] * v[q][j][3];
            const float rstd = __builtin_amdgcn_rsqf(wave_sum(ss) * (1.0f / D) + EPS);
#pragma unroll
            for (int j = 0; j < 4; ++j) {
                const int c0 = j * 256 + lane * 4;
                const f32x4 w = *(const f32x4*)(nw + c0), sh = *(const f32x4*)(m + c0), sc = *(const f32x4*)(m + 1024 + c0);
                const f32x4 o = v[q][j] * rstd * w * (sc + 1.0f) + sh;
                uint2 p; p.x = cvt_pk_bf16(o[0], o[1]); p.y = cvt_pk_bf16(o[2], o[3]);
                *(uint2*)(H + (size_t)r * D + c0) = p;
            } } }
    }
}

__device__ __forceinline__ bf16x8 pack8(const f32x4& a, const f32x4& b) {
    u32x4 w; w.x = cvt_pk_bf16(a[0], a[1]); w.y = cvt_pk_bf16(a[2], a[3]); w.z = cvt_pk_bf16(b[0], b[1]); w.w = cvt_pk_bf16(b[2], b[3]);
    return __builtin_bit_cast(bf16x8, w);
}
constexpr int HW_BUF = 45056;
constexpr int HW_QD = 0, HW_KET = 17408, HW_PM = 35840;
constexpr int HW_VT = 2 * HW_BUF, HW_KD = HW_VT + 18432, HW_OS = HW_KD + 17408, HW_TOT = HW_OS + 17408, HW_DEC = HW_TOT + 1024;
__device__ __forceinline__ void phase_hgrn2_ws(LAS unsigned char* lds, const bf16_t* __restrict__ P, const float* __restrict__ lb, bf16_t* __restrict__ OF, bf16_t* __restrict__ OB, int item) {
    const int b = item >> 3, h = (item >> 1) & 3, dir = item & 1;
    const int tid = threadIdx.x, w = __builtin_amdgcn_readfirstlane(tid >> 6), lane = tid & 63, l15 = lane & 15, G4 = lane >> 4;
    bf16_t* OD = dir ? OB : OF;
    const int cf = dir ? C_FB : C_FF;
    constexpr int NC = (CTXL + T) / 64;
    LAS float* TOT = (LAS float*)(lds + HW_TOT);
#define HW_BAR() do { asm volatile("s_waitcnt lgkmcnt(0)" ::: "memory"); __builtin_amdgcn_s_barrier(); asm volatile("" ::: "memory"); } while (0)
    __syncthreads();
    if (w >= 4) {
        const int et = tid - 256, k = et & 127, seg = et >> 7, ew = w - 4;
        const int kslot = (k & ~31) | (((k >> 2) & 3) << 3) | (((k >> 4) & 1) << 2) | (k & 3);
        const float lbv = lb[dir * HGW + h * 128 + k];
        const char* Pc = (const char*)P; const int sstep = dir ? -(INW * 2) : INW * 2;
#define HW_OFF0(m_) ({ const int p_ = 64 * (m_) + 32 * seg; const unsigned r_ = p_ < CTXL ? (unsigned)(NLAT + b * CTXL + (dir ? CTXL - 1 - p_ : p_)) : (unsigned)(b * T + (dir ? T - 1 - (p_ - CTXL) : (p_ - CTXL))); (r_ * (unsigned)INW + (unsigned)(h * 128 + k)) * 2u; })
#define HW_LD(off0_, i_, col_) (*(const bf16_t*)(Pc + (unsigned)((int)(off0_) + (i_) * sstep + (col_) * 2)))
        typedef unsigned short us2 __attribute__((ext_vector_type(2)));
        us2 rf[16];
        { const unsigned o0 = HW_OFF0(0);
#pragma unroll
        for (int i = 0; i < 32; ++i) rf[i >> 1][i & 1] = HW_LD(o0, i, cf); }
#pragma unroll 1
        for (int m = 0; m < NC + 1; ++m) {
            const int par = m & 1;
            LAS unsigned char* buf = lds + par * HW_BUF;
            HW_BAR();
            us2 rq[16], rv[16]; float fv[32], cs[32]; float run = 0.f;
            if (m < NC) {
#pragma unroll
                for (int i = 0; i < 32; ++i) { const unsigned o0 = HW_OFF0(m); rq[i >> 1][i & 1] = HW_LD(o0, i, C_Q); rv[i >> 1][i & 1] = HW_LD(o0, i, C_I); }
#pragma unroll
                for (int i = 0; i < 32; ++i) { const float f = lbv + (1.f - lbv) * sigmoidf_(bf2f(rf[i >> 1][i & 1])); fv[i] = f; run += flog(f); cs[i] = run; }
                TOT[seg * 128 + k] = run;
                if (m + 1 < NC) {
#pragma unroll
                    for (int i = 0; i < 32; ++i) { const unsigned o0 = HW_OFF0(m + 1); rf[i >> 1][i & 1] = HW_LD(o0, i, cf); }
                }
            }
            HW_BAR();
            if (m < NC) {
                const float t0 = TOT[k], t1 = TOT[128 + k];
                const float prefix = seg == 0 ? 0.f : t0, blast = t0 + t1, eb = fexp(blast);
                if (seg == 0) ((LAS float*)(lds + HW_DEC + par * 512))[k] = eb;
#pragma unroll
                for (int q4 = 0; q4 < 4; ++q4) {
                    float ke[8];
#pragma unroll
                    for (int i2 = 0; i2 < 4; ++i2) {
                        const int i = 8 * q4 + 2 * i2, j = 32 * seg + i;
                        const float bc0 = prefix + cs[i], bc1 = prefix + cs[i + 1], e0 = fexp(bc0), e1 = fexp(bc1);
                        const float kf0 = (1.f - fv[i]) * frcp(e0), kf1 = (1.f - fv[i + 1]) * frcp(e1);
                        const u32 qd = cvt_pk_bf16(bf2f(rq[i >> 1][0]) * e0, bf2f(rq[i >> 1][1]) * e1), kd = cvt_pk_bf16(kf0, kf1);
                        *(LAS bf16_t*)(buf + HW_QD + j * 272 + kslot * 2) = (bf16_t)qd; *(LAS bf16_t*)(buf + HW_QD + (j + 1) * 272 + kslot * 2) = (bf16_t)(qd >> 16);
                        *(LAS bf16_t*)(lds + HW_KD + j * 272 + kslot * 2) = (bf16_t)kd; *(LAS bf16_t*)(lds + HW_KD + (j + 1) * 272 + kslot * 2) = (bf16_t)(kd >> 16);
                        ke[2 * i2] = kf0 * eb; ke[2 * i2 + 1] = kf1 * eb;
                    }
                    u32x4 wk, wv;
#pragma unroll
                    for (int i = 0; i < 4; ++i) { wk[i] = cvt_pk_bf16(ke[2 * i], ke[2 * i + 1]); wv[i] = __builtin_bit_cast(u32, rv[4 * q4 + i]); }
                    *(LAS u32x4*)(buf + HW_KET + k * 144 + seg * 64 + q4 * 16) = wk;
                    *(LAS u32x4*)(lds + HW_VT + k * 144 + seg * 64 + q4 * 16) = wv;
                }
            }
            HW_BAR();
            if (m < NC && m >= CTXL / 64) {
                const int mt = ew;
                f32x4 pa[4];
#pragma unroll
                for (int q = 0; q < 4; ++q) pa[q] = (f32x4){0.f, 0.f, 0.f, 0.f};
#pragma unroll
                for (int s = 0; s < 4; ++s) {
                    const bf16x8 a = *(const LAS bf16x8*)(buf + HW_QD + (16 * mt + l15) * 272 + (32 * s + 8 * G4) * 2);
#pragma unroll
                    for (int q = 0; q < 4; ++q) { const bf16x8 bq = *(const LAS bf16x8*)(lds + HW_KD + (16 * q + l15) * 272 + (32 * s + 8 * G4) * 2); pa[q] = __builtin_amdgcn_mfma_f32_16x16x32_bf16(a, bq, pa[q], 0, 0, 0); }
                }
#pragma unroll
                for (int q = 0; q < 4; ++q)
#pragma unroll
                    for (int r = 0; r < 4; ++r) { const int c = 16 * mt + 4 * G4 + r, j = 16 * q + l15; *(LAS bf16_t*)(buf + HW_PM + c * 144 + j * 2) = f2bf(j <= c ? pa[q][r] : 0.f); }
                asm volatile("s_waitcnt lgkmcnt(0)" ::: "memory");
            }
        }
#undef HW_OFF0
#undef HW_LD
    } else {
        f32x4 S[8][2];
#pragma unroll
        for (int t = 0; t < 8; ++t) { S[t][0] = (f32x4){0.f, 0.f, 0.f, 0.f}; S[t][1] = (f32x4){0.f, 0.f, 0.f, 0.f}; }
        HW_BAR(); HW_BAR(); HW_BAR();
#pragma unroll 1
        for (int n = 0; n < NC; ++n) {
            const int par = n & 1; const bool lat = n >= CTXL / 64;
            LAS unsigned char* buf = lds + par * HW_BUF;
            HW_BAR();
            bf16x8 vb[2][2];
#pragma unroll
            for (int nt = 0; nt < 2; ++nt)
#pragma unroll
                for (int s = 0; s < 2; ++s) vb[nt][s] = *(const LAS bf16x8*)(lds + HW_VT + (32 * w + 16 * nt + l15) * 144 + (32 * s + 8 * G4) * 2);
            HW_BAR();
            if (lat) {
                bf16x8 sb[2][4];
#pragma unroll
                for (int nt = 0; nt < 2; ++nt)
#pragma unroll
                    for (int s = 0; s < 4; ++s) sb[nt][s] = pack8(S[2 * s][nt], S[2 * s + 1][nt]);
#pragma unroll
                for (int mt = 0; mt < 4; ++mt) {
                    f32x4 oa[2] = {(f32x4){0.f, 0.f, 0.f, 0.f}, (f32x4){0.f, 0.f, 0.f, 0.f}};
#pragma unroll
                    for (int s = 0; s < 2; ++s) { const bf16x8 a = *(const LAS bf16x8*)(buf + HW_PM + (16 * mt + l15) * 144 + (32 * s + 8 * G4) * 2);
                        oa[0] = __builtin_amdgcn_mfma_f32_16x16x32_bf16(a, vb[0][s], oa[0], 0, 0, 0); oa[1] = __builtin_amdgcn_mfma_f32_16x16x32_bf16(a, vb[1][s], oa[1], 0, 0, 0); }
#pragma unroll
                    for (int s = 0; s < 4; ++s) { const bf16x8 a = *(const LAS bf16x8*)(buf + HW_QD + (16 * mt + l15) * 272 + (32 * s + 8 * G4) * 2);
                        oa[0] = __builtin_amdgcn_mfma_f32_16x16x32_bf16(a, sb[0][s], oa[0], 0, 0, 0); oa[1] = __builtin_amdgcn_mfma_f32_16x16x32_bf16(a, sb[1][s], oa[1], 0, 0, 0); }
#pragma unroll
                    for (int nt = 0; nt < 2; ++nt)
#pragma unroll
                        for (int r = 0; r < 4; ++r) *(LAS bf16_t*)(lds + HW_OS + (16 * mt + 4 * G4 + r) * 272 + (32 * w + 16 * nt + l15) * 2) = f2bf(oa[nt][r]);
                }
            }
#pragma unroll
            for (int t = 0; t < 8; ++t) {
                const f32x4 d4 = *(const LAS f32x4*)(lds + HW_DEC + par * 512 + (16 * t + 4 * G4) * 4);
                S[t][0] = S[t][0] * d4; S[t][1] = S[t][1] * d4;
#pragma unroll
                for (int s = 0; s < 2; ++s) { const bf16x8 a = *(const LAS bf16x8*)(buf + HW_KET + (16 * t + l15) * 144 + (32 * s + 8 * G4) * 2);
                    S[t][0] = __builtin_amdgcn_mfma_f32_16x16x32_bf16(a, vb[0][s], S[t][0], 0, 0, 0); S[t][1] = __builtin_amdgcn_mfma_f32_16x16x32_bf16(a, vb[1][s], S[t][1], 0, 0, 0); }
            }
            HW_BAR();
            if (lat) {
                const int j = tid >> 2, part = tid & 3, p = 64 * n + j, tt = dir ? T - 1 - (p - CTXL) : (p - CTXL);
                bf16_t* dst = OD + ((size_t)b * T + tt) * HGW + h * 128 + part * 32;
#pragma unroll
                for (int q = 0; q < 4; ++q) *(u32x4*)(dst + q * 8) = *(const LAS u32x4*)(lds + HW_OS + j * 272 + part * 64 + q * 16);
            }
        }
    }
    __syncthreads();
#undef HW_BAR
}

__device__ __forceinline__ size_t rg_row(int b, bool lat, int p) {
    return lat ? (size_t)b * T + (size_t)(p % GROWS) * GRIDW + (p / GROWS) : (size_t)NLAT + b * CTXL + p;
}
constexpr int RC_T = 64 * 144;
constexpr int RC_XC = 0, RC_RG = 2 * RC_T, RC_HI = 4 * RC_T, RC_OUT = 6 * RC_T;
__device__ __forceinline__ void phase_rg_chain(LAS unsigned char* lds, const bf16_t* __restrict__ P, const float* __restrict__ conv_w, const float* __restrict__ conv_b, const bf16_t* __restrict__ WG_t,
                                               const float* __restrict__ ba, const float* __restrict__ bx, const float* __restrict__ coef, bf16_t* __restrict__ HT, bf16_t* __restrict__ MIX, int item) {
    const int b = item >> 3, hd = item & 7;
    const int tid = threadIdx.x, w = __builtin_amdgcn_readfirstlane(tid >> 6), lane = tid & 63, l15 = lane & 15, G4 = lane >> 4;
    const int d = w >> 2, cg = w & 3, ch = 64 * hd + 16 * cg + l15;
    const int ds = tid >> 8, t8 = tid & 255, pg = t8 >> 4, cg4 = t8 & 15;
    bf16x8 F[4];
#pragma unroll
    for (int s = 0; s < 2; ++s) {
        F[s] = *(const bf16x8*)(WG_t + ((size_t)(hd * 256 + 64 * (2 * d) + 16 * cg + l15) * 64 + 32 * s + 8 * G4));
        F[2 + s] = *(const bf16x8*)(WG_t + ((size_t)(hd * 256 + 64 * (2 * d + 1) + 16 * cg + l15) * 64 + 32 * s + 8 * G4)); }
    const float bav = ba[d * RGW + ch], bxv = bx[d * RGW + ch], cf = coef[d * RGW + ch];
    const f32x4 cw0 = *(const f32x4*)(conv_w + 0 * RGW + 64 * hd + 4 * cg4), cw1 = *(const f32x4*)(conv_w + 1 * RGW + 64 * hd + 4 * cg4), cw2 = *(const f32x4*)(conv_w + 2 * RGW + 64 * hd + 4 * cg4),
                cw3 = *(const f32x4*)(conv_w + 3 * RGW + 64 * hd + 4 * cg4), cb4 = *(const f32x4*)(conv_b + 64 * hd + 4 * cg4);
    float hcar = 0.f;
#define RC_CHUNK(dd, s_) ((dd) == 0 ? (s_) : ((s_) < CTXL / 64 ? CTXL / 64 - 1 - (s_) : NCHK + CTXL / 64 - 1 - (s_)))
    u32x2 rxr[7]; u32x4 rgr[2], hir[2];
#define RC_LOAD_RX(s_) do { const int n_ = RC_CHUNK(ds, s_); const bool lat_ = n_ >= CTXL / 64; const int L_ = lat_ ? T : CTXL, p0_ = 64 * (lat_ ? n_ - CTXL / 64 : n_); \
        _Pragma("unroll") for (int i = 0; i < 7; ++i) { const int p = p0_ + 4 * pg - 2 + i; rxr[i] = (p >= 0 && p < L_) ? *(const u32x2*)(P + rg_row(b, lat_, p) * INW + C_RX + 64 * hd + 4 * cg4) : (u32x2){0u, 0u}; } } while (0)
#define RC_ROW(s_, q_) (rg_row(b, true, 64 * (RC_CHUNK(ds, s_) - CTXL / 64) + ((q_) >> 3)))
#define RC_LOAD_RG(s_) do { _Pragma("unroll") for (int j = 0; j < 2; ++j) { const int q = t8 * 2 + j; rgr[j] = *(const u32x4*)(P + RC_ROW(s_, q) * INW + C_RG + 64 * hd + (q & 7) * 8); } } while (0)
#define RC_LOAD_HI(s_) do { _Pragma("unroll") for (int j = 0; j < 2; ++j) { const int q = t8 * 2 + j; rgr[j] = rgr[j]; hir[j] = __builtin_nontemporal_load((const u32x4*)(HT + RC_ROW(s_, q) * RGW + 64 * hd + (q & 7) * 8)); } } while (0)
    RC_LOAD_RX(0);
#pragma unroll 1
    for (int s = 0; s < NCHK; ++s) {
        const int role = s < CTXL / 64 ? 0 : (s < 20 ? 1 : 2);
        if (s == 20) { asm volatile("s_waitcnt vmcnt(0)" ::: "memory"); __syncthreads(); RC_LOAD_RG(20); RC_LOAD_HI(20); }
        {
            float xin[7][4];
#pragma unroll
            for (int i = 0; i < 7; ++i) { xin[i][0] = __uint_as_float(rxr[i].x << 16); xin[i][1] = __uint_as_float(rxr[i].x & 0xffff0000u); xin[i][2] = __uint_as_float(rxr[i].y << 16); xin[i][3] = __uint_as_float(rxr[i].y & 0xffff0000u); }
#pragma unroll
            for (int q = 0; q < 4; ++q) {
                float o[4];
#pragma unroll
                for (int c = 0; c < 4; ++c) o[c] = cb4[c] + cw0[c] * xin[q][c] + cw1[c] * xin[q + 1][c] + cw2[c] * xin[q + 2][c] + cw3[c] * xin[q + 3][c];
                *(LAS unsigned long long*)(lds + RC_XC + ds * RC_T + (4 * pg + q) * 144 + cg4 * 8) = ((unsigned long long)cvt_pk_bf16(o[2], o[3]) << 32) | cvt_pk_bf16(o[0], o[1]);
            }
            if (role == 2) {
#pragma unroll
                for (int j = 0; j < 2; ++j) { const int q = t8 * 2 + j; *(LAS u32x4*)(lds + RC_RG + ds * RC_T + (q >> 3) * 144 + (q & 7) * 16) = rgr[j]; *(LAS u32x4*)(lds + RC_HI + ds * RC_T + (q >> 3) * 144 + (q & 7) * 16) = hir[j]; }
            }
        }
        __syncthreads();
        if (s + 1 < NCHK) { RC_LOAD_RX(s + 1); if (s + 1 > 20) { RC_LOAD_RG(s + 1); RC_LOAD_HI(s + 1); } }
        {
            bf16x8 af[4][2];
#pragma unroll
            for (int mt = 0; mt < 4; ++mt)
#pragma unroll
                for (int k = 0; k < 2; ++k) af[mt][k] = *(const LAS bf16x8*)(lds + RC_XC + d * RC_T + (16 * (l15 >> 2) + 4 * mt + (l15 & 3)) * 144 + (32 * k + 8 * G4) * 2);
            f32x4 ra[4], xa[4];
#pragma unroll
            for (int mt = 0; mt < 4; ++mt) { ra[mt] = (f32x4){0.f, 0.f, 0.f, 0.f}; xa[mt] = (f32x4){0.f, 0.f, 0.f, 0.f};
#pragma unroll
                for (int k = 0; k < 2; ++k) { ra[mt] = __builtin_amdgcn_mfma_f32_16x16x32_bf16(af[mt][k], F[k], ra[mt], 0, 0, 0); xa[mt] = __builtin_amdgcn_mfma_f32_16x16x32_bf16(af[mt][k], F[2 + k], xa[mt], 0, 0, 0); } }
            float av[16], bv[16];
#pragma unroll
            for (int t = 0; t < 16; ++t) {
                const float r = sigmoidf_(ra[t >> 2][t & 3] + bav), ig = sigmoidf_(xa[t >> 2][t & 3] + bxv);
                const float a = fexp(cf * r);
                av[t] = a; bv[t] = fsqrt(fmaxf(1.0f - a * a, 0.f)) * ig * bf2f(*(const LAS bf16_t*)(lds + RC_XC + d * RC_T + (16 * G4 + t) * 144 + (16 * cg + l15) * 2));
            }
            float Al = 1.f, Bl = 0.f;
            if (d == 0) {
#pragma unroll
                for (int t = 0; t < 16; ++t) { Bl = av[t] * Bl + bv[t]; Al *= av[t]; }
            } else {
#pragma unroll
                for (int t = 15; t >= 0; --t) { Bl = av[t] * Bl + bv[t]; Al *= av[t]; }
            }
            float Ag[4], Bg[4];
#pragma unroll
            for (int g = 0; g < 4; ++g) { Ag[g] = __shfl(Al, l15 + 16 * g); Bg[g] = __shfl(Bl, l15 + 16 * g); }
            float h = hcar, hend;
            if (d == 0) {
                const float s1 = Ag[0] * h + Bg[0], s2 = Ag[1] * s1 + Bg[1], s3 = Ag[2] * s2 + Bg[2]; hend = Ag[3] * s3 + Bg[3];
                h = G4 == 0 ? h : G4 == 1 ? s1 : G4 == 2 ? s2 : s3;
            } else {
                const float s2 = Ag[3] * h + Bg[3], s1 = Ag[2] * s2 + Bg[2], s0 = Ag[1] * s1 + Bg[1]; hend = Ag[0] * s0 + Bg[0];
                h = G4 == 3 ? h : G4 == 2 ? s2 : G4 == 1 ? s1 : s0;
            }
            hcar = hend;
            if (role != 0) {
                float hv[16];
                if (d == 0) {
#pragma unroll
                    for (int t = 0; t < 16; ++t) { h = av[t] * h + bv[t]; hv[t] = h; }
                } else {
#pragma unroll
                    for (int t = 15; t >= 0; --t) { h = av[t] * h + bv[t]; hv[t] = h; }
                }
#pragma unroll
                for (int t = 0; t < 16; ++t) {
                    const int off = (16 * G4 + t) * 144 + (16 * cg + l15) * 2;
                    float o = hv[t];
                    if (role == 2) o = gelu_tanh(bf2f(*(const LAS bf16_t*)(lds + RC_RG + d * RC_T + off))) * (o + bf2f(*(const LAS bf16_t*)(lds + RC_HI + d * RC_T + off)));
                    *(LAS bf16_t*)(lds + RC_OUT + d * RC_T + off) = f2bf(o);
                }
            }
        }
        __syncthreads();
        if (role != 0) {
#pragma unroll
            for (int j = 0; j < 2; ++j) { const int q = t8 * 2 + j; const u32x4 v = *(const LAS u32x4*)(lds + RC_OUT + ds * RC_T + (q >> 3) * 144 + (q & 7) * 16);
                if (role == 1) *(u32x4*)(HT + RC_ROW(s, q) * RGW + 64 * hd + (q & 7) * 8) = v;
                else *(u32x4*)(MIX + RC_ROW(s, q) * D + HGW + 64 * hd + (q & 7) * 8) = v; }
        }
    }
#undef RC_CHUNK
#undef RC_LOAD_RX
#undef RC_ROW
#undef RC_LOAD_RG
#undef RC_LOAD_HI
}

__device__ __forceinline__ void phase_mix_finish(const bf16_t* __restrict__ P, const bf16_t* __restrict__ OF, const bf16_t* __restrict__ OB,
                                                 const float* __restrict__ hg_nw, bf16_t* __restrict__ MIX, int bid, int G) {
    constexpr int RB = 4;
    const int lane = threadIdx.x & 63, gw = bid * 8 + (threadIdx.x >> 6), NW = G * 8, c0 = lane * 8;
    const f32x4 nw0 = *(const f32x4*)(hg_nw + c0), nw1 = *(const f32x4*)(hg_nw + c0 + 4);
    const float nwv[8] = {nw0[0], nw0[1], nw0[2], nw0[3], nw1[0], nw1[1], nw1[2], nw1[3]};
    for (int r0 = gw; r0 < NLAT; r0 += RB * NW) {
        u32x4 a4[RB], b4[RB], g4[RB];
#pragma unroll
        for (int q = 0; q < RB; ++q) { const int r = r0 + q * NW; const int rr = r < NLAT ? r : r0;
            a4[q] = *(const u32x4*)(OF + (size_t)rr * HGW + c0); b4[q] = *(const u32x4*)(OB + (size_t)rr * HGW + c0); g4[q] = *(const u32x4*)(P + (size_t)rr * INW + C_G + c0); }
#pragma unroll
        for (int q = 0; q < RB; ++q) { const int r = r0 + q * NW; if (r < NLAT) {
            float o[8]; float ss = 0.f;
#pragma unroll
            for (int i = 0; i < 4; ++i) { o[2 * i] = __uint_as_float(a4[q][i] << 16) + __uint_as_float(b4[q][i] << 16); o[2 * i + 1] = __uint_as_float(a4[q][i] & 0xffff0000u) + __uint_as_float(b4[q][i] & 0xffff0000u); }
#pragma unroll
            for (int i = 0; i < 8; ++i) ss += o[i] * o[i];
            ss += __shfl_xor(ss, 1); ss += __shfl_xor(ss, 2); ss += __shfl_xor(ss, 4); ss += __shfl_xor(ss, 8);
            const float rstd = __builtin_amdgcn_rsqf(ss * (1.0f / 128.0f) + EPS);
            u32x4 w;
#pragma unroll
            for (int i = 0; i < 4; ++i) {
                const float g0 = __uint_as_float(g4[q][i] << 16), g1 = __uint_as_float(g4[q][i] & 0xffff0000u);
                w[i] = cvt_pk_bf16(o[2 * i] * rstd * nwv[2 * i] * (g0 * sigmoidf_(g0)), o[2 * i + 1] * rstd * nwv[2 * i + 1] * (g1 * sigmoidf_(g1)));
            }
            *(u32x4*)(MIX + (size_t)r * D + c0) = w;
        } }
    }
}

__device__ __forceinline__ void phase_norm2_route(LAS unsigned char* lds, const bf16_t* __restrict__ x1, const float* __restrict__ nw, const float* __restrict__ mod,
                                                  const float* __restrict__ rw, const float* __restrict__ rb, fp8_t* __restrict__ H2,
                                                  u32* __restrict__ cnt, u32* __restrict__ toktab, float* __restrict__ wtab, int bid, int G) {
    LAS float* rwT = (LAS float*)lds;
    LAS u32* hist = (LAS u32*)(lds + 131072);
    LAS u32* ent = (LAS u32*)(lds + 131072 + 4096);
    const int tid = threadIdx.x, lane = tid & 63, w = tid >> 6;
    for (int i = tid; i < 32 * 1024; i += 512) { const int k = i >> 5, e = i & 31; rwT[e * 1024 + k] = rw[i]; }
    if (tid < 128) hist[tid] = 0;
    __syncthreads();
    const int gw = bid * 8 + w, NW = G * 8;
    const int myexp = ((lane >> 5) & 1) * 16 + ((lane >> 4) & 1) * 8 + ((lane >> 3) & 1) * 4 + ((lane >> 2) & 1) * 2 + ((lane >> 1) & 1);
    const float myrb = rb[myexp];
    int it = 0;
    u32x2 rawn[2][4];
#pragma unroll
    for (int q = 0; q < 2; ++q)
#pragma unroll
        for (int j = 0; j < 4; ++j) rawn[q][j] = __builtin_nontemporal_load((const u32x2*)(x1 + (size_t)(gw + q * NW) * D + j * 256 + lane * 4));
    for (int r0 = gw; r0 < NLAT; r0 += 2 * NW, it += 2) {
        f32x4 v[2][4];
        u32x2 rawc[2][4];
#pragma unroll
        for (int q = 0; q < 2; ++q)
#pragma unroll
            for (int j = 0; j < 4; ++j) rawc[q][j] = rawn[q][j];
        { const int rn0 = r0 + 2 * NW < NLAT ? r0 + 2 * NW : r0;
#pragma unroll
          for (int q = 0; q < 2; ++q)
#pragma unroll
            for (int j = 0; j < 4; ++j) rawn[q][j] = __builtin_nontemporal_load((const u32x2*)(x1 + (size_t)(rn0 + q * NW) * D + j * 256 + lane * 4)); }
#pragma unroll
        for (int q = 0; q < 2; ++q) {
            const int r = r0 + q * NW;
            const float* m = mod + (size_t)(r >> 11) * 6144;
            u32x2 raw[4];
#pragma unroll
            for (int j = 0; j < 4; ++j) raw[j] = rawc[q][j];
            float ss = 0.f;
#pragma unroll
            for (int j = 0; j < 4; ++j) { v[q][j][0] = __uint_as_float(raw[j].x << 16); v[q][j][1] = __uint_as_float(raw[j].x & 0xffff0000u); v[q][j][2] = __uint_as_float(raw[j].y << 16); v[q][j][3] = __uint_as_float(raw[j].y & 0xffff0000u);
                ss += v[q][j][0] * v[q][j][0] + v[q][j][1] * v[q][j][1] + v[q][j][2] * v[q][j][2] + v[q][j][3] * v[q][j][3]; }
            const float rstd = __builtin_amdgcn_rsqf(wave_sum(ss) * (1.0f / D) + EPS);
#pragma unroll
            for (int j = 0; j < 4; ++j) {
                const int c0 = j * 256 + lane * 4;
                const f32x4 ww = *(const f32x4*)(nw + c0), sh = *(const f32x4*)(m + 3072 + c0), sc = *(const f32x4*)(m + 4096 + c0);
                v[q][j] = v[q][j] * rstd * ww * (sc + 1.0f) + sh;
                *(unsigned*)(H2 + (size_t)r * D + c0) = pk4_fp8(v[q][j][0] * SC_H2, v[q][j][1] * SC_H2, v[q][j][2] * SC_H2, v[q][j][3] * SC_H2);
            }
        }
        float part[2][32];
#pragma unroll
        for (int e = 0; e < 32; ++e) {
            float p0 = 0.f, p1 = 0.f;
#pragma unroll
            for (int j = 0; j < 4; ++j) { const f32x4 q = *(const LAS f32x4*)(rwT + e * 1024 + j * 256 + lane * 4);
                p0 += v[0][j][0] * q[0] + v[0][j][1] * q[1] + v[0][j][2] * q[2] + v[0][j][3] * q[3]; p1 += v[1][j][0] * q[0] + v[1][j][1] * q[1] + v[1][j][2] * q[2] + v[1][j][3] * q[3]; }
            part[0][e] = p0; part[1][e] = p1;
        }
#define RT_STEP(N, M) { const bool up = (lane & (M)) != 0; _Pragma("unroll") for (int q = 0; q < 2; ++q) _Pragma("unroll") for (int i = 0; i < (N); ++i) { const float keep = up ? part[q][(N) + i] : part[q][i], send = up ? part[q][i] : part[q][(N) + i]; part[q][i] = keep + __shfl_xor(send, (M)); } }
        RT_STEP(16, 32) RT_STEP(8, 16) RT_STEP(4, 8) RT_STEP(2, 4) RT_STEP(1, 2)
#undef RT_STEP
#pragma unroll
        for (int q = 0; q < 2; ++q) {
            const int r = r0 + q * NW;
            const float mylogit = part[q][0] + __shfl_xor(part[q][0], 1) + myrb;
            int rank = 0;
#pragma unroll
            for (int x = 0; x < 32; ++x) {
                const int src = ((x >> 4) & 1) * 32 + ((x >> 3) & 1) * 16 + ((x >> 2) & 1) * 8 + ((x >> 1) & 1) * 4 + (x & 1) * 2;
                const float oq = __builtin_bit_cast(float, __builtin_amdgcn_readlane(__builtin_bit_cast(int, mylogit), src));
                rank += (oq > mylogit || (oq == mylogit && x < myexp)) ? 1 : 0;
            }
            float tv[4]; int ti[4];
#pragma unroll
            for (int k = 0; k < 4; ++k) {
                const unsigned long long mk = __ballot(rank == k && (lane & 1) == 0);
                const int src = __builtin_amdgcn_readfirstlane((int)__builtin_ctzll(mk));
                tv[k] = __builtin_bit_cast(float, __builtin_amdgcn_readlane(__builtin_bit_cast(int, mylogit), src));
                ti[k] = ((src >> 5) & 1) * 16 + ((src >> 4) & 1) * 8 + ((src >> 3) & 1) * 4 + ((src >> 2) & 1) * 2 + ((src >> 1) & 1);
            }
            const float e1 = fexp(tv[1] - tv[0]), e2 = fexp(tv[2] - tv[0]), e3 = fexp(tv[3] - tv[0]); const float inv = frcp(1.0f + e1 + e2 + e3);
            const float g0 = inv, g1 = e1 * inv, g2 = e2 * inv, g3 = e3 * inv;
            if (lane < 4) {
                const int half = r >= HALF_TOK ? 1 : 0;
                const int e = lane == 0 ? ti[0] : lane == 1 ? ti[1] : lane == 2 ? ti[2] : ti[3];
                const float gv = lane == 0 ? g0 : lane == 1 ? g1 : lane == 2 ? g2 : g3;
                const u32 lp = atomicAdd((u32*)&hist[half * 32 + e], 1u);
                const int idx = ((it + q) * 8 + w) * 4 + lane;
                ent[idx * 2] = ((u32)e << 24) | lp; ent[idx * 2 + 1] = __float_as_uint(gv);
            }
        }
    }
    __syncthreads();
    if (tid < 64) hist[64 + tid] = atomicAdd(&cnt[tid], hist[tid]);
    __syncthreads();
    it = 0;
    for (int r = gw; r < NLAT; r += NW, ++it) {
        if (lane < 4) {
            const int half = r >= HALF_TOK ? 1 : 0; const int idx = (it * 8 + w) * 4 + lane;
            const u32 ev = ent[idx * 2]; const int e = ev >> 24; const u32 pos = hist[64 + half * 32 + e] + (ev & 0xffffffu);
            toktab[((size_t)half * 32 + e) * CAP + pos] = (u32)r * 4u + lane;
            wtab[((size_t)half * 32 + e) * CAP + pos] = __uint_as_float(ent[idx * 2 + 1]);
        }
    }
}

__device__ __forceinline__ void phase_combine(float* __restrict__ out, const bf16_t* __restrict__ X1, const fp8_t* __restrict__ Y, const float* __restrict__ mod, const float* __restrict__ fw, int bid, int G) {
    constexpr int RB = 2;
    typedef float f32x2_ __attribute__((ext_vector_type(2)));
    const int lane = threadIdx.x & 63, gw = bid * 8 + (threadIdx.x >> 6), NW = G * 8;
    for (int r0 = gw; r0 < NLAT; r0 += RB * NW) {
        u32x2 xv[RB][4]; unsigned yv[RB][4][4];
#pragma unroll
        for (int q = 0; q < RB; ++q) { const int r = r0 + q * NW < NLAT ? r0 + q * NW : r0;
#pragma unroll
            for (int j = 0; j < 4; ++j) { xv[q][j] = __builtin_nontemporal_load((const u32x2*)(X1 + (size_t)r * D + j * 256 + lane * 4));
#pragma unroll
                for (int k = 0; k < 4; ++k) yv[q][j][k] = __builtin_nontemporal_load((const unsigned*)(Y + ((size_t)r * 4 + k) * D + j * 256 + lane * 4)); } }
#pragma unroll
        for (int q = 0; q < RB; ++q) { const int r = r0 + q * NW; if (r < NLAT) {
            const float* g2 = mod + (size_t)(r >> 11) * 6144 + 5120;
            f32x4 v[4]; float ss = 0.f;
#pragma unroll
            for (int j = 0; j < 4; ++j) { const int c0 = j * 256 + lane * 4;
                f32x4 sm = (f32x4){0.f, 0.f, 0.f, 0.f};
#pragma unroll
                for (int k = 0; k < 4; ++k) { const f32x2_ lo = __builtin_amdgcn_cvt_pk_f32_fp8(yv[q][j][k], false), hi = __builtin_amdgcn_cvt_pk_f32_fp8(yv[q][j][k], true); sm[0] += lo[0]; sm[1] += lo[1]; sm[2] += hi[0]; sm[3] += hi[1]; }
                const f32x4 g = *(const f32x4*)(g2 + c0);
                v[j][0] = __uint_as_float(xv[q][j].x << 16); v[j][1] = __uint_as_float(xv[q][j].x & 0xffff0000u); v[j][2] = __uint_as_float(xv[q][j].y << 16); v[j][3] = __uint_as_float(xv[q][j].y & 0xffff0000u);
                v[j] = v[j] + g * sm * (1.0f / SC_Y);
                ss += v[j][0] * v[j][0] + v[j][1] * v[j][1] + v[j][2] * v[j][2] + v[j][3] * v[j][3]; }
            const float rstd = __builtin_amdgcn_rsqf(wave_sum(ss) * (1.0f / D) + EPS);
#pragma unroll
            for (int j = 0; j < 4; ++j) { const int c0 = j * 256 + lane * 4; const f32x4 w = *(const f32x4*)(fw + c0); __builtin_nontemporal_store(v[j] * rstd * w, (f32x4*)(out + (size_t)r * D + c0)); }
        } }
    }
}

#define XB_TMO      128
#define XB_XCNT(j)  (256  + 64 * (j))
#define XB_XSUB(j)  (1280 + 64 * (j))
#define XB_XGEN(j)  (2304 + 64 * (j))
#define XB_TOP      3328
#define XB_TOPGEN   3392
#define XCD_BAR_WORDS 3456
#define XB_SPIN_CAP (1u << 20)
__device__ __forceinline__ unsigned xb_ld(unsigned* p)              { return __hip_atomic_load(p, __ATOMIC_RELAXED, __HIP_MEMORY_SCOPE_AGENT); }
__device__ __forceinline__ unsigned xb_add(unsigned* p, unsigned v) { return __hip_atomic_fetch_add(p, v, __ATOMIC_RELAXED, __HIP_MEMORY_SCOPE_AGENT); }
__device__ __forceinline__ unsigned xb_xcc_id() { return (unsigned)__builtin_amdgcn_s_getreg((3 << 11) | 20) & 0xFu; }
#define XB_SPIN(cond, bar) do { unsigned _sp = 0; while (cond) { __builtin_amdgcn_s_sleep(1); \
    if ((++_sp & 255u) == 0u) { if (xb_ld(&(bar)[XB_TMO])) break; if (_sp > XB_SPIN_CAP) { atomicAdd(&(bar)[XB_TMO], 1u); break; } } } } while (0)
struct XcdBarrier { unsigned* bar; unsigned x; volatile LAS unsigned* st; };
__device__ __forceinline__ XcdBarrier xcd_barrier_post(unsigned* bar, volatile LAS unsigned* st) {
    XcdBarrier b; b.bar = bar; b.x = xb_xcc_id(); b.st = st;
    if (threadIdx.x == 0) (void)xb_add(&bar[XB_XCNT(b.x)], 1u);
    return b;
}
__device__ __forceinline__ void xcd_barrier_complete(unsigned* bar, unsigned x, unsigned& nloc, unsigned& nx) {
    const unsigned G = gridDim.x * gridDim.y * gridDim.z;
    unsigned sum, cnt, mine, sp = 0u;
    for (;;) {
        sum = 0u; cnt = 0u; mine = 0u;
#pragma unroll
        for (unsigned j = 0; j < 16; ++j) { const unsigned c = xb_ld(&bar[XB_XCNT(j)]); sum += c; cnt += (c > 0u) ? 1u : 0u; mine = (j == x) ? c : mine; }
        if (sum == G) break;
        __builtin_amdgcn_s_sleep(1);
        if ((++sp & 255u) == 0u) { if (xb_ld(&bar[XB_TMO])) break; if (sp > XB_SPIN_CAP) { atomicAdd(&bar[XB_TMO], 1u); break; } }
    }
    nloc = mine > 0u ? mine : 1u; nx = cnt > 0u ? cnt : 1u;
}
__device__ __forceinline__ void xcd_barrier(unsigned* bar, volatile LAS unsigned* st) {
    asm volatile("s_waitcnt vmcnt(0)" ::: "memory");
    __syncthreads();
    if (threadIdx.x == 0) {
        __builtin_amdgcn_s_waitcnt(0);
        const unsigned x = xb_xcc_id();
        unsigned nloc = st[0], nx = st[1];
        if (nloc == 0u) { xcd_barrier_complete(bar, x, nloc, nx); st[0] = nloc; st[1] = nx; }
        const unsigned old = xb_add(&bar[XB_XSUB(x)], 1u);
        const unsigned gen = old / nloc;
        if (old + 1u == (gen + 1u) * nloc) {
            __builtin_amdgcn_fence(__ATOMIC_RELEASE, "agent");
            asm volatile("s_waitcnt vmcnt(0)" ::: "memory");
            const unsigned og = xb_add(&bar[XB_TOP], 1u);
            const unsigned tg = og / nx;
            if (og + 1u == (tg + 1u) * nx) xb_add(&bar[XB_TOPGEN], 1u);
            else XB_SPIN(xb_ld(&bar[XB_TOPGEN]) == tg, bar);
            __builtin_amdgcn_fence(__ATOMIC_ACQUIRE, "agent");
            xb_add(&bar[XB_XGEN(x)], 1u);
            asm volatile("s_waitcnt vmcnt(0)" ::: "memory");
        } else {
            XB_SPIN(xb_ld(&bar[XB_XGEN(x)]) == gen, bar);
            __builtin_amdgcn_fence(__ATOMIC_ACQUIRE, "agent");
            asm volatile("s_waitcnt vmcnt(0)" ::: "memory");
        }
    }
    __syncthreads();
}
constexpr size_t WS_BAR = 16384;
constexpr int LDS_BARST = LDS_BYTES - 16;

struct MegaArgs {
    const float *x, *c, *ctx, *c_ctx, *norm1_w, *norm2_w, *w_ada, *b_ada, *w_in, *lbl, *hg_nw, *conv_w, *conv_b, *rg_wa, *rg_ba, *rg_wx, *rg_bx, *rg_lam, *w_out,
        *router_w, *router_b, *wgu, *bgu, *wd, *bd, *final_w;
    float* out; unsigned char* ws;
};
typedef const MegaArgs __attribute__((address_space(4)))* KArgs;
__device__ __forceinline__ KArgs kargs() { auto p = __builtin_amdgcn_kernarg_segment_ptr(); asm volatile("" : "+s"(p)); return (KArgs)p; }
#define WSP(T, off) ((T*)(ws + (off)))
#define GRID_SYNC_CG() cg::this_grid().sync()
#define GRID_SYNC() do { KArgs a_ = kargs(); xcd_barrier((unsigned*)(a_->ws + WS_BAR), (volatile LAS unsigned*)(lds + LDS_BARST)); } while (0)
__global__ __launch_bounds__(512, 2) void k_mega(MegaArgs a_unused) {
    extern __shared__ __attribute__((aligned(16))) unsigned char lds_[];
    LAS unsigned char* lds = (LAS unsigned char*)lds_;
    if (threadIdx.x < 4) ((volatile LAS unsigned*)(lds + LDS_BARST))[threadIdx.x] = 0u;
    __syncthreads();
    { KArgs a = kargs(); (void)xcd_barrier_post((unsigned*)(a->ws + WS_BAR), (volatile LAS unsigned*)(lds + LDS_BARST)); }
    { KArgs a = kargs(); unsigned char* ws = a->ws; const int bid = blockIdx.x, G = gridDim.x;
      ProArgs pa; pa.c = a->c; pa.c_ctx = a->c_ctx; pa.w_ada = a->w_ada; pa.b_ada = a->b_ada; pa.lbl = a->lbl; pa.w_in = a->w_in; pa.w_out = a->w_out; pa.wgu = a->wgu; pa.wd = a->wd; pa.rg_wa = a->rg_wa; pa.rg_wx = a->rg_wx; pa.rg_lam = a->rg_lam;
      pa.coef = WSP(float, WS_COEF); pa.WG_t = WSP(bf16_t, WS_WG); pa.mod = WSP(float, WS_MOD); pa.lb = WSP(float, WS_LB); pa.Win_t = WSP(bf16_t, WS_WIN); pa.Wout_t = WSP(bf16_t, WS_WOUT); pa.Wgu_t = WSP(fp8_t, WS_WGU); pa.Wd_t = WSP(fp8_t, WS_WD);
      phase_prologue(lds, pa, bid, G, true, 0, 0); }
    { KArgs a_ = kargs(); if (a_->ws == nullptr) GRID_SYNC_CG(); }
    GRID_SYNC();
    { KArgs a = kargs(); unsigned char* ws = a->ws; phase_norm1(a->x, a->ctx, a->norm1_w, WSP(float, WS_MOD), WSP(bf16_t, WS_H), blockIdx.x, gridDim.x); }
    { KArgs a = kargs(); unsigned char* ws = a->ws;
      ProArgs pa; pa.c = nullptr; pa.c_ctx = nullptr; pa.w_ada = nullptr; pa.b_ada = nullptr; pa.lbl = nullptr; pa.w_in = a->w_in; pa.w_out = a->w_out; pa.wgu = nullptr; pa.wd = nullptr; pa.rg_wa = nullptr; pa.rg_wx = nullptr; pa.rg_lam = nullptr; pa.coef = nullptr; pa.WG_t = nullptr;
      pa.mod = nullptr; pa.lb = nullptr; pa.Win_t = WSP(bf16_t, WS_WIN); pa.Wout_t = WSP(bf16_t, WS_WOUT); pa.Wgu_t = nullptr; pa.Wd_t = nullptr;
      phase_prologue(lds, pa, blockIdx.x, gridDim.x, false, 0, IT_IN + IT_OUT); }
    GRID_SYNC();
    { KArgs a = kargs(); unsigned char* ws = a->ws; PolInProj P; P.A = WSP(bf16_t, WS_H); P.Bt = WSP(bf16_t, WS_WIN); P.O = WSP(bf16_t, WS_PROJ); P.ord.init(NLAT / BM, INW / BM, gridDim.x, blockIdx.x); gemm_phase(lds, P); }
    GRID_SYNC();
    { KArgs a = kargs(); unsigned char* ws = a->ws;
      for (int item = blockIdx.x; item < 256; item += gridDim.x)
          phase_rg_chain(lds, WSP(bf16_t, WS_PROJ), a->conv_w, a->conv_b, WSP(bf16_t, WS_WG), a->rg_ba, a->rg_bx, WSP(float, WS_COEF), WSP(bf16_t, WS_HF), WSP(bf16_t, WS_MIX2), item); }
    __syncthreads();
    { KArgs a = kargs(); unsigned char* ws = a->ws;
      for (int item = blockIdx.x; item < 256; item += gridDim.x) phase_hgrn2_ws(lds, WSP(bf16_t, WS_PROJ), WSP(float, WS_LB), WSP(bf16_t, WS_OF), WSP(bf16_t, WS_OB), item); }
    GRID_SYNC();
    { KArgs a = kargs(); unsigned char* ws = a->ws; phase_mix_finish(WSP(bf16_t, WS_PROJ), WSP(bf16_t, WS_OF), WSP(bf16_t, WS_OB), a->hg_nw, WSP(bf16_t, WS_MIX2), blockIdx.x, gridDim.x); }
    GRID_SYNC();
    { KArgs a = kargs(); unsigned char* ws = a->ws; PolOutProj P; P.A = WSP(bf16_t, WS_MIX2); P.Bt = WSP(bf16_t, WS_WOUT); P.x = a->x; P.mod = WSP(float, WS_MOD); P.O = WSP(bf16_t, WS_X1); P.ord.init(NLAT / BM, D / BM, gridDim.x, blockIdx.x); gemm_phase(lds, P); }
    GRID_SYNC();
    { KArgs a = kargs(); unsigned char* ws = a->ws;
      phase_norm2_route(lds, WSP(bf16_t, WS_X1), a->norm2_w, WSP(float, WS_MOD), a->router_w, a->router_b, WSP(fp8_t, WS_H2), WSP(u32, WS_CTL), WSP(u32, WS_TOKTAB), WSP(float, WS_WTAB), blockIdx.x, gridDim.x); }
    __syncthreads();
    { KArgs a = kargs(); unsigned char* ws = a->ws;
      ProArgs pa; pa.c = nullptr; pa.c_ctx = nullptr; pa.w_ada = nullptr; pa.b_ada = nullptr; pa.lbl = nullptr; pa.w_in = nullptr; pa.w_out = nullptr; pa.wgu = a->wgu; pa.wd = a->wd; pa.rg_wa = nullptr; pa.rg_wx = nullptr; pa.rg_lam = nullptr; pa.coef = nullptr; pa.WG_t = nullptr;
      pa.mod = nullptr; pa.lb = nullptr; pa.Win_t = nullptr; pa.Wout_t = nullptr; pa.Wgu_t = WSP(fp8_t, WS_WGU); pa.Wd_t = WSP(fp8_t, WS_WD);
      phase_prologue(lds, pa, blockIdx.x, gridDim.x, false, IT_IN + IT_OUT, IT_ALL); }
    GRID_SYNC();
#pragma unroll 1
    for (int half = 0; half < NHALF; ++half) {
        { KArgs a = kargs(); unsigned char* ws = a->ws; LAS int* tstart = (LAS int*)(lds + LDS_AUX);
          const int tot = moe_tile_table(tstart, WSP(u32, WS_CTL), half);
          PolGateUp P; P.A = WSP(fp8_t, WS_H2); P.Bt = WSP(fp8_t, WS_WGU); P.bgu = a->bgu; P.toktab = WSP(u32, WS_TOKTAB); P.wtab = WSP(float, WS_WTAB); P.O = WSP(fp8_t, WS_ACT); P.mt.tstart = tstart; P.mt.cnt = WSP(u32, WS_CTL); P.mt.half = half;
          P.ord.init(tot, DFF / HALFT, gridDim.x, blockIdx.x);
          gemm_phase(lds, P); }
        GRID_SYNC();
        { KArgs a = kargs(); unsigned char* ws = a->ws; LAS int* tstart = (LAS int*)(lds + LDS_AUX);
          const int tot = moe_tile_table(tstart, WSP(u32, WS_CTL), half);
          PolDown P; P.A = WSP(fp8_t, WS_ACT); P.Bt = WSP(fp8_t, WS_WD); P.bd = a->bd; P.toktab = WSP(u32, WS_TOKTAB); P.wtab = WSP(float, WS_WTAB); P.O = WSP(fp8_t, WS_Y); P.mt.tstart = tstart; P.mt.cnt = WSP(u32, WS_CTL); P.mt.half = half;
          P.ord.init(tot, D / BM, gridDim.x, blockIdx.x);
          gemm_phase(lds, P); }
        GRID_SYNC();
        { KArgs a = kargs(); unsigned char* ws = a->ws; phase_combine(a->out, WSP(bf16_t, WS_X1), WSP(fp8_t, WS_Y), WSP(float, WS_MOD), a->final_w, blockIdx.x, gridDim.x); }
        __syncthreads();
    }
}

extern "C" void kernel_launch(void* const* d_in, const int* in_sizes, int n_in, void* d_out, int out_size, void* d_ws, size_t ws_size, hipStream_t stream) {
    static int grid_blocks = 0;
    if (!grid_blocks) {
        int dev = 0, cus = 0, per_cu = 0;
        (void)hipGetDevice(&dev);
        (void)hipDeviceGetAttribute(&cus, hipDeviceAttributeMultiprocessorCount, dev);
        (void)hipFuncSetAttribute((const void*)k_mega, hipFuncAttributeMaxDynamicSharedMemorySize, LDS_BYTES);
        (void)hipOccupancyMaxActiveBlocksPerMultiprocessor(&per_cu, (const void*)k_mega, 512, LDS_BYTES);
        if (per_cu < 1) { fprintf(stderr, "kernel_launch: occupancy query says %d blocks/CU\n", per_cu); per_cu = 1; }
        grid_blocks = cus * 1;
    }
    if (ws_size < 1024 * MiB) { fprintf(stderr, "kernel_launch: workspace too small (%zu)\n", ws_size); return; }
    MegaArgs a{};
    const float** ap = (const float**)&a;
    for (int i = 0; i < 26; ++i) ap[i] = (const float*)d_in[i];
    a.out = (float*)d_out; a.ws = (unsigned char*)d_ws;
    (void)hipMemsetAsync((unsigned char*)d_ws + WS_CTL, 0, 32768, stream);
    void* args[] = {&a};
    hipError_t e = hipLaunchCooperativeKernel((const void*)k_mega, dim3(grid_blocks), dim3(512), args, LDS_BYTES, stream);
    if (e != hipSuccess) fprintf(stderr, "cooperative launch failed: %s (grid %d)\n", hipGetErrorString(e), grid_blocks);
}
```

```cpp
#include <hip/hip_runtime.h>
#include <hip/hip_cooperative_groups.h>
#include <cstdio>
#include <cstdint>

typedef unsigned short bf16_t;
typedef unsigned int u32;
namespace cg = cooperative_groups;

constexpr int D = 1024, NB = 32, T = 2048, CTXL = 256, GRIDW = 64, GROWS = T / GRIDW;
constexpr int NLAT = NB * T;
constexpr int NCTX = NB * CTXL;
constexpr int NROWS = NLAT + NCTX;
constexpr int HGW = 512, RGW = 512, INW = 3584;
constexpr int C_Q = 0, C_I = 512, C_FF = 1024, C_FB = 1536, C_G = 2048, C_RX = 2560, C_RG = 3072;
constexpr int NE = 32, TOPK = 4, DFF = 1024;
constexpr int NCHK = (CTXL + T) / 64;
constexpr int NHALF = 1;
constexpr int HALF_TOK = NLAT / NHALF;
constexpr int CAP = HALF_TOK;
constexpr int MAXSLOT = HALF_TOK * TOPK + NE * 256;
constexpr float EPS = 1e-6f;

constexpr size_t MiB = 1u << 20;
constexpr size_t WS_CTL = 0;
constexpr size_t WS_WG = 64 * 1024;
constexpr size_t WS_MOD = 1 * MiB;
constexpr size_t WS_LB = WS_MOD + 33 * 6144 * 4;
constexpr size_t WS_COEF = WS_LB + 4096;
constexpr size_t WS_TOKTAB = 2 * MiB;
constexpr size_t WS_WTAB = 10 * MiB;
constexpr size_t WS_WIN = 18 * MiB, WS_WOUT = 25 * MiB;
constexpr size_t WS_OF = 28 * MiB, WS_OB = 92 * MiB;
constexpr size_t WS_HF = 156 * MiB;
constexpr size_t WS_H = 284 * MiB;
constexpr size_t WS_MIX2 = WS_H;
constexpr size_t WS_PROJ = 428 * MiB;
constexpr size_t WS_H2 = 28 * MiB;
constexpr size_t WS_WGU = 92 * MiB, WS_WD = 156 * MiB;
constexpr size_t WS_ACT = 188 * MiB;
constexpr size_t WS_Y = 452 * MiB;
constexpr size_t WS_X1 = 708 * MiB;
constexpr float SC_Y = 16.0f;

__device__ __forceinline__ float bf2f(bf16_t b) { return __uint_as_float(((u32)b) << 16); }
__device__ __forceinline__ bf16_t f2bf(float f) { u32 u = __float_as_uint(f); u += 0x7fffu + ((u >> 16) & 1u); return (bf16_t)(u >> 16); }
__device__ __forceinline__ u32 pk2(float lo, float hi) { return (u32)f2bf(lo) | ((u32)f2bf(hi) << 16); }
__device__ __forceinline__ float fexp(float x) { return __builtin_amdgcn_exp2f(x * 1.4426950408889634f); }
__device__ __forceinline__ float frcp(float x) { return __builtin_amdgcn_rcpf(x); }
__device__ __forceinline__ float flog(float x) { return __builtin_amdgcn_logf(x) * 0.6931471805599453f; }
__device__ __forceinline__ float fsqrt(float x) { return __builtin_amdgcn_sqrtf(x); }
__device__ __forceinline__ float sigmoidf_(float x) { return frcp(1.0f + fexp(-x)); }
__device__ __forceinline__ float wave_sum(float v) {
#pragma unroll
    for (int o = 1; o < 64; o <<= 1) v += __shfl_xor(v, o);
    return v;
}

__device__ __forceinline__ float gelu_tanh(float x) { const float u = 1.5957691216057308f * (x + 0.044715f * x * x * x); return x * sigmoidf_(u); }
#define LAS __attribute__((address_space(3)))
typedef short bf16x8 __attribute__((ext_vector_type(8)));
typedef float f32x4 __attribute__((ext_vector_type(4)));
typedef unsigned u32x4 __attribute__((ext_vector_type(4)));
typedef int v8i __attribute__((ext_vector_type(8)));
typedef int v4i_ __attribute__((ext_vector_type(4)));
typedef unsigned u32x2 __attribute__((ext_vector_type(2)));
typedef float f32x2 __attribute__((ext_vector_type(2)));
typedef unsigned char fp8_t;
constexpr float SC_H2 = 16.0f, SC_W = 32.0f, SC_ACT = 4.0f;
__device__ __forceinline__ unsigned pk4_fp8(float a, float b, float c, float d) {
    a = fminf(fmaxf(a, -448.f), 448.f); b = fminf(fmaxf(b, -448.f), 448.f); c = fminf(fmaxf(c, -448.f), 448.f); d = fminf(fmaxf(d, -448.f), 448.f);
    int r = 0; r = __builtin_amdgcn_cvt_pk_fp8_f32(a, b, r, false); r = __builtin_amdgcn_cvt_pk_fp8_f32(c, d, r, true); return (unsigned)r; }
__device__ __forceinline__ unsigned pk4_fp8_nc(float a, float b, float c, float d) { int r = 0; r = __builtin_amdgcn_cvt_pk_fp8_f32(a, b, r, false); r = __builtin_amdgcn_cvt_pk_fp8_f32(c, d, r, true); return (unsigned)r; }
constexpr int BM = 256, BK = 64, HALFT = 128, HTB = HALFT * BK * 2, STAGE_BYTES = 8 * HTB, NXCD = 8, WGM = 8;
constexpr int GK = 1024;
constexpr int LDS_BYTES = 147456;
constexpr int LDS_AUX = STAGE_BYTES;

__device__ __forceinline__ int lds_byte(int r, int c) { const int st = (r >> 4) * 2 + (c >> 5), rr = r & 15, cc = c & 31, ob = rr * 64 + cc * 2; return st * 1024 + (ob ^ (((ob >> 9) & 1) << 5)); }
__device__ __forceinline__ void stage_rc(int b, int& R, int& C) { const int st = b / 1024, sb = b % 1024, swz = sb ^ (((sb >> 9) & 1) << 5); R = (st >> 1) * 16 + swz / 64; C = (st & 1) * 32 + (swz % 64) / 2; }
__device__ __forceinline__ int perm32(int rho) { const int n = rho >> 4, i = rho & 15; return 8 * (i >> 2) + 4 * n + (i & 3); }
__device__ __forceinline__ unsigned cvt_pk_bf16(float lo, float hi) { unsigned r; asm volatile("v_cvt_pk_bf16_f32 %0, %1, %2" : "=v"(r) : "v"(lo), "v"(hi)); return r; }

struct Unit { int pm, pn, e, pos0, cn; };
struct TileOrder {
    int nM, nN, nwg, G, c;
    __device__ __forceinline__ void init(int nM_, int nN_, int G_, int c_) { nM = nM_; nN = nN_; nwg = nM * nN; G = G_; c = c_; }
    __device__ __forceinline__ bool tile(int i, int& pm, int& pn) const {
        const long L = (long)i * G + c; if (L >= nwg) return false;
        int wgid = (int)L; { const int q = nwg / NXCD, r = nwg % NXCD, xcd = wgid % NXCD, off = wgid / NXCD; wgid = (xcd < r ? xcd * (q + 1) : r * (q + 1) + (xcd - r) * q) + off; }
        const int nig = WGM * nN, gid = wgid / nig, fm = gid * WGM, gsz = (nM - fm) < WGM ? (nM - fm) : WGM;
        pm = fm + ((wgid % nig) % gsz); pn = (wgid % nig) / gsz; return true;
    }
};

template <class POL>
__device__ __forceinline__ void gemm_phase(LAS unsigned char* lds, const POL& P) {
    int tid_ = threadIdx.x; asm volatile("" : "+v"(tid_));
    const int tid = tid_, wid = __builtin_amdgcn_readfirstlane(tid >> 6), lane = tid & 63, wr = wid >> 2, wc = wid & 3, fr = lane & 15, fq = lane >> 4;
    constexpr int KB = POL::FP8 ? 1024 : 2048, nt = KB / 128;
    int sR[2], sC[2]; unsigned voffA[2], voffB[2];
#pragma unroll
    for (int i = 0; i < 2; ++i) { stage_rc(tid * 16 + i * 8192, sR[i], sC[i]); const int Rb = POL::PERM ? ((sR[i] & ~31) + perm32(sR[i] & 31)) : sR[i]; voffA[i] = (unsigned)(sR[i] * KB + sC[i] * 2); voffB[i] = (unsigned)(Rb * KB + sC[i] * 2); }
    constexpr size_t kstep = (size_t)(BK * 2);
    constexpr unsigned hstepB = (unsigned)HALFT * KB;
    const unsigned ldsw = (unsigned)wid * 1024u;
    const int aoff = POL::FP8 ? lds_byte(wr * 64 + fr, fq * 16) : lds_byte(wr * 64 + fr, fq * 8), boff = POL::FP8 ? lds_byte(wc * 32 + fr, fq * 16) : lds_byte(wc * 32 + fr, fq * 8);
#define G_SA(b, h) (((b) * 2 + (h)) * HTB)
#define G_SB(b, h) ((4 + (b) * 2 + (h)) * HTB)
#define G_AOFF(OFF, h, i) (POL::GATHER ? (OFF)[h][i] : voffA[i])
#define G_STAGE_A(bufoff, gbase, OFF, h) do { const char* _gb = (const char*)(gbase) + (POL::GATHER ? (size_t)0 : (size_t)(h) * hstepB); _Pragma("unroll") for (int _i = 0; _i < 2; ++_i) \
        __builtin_amdgcn_global_load_lds((const unsigned*)(_gb + G_AOFF(OFF, h, _i)), (LAS unsigned*)(lds + (bufoff) + ldsw + _i * 8192), 16, 0, 0); } while (0)
#define G_STAGE_B(bufoff, gbase, hoff) do { const char* _gb = (const char*)(gbase) + (size_t)(hoff); _Pragma("unroll") for (int _i = 0; _i < 2; ++_i) \
        __builtin_amdgcn_global_load_lds((const unsigned*)(_gb + voffB[_i]), (LAS unsigned*)(lds + (bufoff) + ldsw + _i * 8192), 16, 0, 0); } while (0)
#define G_LD8(p) __builtin_shufflevector(*(const LAS v4i_*)(p), *(const LAS v4i_*)((p) + 16), 0, 1, 2, 3, 4, 5, 6, 7)
#define G_LDA(dst, b, h) do { if (POL::FP8) { _Pragma("unroll") for (int m = 0; m < 4; ++m) dst##8[m] = G_LD8(lds + G_SA(b, h) + aoff + m * 2048); } \
        else { _Pragma("unroll") for (int m = 0; m < 4; ++m) _Pragma("unroll") for (int k = 0; k < 2; ++k) dst[m][k] = *(const LAS bf16x8*)(lds + G_SA(b, h) + aoff + m * 2048 + k * 1024); } } while (0)
#define G_LDB(dst, b, h) do { if (POL::FP8) { _Pragma("unroll") for (int n = 0; n < 2; ++n) dst##8[n] = G_LD8(lds + G_SB(b, h) + boff + n * 2048); } \
        else { _Pragma("unroll") for (int n = 0; n < 2; ++n) _Pragma("unroll") for (int k = 0; k < 2; ++k) dst[n][k] = *(const LAS bf16x8*)(lds + G_SB(b, h) + boff + n * 2048 + k * 1024); } } while (0)
#define G_MMA(ai, bj, At, Bt) do { __builtin_amdgcn_s_setprio(1); \
        if (POL::FP8) { _Pragma("unroll") for (int m = 0; m < 4; ++m) _Pragma("unroll") for (int n = 0; n < 2; ++n) \
            asm volatile("v_mfma_scale_f32_16x16x128_f8f6f4 %0, %1, %2, %0, %3, %3 op_sel_hi:[0,0,0]" : "+v"(acc[ai][bj][m][n]) : "v"(Bt##8[n]), "v"(At##8[m]), "v"(mxs)); } \
        else { _Pragma("unroll") for (int m = 0; m < 4; ++m) _Pragma("unroll") for (int n = 0; n < 2; ++n) _Pragma("unroll") for (int k = 0; k < 2; ++k) \
            acc[ai][bj][m][n] = __builtin_amdgcn_mfma_f32_16x16x32_bf16(Bt[n][k], At[m][k], acc[ai][bj][m][n], 0, 0, 0); } \
        __builtin_amdgcn_s_setprio(0); } while (0)
#define G_WAIT_V(n) asm volatile("s_waitcnt vmcnt(" #n ")" ::: "memory")
#define G_WAIT_L(n) asm volatile("s_waitcnt lgkmcnt(" #n ")" ::: "memory")
#define G_BAR __builtin_amdgcn_s_barrier()
#define G_SCHED __builtin_amdgcn_sched_barrier(0)
#define G_TRIP(A1, OC, A2, ON, B2) do { \
        G_LDB(B0, 0, 0); G_SCHED; G_LDA(At, 0, 0); G_STAGE_A(G_SA(1, 1), A1, OC, 1); \
        G_WAIT_L(8); G_BAR; G_WAIT_L(0); G_MMA(0, 0, At, B0); G_BAR; G_SCHED; \
        G_LDB(B1, 0, 1); G_STAGE_B(G_SB(0, 0), B2, 0u); \
        G_BAR; G_WAIT_L(0); G_MMA(0, 1, At, B1); G_BAR; \
        G_LDA(At, 0, 1); G_STAGE_A(G_SA(0, 0), A2, ON, 0); \
        G_BAR; G_WAIT_L(0); G_MMA(1, 0, At, B0); G_BAR; G_SCHED; \
        G_STAGE_B(G_SB(0, 1), B2, hstepB); \
        G_WAIT_V(6); G_BAR; G_MMA(1, 1, At, B1); G_BAR; \
        G_LDB(B0, 1, 0); G_SCHED; G_LDA(At, 1, 0); G_STAGE_A(G_SA(0, 1), A2, ON, 1); \
        G_WAIT_L(8); G_BAR; G_WAIT_L(0); G_MMA(0, 0, At, B0); G_BAR; G_SCHED; \
        G_LDB(B1, 1, 1); G_STAGE_B(G_SB(1, 0), (B2) + kstep, 0u); \
        G_BAR; G_WAIT_L(0); G_MMA(0, 1, At, B1); G_BAR; \
        G_LDA(At, 1, 1); G_STAGE_A(G_SA(1, 0), (A2) + kstep, ON, 0); \
        G_BAR; G_WAIT_L(0); G_MMA(1, 0, At, B0); G_BAR; G_SCHED; \
        G_STAGE_B(G_SB(1, 1), (B2) + kstep, hstepB); \
        G_WAIT_V(6); G_BAR; G_MMA(1, 1, At, B1); G_BAR; } while (0)
#define G_TRIP2(A1, OC, A2, ON, B2) do { \
        G_LDB(B0, 0, 0); G_LDB(B1, 0, 1); G_SCHED; G_LDA(At, 0, 0); G_STAGE_A(G_SA(1, 1), A1, OC, 1); \
        G_WAIT_V(8); G_WAIT_L(0); G_BAR; G_MMA(0, 0, At, B0); G_MMA(0, 1, At, B1); G_BAR; G_SCHED; \
        G_LDA(At, 0, 1); G_STAGE_B(G_SB(0, 0), B2, 0u); G_STAGE_B(G_SB(0, 1), B2, hstepB); G_STAGE_A(G_SA(0, 0), A2, ON, 0); \
        G_WAIT_V(8); G_WAIT_L(0); G_BAR; G_MMA(1, 0, At, B0); G_MMA(1, 1, At, B1); G_BAR; G_SCHED; \
        G_LDB(B0, 1, 0); G_LDB(B1, 1, 1); G_SCHED; G_LDA(At, 1, 0); G_STAGE_A(G_SA(0, 1), A2, ON, 1); \
        G_WAIT_V(8); G_WAIT_L(0); G_BAR; G_MMA(0, 0, At, B0); G_MMA(0, 1, At, B1); G_BAR; G_SCHED; \
        G_LDA(At, 1, 1); G_STAGE_B(G_SB(1, 0), (B2) + kstep, 0u); G_STAGE_B(G_SB(1, 1), (B2) + kstep, hstepB); G_STAGE_A(G_SA(1, 0), (A2) + kstep, ON, 0); \
        G_WAIT_V(8); G_WAIT_L(0); G_BAR; G_MMA(1, 0, At, B0); G_MMA(1, 1, At, B1); G_BAR; G_SCHED; } while (0)
#ifndef GEMM_SP2
#define GEMM_SP2 1
#endif
    Unit cur, nxt; int ui = 0;
    if (!P.next(0, cur)) return;
    f32x4 acc[2][2][4][2];
#pragma unroll
    for (int a = 0; a < 2; ++a)
#pragma unroll
        for (int b = 0; b < 2; ++b)
#pragma unroll
            for (int m = 0; m < 4; ++m)
#pragma unroll
                for (int n = 0; n < 2; ++n) acc[a][b][m][n] = (f32x4){0.f, 0.f, 0.f, 0.f};
    const int mxs = 0x7f7f7f7f;
    bf16x8 At[4][2], B0[2][2], B1[2][2]; v8i At8[4], B08[2], B18[2];
    unsigned oc[2][2], on[2][2];
    if (POL::ROWS) { P.stage_rows(cur, 0); __syncthreads(); }
#pragma unroll
    for (int h = 0; h < 2; ++h)
#pragma unroll
        for (int i = 0; i < 2; ++i) { oc[h][i] = POL::GATHER ? P.a_off_l(0, h * HALFT + sR[i]) + (unsigned)sC[i] * 2u : 0u; on[h][i] = 0u; }
    const char* cA = P.a_base(cur); const char* cB = P.b_base(cur);
    if (GEMM_SP2) {
        G_STAGE_B(G_SB(0, 0), cB, 0u); G_STAGE_B(G_SB(0, 1), cB, hstepB); G_STAGE_A(G_SA(0, 0), cA, oc, 0); G_STAGE_A(G_SA(0, 1), cA, oc, 1);
        if (wr == 1) G_BAR;
        G_WAIT_V(2); G_BAR;
        G_STAGE_B(G_SB(1, 0), cB + kstep, 0u); G_STAGE_A(G_SA(1, 0), cA + kstep, oc, 0); G_STAGE_B(G_SB(1, 1), cB + kstep, hstepB);
        G_WAIT_V(6); G_BAR;
    } else {
    G_STAGE_B(G_SB(0, 0), cB, 0u); G_STAGE_A(G_SA(0, 0), cA, oc, 0); G_STAGE_B(G_SB(0, 1), cB, hstepB); G_STAGE_A(G_SA(0, 1), cA, oc, 1);
    if (wr == 1) G_BAR;
    G_WAIT_V(4); G_BAR;
    G_STAGE_B(G_SB(1, 0), cB + kstep, 0u); G_STAGE_A(G_SA(1, 0), cA + kstep, oc, 0); G_STAGE_B(G_SB(1, 1), cB + kstep, hstepB);
    G_WAIT_V(6); G_BAR;
    }
    for (;;) {
        const bool has_next = P.next(ui + 1, nxt);
        const char* nA = has_next ? P.a_base(nxt) : cA; const char* nB = has_next ? P.b_base(nxt) : cB;
        if (POL::ROWS) { if (has_next) P.stage_rows(nxt, (ui + 1) & 1); }
#pragma unroll 1
        for (int t = 0; t < nt; t += 2) {
            const bool last = (t == nt - 2);
            const char* a1 = cA + (size_t)(t + 1) * kstep; const char* a2 = last ? nA : cA + (size_t)(t + 2) * kstep; const char* b2 = last ? nB : cB + (size_t)(t + 2) * kstep;
            if (POL::GATHER) {
                unsigned os[2][2];
                if (last) {
#pragma unroll
                    for (int h = 0; h < 2; ++h)
#pragma unroll
                        for (int i = 0; i < 2; ++i) on[h][i] = has_next ? P.a_off_l((ui + 1) & 1, h * HALFT + sR[i]) + (unsigned)sC[i] * 2u : oc[h][i];
                }
#pragma unroll
                for (int h = 0; h < 2; ++h)
#pragma unroll
                    for (int i = 0; i < 2; ++i) os[h][i] = last ? on[h][i] : oc[h][i];
                if (GEMM_SP2) { G_TRIP2(a1, oc, a2, os, b2); } else { G_TRIP(a1, oc, a2, os, b2); }
            } else { if (GEMM_SP2) { G_TRIP2(a1, oc, a2, oc, b2); } else { G_TRIP(a1, oc, a2, oc, b2); } }
        }
        if (POL::FP8) asm volatile("s_nop 15\n\ts_nop 15" ::: "memory");
        if (wr == 0) G_BAR;
        P.epi(acc, cur, wr, wc, fr, fq, ui & 1);
        if (!has_next) break;
#pragma unroll
        for (int a = 0; a < 2; ++a)
#pragma unroll
            for (int b = 0; b < 2; ++b)
#pragma unroll
                for (int m = 0; m < 4; ++m)
#pragma unroll
                    for (int n = 0; n < 2; ++n) acc[a][b][m][n] = (f32x4){0.f, 0.f, 0.f, 0.f};
        cur = nxt; cA = nA; cB = nB; ++ui;
        if (POL::GATHER) {
#pragma unroll
            for (int h = 0; h < 2; ++h)
#pragma unroll
                for (int i = 0; i < 2; ++i) oc[h][i] = on[h][i];
        }
        if (wr == 1) G_BAR;
    }
    G_WAIT_V(0);
    G_BAR;
#undef G_SA
#undef G_SB
#undef G_AOFF
#undef G_STAGE_A
#undef G_STAGE_B
#undef G_LDA
#undef G_LDB
#undef G_MMA
#undef G_LD8
#undef G_WAIT_V
#undef G_WAIT_L
#undef G_BAR
#undef G_SCHED
#undef G_TRIP
#undef G_TRIP2
}

struct PolInProj {
    static constexpr bool PERM = true, GATHER = false, FP8 = false, ROWS = false;
    __device__ __forceinline__ void stage_rows(const Unit&, int) const {}
    __device__ __forceinline__ unsigned a_off_l(int, int) const { return 0u; }
    const bf16_t* A; const bf16_t* Bt; bf16_t* O; TileOrder ord;
    __device__ __forceinline__ bool next(int i, Unit& u) const {
        constexpr int NLATU = (NLAT / BM) * (INW / BM);
        const int L = i * ord.G + ord.c;
        if (L < NLATU) return ord.tile(i, u.pm, u.pn);
        const int q = L - NLATU; if (q >= (NCTX / BM) * 8) return false;
        u.pm = NLAT / BM + (q >> 3); const int j = q & 7; u.pn = j < 6 ? 2 + j : 4 + j; return true;
    }
    __device__ __forceinline__ const char* a_base(const Unit& u) const { return (const char*)A + (size_t)u.pm * BM * GK * 2; }
    __device__ __forceinline__ unsigned a_off(const Unit&, int r) const { return (unsigned)r * GK * 2u; }
    __device__ __forceinline__ const char* b_base(const Unit& u) const { return (const char*)Bt + (size_t)u.pn * BM * GK * 2; }
    __device__ __forceinline__ void epi(const f32x4 (&acc)[2][2][4][2], const Unit& u, int wr, int wc, int fr, int fq, int par) const {
        const int row0 = u.pm * BM + wr * 64 + fr, col0 = u.pn * BM + wc * 32 + 8 * fq;
        const bool qsilu = u.pn < HGW / BM;
#pragma unroll
        for (int ai = 0; ai < 2; ++ai)
#pragma unroll
            for (int m = 0; m < 4; ++m) { bf16_t* rowp = O + (size_t)(row0 + ai * HALFT + m * 16) * INW + col0;
#pragma unroll
                for (int bj = 0; bj < 2; ++bj) { f32x4 v0 = acc[ai][bj][m][0], v1 = acc[ai][bj][m][1];
                    if (qsilu) {
#pragma unroll
                        for (int e = 0; e < 4; ++e) { v0[e] = v0[e] * sigmoidf_(v0[e]); v1[e] = v1[e] * sigmoidf_(v1[e]); } }
                    u32x4 w; w.x = cvt_pk_bf16(v0[0], v0[1]); w.y = cvt_pk_bf16(v0[2], v0[3]); w.z = cvt_pk_bf16(v1[0], v1[1]); w.w = cvt_pk_bf16(v1[2], v1[3]);
                    *(u32x4*)(rowp + bj * HALFT) = w; } }
    }
};
struct PolOutProj {
    static constexpr bool PERM = true, GATHER = false, FP8 = false, ROWS = false;
    __device__ __forceinline__ void stage_rows(const Unit&, int) const {}
    __device__ __forceinline__ unsigned a_off_l(int, int) const { return 0u; }
    const bf16_t* A; const bf16_t* Bt; const float* x; const float* mod; bf16_t* O; TileOrder ord;
    __device__ __forceinline__ bool next(int i, Unit& u) const { return ord.tile(i, u.pm, u.pn); }
    __device__ __forceinline__ const char* a_base(const Unit& u) const { return (const char*)A + (size_t)u.pm * BM * GK * 2; }
    __device__ __forceinline__ unsigned a_off(const Unit&, int r) const { return (unsigned)r * GK * 2u; }
    __device__ __forceinline__ const char* b_base(const Unit& u) const { return (const char*)Bt + (size_t)u.pn * BM * GK * 2; }
    __device__ __forceinline__ void epi(const f32x4 (&acc)[2][2][4][2], const Unit& u, int wr, int wc, int fr, int fq, int par) const {
        const int row0 = u.pm * BM + wr * 64 + fr, col0 = u.pn * BM + wc * 32 + 8 * fq;
        const float* g1 = mod + (size_t)((u.pm * BM) >> 11) * 6144 + 2048 + col0;
        f32x4 gv[2][2];
#pragma unroll
        for (int bj = 0; bj < 2; ++bj) { gv[bj][0] = *(const f32x4*)(g1 + bj * HALFT); gv[bj][1] = *(const f32x4*)(g1 + bj * HALFT + 4); }
#pragma unroll
        for (int ai = 0; ai < 2; ++ai)
#pragma unroll
            for (int m = 0; m < 4; ++m) { const size_t off = (size_t)(row0 + ai * HALFT + m * 16) * D + col0;
#pragma unroll
                for (int bj = 0; bj < 2; ++bj) {
                    const f32x4 x0 = __builtin_nontemporal_load((const f32x4*)(x + off + bj * HALFT)), x1v = __builtin_nontemporal_load((const f32x4*)(x + off + bj * HALFT + 4));
                    const f32x4 v0 = x0 + gv[bj][0] * acc[ai][bj][m][0], v1 = x1v + gv[bj][1] * acc[ai][bj][m][1];
                    u32x4 w; w.x = cvt_pk_bf16(v0[0], v0[1]); w.y = cvt_pk_bf16(v0[2], v0[3]); w.z = cvt_pk_bf16(v1[0], v1[1]); w.w = cvt_pk_bf16(v1[2], v1[3]);
                    *(u32x4*)(O + off + bj * HALFT) = w; }
                asm volatile("" ::: "memory"); }
    }
};
struct MoeTiles {
    const LAS int* tstart; const u32* cnt; int half;
    __device__ __forceinline__ LAS u32* rows(int par) const { return (LAS u32*)((LAS unsigned char*)tstart + 8192) + par * 512; }
    __device__ __forceinline__ void stage(const Unit& u, int par, const u32* toktab, const float* wtab) const {
        if (threadIdx.x < BM) { const int p = u.pos0 + threadIdx.x; const size_t tb = ((size_t)half * NE + u.e) * CAP; const bool ok = p < u.cn;
            const u32 tk = ok ? toktab[tb + p] : ~0u; const float wg = ok ? wtab[tb + p] : 0.f; LAS u32* rt = rows(par); rt[threadIdx.x * 2] = tk; rt[threadIdx.x * 2 + 1] = __float_as_uint(wg); }
    }
    __device__ __forceinline__ void find(Unit& u) const {
        const int e = __builtin_amdgcn_readfirstlane(tstart[64 + u.pm]);
        u.e = e; u.pos0 = (u.pm - __builtin_amdgcn_readfirstlane(tstart[e])) * BM; u.cn = (int)cnt[half * NE + e];
    }
};
struct PolGateUp {
    static constexpr bool PERM = true, GATHER = true, FP8 = true, ROWS = true;
    const fp8_t* A; const fp8_t* Bt; const float* bgu; const u32* toktab; const float* wtab; fp8_t* O; MoeTiles mt; TileOrder ord;
    __device__ __forceinline__ void stage_rows(const Unit& u, int par) const { mt.stage(u, par, toktab, wtab); }
    __device__ __forceinline__ unsigned a_off_l(int par, int r) const { const u32 tk = mt.rows(par)[r * 2]; return (tk == ~0u ? 0u : (tk >> 2)) * 1024u; }
    __device__ __forceinline__ bool next(int i, Unit& u) const { if (!ord.tile(i, u.pm, u.pn)) return false; mt.find(u); return true; }
    __device__ __forceinline__ const char* a_base(const Unit&) const { return (const char*)A; }
    __device__ __forceinline__ unsigned a_off(const Unit& u, int r) const {
        const int p = u.pos0 + r; const u32 tk = toktab[((size_t)mt.half * NE + u.e) * CAP + (p < u.cn ? p : 0)];
        return (tk >> 2) * 1024u;
    }
    __device__ __forceinline__ const char* b_base(const Unit& u) const { return (const char*)Bt + ((size_t)u.e * 2048 + (size_t)u.pn * BM) * 1024; }
    __device__ __forceinline__ void epi(const f32x4 (&acc)[2][2][4][2], const Unit& u, int wr, int wc, int fr, int fq, int par) const {
        const int row0 = u.pm * BM + wr * 64 + fr, cc = u.pn * HALFT + wc * 32 + 8 * fq;
        const float* bg = bgu + (size_t)u.e * 2048 + cc;
        const f32x4 bg0 = *(const f32x4*)bg, bg1 = *(const f32x4*)(bg + 4), bu0 = *(const f32x4*)(bg + 1024), bu1 = *(const f32x4*)(bg + 1028);
        constexpr float inv = 1.0f / (SC_H2 * SC_W);
#pragma unroll
        for (int ai = 0; ai < 2; ++ai)
#pragma unroll
            for (int m = 0; m < 4; ++m) {
                f32x4 g0 = acc[ai][0][m][0] * inv + bg0, g1 = acc[ai][0][m][1] * inv + bg1, u0 = acc[ai][1][m][0] * inv + bu0, u1 = acc[ai][1][m][1] * inv + bu1;
                float o[8];
#pragma unroll
                for (int j = 0; j < 4; ++j) {
                    const float ga = fminf(g0[j], 7.0f), gb = fminf(g1[j], 7.0f);
                    const float ua = fminf(fmaxf(u0[j], -7.0f), 7.0f), ub = fminf(fmaxf(u1[j], -7.0f), 7.0f);
                    o[j] = ga * sigmoidf_(1.702f * ga) * (ua + 1.0f) * SC_ACT; o[4 + j] = gb * sigmoidf_(1.702f * gb) * (ub + 1.0f) * SC_ACT;
                }
                uint2 w; w.x = pk4_fp8_nc(o[0], o[1], o[2], o[3]); w.y = pk4_fp8_nc(o[4], o[5], o[6], o[7]);
                *(uint2*)(O + (size_t)(row0 + ai * HALFT + m * 16) * DFF + cc) = w;
                asm volatile("" ::: "memory");
            }
    }
};
struct PolDown {
    static constexpr bool PERM = true, GATHER = false, FP8 = true, ROWS = true;
    const fp8_t* A; const fp8_t* Bt; const float* bd; const u32* toktab; const float* wtab; fp8_t* O; MoeTiles mt; TileOrder ord;
    __device__ __forceinline__ void stage_rows(const Unit& u, int par) const { mt.stage(u, par, toktab, wtab); }
    __device__ __forceinline__ unsigned a_off_l(int, int) const { return 0u; }
    __device__ __forceinline__ bool next(int i, Unit& u) const { if (!ord.tile(i, u.pm, u.pn)) return false; mt.find(u); return true; }
    __device__ __forceinline__ const char* a_base(const Unit& u) const { return (const char*)A + (size_t)u.pm * BM * 1024; }
    __device__ __forceinline__ unsigned a_off(const Unit&, int r) const { return (unsigned)r * 1024u; }
    __device__ __forceinline__ const char* b_base(const Unit& u) const { return (const char*)Bt + ((size_t)u.e * 1024 + (size_t)u.pn * BM) * 1024; }
    __device__ __forceinline__ void epi(const f32x4 (&acc)[2][2][4][2], const Unit& u, int wr, int wc, int fr, int fq, int par) const {
        const int col0 = u.pn * BM + wc * 32 + 8 * fq;
        const float* bp = bd + (size_t)u.e * D + col0;
        f32x4 bv[2][2];
#pragma unroll
        for (int bj = 0; bj < 2; ++bj) { bv[bj][0] = *(const f32x4*)(bp + bj * HALFT); bv[bj][1] = *(const f32x4*)(bp + bj * HALFT + 4); }
        const LAS u32* rt = mt.rows(par);
        constexpr float inv = 1.0f / (SC_ACT * SC_W);
#pragma unroll
        for (int ai = 0; ai < 2; ++ai)
#pragma unroll
            for (int m = 0; m < 4; ++m) {
                const int rr = ai * HALFT + wr * 64 + m * 16 + fr;
                const u32 tk = rt[rr * 2];
                if (tk != ~0u) {
                    const float wg = __uint_as_float(rt[rr * 2 + 1]) * SC_Y;
                    fp8_t* rowp = O + (size_t)(tk - (u32)mt.half * HALF_TOK * 4u) * D + col0;
#pragma unroll
                    for (int bj = 0; bj < 2; ++bj) { const f32x4 v0 = (acc[ai][bj][m][0] * inv + bv[bj][0]) * wg, v1 = (acc[ai][bj][m][1] * inv + bv[bj][1]) * wg;
                        uint2 w; w.x = pk4_fp8(v0[0], v0[1], v0[2], v0[3]); w.y = pk4_fp8(v1[0], v1[1], v1[2], v1[3]);
                        *(uint2*)(rowp + bj * HALFT) = w; }
                }
            }
    }
};
__device__ __forceinline__ int moe_tile_table(LAS int* tstart, const u32* cnt, int half) {
    __syncthreads();
    if (threadIdx.x == 0) { int s = 0; for (int e = 0; e < NE; ++e) { tstart[e] = s; s += ((int)cnt[half * NE + e] + BM - 1) / BM; } tstart[NE] = s; }
    __syncthreads();
    const int tot = tstart[NE];
    for (int t = threadIdx.x; t < tot; t += 512) { int e = 0;
#pragma unroll 1
        for (int i = 1; i < NE; ++i) if (t >= tstart[i]) e = i;
        tstart[64 + t] = e; }
    __syncthreads();
    return tot;
}

__device__ __forceinline__ void conv_item(const float* __restrict__ W, int N, bf16_t* __restrict__ WT, int k0, int n0, size_t rowbase, LAS float* scr, int lane) {
#pragma unroll 4
    for (int i = 0; i < 16; ++i) { const int k = 4 * i + (lane >> 4); const f32x4 v = __builtin_nontemporal_load((const f32x4*)(W + (size_t)(k0 + k) * N + n0 + (lane & 15) * 4)); *(LAS f32x4*)(scr + k * 68 + (lane & 15) * 4) = v; }
    asm volatile("s_waitcnt lgkmcnt(0)" ::: "memory");
    const int c = lane & 7;
#pragma unroll
    for (int j = 0; j < 8; ++j) { const int n = (lane >> 3) + 8 * j; const LAS float* s = scr + (8 * c) * 68 + n;
        u32x4 o; o.x = cvt_pk_bf16(s[0 * 68], s[1 * 68]); o.y = cvt_pk_bf16(s[2 * 68], s[3 * 68]); o.z = cvt_pk_bf16(s[4 * 68], s[5 * 68]); o.w = cvt_pk_bf16(s[6 * 68], s[7 * 68]);
        *(u32x4*)(WT + (rowbase + n) * GK + k0 + 8 * c) = o; }
    asm volatile("s_waitcnt lgkmcnt(0)" ::: "memory");
}
__device__ __forceinline__ void conv_item8(const float* __restrict__ W, int N, fp8_t* __restrict__ WT, int k0, int n0, size_t rowbase, LAS float* scr, int lane) {
#pragma unroll 4
    for (int i = 0; i < 16; ++i) { const int k = 4 * i + (lane >> 4); const f32x4 v = __builtin_nontemporal_load((const f32x4*)(W + (size_t)(k0 + k) * N + n0 + (lane & 15) * 4)); *(LAS f32x4*)(scr + k * 68 + (lane & 15) * 4) = v; }
    asm volatile("s_waitcnt lgkmcnt(0)" ::: "memory");
    const LAS float* sp = scr + lane;
#pragma unroll
    for (int q = 0; q < 4; ++q) {
        u32x4 o;
        o.x = pk4_fp8(sp[(16 * q + 0) * 68] * SC_W, sp[(16 * q + 1) * 68] * SC_W, sp[(16 * q + 2) * 68] * SC_W, sp[(16 * q + 3) * 68] * SC_W);
        o.y = pk4_fp8(sp[(16 * q + 4) * 68] * SC_W, sp[(16 * q + 5) * 68] * SC_W, sp[(16 * q + 6) * 68] * SC_W, sp[(16 * q + 7) * 68] * SC_W);
        o.z = pk4_fp8(sp[(16 * q + 8) * 68] * SC_W, sp[(16 * q + 9) * 68] * SC_W, sp[(16 * q + 10) * 68] * SC_W, sp[(16 * q + 11) * 68] * SC_W);
        o.w = pk4_fp8(sp[(16 * q + 12) * 68] * SC_W, sp[(16 * q + 13) * 68] * SC_W, sp[(16 * q + 14) * 68] * SC_W, sp[(16 * q + 15) * 68] * SC_W);
        *(u32x4*)(WT + (rowbase + lane) * GK + k0 + 16 * q) = o;
    }
    asm volatile("s_waitcnt lgkmcnt(0)" ::: "memory");
}
constexpr int IT_IN = 16 * (INW / 64), IT_OUT = 16 * (D / 64), IT_GU = NE * 16 * 32, IT_D = NE * 16 * 16, IT_ALL = IT_IN + IT_OUT + IT_GU + IT_D;
struct ProArgs { const float *c, *c_ctx, *w_ada, *b_ada, *lbl, *w_in, *w_out, *wgu, *wd, *rg_wa, *rg_wx, *rg_lam; float *mod, *lb, *coef; bf16_t *Win_t, *Wout_t, *WG_t; fp8_t *Wgu_t, *Wd_t; };
__device__ __forceinline__ void phase_prologue(LAS unsigned char* lds, const ProArgs& a, int bid, int G, bool do_mod, int it_lo, int it_hi) {
    const int tid = threadIdx.x, lane = tid & 63, w = tid >> 6;
    if (!do_mod) {} else if (bid < 96) {
        LAS float* s = (LAS float*)lds;
        for (int i = tid; i < 33 * D; i += 512) { const int b = i >> 10, k = i & 1023; const float v = b < NB ? a.c[(size_t)b * D + k] : a.c_ctx[k]; s[i] = v * sigmoidf_(v); }
        __syncthreads();
        const int n = bid * 64 + lane;
        float acc[33];
#pragma unroll
        for (int b = 0; b < 33; ++b) acc[b] = 0.f;
#pragma unroll 1
        for (int k = 128 * w; k < 128 * w + 128; k += 16) {
            float wv[16];
#pragma unroll
            for (int i = 0; i < 16; ++i) wv[i] = __builtin_nontemporal_load(a.w_ada + (size_t)(k + i) * 6144 + n);
#pragma unroll
            for (int b = 0; b < 33; ++b)
#pragma unroll
                for (int i4 = 0; i4 < 4; ++i4) { const f32x4 sv = *(const LAS f32x4*)(s + b * D + k + 4 * i4); acc[b] += sv[0] * wv[4 * i4] + sv[1] * wv[4 * i4 + 1] + sv[2] * wv[4 * i4 + 2] + sv[3] * wv[4 * i4 + 3]; }
        }
        __syncthreads();
        LAS float* red = (LAS float*)lds;
#pragma unroll
        for (int b = 0; b < 33; ++b) red[(w * 33 + b) * 64 + lane] = acc[b];
        __syncthreads();
        for (int i = tid; i < 33 * 64; i += 512) { const int b = i >> 6, l = i & 63; float sum = a.b_ada[bid * 64 + l];
#pragma unroll
            for (int ww = 0; ww < 8; ++ww) sum += red[(ww * 33 + b) * 64 + l];
            a.mod[(size_t)b * 6144 + bid * 64 + l] = sum; }
        __syncthreads();
    } else if (bid == 96) {
        for (int i = tid; i < 2 * HGW; i += 512) { const float l0 = a.lbl[i], l1 = a.lbl[2 * HGW + i]; a.lb[i] = 1.0f / (1.0f + __expf(l1 - l0)); }
        for (int i = tid; i < 2 * RGW; i += 512) { const float l = a.rg_lam[i]; const float sp = (-l > 20.f) ? -l : log1pf(__expf(-l)); a.coef[i] = -8.0f * sp; }
    } else if (bid == 97) {
        for (int idx = tid; idx < 8 * 256 * 64; idx += 512) { const int hd = idx >> 14, n = (idx >> 6) & 255, kk = idx & 63, g = n >> 6, j = n & 63, d = g >> 1;
            const float* src = (g & 1) ? a.rg_wx : a.rg_wa; a.WG_t[idx] = f2bf(src[(((size_t)d * 8 + hd) * 64 + kk) * 64 + j]); }
    }
    LAS float* scr = (LAS float*)(lds + w * (64 * 68 * 4));
    const int gw = bid * 8 + w, NW = G * 8;
    for (int it = it_lo + gw; it < it_hi; it += NW) {
        int r = it;
        if (r < IT_IN) { const int kb = r / (INW / 64), nb = r % (INW / 64); conv_item(a.w_in, INW, a.Win_t, kb * 64, nb * 64, (size_t)nb * 64, scr, lane); continue; } r -= IT_IN;
        if (r < IT_OUT) { const int kb = r / 16, nb = r % 16; conv_item(a.w_out, D, a.Wout_t, kb * 64, nb * 64, (size_t)nb * 64, scr, lane); continue; } r -= IT_OUT;
        if (r < IT_GU) { const int e = r / 512, q = r % 512, kb = q / 32, nb = q % 32, n0 = nb * 64, bj = n0 >> 10, rem = n0 & 1023, pn = rem >> 7, cc0 = rem & 127;
            conv_item8(a.wgu + (size_t)e * D * 2048, 2048, a.Wgu_t, kb * 64, n0, (size_t)e * 2048 + pn * 256 + bj * 128 + cc0, scr, lane); continue; } r -= IT_GU;
        { const int e = r / 256, q = r % 256, kb = q / 16, nb = q % 16; conv_item8(a.wd + (size_t)e * DFF * D, D, a.Wd_t, kb * 64, nb * 64, (size_t)e * 1024 + nb * 64, scr, lane); }
    }
}


__device__ __forceinline__ void phase_norm1(const float* __restrict__ x, const float* __restrict__ ctx, const float* __restrict__ nw, const float* __restrict__ mod, bf16_t* __restrict__ H, int bid, int G) {
    constexpr int RB = 4;
    const int lane = threadIdx.x & 63, gw = bid * 8 + (threadIdx.x >> 6), NW = G * 8;
    for (int r0 = gw; r0 < NROWS; r0 += RB * NW) {
        f32x4 v[RB][4];
#pragma unroll
        for (int q = 0; q < RB; ++q) { const int r = r0 + q * NW; const int rr = r < NROWS ? r : r0;
            const float* src = rr < NLAT ? x + (size_t)rr * D : ctx + (size_t)(rr - NLAT) * D;
#pragma unroll
            for (int j = 0; j < 4; ++j) v[q][j] = __builtin_nontemporal_load((const f32x4*)(src + j * 256 + lane * 4)); }
#pragma unroll
        for (int q = 0; q < RB; ++q) { const int r = r0 + q * NW; if (r < NROWS) {
            const float* m = mod + (size_t)(r < NLAT ? (r >> 11) : NB) * 6144;
            float ss = 0.f;
#pragma unroll
            for (int j = 0; j < 4; ++j) ss += v[q][j][0] * v[q][j][0] + v[q][j][1] * v[q][j][1] + v[q][j][2] * v[q][j][2] + v[q][j][3] * v[q][j][3];
            const float rstd = __builtin_amdgcn_rsqf(wave_sum(ss) * (1.0f / D) + EPS);
#pragma unroll
            for (int j = 0; j < 4; ++j) {
                const int c0 = j * 256 + lane * 4;
                const f32x4 w = *(const f32x4*)(nw + c0), sh = *(const f32x4*)(m + c0), sc = *(const f32x4*)(m + 1024 + c0);
                const f32x4 o = v[q][j] * rstd * w * (sc + 1.0f) + sh;
                uint2 p; p.x = cvt_pk_bf16(o[0], o[1]); p.y = cvt_pk_bf16(o[2], o[3]);
                *(uint2*)(H + (size_t)r * D + c0) = p;
            } } }
    }
}

__device__ __forceinline__ bf16x8 pack8(const f32x4& a, const f32x4& b) {
    u32x4 w; w.x = cvt_pk_bf16(a[0], a[1]); w.y = cvt_pk_bf16(a[2], a[3]); w.z = cvt_pk_bf16(b[0], b[1]); w.w = cvt_pk_bf16(b[2], b[3]);
    return __builtin_bit_cast(bf16x8, w);
}
constexpr int HW_BUF = 45056;
constexpr int HW_QD = 0, HW_KET = 17408, HW_PM = 35840;
constexpr int HW_VT = 2 * HW_BUF, HW_KD = HW_VT + 18432, HW_OS = HW_KD + 17408, HW_TOT = HW_OS + 17408, HW_DEC = HW_TOT + 2048;
__device__ __forceinline__ void phase_hgrn2_ws(LAS unsigned char* lds, const bf16_t* __restrict__ P, const float* __restrict__ lb, bf16_t* __restrict__ OF, bf16_t* __restrict__ OB, int item) {
    const int b = item >> 3, h = (item >> 1) & 3, dir = item & 1;
    const int tid = threadIdx.x, w = __builtin_amdgcn_readfirstlane(tid >> 6), lane = tid & 63, l15 = lane & 15, G4 = lane >> 4;
    bf16_t* OD = dir ? OB : OF;
    const int cf = dir ? C_FB : C_FF;
    constexpr int NC = (CTXL + T) / 64;
    LAS float* TOT = (LAS float*)(lds + HW_TOT);
#define HW_BAR() do { asm volatile("s_waitcnt lgkmcnt(0)" ::: "memory"); __builtin_amdgcn_s_barrier(); asm volatile("" ::: "memory"); } while (0)
    __syncthreads();
    if (w >= 4) {
        const int et = tid - 256, kp = et & 63, k = 2 * kp, seg = et >> 6, ew = w - 4;
        const int kslot = (k & ~31) | (((k >> 2) & 3) << 3) | (((k >> 4) & 1) << 2) | (k & 3);
        const float lb0 = lb[dir * HGW + h * 128 + k], lb1 = lb[dir * HGW + h * 128 + k + 1];
        const char* Pc = (const char*)P; const int sstep = dir ? -(INW * 2) : INW * 2;
#define HW_OFF0(m_) ({ const int p_ = 64 * (m_) + 16 * seg; const unsigned r_ = p_ < CTXL ? (unsigned)(NLAT + b * CTXL + (dir ? CTXL - 1 - p_ : p_)) : (unsigned)(b * T + (dir ? T - 1 - (p_ - CTXL) : (p_ - CTXL))); (r_ * (unsigned)INW + (unsigned)(h * 128 + k)) * 2u; })
#define HW_LD(off0_, i_, col_) (*(const u32*)(Pc + (unsigned)((int)(off0_) + (i_) * sstep + (col_) * 2)))
#define BF_LO(w_) __uint_as_float((w_) << 16)
#define BF_HI(w_) __uint_as_float((w_) & 0xffff0000u)
        u32 rf[16];
        { const unsigned o0 = HW_OFF0(0);
#pragma unroll
        for (int i = 0; i < 16; ++i) rf[i] = HW_LD(o0, i, cf); }
#pragma unroll 1
        for (int m = 0; m < NC + 1; ++m) {
            const int par = m & 1;
            LAS unsigned char* buf = lds + par * HW_BUF;
            HW_BAR();
            u32 rq[16], rv[16]; float f0v[16], f1v[16], c0v[16], c1v[16]; float run0 = 0.f, run1 = 0.f;
            if (m < NC) {
                const unsigned o0 = HW_OFF0(m);
#pragma unroll
                for (int i = 0; i < 16; ++i) { rq[i] = HW_LD(o0, i, C_Q); rv[i] = HW_LD(o0, i, C_I); }
#pragma unroll
                for (int i = 0; i < 16; ++i) { const float f0 = lb0 + (1.f - lb0) * sigmoidf_(BF_LO(rf[i])), f1 = lb1 + (1.f - lb1) * sigmoidf_(BF_HI(rf[i]));
                    f0v[i] = f0; f1v[i] = f1; run0 += flog(f0); run1 += flog(f1); c0v[i] = run0; c1v[i] = run1; }
                *(LAS f32x2*)(TOT + seg * 128 + k) = (f32x2){run0, run1};
                if (m + 1 < NC) { const unsigned o1 = HW_OFF0(m + 1);
#pragma unroll
                    for (int i = 0; i < 16; ++i) rf[i] = HW_LD(o1, i, cf); }
            }
            HW_BAR();
            if (m < NC) {
                f32x2 tt[4];
#pragma unroll
                for (int q = 0; q < 4; ++q) tt[q] = *(const LAS f32x2*)(TOT + q * 128 + k);
                const float p0 = seg == 0 ? 0.f : seg == 1 ? tt[0].x : seg == 2 ? tt[0].x + tt[1].x : tt[0].x + tt[1].x + tt[2].x;
                const float p1 = seg == 0 ? 0.f : seg == 1 ? tt[0].y : seg == 2 ? tt[0].y + tt[1].y : tt[0].y + tt[1].y + tt[2].y;
                const float eb0 = fexp((tt[0].x + tt[1].x) + (tt[2].x + tt[3].x)), eb1 = fexp((tt[0].y + tt[1].y) + (tt[2].y + tt[3].y));
                if (seg == 0) *(LAS f32x2*)(lds + HW_DEC + par * 512 + k * 4) = (f32x2){eb0, eb1};
                float ke0[16], ke1[16];
#pragma unroll
                for (int i = 0; i < 16; ++i) {
                    const int j = 16 * seg + i;
                    const float e0 = fexp(p0 + c0v[i]), e1 = fexp(p1 + c1v[i]);
                    const float kf0 = (1.f - f0v[i]) * frcp(e0), kf1 = (1.f - f1v[i]) * frcp(e1);
                    *(LAS u32*)(buf + HW_QD + j * 272 + kslot * 2) = cvt_pk_bf16(BF_LO(rq[i]) * e0, BF_HI(rq[i]) * e1);
                    *(LAS u32*)(lds + HW_KD + j * 272 + kslot * 2) = cvt_pk_bf16(kf0, kf1);
                    ke0[i] = kf0 * eb0; ke1[i] = kf1 * eb1;
                }
#pragma unroll
                for (int q4 = 0; q4 < 2; ++q4) {
                    u32x4 a0, a1, v0, v1;
#pragma unroll
                    for (int i = 0; i < 4; ++i) { const int t = 8 * q4 + 2 * i;
                        a0[i] = cvt_pk_bf16(ke0[t], ke0[t + 1]); a1[i] = cvt_pk_bf16(ke1[t], ke1[t + 1]);
                        v0[i] = (rv[t] & 0xffffu) | (rv[t + 1] << 16); v1[i] = (rv[t] >> 16) | (rv[t + 1] & 0xffff0000u); }
                    *(LAS u32x4*)(buf + HW_KET + k * 144 + seg * 32 + q4 * 16) = a0; *(LAS u32x4*)(buf + HW_KET + (k + 1) * 144 + seg * 32 + q4 * 16) = a1;
                    *(LAS u32x4*)(lds + HW_VT + k * 144 + seg * 32 + q4 * 16) = v0; *(LAS u32x4*)(lds + HW_VT + (k + 1) * 144 + seg * 32 + q4 * 16) = v1;
                }
            }
            HW_BAR();
            if (m < NC && m >= CTXL / 64) {
                const int mt = ew;
                f32x4 pa[4];
#pragma unroll
                for (int q = 0; q < 4; ++q) pa[q] = (f32x4){0.f, 0.f, 0.f, 0.f};
#pragma unroll
                for (int s = 0; s < 4; ++s) {
                    const bf16x8 a = *(const LAS bf16x8*)(buf + HW_QD + (16 * mt + l15) * 272 + (32 * s + 8 * G4) * 2);
#pragma unroll
                    for (int q = 0; q < 4; ++q) { const bf16x8 bq = *(const LAS bf16x8*)(lds + HW_KD + (16 * q + l15) * 272 + (32 * s + 8 * G4) * 2); pa[q] = __builtin_amdgcn_mfma_f32_16x16x32_bf16(a, bq, pa[q], 0, 0, 0); }
                }
#pragma unroll
                for (int q = 0; q < 4; ++q)
#pragma unroll
                    for (int r = 0; r < 4; ++r) { const int c = 16 * mt + 4 * G4 + r, j = 16 * q + l15; *(LAS bf16_t*)(buf + HW_PM + c * 144 + j * 2) = f2bf(j <= c ? pa[q][r] : 0.f); }
                asm volatile("s_waitcnt lgkmcnt(0)" ::: "memory");
            }
        }
#undef HW_OFF0
#undef HW_LD
#undef BF_LO
#undef BF_HI
    } else {
        f32x4 S[8][2];
#pragma unroll
        for (int t = 0; t < 8; ++t) { S[t][0] = (f32x4){0.f, 0.f, 0.f, 0.f}; S[t][1] = (f32x4){0.f, 0.f, 0.f, 0.f}; }
        HW_BAR(); HW_BAR(); HW_BAR();
#pragma unroll 1
        for (int n = 0; n < NC; ++n) {
            const int par = n & 1; const bool lat = n >= CTXL / 64;
            LAS unsigned char* buf = lds + par * HW_BUF;
            HW_BAR();
            bf16x8 vb[2][2];
#pragma unroll
            for (int nt = 0; nt < 2; ++nt)
#pragma unroll
                for (int s = 0; s < 2; ++s) vb[nt][s] = *(const LAS bf16x8*)(lds + HW_VT + (32 * w + 16 * nt + l15) * 144 + (32 * s + 8 * G4) * 2);
            HW_BAR();
            if (lat) {
                bf16x8 sb[2][4];
#pragma unroll
                for (int nt = 0; nt < 2; ++nt)
#pragma unroll
                    for (int s = 0; s < 4; ++s) sb[nt][s] = pack8(S[2 * s][nt], S[2 * s + 1][nt]);
#pragma unroll
                for (int mt = 0; mt < 4; ++mt) {
                    f32x4 oa[2] = {(f32x4){0.f, 0.f, 0.f, 0.f}, (f32x4){0.f, 0.f, 0.f, 0.f}};
#pragma unroll
                    for (int s = 0; s < 2; ++s) { const bf16x8 a = *(const LAS bf16x8*)(buf + HW_PM + (16 * mt + l15) * 144 + (32 * s + 8 * G4) * 2);
                        oa[0] = __builtin_amdgcn_mfma_f32_16x16x32_bf16(a, vb[0][s], oa[0], 0, 0, 0); oa[1] = __builtin_amdgcn_mfma_f32_16x16x32_bf16(a, vb[1][s], oa[1], 0, 0, 0); }
#pragma unroll
                    for (int s = 0; s < 4; ++s) { const bf16x8 a = *(const LAS bf16x8*)(buf + HW_QD + (16 * mt + l15) * 272 + (32 * s + 8 * G4) * 2);
                        oa[0] = __builtin_amdgcn_mfma_f32_16x16x32_bf16(a, sb[0][s], oa[0], 0, 0, 0); oa[1] = __builtin_amdgcn_mfma_f32_16x16x32_bf16(a, sb[1][s], oa[1], 0, 0, 0); }
#pragma unroll
                    for (int nt = 0; nt < 2; ++nt)
#pragma unroll
                        for (int r = 0; r < 4; ++r) *(LAS bf16_t*)(lds + HW_OS + (16 * mt + 4 * G4 + r) * 272 + (32 * w + 16 * nt + l15) * 2) = f2bf(oa[nt][r]);
                }
            }
#pragma unroll
            for (int t = 0; t < 8; ++t) {
                const f32x4 d4 = *(const LAS f32x4*)(lds + HW_DEC + par * 512 + (16 * t + 4 * G4) * 4);
                S[t][0] = S[t][0] * d4; S[t][1] = S[t][1] * d4;
#pragma unroll
                for (int s = 0; s < 2; ++s) { const bf16x8 a = *(const LAS bf16x8*)(buf + HW_KET + (16 * t + l15) * 144 + (32 * s + 8 * G4) * 2);
                    S[t][0] = __builtin_amdgcn_mfma_f32_16x16x32_bf16(a, vb[0][s], S[t][0], 0, 0, 0); S[t][1] = __builtin_amdgcn_mfma_f32_16x16x32_bf16(a, vb[1][s], S[t][1], 0, 0, 0); }
            }
            HW_BAR();
            if (lat) {
                const int j = tid >> 2, part = tid & 3, p = 64 * n + j, tt = dir ? T - 1 - (p - CTXL) : (p - CTXL);
                bf16_t* dst = OD + ((size_t)b * T + tt) * HGW + h * 128 + part * 32;
#pragma unroll
                for (int q = 0; q < 4; ++q) *(u32x4*)(dst + q * 8) = *(const LAS u32x4*)(lds + HW_OS + j * 272 + part * 64 + q * 16);
            }
        }
    }
    __syncthreads();
#undef HW_BAR
}

__device__ __forceinline__ size_t rg_row(int b, bool lat, int p) {
    return lat ? (size_t)b * T + (size_t)(p % GROWS) * GRIDW + (p / GROWS) : (size_t)NLAT + b * CTXL + p;
}
constexpr int RC_T = 64 * 144;
constexpr int RC_XC = 0, RC_RG = 2 * RC_T, RC_HI = 4 * RC_T, RC_OUT = 6 * RC_T;
__device__ __forceinline__ void phase_rg_chain(LAS unsigned char* lds, const bf16_t* __restrict__ P, const float* __restrict__ conv_w, const float* __restrict__ conv_b, const bf16_t* __restrict__ WG_t,
                                               const float* __restrict__ ba, const float* __restrict__ bx, const float* __restrict__ coef, bf16_t* __restrict__ HT, bf16_t* __restrict__ MIX, int item) {
    const int b = item >> 3, hd = item & 7;
    const int tid = threadIdx.x, w = __builtin_amdgcn_readfirstlane(tid >> 6), lane = tid & 63, l15 = lane & 15, G4 = lane >> 4;
    const int d = w >> 2, cg = w & 3, ch = 64 * hd + 16 * cg + l15;
    const int ds = tid >> 8, t8 = tid & 255, pg = t8 >> 4, cg4 = t8 & 15;
    bf16x8 F[4];
#pragma unroll
    for (int s = 0; s < 2; ++s) {
        F[s] = *(const bf16x8*)(WG_t + ((size_t)(hd * 256 + 64 * (2 * d) + 16 * cg + l15) * 64 + 32 * s + 8 * G4));
        F[2 + s] = *(const bf16x8*)(WG_t + ((size_t)(hd * 256 + 64 * (2 * d + 1) + 16 * cg + l15) * 64 + 32 * s + 8 * G4)); }
    const float bav = ba[d * RGW + ch], bxv = bx[d * RGW + ch], cf = coef[d * RGW + ch];
    const f32x4 cw0 = *(const f32x4*)(conv_w + 0 * RGW + 64 * hd + 4 * cg4), cw1 = *(const f32x4*)(conv_w + 1 * RGW + 64 * hd + 4 * cg4), cw2 = *(const f32x4*)(conv_w + 2 * RGW + 64 * hd + 4 * cg4),
                cw3 = *(const f32x4*)(conv_w + 3 * RGW + 64 * hd + 4 * cg4), cb4 = *(const f32x4*)(conv_b + 64 * hd + 4 * cg4);
    float hcar = 0.f;
#define RC_CHUNK(dd, s_) ((dd) == 0 ? (s_) : ((s_) < CTXL / 64 ? CTXL / 64 - 1 - (s_) : NCHK + CTXL / 64 - 1 - (s_)))
    u32x2 rxr[7]; u32x4 rgr[2], hir[2];
#define RC_LOAD_RX(s_) do { const int n_ = RC_CHUNK(ds, s_); const bool lat_ = n_ >= CTXL / 64; const int L_ = lat_ ? T : CTXL, p0_ = 64 * (lat_ ? n_ - CTXL / 64 : n_); \
        _Pragma("unroll") for (int i = 0; i < 7; ++i) { const int p = p0_ + 4 * pg - 2 + i; rxr[i] = (p >= 0 && p < L_) ? *(const u32x2*)(P + rg_row(b, lat_, p) * INW + C_RX + 64 * hd + 4 * cg4) : (u32x2){0u, 0u}; } } while (0)
#define RC_ROW(s_, q_) (rg_row(b, true, 64 * (RC_CHUNK(ds, s_) - CTXL / 64) + ((q_) >> 3)))
#define RC_LOAD_RG(s_) do { _Pragma("unroll") for (int j = 0; j < 2; ++j) { const int q = t8 * 2 + j; rgr[j] = *(const u32x4*)(P + RC_ROW(s_, q) * INW + C_RG + 64 * hd + (q & 7) * 8); } } while (0)
#define RC_LOAD_HI(s_) do { _Pragma("unroll") for (int j = 0; j < 2; ++j) { const int q = t8 * 2 + j; rgr[j] = rgr[j]; hir[j] = __builtin_nontemporal_load((const u32x4*)(HT + RC_ROW(s_, q) * RGW + 64 * hd + (q & 7) * 8)); } } while (0)
    RC_LOAD_RX(0);
#pragma unroll 1
    for (int s = 0; s < NCHK; ++s) {
        const int role = s < CTXL / 64 ? 0 : (s < 20 ? 1 : 2);
        if (s == 20) { asm volatile("s_waitcnt vmcnt(0)" ::: "memory"); __syncthreads(); RC_LOAD_RG(20); RC_LOAD_HI(20); }
        {
            float xin[7][4];
#pragma unroll
            for (int i = 0; i < 7; ++i) { xin[i][0] = __uint_as_float(rxr[i].x << 16); xin[i][1] = __uint_as_float(rxr[i].x & 0xffff0000u); xin[i][2] = __uint_as_float(rxr[i].y << 16); xin[i][3] = __uint_as_float(rxr[i].y & 0xffff0000u); }
#pragma unroll
            for (int q = 0; q < 4; ++q) {
                float o[4];
#pragma unroll
                for (int c = 0; c < 4; ++c) o[c] = cb4[c] + cw0[c] * xin[q][c] + cw1[c] * xin[q + 1][c] + cw2[c] * xin[q + 2][c] + cw3[c] * xin[q + 3][c];
                *(LAS unsigned long long*)(lds + RC_XC + ds * RC_T + (4 * pg + q) * 144 + cg4 * 8) = ((unsigned long long)cvt_pk_bf16(o[2], o[3]) << 32) | cvt_pk_bf16(o[0], o[1]);
            }
            if (role == 2) {
#pragma unroll
                for (int j = 0; j < 2; ++j) { const int q = t8 * 2 + j; *(LAS u32x4*)(lds + RC_RG + ds * RC_T + (q >> 3) * 144 + (q & 7) * 16) = rgr[j]; *(LAS u32x4*)(lds + RC_HI + ds * RC_T + (q >> 3) * 144 + (q & 7) * 16) = hir[j]; }
            }
        }
        __syncthreads();
        if (s + 1 < NCHK) { RC_LOAD_RX(s + 1); if (s + 1 > 20) { RC_LOAD_RG(s + 1); RC_LOAD_HI(s + 1); } }
        {
            bf16x8 af[4][2];
#pragma unroll
            for (int mt = 0; mt < 4; ++mt)
#pragma unroll
                for (int k = 0; k < 2; ++k) af[mt][k] = *(const LAS bf16x8*)(lds + RC_XC + d * RC_T + (16 * (l15 >> 2) + 4 * mt + (l15 & 3)) * 144 + (32 * k + 8 * G4) * 2);
            f32x4 ra[4], xa[4];
#pragma unroll
            for (int mt = 0; mt < 4; ++mt) { ra[mt] = (f32x4){0.f, 0.f, 0.f, 0.f}; xa[mt] = (f32x4){0.f, 0.f, 0.f, 0.f};
#pragma unroll
                for (int k = 0; k < 2; ++k) { ra[mt] = __builtin_amdgcn_mfma_f32_16x16x32_bf16(af[mt][k], F[k], ra[mt], 0, 0, 0); xa[mt] = __builtin_amdgcn_mfma_f32_16x16x32_bf16(af[mt][k], F[2 + k], xa[mt], 0, 0, 0); } }
            float av[16], bv[16];
#pragma unroll
            for (int t = 0; t < 16; ++t) {
                const float r = sigmoidf_(ra[t >> 2][t & 3] + bav), ig = sigmoidf_(xa[t >> 2][t & 3] + bxv);
                const float a = fexp(cf * r);
                av[t] = a; bv[t] = fsqrt(fmaxf(1.0f - a * a, 0.f)) * ig * bf2f(*(const LAS bf16_t*)(lds + RC_XC + d * RC_T + (16 * G4 + t) * 144 + (16 * cg + l15) * 2));
            }
            float Al = 1.f, Bl = 0.f;
            if (d == 0) {
#pragma unroll
                for (int t = 0; t < 16; ++t) { Bl = av[t] * Bl + bv[t]; Al *= av[t]; }
            } else {
#pragma unroll
                for (int t = 15; t >= 0; --t) { Bl = av[t] * Bl + bv[t]; Al *= av[t]; }
            }
            float Ag[4], Bg[4];
#pragma unroll
            for (int g = 0; g < 4; ++g) { Ag[g] = __shfl(Al, l15 + 16 * g); Bg[g] = __shfl(Bl, l15 + 16 * g); }
            float h = hcar, hend;
            if (d == 0) {
                const float s1 = Ag[0] * h + Bg[0], s2 = Ag[1] * s1 + Bg[1], s3 = Ag[2] * s2 + Bg[2]; hend = Ag[3] * s3 + Bg[3];
                h = G4 == 0 ? h : G4 == 1 ? s1 : G4 == 2 ? s2 : s3;
            } else {
                const float s2 = Ag[3] * h + Bg[3], s1 = Ag[2] * s2 + Bg[2], s0 = Ag[1] * s1 + Bg[1]; hend = Ag[0] * s0 + Bg[0];
                h = G4 == 3 ? h : G4 == 2 ? s2 : G4 == 1 ? s1 : s0;
            }
            hcar = hend;
            if (role != 0) {
                float hv[16];
                if (d == 0) {
#pragma unroll
                    for (int t = 0; t < 16; ++t) { h = av[t] * h + bv[t]; hv[t] = h; }
                } else {
#pragma unroll
                    for (int t = 15; t >= 0; --t) { h = av[t] * h + bv[t]; hv[t] = h; }
                }
#pragma unroll
                for (int t = 0; t < 16; ++t) {
                    const int off = (16 * G4 + t) * 144 + (16 * cg + l15) * 2;
                    float o = hv[t];
                    if (role == 2) o = gelu_tanh(bf2f(*(const LAS bf16_t*)(lds + RC_RG + d * RC_T + off))) * (o + bf2f(*(const LAS bf16_t*)(lds + RC_HI + d * RC_T + off)));
                    *(LAS bf16_t*)(lds + RC_OUT + d * RC_T + off) = f2bf(o);
                }
            }
        }
        __syncthreads();
        if (role != 0) {
#pragma unroll
            for (int j = 0; j < 2; ++j) { const int q = t8 * 2 + j; const u32x4 v = *(const LAS u32x4*)(lds + RC_OUT + ds * RC_T + (q >> 3) * 144 + (q & 7) * 16);
                if (role == 1) *(u32x4*)(HT + RC_ROW(s, q) * RGW + 64 * hd + (q & 7) * 8) = v;
                else *(u32x4*)(MIX + RC_ROW(s, q) * D + HGW + 64 * hd + (q & 7) * 8) = v; }
        }
    }
#undef RC_CHUNK
#undef RC_LOAD_RX
#undef RC_ROW
#undef RC_LOAD_RG
#undef RC_LOAD_HI
}

__device__ __forceinline__ void phase_mix_finish(const bf16_t* __restrict__ P, const bf16_t* __restrict__ OF, const bf16_t* __restrict__ OB,
                                                 const float* __restrict__ hg_nw, bf16_t* __restrict__ MIX, int bid, int G) {
    constexpr int RB = 4;
    const int lane = threadIdx.x & 63, gw = bid * 8 + (threadIdx.x >> 6), NW = G * 8, c0 = lane * 8;
    const f32x4 nw0 = *(const f32x4*)(hg_nw + c0), nw1 = *(const f32x4*)(hg_nw + c0 + 4);
    const float nwv[8] = {nw0[0], nw0[1], nw0[2], nw0[3], nw1[0], nw1[1], nw1[2], nw1[3]};
    for (int r0 = gw; r0 < NLAT; r0 += RB * NW) {
        u32x4 a4[RB], b4[RB], g4[RB];
#pragma unroll
        for (int q = 0; q < RB; ++q) { const int r = r0 + q * NW; const int rr = r < NLAT ? r : r0;
            a4[q] = *(const u32x4*)(OF + (size_t)rr * HGW + c0); b4[q] = *(const u32x4*)(OB + (size_t)rr * HGW + c0); g4[q] = *(const u32x4*)(P + (size_t)rr * INW + C_G + c0); }
#pragma unroll
        for (int q = 0; q < RB; ++q) { const int r = r0 + q * NW; if (r < NLAT) {
            float o[8]; float ss = 0.f;
#pragma unroll
            for (int i = 0; i < 4; ++i) { o[2 * i] = __uint_as_float(a4[q][i] << 16) + __uint_as_float(b4[q][i] << 16); o[2 * i + 1] = __uint_as_float(a4[q][i] & 0xffff0000u) + __uint_as_float(b4[q][i] & 0xffff0000u); }
#pragma unroll
            for (int i = 0; i < 8; ++i) ss += o[i] * o[i];
            ss += __shfl_xor(ss, 1); ss += __shfl_xor(ss, 2); ss += __shfl_xor(ss, 4); ss += __shfl_xor(ss, 8);
            const float rstd = __builtin_amdgcn_rsqf(ss * (1.0f / 128.0f) + EPS);
            u32x4 w;
#pragma unroll
            for (int i = 0; i < 4; ++i) {
                const float g0 = __uint_as_float(g4[q][i] << 16), g1 = __uint_as_float(g4[q][i] & 0xffff0000u);
                w[i] = cvt_pk_bf16(o[2 * i] * rstd * nwv[2 * i] * (g0 * sigmoidf_(g0)), o[2 * i + 1] * rstd * nwv[2 * i + 1] * (g1 * sigmoidf_(g1)));
            }
            *(u32x4*)(MIX + (size_t)r * D + c0) = w;
        } }
    }
}

__device__ __forceinline__ void phase_norm2_route(LAS unsigned char* lds, const bf16_t* __restrict__ x1, const float* __restrict__ nw, const float* __restrict__ mod,
                                                  const float* __restrict__ rw, const float* __restrict__ rb, fp8_t* __restrict__ H2,
                                                  u32* __restrict__ cnt, u32* __restrict__ toktab, float* __restrict__ wtab, int bid, int G) {
    LAS float* rwT = (LAS float*)lds;
    LAS u32* hist = (LAS u32*)(lds + 131072);
    LAS u32* ent = (LAS u32*)(lds + 131072 + 4096);
    const int tid = threadIdx.x, lane = tid & 63, w = tid >> 6;
    for (int i = tid; i < 32 * 1024; i += 512) { const int k = i >> 5, e = i & 31; rwT[e * 1024 + k] = rw[i]; }
    if (tid < 128) hist[tid] = 0;
    __syncthreads();
    const int gw = bid * 8 + w, NW = G * 8;
    const int myexp = ((lane >> 5) & 1) * 16 + ((lane >> 4) & 1) * 8 + ((lane >> 3) & 1) * 4 + ((lane >> 2) & 1) * 2 + ((lane >> 1) & 1);
    const float myrb = rb[myexp];
    int it = 0;
    u32x2 rawn[2][4];
#pragma unroll
    for (int q = 0; q < 2; ++q)
#pragma unroll
        for (int j = 0; j < 4; ++j) rawn[q][j] = __builtin_nontemporal_load((const u32x2*)(x1 + (size_t)(gw + q * NW) * D + j * 256 + lane * 4));
    for (int r0 = gw; r0 < NLAT; r0 += 2 * NW, it += 2) {
        f32x4 v[2][4];
        u32x2 rawc[2][4];
#pragma unroll
        for (int q = 0; q < 2; ++q)
#pragma unroll
            for (int j = 0; j < 4; ++j) rawc[q][j] = rawn[q][j];
        { const int rn0 = r0 + 2 * NW < NLAT ? r0 + 2 * NW : r0;
#pragma unroll
          for (int q = 0; q < 2; ++q)
#pragma unroll
            for (int j = 0; j < 4; ++j) rawn[q][j] = __builtin_nontemporal_load((const u32x2*)(x1 + (size_t)(rn0 + q * NW) * D + j * 256 + lane * 4)); }
#pragma unroll
        for (int q = 0; q < 2; ++q) {
            const int r = r0 + q * NW;
            const float* m = mod + (size_t)(r >> 11) * 6144;
            u32x2 raw[4];
#pragma unroll
            for (int j = 0; j < 4; ++j) raw[j] = rawc[q][j];
            float ss = 0.f;
#pragma unroll
            for (int j = 0; j < 4; ++j) { v[q][j][0] = __uint_as_float(raw[j].x << 16); v[q][j][1] = __uint_as_float(raw[j].x & 0xffff0000u); v[q][j][2] = __uint_as_float(raw[j].y << 16); v[q][j][3] = __uint_as_float(raw[j].y & 0xffff0000u);
                ss += v[q][j][0] * v[q][j][0] + v[q][j][1] * v[q][j][1] + v[q][j][2] * v[q][j][2] + v[q][j][3] * v[q][j][3]; }
            const float rstd = __builtin_amdgcn_rsqf(wave_sum(ss) * (1.0f / D) + EPS);
#pragma unroll
            for (int j = 0; j < 4; ++j) {
                const int c0 = j * 256 + lane * 4;
                const f32x4 ww = *(const f32x4*)(nw + c0), sh = *(const f32x4*)(m + 3072 + c0), sc = *(const f32x4*)(m + 4096 + c0);
                v[q][j] = v[q][j] * rstd * ww * (sc + 1.0f) + sh;
                *(unsigned*)(H2 + (size_t)r * D + c0) = pk4_fp8(v[q][j][0] * SC_H2, v[q][j][1] * SC_H2, v[q][j][2] * SC_H2, v[q][j][3] * SC_H2);
            }
        }
        float part[2][32];
#pragma unroll
        for (int e = 0; e < 32; ++e) {
            float p0 = 0.f, p1 = 0.f;
#pragma unroll
            for (int j = 0; j < 4; ++j) { const f32x4 q = *(const LAS f32x4*)(rwT + e * 1024 + j * 256 + lane * 4);
                p0 += v[0][j][0] * q[0] + v[0][j][1] * q[1] + v[0][j][2] * q[2] + v[0][j][3] * q[3]; p1 += v[1][j][0] * q[0] + v[1][j][1] * q[1] + v[1][j][2] * q[2] + v[1][j][3] * q[3]; }
            part[0][e] = p0; part[1][e] = p1;
        }
#define RT_STEP(N, M) { const bool up = (lane & (M)) != 0; _Pragma("unroll") for (int q = 0; q < 2; ++q) _Pragma("unroll") for (int i = 0; i < (N); ++i) { const float keep = up ? part[q][(N) + i] : part[q][i], send = up ? part[q][i] : part[q][(N) + i]; part[q][i] = keep + __shfl_xor(send, (M)); } }
        RT_STEP(16, 32) RT_STEP(8, 16) RT_STEP(4, 8) RT_STEP(2, 4) RT_STEP(1, 2)
#undef RT_STEP
#pragma unroll
        for (int q = 0; q < 2; ++q) {
            const int r = r0 + q * NW;
            const float mylogit = part[q][0] + __shfl_xor(part[q][0], 1) + myrb;
            int rank = 0;
#pragma unroll
            for (int x = 0; x < 32; ++x) {
                const int src = ((x >> 4) & 1) * 32 + ((x >> 3) & 1) * 16 + ((x >> 2) & 1) * 8 + ((x >> 1) & 1) * 4 + (x & 1) * 2;
                const float oq = __builtin_bit_cast(float, __builtin_amdgcn_readlane(__builtin_bit_cast(int, mylogit), src));
                rank += (oq > mylogit || (oq == mylogit && x < myexp)) ? 1 : 0;
            }
            float tv[4]; int ti[4];
#pragma unroll
            for (int k = 0; k < 4; ++k) {
                const unsigned long long mk = __ballot(rank == k && (lane & 1) == 0);
                const int src = __builtin_amdgcn_readfirstlane((int)__builtin_ctzll(mk));
                tv[k] = __builtin_bit_cast(float, __builtin_amdgcn_readlane(__builtin_bit_cast(int, mylogit), src));
                ti[k] = ((src >> 5) & 1) * 16 + ((src >> 4) & 1) * 8 + ((src >> 3) & 1) * 4 + ((src >> 2) & 1) * 2 + ((src >> 1) & 1);
            }
            const float e1 = fexp(tv[1] - tv[0]), e2 = fexp(tv[2] - tv[0]), e3 = fexp(tv[3] - tv[0]); const float inv = frcp(1.0f + e1 + e2 + e3);
            const float g0 = inv, g1 = e1 * inv, g2 = e2 * inv, g3 = e3 * inv;
            if (lane < 4) {
                const int half = r >= HALF_TOK ? 1 : 0;
                const int e = lane == 0 ? ti[0] : lane == 1 ? ti[1] : lane == 2 ? ti[2] : ti[3];
                const float gv = lane == 0 ? g0 : lane == 1 ? g1 : lane == 2 ? g2 : g3;
                const u32 lp = atomicAdd((u32*)&hist[half * 32 + e], 1u);
                const int idx = ((it + q) * 8 + w) * 4 + lane;
                ent[idx * 2] = ((u32)e << 24) | lp; ent[idx * 2 + 1] = __float_as_uint(gv);
            }
        }
    }
    __syncthreads();
    if (tid < 64) hist[64 + tid] = atomicAdd(&cnt[tid], hist[tid]);
    __syncthreads();
    it = 0;
    for (int r = gw; r < NLAT; r += NW, ++it) {
        if (lane < 4) {
            const int half = r >= HALF_TOK ? 1 : 0; const int idx = (it * 8 + w) * 4 + lane;
            const u32 ev = ent[idx * 2]; const int e = ev >> 24; const u32 pos = hist[64 + half * 32 + e] + (ev & 0xffffffu);
            toktab[((size_t)half * 32 + e) * CAP + pos] = (u32)r * 4u + lane;
            wtab[((size_t)half * 32 + e) * CAP + pos] = __uint_as_float(ent[idx * 2 + 1]);
        }
    }
}

__device__ __forceinline__ void phase_combine(float* __restrict__ out, const bf16_t* __restrict__ X1, const fp8_t* __restrict__ Y, const float* __restrict__ mod, const float* __restrict__ fw, int bid, int G) {
    constexpr int RB = 2;
    typedef float f32x2_ __attribute__((ext_vector_type(2)));
    const int lane = threadIdx.x & 63, gw = bid * 8 + (threadIdx.x >> 6), NW = G * 8;
    for (int r0 = gw; r0 < NLAT; r0 += RB * NW) {
        u32x2 xv[RB][4]; unsigned yv[RB][4][4];
#pragma unroll
        for (int q = 0; q < RB; ++q) { const int r = r0 + q * NW < NLAT ? r0 + q * NW : r0;
#pragma unroll
            for (int j = 0; j < 4; ++j) { xv[q][j] = __builtin_nontemporal_load((const u32x2*)(X1 + (size_t)r * D + j * 256 + lane * 4));
#pragma unroll
                for (int k = 0; k < 4; ++k) yv[q][j][k] = __builtin_nontemporal_load((const unsigned*)(Y + ((size_t)r * 4 + k) * D + j * 256 + lane * 4)); } }
#pragma unroll
        for (int q = 0; q < RB; ++q) { const int r = r0 + q * NW; if (r < NLAT) {
            const float* g2 = mod + (size_t)(r >> 11) * 6144 + 5120;
            f32x4 v[4]; float ss = 0.f;
#pragma unroll
            for (int j = 0; j < 4; ++j) { const int c0 = j * 256 + lane * 4;
                f32x4 sm = (f32x4){0.f, 0.f, 0.f, 0.f};
#pragma unroll
                for (int k = 0; k < 4; ++k) { const f32x2_ lo = __builtin_amdgcn_cvt_pk_f32_fp8(yv[q][j][k], false), hi = __builtin_amdgcn_cvt_pk_f32_fp8(yv[q][j][k], true); sm[0] += lo[0]; sm[1] += lo[1]; sm[2] += hi[0]; sm[3] += hi[1]; }
                const f32x4 g = *(const f32x4*)(g2 + c0);
                v[j][0] = __uint_as_float(xv[q][j].x << 16); v[j][1] = __uint_as_float(xv[q][j].x & 0xffff0000u); v[j][2] = __uint_as_float(xv[q][j].y << 16); v[j][3] = __uint_as_float(xv[q][j].y & 0xffff0000u);
                v[j] = v[j] + g * sm * (1.0f / SC_Y);
                ss += v[j][0] * v[j][0] + v[j][1] * v[j][1] + v[j][2] * v[j][2] + v[j][3] * v[j][3]; }
            const float rstd = __builtin_amdgcn_rsqf(wave_sum(ss) * (1.0f / D) + EPS);
#pragma unroll
            for (int j = 0; j < 4; ++j) { const int c0 = j * 256 + lane * 4; const f32x4 w = *(const f32x4*)(fw + c0); __builtin_nontemporal_store(v[j] * rstd * w, (f32x4*)(out + (size_t)r * D + c0)); }
        } }
    }
}

#define XB_TMO      128
#define XB_XCNT(j)  (256  + 64 * (j))
#define XB_XSUB(j)  (1280 + 64 * (j))
#define XB_XGEN(j)  (2304 + 64 * (j))
#define XB_TOP      3328
#define XB_TOPGEN   3392
#define XCD_BAR_WORDS 3456
#define XB_SPIN_CAP (1u << 20)
__device__ __forceinline__ unsigned xb_ld(unsigned* p)              { return __hip_atomic_load(p, __ATOMIC_RELAXED, __HIP_MEMORY_SCOPE_AGENT); }
__device__ __forceinline__ unsigned xb_add(unsigned* p, unsigned v) { return __hip_atomic_fetch_add(p, v, __ATOMIC_RELAXED, __HIP_MEMORY_SCOPE_AGENT); }
__device__ __forceinline__ unsigned xb_xcc_id() { return (unsigned)__builtin_amdgcn_s_getreg((3 << 11) | 20) & 0xFu; }
#define XB_SPIN(cond, bar) do { unsigned _sp = 0; while (cond) { __builtin_amdgcn_s_sleep(1); \
    if ((++_sp & 255u) == 0u) { if (xb_ld(&(bar)[XB_TMO])) break; if (_sp > XB_SPIN_CAP) { atomicAdd(&(bar)[XB_TMO], 1u); break; } } } } while (0)
struct XcdBarrier { unsigned* bar; unsigned x; volatile LAS unsigned* st; };
__device__ __forceinline__ XcdBarrier xcd_barrier_post(unsigned* bar, volatile LAS unsigned* st) {
    XcdBarrier b; b.bar = bar; b.x = xb_xcc_id(); b.st = st;
    if (threadIdx.x == 0) (void)xb_add(&bar[XB_XCNT(b.x)], 1u);
    return b;
}
__device__ __forceinline__ void xcd_barrier_complete(unsigned* bar, unsigned x, unsigned& nloc, unsigned& nx) {
    const unsigned G = gridDim.x * gridDim.y * gridDim.z;
    unsigned sum, cnt, mine, sp = 0u;
    for (;;) {
        sum = 0u; cnt = 0u; mine = 0u;
#pragma unroll
        for (unsigned j = 0; j < 16; ++j) { const unsigned c = xb_ld(&bar[XB_XCNT(j)]); sum += c; cnt += (c > 0u) ? 1u : 0u; mine = (j == x) ? c : mine; }
        if (sum == G) break;
        __builtin_amdgcn_s_sleep(1);
        if ((++sp & 255u) == 0u) { if (xb_ld(&bar[XB_TMO])) break; if (sp > XB_SPIN_CAP) { atomicAdd(&bar[XB_TMO], 1u); break; } }
    }
    nloc = mine > 0u ? mine : 1u; nx = cnt > 0u ? cnt : 1u;
}
__device__ __forceinline__ void xcd_barrier(unsigned* bar, volatile LAS unsigned* st) {
    asm volatile("s_waitcnt vmcnt(0)" ::: "memory");
    __syncthreads();
    if (threadIdx.x == 0) {
        __builtin_amdgcn_s_waitcnt(0);
        const unsigned x = xb_xcc_id();
        unsigned nloc = st[0], nx = st[1];
        if (nloc == 0u) { xcd_barrier_complete(bar, x, nloc, nx); st[0] = nloc; st[1] = nx; }
        const unsigned old = xb_add(&bar[XB_XSUB(x)], 1u);
        const unsigned gen = old / nloc;
        if (old + 1u == (gen + 1u) * nloc) {
            __builtin_amdgcn_fence(__ATOMIC_RELEASE, "agent");
            asm volatile("s_waitcnt vmcnt(0)" ::: "memory");
            const unsigned og = xb_add(&bar[XB_TOP], 1u);
            const unsigned tg = og / nx;
            if (og + 1u == (tg + 1u) * nx) xb_add(&bar[XB_TOPGEN], 1u);
            else XB_SPIN(xb_ld(&bar[XB_TOPGEN]) == tg, bar);
            __builtin_amdgcn_fence(__ATOMIC_ACQUIRE, "agent");
            xb_add(&bar[XB_XGEN(x)], 1u);
            asm volatile("s_waitcnt vmcnt(0)" ::: "memory");
        } else {
            XB_SPIN(xb_ld(&bar[XB_XGEN(x)]) == gen, bar);
            __builtin_amdgcn_fence(__ATOMIC_ACQUIRE, "agent");
            asm volatile("s_waitcnt vmcnt(0)" ::: "memory");
        }
    }
    __syncthreads();
}
constexpr size_t WS_BAR = 16384;
constexpr int LDS_BARST = LDS_BYTES - 16;

struct MegaArgs {
    const float *x, *c, *ctx, *c_ctx, *norm1_w, *norm2_w, *w_ada, *b_ada, *w_in, *lbl, *hg_nw, *conv_w, *conv_b, *rg_wa, *rg_ba, *rg_wx, *rg_bx, *rg_lam, *w_out,
        *router_w, *router_b, *wgu, *bgu, *wd, *bd, *final_w;
    float* out; unsigned char* ws;
};
typedef const MegaArgs __attribute__((address_space(4)))* KArgs;
__device__ __forceinline__ KArgs kargs() { auto p = __builtin_amdgcn_kernarg_segment_ptr(); asm volatile("" : "+s"(p)); return (KArgs)p; }
#define WSP(T, off) ((T*)(ws + (off)))
#define GRID_SYNC_CG() cg::this_grid().sync()
#define GRID_SYNC() do { KArgs a_ = kargs(); xcd_barrier((unsigned*)(a_->ws + WS_BAR), (volatile LAS unsigned*)(lds + LDS_BARST)); } while (0)
__global__ __launch_bounds__(512, 2) void k_mega(MegaArgs a_unused) {
    extern __shared__ __attribute__((aligned(16))) unsigned char lds_[];
    LAS unsigned char* lds = (LAS unsigned char*)lds_;
    if (threadIdx.x < 4) ((volatile LAS unsigned*)(lds + LDS_BARST))[threadIdx.x] = 0u;
    __syncthreads();
    { KArgs a = kargs(); (void)xcd_barrier_post((unsigned*)(a->ws + WS_BAR), (volatile LAS unsigned*)(lds + LDS_BARST)); }
    { KArgs a = kargs(); unsigned char* ws = a->ws; const int bid = blockIdx.x, G = gridDim.x;
      ProArgs pa; pa.c = a->c; pa.c_ctx = a->c_ctx; pa.w_ada = a->w_ada; pa.b_ada = a->b_ada; pa.lbl = a->lbl; pa.w_in = a->w_in; pa.w_out = a->w_out; pa.wgu = a->wgu; pa.wd = a->wd; pa.rg_wa = a->rg_wa; pa.rg_wx = a->rg_wx; pa.rg_lam = a->rg_lam;
      pa.coef = WSP(float, WS_COEF); pa.WG_t = WSP(bf16_t, WS_WG); pa.mod = WSP(float, WS_MOD); pa.lb = WSP(float, WS_LB); pa.Win_t = WSP(bf16_t, WS_WIN); pa.Wout_t = WSP(bf16_t, WS_WOUT); pa.Wgu_t = WSP(fp8_t, WS_WGU); pa.Wd_t = WSP(fp8_t, WS_WD);
      phase_prologue(lds, pa, bid, G, true, 0, 0); }
    { KArgs a_ = kargs(); if (a_->ws == nullptr) GRID_SYNC_CG(); }
    GRID_SYNC();
    { KArgs a = kargs(); unsigned char* ws = a->ws; phase_norm1(a->x, a->ctx, a->norm1_w, WSP(float, WS_MOD), WSP(bf16_t, WS_H), blockIdx.x, gridDim.x); }
    { KArgs a = kargs(); unsigned char* ws = a->ws;
      ProArgs pa; pa.c = nullptr; pa.c_ctx = nullptr; pa.w_ada = nullptr; pa.b_ada = nullptr; pa.lbl = nullptr; pa.w_in = a->w_in; pa.w_out = a->w_out; pa.wgu = nullptr; pa.wd = nullptr; pa.rg_wa = nullptr; pa.rg_wx = nullptr; pa.rg_lam = nullptr; pa.coef = nullptr; pa.WG_t = nullptr;
      pa.mod = nullptr; pa.lb = nullptr; pa.Win_t = WSP(bf16_t, WS_WIN); pa.Wout_t = WSP(bf16_t, WS_WOUT); pa.Wgu_t = nullptr; pa.Wd_t = nullptr;
      phase_prologue(lds, pa, blockIdx.x, gridDim.x, false, 0, IT_IN + IT_OUT); }
    GRID_SYNC();
    { KArgs a = kargs(); unsigned char* ws = a->ws; PolInProj P; P.A = WSP(bf16_t, WS_H); P.Bt = WSP(bf16_t, WS_WIN); P.O = WSP(bf16_t, WS_PROJ); P.ord.init(NLAT / BM, INW / BM, gridDim.x, blockIdx.x); gemm_phase(lds, P); }
    GRID_SYNC();
    { KArgs a = kargs(); unsigned char* ws = a->ws;
      for (int item = blockIdx.x; item < 256; item += gridDim.x)
          phase_rg_chain(lds, WSP(bf16_t, WS_PROJ), a->conv_w, a->conv_b, WSP(bf16_t, WS_WG), a->rg_ba, a->rg_bx, WSP(float, WS_COEF), WSP(bf16_t, WS_HF), WSP(bf16_t, WS_MIX2), item); }
    __syncthreads();
    { KArgs a = kargs(); unsigned char* ws = a->ws;
      for (int item = blockIdx.x; item < 256; item += gridDim.x) phase_hgrn2_ws(lds, WSP(bf16_t, WS_PROJ), WSP(float, WS_LB), WSP(bf16_t, WS_OF), WSP(bf16_t, WS_OB), item); }
    GRID_SYNC();
    { KArgs a = kargs(); unsigned char* ws = a->ws; phase_mix_finish(WSP(bf16_t, WS_PROJ), WSP(bf16_t, WS_OF), WSP(bf16_t, WS_OB), a->hg_nw, WSP(bf16_t, WS_MIX2), blockIdx.x, gridDim.x); }
    GRID_SYNC();
    { KArgs a = kargs(); unsigned char* ws = a->ws; PolOutProj P; P.A = WSP(bf16_t, WS_MIX2); P.Bt = WSP(bf16_t, WS_WOUT); P.x = a->x; P.mod = WSP(float, WS_MOD); P.O = WSP(bf16_t, WS_X1); P.ord.init(NLAT / BM, D / BM, gridDim.x, blockIdx.x); gemm_phase(lds, P); }
    GRID_SYNC();
    { KArgs a = kargs(); unsigned char* ws = a->ws;
      phase_norm2_route(lds, WSP(bf16_t, WS_X1), a->norm2_w, WSP(float, WS_MOD), a->router_w, a->router_b, WSP(fp8_t, WS_H2), WSP(u32, WS_CTL), WSP(u32, WS_TOKTAB), WSP(float, WS_WTAB), blockIdx.x, gridDim.x); }
    __syncthreads();
    { KArgs a = kargs(); unsigned char* ws = a->ws;
      ProArgs pa; pa.c = nullptr; pa.c_ctx = nullptr; pa.w_ada = nullptr; pa.b_ada = nullptr; pa.lbl = nullptr; pa.w_in = nullptr; pa.w_out = nullptr; pa.wgu = a->wgu; pa.wd = a->wd; pa.rg_wa = nullptr; pa.rg_wx = nullptr; pa.rg_lam = nullptr; pa.coef = nullptr; pa.WG_t = nullptr;
      pa.mod = nullptr; pa.lb = nullptr; pa.Win_t = nullptr; pa.Wout_t = nullptr; pa.Wgu_t = WSP(fp8_t, WS_WGU); pa.Wd_t = WSP(fp8_t, WS_WD);
      phase_prologue(lds, pa, blockIdx.x, gridDim.x, false, IT_IN + IT_OUT, IT_ALL); }
    GRID_SYNC();
#pragma unroll 1
    for (int half = 0; half < NHALF; ++half) {
        { KArgs a = kargs(); unsigned char* ws = a->ws; LAS int* tstart = (LAS int*)(lds + LDS_AUX);
          const int tot = moe_tile_table(tstart, WSP(u32, WS_CTL), half);
          PolGateUp P; P.A = WSP(fp8_t, WS_H2); P.Bt = WSP(fp8_t, WS_WGU); P.bgu = a->bgu; P.toktab = WSP(u32, WS_TOKTAB); P.wtab = WSP(float, WS_WTAB); P.O = WSP(fp8_t, WS_ACT); P.mt.tstart = tstart; P.mt.cnt = WSP(u32, WS_CTL); P.mt.half = half;
          P.ord.init(tot, DFF / HALFT, gridDim.x, blockIdx.x);
          gemm_phase(lds, P); }
        GRID_SYNC();
        { KArgs a = kargs(); unsigned char* ws = a->ws; LAS int* tstart = (LAS int*)(lds + LDS_AUX);
          const int tot = moe_tile_table(tstart, WSP(u32, WS_CTL), half);
          PolDown P; P.A = WSP(fp8_t, WS_ACT); P.Bt = WSP(fp8_t, WS_WD); P.bd = a->bd; P.toktab = WSP(u32, WS_TOKTAB); P.wtab = WSP(float, WS_WTAB); P.O = WSP(fp8_t, WS_Y); P.mt.tstart = tstart; P.mt.cnt = WSP(u32, WS_CTL); P.mt.half = half;
          P.ord.init(tot, D / BM, gridDim.x, blockIdx.x);
          gemm_phase(lds, P); }
        GRID_SYNC();
        { KArgs a = kargs(); unsigned char* ws = a->ws; phase_combine(a->out, WSP(bf16_t, WS_X1), WSP(fp8_t, WS_Y), WSP(float, WS_MOD), a->final_w, blockIdx.x, gridDim.x); }
        __syncthreads();
    }
}

extern "C" void kernel_launch(void* const* d_in, const int* in_sizes, int n_in, void* d_out, int out_size, void* d_ws, size_t ws_size, hipStream_t stream) {
    static int grid_blocks = 0;
    if (!grid_blocks) {
        int dev = 0, cus = 0, per_cu = 0;
        (void)hipGetDevice(&dev);
        (void)hipDeviceGetAttribute(&cus, hipDeviceAttributeMultiprocessorCount, dev);
        (void)hipFuncSetAttribute((const void*)k_mega, hipFuncAttributeMaxDynamicSharedMemorySize, LDS_BYTES);
        (void)hipOccupancyMaxActiveBlocksPerMultiprocessor(&per_cu, (const void*)k_mega, 512, LDS_BYTES);
        if (per_cu < 1) { fprintf(stderr, "kernel_launch: occupancy query says %d blocks/CU\n", per_cu); per_cu = 1; }
        grid_blocks = cus * 1;
    }
    if (ws_size < 1024 * MiB) { fprintf(stderr, "kernel_launch: workspace too small (%zu)\n", ws_size); return; }
    MegaArgs a{};
    const float** ap = (const float**)&a;
    for (int i = 0; i < 26; ++i) ap[i] = (const float*)d_in[i];
    a.out = (float*)d_out; a.ws = (unsigned char*)d_ws;
    (void)hipMemsetAsync((unsigned char*)d_ws + WS_CTL, 0, 32768, stream);
    void* args[] = {&a};
    hipError_t e = hipLaunchCooperativeKernel((const void*)k_mega, dim3(grid_blocks), dim3(512), args, LDS_BYTES, stream);
    if (e != hipSuccess) fprintf(stderr, "cooperative launch failed: %s (grid %d)\n", hipGetErrorString(e), grid_blocks);
}
```

```cpp
#include <hip/hip_runtime.h>
#include <hip/hip_cooperative_groups.h>
#include <cstdio>
#include <cstdint>

typedef unsigned short bf16_t;
typedef unsigned int u32;
namespace cg = cooperative_groups;

constexpr int D = 1024, NB = 32, T = 2048, CTXL = 256, GRIDW = 64, GROWS = T / GRIDW;
constexpr int NLAT = NB * T;
constexpr int NCTX = NB * CTXL;
constexpr int NROWS = NLAT + NCTX;
constexpr int HGW = 512, RGW = 512, INW = 3584;
constexpr int C_Q = 0, C_I = 512, C_FF = 1024, C_FB = 1536, C_G = 2048, C_RX = 2560, C_RG = 3072;
constexpr int NE = 32, TOPK = 4, DFF = 1024;
constexpr int NCHK = (CTXL + T) / 64;
constexpr int NHALF = 1;
constexpr int HALF_TOK = NLAT / NHALF;
constexpr int CAP = HALF_TOK;
constexpr int MAXSLOT = HALF_TOK * TOPK + NE * 256;
constexpr float EPS = 1e-6f;

constexpr size_t MiB = 1u << 20;
constexpr size_t WS_CTL = 0;
constexpr size_t WS_WG = 64 * 1024;
constexpr size_t WS_MOD = 1 * MiB;
constexpr size_t WS_LB = WS_MOD + 33 * 6144 * 4;
constexpr size_t WS_COEF = WS_LB + 4096;
constexpr size_t WS_TOKTAB = 2 * MiB;
constexpr size_t WS_WTAB = 10 * MiB;
constexpr size_t WS_WIN = 18 * MiB, WS_WOUT = 25 * MiB;
constexpr size_t WS_OF = 28 * MiB, WS_OB = 92 * MiB;
constexpr size_t WS_HF = 156 * MiB;
constexpr size_t WS_H = 284 * MiB;
constexpr size_t WS_MIX2 = WS_H;
constexpr size_t WS_PROJ = 428 * MiB;
constexpr size_t WS_H2 = 28 * MiB;
constexpr size_t WS_WGU = 92 * MiB, WS_WD = 156 * MiB;
constexpr size_t WS_ACT = 188 * MiB;
constexpr size_t WS_Y = 452 * MiB;
constexpr size_t WS_X1 = 708 * MiB;
constexpr float SC_Y = 16.0f;

__device__ __forceinline__ float bf2f(bf16_t b) { return __uint_as_float(((u32)b) << 16); }
__device__ __forceinline__ bf16_t f2bf(float f) { u32 u = __float_as_uint(f); u += 0x7fffu + ((u >> 16) & 1u); return (bf16_t)(u >> 16); }
__device__ __forceinline__ u32 pk2(float lo, float hi) { return (u32)f2bf(lo) | ((u32)f2bf(hi) << 16); }
__device__ __forceinline__ float fexp(float x) { return __builtin_amdgcn_exp2f(x * 1.4426950408889634f); }
__device__ __forceinline__ float frcp(float x) { return __builtin_amdgcn_rcpf(x); }
__device__ __forceinline__ float flog(float x) { return __builtin_amdgcn_logf(x) * 0.6931471805599453f; }
__device__ __forceinline__ float fsqrt(float x) { return __builtin_amdgcn_sqrtf(x); }
__device__ __forceinline__ float sigmoidf_(float x) { return frcp(1.0f + fexp(-x)); }
__device__ __forceinline__ float wave_sum(float v) {
#pragma unroll
    for (int o = 1; o < 64; o <<= 1) v += __shfl_xor(v, o);
    return v;
}

__device__ __forceinline__ float gelu_tanh(float x) { const float u = 1.5957691216057308f * (x + 0.044715f * x * x * x); return x * sigmoidf_(u); }
#define LAS __attribute__((address_space(3)))
typedef short bf16x8 __attribute__((ext_vector_type(8)));
typedef float f32x4 __attribute__((ext_vector_type(4)));
typedef unsigned u32x4 __attribute__((ext_vector_type(4)));
typedef int v8i __attribute__((ext_vector_type(8)));
typedef int v4i_ __attribute__((ext_vector_type(4)));
typedef unsigned u32x2 __attribute__((ext_vector_type(2)));
typedef float f32x2 __attribute__((ext_vector_type(2)));
typedef unsigned char fp8_t;
constexpr float SC_H2 = 16.0f, SC_W = 32.0f, SC_ACT = 4.0f;
__device__ __forceinline__ unsigned pk4_fp8(float a, float b, float c, float d) {
    a = fminf(fmaxf(a, -448.f), 448.f); b = fminf(fmaxf(b, -448.f), 448.f); c = fminf(fmaxf(c, -448.f), 448.f); d = fminf(fmaxf(d, -448.f), 448.f);
    int r = 0; r = __builtin_amdgcn_cvt_pk_fp8_f32(a, b, r, false); r = __builtin_amdgcn_cvt_pk_fp8_f32(c, d, r, true); return (unsigned)r; }
__device__ __forceinline__ unsigned pk4_fp8_nc(float a, float b, float c, float d) { int r = 0; r = __builtin_amdgcn_cvt_pk_fp8_f32(a, b, r, false); r = __builtin_amdgcn_cvt_pk_fp8_f32(c, d, r, true); return (unsigned)r; }
constexpr int BM = 256, BK = 64, HALFT = 128, HTB = HALFT * BK * 2, STAGE_BYTES = 8 * HTB, NXCD = 8, WGM = 8;
constexpr int GK = 1024;
constexpr int LDS_BYTES = 147456;
constexpr int LDS_AUX = STAGE_BYTES;

__device__ __forceinline__ int lds_byte(int r, int c) { const int st = (r >> 4) * 2 + (c >> 5), rr = r & 15, cc = c & 31, ob = rr * 64 + cc * 2; return st * 1024 + (ob ^ (((ob >> 9) & 1) << 5)); }
__device__ __forceinline__ void stage_rc(int b, int& R, int& C) { const int st = b / 1024, sb = b % 1024, swz = sb ^ (((sb >> 9) & 1) << 5); R = (st >> 1) * 16 + swz / 64; C = (st & 1) * 32 + (swz % 64) / 2; }
__device__ __forceinline__ int perm32(int rho) { const int n = rho >> 4, i = rho & 15; return 8 * (i >> 2) + 4 * n + (i & 3); }
__device__ __forceinline__ unsigned cvt_pk_bf16(float lo, float hi) { unsigned r; asm volatile("v_cvt_pk_bf16_f32 %0, %1, %2" : "=v"(r) : "v"(lo), "v"(hi)); return r; }

struct Unit { int pm, pn, e, pos0, cn; };
struct TileOrder {
    int nM, nN, nwg, G, c;
    __device__ __forceinline__ void init(int nM_, int nN_, int G_, int c_) { nM = nM_; nN = nN_; nwg = nM * nN; G = G_; c = c_; }
    __device__ __forceinline__ bool tile(int i, int& pm, int& pn) const {
        const long L = (long)i * G + c; if (L >= nwg) return false;
        int wgid = (int)L; { const int q = nwg / NXCD, r = nwg % NXCD, xcd = wgid % NXCD, off = wgid / NXCD; wgid = (xcd < r ? xcd * (q + 1) : r * (q + 1) + (xcd - r) * q) + off; }
        const int nig = WGM * nN, gid = wgid / nig, fm = gid * WGM, gsz = (nM - fm) < WGM ? (nM - fm) : WGM;
        pm = fm + ((wgid % nig) % gsz); pn = (wgid % nig) / gsz; return true;
    }
};

template <class POL>
__device__ __forceinline__ void gemm_phase(LAS unsigned char* lds, const POL& P) {
    int tid_ = threadIdx.x; asm volatile("" : "+v"(tid_));
    const int tid = tid_, wid = __builtin_amdgcn_readfirstlane(tid >> 6), lane = tid & 63, wr = wid >> 2, wc = wid & 3, fr = lane & 15, fq = lane >> 4;
    constexpr int KB = POL::FP8 ? 1024 : 2048, nt = KB / 128;
    int sR[2], sC[2]; unsigned voffA[2], voffB[2];
#pragma unroll
    for (int i = 0; i < 2; ++i) { stage_rc(tid * 16 + i * 8192, sR[i], sC[i]); const int Rb = POL::PERM ? ((sR[i] & ~31) + perm32(sR[i] & 31)) : sR[i]; voffA[i] = (unsigned)(sR[i] * KB + sC[i] * 2); voffB[i] = (unsigned)(Rb * KB + sC[i] * 2); }
    constexpr size_t kstep = (size_t)(BK * 2);
    constexpr unsigned hstepB = (unsigned)HALFT * KB;
    const unsigned ldsw = (unsigned)wid * 1024u;
    const int aoff = POL::FP8 ? lds_byte(wr * 64 + fr, fq * 16) : lds_byte(wr * 64 + fr, fq * 8), boff = POL::FP8 ? lds_byte(wc * 32 + fr, fq * 16) : lds_byte(wc * 32 + fr, fq * 8);
#define G_SA(b, h) (((b) * 2 + (h)) * HTB)
#define G_SB(b, h) ((4 + (b) * 2 + (h)) * HTB)
#define G_AOFF(OFF, h, i) (POL::GATHER ? (OFF)[h][i] : voffA[i])
#define G_STAGE_A(bufoff, gbase, OFF, h) do { const char* _gb = (const char*)(gbase) + (POL::GATHER ? (size_t)0 : (size_t)(h) * hstepB); _Pragma("unroll") for (int _i = 0; _i < 2; ++_i) \
        __builtin_amdgcn_global_load_lds((const unsigned*)(_gb + G_AOFF(OFF, h, _i)), (LAS unsigned*)(lds + (bufoff) + ldsw + _i * 8192), 16, 0, 0); } while (0)
#define G_STAGE_B(bufoff, gbase, hoff) do { const char* _gb = (const char*)(gbase) + (size_t)(hoff); _Pragma("unroll") for (int _i = 0; _i < 2; ++_i) \
        __builtin_amdgcn_global_load_lds((const unsigned*)(_gb + voffB[_i]), (LAS unsigned*)(lds + (bufoff) + ldsw + _i * 8192), 16, 0, 0); } while (0)
#define G_LD8(p) __builtin_shufflevector(*(const LAS v4i_*)(p), *(const LAS v4i_*)((p) + 16), 0, 1, 2, 3, 4, 5, 6, 7)
#define G_LDA(dst, b, h) do { if (POL::FP8) { _Pragma("unroll") for (int m = 0; m < 4; ++m) dst##8[m] = G_LD8(lds + G_SA(b, h) + aoff + m * 2048); } \
        else { _Pragma("unroll") for (int m = 0; m < 4; ++m) _Pragma("unroll") for (int k = 0; k < 2; ++k) dst[m][k] = *(const LAS bf16x8*)(lds + G_SA(b, h) + aoff + m * 2048 + k * 1024); } } while (0)
#define G_LDB(dst, b, h) do { if (POL::FP8) { _Pragma("unroll") for (int n = 0; n < 2; ++n) dst##8[n] = G_LD8(lds + G_SB(b, h) + boff + n * 2048); } \
        else { _Pragma("unroll") for (int n = 0; n < 2; ++n) _Pragma("unroll") for (int k = 0; k < 2; ++k) dst[n][k] = *(const LAS bf16x8*)(lds + G_SB(b, h) + boff + n * 2048 + k * 1024); } } while (0)
#define G_MMA(ai, bj, At, Bt) do { __builtin_amdgcn_s_setprio(1); \
        if (POL::FP8) { _Pragma("unroll") for (int m = 0; m < 4; ++m) _Pragma("unroll") for (int n = 0; n < 2; ++n) \
            asm volatile("v_mfma_scale_f32_16x16x128_f8f6f4 %0, %1, %2, %0, %3, %3 op_sel_hi:[0,0,0]" : "+v"(acc[ai][bj][m][n]) : "v"(Bt##8[n]), "v"(At##8[m]), "v"(mxs)); } \
        else { _Pragma("unroll") for (int m = 0; m < 4; ++m) _Pragma("unroll") for (int n = 0; n < 2; ++n) _Pragma("unroll") for (int k = 0; k < 2; ++k) \
            acc[ai][bj][m][n] = __builtin_amdgcn_mfma_f32_16x16x32_bf16(Bt[n][k], At[m][k], acc[ai][bj][m][n], 0, 0, 0); } \
        __builtin_amdgcn_s_setprio(0); } while (0)
#define G_WAIT_V(n) asm volatile("s_waitcnt vmcnt(" #n ")" ::: "memory")
#define G_WAIT_L(n) asm volatile("s_waitcnt lgkmcnt(" #n ")" ::: "memory")
#define G_BAR __builtin_amdgcn_s_barrier()
#define G_SCHED __builtin_amdgcn_sched_barrier(0)
#define G_TRIP(A1, OC, A2, ON, B2) do { \
        G_LDB(B0, 0, 0); G_SCHED; G_LDA(At, 0, 0); G_STAGE_A(G_SA(1, 1), A1, OC, 1); \
        G_WAIT_L(8); G_BAR; G_WAIT_L(0); G_MMA(0, 0, At, B0); G_BAR; G_SCHED; \
        G_LDB(B1, 0, 1); G_STAGE_B(G_SB(0, 0), B2, 0u); \
        G_BAR; G_WAIT_L(0); G_MMA(0, 1, At, B1); G_BAR; \
        G_LDA(At, 0, 1); G_STAGE_A(G_SA(0, 0), A2, ON, 0); \
        G_BAR; G_WAIT_L(0); G_MMA(1, 0, At, B0); G_BAR; G_SCHED; \
        G_STAGE_B(G_SB(0, 1), B2, hstepB); \
        G_WAIT_V(6); G_BAR; G_MMA(1, 1, At, B1); G_BAR; \
        G_LDB(B0, 1, 0); G_SCHED; G_LDA(At, 1, 0); G_STAGE_A(G_SA(0, 1), A2, ON, 1); \
        G_WAIT_L(8); G_BAR; G_WAIT_L(0); G_MMA(0, 0, At, B0); G_BAR; G_SCHED; \
        G_LDB(B1, 1, 1); G_STAGE_B(G_SB(1, 0), (B2) + kstep, 0u); \
        G_BAR; G_WAIT_L(0); G_MMA(0, 1, At, B1); G_BAR; \
        G_LDA(At, 1, 1); G_STAGE_A(G_SA(1, 0), (A2) + kstep, ON, 0); \
        G_BAR; G_WAIT_L(0); G_MMA(1, 0, At, B0); G_BAR; G_SCHED; \
        G_STAGE_B(G_SB(1, 1), (B2) + kstep, hstepB); \
        G_WAIT_V(6); G_BAR; G_MMA(1, 1, At, B1); G_BAR; } while (0)
#define G_TRIP2(A1, OC, A2, ON, B2) do { \
        G_LDB(B0, 0, 0); G_LDB(B1, 0, 1); G_SCHED; G_LDA(At, 0, 0); G_STAGE_A(G_SA(1, 1), A1, OC, 1); \
        G_WAIT_V(8); G_WAIT_L(0); G_BAR; G_MMA(0, 0, At, B0); G_MMA(0, 1, At, B1); G_BAR; G_SCHED; \
        G_LDA(At, 0, 1); G_STAGE_B(G_SB(0, 0), B2, 0u); G_STAGE_B(G_SB(0, 1), B2, hstepB); G_STAGE_A(G_SA(0, 0), A2, ON, 0); \
        G_WAIT_V(8); G_WAIT_L(0); G_BAR; G_MMA(1, 0, At, B0); G_MMA(1, 1, At, B1); G_BAR; G_SCHED; \
        G_LDB(B0, 1, 0); G_LDB(B1, 1, 1); G_SCHED; G_LDA(At, 1, 0); G_STAGE_A(G_SA(0, 1), A2, ON, 1); \
        G_WAIT_V(8); G_WAIT_L(0); G_BAR; G_MMA(0, 0, At, B0); G_MMA(0, 1, At, B1); G_BAR; G_SCHED; \
        G_LDA(At, 1, 1); G_STAGE_B(G_SB(1, 0), (B2) + kstep, 0u); G_STAGE_B(G_SB(1, 1), (B2) + kstep, hstepB); G_STAGE_A(G_SA(1, 0), (A2) + kstep, ON, 0); \
        G_WAIT_V(8); G_WAIT_L(0); G_BAR; G_MMA(1, 0, At, B0); G_MMA(1, 1, At, B1); G_BAR; G_SCHED; } while (0)
#ifndef GEMM_SP2
#define GEMM_SP2 1
#endif
    Unit cur, nxt; int ui = 0;
    if (!P.next(0, cur)) return;
    f32x4 acc[2][2][4][2];
#pragma unroll
    for (int a = 0; a < 2; ++a)
#pragma unroll
        for (int b = 0; b < 2; ++b)
#pragma unroll
            for (int m = 0; m < 4; ++m)
#pragma unroll
                for (int n = 0; n < 2; ++n) acc[a][b][m][n] = (f32x4){0.f, 0.f, 0.f, 0.f};
    const int mxs = 0x7f7f7f7f;
    bf16x8 At[4][2], B0[2][2], B1[2][2]; v8i At8[4], B08[2], B18[2];
    unsigned oc[2][2], on[2][2];
    if (POL::ROWS) { P.stage_rows(cur, 0); __syncthreads(); }
#pragma unroll
    for (int h = 0; h < 2; ++h)
#pragma unroll
        for (int i = 0; i < 2; ++i) { oc[h][i] = POL::GATHER ? P.a_off_l(0, h * HALFT + sR[i]) + (unsigned)sC[i] * 2u : 0u; on[h][i] = 0u; }
    const char* cA = P.a_base(cur); const char* cB = P.b_base(cur);
    if (GEMM_SP2) {
        G_STAGE_B(G_SB(0, 0), cB, 0u); G_STAGE_B(G_SB(0, 1), cB, hstepB); G_STAGE_A(G_SA(0, 0), cA, oc, 0); G_STAGE_A(G_SA(0, 1), cA, oc, 1);
        if (wr == 1) G_BAR;
        G_WAIT_V(2); G_BAR;
        G_STAGE_B(G_SB(1, 0), cB + kstep, 0u); G_STAGE_A(G_SA(1, 0), cA + kstep, oc, 0); G_STAGE_B(G_SB(1, 1), cB + kstep, hstepB);
        G_WAIT_V(6); G_BAR;
    } else {
    G_STAGE_B(G_SB(0, 0), cB, 0u); G_STAGE_A(G_SA(0, 0), cA, oc, 0); G_STAGE_B(G_SB(0, 1), cB, hstepB); G_STAGE_A(G_SA(0, 1), cA, oc, 1);
    if (wr == 1) G_BAR;
    G_WAIT_V(4); G_BAR;
    G_STAGE_B(G_SB(1, 0), cB + kstep, 0u); G_STAGE_A(G_SA(1, 0), cA + kstep, oc, 0); G_STAGE_B(G_SB(1, 1), cB + kstep, hstepB);
    G_WAIT_V(6); G_BAR;
    }
    for (;;) {
        const bool has_next = P.next(ui + 1, nxt);
        const char* nA = has_next ? P.a_base(nxt) : cA; const char* nB = has_next ? P.b_base(nxt) : cB;
        if (POL::ROWS) { if (has_next) P.stage_rows(nxt, (ui + 1) & 1); }
#pragma unroll 1
        for (int t = 0; t < nt; t += 2) {
            const bool last = (t == nt - 2);
            const char* a1 = cA + (size_t)(t + 1) * kstep; const char* a2 = last ? nA : cA + (size_t)(t + 2) * kstep; const char* b2 = last ? nB : cB + (size_t)(t + 2) * kstep;
            if (POL::GATHER) {
                unsigned os[2][2];
                if (last) {
#pragma unroll
                    for (int h = 0; h < 2; ++h)
#pragma unroll
                        for (int i = 0; i < 2; ++i) on[h][i] = has_next ? P.a_off_l((ui + 1) & 1, h * HALFT + sR[i]) + (unsigned)sC[i] * 2u : oc[h][i];
                }
#pragma unroll
                for (int h = 0; h < 2; ++h)
#pragma unroll
                    for (int i = 0; i < 2; ++i) os[h][i] = last ? on[h][i] : oc[h][i];
                if (GEMM_SP2) { G_TRIP2(a1, oc, a2, os, b2); } else { G_TRIP(a1, oc, a2, os, b2); }
            } else { if (GEMM_SP2) { G_TRIP2(a1, oc, a2, oc, b2); } else { G_TRIP(a1, oc, a2, oc, b2); } }
        }
        if (POL::FP8) asm volatile("s_nop 15\n\ts_nop 15" ::: "memory");
        if (wr == 0) G_BAR;
        P.epi(acc, cur, wr, wc, fr, fq, ui & 1);
        if (!has_next) break;
#pragma unroll
        for (int a = 0; a < 2; ++a)
#pragma unroll
            for (int b = 0; b < 2; ++b)
#pragma unroll
                for (int m = 0; m < 4; ++m)
#pragma unroll
                    for (int n = 0; n < 2; ++n) acc[a][b][m][n] = (f32x4){0.f, 0.f, 0.f, 0.f};
        cur = nxt; cA = nA; cB = nB; ++ui;
        if (POL::GATHER) {
#pragma unroll
            for (int h = 0; h < 2; ++h)
#pragma unroll
                for (int i = 0; i < 2; ++i) oc[h][i] = on[h][i];
        }
        if (wr == 1) G_BAR;
    }
    G_WAIT_V(0);
    G_BAR;
#undef G_SA
#undef G_SB
#undef G_AOFF
#undef G_STAGE_A
#undef G_STAGE_B
#undef G_LDA
#undef G_LDB
#undef G_MMA
#undef G_LD8
#undef G_WAIT_V
#undef G_WAIT_L
#undef G_BAR
#undef G_SCHED
#undef G_TRIP
#undef G_TRIP2
}

struct PolInProj {
    static constexpr bool PERM = true, GATHER = false, FP8 = false, ROWS = false;
    __device__ __forceinline__ void stage_rows(const Unit&, int) const {}
    __device__ __forceinline__ unsigned a_off_l(int, int) const { return 0u; }
    const bf16_t* A; const bf16_t* Bt; bf16_t* O; TileOrder ord;
    __device__ __forceinline__ bool next(int i, Unit& u) const {
        constexpr int NLATU = (NLAT / BM) * (INW / BM);
        const int L = i * ord.G + ord.c;
        if (L < NLATU) return ord.tile(i, u.pm, u.pn);
        const int q = L - NLATU; if (q >= (NCTX / BM) * 8) return false;
        u.pm = NLAT / BM + (q >> 3); const int j = q & 7; u.pn = j < 6 ? 2 + j : 4 + j; return true;
    }
    __device__ __forceinline__ const char* a_base(const Unit& u) const { return (const char*)A + (size_t)u.pm * BM * GK * 2; }
    __device__ __forceinline__ unsigned a_off(const Unit&, int r) const { return (unsigned)r * GK * 2u; }
    __device__ __forceinline__ const char* b_base(const Unit& u) const { return (const char*)Bt + (size_t)u.pn * BM * GK * 2; }
    __device__ __forceinline__ void epi(const f32x4 (&acc)[2][2][4][2], const Unit& u, int wr, int wc, int fr, int fq, int par) const {
        const int row0 = u.pm * BM + wr * 64 + fr, col0 = u.pn * BM + wc * 32 + 8 * fq;
        const bool qsilu = u.pn < HGW / BM;
#pragma unroll
        for (int ai = 0; ai < 2; ++ai)
#pragma unroll
            for (int m = 0; m < 4; ++m) { bf16_t* rowp = O + (size_t)(row0 + ai * HALFT + m * 16) * INW + col0;
#pragma unroll
                for (int bj = 0; bj < 2; ++bj) { f32x4 v0 = acc[ai][bj][m][0], v1 = acc[ai][bj][m][1];
                    if (qsilu) {
#pragma unroll
                        for (int e = 0; e < 4; ++e) { v0[e] = v0[e] * sigmoidf_(v0[e]); v1[e] = v1[e] * sigmoidf_(v1[e]); } }
                    u32x4 w; w.x = cvt_pk_bf16(v0[0], v0[1]); w.y = cvt_pk_bf16(v0[2], v0[3]); w.z = cvt_pk_bf16(v1[0], v1[1]); w.w = cvt_pk_bf16(v1[2], v1[3]);
                    *(u32x4*)(rowp + bj * HALFT) = w; } }
    }
};
struct PolOutProj {
    static constexpr bool PERM = true, GATHER = false, FP8 = false, ROWS = false;
    __device__ __forceinline__ void stage_rows(const Unit&, int) const {}
    __device__ __forceinline__ unsigned a_off_l(int, int) const { return 0u; }
    const bf16_t* A; const bf16_t* Bt; const float* x; const float* mod; bf16_t* O; TileOrder ord;
    __device__ __forceinline__ bool next(int i, Unit& u) const { return ord.tile(i, u.pm, u.pn); }
    __device__ __forceinline__ const char* a_base(const Unit& u) const { return (const char*)A + (size_t)u.pm * BM * GK * 2; }
    __device__ __forceinline__ unsigned a_off(const Unit&, int r) const { return (unsigned)r * GK * 2u; }
    __device__ __forceinline__ const char* b_base(const Unit& u) const { return (const char*)Bt + (size_t)u.pn * BM * GK * 2; }
    __device__ __forceinline__ void epi(const f32x4 (&acc)[2][2][4][2], const Unit& u, int wr, int wc, int fr, int fq, int par) const {
        const int row0 = u.pm * BM + wr * 64 + fr, col0 = u.pn * BM + wc * 32 + 8 * fq;
        const float* g1 = mod + (size_t)((u.pm * BM) >> 11) * 6144 + 2048 + col0;
        f32x4 gv[2][2];
#pragma unroll
        for (int bj = 0; bj < 2; ++bj) { gv[bj][0] = *(const f32x4*)(g1 + bj * HALFT); gv[bj][1] = *(const f32x4*)(g1 + bj * HALFT + 4); }
#pragma unroll
        for (int ai = 0; ai < 2; ++ai)
#pragma unroll
            for (int m = 0; m < 4; ++m) { const size_t off = (size_t)(row0 + ai * HALFT + m * 16) * D + col0;
#pragma unroll
                for (int bj = 0; bj < 2; ++bj) {
                    const f32x4 x0 = __builtin_nontemporal_load((const f32x4*)(x + off + bj * HALFT)), x1v = __builtin_nontemporal_load((const f32x4*)(x + off + bj * HALFT + 4));
                    const f32x4 v0 = x0 + gv[bj][0] * acc[ai][bj][m][0], v1 = x1v + gv[bj][1] * acc[ai][bj][m][1];
                    u32x4 w; w.x = cvt_pk_bf16(v0[0], v0[1]); w.y = cvt_pk_bf16(v0[2], v0[3]); w.z = cvt_pk_bf16(v1[0], v1[1]); w.w = cvt_pk_bf16(v1[2], v1[3]);
                    *(u32x4*)(O + off + bj * HALFT) = w; }
                asm volatile("" ::: "memory"); }
    }
};
struct MoeTiles {
    const LAS int* tstart; const u32* cnt; int half;
    __device__ __forceinline__ LAS u32* rows(int par) const { return (LAS u32*)((LAS unsigned char*)tstart + 8192) + par * 512; }
    __device__ __forceinline__ void stage(const Unit& u, int par, const u32* toktab, const float* wtab) const {
        if (threadIdx.x < BM) { const int p = u.pos0 + threadIdx.x; const size_t tb = ((size_t)half * NE + u.e) * CAP; const bool ok = p < u.cn;
            const u32 tk = ok ? toktab[tb + p] : ~0u; const float wg = ok ? wtab[tb + p] : 0.f; LAS u32* rt = rows(par); rt[threadIdx.x * 2] = tk; rt[threadIdx.x * 2 + 1] = __float_as_uint(wg); }
    }
    __device__ __forceinline__ void find(Unit& u) const {
        const int e = __builtin_amdgcn_readfirstlane(tstart[64 + u.pm]);
        u.e = e; u.pos0 = (u.pm - __builtin_amdgcn_readfirstlane(tstart[e])) * BM; u.cn = (int)cnt[half * NE + e];
    }
};
struct PolGateUp {
    static constexpr bool PERM = true, GATHER = true, FP8 = true, ROWS = true;
    const fp8_t* A; const fp8_t* Bt; const float* bgu; const u32* toktab; const float* wtab; fp8_t* O; MoeTiles mt; TileOrder ord;
    __device__ __forceinline__ void stage_rows(const Unit& u, int par) const { mt.stage(u, par, toktab, wtab); }
    __device__ __forceinline__ unsigned a_off_l(int par, int r) const { const u32 tk = mt.rows(par)[r * 2]; return (tk == ~0u ? 0u : (tk >> 2)) * 1024u; }
    __device__ __forceinline__ bool next(int i, Unit& u) const { if (!ord.tile(i, u.pm, u.pn)) return false; mt.find(u); return true; }
    __device__ __forceinline__ const char* a_base(const Unit&) const { return (const char*)A; }
    __device__ __forceinline__ unsigned a_off(const Unit& u, int r) const {
        const int p = u.pos0 + r; const u32 tk = toktab[((size_t)mt.half * NE + u.e) * CAP + (p < u.cn ? p : 0)];
        return (tk >> 2) * 1024u;
    }
    __device__ __forceinline__ const char* b_base(const Unit& u) const { return (const char*)Bt + ((size_t)u.e * 2048 + (size_t)u.pn * BM) * 1024; }
    __device__ __forceinline__ void epi(const f32x4 (&acc)[2][2][4][2], const Unit& u, int wr, int wc, int fr, int fq, int par) const {
        const int row0 = u.pm * BM + wr * 64 + fr, cc = u.pn * HALFT + wc * 32 + 8 * fq;
        const float* bg = bgu + (size_t)u.e * 2048 + cc;
        const f32x4 bg0 = *(const f32x4*)bg, bg1 = *(const f32x4*)(bg + 4), bu0 = *(const f32x4*)(bg + 1024), bu1 = *(const f32x4*)(bg + 1028);
        constexpr float inv = 1.0f / (SC_H2 * SC_W);
#pragma unroll
        for (int ai = 0; ai < 2; ++ai)
#pragma unroll
            for (int m = 0; m < 4; ++m) {
                f32x4 g0 = acc[ai][0][m][0] * inv + bg0, g1 = acc[ai][0][m][1] * inv + bg1, u0 = acc[ai][1][m][0] * inv + bu0, u1 = acc[ai][1][m][1] * inv + bu1;
                float o[8];
#pragma unroll
                for (int j = 0; j < 4; ++j) {
                    const float ga = fminf(g0[j], 7.0f), gb = fminf(g1[j], 7.0f);
                    const float ua = fminf(fmaxf(u0[j], -7.0f), 7.0f), ub = fminf(fmaxf(u1[j], -7.0f), 7.0f);
                    o[j] = ga * sigmoidf_(1.702f * ga) * (ua + 1.0f) * SC_ACT; o[4 + j] = gb * sigmoidf_(1.702f * gb) * (ub + 1.0f) * SC_ACT;
                }
                uint2 w; w.x = pk4_fp8_nc(o[0], o[1], o[2], o[3]); w.y = pk4_fp8_nc(o[4], o[5], o[6], o[7]);
                *(uint2*)(O + (size_t)(row0 + ai * HALFT + m * 16) * DFF + cc) = w;
                asm volatile("" ::: "memory");
            }
    }
};
struct PolDown {
    static constexpr bool PERM = true, GATHER = false, FP8 = true, ROWS = true;
    const fp8_t* A; const fp8_t* Bt; const float* bd; const u32* toktab; const float* wtab; fp8_t* O; MoeTiles mt; TileOrder ord;
    __device__ __forceinline__ void stage_rows(const Unit& u, int par) const { mt.stage(u, par, toktab, wtab); }
    __device__ __forceinline__ unsigned a_off_l(int, int) const { return 0u; }
    __device__ __forceinline__ bool next(int i, Unit& u) const { if (!ord.tile(i, u.pm, u.pn)) return false; mt.find(u); return true; }
    __device__ __forceinline__ const char* a_base(const Unit& u) const { return (const char*)A + (size_t)u.pm * BM * 1024; }
    __device__ __forceinline__ unsigned a_off(const Unit&, int r) const { return (unsigned)r * 1024u; }
    __device__ __forceinline__ const char* b_base(const Unit& u) const { return (const char*)Bt + ((size_t)u.e * 1024 + (size_t)u.pn * BM) * 1024; }
    __device__ __forceinline__ void epi(const f32x4 (&acc)[2][2][4][2], const Unit& u, int wr, int wc, int fr, int fq, int par) const {
        const int col0 = u.pn * BM + wc * 32 + 8 * fq;
        const float* bp = bd + (size_t)u.e * D + col0;
        f32x4 bv[2][2];
#pragma unroll
        for (int bj = 0; bj < 2; ++bj) { bv[bj][0] = *(const f32x4*)(bp + bj * HALFT); bv[bj][1] = *(const f32x4*)(bp + bj * HALFT + 4); }
        const LAS u32* rt = mt.rows(par);
        constexpr float inv = 1.0f / (SC_ACT * SC_W);
#pragma unroll
        for (int ai = 0; ai < 2; ++ai)
#pragma unroll
            for (int m = 0; m < 4; ++m) {
                const int rr = ai * HALFT + wr * 64 + m * 16 + fr;
                const u32 tk = rt[rr * 2];
                if (tk != ~0u) {
                    const float wg = __uint_as_float(rt[rr * 2 + 1]) * SC_Y;
                    fp8_t* rowp = O + (size_t)(tk - (u32)mt.half * HALF_TOK * 4u) * D + col0;
#pragma unroll
                    for (int bj = 0; bj < 2; ++bj) { const f32x4 v0 = (acc[ai][bj][m][0] * inv + bv[bj][0]) * wg, v1 = (acc[ai][bj][m][1] * inv + bv[bj][1]) * wg;
                        uint2 w; w.x = pk4_fp8(v0[0], v0[1], v0[2], v0[3]); w.y = pk4_fp8(v1[0], v1[1], v1[2], v1[3]);
                        *(uint2*)(rowp + bj * HALFT) = w; }
                }
            }
    }
};
__device__ __forceinline__ int moe_tile_table(LAS int* tstart, const u32* cnt, int half) {
    __syncthreads();
    if (threadIdx.x == 0) { int s = 0; for (int e = 0; e < NE; ++e) { tstart[e] = s; s += ((int)cnt[half * NE + e] + BM - 1) / BM; } tstart[NE] = s; }
    __syncthreads();
    const int tot = tstart[NE];
    for (int t = threadIdx.x; t < tot; t += 512) { int e = 0;
#pragma unroll 1
        for (int i = 1; i < NE; ++i) if (t >= tstart[i]) e = i;
        tstart[64 + t] = e; }
    __syncthreads();
    return tot;
}

__device__ __forceinline__ void conv_item(const float* __restrict__ W, int N, bf16_t* __restrict__ WT, int k0, int n0, size_t rowbase, LAS float* scr, int lane) {
#pragma unroll 4
    for (int i = 0; i < 16; ++i) { const int k = 4 * i + (lane >> 4); const f32x4 v = __builtin_nontemporal_load((const f32x4*)(W + (size_t)(k0 + k) * N + n0 + (lane & 15) * 4)); *(LAS f32x4*)(scr + k * 68 + (lane & 15) * 4) = v; }
    asm volatile("s_waitcnt lgkmcnt(0)" ::: "memory");
    const int c = lane & 7;
#pragma unroll
    for (int j = 0; j < 8; ++j) { const int n = (lane >> 3) + 8 * j; const LAS float* s = scr + (8 * c) * 68 + n;
        u32x4 o; o.x = cvt_pk_bf16(s[0 * 68], s[1 * 68]); o.y = cvt_pk_bf16(s[2 * 68], s[3 * 68]); o.z = cvt_pk_bf16(s[4 * 68], s[5 * 68]); o.w = cvt_pk_bf16(s[6 * 68], s[7 * 68]);
        *(u32x4*)(WT + (rowbase + n) * GK + k0 + 8 * c) = o; }
    asm volatile("s_waitcnt lgkmcnt(0)" ::: "memory");
}
__device__ __forceinline__ void conv_item8(const float* __restrict__ W, int N, fp8_t* __restrict__ WT, int k0, int n0, size_t rowbase, LAS float* scr, int lane) {
#pragma unroll 4
    for (int i = 0; i < 16; ++i) { const int k = 4 * i + (lane >> 4); const f32x4 v = __builtin_nontemporal_load((const f32x4*)(W + (size_t)(k0 + k) * N + n0 + (lane & 15) * 4)); *(LAS f32x4*)(scr + k * 68 + (lane & 15) * 4) = v; }
    asm volatile("s_waitcnt lgkmcnt(0)" ::: "memory");
    const LAS float* sp = scr + lane;
#pragma unroll
    for (int q = 0; q < 4; ++q) {
        u32x4 o;
        o.x = pk4_fp8(sp[(16 * q + 0) * 68] * SC_W, sp[(16 * q + 1) * 68] * SC_W, sp[(16 * q + 2) * 68] * SC_W, sp[(16 * q + 3) * 68] * SC_W);
        o.y = pk4_fp8(sp[(16 * q + 4) * 68] * SC_W, sp[(16 * q + 5) * 68] * SC_W, sp[(16 * q + 6) * 68] * SC_W, sp[(16 * q + 7) * 68] * SC_W);
        o.z = pk4_fp8(sp[(16 * q + 8) * 68] * SC_W, sp[(16 * q + 9) * 68] * SC_W, sp[(16 * q + 10) * 68] * SC_W, sp[(16 * q + 11) * 68] * SC_W);
        o.w = pk4_fp8(sp[(16 * q + 12) * 68] * SC_W, sp[(16 * q + 13) * 68] * SC_W, sp[(16 * q + 14) * 68] * SC_W, sp[(16 * q + 15) * 68] * SC_W);
        *(u32x4*)(WT + (rowbase + lane) * GK + k0 + 16 * q) = o;
    }
    asm volatile("s_waitcnt lgkmcnt(0)" ::: "memory");
}
constexpr int IT_IN = 16 * (INW / 64), IT_OUT = 16 * (D / 64), IT_GU = NE * 16 * 32, IT_D = NE * 16 * 16, IT_ALL = IT_IN + IT_OUT + IT_GU + IT_D;
struct ProArgs { const float *c, *c_ctx, *w_ada, *b_ada, *lbl, *w_in, *w_out, *wgu, *wd, *rg_wa, *rg_wx, *rg_lam; float *mod, *lb, *coef; bf16_t *Win_t, *Wout_t, *WG_t; fp8_t *Wgu_t, *Wd_t; };
__device__ __forceinline__ void phase_prologue(LAS unsigned char* lds, const ProArgs& a, int bid, int G, bool do_mod, int it_lo, int it_hi) {
    const int tid = threadIdx.x, lane = tid & 63, w = tid >> 6;
    if (!do_mod) {} else if (bid < 96) {
        LAS float* s = (LAS float*)lds;
        for (int i = tid; i < 33 * D; i += 512) { const int b = i >> 10, k = i & 1023; const float v = b < NB ? a.c[(size_t)b * D + k] : a.c_ctx[k]; s[i] = v * sigmoidf_(v); }
        __syncthreads();
        const int n = bid * 64 + lane;
        float acc[33];
#pragma unroll
        for (int b = 0; b < 33; ++b) acc[b] = 0.f;
#pragma unroll 1
        for (int k = 128 * w; k < 128 * w + 128; k += 16) {
            float wv[16];
#pragma unroll
            for (int i = 0; i < 16; ++i) wv[i] = __builtin_nontemporal_load(a.w_ada + (size_t)(k + i) * 6144 + n);
#pragma unroll
            for (int b = 0; b < 33; ++b)
#pragma unroll
                for (int i4 = 0; i4 < 4; ++i4) { const f32x4 sv = *(const LAS f32x4*)(s + b * D + k + 4 * i4); acc[b] += sv[0] * wv[4 * i4] + sv[1] * wv[4 * i4 + 1] + sv[2] * wv[4 * i4 + 2] + sv[3] * wv[4 * i4 + 3]; }
        }
        __syncthreads();
        LAS float* red = (LAS float*)lds;
#pragma unroll
        for (int b = 0; b < 33; ++b) red[(w * 33 + b) * 64 + lane] = acc[b];
        __syncthreads();
        for (int i = tid; i < 33 * 64; i += 512) { const int b = i >> 6, l = i & 63; float sum = a.b_ada[bid * 64 + l];
#pragma unroll
            for (int ww = 0; ww < 8; ++ww) sum += red[(ww * 33 + b) * 64 + l];
            a.mod[(size_t)b * 6144 + bid * 64 + l] = sum; }
        __syncthreads();
    } else if (bid == 96) {
        for (int i = tid; i < 2 * HGW; i += 512) { const float l0 = a.lbl[i], l1 = a.lbl[2 * HGW + i]; a.lb[i] = 1.0f / (1.0f + __expf(l1 - l0)); }
        for (int i = tid; i < 2 * RGW; i += 512) { const float l = a.rg_lam[i]; const float sp = (-l > 20.f) ? -l : log1pf(__expf(-l)); a.coef[i] = -8.0f * sp; }
    } else if (bid == 97) {
        for (int idx = tid; idx < 8 * 256 * 64; idx += 512) { const int hd = idx >> 14, n = (idx >> 6) & 255, kk = idx & 63, g = n >> 6, j = n & 63, d = g >> 1;
            const float* src = (g & 1) ? a.rg_wx : a.rg_wa; a.WG_t[idx] = f2bf(src[(((size_t)d * 8 + hd) * 64 + kk) * 64 + j]); }
    }
    LAS float* scr = (LAS float*)(lds + w * (64 * 68 * 4));
    const int gw = bid * 8 + w, NW = G * 8;
    for (int it = it_lo + gw; it < it_hi; it += NW) {
        int r = it;
        if (r < IT_IN) { const int kb = r / (INW / 64), nb = r % (INW / 64); conv_item(a.w_in, INW, a.Win_t, kb * 64, nb * 64, (size_t)nb * 64, scr, lane); continue; } r -= IT_IN;
        if (r < IT_OUT) { const int kb = r / 16, nb = r % 16; conv_item(a.w_out, D, a.Wout_t, kb * 64, nb * 64, (size_t)nb * 64, scr, lane); continue; } r -= IT_OUT;
        if (r < IT_GU) { const int e = r / 512, q = r % 512, kb = q / 32, nb = q % 32, n0 = nb * 64, bj = n0 >> 10, rem = n0 & 1023, pn = rem >> 7, cc0 = rem & 127;
            conv_item8(a.wgu + (size_t)e * D * 2048, 2048, a.Wgu_t, kb * 64, n0, (size_t)e * 2048 + pn * 256 + bj * 128 + cc0, scr, lane); continue; } r -= IT_GU;
        { const int e = r / 256, q = r % 256, kb = q / 16, nb = q % 16; conv_item8(a.wd + (size_t)e * DFF * D, D, a.Wd_t, kb * 64, nb * 64, (size_t)e * 1024 + nb * 64, scr, lane); }
    }
}


__device__ __forceinline__ void phase_norm1(const float* __restrict__ x, const float* __restrict__ ctx, const float* __restrict__ nw, const float* __restrict__ mod, bf16_t* __restrict__ H, int bid, int G) {
    constexpr int RB = 4;
    const int lane = threadIdx.x & 63, gw = bid * 8 + (threadIdx.x >> 6), NW = G * 8;
    for (int r0 = gw; r0 < NROWS; r0 += RB * NW) {
        f32x4 v[RB][4];
#pragma unroll
        for (int q = 0; q < RB; ++q) { const int r = r0 + q * NW; const int rr = r < NROWS ? r : r0;
            const float* src = rr < NLAT ? x + (size_t)rr * D : ctx + (size_t)(rr - NLAT) * D;
#pragma unroll
            for (int j = 0; j < 4; ++j) v[q][j] = __builtin_nontemporal_load((const f32x4*)(src + j * 256 + lane * 4)); }
#pragma unroll
        for (int q = 0; q < RB; ++q) { const int r = r0 + q * NW; if (r < NROWS) {
            const float* m = mod + (size_t)(r < NLAT ? (r >> 11) : NB) * 6144;
            float ss = 0.f;
#pragma unroll
            for (int j = 0; j < 4; ++j) ss += v[q][j][0] * v[q][j][0] + v[q][j][1] * v[q][j][1] + v[q][j][2] * v[q][j][2] + v[q][j][3] * v[q][j][3];
            const float rstd = __builtin_amdgcn_rsqf(wave_sum(ss) * (1.0f / D) + EPS);
#pragma unroll
            for (int j = 0; j < 4; ++j) {
                const int c0 = j * 256 + lane * 4;
                const f32x4 w = *(const f32x4*)(nw + c0), sh = *(const f32x4*)(m + c0), sc = *(const f32x4*)(m + 1024 + c0);
                const f32x4 o = v[q][j] * rstd * w * (sc + 1.0f) + sh;
                uint2 p; p.x = cvt_pk_bf16(o[0], o[1]); p.y = cvt_pk_bf16(o[2], o[3]);
                *(uint2*)(H + (size_t)r * D + c0) = p;
            } } }
    }
}

__device__ __forceinline__ bf16x8 pack8(const f32x4& a, const f32x4& b) {
    u32x4 w; w.x = cvt_pk_bf16(a[0], a[1]); w.y = cvt_pk_bf16(a[2], a[3]); w.z = cvt_pk_bf16(b[0], b[1]); w.w = cvt_pk_bf16(b[2], b[3]);
    return __builtin_bit_cast(bf16x8, w);
}
constexpr int HW_BUF = 45056;
constexpr int HW_QD = 0, HW_KET = 17408, HW_PM = 35840;
constexpr int HW_VT = 2 * HW_BUF, HW_KD = HW_VT + 18432, HW_OS = HW_KD + 17408, HW_TOT = HW_OS + 17408, HW_DEC = HW_TOT + 2048;
__device__ __forceinline__ void phase_hgrn2_ws(LAS unsigned char* lds, const bf16_t* __restrict__ P, const float* __restrict__ lb, bf16_t* __restrict__ OF, bf16_t* __restrict__ OB, int item) {
    const int b = item >> 3, h = (item >> 1) & 3, dir = item & 1;
    const int tid = threadIdx.x, w = __builtin_amdgcn_readfirstlane(tid >> 6), lane = tid & 63, l15 = lane & 15, G4 = lane >> 4;
    bf16_t* OD = dir ? OB : OF;
    const int cf = dir ? C_FB : C_FF;
    constexpr int NC = (CTXL + T) / 64;
    LAS float* TOT = (LAS float*)(lds + HW_TOT);
#define HW_BAR() do { asm volatile("s_waitcnt lgkmcnt(0)" ::: "memory"); __builtin_amdgcn_s_barrier(); asm volatile("" ::: "memory"); } while (0)
    __syncthreads();
    if (w >= 4) {
        const int et = tid - 256, kp = et & 63, k = 2 * kp, seg = et >> 6, ew = w - 4;
        const int kslot = (k & ~31) | (((k >> 2) & 3) << 3) | (((k >> 4) & 1) << 2) | (k & 3);
        const float lb0 = lb[dir * HGW + h * 128 + k], lb1 = lb[dir * HGW + h * 128 + k + 1];
        const char* Pc = (const char*)P; const int sstep = dir ? -(INW * 2) : INW * 2;
#define HW_OFF0(m_) ({ const int p_ = 64 * (m_) + 16 * seg; const unsigned r_ = p_ < CTXL ? (unsigned)(NLAT + b * CTXL + (dir ? CTXL - 1 - p_ : p_)) : (unsigned)(b * T + (dir ? T - 1 - (p_ - CTXL) : (p_ - CTXL))); (r_ * (unsigned)INW + (unsigned)(h * 128 + k)) * 2u; })
#define HW_LD(off0_, i_, col_) (*(const u32*)(Pc + (unsigned)((int)(off0_) + (i_) * sstep + (col_) * 2)))
#define BF_LO(w_) __uint_as_float((w_) << 16)
#define BF_HI(w_) __uint_as_float((w_) & 0xffff0000u)
        u32 rf[16];
        { const unsigned o0 = HW_OFF0(0);
#pragma unroll
        for (int i = 0; i < 16; ++i) rf[i] = HW_LD(o0, i, cf); }
#pragma unroll 1
        for (int m = 0; m < NC + 1; ++m) {
            const int par = m & 1;
            LAS unsigned char* buf = lds + par * HW_BUF;
            HW_BAR();
            u32 rq[16], rv[16]; float f0v[16], f1v[16], c0v[16], c1v[16]; float run0 = 0.f, run1 = 0.f;
            if (m < NC) {
                const unsigned o0 = HW_OFF0(m);
#pragma unroll
                for (int i = 0; i < 16; ++i) { rq[i] = HW_LD(o0, i, C_Q); rv[i] = HW_LD(o0, i, C_I); }
#pragma unroll
                for (int i = 0; i < 16; ++i) { const float f0 = lb0 + (1.f - lb0) * sigmoidf_(BF_LO(rf[i])), f1 = lb1 + (1.f - lb1) * sigmoidf_(BF_HI(rf[i]));
                    f0v[i] = f0; f1v[i] = f1; run0 += flog(f0); run1 += flog(f1); c0v[i] = run0; c1v[i] = run1; }
                *(LAS f32x2*)(TOT + seg * 128 + k) = (f32x2){run0, run1};
                if (m + 1 < NC) { const unsigned o1 = HW_OFF0(m + 1);
#pragma unroll
                    for (int i = 0; i < 16; ++i) rf[i] = HW_LD(o1, i, cf); }
            }
            HW_BAR();
            if (m < NC) {
                f32x2 tt[4];
#pragma unroll
                for (int q = 0; q < 4; ++q) tt[q] = *(const LAS f32x2*)(TOT + q * 128 + k);
                const float p0 = seg == 0 ? 0.f : seg == 1 ? tt[0].x : seg == 2 ? tt[0].x + tt[1].x : tt[0].x + tt[1].x + tt[2].x;
                const float p1 = seg == 0 ? 0.f : seg == 1 ? tt[0].y : seg == 2 ? tt[0].y + tt[1].y : tt[0].y + tt[1].y + tt[2].y;
                const float eb0 = fexp((tt[0].x + tt[1].x) + (tt[2].x + tt[3].x)), eb1 = fexp((tt[0].y + tt[1].y) + (tt[2].y + tt[3].y));
                if (seg == 0) *(LAS f32x2*)(lds + HW_DEC + par * 512 + k * 4) = (f32x2){eb0, eb1};
                float ke0[16], ke1[16];
#pragma unroll
                for (int i = 0; i < 16; ++i) {
                    const int j = 16 * seg + i;
                    const float e0 = fexp(p0 + c0v[i]), e1 = fexp(p1 + c1v[i]);
                    const float kf0 = (1.f - f0v[i]) * frcp(e0), kf1 = (1.f - f1v[i]) * frcp(e1);
                    *(LAS u32*)(buf + HW_QD + j * 272 + kslot * 2) = cvt_pk_bf16(BF_LO(rq[i]) * e0, BF_HI(rq[i]) * e1);
                    *(LAS u32*)(lds + HW_KD + j * 272 + kslot * 2) = cvt_pk_bf16(kf0, kf1);
                    ke0[i] = kf0 * eb0; ke1[i] = kf1 * eb1;
                }
#pragma unroll
                for (int q4 = 0; q4 < 2; ++q4) {
                    u32x4 a0, a1, v0, v1;
#pragma unroll
                    for (int i = 0; i < 4; ++i) { const int t = 8 * q4 + 2 * i;
                        a0[i] = cvt_pk_bf16(ke0[t], ke0[t + 1]); a1[i] = cvt_pk_bf16(ke1[t], ke1[t + 1]);
                        v0[i] = (rv[t] & 0xffffu) | (rv[t + 1] << 16); v1[i] = (rv[t] >> 16) | (rv[t + 1] & 0xffff0000u); }
                    *(LAS u32x4*)(buf + HW_KET + k * 144 + seg * 32 + q4 * 16) = a0; *(LAS u32x4*)(buf + HW_KET + (k + 1) * 144 + seg * 32 + q4 * 16) = a1;
                    *(LAS u32x4*)(lds + HW_VT + k * 144 + seg * 32 + q4 * 16) = v0; *(LAS u32x4*)(lds + HW_VT + (k + 1) * 144 + seg * 32 + q4 * 16) = v1;
                }
            }
            HW_BAR();
            if (m < NC && m >= CTXL / 64) {
                const int mt = ew;
                f32x4 pa[4];
#pragma unroll
                for (int q = 0; q < 4; ++q) pa[q] = (f32x4){0.f, 0.f, 0.f, 0.f};
#pragma unroll
                for (int s = 0; s < 4; ++s) {
                    const bf16x8 a = *(const LAS bf16x8*)(buf + HW_QD + (16 * mt + l15) * 272 + (32 * s + 8 * G4) * 2);
#pragma unroll
                    for (int q = 0; q < 4; ++q) { const bf16x8 bq = *(const LAS bf16x8*)(lds + HW_KD + (16 * q + l15) * 272 + (32 * s + 8 * G4) * 2); pa[q] = __builtin_amdgcn_mfma_f32_16x16x32_bf16(a, bq, pa[q], 0, 0, 0); }
                }
#pragma unroll
                for (int q = 0; q < 4; ++q)
#pragma unroll
                    for (int r = 0; r < 4; ++r) { const int c = 16 * mt + 4 * G4 + r, j = 16 * q + l15; *(LAS bf16_t*)(buf + HW_PM + c * 144 + j * 2) = f2bf(j <= c ? pa[q][r] : 0.f); }
                asm volatile("s_waitcnt lgkmcnt(0)" ::: "memory");
            }
        }
#undef HW_OFF0
#undef HW_LD
#undef BF_LO
#undef BF_HI
    } else {
        f32x4 S[8][2];
#pragma unroll
        for (int t = 0; t < 8; ++t) { S[t][0] = (f32x4){0.f, 0.f, 0.f, 0.f}; S[t][1] = (f32x4){0.f, 0.f, 0.f, 0.f}; }
        HW_BAR(); HW_BAR(); HW_BAR();
#pragma unroll 1
        for (int n = 0; n < NC; ++n) {
            const int par = n & 1; const bool lat = n >= CTXL / 64;
            LAS unsigned char* buf = lds + par * HW_BUF;
            HW_BAR();
            bf16x8 vb[2][2];
#pragma unroll
            for (int nt = 0; nt < 2; ++nt)
#pragma unroll
                for (int s = 0; s < 2; ++s) vb[nt][s] = *(const LAS bf16x8*)(lds + HW_VT + (32 * w + 16 * nt + l15) * 144 + (32 * s + 8 * G4) * 2);
            HW_BAR();
            if (lat) {
                bf16x8 sb[2][4];
#pragma unroll
                for (int nt = 0; nt < 2; ++nt)
#pragma unroll
                    for (int s = 0; s < 4; ++s) sb[nt][s] = pack8(S[2 * s][nt], S[2 * s + 1][nt]);
#pragma unroll
                for (int mt = 0; mt < 4; ++mt) {
                    f32x4 oa[2] = {(f32x4){0.f, 0.f, 0.f, 0.f}, (f32x4){0.f, 0.f, 0.f, 0.f}};
#pragma unroll
                    for (int s = 0; s < 2; ++s) { const bf16x8 a = *(const LAS bf16x8*)(buf + HW_PM + (16 * mt + l15) * 144 + (32 * s + 8 * G4) * 2);
                        oa[0] = __builtin_amdgcn_mfma_f32_16x16x32_bf16(a, vb[0][s], oa[0], 0, 0, 0); oa[1] = __builtin_amdgcn_mfma_f32_16x16x32_bf16(a, vb[1][s], oa[1], 0, 0, 0); }
#pragma unroll
                    for (int s = 0; s < 4; ++s) { const bf16x8 a = *(const LAS bf16x8*)(buf + HW_QD + (16 * mt + l15) * 272 + (32 * s + 8 * G4) * 2);
                        oa[0] = __builtin_amdgcn_mfma_f32_16x16x32_bf16(a, sb[0][s], oa[0], 0, 0, 0); oa[1] = __builtin_amdgcn_mfma_f32_16x16x32_bf16(a, sb[1][s], oa[1], 0, 0, 0); }
#pragma unroll
                    for (int nt = 0; nt < 2; ++nt)
#pragma unroll
                        for (int r = 0; r < 4; ++r) *(LAS bf16_t*)(lds + HW_OS + (16 * mt + 4 * G4 + r) * 272 + (32 * w + 16 * nt + l15) * 2) = f2bf(oa[nt][r]);
                }
            }
#pragma unroll
            for (int t = 0; t < 8; ++t) {
                const f32x4 d4 = *(const LAS f32x4*)(lds + HW_DEC + par * 512 + (16 * t + 4 * G4) * 4);
                S[t][0] = S[t][0] * d4; S[t][1] = S[t][1] * d4;
#pragma unroll
                for (int s = 0; s < 2; ++s) { const bf16x8 a = *(const LAS bf16x8*)(buf + HW_KET + (16 * t + l15) * 144 + (32 * s + 8 * G4) * 2);
                    S[t][0] = __builtin_amdgcn_mfma_f32_16x16x32_bf16(a, vb[0][s], S[t][0], 0, 0, 0); S[t][1] = __builtin_amdgcn_mfma_f32_16x16x32_bf16(a, vb[1][s], S[t][1], 0, 0, 0); }
            }
            HW_BAR();
            if (lat) {
                const int j = tid >> 2, part = tid & 3, p = 64 * n + j, tt = dir ? T - 1 - (p - CTXL) : (p - CTXL);
                bf16_t* dst = OD + ((size_t)b * T + tt) * HGW + h * 128 + part * 32;
#pragma unroll
                for (int q = 0; q < 4; ++q) *(u32x4*)(dst + q * 8) = *(const LAS u32x4*)(lds + HW_OS + j * 272 + part * 64 + q * 16);
            }
        }
    }
    __syncthreads();
#undef HW_BAR
}

__device__ __forceinline__ size_t rg_row(int b, bool lat, int p) {
    return lat ? (size_t)b * T + (size_t)(p % GROWS) * GRIDW + (p / GROWS) : (size_t)NLAT + b * CTXL + p;
}
constexpr int RC_T = 64 * 144;
constexpr int RC_XC = 0, RC_RG = 2 * RC_T, RC_HI = 4 * RC_T, RC_OUT = 6 * RC_T;
__device__ __forceinline__ void phase_rg_chain(LAS unsigned char* lds, const bf16_t* __restrict__ P, const float* __restrict__ conv_w, const float* __restrict__ conv_b, const bf16_t* __restrict__ WG_t,
                                               const float* __restrict__ ba, const float* __restrict__ bx, const float* __restrict__ coef, bf16_t* __restrict__ HT, bf16_t* __restrict__ MIX, int item) {
    const int b = item >> 3, hd = item & 7;
    const int tid = threadIdx.x, w = __builtin_amdgcn_readfirstlane(tid >> 6), lane = tid & 63, l15 = lane & 15, G4 = lane >> 4;
    const int d = w >> 2, cg = w & 3, ch = 64 * hd + 16 * cg + l15;
    const int ds = tid >> 8, t8 = tid & 255, pg = t8 >> 4, cg4 = t8 & 15;
    bf16x8 F[4];
#pragma unroll
    for (int s = 0; s < 2; ++s) {
        F[s] = *(const bf16x8*)(WG_t + ((size_t)(hd * 256 + 64 * (2 * d) + 16 * cg + l15) * 64 + 32 * s + 8 * G4));
        F[2 + s] = *(const bf16x8*)(WG_t + ((size_t)(hd * 256 + 64 * (2 * d + 1) + 16 * cg + l15) * 64 + 32 * s + 8 * G4)); }
    const float bav = ba[d * RGW + ch], bxv = bx[d * RGW + ch], cf = coef[d * RGW + ch];
    const f32x4 cw0 = *(const f32x4*)(conv_w + 0 * RGW + 64 * hd + 4 * cg4), cw1 = *(const f32x4*)(conv_w + 1 * RGW + 64 * hd + 4 * cg4), cw2 = *(const f32x4*)(conv_w + 2 * RGW + 64 * hd + 4 * cg4),
                cw3 = *(const f32x4*)(conv_w + 3 * RGW + 64 * hd + 4 * cg4), cb4 = *(const f32x4*)(conv_b + 64 * hd + 4 * cg4);
    float hcar = 0.f;
#define RC_CHUNK(dd, s_) ((dd) == 0 ? (s_) : ((s_) < CTXL / 64 ? CTXL / 64 - 1 - (s_) : NCHK + CTXL / 64 - 1 - (s_)))
    u32x2 rxr[7]; u32x4 rgr[2], hir[2];
#define RC_LOAD_RX(s_) do { const int n_ = RC_CHUNK(ds, s_); const bool lat_ = n_ >= CTXL / 64; const int L_ = lat_ ? T : CTXL, p0_ = 64 * (lat_ ? n_ - CTXL / 64 : n_); \
        _Pragma("unroll") for (int i = 0; i < 7; ++i) { const int p = p0_ + 4 * pg - 2 + i; rxr[i] = (p >= 0 && p < L_) ? *(const u32x2*)(P + rg_row(b, lat_, p) * INW + C_RX + 64 * hd + 4 * cg4) : (u32x2){0u, 0u}; } } while (0)
#define RC_ROW(s_, q_) (rg_row(b, true, 64 * (RC_CHUNK(ds, s_) - CTXL / 64) + ((q_) >> 3)))
#define RC_LOAD_RG(s_) do { _Pragma("unroll") for (int j = 0; j < 2; ++j) { const int q = t8 * 2 + j; rgr[j] = *(const u32x4*)(P + RC_ROW(s_, q) * INW + C_RG + 64 * hd + (q & 7) * 8); } } while (0)
#define RC_LOAD_HI(s_) do { _Pragma("unroll") for (int j = 0; j < 2; ++j) { const int q = t8 * 2 + j; rgr[j] = rgr[j]; hir[j] = __builtin_nontemporal_load((const u32x4*)(HT + RC_ROW(s_, q) * RGW + 64 * hd + (q & 7) * 8)); } } while (0)
    RC_LOAD_RX(0);
#pragma unroll 1
    for (int s = 0; s < NCHK; ++s) {
        const int role = s < CTXL / 64 ? 0 : (s < 20 ? 1 : 2);
        if (s == 20) { asm volatile("s_waitcnt vmcnt(0)" ::: "memory"); __syncthreads(); RC_LOAD_RG(20); RC_LOAD_HI(20); }
        {
            float xin[7][4];
#pragma unroll
            for (int i = 0; i < 7; ++i) { xin[i][0] = __uint_as_float(rxr[i].x << 16); xin[i][1] = __uint_as_float(rxr[i].x & 0xffff0000u); xin[i][2] = __uint_as_float(rxr[i].y << 16); xin[i][3] = __uint_as_float(rxr[i].y & 0xffff0000u); }
#pragma unroll
            for (int q = 0; q < 4; ++q) {
                float o[4];
#pragma unroll
                for (int c = 0; c < 4; ++c) o[c] = cb4[c] + cw0[c] * xin[q][c] + cw1[c] * xin[q + 1][c] + cw2[c] * xin[q + 2][c] + cw3[c] * xin[q + 3][c];
                *(LAS unsigned long long*)(lds + RC_XC + ds * RC_T + (4 * pg + q) * 144 + cg4 * 8) = ((unsigned long long)cvt_pk_bf16(o[2], o[3]) << 32) | cvt_pk_bf16(o[0], o[1]);
            }
            if (role == 2) {
#pragma unroll
                for (int j = 0; j < 2; ++j) { const int q = t8 * 2 + j; *(LAS u32x4*)(lds + RC_RG + ds * RC_T + (q >> 3) * 144 + (q & 7) * 16) = rgr[j]; *(LAS u32x4*)(lds + RC_HI + ds * RC_T + (q >> 3) * 144 + (q & 7) * 16) = hir[j]; }
            }
        }
        __syncthreads();
        if (s + 1 < NCHK) { RC_LOAD_RX(s + 1); if (s + 1 > 20) { RC_LOAD_RG(s + 1); RC_LOAD_HI(s + 1); } }
        {
            bf16x8 af[4][2];
#pragma unroll
            for (int mt = 0; mt < 4; ++mt)
#pragma unroll
                for (int k = 0; k < 2; ++k) af[mt][k] = *(const LAS bf16x8*)(lds + RC_XC + d * RC_T + (16 * (l15 >> 2) + 4 * mt + (l15 & 3)) * 144 + (32 * k + 8 * G4) * 2);
            f32x4 ra[4], xa[4];
#pragma unroll
            for (int mt = 0; mt < 4; ++mt) { ra[mt] = (f32x4){0.f, 0.f, 0.f, 0.f}; xa[mt] = (f32x4){0.f, 0.f, 0.f, 0.f};
#pragma unroll
                for (int k = 0; k < 2; ++k) { ra[mt] = __builtin_amdgcn_mfma_f32_16x16x32_bf16(af[mt][k], F[k], ra[mt], 0, 0, 0); xa[mt] = __builtin_amdgcn_mfma_f32_16x16x32_bf16(af[mt][k], F[2 + k], xa[mt], 0, 0, 0); } }
            float av[16], bv[16];
#pragma unroll
            for (int t = 0; t < 16; ++t) {
                const float r = sigmoidf_(ra[t >> 2][t & 3] + bav), ig = sigmoidf_(xa[t >> 2][t & 3] + bxv);
                const float a = fexp(cf * r);
                av[t] = a; bv[t] = fsqrt(fmaxf(1.0f - a * a, 0.f)) * ig * bf2f(*(const LAS bf16_t*)(lds + RC_XC + d * RC_T + (16 * G4 + t) * 144 + (16 * cg + l15) * 2));
            }
            float Al = 1.f, Bl = 0.f;
            if (d == 0) {
#pragma unroll
                for (int t = 0; t < 16; ++t) { Bl = av[t] * Bl + bv[t]; Al *= av[t]; }
            } else {
#pragma unroll
                for (int t = 15; t >= 0; --t) { Bl = av[t] * Bl + bv[t]; Al *= av[t]; }
            }
            float Ag[4], Bg[4];
#pragma unroll
            for (int g = 0; g < 4; ++g) { Ag[g] = __shfl(Al, l15 + 16 * g); Bg[g] = __shfl(Bl, l15 + 16 * g); }
            float h = hcar, hend;
            if (d == 0) {
                const float s1 = Ag[0] * h + Bg[0], s2 = Ag[1] * s1 + Bg[1], s3 = Ag[2] * s2 + Bg[2]; hend = Ag[3] * s3 + Bg[3];
                h = G4 == 0 ? h : G4 == 1 ? s1 : G4 == 2 ? s2 : s3;
            } else {
                const float s2 = Ag[3] * h + Bg[3], s1 = Ag[2] * s2 + Bg[2], s0 = Ag[1] * s1 + Bg[1]; hend = Ag[0] * s0 + Bg[0];
                h = G4 == 3 ? h : G4 == 2 ? s2 : G4 == 1 ? s1 : s0;
            }
            hcar = hend;
            if (role != 0) {
                float hv[16];
                if (d == 0) {
#pragma unroll
                    for (int t = 0; t < 16; ++t) { h = av[t] * h + bv[t]; hv[t] = h; }
                } else {
#pragma unroll
                    for (int t = 15; t >= 0; --t) { h = av[t] * h + bv[t]; hv[t] = h; }
                }
#pragma unroll
                for (int t = 0; t < 16; ++t) {
                    const int off = (16 * G4 + t) * 144 + (16 * cg + l15) * 2;
                    float o = hv[t];
                    if (role == 2) o = gelu_tanh(bf2f(*(const LAS bf16_t*)(lds + RC_RG + d * RC_T + off))) * (o + bf2f(*(const LAS bf16_t*)(lds + RC_HI + d * RC_T + off)));
                    *(LAS bf16_t*)(lds + RC_OUT + d * RC_T + off) = f2bf(o);
                }
            }
        }
        __syncthreads();
        if (role != 0) {
#pragma unroll
            for (int j = 0; j < 2; ++j) { const int q = t8 * 2 + j; const u32x4 v = *(const LAS u32x4*)(lds + RC_OUT + ds * RC_T + (q >> 3) * 144 + (q & 7) * 16);
                if (role == 1) *(u32x4*)(HT + RC_ROW(s, q) * RGW + 64 * hd + (q & 7) * 8) = v;
                else *(u32x4*)(MIX + RC_ROW(s, q) * D + HGW + 64 * hd + (q & 7) * 8) = v; }
        }
    }
#undef RC_CHUNK
#undef RC_LOAD_RX
#undef RC_ROW
#undef RC_LOAD_RG
#undef RC_LOAD_HI
}

__device__ __forceinline__ void phase_mix_finish(const bf16_t* __restrict__ P, const bf16_t* __restrict__ OF, const bf16_t* __restrict__ OB,
                                                 const float* __restrict__ hg_nw, bf16_t* __restrict__ MIX, int bid, int G) {
    constexpr int RB = 4;
    const int lane = threadIdx.x & 63, gw = bid * 8 + (threadIdx.x >> 6), NW = G * 8, c0 = lane * 8;
    const f32x4 nw0 = *(const f32x4*)(hg_nw + c0), nw1 = *(const f32x4*)(hg_nw + c0 + 4);
    const float nwv[8] = {nw0[0], nw0[1], nw0[2], nw0[3], nw1[0], nw1[1], nw1[2], nw1[3]};
    for (int r0 = gw; r0 < NLAT; r0 += RB * NW) {
        u32x4 a4[RB], b4[RB], g4[RB];
#pragma unroll
        for (int q = 0; q < RB; ++q) { const int r = r0 + q * NW; const int rr = r < NLAT ? r : r0;
            a4[q] = *(const u32x4*)(OF + (size_t)rr * HGW + c0); b4[q] = *(const u32x4*)(OB + (size_t)rr * HGW + c0); g4[q] = *(const u32x4*)(P + (size_t)rr * INW + C_G + c0); }
#pragma unroll
        for (int q = 0; q < RB; ++q) { const int r = r0 + q * NW; if (r < NLAT) {
            float o[8]; float ss = 0.f;
#pragma unroll
            for (int i = 0; i < 4; ++i) { o[2 * i] = __uint_as_float(a4[q][i] << 16) + __uint_as_float(b4[q][i] << 16); o[2 * i + 1] = __uint_as_float(a4[q][i] & 0xffff0000u) + __uint_as_float(b4[q][i] & 0xffff0000u); }
#pragma unroll
            for (int i = 0; i < 8; ++i) ss += o[i] * o[i];
            ss += __shfl_xor(ss, 1); ss += __shfl_xor(ss, 2); ss += __shfl_xor(ss, 4); ss += __shfl_xor(ss, 8);
            const float rstd = __builtin_amdgcn_rsqf(ss * (1.0f / 128.0f) + EPS);
            u32x4 w;
#pragma unroll
            for (int i = 0; i < 4; ++i) {
                const float g0 = __uint_as_float(g4[q][i] << 16), g1 = __uint_as_float(g4[q][i] & 0xffff0000u);
                w[i] = cvt_pk_bf16(o[2 * i] * rstd * nwv[2 * i] * (g0 * sigmoidf_(g0)), o[2 * i + 1] * rstd * nwv[2 * i + 1] * (g1 * sigmoidf_(g1)));
            }
            *(u32x4*)(MIX + (size_t)r * D + c0) = w;
        } }
    }
}

__device__ __forceinline__ void phase_norm2_route(LAS unsigned char* lds, const bf16_t* __restrict__ x1, const float* __restrict__ nw, const float* __restrict__ mod,
                                                  const float* __restrict__ rw, const float* __restrict__ rb, fp8_t* __restrict__ H2,
                                                  u32* __restrict__ cnt, u32* __restrict__ toktab, float* __restrict__ wtab, int bid, int G) {
    LAS float* rwT = (LAS float*)lds;
    LAS u32* hist = (LAS u32*)(lds + 131072);
    LAS u32* ent = (LAS u32*)(lds + 131072 + 4096);
    const int tid = threadIdx.x, lane = tid & 63, w = tid >> 6;
    for (int i = tid; i < 32 * 1024; i += 512) { const int k = i >> 5, e = i & 31; rwT[e * 1024 + k] = rw[i]; }
    if (tid < 128) hist[tid] = 0;
    __syncthreads();
    const int gw = bid * 8 + w, NW = G * 8;
    const int myexp = ((lane >> 5) & 1) * 16 + ((lane >> 4) & 1) * 8 + ((lane >> 3) & 1) * 4 + ((lane >> 2) & 1) * 2 + ((lane >> 1) & 1);
    const float myrb = rb[myexp];
    int it = 0;
    u32x2 rawn[2][4];
#pragma unroll
    for (int q = 0; q < 2; ++q)
#pragma unroll
        for (int j = 0; j < 4; ++j) rawn[q][j] = __builtin_nontemporal_load((const u32x2*)(x1 + (size_t)(gw + q * NW) * D + j * 256 + lane * 4));
    for (int r0 = gw; r0 < NLAT; r0 += 2 * NW, it += 2) {
        f32x4 v[2][4];
        u32x2 rawc[2][4];
#pragma unroll
        for (int q = 0; q < 2; ++q)
#pragma unroll
            for (int j = 0; j < 4; ++j) rawc[q][j] = rawn[q][j];
        { const int rn0 = r0 + 2 * NW < NLAT ? r0 + 2 * NW : r0;
#pragma unroll
          for (int q = 0; q < 2; ++q)
#pragma unroll
            for (int j = 0; j < 4; ++j) rawn[q][j] = __builtin_nontemporal_load((const u32x2*)(x1 + (size_t)(rn0 + q * NW) * D + j * 256 + lane * 4)); }
#pragma unroll
        for (int q = 0; q < 2; ++q) {
            const int r = r0 + q * NW;
            const float* m = mod + (size_t)(r >> 11) * 6144;
            u32x2 raw[4];
#pragma unroll
            for (int j = 0; j < 4; ++j) raw[j] = rawc[q][j];
            float ss = 0.f;
#pragma unroll
            for (int j = 0; j < 4; ++j) { v[q][j][0] = __uint_as_float(raw[j].x << 16); v[q][j][1] = __uint_as_float(raw[j].x & 0xffff0000u); v[q][j][2] = __uint_as_float(raw[j].y << 16); v[q][j][3] = __uint_as_float(raw[j].y & 0xffff0000u);
                ss += v[q][j][0] * v[q][j][0] + v[q][j][1] * v[q][j][1] + v[q][j][2] * v[q][j][2] + v[q][j][3] * v[q][j][3]; }
            const float rstd = __builtin_amdgcn_rsqf(wave_sum(ss) * (1.0f / D) + EPS);
#pragma unroll
            for (int j = 0; j < 4; ++j) {
                const int c0 = j * 256 + lane * 4;
                const f32x4 ww = *(const f32x4*)(nw + c0), sh = *(const f32x4*)(m + 3072 + c0), sc = *(const f32x4*)(m + 4096 + c0);
                v[q][j] = v[q][j] * rstd * ww * (sc + 1.0f) + sh;
                *(unsigned*)(H2 + (size_t)r * D + c0) = pk4_fp8(v[q][j][0] * SC_H2, v[q][j][1] * SC_H2, v[q][j][2] * SC_H2, v[q][j][3] * SC_H2);
            }
        }
        float part[2][32];
#pragma unroll
        for (int e = 0; e < 32; ++e) {
            float p0 = 0.f, p1 = 0.f;
#pragma unroll
            for (int j = 0; j < 4; ++j) { const f32x4 q = *(const LAS f32x4*)(rwT + e * 1024 + j * 256 + lane * 4);
                p0 += v[0][j][0] * q[0] + v[0][j][1] * q[1] + v[0][j][2] * q[2] + v[0][j][3] * q[3]; p1 += v[1][j][0] * q[0] + v[1][j][1] * q[1] + v[1][j][2] * q[2] + v[1][j][3] * q[3]; }
            part[0][e] = p0; part[1][e] = p1;
        }
#define RT_STEP(N, M) { const bool up = (lane & (M)) != 0; _Pragma("unroll") for (int q = 0; q < 2; ++q) _Pragma("unroll") for (int i = 0; i < (N); ++i) { const float keep = up ? part[q][(N) + i] : part[q][i], send = up ? part[q][i] : part[q][(N) + i]; part[q][i] = keep + __shfl_xor(send, (M)); } }
        RT_STEP(16, 32) RT_STEP(8, 16) RT_STEP(4, 8) RT_STEP(2, 4) RT_STEP(1, 2)
#undef RT_STEP
#pragma unroll
        for (int q = 0; q < 2; ++q) {
            const int r = r0 + q * NW;
            const float mylogit = part[q][0] + __shfl_xor(part[q][0], 1) + myrb;
            int rank = 0;
#pragma unroll
            for (int x = 0; x < 32; ++x) {
                const int src = ((x >> 4) & 1) * 32 + ((x >> 3) & 1) * 16 + ((x >> 2) & 1) * 8 + ((x >> 1) & 1) * 4 + (x & 1) * 2;
                const float oq = __builtin_bit_cast(float, __builtin_amdgcn_readlane(__builtin_bit_cast(int, mylogit), src));
                rank += (oq > mylogit || (oq == mylogit && x < myexp)) ? 1 : 0;
            }
            float tv[4]; int ti[4];
#pragma unroll
            for (int k = 0; k < 4; ++k) {
                const unsigned long long mk = __ballot(rank == k && (lane & 1) == 0);
                const int src = __builtin_amdgcn_readfirstlane((int)__builtin_ctzll(mk));
                tv[k] = __builtin_bit_cast(float, __builtin_amdgcn_readlane(__builtin_bit_cast(int, mylogit), src));
                ti[k] = ((src >> 5) & 1) * 16 + ((src >> 4) & 1) * 8 + ((src >> 3) & 1) * 4 + ((src >> 2) & 1) * 2 + ((src >> 1) & 1);
            }
            const float e1 = fexp(tv[1] - tv[0]), e2 = fexp(tv[2] - tv[0]), e3 = fexp(tv[3] - tv[0]); const float inv = frcp(1.0f + e1 + e2 + e3);
            const float g0 = inv, g1 = e1 * inv, g2 = e2 * inv, g3 = e3 * inv;
            if (lane < 4) {
                const int half = r >= HALF_TOK ? 1 : 0;
                const int e = lane == 0 ? ti[0] : lane == 1 ? ti[1] : lane == 2 ? ti[2] : ti[3];
                const float gv = lane == 0 ? g0 : lane == 1 ? g1 : lane == 2 ? g2 : g3;
                const u32 lp = atomicAdd((u32*)&hist[half * 32 + e], 1u);
                const int idx = ((it + q) * 8 + w) * 4 + lane;
                ent[idx * 2] = ((u32)e << 24) | lp; ent[idx * 2 + 1] = __float_as_uint(gv);
            }
        }
    }
    __syncthreads();
    if (tid < 64) hist[64 + tid] = atomicAdd(&cnt[tid], hist[tid]);
    __syncthreads();
    it = 0;
    for (int r = gw; r < NLAT; r += NW, ++it) {
        if (lane < 4) {
            const int half = r >= HALF_TOK ? 1 : 0; const int idx = (it * 8 + w) * 4 + lane;
            const u32 ev = ent[idx * 2]; const int e = ev >> 24; const u32 pos = hist[64 + half * 32 + e] + (ev & 0xffffffu);
            toktab[((size_t)half * 32 + e) * CAP + pos] = (u32)r * 4u + lane;
            wtab[((size_t)half * 32 + e) * CAP + pos] = __uint_as_float(ent[idx * 2 + 1]);
        }
    }
}

__device__ __forceinline__ void phase_combine(float* __restrict__ out, const bf16_t* __restrict__ X1, const fp8_t* __restrict__ Y, const float* __restrict__ mod, const float* __restrict__ fw, int bid, int G) {
    constexpr int RB = 2;
    typedef float f32x2_ __attribute__((ext_vector_type(2)));
    const int lane = threadIdx.x & 63, gw = bid * 8 + (threadIdx.x >> 6), NW = G * 8;
    for (int r0 = gw; r0 < NLAT; r0 += RB * NW) {
        u32x2 xv[RB][4]; unsigned yv[RB][4][4];
#pragma unroll
        for (int q = 0; q < RB; ++q) { const int r = r0 + q * NW < NLAT ? r0 + q * NW : r0;
#pragma unroll
            for (int j = 0; j < 4; ++j) { xv[q][j] = __builtin_nontemporal_load((const u32x2*)(X1 + (size_t)r * D + j * 256 + lane * 4));
#pragma unroll
                for (int k = 0; k < 4; ++k) yv[q][j][k] = __builtin_nontemporal_load((const unsigned*)(Y + ((size_t)r * 4 + k) * D + j * 256 + lane * 4)); } }
#pragma unroll
        for (int q = 0; q < RB; ++q) { const int r = r0 + q * NW; if (r < NLAT) {
            const float* g2 = mod + (size_t)(r >> 11) * 6144 + 5120;
            f32x4 v[4]; float ss = 0.f;
#pragma unroll
            for (int j = 0; j < 4; ++j) { const int c0 = j * 256 + lane * 4;
                f32x4 sm = (f32x4){0.f, 0.f, 0.f, 0.f};
#pragma unroll
                for (int k = 0; k < 4; ++k) { const f32x2_ lo = __builtin_amdgcn_cvt_pk_f32_fp8(yv[q][j][k], false), hi = __builtin_amdgcn_cvt_pk_f32_fp8(yv[q][j][k], true); sm[0] += lo[0]; sm[1] += lo[1]; sm[2] += hi[0]; sm[3] += hi[1]; }
                const f32x4 g = *(const f32x4*)(g2 + c0);
                v[j][0] = __uint_as_float(xv[q][j].x << 16); v[j][1] = __uint_as_float(xv[q][j].x & 0xffff0000u); v[j][2] = __uint_as_float(xv[q][j].y << 16); v[j][3] = __uint_as_float(xv[q][j].y & 0xffff0000u);
                v[j] = v[j] + g * sm * (1.0f / SC_Y);
                ss += v[j][0] * v[j][0] + v[j][1] * v[j][1] + v[j][2] * v[j][2] + v[j][3] * v[j][3]; }
            const float rstd = __builtin_amdgcn_rsqf(wave_sum(ss) * (1.0f / D) + EPS);
#pragma unroll
            for (int j = 0; j < 4; ++j) { const int c0 = j * 256 + lane * 4; const f32x4 w = *(const f32x4*)(fw + c0); __builtin_nontemporal_store(v[j] * rstd * w, (f32x4*)(out + (size_t)r * D + c0)); }
        } }
    }
}

#define XB_TMO      128
#define XB_XCNT(j)  (256  + 64 * (j))
#define XB_XSUB(j)  (1280 + 64 * (j))
#define XB_XGEN(j)  (2304 + 64 * (j))
#define XB_TOP      3328
#define XB_TOPGEN   3392
#define XCD_BAR_WORDS 3456
#define XB_SPIN_CAP (1u << 20)
__device__ __forceinline__ unsigned xb_ld(unsigned* p)              { return __hip_atomic_load(p, __ATOMIC_RELAXED, __HIP_MEMORY_SCOPE_AGENT); }
__device__ __forceinline__ unsigned xb_add(unsigned* p, unsigned v) { return __hip_atomic_fetch_add(p, v, __ATOMIC_RELAXED, __HIP_MEMORY_SCOPE_AGENT); }
__device__ __forceinline__ unsigned xb_xcc_id() { return (unsigned)__builtin_amdgcn_s_getreg((3 << 11) | 20) & 0xFu; }
#define XB_SPIN(cond, bar) do { unsigned _sp = 0; while (cond) { __builtin_amdgcn_s_sleep(1); \
    if ((++_sp & 255u) == 0u) { if (xb_ld(&(bar)[XB_TMO])) break; if (_sp > XB_SPIN_CAP) { atomicAdd(&(bar)[XB_TMO], 1u); break; } } } } while (0)
struct XcdBarrier { unsigned* bar; unsigned x; volatile LAS unsigned* st; };
__device__ __forceinline__ XcdBarrier xcd_barrier_post(unsigned* bar, volatile LAS unsigned* st) {
    XcdBarrier b; b.bar = bar; b.x = xb_xcc_id(); b.st = st;
    if (threadIdx.x == 0) (void)xb_add(&bar[XB_XCNT(b.x)], 1u);
    return b;
}
__device__ __forceinline__ void xcd_barrier_complete(unsigned* bar, unsigned x, unsigned& nloc, unsigned& nx) {
    const unsigned G = gridDim.x * gridDim.y * gridDim.z;
    unsigned sum, cnt, mine, sp = 0u;
    for (;;) {
        sum = 0u; cnt = 0u; mine = 0u;
#pragma unroll
        for (unsigned j = 0; j < 16; ++j) { const unsigned c = xb_ld(&bar[XB_XCNT(j)]); sum += c; cnt += (c > 0u) ? 1u : 0u; mine = (j == x) ? c : mine; }
        if (sum == G) break;
        __builtin_amdgcn_s_sleep(1);
        if ((++sp & 255u) == 0u) { if (xb_ld(&bar[XB_TMO])) break; if (sp > XB_SPIN_CAP) { atomicAdd(&bar[XB_TMO], 1u); break; } }
    }
    nloc = mine > 0u ? mine : 1u; nx = cnt > 0u ? cnt : 1u;
}
__device__ __forceinline__ void xcd_barrier(unsigned* bar, volatile LAS unsigned* st) {
    asm volatile("s_waitcnt vmcnt(0)" ::: "memory");
    __syncthreads();
    if (threadIdx.x == 0) {
        __builtin_amdgcn_s_waitcnt(0);
        const unsigned x = xb_xcc_id();
        unsigned nloc = st[0], nx = st[1];
        if (nloc == 0u) { xcd_barrier_complete(bar, x, nloc, nx); st[0] = nloc; st[1] = nx; }
        const unsigned old = xb_add(&bar[XB_XSUB(x)], 1u);
        const unsigned gen = old / nloc;
        if (old + 1u == (gen + 1u) * nloc) {
            __builtin_amdgcn_fence(__ATOMIC_RELEASE, "agent");
            asm volatile("s_waitcnt vmcnt(0)" ::: "memory");
            const unsigned og = xb_add(&bar[XB_TOP], 1u);
            const unsigned tg = og / nx;
            if (og + 1u == (tg + 1u) * nx) xb_add(&bar[XB_TOPGEN], 1u);
            else XB_SPIN(xb_ld(&bar[XB_TOPGEN]) == tg, bar);
            __builtin_amdgcn_fence(__ATOMIC_ACQUIRE, "agent");
            xb_add(&bar[XB_XGEN(x)], 1u);
            asm volatile("s_waitcnt vmcnt(0)" ::: "memory");
        } else {
            XB_SPIN(xb_ld(&bar[XB_XGEN(x)]) == gen, bar);
            __builtin_amdgcn_fence(__ATOMIC_ACQUIRE, "agent");
            asm volatile("s_waitcnt vmcnt(0)" ::: "memory");
        }
    }
    __syncthreads();
}
constexpr size_t WS_BAR = 16384;
constexpr int LDS_BARST = LDS_BYTES - 16;

struct MegaArgs {
    const float *x, *c, *ctx, *c_ctx, *norm1_w, *norm2_w, *w_ada, *b_ada, *w_in, *lbl, *hg_nw, *conv_w, *conv_b, *rg_wa, *rg_ba, *rg_wx, *rg_bx, *rg_lam, *w_out,
        *router_w, *router_b, *wgu, *bgu, *wd, *bd, *final_w;
    float* out; unsigned char* ws;
};
typedef const MegaArgs __attribute__((address_space(4)))* KArgs;
__device__ __forceinline__ KArgs kargs() { auto p = __builtin_amdgcn_kernarg_segment_ptr(); asm volatile("" : "+s"(p)); return (KArgs)p; }
#define WSP(T, off) ((T*)(ws + (off)))
#define GRID_SYNC_CG() cg::this_grid().sync()
#define GRID_SYNC() do { KArgs a_ = kargs(); xcd_barrier((unsigned*)(a_->ws + WS_BAR), (volatile LAS unsigned*)(lds + LDS_BARST)); } while (0)
__global__ __launch_bounds__(512, 2) void k_mega(MegaArgs a_unused) {
    extern __shared__ __attribute__((aligned(16))) unsigned char lds_[];
    LAS unsigned char* lds = (LAS unsigned char*)lds_;
    if (threadIdx.x < 4) ((volatile LAS unsigned*)(lds + LDS_BARST))[threadIdx.x] = 0u;
    __syncthreads();
    { KArgs a = kargs(); (void)xcd_barrier_post((unsigned*)(a->ws + WS_BAR), (volatile LAS unsigned*)(lds + LDS_BARST)); }
    { KArgs a = kargs(); unsigned char* ws = a->ws; const int bid = blockIdx.x, G = gridDim.x;
      ProArgs pa; pa.c = a->c; pa.c_ctx = a->c_ctx; pa.w_ada = a->w_ada; pa.b_ada = a->b_ada; pa.lbl = a->lbl; pa.w_in = a->w_in; pa.w_out = a->w_out; pa.wgu = a->wgu; pa.wd = a->wd; pa.rg_wa = a->rg_wa; pa.rg_wx = a->rg_wx; pa.rg_lam = a->rg_lam;
      pa.coef = WSP(float, WS_COEF); pa.WG_t = WSP(bf16_t, WS_WG); pa.mod = WSP(float, WS_MOD); pa.lb = WSP(float, WS_LB); pa.Win_t = WSP(bf16_t, WS_WIN); pa.Wout_t = WSP(bf16_t, WS_WOUT); pa.Wgu_t = WSP(fp8_t, WS_WGU); pa.Wd_t = WSP(fp8_t, WS_WD);
      phase_prologue(lds, pa, bid, G, true, 0, 0); }
    { KArgs a_ = kargs(); if (a_->ws == nullptr) GRID_SYNC_CG(); }
    GRID_SYNC();
    { KArgs a = kargs(); unsigned char* ws = a->ws; phase_norm1(a->x, a->ctx, a->norm1_w, WSP(float, WS_MOD), WSP(bf16_t, WS_H), blockIdx.x, gridDim.x); }
    { KArgs a = kargs(); unsigned char* ws = a->ws;
      ProArgs pa; pa.c = nullptr; pa.c_ctx = nullptr; pa.w_ada = nullptr; pa.b_ada = nullptr; pa.lbl = nullptr; pa.w_in = a->w_in; pa.w_out = a->w_out; pa.wgu = nullptr; pa.wd = nullptr; pa.rg_wa = nullptr; pa.rg_wx = nullptr; pa.rg_lam = nullptr; pa.coef = nullptr; pa.WG_t = nullptr;
      pa.mod = nullptr; pa.lb = nullptr; pa.Win_t = WSP(bf16_t, WS_WIN); pa.Wout_t = WSP(bf16_t, WS_WOUT); pa.Wgu_t = nullptr; pa.Wd_t = nullptr;
      phase_prologue(lds, pa, blockIdx.x, gridDim.x, false, 0, IT_IN + IT_OUT); }
    GRID_SYNC();
    { KArgs a = kargs(); unsigned char* ws = a->ws; PolInProj P; P.A = WSP(bf16_t, WS_H); P.Bt = WSP(bf16_t, WS_WIN); P.O = WSP(bf16_t, WS_PROJ); P.ord.init(NLAT / BM, INW / BM, gridDim.x, blockIdx.x); gemm_phase(lds, P); }
    GRID_SYNC();
    { KArgs a = kargs(); unsigned char* ws = a->ws;
      for (int item = blockIdx.x; item < 256; item += gridDim.x)
          phase_rg_chain(lds, WSP(bf16_t, WS_PROJ), a->conv_w, a->conv_b, WSP(bf16_t, WS_WG), a->rg_ba, a->rg_bx, WSP(float, WS_COEF), WSP(bf16_t, WS_HF), WSP(bf16_t, WS_MIX2), item); }
    __syncthreads();
    { KArgs a = kargs(); unsigned char* ws = a->ws;
      for (int item = blockIdx.x; item < 256; item += gridDim.x) phase_hgrn2_ws(lds, WSP(bf16_t, WS_PROJ), WSP(float, WS_LB), WSP(bf16_t, WS_OF), WSP(bf16_t, WS_OB), item); }
    GRID_SYNC();
    { KArgs a = kargs(); unsigned char* ws = a->ws; phase_mix_finish(WSP(bf16_t, WS_PROJ), WSP(bf16_t, WS_OF), WSP(bf16_t, WS_OB), a->hg_nw, WSP(bf16_t, WS_MIX2), blockIdx.x, gridDim.x); }
    GRID_SYNC();
    { KArgs a = kargs(); unsigned char* ws = a->ws; PolOutProj P; P.A = WSP(bf16_t, WS_MIX2); P.Bt = WSP(bf16_t, WS_WOUT); P.x = a->x; P.mod = WSP(float, WS_MOD); P.O = WSP(bf16_t, WS_X1); P.ord.init(NLAT / BM, D / BM, gridDim.x, blockIdx.x); gemm_phase(lds, P); }
    GRID_SYNC();
    { KArgs a = kargs(); unsigned char* ws = a->ws;
      phase_norm2_route(lds, WSP(bf16_t, WS_X1), a->norm2_w, WSP(float, WS_MOD), a->router_w, a->router_b, WSP(fp8_t, WS_H2), WSP(u32, WS_CTL), WSP(u32, WS_TOKTAB), WSP(float, WS_WTAB), blockIdx.x, gridDim.x); }
    __syncthreads();
    { KArgs a = kargs(); unsigned char* ws = a->ws;
      ProArgs pa; pa.c = nullptr; pa.c_ctx = nullptr; pa.w_ada = nullptr; pa.b_ada = nullptr; pa.lbl = nullptr; pa.w_in = nullptr; pa.w_out = nullptr; pa.wgu = a->wgu; pa.wd = a->wd; pa.rg_wa = nullptr; pa.rg_wx = nullptr; pa.rg_lam = nullptr; pa.coef = nullptr; pa.WG_t = nullptr;
      pa.mod = nullptr; pa.lb = nullptr; pa.Win_t = nullptr; pa.Wout_t = nullptr; pa.Wgu_t = WSP(fp8_t, WS_WGU); pa.Wd_t = WSP(fp8_t, WS_WD);
      phase_prologue(lds, pa, blockIdx.x, gridDim.x, false, IT_IN + IT_OUT, IT_ALL); }
    GRID_SYNC();
#pragma unroll 1
    for (int half = 0; half < NHALF; ++half) {
        { KArgs a = kargs(); unsigned char* ws = a->ws; LAS int* tstart = (LAS int*)(lds + LDS_AUX);
          const int tot = moe_tile_table(tstart, WSP(u32, WS_CTL), half);
          PolGateUp P; P.A = WSP(fp8_t, WS_H2); P.Bt = WSP(fp8_t, WS_WGU); P.bgu = a->bgu; P.toktab = WSP(u32, WS_TOKTAB); P.wtab = WSP(float, WS_WTAB); P.O = WSP(fp8_t, WS_ACT); P.mt.tstart = tstart; P.mt.cnt = WSP(u32, WS_CTL); P.mt.half = half;
          P.ord.init(tot, DFF / HALFT, gridDim.x, blockIdx.x);
          gemm_phase(lds, P); }
        GRID_SYNC();
        { KArgs a = kargs(); unsigned char* ws = a->ws; LAS int* tstart = (LAS int*)(lds + LDS_AUX);
          const int tot = moe_tile_table(tstart, WSP(u32, WS_CTL), half);
          {
              const u32x4* wp = (const u32x4*)WSP(fp8_t, WS_WD) + (size_t)blockIdx.x * 8192 + threadIdx.x; u32x4 acc_ = (u32x4){0u, 0u, 0u, 0u};
#pragma unroll
              for (int i = 0; i < 16; ++i) acc_ |= wp[i * 512];
              asm volatile("" :: "v"(acc_));
          }
          PolDown P; P.A = WSP(fp8_t, WS_ACT); P.Bt = WSP(fp8_t, WS_WD); P.bd = a->bd; P.toktab = WSP(u32, WS_TOKTAB); P.wtab = WSP(float, WS_WTAB); P.O = WSP(fp8_t, WS_Y); P.mt.tstart = tstart; P.mt.cnt = WSP(u32, WS_CTL); P.mt.half = half;
          P.ord.init(tot, D / BM, gridDim.x, blockIdx.x);
          gemm_phase(lds, P); }
        GRID_SYNC();
        { KArgs a = kargs(); unsigned char* ws = a->ws; phase_combine(a->out, WSP(bf16_t, WS_X1), WSP(fp8_t, WS_Y), WSP(float, WS_MOD), a->final_w, blockIdx.x, gridDim.x); }
        __syncthreads();
    }
}

extern "C" void kernel_launch(void* const* d_in, const int* in_sizes, int n_in, void* d_out, int out_size, void* d_ws, size_t ws_size, hipStream_t stream) {
    static int grid_blocks = 0;
    if (!grid_blocks) {
        int dev = 0, cus = 0, per_cu = 0;
        (void)hipGetDevice(&dev);
        (void)hipDeviceGetAttribute(&cus, hipDeviceAttributeMultiprocessorCount, dev);
        (void)hipFuncSetAttribute((const void*)k_mega, hipFuncAttributeMaxDynamicSharedMemorySize, LDS_BYTES);
        (void)hipOccupancyMaxActiveBlocksPerMultiprocessor(&per_cu, (const void*)k_mega, 512, LDS_BYTES);
        if (per_cu < 1) { fprintf(stderr, "kernel_launch: occupancy query says %d blocks/CU\n", per_cu); per_cu = 1; }
        grid_blocks = cus * 1;
    }
    if (ws_size < 1024 * MiB) { fprintf(stderr, "kernel_launch: workspace too small (%zu)\n", ws_size); return; }
    MegaArgs a{};
    const float** ap = (const float**)&a;
    for (int i = 0; i < 26; ++i) ap[i] = (const float*)d_in[i];
    a.out = (float*)d_out; a.ws = (unsigned char*)d_ws;
    (void)hipMemsetAsync((unsigned char*)d_ws + WS_CTL, 0, 32768, stream);
    void* args[] = {&a};
    hipError_t e = hipLaunchCooperativeKernel((const void*)k_mega, dim3(grid_blocks), dim3(512), args, LDS_BYTES, stream);
    if (e != hipSuccess) fprintf(stderr, "cooperative launch failed: %s (grid %d)\n", hipGetErrorString(e), grid_blocks);
}
```

```cpp
#include <hip/hip_runtime.h>
#include <hip/hip_cooperative_groups.h>
#include <cstdio>
#include <cstdint>

typedef unsigned short bf16_t;
typedef unsigned int u32;
namespace cg = cooperative_groups;

constexpr int D = 1024, NB = 32, T = 2048, CTXL = 256, GRIDW = 64, GROWS = T / GRIDW;
constexpr int NLAT = NB * T;
constexpr int NCTX = NB * CTXL;
constexpr int NROWS = NLAT + NCTX;
constexpr int HGW = 512, RGW = 512, INW = 3584;
constexpr int C_Q = 0, C_I = 512, C_FF = 1024, C_FB = 1536, C_G = 2048, C_RX = 2560, C_RG = 3072;
constexpr int NE = 32, TOPK = 4, DFF = 1024;
constexpr int NCHK = (CTXL + T) / 64;
constexpr int NHALF = 1;
constexpr int HALF_TOK = NLAT / NHALF;
constexpr int CAP = HALF_TOK;
constexpr int MAXSLOT = HALF_TOK * TOPK + NE * 256;
constexpr float EPS = 1e-6f;

constexpr size_t MiB = 1u << 20;
constexpr size_t WS_CTL = 0;
constexpr size_t WS_WG = 64 * 1024;
constexpr size_t WS_MOD = 1 * MiB;
constexpr size_t WS_LB = WS_MOD + 33 * 6144 * 4;
constexpr size_t WS_COEF = WS_LB + 4096;
constexpr size_t WS_TOKTAB = 2 * MiB;
constexpr size_t WS_WTAB = 10 * MiB;
constexpr size_t WS_WIN = 18 * MiB, WS_WOUT = 25 * MiB;
constexpr size_t WS_OF = 28 * MiB, WS_OB = 92 * MiB;
constexpr size_t WS_HF = 156 * MiB;
constexpr size_t WS_H = 284 * MiB;
constexpr size_t WS_MIX2 = WS_H;
constexpr size_t WS_PROJ = 428 * MiB;
constexpr size_t WS_H2 = 28 * MiB;
constexpr size_t WS_WGU = 92 * MiB, WS_WD = 156 * MiB;
constexpr size_t WS_ACT = 188 * MiB;
constexpr size_t WS_Y = 452 * MiB;
constexpr size_t WS_X1 = 708 * MiB;
constexpr float SC_Y = 16.0f;

__device__ __forceinline__ float bf2f(bf16_t b) { return __uint_as_float(((u32)b) << 16); }
__device__ __forceinline__ bf16_t f2bf(float f) { u32 u = __float_as_uint(f); u += 0x7fffu + ((u >> 16) & 1u); return (bf16_t)(u >> 16); }
__device__ __forceinline__ u32 pk2(float lo, float hi) { return (u32)f2bf(lo) | ((u32)f2bf(hi) << 16); }
__device__ __forceinline__ float fexp(float x) { return __builtin_amdgcn_exp2f(x * 1.4426950408889634f); }
__device__ __forceinline__ float frcp(float x) { return __builtin_amdgcn_rcpf(x); }
__device__ __forceinline__ float flog(float x) { return __builtin_amdgcn_logf(x) * 0.6931471805599453f; }
__device__ __forceinline__ float fsqrt(float x) { return __builtin_amdgcn_sqrtf(x); }
__device__ __forceinline__ float sigmoidf_(float x) { return frcp(1.0f + fexp(-x)); }
__device__ __forceinline__ float wave_sum(float v) {
#pragma unroll
    for (int o = 1; o < 64; o <<= 1) v += __shfl_xor(v, o);
    return v;
}

__device__ __forceinline__ float gelu_tanh(float x) { const float u = 1.5957691216057308f * (x + 0.044715f * x * x * x); return x * sigmoidf_(u); }
#define LAS __attribute__((address_space(3)))
typedef short bf16x8 __attribute__((ext_vector_type(8)));
typedef float f32x4 __attribute__((ext_vector_type(4)));
typedef unsigned u32x4 __attribute__((ext_vector_type(4)));
typedef int v8i __attribute__((ext_vector_type(8)));
typedef int v4i_ __attribute__((ext_vector_type(4)));
typedef unsigned u32x2 __attribute__((ext_vector_type(2)));
typedef float f32x2 __attribute__((ext_vector_type(2)));
typedef unsigned char fp8_t;
constexpr float SC_H2 = 16.0f, SC_W = 32.0f, SC_ACT = 4.0f;
__device__ __forceinline__ unsigned pk4_fp8(float a, float b, float c, float d) {
    a = fminf(fmaxf(a, -448.f), 448.f); b = fminf(fmaxf(b, -448.f), 448.f); c = fminf(fmaxf(c, -448.f), 448.f); d = fminf(fmaxf(d, -448.f), 448.f);
    int r = 0; r = __builtin_amdgcn_cvt_pk_fp8_f32(a, b, r, false); r = __builtin_amdgcn_cvt_pk_fp8_f32(c, d, r, true); return (unsigned)r; }
__device__ __forceinline__ unsigned pk4_fp8_nc(float a, float b, float c, float d) { int r = 0; r = __builtin_amdgcn_cvt_pk_fp8_f32(a, b, r, false); r = __builtin_amdgcn_cvt_pk_fp8_f32(c, d, r, true); return (unsigned)r; }
constexpr int BM = 256, BK = 64, HALFT = 128, HTB = HALFT * BK * 2, STAGE_BYTES = 8 * HTB, NXCD = 8, WGM = 8;
constexpr int GK = 1024;
constexpr int LDS_BYTES = 147456;
constexpr int LDS_AUX = STAGE_BYTES;

__device__ __forceinline__ int lds_byte(int r, int c) { const int st = (r >> 4) * 2 + (c >> 5), rr = r & 15, cc = c & 31, ob = rr * 64 + cc * 2; return st * 1024 + (ob ^ (((ob >> 9) & 1) << 5)); }
__device__ __forceinline__ void stage_rc(int b, int& R, int& C) { const int st = b / 1024, sb = b % 1024, swz = sb ^ (((sb >> 9) & 1) << 5); R = (st >> 1) * 16 + swz / 64; C = (st & 1) * 32 + (swz % 64) / 2; }
__device__ __forceinline__ int perm32(int rho) { const int n = rho >> 4, i = rho & 15; return 8 * (i >> 2) + 4 * n + (i & 3); }
__device__ __forceinline__ unsigned cvt_pk_bf16(float lo, float hi) { unsigned r; asm volatile("v_cvt_pk_bf16_f32 %0, %1, %2" : "=v"(r) : "v"(lo), "v"(hi)); return r; }

struct Unit { int pm, pn, e, pos0, cn; };
struct TileOrder {
    int nM, nN, nwg, G, c;
    __device__ __forceinline__ void init(int nM_, int nN_, int G_, int c_) { nM = nM_; nN = nN_; nwg = nM * nN; G = G_; c = c_; }
    __device__ __forceinline__ bool tile(int i, int& pm, int& pn) const {
        const long L = (long)i * G + c; if (L >= nwg) return false;
        int wgid = (int)L; { const int q = nwg / NXCD, r = nwg % NXCD, xcd = wgid % NXCD, off = wgid / NXCD; wgid = (xcd < r ? xcd * (q + 1) : r * (q + 1) + (xcd - r) * q) + off; }
        const int nig = WGM * nN, gid = wgid / nig, fm = gid * WGM, gsz = (nM - fm) < WGM ? (nM - fm) : WGM;
        pm = fm + ((wgid % nig) % gsz); pn = (wgid % nig) / gsz; return true;
    }
};

template <class POL>
__device__ __forceinline__ void gemm_phase(LAS unsigned char* lds, const POL& P) {
    int tid_ = threadIdx.x; asm volatile("" : "+v"(tid_));
    const int tid = tid_, wid = __builtin_amdgcn_readfirstlane(tid >> 6), lane = tid & 63, wr = wid >> 2, wc = wid & 3, fr = lane & 15, fq = lane >> 4;
    constexpr int KB = POL::FP8 ? 1024 : 2048, nt = KB / 128;
    int sR[2], sC[2]; unsigned voffA[2], voffB[2];
#pragma unroll
    for (int i = 0; i < 2; ++i) { stage_rc(tid * 16 + i * 8192, sR[i], sC[i]); const int Rb = POL::PERM ? ((sR[i] & ~31) + perm32(sR[i] & 31)) : sR[i]; voffA[i] = (unsigned)(sR[i] * KB + sC[i] * 2); voffB[i] = (unsigned)(Rb * KB + sC[i] * 2); }
    constexpr size_t kstep = (size_t)(BK * 2);
    constexpr unsigned hstepB = (unsigned)HALFT * KB;
    const unsigned ldsw = (unsigned)wid * 1024u;
    const int aoff = lds_byte(wr * 64 + fr, fq * 8), boff = lds_byte(wc * 32 + fr, fq * 8);
#define G_SA(b, h) (((b) * 2 + (h)) * HTB)
#define G_SB(b, h) ((4 + (b) * 2 + (h)) * HTB)
#define G_AOFF(OFF, h, i) (POL::GATHER ? (OFF)[h][i] : voffA[i])
#define G_STAGE_A(bufoff, gbase, OFF, h) do { const char* _gb = (const char*)(gbase) + (POL::GATHER ? (size_t)0 : (size_t)(h) * hstepB); _Pragma("unroll") for (int _i = 0; _i < 2; ++_i) \
        __builtin_amdgcn_global_load_lds((const unsigned*)(_gb + G_AOFF(OFF, h, _i)), (LAS unsigned*)(lds + (bufoff) + ldsw + _i * 8192), 16, 0, 0); } while (0)
#define G_STAGE_B(bufoff, gbase, hoff) do { const char* _gb = (const char*)(gbase) + (size_t)(hoff); _Pragma("unroll") for (int _i = 0; _i < 2; ++_i) \
        __builtin_amdgcn_global_load_lds((const unsigned*)(_gb + voffB[_i]), (LAS unsigned*)(lds + (bufoff) + ldsw + _i * 8192), 16, 0, 0); } while (0)
#define G_LD8(p) __builtin_shufflevector(*(const LAS v4i_*)(p), *(const LAS v4i_*)((p) + 1024), 0, 1, 2, 3, 4, 5, 6, 7)
#define G_LDA(dst, b, h) do { if (POL::FP8) { _Pragma("unroll") for (int m = 0; m < 4; ++m) dst##8[m] = G_LD8(lds + G_SA(b, h) + aoff + m * 2048); } \
        else { _Pragma("unroll") for (int m = 0; m < 4; ++m) _Pragma("unroll") for (int k = 0; k < 2; ++k) dst[m][k] = *(const LAS bf16x8*)(lds + G_SA(b, h) + aoff + m * 2048 + k * 1024); } } while (0)
#define G_LDB(dst, b, h) do { if (POL::FP8) { _Pragma("unroll") for (int n = 0; n < 2; ++n) dst##8[n] = G_LD8(lds + G_SB(b, h) + boff + n * 2048); } \
        else { _Pragma("unroll") for (int n = 0; n < 2; ++n) _Pragma("unroll") for (int k = 0; k < 2; ++k) dst[n][k] = *(const LAS bf16x8*)(lds + G_SB(b, h) + boff + n * 2048 + k * 1024); } } while (0)
#define G_MMA(ai, bj, At, Bt) do { __builtin_amdgcn_s_setprio(1); \
        if (POL::FP8) { _Pragma("unroll") for (int m = 0; m < 4; ++m) _Pragma("unroll") for (int n = 0; n < 2; ++n) \
            asm volatile("v_mfma_scale_f32_16x16x128_f8f6f4 %0, %1, %2, %0, %3, %3 op_sel_hi:[0,0,0]" : "+v"(acc[ai][bj][m][n]) : "v"(Bt##8[n]), "v"(At##8[m]), "v"(mxs)); } \
        else { _Pragma("unroll") for (int m = 0; m < 4; ++m) _Pragma("unroll") for (int n = 0; n < 2; ++n) _Pragma("unroll") for (int k = 0; k < 2; ++k) \
            acc[ai][bj][m][n] = __builtin_amdgcn_mfma_f32_16x16x32_bf16(Bt[n][k], At[m][k], acc[ai][bj][m][n], 0, 0, 0); } \
        __builtin_amdgcn_s_setprio(0); } while (0)
#define G_WAIT_V(n) asm volatile("s_waitcnt vmcnt(" #n ")" ::: "memory")
#define G_WAIT_L(n) asm volatile("s_waitcnt lgkmcnt(" #n ")" ::: "memory")
#define G_BAR __builtin_amdgcn_s_barrier()
#define G_SCHED __builtin_amdgcn_sched_barrier(0)
#define G_TRIP(A1, OC, A2, ON, B2) do { \
        G_LDB(B0, 0, 0); G_SCHED; G_LDA(At, 0, 0); G_STAGE_A(G_SA(1, 1), A1, OC, 1); \
        G_WAIT_L(8); G_BAR; G_WAIT_L(0); G_MMA(0, 0, At, B0); G_BAR; G_SCHED; \
        G_LDB(B1, 0, 1); G_STAGE_B(G_SB(0, 0), B2, 0u); \
        G_BAR; G_WAIT_L(0); G_MMA(0, 1, At, B1); G_BAR; \
        G_LDA(At, 0, 1); G_STAGE_A(G_SA(0, 0), A2, ON, 0); \
        G_BAR; G_WAIT_L(0); G_MMA(1, 0, At, B0); G_BAR; G_SCHED; \
        G_STAGE_B(G_SB(0, 1), B2, hstepB); \
        G_WAIT_V(6); G_BAR; G_MMA(1, 1, At, B1); G_BAR; \
        G_LDB(B0, 1, 0); G_SCHED; G_LDA(At, 1, 0); G_STAGE_A(G_SA(0, 1), A2, ON, 1); \
        G_WAIT_L(8); G_BAR; G_WAIT_L(0); G_MMA(0, 0, At, B0); G_BAR; G_SCHED; \
        G_LDB(B1, 1, 1); G_STAGE_B(G_SB(1, 0), (B2) + kstep, 0u); \
        G_BAR; G_WAIT_L(0); G_MMA(0, 1, At, B1); G_BAR; \
        G_LDA(At, 1, 1); G_STAGE_A(G_SA(1, 0), (A2) + kstep, ON, 0); \
        G_BAR; G_WAIT_L(0); G_MMA(1, 0, At, B0); G_BAR; G_SCHED; \
        G_STAGE_B(G_SB(1, 1), (B2) + kstep, hstepB); \
        G_WAIT_V(6); G_BAR; G_MMA(1, 1, At, B1); G_BAR; } while (0)
#define G_TRIP2(A1, OC, A2, ON, B2) do { \
        G_LDB(B0, 0, 0); G_LDB(B1, 0, 1); G_SCHED; G_LDA(At, 0, 0); G_STAGE_A(G_SA(1, 1), A1, OC, 1); \
        G_WAIT_V(8); G_WAIT_L(0); G_BAR; G_MMA(0, 0, At, B0); G_MMA(0, 1, At, B1); G_BAR; G_SCHED; \
        G_LDA(At, 0, 1); G_STAGE_B(G_SB(0, 0), B2, 0u); G_STAGE_B(G_SB(0, 1), B2, hstepB); G_STAGE_A(G_SA(0, 0), A2, ON, 0); \
        G_WAIT_V(8); G_WAIT_L(0); G_BAR; G_MMA(1, 0, At, B0); G_MMA(1, 1, At, B1); G_BAR; G_SCHED; \
        G_LDB(B0, 1, 0); G_LDB(B1, 1, 1); G_SCHED; G_LDA(At, 1, 0); G_STAGE_A(G_SA(0, 1), A2, ON, 1); \
        G_WAIT_V(8); G_WAIT_L(0); G_BAR; G_MMA(0, 0, At, B0); G_MMA(0, 1, At, B1); G_BAR; G_SCHED; \
        G_LDA(At, 1, 1); G_STAGE_B(G_SB(1, 0), (B2) + kstep, 0u); G_STAGE_B(G_SB(1, 1), (B2) + kstep, hstepB); G_STAGE_A(G_SA(1, 0), (A2) + kstep, ON, 0); \
        G_WAIT_V(8); G_WAIT_L(0); G_BAR; G_MMA(1, 0, At, B0); G_MMA(1, 1, At, B1); G_BAR; G_SCHED; } while (0)
#ifndef GEMM_SP2
#define GEMM_SP2 1
#endif
    Unit cur, nxt; int ui = 0;
    if (!P.next(0, cur)) return;
    f32x4 acc[2][2][4][2];
#pragma unroll
    for (int a = 0; a < 2; ++a)
#pragma unroll
        for (int b = 0; b < 2; ++b)
#pragma unroll
            for (int m = 0; m < 4; ++m)
#pragma unroll
                for (int n = 0; n < 2; ++n) acc[a][b][m][n] = (f32x4){0.f, 0.f, 0.f, 0.f};
    const int mxs = 0x7f7f7f7f;
    bf16x8 At[4][2], B0[2][2], B1[2][2]; v8i At8[4], B08[2], B18[2];
    unsigned oc[2][2], on[2][2];
    if (POL::ROWS) { P.stage_rows(cur, 0); __syncthreads(); }
#pragma unroll
    for (int h = 0; h < 2; ++h)
#pragma unroll
        for (int i = 0; i < 2; ++i) { oc[h][i] = POL::GATHER ? P.a_off_l(0, h * HALFT + sR[i]) + (unsigned)sC[i] * 2u : 0u; on[h][i] = 0u; }
    const char* cA = P.a_base(cur); const char* cB = P.b_base(cur);
    if (GEMM_SP2) {
        G_STAGE_B(G_SB(0, 0), cB, 0u); G_STAGE_B(G_SB(0, 1), cB, hstepB); G_STAGE_A(G_SA(0, 0), cA, oc, 0); G_STAGE_A(G_SA(0, 1), cA, oc, 1);
        if (wr == 1) G_BAR;
        G_WAIT_V(2); G_BAR;
        G_STAGE_B(G_SB(1, 0), cB + kstep, 0u); G_STAGE_A(G_SA(1, 0), cA + kstep, oc, 0); G_STAGE_B(G_SB(1, 1), cB + kstep, hstepB);
        G_WAIT_V(6); G_BAR;
    } else {
    G_STAGE_B(G_SB(0, 0), cB, 0u); G_STAGE_A(G_SA(0, 0), cA, oc, 0); G_STAGE_B(G_SB(0, 1), cB, hstepB); G_STAGE_A(G_SA(0, 1), cA, oc, 1);
    if (wr == 1) G_BAR;
    G_WAIT_V(4); G_BAR;
    G_STAGE_B(G_SB(1, 0), cB + kstep, 0u); G_STAGE_A(G_SA(1, 0), cA + kstep, oc, 0); G_STAGE_B(G_SB(1, 1), cB + kstep, hstepB);
    G_WAIT_V(6); G_BAR;
    }
    for (;;) {
        const bool has_next = P.next(ui + 1, nxt);
        const char* nA = has_next ? P.a_base(nxt) : cA; const char* nB = has_next ? P.b_base(nxt) : cB;
        if (POL::ROWS) { if (has_next) P.stage_rows(nxt, (ui + 1) & 1); }
#pragma unroll 1
        for (int t = 0; t < nt; t += 2) {
            const bool last = (t == nt - 2);
            const char* a1 = cA + (size_t)(t + 1) * kstep; const char* a2 = last ? nA : cA + (size_t)(t + 2) * kstep; const char* b2 = last ? nB : cB + (size_t)(t + 2) * kstep;
            if (POL::GATHER) {
                unsigned os[2][2];
                if (last) {
#pragma unroll
                    for (int h = 0; h < 2; ++h)
#pragma unroll
                        for (int i = 0; i < 2; ++i) on[h][i] = has_next ? P.a_off_l((ui + 1) & 1, h * HALFT + sR[i]) + (unsigned)sC[i] * 2u : oc[h][i];
                }
#pragma unroll
                for (int h = 0; h < 2; ++h)
#pragma unroll
                    for (int i = 0; i < 2; ++i) os[h][i] = last ? on[h][i] : oc[h][i];
                if (GEMM_SP2) { G_TRIP2(a1, oc, a2, os, b2); } else { G_TRIP(a1, oc, a2, os, b2); }
            } else { if (GEMM_SP2) { G_TRIP2(a1, oc, a2, oc, b2); } else { G_TRIP(a1, oc, a2, oc, b2); } }
        }
        if (POL::FP8) asm volatile("s_nop 15\n\ts_nop 15" ::: "memory");
        if (wr == 0) G_BAR;
        P.epi(acc, cur, wr, wc, fr, fq, ui & 1);
        if (!has_next) break;
#pragma unroll
        for (int a = 0; a < 2; ++a)
#pragma unroll
            for (int b = 0; b < 2; ++b)
#pragma unroll
                for (int m = 0; m < 4; ++m)
#pragma unroll
                    for (int n = 0; n < 2; ++n) acc[a][b][m][n] = (f32x4){0.f, 0.f, 0.f, 0.f};
        cur = nxt; cA = nA; cB = nB; ++ui;
        if (POL::GATHER) {
#pragma unroll
            for (int h = 0; h < 2; ++h)
#pragma unroll
                for (int i = 0; i < 2; ++i) oc[h][i] = on[h][i];
        }
        if (wr == 1) G_BAR;
    }
    G_WAIT_V(0);
    G_BAR;
#undef G_SA
#undef G_SB
#undef G_AOFF
#undef G_STAGE_A
#undef G_STAGE_B
#undef G_LDA
#undef G_LDB
#undef G_MMA
#undef G_LD8
#undef G_WAIT_V
#undef G_WAIT_L
#undef G_BAR
#undef G_SCHED
#undef G_TRIP
#undef G_TRIP2
}

struct PolInProj {
    static constexpr bool PERM = true, GATHER = false, FP8 = false, ROWS = false;
    __device__ __forceinline__ void stage_rows(const Unit&, int) const {}
    __device__ __forceinline__ unsigned a_off_l(int, int) const { return 0u; }
    const bf16_t* A; const bf16_t* Bt; bf16_t* O; TileOrder ord;
    __device__ __forceinline__ bool next(int i, Unit& u) const {
        constexpr int NLATU = (NLAT / BM) * (INW / BM);
        const int L = i * ord.G + ord.c;
        if (L < NLATU) return ord.tile(i, u.pm, u.pn);
        const int q = L - NLATU; if (q >= (NCTX / BM) * 8) return false;
        u.pm = NLAT / BM + (q >> 3); const int j = q & 7; u.pn = j < 6 ? 2 + j : 4 + j; return true;
    }
    __device__ __forceinline__ const char* a_base(const Unit& u) const { return (const char*)A + (size_t)u.pm * BM * GK * 2; }
    __device__ __forceinline__ unsigned a_off(const Unit&, int r) const { return (unsigned)r * GK * 2u; }
    __device__ __forceinline__ const char* b_base(const Unit& u) const { return (const char*)Bt + (size_t)u.pn * BM * GK * 2; }
    __device__ __forceinline__ void epi(const f32x4 (&acc)[2][2][4][2], const Unit& u, int wr, int wc, int fr, int fq, int par) const {
        const int row0 = u.pm * BM + wr * 64 + fr, col0 = u.pn * BM + wc * 32 + 8 * fq;
        const bool qsilu = u.pn < HGW / BM;
#pragma unroll
        for (int ai = 0; ai < 2; ++ai)
#pragma unroll
            for (int m = 0; m < 4; ++m) { bf16_t* rowp = O + (size_t)(row0 + ai * HALFT + m * 16) * INW + col0;
#pragma unroll
                for (int bj = 0; bj < 2; ++bj) { f32x4 v0 = acc[ai][bj][m][0], v1 = acc[ai][bj][m][1];
                    if (qsilu) {
#pragma unroll
                        for (int e = 0; e < 4; ++e) { v0[e] = v0[e] * sigmoidf_(v0[e]); v1[e] = v1[e] * sigmoidf_(v1[e]); } }
                    u32x4 w; w.x = cvt_pk_bf16(v0[0], v0[1]); w.y = cvt_pk_bf16(v0[2], v0[3]); w.z = cvt_pk_bf16(v1[0], v1[1]); w.w = cvt_pk_bf16(v1[2], v1[3]);
                    *(u32x4*)(rowp + bj * HALFT) = w; } }
    }
};
struct PolOutProj {
    static constexpr bool PERM = true, GATHER = false, FP8 = false, ROWS = false;
    __device__ __forceinline__ void stage_rows(const Unit&, int) const {}
    __device__ __forceinline__ unsigned a_off_l(int, int) const { return 0u; }
    const bf16_t* A; const bf16_t* Bt; const float* x; const float* mod; bf16_t* O; TileOrder ord;
    __device__ __forceinline__ bool next(int i, Unit& u) const { return ord.tile(i, u.pm, u.pn); }
    __device__ __forceinline__ const char* a_base(const Unit& u) const { return (const char*)A + (size_t)u.pm * BM * GK * 2; }
    __device__ __forceinline__ unsigned a_off(const Unit&, int r) const { return (unsigned)r * GK * 2u; }
    __device__ __forceinline__ const char* b_base(const Unit& u) const { return (const char*)Bt + (size_t)u.pn * BM * GK * 2; }
    __device__ __forceinline__ void epi(const f32x4 (&acc)[2][2][4][2], const Unit& u, int wr, int wc, int fr, int fq, int par) const {
        const int row0 = u.pm * BM + wr * 64 + fr, col0 = u.pn * BM + wc * 32 + 8 * fq;
        const float* g1 = mod + (size_t)((u.pm * BM) >> 11) * 6144 + 2048 + col0;
        f32x4 gv[2][2];
#pragma unroll
        for (int bj = 0; bj < 2; ++bj) { gv[bj][0] = *(const f32x4*)(g1 + bj * HALFT); gv[bj][1] = *(const f32x4*)(g1 + bj * HALFT + 4); }
#pragma unroll
        for (int ai = 0; ai < 2; ++ai)
#pragma unroll
            for (int m = 0; m < 4; ++m) { const size_t off = (size_t)(row0 + ai * HALFT + m * 16) * D + col0;
#pragma unroll
                for (int bj = 0; bj < 2; ++bj) {
                    const f32x4 x0 = __builtin_nontemporal_load((const f32x4*)(x + off + bj * HALFT)), x1v = __builtin_nontemporal_load((const f32x4*)(x + off + bj * HALFT + 4));
                    const f32x4 v0 = x0 + gv[bj][0] * acc[ai][bj][m][0], v1 = x1v + gv[bj][1] * acc[ai][bj][m][1];
                    u32x4 w; w.x = cvt_pk_bf16(v0[0], v0[1]); w.y = cvt_pk_bf16(v0[2], v0[3]); w.z = cvt_pk_bf16(v1[0], v1[1]); w.w = cvt_pk_bf16(v1[2], v1[3]);
                    *(u32x4*)(O + off + bj * HALFT) = w; }
                asm volatile("" ::: "memory"); }
    }
};
struct MoeTiles {
    const LAS int* tstart; const u32* cnt; int half;
    __device__ __forceinline__ LAS u32* rows(int par) const { return (LAS u32*)((LAS unsigned char*)tstart + 8192) + par * 512; }
    __device__ __forceinline__ void stage(const Unit& u, int par, const u32* toktab, const float* wtab) const {
        if (threadIdx.x < BM) { const int p = u.pos0 + threadIdx.x; const size_t tb = ((size_t)half * NE + u.e) * CAP; const bool ok = p < u.cn;
            const u32 tk = ok ? toktab[tb + p] : ~0u; const float wg = ok ? wtab[tb + p] : 0.f; LAS u32* rt = rows(par); rt[threadIdx.x * 2] = tk; rt[threadIdx.x * 2 + 1] = __float_as_uint(wg); }
    }
    __device__ __forceinline__ void find(Unit& u) const {
        const int e = __builtin_amdgcn_readfirstlane(tstart[64 + u.pm]);
        u.e = e; u.pos0 = (u.pm - __builtin_amdgcn_readfirstlane(tstart[e])) * BM; u.cn = (int)cnt[half * NE + e];
    }
};
struct PolGateUp {
    static constexpr bool PERM = true, GATHER = true, FP8 = true, ROWS = true;
    const fp8_t* A; const fp8_t* Bt; const float* bgu; const u32* toktab; const float* wtab; fp8_t* O; MoeTiles mt; TileOrder ord;
    __device__ __forceinline__ void stage_rows(const Unit& u, int par) const { mt.stage(u, par, toktab, wtab); }
    __device__ __forceinline__ unsigned a_off_l(int par, int r) const { const u32 tk = mt.rows(par)[r * 2]; return (tk == ~0u ? 0u : (tk >> 2)) * 1024u; }
    __device__ __forceinline__ bool next(int i, Unit& u) const { if (!ord.tile(i, u.pm, u.pn)) return false; mt.find(u); return true; }
    __device__ __forceinline__ const char* a_base(const Unit&) const { return (const char*)A; }
    __device__ __forceinline__ unsigned a_off(const Unit& u, int r) const {
        const int p = u.pos0 + r; const u32 tk = toktab[((size_t)mt.half * NE + u.e) * CAP + (p < u.cn ? p : 0)];
        return (tk >> 2) * 1024u;
    }
    __device__ __forceinline__ const char* b_base(const Unit& u) const { return (const char*)Bt + ((size_t)u.e * 2048 + (size_t)u.pn * BM) * 1024; }
    __device__ __forceinline__ void epi(const f32x4 (&acc)[2][2][4][2], const Unit& u, int wr, int wc, int fr, int fq, int par) const {
        const int row0 = u.pm * BM + wr * 64 + fr, cc = u.pn * HALFT + wc * 32 + 8 * fq;
        const float* bg = bgu + (size_t)u.e * 2048 + cc;
        const f32x4 bg0 = *(const f32x4*)bg, bg1 = *(const f32x4*)(bg + 4), bu0 = *(const f32x4*)(bg + 1024), bu1 = *(const f32x4*)(bg + 1028);
        constexpr float inv = 1.0f / (SC_H2 * SC_W);
#pragma unroll
        for (int ai = 0; ai < 2; ++ai)
#pragma unroll
            for (int m = 0; m < 4; ++m) {
                f32x4 g0 = acc[ai][0][m][0] * inv + bg0, g1 = acc[ai][0][m][1] * inv + bg1, u0 = acc[ai][1][m][0] * inv + bu0, u1 = acc[ai][1][m][1] * inv + bu1;
                float o[8];
#pragma unroll
                for (int j = 0; j < 4; ++j) {
                    const float ga = fminf(g0[j], 7.0f), gb = fminf(g1[j], 7.0f);
                    const float ua = fminf(fmaxf(u0[j], -7.0f), 7.0f), ub = fminf(fmaxf(u1[j], -7.0f), 7.0f);
                    o[j] = ga * sigmoidf_(1.702f * ga) * (ua + 1.0f) * SC_ACT; o[4 + j] = gb * sigmoidf_(1.702f * gb) * (ub + 1.0f) * SC_ACT;
                }
                uint2 w; w.x = pk4_fp8_nc(o[0], o[1], o[2], o[3]); w.y = pk4_fp8_nc(o[4], o[5], o[6], o[7]);
                *(uint2*)(O + (size_t)(row0 + ai * HALFT + m * 16) * DFF + cc) = w;
                asm volatile("" ::: "memory");
            }
    }
};
struct PolDown {
    static constexpr bool PERM = true, GATHER = false, FP8 = true, ROWS = true;
    const fp8_t* A; const fp8_t* Bt; const float* bd; const u32* toktab; const float* wtab; fp8_t* O; MoeTiles mt; TileOrder ord;
    __device__ __forceinline__ void stage_rows(const Unit& u, int par) const { mt.stage(u, par, toktab, wtab); }
    __device__ __forceinline__ unsigned a_off_l(int, int) const { return 0u; }
    __device__ __forceinline__ bool next(int i, Unit& u) const { if (!ord.tile(i, u.pm, u.pn)) return false; mt.find(u); return true; }
    __device__ __forceinline__ const char* a_base(const Unit& u) const { return (const char*)A + (size_t)u.pm * BM * 1024; }
    __device__ __forceinline__ unsigned a_off(const Unit&, int r) const { return (unsigned)r * 1024u; }
    __device__ __forceinline__ const char* b_base(const Unit& u) const { return (const char*)Bt + ((size_t)u.e * 1024 + (size_t)u.pn * BM) * 1024; }
    __device__ __forceinline__ void epi(const f32x4 (&acc)[2][2][4][2], const Unit& u, int wr, int wc, int fr, int fq, int par) const {
        const int col0 = u.pn * BM + wc * 32 + 8 * fq;
        const float* bp = bd + (size_t)u.e * D + col0;
        f32x4 bv[2][2];
#pragma unroll
        for (int bj = 0; bj < 2; ++bj) { bv[bj][0] = *(const f32x4*)(bp + bj * HALFT); bv[bj][1] = *(const f32x4*)(bp + bj * HALFT + 4); }
        const LAS u32* rt = mt.rows(par);
        constexpr float inv = 1.0f / (SC_ACT * SC_W);
#pragma unroll
        for (int ai = 0; ai < 2; ++ai)
#pragma unroll
            for (int m = 0; m < 4; ++m) {
                const int rr = ai * HALFT + wr * 64 + m * 16 + fr;
                const u32 tk = rt[rr * 2];
                if (tk != ~0u) {
                    const float wg = __uint_as_float(rt[rr * 2 + 1]) * SC_Y;
                    fp8_t* rowp = O + (size_t)(tk - (u32)mt.half * HALF_TOK * 4u) * D + col0;
#pragma unroll
                    for (int bj = 0; bj < 2; ++bj) { const f32x4 v0 = (acc[ai][bj][m][0] * inv + bv[bj][0]) * wg, v1 = (acc[ai][bj][m][1] * inv + bv[bj][1]) * wg;
                        uint2 w; w.x = pk4_fp8(v0[0], v0[1], v0[2], v0[3]); w.y = pk4_fp8(v1[0], v1[1], v1[2], v1[3]);
                        *(uint2*)(rowp + bj * HALFT) = w; }
                }
            }
    }
};
__device__ __forceinline__ int moe_tile_table(LAS int* tstart, const u32* cnt, int half) {
    __syncthreads();
    if (threadIdx.x == 0) { int s = 0; for (int e = 0; e < NE; ++e) { tstart[e] = s; s += ((int)cnt[half * NE + e] + BM - 1) / BM; } tstart[NE] = s; }
    __syncthreads();
    const int tot = tstart[NE];
    for (int t = threadIdx.x; t < tot; t += 512) { int e = 0;
#pragma unroll 1
        for (int i = 1; i < NE; ++i) if (t >= tstart[i]) e = i;
        tstart[64 + t] = e; }
    __syncthreads();
    return tot;
}

__device__ __forceinline__ void conv_item(const float* __restrict__ W, int N, bf16_t* __restrict__ WT, int k0, int n0, size_t rowbase, LAS float* scr, int lane) {
#pragma unroll 4
    for (int i = 0; i < 16; ++i) { const int k = 4 * i + (lane >> 4); const f32x4 v = __builtin_nontemporal_load((const f32x4*)(W + (size_t)(k0 + k) * N + n0 + (lane & 15) * 4)); *(LAS f32x4*)(scr + k * 68 + (lane & 15) * 4) = v; }
    asm volatile("s_waitcnt lgkmcnt(0)" ::: "memory");
    const int c = lane & 7;
#pragma unroll
    for (int j = 0; j < 8; ++j) { const int n = (lane >> 3) + 8 * j; const LAS float* s = scr + (8 * c) * 68 + n;
        u32x4 o; o.x = cvt_pk_bf16(s[0 * 68], s[1 * 68]); o.y = cvt_pk_bf16(s[2 * 68], s[3 * 68]); o.z = cvt_pk_bf16(s[4 * 68], s[5 * 68]); o.w = cvt_pk_bf16(s[6 * 68], s[7 * 68]);
        *(u32x4*)(WT + (rowbase + n) * GK + k0 + 8 * c) = o; }
    asm volatile("s_waitcnt lgkmcnt(0)" ::: "memory");
}
__device__ __forceinline__ void conv_item8(const float* __restrict__ W, int N, fp8_t* __restrict__ WT, int k0, int n0, size_t rowbase, LAS float* scr, int lane) {
#pragma unroll 4
    for (int i = 0; i < 16; ++i) { const int k = 4 * i + (lane >> 4); const f32x4 v = __builtin_nontemporal_load((const f32x4*)(W + (size_t)(k0 + k) * N + n0 + (lane & 15) * 4)); *(LAS f32x4*)(scr + k * 68 + (lane & 15) * 4) = v; }
    asm volatile("s_waitcnt lgkmcnt(0)" ::: "memory");
    const LAS float* sp = scr + lane;
#pragma unroll
    for (int q = 0; q < 4; ++q) {
        u32x4 o;
        o.x = pk4_fp8(sp[(16 * q + 0) * 68] * SC_W, sp[(16 * q + 1) * 68] * SC_W, sp[(16 * q + 2) * 68] * SC_W, sp[(16 * q + 3) * 68] * SC_W);
        o.y = pk4_fp8(sp[(16 * q + 4) * 68] * SC_W, sp[(16 * q + 5) * 68] * SC_W, sp[(16 * q + 6) * 68] * SC_W, sp[(16 * q + 7) * 68] * SC_W);
        o.z = pk4_fp8(sp[(16 * q + 8) * 68] * SC_W, sp[(16 * q + 9) * 68] * SC_W, sp[(16 * q + 10) * 68] * SC_W, sp[(16 * q + 11) * 68] * SC_W);
        o.w = pk4_fp8(sp[(16 * q + 12) * 68] * SC_W, sp[(16 * q + 13) * 68] * SC_W, sp[(16 * q + 14) * 68] * SC_W, sp[(16 * q + 15) * 68] * SC_W);
        *(u32x4*)(WT + (rowbase + lane) * GK + k0 + 16 * q) = o;
    }
    asm volatile("s_waitcnt lgkmcnt(0)" ::: "memory");
}
constexpr int IT_IN = 16 * (INW / 64), IT_OUT = 16 * (D / 64), IT_GU = NE * 16 * 32, IT_D = NE * 16 * 16, IT_ALL = IT_IN + IT_OUT + IT_GU + IT_D;
struct ProArgs { const float *c, *c_ctx, *w_ada, *b_ada, *lbl, *w_in, *w_out, *wgu, *wd, *rg_wa, *rg_wx, *rg_lam; float *mod, *lb, *coef; bf16_t *Win_t, *Wout_t, *WG_t; fp8_t *Wgu_t, *Wd_t; };
__device__ __forceinline__ void phase_prologue(LAS unsigned char* lds, const ProArgs& a, int bid, int G, bool do_mod, int it_lo, int it_hi) {
    const int tid = threadIdx.x, lane = tid & 63, w = tid >> 6;
    if (!do_mod) {} else if (bid < 96) {
        LAS float* s = (LAS float*)lds;
        for (int i = tid; i < 33 * D; i += 512) { const int b = i >> 10, k = i & 1023; const float v = b < NB ? a.c[(size_t)b * D + k] : a.c_ctx[k]; s[i] = v * sigmoidf_(v); }
        __syncthreads();
        const int n = bid * 64 + lane;
        float acc[33];
#pragma unroll
        for (int b = 0; b < 33; ++b) acc[b] = 0.f;
#pragma unroll 1
        for (int k = 128 * w; k < 128 * w + 128; k += 16) {
            float wv[16];
#pragma unroll
            for (int i = 0; i < 16; ++i) wv[i] = __builtin_nontemporal_load(a.w_ada + (size_t)(k + i) * 6144 + n);
#pragma unroll
            for (int b = 0; b < 33; ++b)
#pragma unroll
                for (int i4 = 0; i4 < 4; ++i4) { const f32x4 sv = *(const LAS f32x4*)(s + b * D + k + 4 * i4); acc[b] += sv[0] * wv[4 * i4] + sv[1] * wv[4 * i4 + 1] + sv[2] * wv[4 * i4 + 2] + sv[3] * wv[4 * i4 + 3]; }
        }
        __syncthreads();
        LAS float* red = (LAS float*)lds;
#pragma unroll
        for (int b = 0; b < 33; ++b) red[(w * 33 + b) * 64 + lane] = acc[b];
        __syncthreads();
        for (int i = tid; i < 33 * 64; i += 512) { const int b = i >> 6, l = i & 63; float sum = a.b_ada[bid * 64 + l];
#pragma unroll
            for (int ww = 0; ww < 8; ++ww) sum += red[(ww * 33 + b) * 64 + l];
            a.mod[(size_t)b * 6144 + bid * 64 + l] = sum; }
        __syncthreads();
    } else if (bid == 96) {
        for (int i = tid; i < 2 * HGW; i += 512) { const float l0 = a.lbl[i], l1 = a.lbl[2 * HGW + i]; a.lb[i] = 1.0f / (1.0f + __expf(l1 - l0)); }
        for (int i = tid; i < 2 * RGW; i += 512) { const float l = a.rg_lam[i]; const float sp = (-l > 20.f) ? -l : log1pf(__expf(-l)); a.coef[i] = -8.0f * sp; }
    } else if (bid == 97) {
        for (int idx = tid; idx < 8 * 256 * 64; idx += 512) { const int hd = idx >> 14, n = (idx >> 6) & 255, kk = idx & 63, g = n >> 6, j = n & 63, d = g >> 1;
            const float* src = (g & 1) ? a.rg_wx : a.rg_wa; a.WG_t[idx] = f2bf(src[(((size_t)d * 8 + hd) * 64 + kk) * 64 + j]); }
    }
    LAS float* scr = (LAS float*)(lds + w * (64 * 68 * 4));
    const int gw = bid * 8 + w, NW = G * 8;
    for (int it = it_lo + gw; it < it_hi; it += NW) {
        int r = it;
        if (r < IT_IN) { const int kb = r / (INW / 64), nb = r % (INW / 64); conv_item(a.w_in, INW, a.Win_t, kb * 64, nb * 64, (size_t)nb * 64, scr, lane); continue; } r -= IT_IN;
        if (r < IT_OUT) { const int kb = r / 16, nb = r % 16; conv_item(a.w_out, D, a.Wout_t, kb * 64, nb * 64, (size_t)nb * 64, scr, lane); continue; } r -= IT_OUT;
        if (r < IT_GU) { const int e = r / 512, q = r % 512, kb = q / 32, nb = q % 32, n0 = nb * 64, bj = n0 >> 10, rem = n0 & 1023, pn = rem >> 7, cc0 = rem & 127;
            conv_item8(a.wgu + (size_t)e * D * 2048, 2048, a.Wgu_t, kb * 64, n0, (size_t)e * 2048 + pn * 256 + bj * 128 + cc0, scr, lane); continue; } r -= IT_GU;
        { const int e = r / 256, q = r % 256, kb = q / 16, nb = q % 16; conv_item8(a.wd + (size_t)e * DFF * D, D, a.Wd_t, kb * 64, nb * 64, (size_t)e * 1024 + nb * 64, scr, lane); }
    }
}


__device__ __forceinline__ void phase_norm1(const float* __restrict__ x, const float* __restrict__ ctx, const float* __restrict__ nw, const float* __restrict__ mod, bf16_t* __restrict__ H, int bid, int G) {
    constexpr int RB = 4;
    const int lane = threadIdx.x & 63, gw = bid * 8 + (threadIdx.x >> 6), NW = G * 8;
    for (int r0 = gw; r0 < NROWS; r0 += RB * NW) {
        f32x4 v[RB][4];
#pragma unroll
        for (int q = 0; q < RB; ++q) { const int r = r0 + q * NW; const int rr = r < NROWS ? r : r0;
            const float* src = rr < NLAT ? x + (size_t)rr * D : ctx + (size_t)(rr - NLAT) * D;
#pragma unroll
            for (int j = 0; j < 4; ++j) v[q][j] = __builtin_nontemporal_load((const f32x4*)(src + j * 256 + lane * 4)); }
#pragma unroll
        for (int q = 0; q < RB; ++q) { const int r = r0 + q * NW; if (r < NROWS) {
            const float* m = mod + (size_t)(r < NLAT ? (r >> 11) : NB) * 6144;
            float ss = 0.f;
#pragma unroll
            for (int j = 0; j < 4; ++j) ss += v[q][j][0] * v[q][j][0] + v[q][j][1] * v[q][j][1] + v[q][j][2] * v[q][j][2] + v[q][j][3] * v[q][j][3];
            const float rstd = __builtin_amdgcn_rsqf(wave_sum(ss) * (1.0f / D) + EPS);
#pragma unroll
            for (int j = 0; j < 4; ++j) {
                const int c0 = j * 256 + lane * 4;
                const f32x4 w = *(const f32x4*)(nw + c0), sh = *(const f32x4*)(m + c0), sc = *(const f32x4*)(m + 1024 + c0);
                const f32x4 o = v[q][j] * rstd * w * (sc + 1.0f) + sh;
                uint2 p; p.x = cvt_pk_bf16(o[0], o[1]); p.y = cvt_pk_bf16(o[2], o[3]);
                *(uint2*)(H + (size_t)r * D + c0) = p;
            } } }
    }
}

__device__ __forceinline__ bf16x8 pack8(const f32x4& a, const f32x4& b) {
    u32x4 w; w.x = cvt_pk_bf16(a[0], a[1]); w.y = cvt_pk_bf16(a[2], a[3]); w.z = cvt_pk_bf16(b[0], b[1]); w.w = cvt_pk_bf16(b[2], b[3]);
    return __builtin_bit_cast(bf16x8, w);
}
constexpr int HW_BUF = 45056;
constexpr int HW_QD = 0, HW_KET = 17408, HW_PM = 35840;
constexpr int HW_VT = 2 * HW_BUF, HW_KD = HW_VT + 18432, HW_OS = HW_KD + 17408, HW_TOT = HW_OS + 17408, HW_DEC = HW_TOT + 2048;
__device__ __forceinline__ void phase_hgrn2_ws(LAS unsigned char* lds, const bf16_t* __restrict__ P, const float* __restrict__ lb, bf16_t* __restrict__ OF, bf16_t* __restrict__ OB, int item) {
    const int b = item >> 3, h = (item >> 1) & 3, dir = item & 1;
    const int tid = threadIdx.x, w = __builtin_amdgcn_readfirstlane(tid >> 6), lane = tid & 63, l15 = lane & 15, G4 = lane >> 4;
    bf16_t* OD = dir ? OB : OF;
    const int cf = dir ? C_FB : C_FF;
    constexpr int NC = (CTXL + T) / 64;
    LAS float* TOT = (LAS float*)(lds + HW_TOT);
#define HW_BAR() do { asm volatile("s_waitcnt lgkmcnt(0)" ::: "memory"); __builtin_amdgcn_s_barrier(); asm volatile("" ::: "memory"); } while (0)
    __syncthreads();
    if (w >= 4) {
        const int et = tid - 256, kp = et & 63, k = 2 * kp, seg = et >> 6, ew = w - 4;
        const int kslot = (k & ~31) | (((k >> 2) & 3) << 3) | (((k >> 4) & 1) << 2) | (k & 3);
        const float lb0 = lb[dir * HGW + h * 128 + k], lb1 = lb[dir * HGW + h * 128 + k + 1];
        const char* Pc = (const char*)P; const int sstep = dir ? -(INW * 2) : INW * 2;
#define HW_OFF0(m_) ({ const int p_ = 64 * (m_) + 16 * seg; const unsigned r_ = p_ < CTXL ? (unsigned)(NLAT + b * CTXL + (dir ? CTXL - 1 - p_ : p_)) : (unsigned)(b * T + (dir ? T - 1 - (p_ - CTXL) : (p_ - CTXL))); (r_ * (unsigned)INW + (unsigned)(h * 128 + k)) * 2u; })
#define HW_LD(off0_, i_, col_) (*(const u32*)(Pc + (unsigned)((int)(off0_) + (i_) * sstep + (col_) * 2)))
#define BF_LO(w_) __uint_as_float((w_) << 16)
#define BF_HI(w_) __uint_as_float((w_) & 0xffff0000u)
        u32 rf[16];
        { const unsigned o0 = HW_OFF0(0);
#pragma unroll
        for (int i = 0; i < 16; ++i) rf[i] = HW_LD(o0, i, cf); }
#pragma unroll 1
        for (int m = 0; m < NC + 1; ++m) {
            const int par = m & 1;
            LAS unsigned char* buf = lds + par * HW_BUF;
            HW_BAR();
            u32 rq[16], rv[16]; float f0v[16], f1v[16], c0v[16], c1v[16]; float run0 = 0.f, run1 = 0.f;
            if (m < NC) {
                const unsigned o0 = HW_OFF0(m);
#pragma unroll
                for (int i = 0; i < 16; ++i) { rq[i] = HW_LD(o0, i, C_Q); rv[i] = HW_LD(o0, i, C_I); }
#pragma unroll
                for (int i = 0; i < 16; ++i) { const float f0 = lb0 + (1.f - lb0) * sigmoidf_(BF_LO(rf[i])), f1 = lb1 + (1.f - lb1) * sigmoidf_(BF_HI(rf[i]));
                    f0v[i] = f0; f1v[i] = f1; run0 += flog(f0); run1 += flog(f1); c0v[i] = run0; c1v[i] = run1; }
                *(LAS f32x2*)(TOT + seg * 128 + k) = (f32x2){run0, run1};
                if (m + 1 < NC) { const unsigned o1 = HW_OFF0(m + 1);
#pragma unroll
                    for (int i = 0; i < 16; ++i) rf[i] = HW_LD(o1, i, cf); }
            }
            HW_BAR();
            if (m < NC) {
                f32x2 tt[4];
#pragma unroll
                for (int q = 0; q < 4; ++q) tt[q] = *(const LAS f32x2*)(TOT + q * 128 + k);
                const float p0 = seg == 0 ? 0.f : seg == 1 ? tt[0].x : seg == 2 ? tt[0].x + tt[1].x : tt[0].x + tt[1].x + tt[2].x;
                const float p1 = seg == 0 ? 0.f : seg == 1 ? tt[0].y : seg == 2 ? tt[0].y + tt[1].y : tt[0].y + tt[1].y + tt[2].y;
                const float eb0 = fexp((tt[0].x + tt[1].x) + (tt[2].x + tt[3].x)), eb1 = fexp((tt[0].y + tt[1].y) + (tt[2].y + tt[3].y));
                if (seg == 0) *(LAS f32x2*)(lds + HW_DEC + par * 512 + k * 4) = (f32x2){eb0, eb1};
                float ke0[16], ke1[16];
#pragma unroll
                for (int i = 0; i < 16; ++i) {
                    const int j = 16 * seg + i;
                    const float e0 = fexp(p0 + c0v[i]), e1 = fexp(p1 + c1v[i]);
                    const float kf0 = (1.f - f0v[i]) * frcp(e0), kf1 = (1.f - f1v[i]) * frcp(e1);
                    *(LAS u32*)(buf + HW_QD + j * 272 + kslot * 2) = cvt_pk_bf16(BF_LO(rq[i]) * e0, BF_HI(rq[i]) * e1);
                    *(LAS u32*)(lds + HW_KD + j * 272 + kslot * 2) = cvt_pk_bf16(kf0, kf1);
                    ke0[i] = kf0 * eb0; ke1[i] = kf1 * eb1;
                }
#pragma unroll
                for (int q4 = 0; q4 < 2; ++q4) {
                    u32x4 a0, a1, v0, v1;
#pragma unroll
                    for (int i = 0; i < 4; ++i) { const int t = 8 * q4 + 2 * i;
                        a0[i] = cvt_pk_bf16(ke0[t], ke0[t + 1]); a1[i] = cvt_pk_bf16(ke1[t], ke1[t + 1]);
                        v0[i] = (rv[t] & 0xffffu) | (rv[t + 1] << 16); v1[i] = (rv[t] >> 16) | (rv[t + 1] & 0xffff0000u); }
                    *(LAS u32x4*)(buf + HW_KET + k * 144 + seg * 32 + q4 * 16) = a0; *(LAS u32x4*)(buf + HW_KET + (k + 1) * 144 + seg * 32 + q4 * 16) = a1;
                    *(LAS u32x4*)(lds + HW_VT + k * 144 + seg * 32 + q4 * 16) = v0; *(LAS u32x4*)(lds + HW_VT + (k + 1) * 144 + seg * 32 + q4 * 16) = v1;
                }
            }
            HW_BAR();
            if (m < NC && m >= CTXL / 64) {
                const int mt = ew;
                f32x4 pa[4];
#pragma unroll
                for (int q = 0; q < 4; ++q) pa[q] = (f32x4){0.f, 0.f, 0.f, 0.f};
#pragma unroll
                for (int s = 0; s < 4; ++s) {
                    const bf16x8 a = *(const LAS bf16x8*)(buf + HW_QD + (16 * mt + l15) * 272 + (32 * s + 8 * G4) * 2);
#pragma unroll
                    for (int q = 0; q < 4; ++q) { const bf16x8 bq = *(const LAS bf16x8*)(lds + HW_KD + (16 * q + l15) * 272 + (32 * s + 8 * G4) * 2); pa[q] = __builtin_amdgcn_mfma_f32_16x16x32_bf16(a, bq, pa[q], 0, 0, 0); }
                }
#pragma unroll
                for (int q = 0; q < 4; ++q)
#pragma unroll
                    for (int r = 0; r < 4; ++r) { const int c = 16 * mt + 4 * G4 + r, j = 16 * q + l15; *(LAS bf16_t*)(buf + HW_PM + c * 144 + j * 2) = f2bf(j <= c ? pa[q][r] : 0.f); }
                asm volatile("s_waitcnt lgkmcnt(0)" ::: "memory");
            }
        }
#undef HW_OFF0
#undef HW_LD
#undef BF_LO
#undef BF_HI
    } else {
        f32x4 S[8][2];
#pragma unroll
        for (int t = 0; t < 8; ++t) { S[t][0] = (f32x4){0.f, 0.f, 0.f, 0.f}; S[t][1] = (f32x4){0.f, 0.f, 0.f, 0.f}; }
        HW_BAR(); HW_BAR(); HW_BAR();
#pragma unroll 1
        for (int n = 0; n < NC; ++n) {
            const int par = n & 1; const bool lat = n >= CTXL / 64;
            LAS unsigned char* buf = lds + par * HW_BUF;
            HW_BAR();
            bf16x8 vb[2][2];
#pragma unroll
            for (int nt = 0; nt < 2; ++nt)
#pragma unroll
                for (int s = 0; s < 2; ++s) vb[nt][s] = *(const LAS bf16x8*)(lds + HW_VT + (32 * w + 16 * nt + l15) * 144 + (32 * s + 8 * G4) * 2);
            HW_BAR();
            if (lat) {
                bf16x8 sb[2][4];
#pragma unroll
                for (int nt = 0; nt < 2; ++nt)
#pragma unroll
                    for (int s = 0; s < 4; ++s) sb[nt][s] = pack8(S[2 * s][nt], S[2 * s + 1][nt]);
#pragma unroll
                for (int mt = 0; mt < 4; ++mt) {
                    f32x4 oa[2] = {(f32x4){0.f, 0.f, 0.f, 0.f}, (f32x4){0.f, 0.f, 0.f, 0.f}};
#pragma unroll
                    for (int s = 0; s < 2; ++s) { const bf16x8 a = *(const LAS bf16x8*)(buf + HW_PM + (16 * mt + l15) * 144 + (32 * s + 8 * G4) * 2);
                        oa[0] = __builtin_amdgcn_mfma_f32_16x16x32_bf16(a, vb[0][s], oa[0], 0, 0, 0); oa[1] = __builtin_amdgcn_mfma_f32_16x16x32_bf16(a, vb[1][s], oa[1], 0, 0, 0); }
#pragma unroll
                    for (int s = 0; s < 4; ++s) { const bf16x8 a = *(const LAS bf16x8*)(buf + HW_QD + (16 * mt + l15) * 272 + (32 * s + 8 * G4) * 2);
                        oa[0] = __builtin_amdgcn_mfma_f32_16x16x32_bf16(a, sb[0][s], oa[0], 0, 0, 0); oa[1] = __builtin_amdgcn_mfma_f32_16x16x32_bf16(a, sb[1][s], oa[1], 0, 0, 0); }
#pragma unroll
                    for (int nt = 0; nt < 2; ++nt)
#pragma unroll
                        for (int r = 0; r < 4; ++r) *(LAS bf16_t*)(lds + HW_OS + (16 * mt + 4 * G4 + r) * 272 + (32 * w + 16 * nt + l15) * 2) = f2bf(oa[nt][r]);
                }
            }
#pragma unroll
            for (int t = 0; t < 8; ++t) {
                const f32x4 d4 = *(const LAS f32x4*)(lds + HW_DEC + par * 512 + (16 * t + 4 * G4) * 4);
                S[t][0] = S[t][0] * d4; S[t][1] = S[t][1] * d4;
#pragma unroll
                for (int s = 0; s < 2; ++s) { const bf16x8 a = *(const LAS bf16x8*)(buf + HW_KET + (16 * t + l15) * 144 + (32 * s + 8 * G4) * 2);
                    S[t][0] = __builtin_amdgcn_mfma_f32_16x16x32_bf16(a, vb[0][s], S[t][0], 0, 0, 0); S[t][1] = __builtin_amdgcn_mfma_f32_16x16x32_bf16(a, vb[1][s], S[t][1], 0, 0, 0); }
            }
            HW_BAR();
            if (lat) {
                const int j = tid >> 2, part = tid & 3, p = 64 * n + j, tt = dir ? T - 1 - (p - CTXL) : (p - CTXL);
                bf16_t* dst = OD + ((size_t)b * T + tt) * HGW + h * 128 + part * 32;
#pragma unroll
                for (int q = 0; q < 4; ++q) *(u32x4*)(dst + q * 8) = *(const LAS u32x4*)(lds + HW_OS + j * 272 + part * 64 + q * 16);
            }
        }
    }
    __syncthreads();
#undef HW_BAR
}

__device__ __forceinline__ size_t rg_row(int b, bool lat, int p) {
    return lat ? (size_t)b * T + (size_t)(p % GROWS) * GRIDW + (p / GROWS) : (size_t)NLAT + b * CTXL + p;
}
constexpr int RC_T = 64 * 144;
constexpr int RC_XC = 0, RC_RG = 2 * RC_T, RC_HI = 4 * RC_T, RC_OUT = 6 * RC_T;
__device__ __forceinline__ void phase_rg_chain(LAS unsigned char* lds, const bf16_t* __restrict__ P, const float* __restrict__ conv_w, const float* __restrict__ conv_b, const bf16_t* __restrict__ WG_t,
                                               const float* __restrict__ ba, const float* __restrict__ bx, const float* __restrict__ coef, bf16_t* __restrict__ HT, bf16_t* __restrict__ MIX, int item) {
    const int b = item >> 3, hd = item & 7;
    const int tid = threadIdx.x, w = __builtin_amdgcn_readfirstlane(tid >> 6), lane = tid & 63, l15 = lane & 15, G4 = lane >> 4;
    const int d = w >> 2, cg = w & 3, ch = 64 * hd + 16 * cg + l15;
    const int ds = tid >> 8, t8 = tid & 255, pg = t8 >> 4, cg4 = t8 & 15;
    bf16x8 F[4];
#pragma unroll
    for (int s = 0; s < 2; ++s) {
        F[s] = *(const bf16x8*)(WG_t + ((size_t)(hd * 256 + 64 * (2 * d) + 16 * cg + l15) * 64 + 32 * s + 8 * G4));
        F[2 + s] = *(const bf16x8*)(WG_t + ((size_t)(hd * 256 + 64 * (2 * d + 1) + 16 * cg + l15) * 64 + 32 * s + 8 * G4)); }
    const float bav = ba[d * RGW + ch], bxv = bx[d * RGW + ch], cf = coef[d * RGW + ch];
    const f32x4 cw0 = *(const f32x4*)(conv_w + 0 * RGW + 64 * hd + 4 * cg4), cw1 = *(const f32x4*)(conv_w + 1 * RGW + 64 * hd + 4 * cg4), cw2 = *(const f32x4*)(conv_w + 2 * RGW + 64 * hd + 4 * cg4),
                cw3 = *(const f32x4*)(conv_w + 3 * RGW + 64 * hd + 4 * cg4), cb4 = *(const f32x4*)(conv_b + 64 * hd + 4 * cg4);
    float hcar = 0.f;
#define RC_CHUNK(dd, s_) ((dd) == 0 ? (s_) : ((s_) < CTXL / 64 ? CTXL / 64 - 1 - (s_) : NCHK + CTXL / 64 - 1 - (s_)))
    u32x2 rxr[7]; u32x4 rgr[2], hir[2];
#define RC_LOAD_RX(s_) do { const int n_ = RC_CHUNK(ds, s_); const bool lat_ = n_ >= CTXL / 64; const int L_ = lat_ ? T : CTXL, p0_ = 64 * (lat_ ? n_ - CTXL / 64 : n_); \
        _Pragma("unroll") for (int i = 0; i < 7; ++i) { const int p = p0_ + 4 * pg - 2 + i; rxr[i] = (p >= 0 && p < L_) ? *(const u32x2*)(P + rg_row(b, lat_, p) * INW + C_RX + 64 * hd + 4 * cg4) : (u32x2){0u, 0u}; } } while (0)
#define RC_ROW(s_, q_) (rg_row(b, true, 64 * (RC_CHUNK(ds, s_) - CTXL / 64) + ((q_) >> 3)))
#define RC_LOAD_RG(s_) do { _Pragma("unroll") for (int j = 0; j < 2; ++j) { const int q = t8 * 2 + j; rgr[j] = *(const u32x4*)(P + RC_ROW(s_, q) * INW + C_RG + 64 * hd + (q & 7) * 8); } } while (0)
#define RC_LOAD_HI(s_) do { _Pragma("unroll") for (int j = 0; j < 2; ++j) { const int q = t8 * 2 + j; rgr[j] = rgr[j]; hir[j] = __builtin_nontemporal_load((const u32x4*)(HT + RC_ROW(s_, q) * RGW + 64 * hd + (q & 7) * 8)); } } while (0)
    RC_LOAD_RX(0);
#pragma unroll 1
    for (int s = 0; s < NCHK; ++s) {
        const int role = s < CTXL / 64 ? 0 : (s < 20 ? 1 : 2);
        if (s == 20) { asm volatile("s_waitcnt vmcnt(0)" ::: "memory"); __syncthreads(); RC_LOAD_RG(20); RC_LOAD_HI(20); }
        {
            float xin[7][4];
#pragma unroll
            for (int i = 0; i < 7; ++i) { xin[i][0] = __uint_as_float(rxr[i].x << 16); xin[i][1] = __uint_as_float(rxr[i].x & 0xffff0000u); xin[i][2] = __uint_as_float(rxr[i].y << 16); xin[i][3] = __uint_as_float(rxr[i].y & 0xffff0000u); }
#pragma unroll
            for (int q = 0; q < 4; ++q) {
                float o[4];
#pragma unroll
                for (int c = 0; c < 4; ++c) o[c] = cb4[c] + cw0[c] * xin[q][c] + cw1[c] * xin[q + 1][c] + cw2[c] * xin[q + 2][c] + cw3[c] * xin[q + 3][c];
                *(LAS unsigned long long*)(lds + RC_XC + ds * RC_T + (4 * pg + q) * 144 + cg4 * 8) = ((unsigned long long)cvt_pk_bf16(o[2], o[3]) << 32) | cvt_pk_bf16(o[0], o[1]);
            }
            if (role == 2) {
#pragma unroll
                for (int j = 0; j < 2; ++j) { const int q = t8 * 2 + j; *(LAS u32x4*)(lds + RC_RG + ds * RC_T + (q >> 3) * 144 + (q & 7) * 16) = rgr[j]; *(LAS u32x4*)(lds + RC_HI + ds * RC_T + (q >> 3) * 144 + (q & 7) * 16) = hir[j]; }
            }
        }
        __syncthreads();
        if (s + 1 < NCHK) { RC_LOAD_RX(s + 1); if (s + 1 > 20) { RC_LOAD_RG(s + 1); RC_LOAD_HI(s + 1); } }
        {
            bf16x8 af[4][2];
#pragma unroll
            for (int mt = 0; mt < 4; ++mt)
#pragma unroll
                for (int k = 0; k < 2; ++k) af[mt][k] = *(const LAS bf16x8*)(lds + RC_XC + d * RC_T + (16 * (l15 >> 2) + 4 * mt + (l15 & 3)) * 144 + (32 * k + 8 * G4) * 2);
            f32x4 ra[4], xa[4];
#pragma unroll
            for (int mt = 0; mt < 4; ++mt) { ra[mt] = (f32x4){0.f, 0.f, 0.f, 0.f}; xa[mt] = (f32x4){0.f, 0.f, 0.f, 0.f};
#pragma unroll
                for (int k = 0; k < 2; ++k) { ra[mt] = __builtin_amdgcn_mfma_f32_16x16x32_bf16(af[mt][k], F[k], ra[mt], 0, 0, 0); xa[mt] = __builtin_amdgcn_mfma_f32_16x16x32_bf16(af[mt][k], F[2 + k], xa[mt], 0, 0, 0); } }
            float av[16], bv[16];
#pragma unroll
            for (int t = 0; t < 16; ++t) {
                const float r = sigmoidf_(ra[t >> 2][t & 3] + bav), ig = sigmoidf_(xa[t >> 2][t & 3] + bxv);
                const float a = fexp(cf * r);
                av[t] = a; bv[t] = fsqrt(fmaxf(1.0f - a * a, 0.f)) * ig * bf2f(*(const LAS bf16_t*)(lds + RC_XC + d * RC_T + (16 * G4 + t) * 144 + (16 * cg + l15) * 2));
            }
            float Al = 1.f, Bl = 0.f;
            if (d == 0) {
#pragma unroll
                for (int t = 0; t < 16; ++t) { Bl = av[t] * Bl + bv[t]; Al *= av[t]; }
            } else {
#pragma unroll
                for (int t = 15; t >= 0; --t) { Bl = av[t] * Bl + bv[t]; Al *= av[t]; }
            }
            float Ag[4], Bg[4];
#pragma unroll
            for (int g = 0; g < 4; ++g) { Ag[g] = __shfl(Al, l15 + 16 * g); Bg[g] = __shfl(Bl, l15 + 16 * g); }
            float h = hcar, hend;
            if (d == 0) {
                const float s1 = Ag[0] * h + Bg[0], s2 = Ag[1] * s1 + Bg[1], s3 = Ag[2] * s2 + Bg[2]; hend = Ag[3] * s3 + Bg[3];
                h = G4 == 0 ? h : G4 == 1 ? s1 : G4 == 2 ? s2 : s3;
            } else {
                const float s2 = Ag[3] * h + Bg[3], s1 = Ag[2] * s2 + Bg[2], s0 = Ag[1] * s1 + Bg[1]; hend = Ag[0] * s0 + Bg[0];
                h = G4 == 3 ? h : G4 == 2 ? s2 : G4 == 1 ? s1 : s0;
            }
            hcar = hend;
            if (role != 0) {
                float hv[16];
                if (d == 0) {
#pragma unroll
                    for (int t = 0; t < 16; ++t) { h = av[t] * h + bv[t]; hv[t] = h; }
                } else {
#pragma unroll
                    for (int t = 15; t >= 0; --t) { h = av[t] * h + bv[t]; hv[t] = h; }
                }
#pragma unroll
                for (int t = 0; t < 16; ++t) {
                    const int off = (16 * G4 + t) * 144 + (16 * cg + l15) * 2;
                    float o = hv[t];
                    if (role == 2) o = gelu_tanh(bf2f(*(const LAS bf16_t*)(lds + RC_RG + d * RC_T + off))) * (o + bf2f(*(const LAS bf16_t*)(lds + RC_HI + d * RC_T + off)));
                    *(LAS bf16_t*)(lds + RC_OUT + d * RC_T + off) = f2bf(o);
                }
            }
        }
        __syncthreads();
        if (role != 0) {
#pragma unroll
            for (int j = 0; j < 2; ++j) { const int q = t8 * 2 + j; const u32x4 v = *(const LAS u32x4*)(lds + RC_OUT + ds * RC_T + (q >> 3) * 144 + (q & 7) * 16);
                if (role == 1) *(u32x4*)(HT + RC_ROW(s, q) * RGW + 64 * hd + (q & 7) * 8) = v;
                else *(u32x4*)(MIX + RC_ROW(s, q) * D + HGW + 64 * hd + (q & 7) * 8) = v; }
        }
    }
#undef RC_CHUNK
#undef RC_LOAD_RX
#undef RC_ROW
#undef RC_LOAD_RG
#undef RC_LOAD_HI
}

__device__ __forceinline__ void phase_mix_finish(const bf16_t* __restrict__ P, const bf16_t* __restrict__ OF, const bf16_t* __restrict__ OB,
                                                 const float* __restrict__ hg_nw, bf16_t* __restrict__ MIX, int bid, int G) {
    constexpr int RB = 4;
    const int lane = threadIdx.x & 63, gw = bid * 8 + (threadIdx.x >> 6), NW = G * 8, c0 = lane * 8;
    const f32x4 nw0 = *(const f32x4*)(hg_nw + c0), nw1 = *(const f32x4*)(hg_nw + c0 + 4);
    const float nwv[8] = {nw0[0], nw0[1], nw0[2], nw0[3], nw1[0], nw1[1], nw1[2], nw1[3]};
    for (int r0 = gw; r0 < NLAT; r0 += RB * NW) {
        u32x4 a4[RB], b4[RB], g4[RB];
#pragma unroll
        for (int q = 0; q < RB; ++q) { const int r = r0 + q * NW; const int rr = r < NLAT ? r : r0;
            a4[q] = *(const u32x4*)(OF + (size_t)rr * HGW + c0); b4[q] = *(const u32x4*)(OB + (size_t)rr * HGW + c0); g4[q] = *(const u32x4*)(P + (size_t)rr * INW + C_G + c0); }
#pragma unroll
        for (int q = 0; q < RB; ++q) { const int r = r0 + q * NW; if (r < NLAT) {
            float o[8]; float ss = 0.f;
#pragma unroll
            for (int i = 0; i < 4; ++i) { o[2 * i] = __uint_as_float(a4[q][i] << 16) + __uint_as_float(b4[q][i] << 16); o[2 * i + 1] = __uint_as_float(a4[q][i] & 0xffff0000u) + __uint_as_float(b4[q][i] & 0xffff0000u); }
#pragma unroll
            for (int i = 0; i < 8; ++i) ss += o[i] * o[i];
            ss += __shfl_xor(ss, 1); ss += __shfl_xor(ss, 2); ss += __shfl_xor(ss, 4); ss += __shfl_xor(ss, 8);
            const float rstd = __builtin_amdgcn_rsqf(ss * (1.0f / 128.0f) + EPS);
            u32x4 w;
#pragma unroll
            for (int i = 0; i < 4; ++i) {
                const float g0 = __uint_as_float(g4[q][i] << 16), g1 = __uint_as_float(g4[q][i] & 0xffff0000u);
                w[i] = cvt_pk_bf16(o[2 * i] * rstd * nwv[2 * i] * (g0 * sigmoidf_(g0)), o[2 * i + 1] * rstd * nwv[2 * i + 1] * (g1 * sigmoidf_(g1)));
            }
            *(u32x4*)(MIX + (size_t)r * D + c0) = w;
        } }
    }
}

__device__ __forceinline__ void phase_norm2_route(LAS unsigned char* lds, const bf16_t* __restrict__ x1, const float* __restrict__ nw, const float* __restrict__ mod,
                                                  const float* __restrict__ rw, const float* __restrict__ rb, fp8_t* __restrict__ H2,
                                                  u32* __restrict__ cnt, u32* __restrict__ toktab, float* __restrict__ wtab, int bid, int G) {
    LAS float* rwT = (LAS float*)lds;
    LAS u32* hist = (LAS u32*)(lds + 131072);
    LAS u32* ent = (LAS u32*)(lds + 131072 + 4096);
    const int tid = threadIdx.x, lane = tid & 63, w = tid >> 6;
    for (int i = tid; i < 32 * 1024; i += 512) { const int k = i >> 5, e = i & 31; rwT[e * 1024 + k] = rw[i]; }
    if (tid < 128) hist[tid] = 0;
    __syncthreads();
    const int gw = bid * 8 + w, NW = G * 8;
    const int myexp = ((lane >> 5) & 1) * 16 + ((lane >> 4) & 1) * 8 + ((lane >> 3) & 1) * 4 + ((lane >> 2) & 1) * 2 + ((lane >> 1) & 1);
    const float myrb = rb[myexp];
    int it = 0;
    u32x2 rawn[2][4];
#pragma unroll
    for (int q = 0; q < 2; ++q)
#pragma unroll
        for (int j = 0; j < 4; ++j) rawn[q][j] = __builtin_nontemporal_load((const u32x2*)(x1 + (size_t)(gw + q * NW) * D + j * 256 + lane * 4));
    for (int r0 = gw; r0 < NLAT; r0 += 2 * NW, it += 2) {
        f32x4 v[2][4];
        u32x2 rawc[2][4];
#pragma unroll
        for (int q = 0; q < 2; ++q)
#pragma unroll
            for (int j = 0; j < 4; ++j) rawc[q][j] = rawn[q][j];
        { const int rn0 = r0 + 2 * NW < NLAT ? r0 + 2 * NW : r0;
#pragma unroll
          for (int q = 0; q < 2; ++q)
#pragma unroll
            for (int j = 0; j < 4; ++j) rawn[q][j] = __builtin_nontemporal_load((const u32x2*)(x1 + (size_t)(rn0 + q * NW) * D + j * 256 + lane * 4)); }
#pragma unroll
        for (int q = 0; q < 2; ++q) {
            const int r = r0 + q * NW;
            const float* m = mod + (size_t)(r >> 11) * 6144;
            u32x2 raw[4];
#pragma unroll
            for (int j = 0; j < 4; ++j) raw[j] = rawc[q][j];
            float ss = 0.f;
#pragma unroll
            for (int j = 0; j < 4; ++j) { v[q][j][0] = __uint_as_float(raw[j].x << 16); v[q][j][1] = __uint_as_float(raw[j].x & 0xffff0000u); v[q][j][2] = __uint_as_float(raw[j].y << 16); v[q][j][3] = __uint_as_float(raw[j].y & 0xffff0000u);
                ss += v[q][j][0] * v[q][j][0] + v[q][j][1] * v[q][j][1] + v[q][j][2] * v[q][j][2] + v[q][j][3] * v[q][j][3]; }
            const float rstd = __builtin_amdgcn_rsqf(wave_sum(ss) * (1.0f / D) + EPS);
#pragma unroll
            for (int j = 0; j < 4; ++j) {
                const int c0 = j * 256 + lane * 4;
                const f32x4 ww = *(const f32x4*)(nw + c0), sh = *(const f32x4*)(m + 3072 + c0), sc = *(const f32x4*)(m + 4096 + c0);
                v[q][j] = v[q][j] * rstd * ww * (sc + 1.0f) + sh;
                *(unsigned*)(H2 + (size_t)r * D + c0) = pk4_fp8(v[q][j][0] * SC_H2, v[q][j][1] * SC_H2, v[q][j][2] * SC_H2, v[q][j][3] * SC_H2);
            }
        }
        float part[2][32];
#pragma unroll
        for (int e = 0; e < 32; ++e) {
            float p0 = 0.f, p1 = 0.f;
#pragma unroll
            for (int j = 0; j < 4; ++j) { const f32x4 q = *(const LAS f32x4*)(rwT + e * 1024 + j * 256 + lane * 4);
                p0 += v[0][j][0] * q[0] + v[0][j][1] * q[1] + v[0][j][2] * q[2] + v[0][j][3] * q[3]; p1 += v[1][j][0] * q[0] + v[1][j][1] * q[1] + v[1][j][2] * q[2] + v[1][j][3] * q[3]; }
            part[0][e] = p0; part[1][e] = p1;
        }
#define RT_STEP(N, M) { const bool up = (lane & (M)) != 0; _Pragma("unroll") for (int q = 0; q < 2; ++q) _Pragma("unroll") for (int i = 0; i < (N); ++i) { const float keep = up ? part[q][(N) + i] : part[q][i], send = up ? part[q][i] : part[q][(N) + i]; part[q][i] = keep + __shfl_xor(send, (M)); } }
        RT_STEP(16, 32) RT_STEP(8, 16) RT_STEP(4, 8) RT_STEP(2, 4) RT_STEP(1, 2)
#undef RT_STEP
#pragma unroll
        for (int q = 0; q < 2; ++q) {
            const int r = r0 + q * NW;
            const float mylogit = part[q][0] + __shfl_xor(part[q][0], 1) + myrb;
            int rank = 0;
#pragma unroll
            for (int x = 0; x < 32; ++x) {
                const int src = ((x >> 4) & 1) * 32 + ((x >> 3) & 1) * 16 + ((x >> 2) & 1) * 8 + ((x >> 1) & 1) * 4 + (x & 1) * 2;
                const float oq = __builtin_bit_cast(float, __builtin_amdgcn_readlane(__builtin_bit_cast(int, mylogit), src));
                rank += (oq > mylogit || (oq == mylogit && x < myexp)) ? 1 : 0;
            }
            float tv[4]; int ti[4];
#pragma unroll
            for (int k = 0; k < 4; ++k) {
                const unsigned long long mk = __ballot(rank == k && (lane & 1) == 0);
                const int src = __builtin_amdgcn_readfirstlane((int)__builtin_ctzll(mk));
                tv[k] = __builtin_bit_cast(float, __builtin_amdgcn_readlane(__builtin_bit_cast(int, mylogit), src));
                ti[k] = ((src >> 5) & 1) * 16 + ((src >> 4) & 1) * 8 + ((src >> 3) & 1) * 4 + ((src >> 2) & 1) * 2 + ((src >> 1) & 1);
            }
            const float e1 = fexp(tv[1] - tv[0]), e2 = fexp(tv[2] - tv[0]), e3 = fexp(tv[3] - tv[0]); const float inv = frcp(1.0f + e1 + e2 + e3);
            const float g0 = inv, g1 = e1 * inv, g2 = e2 * inv, g3 = e3 * inv;
            if (lane < 4) {
                const int half = r >= HALF_TOK ? 1 : 0;
                const int e = lane == 0 ? ti[0] : lane == 1 ? ti[1] : lane == 2 ? ti[2] : ti[3];
                const float gv = lane == 0 ? g0 : lane == 1 ? g1 : lane == 2 ? g2 : g3;
                const u32 lp = atomicAdd((u32*)&hist[half * 32 + e], 1u);
                const int idx = ((it + q) * 8 + w) * 4 + lane;
                ent[idx * 2] = ((u32)e << 24) | lp; ent[idx * 2 + 1] = __float_as_uint(gv);
            }
        }
    }
    __syncthreads();
    if (tid < 64) hist[64 + tid] = atomicAdd(&cnt[tid], hist[tid]);
    __syncthreads();
    it = 0;
    for (int r = gw; r < NLAT; r += NW, ++it) {
        if (lane < 4) {
            const int half = r >= HALF_TOK ? 1 : 0; const int idx = (it * 8 + w) * 4 + lane;
            const u32 ev = ent[idx * 2]; const int e = ev >> 24; const u32 pos = hist[64 + half * 32 + e] + (ev & 0xffffffu);
            toktab[((size_t)half * 32 + e) * CAP + pos] = (u32)r * 4u + lane;
            wtab[((size_t)half * 32 + e) * CAP + pos] = __uint_as_float(ent[idx * 2 + 1]);
        }
    }
}

__device__ __forceinline__ void phase_combine(float* __restrict__ out, const bf16_t* __restrict__ X1, const fp8_t* __restrict__ Y, const float* __restrict__ mod, const float* __restrict__ fw, int bid, int G) {
    constexpr int RB = 2;
    typedef float f32x2_ __attribute__((ext_vector_type(2)));
    const int lane = threadIdx.x & 63, gw = bid * 8 + (threadIdx.x >> 6), NW = G * 8;
    for (int r0 = gw; r0 < NLAT; r0 += RB * NW) {
        u32x2 xv[RB][4]; unsigned yv[RB][4][4];
#pragma unroll
        for (int q = 0; q < RB; ++q) { const int r = r0 + q * NW < NLAT ? r0 + q * NW : r0;
#pragma unroll
            for (int j = 0; j < 4; ++j) { xv[q][j] = __builtin_nontemporal_load((const u32x2*)(X1 + (size_t)r * D + j * 256 + lane * 4));
#pragma unroll
                for (int k = 0; k < 4; ++k) yv[q][j][k] = __builtin_nontemporal_load((const unsigned*)(Y + ((size_t)r * 4 + k) * D + j * 256 + lane * 4)); } }
#pragma unroll
        for (int q = 0; q < RB; ++q) { const int r = r0 + q * NW; if (r < NLAT) {
            const float* g2 = mod + (size_t)(r >> 11) * 6144 + 5120;
            f32x4 v[4]; float ss = 0.f;
#pragma unroll
            for (int j = 0; j < 4; ++j) { const int c0 = j * 256 + lane * 4;
                f32x4 sm = (f32x4){0.f, 0.f, 0.f, 0.f};
#pragma unroll
                for (int k = 0; k < 4; ++k) { const f32x2_ lo = __builtin_amdgcn_cvt_pk_f32_fp8(yv[q][j][k], false), hi = __builtin_amdgcn_cvt_pk_f32_fp8(yv[q][j][k], true); sm[0] += lo[0]; sm[1] += lo[1]; sm[2] += hi[0]; sm[3] += hi[1]; }
                const f32x4 g = *(const f32x4*)(g2 + c0);
                v[j][0] = __uint_as_float(xv[q][j].x << 16); v[j][1] = __uint_as_float(xv[q][j].x & 0xffff0000u); v[j][2] = __uint_as_float(xv[q][j].y << 16); v[j][3] = __uint_as_float(xv[q][j].y & 0xffff0000u);
                v[j] = v[j] + g * sm * (1.0f / SC_Y);
                ss += v[j][0] * v[j][0] + v[j][1] * v[j][1] + v[j][2] * v[j][2] + v[j][3] * v[j][3]; }
            const float rstd = __builtin_amdgcn_rsqf(wave_sum(ss) * (1.0f / D) + EPS);
#pragma unroll
            for (int j = 0; j < 4; ++j) { const int c0 = j * 256 + lane * 4; const f32x4 w = *(const f32x4*)(fw + c0); __builtin_nontemporal_store(v[j] * rstd * w, (f32x4*)(out + (size_t)r * D + c0)); }
        } }
    }
}

#define XB_TMO      128
#define XB_XCNT(j)  (256  + 64 * (j))
#define XB_XSUB(j)  (1280 + 64 * (j))
#define XB_XGEN(j)  (2304 + 64 * (j))
#define XB_TOP      3328
#define XB_TOPGEN   3392
#define XCD_BAR_WORDS 3456
#define XB_SPIN_CAP (1u << 20)
__device__ __forceinline__ unsigned xb_ld(unsigned* p)              { return __hip_atomic_load(p, __ATOMIC_RELAXED, __HIP_MEMORY_SCOPE_AGENT); }
__device__ __forceinline__ unsigned xb_add(unsigned* p, unsigned v) { return __hip_atomic_fetch_add(p, v, __ATOMIC_RELAXED, __HIP_MEMORY_SCOPE_AGENT); }
__device__ __forceinline__ unsigned xb_xcc_id() { return (unsigned)__builtin_amdgcn_s_getreg((3 << 11) | 20) & 0xFu; }
#define XB_SPIN(cond, bar) do { unsigned _sp = 0; while (cond) { __builtin_amdgcn_s_sleep(1); \
    if ((++_sp & 255u) == 0u) { if (xb_ld(&(bar)[XB_TMO])) break; if (_sp > XB_SPIN_CAP) { atomicAdd(&(bar)[XB_TMO], 1u); break; } } } } while (0)
struct XcdBarrier { unsigned* bar; unsigned x; volatile LAS unsigned* st; };
__device__ __forceinline__ XcdBarrier xcd_barrier_post(unsigned* bar, volatile LAS unsigned* st) {
    XcdBarrier b; b.bar = bar; b.x = xb_xcc_id(); b.st = st;
    if (threadIdx.x == 0) (void)xb_add(&bar[XB_XCNT(b.x)], 1u);
    return b;
}
__device__ __forceinline__ void xcd_barrier_complete(unsigned* bar, unsigned x, unsigned& nloc, unsigned& nx) {
    const unsigned G = gridDim.x * gridDim.y * gridDim.z;
    unsigned sum, cnt, mine, sp = 0u;
    for (;;) {
        sum = 0u; cnt = 0u; mine = 0u;
#pragma unroll
        for (unsigned j = 0; j < 16; ++j) { const unsigned c = xb_ld(&bar[XB_XCNT(j)]); sum += c; cnt += (c > 0u) ? 1u : 0u; mine = (j == x) ? c : mine; }
        if (sum == G) break;
        __builtin_amdgcn_s_sleep(1);
        if ((++sp & 255u) == 0u) { if (xb_ld(&bar[XB_TMO])) break; if (sp > XB_SPIN_CAP) { atomicAdd(&bar[XB_TMO], 1u); break; } }
    }
    nloc = mine > 0u ? mine : 1u; nx = cnt > 0u ? cnt : 1u;
}
__device__ __forceinline__ void xcd_barrier(unsigned* bar, volatile LAS unsigned* st) {
    asm volatile("s_waitcnt vmcnt(0)" ::: "memory");
    __syncthreads();
    if (threadIdx.x == 0) {
        __builtin_amdgcn_s_waitcnt(0);
        const unsigned x = xb_xcc_id();
        unsigned nloc = st[0], nx = st[1];
        if (nloc == 0u) { xcd_barrier_complete(bar, x, nloc, nx); st[0] = nloc; st[1] = nx; }
        const unsigned old = xb_add(&bar[XB_XSUB(x)], 1u);
        const unsigned gen = old / nloc;
        if (old + 1u == (gen + 1u) * nloc) {
            __builtin_amdgcn_fence(__ATOMIC_RELEASE, "agent");
            asm volatile("s_waitcnt vmcnt(0)" ::: "memory");
            const unsigned og = xb_add(&bar[XB_TOP], 1u);
            const unsigned tg = og / nx;
            if (og + 1u == (tg + 1u) * nx) xb_add(&bar[XB_TOPGEN], 1u);
            else XB_SPIN(xb_ld(&bar[XB_TOPGEN]) == tg, bar);
            __builtin_amdgcn_fence(__ATOMIC_ACQUIRE, "agent");
            xb_add(&bar[XB_XGEN(x)], 1u);
            asm volatile("s_waitcnt vmcnt(0)" ::: "memory");
        } else {
            XB_SPIN(xb_ld(&bar[XB_XGEN(x)]) == gen, bar);
            __builtin_amdgcn_fence(__ATOMIC_ACQUIRE, "agent");
            asm volatile("s_waitcnt vmcnt(0)" ::: "memory");
        }
    }
    __syncthreads();
}
constexpr size_t WS_BAR = 16384;
constexpr int LDS_BARST = LDS_BYTES - 16;

struct MegaArgs {
    const float *x, *c, *ctx, *c_ctx, *norm1_w, *norm2_w, *w_ada, *b_ada, *w_in, *lbl, *hg_nw, *conv_w, *conv_b, *rg_wa, *rg_ba, *rg_wx, *rg_bx, *rg_lam, *w_out,
        *router_w, *router_b, *wgu, *bgu, *wd, *bd, *final_w;
    float* out; unsigned char* ws;
};
typedef const MegaArgs __attribute__((address_space(4)))* KArgs;
__device__ __forceinline__ KArgs kargs() { auto p = __builtin_amdgcn_kernarg_segment_ptr(); asm volatile("" : "+s"(p)); return (KArgs)p; }
#define WSP(T, off) ((T*)(ws + (off)))
#define GRID_SYNC_CG() cg::this_grid().sync()
#define GRID_SYNC() do { KArgs a_ = kargs(); xcd_barrier((unsigned*)(a_->ws + WS_BAR), (volatile LAS unsigned*)(lds + LDS_BARST)); } while (0)
__global__ __launch_bounds__(512, 2) void k_mega(MegaArgs a_unused) {
    extern __shared__ __attribute__((aligned(16))) unsigned char lds_[];
    LAS unsigned char* lds = (LAS unsigned char*)lds_;
    if (threadIdx.x < 4) ((volatile LAS unsigned*)(lds + LDS_BARST))[threadIdx.x] = 0u;
    __syncthreads();
    { KArgs a = kargs(); (void)xcd_barrier_post((unsigned*)(a->ws + WS_BAR), (volatile LAS unsigned*)(lds + LDS_BARST)); }
    { KArgs a = kargs(); unsigned char* ws = a->ws; const int bid = blockIdx.x, G = gridDim.x;
      ProArgs pa; pa.c = a->c; pa.c_ctx = a->c_ctx; pa.w_ada = a->w_ada; pa.b_ada = a->b_ada; pa.lbl = a->lbl; pa.w_in = a->w_in; pa.w_out = a->w_out; pa.wgu = a->wgu; pa.wd = a->wd; pa.rg_wa = a->rg_wa; pa.rg_wx = a->rg_wx; pa.rg_lam = a->rg_lam;
      pa.coef = WSP(float, WS_COEF); pa.WG_t = WSP(bf16_t, WS_WG); pa.mod = WSP(float, WS_MOD); pa.lb = WSP(float, WS_LB); pa.Win_t = WSP(bf16_t, WS_WIN); pa.Wout_t = WSP(bf16_t, WS_WOUT); pa.Wgu_t = WSP(fp8_t, WS_WGU); pa.Wd_t = WSP(fp8_t, WS_WD);
      phase_prologue(lds, pa, bid, G, true, 0, 0); }
    { KArgs a_ = kargs(); if (a_->ws == nullptr) GRID_SYNC_CG(); }
    GRID_SYNC();
    { KArgs a = kargs(); unsigned char* ws = a->ws; phase_norm1(a->x, a->ctx, a->norm1_w, WSP(float, WS_MOD), WSP(bf16_t, WS_H), blockIdx.x, gridDim.x); }
    { KArgs a = kargs(); unsigned char* ws = a->ws;
      ProArgs pa; pa.c = nullptr; pa.c_ctx = nullptr; pa.w_ada = nullptr; pa.b_ada = nullptr; pa.lbl = nullptr; pa.w_in = a->w_in; pa.w_out = a->w_out; pa.wgu = nullptr; pa.wd = nullptr; pa.rg_wa = nullptr; pa.rg_wx = nullptr; pa.rg_lam = nullptr; pa.coef = nullptr; pa.WG_t = nullptr;
      pa.mod = nullptr; pa.lb = nullptr; pa.Win_t = WSP(bf16_t, WS_WIN); pa.Wout_t = WSP(bf16_t, WS_WOUT); pa.Wgu_t = nullptr; pa.Wd_t = nullptr;
      phase_prologue(lds, pa, blockIdx.x, gridDim.x, false, 0, IT_IN + IT_OUT); }
    GRID_SYNC();
    { KArgs a = kargs(); unsigned char* ws = a->ws; PolInProj P; P.A = WSP(bf16_t, WS_H); P.Bt = WSP(bf16_t, WS_WIN); P.O = WSP(bf16_t, WS_PROJ); P.ord.init(NLAT / BM, INW / BM, gridDim.x, blockIdx.x); gemm_phase(lds, P); }
    GRID_SYNC();
    { KArgs a = kargs(); unsigned char* ws = a->ws;
      for (int item = blockIdx.x; item < 256; item += gridDim.x)
          phase_rg_chain(lds, WSP(bf16_t, WS_PROJ), a->conv_w, a->conv_b, WSP(bf16_t, WS_WG), a->rg_ba, a->rg_bx, WSP(float, WS_COEF), WSP(bf16_t, WS_HF), WSP(bf16_t, WS_MIX2), item); }
    __syncthreads();
    { KArgs a = kargs(); unsigned char* ws = a->ws;
      for (int item = blockIdx.x; item < 256; item += gridDim.x) phase_hgrn2_ws(lds, WSP(bf16_t, WS_PROJ), WSP(float, WS_LB), WSP(bf16_t, WS_OF), WSP(bf16_t, WS_OB), item); }
    GRID_SYNC();
    { KArgs a = kargs(); unsigned char* ws = a->ws; phase_mix_finish(WSP(bf16_t, WS_PROJ), WSP(bf16_t, WS_OF), WSP(bf16_t, WS_OB), a->hg_nw, WSP(bf16_t, WS_MIX2), blockIdx.x, gridDim.x); }
    GRID_SYNC();
    { KArgs a = kargs(); unsigned char* ws = a->ws; PolOutProj P; P.A = WSP(bf16_t, WS_MIX2); P.Bt = WSP(bf16_t, WS_WOUT); P.x = a->x; P.mod = WSP(float, WS_MOD); P.O = WSP(bf16_t, WS_X1); P.ord.init(NLAT / BM, D / BM, gridDim.x, blockIdx.x); gemm_phase(lds, P); }
    GRID_SYNC();
    { KArgs a = kargs(); unsigned char* ws = a->ws;
      phase_norm2_route(lds, WSP(bf16_t, WS_X1), a->norm2_w, WSP(float, WS_MOD), a->router_w, a->router_b, WSP(fp8_t, WS_H2), WSP(u32, WS_CTL), WSP(u32, WS_TOKTAB), WSP(float, WS_WTAB), blockIdx.x, gridDim.x); }
    __syncthreads();
    { KArgs a = kargs(); unsigned char* ws = a->ws;
      ProArgs pa; pa.c = nullptr; pa.c_ctx = nullptr; pa.w_ada = nullptr; pa.b_ada = nullptr; pa.lbl = nullptr; pa.w_in = nullptr; pa.w_out = nullptr; pa.wgu = a->wgu; pa.wd = a->wd; pa.rg_wa = nullptr; pa.rg_wx = nullptr; pa.rg_lam = nullptr; pa.coef = nullptr; pa.WG_t = nullptr;
      pa.mod = nullptr; pa.lb = nullptr; pa.Win_t = nullptr; pa.Wout_t = nullptr; pa.Wgu_t = WSP(fp8_t, WS_WGU); pa.Wd_t = WSP(fp8_t, WS_WD);
      phase_prologue(lds, pa, blockIdx.x, gridDim.x, false, IT_IN + IT_OUT, IT_ALL); }
    GRID_SYNC();
#pragma unroll 1
    for (int half = 0; half < NHALF; ++half) {
        { KArgs a = kargs(); unsigned char* ws = a->ws; LAS int* tstart = (LAS int*)(lds + LDS_AUX);
          const int tot = moe_tile_table(tstart, WSP(u32, WS_CTL), half);
          PolGateUp P; P.A = WSP(fp8_t, WS_H2); P.Bt = WSP(fp8_t, WS_WGU); P.bgu = a->bgu; P.toktab = WSP(u32, WS_TOKTAB); P.wtab = WSP(float, WS_WTAB); P.O = WSP(fp8_t, WS_ACT); P.mt.tstart = tstart; P.mt.cnt = WSP(u32, WS_CTL); P.mt.half = half;
          P.ord.init(tot, DFF / HALFT, gridDim.x, blockIdx.x);
          gemm_phase(lds, P); }
        GRID_SYNC();
        { KArgs a = kargs(); unsigned char* ws = a->ws; LAS int* tstart = (LAS int*)(lds + LDS_AUX);
          const int tot = moe_tile_table(tstart, WSP(u32, WS_CTL), half);
          {
              const u32x4* wp = (const u32x4*)WSP(fp8_t, WS_WD) + (size_t)blockIdx.x * 8192 + threadIdx.x; u32x4 acc_ = (u32x4){0u, 0u, 0u, 0u};
#pragma unroll
              for (int i = 0; i < 16; ++i) acc_ |= wp[i * 512];
              asm volatile("" :: "v"(acc_));
          }
          PolDown P; P.A = WSP(fp8_t, WS_ACT); P.Bt = WSP(fp8_t, WS_WD); P.bd = a->bd; P.toktab = WSP(u32, WS_TOKTAB); P.wtab = WSP(float, WS_WTAB); P.O = WSP(fp8_t, WS_Y); P.mt.tstart = tstart; P.mt.cnt = WSP(u32, WS_CTL); P.mt.half = half;
          P.ord.init(tot, D / BM, gridDim.x, blockIdx.x);
          gemm_phase(lds, P); }
        GRID_SYNC();
        { KArgs a = kargs(); unsigned char* ws = a->ws; phase_combine(a->out, WSP(bf16_t, WS_X1), WSP(fp8_t, WS_Y), WSP(float, WS_MOD), a->final_w, blockIdx.x, gridDim.x); }
        __syncthreads();
    }
}

extern "C" void kernel_launch(void* const* d_in, const int* in_sizes, int n_in, void* d_out, int out_size, void* d_ws, size_t ws_size, hipStream_t stream) {
    static int grid_blocks = 0;
    if (!grid_blocks) {
        int dev = 0, cus = 0, per_cu = 0;
        (void)hipGetDevice(&dev);
        (void)hipDeviceGetAttribute(&cus, hipDeviceAttributeMultiprocessorCount, dev);
        (void)hipFuncSetAttribute((const void*)k_mega, hipFuncAttributeMaxDynamicSharedMemorySize, LDS_BYTES);
        (void)hipOccupancyMaxActiveBlocksPerMultiprocessor(&per_cu, (const void*)k_mega, 512, LDS_BYTES);
        if (per_cu < 1) { fprintf(stderr, "kernel_launch: occupancy query says %d blocks/CU\n", per_cu); per_cu = 1; }
        grid_blocks = cus * 1;
    }
    if (ws_size < 1024 * MiB) { fprintf(stderr, "kernel_launch: workspace too small (%zu)\n", ws_size); return; }
    MegaArgs a{};
    const float** ap = (const float**)&a;
    for (int i = 0; i < 26; ++i) ap[i] = (const float*)d_in[i];
    a.out = (float*)d_out; a.ws = (unsigned char*)d_ws;
    (void)hipMemsetAsync((unsigned char*)d_ws + WS_CTL, 0, 32768, stream);
    void* args[] = {&a};
    hipError_t e = hipLaunchCooperativeKernel((const void*)k_mega, dim3(grid_blocks), dim3(512), args, LDS_BYTES, stream);
    if (e != hipSuccess) fprintf(stderr, "cooperative launch failed: %s (grid %d)\n", hipGetErrorString(e), grid_blocks);
}
```

```cpp
#include <hip/hip_runtime.h>
#include <hip/hip_cooperative_groups.h>
#include <cstdio>
#include <cstdint>

typedef unsigned short bf16_t;
typedef unsigned int u32;
namespace cg = cooperative_groups;

constexpr int D = 1024, NB = 32, T = 2048, CTXL = 256, GRIDW = 64, GROWS = T / GRIDW;
constexpr int NLAT = NB * T;
constexpr int NCTX = NB * CTXL;
constexpr int NROWS = NLAT + NCTX;
constexpr int HGW = 512, RGW = 512, INW = 3584;
constexpr int C_Q = 0, C_I = 512, C_FF = 1024, C_FB = 1536, C_G = 2048, C_RX = 2560, C_RG = 3072;
constexpr int NE = 32, TOPK = 4, DFF = 1024;
constexpr int NCHK = (CTXL + T) / 64;
constexpr int NHALF = 1;
constexpr int HALF_TOK = NLAT / NHALF;
constexpr int CAP = HALF_TOK;
constexpr int MAXSLOT = HALF_TOK * TOPK + NE * 256;
constexpr float EPS = 1e-6f;

constexpr size_t MiB = 1u << 20;
constexpr size_t WS_CTL = 0;
constexpr size_t WS_WG = 64 * 1024;
constexpr size_t WS_MOD = 1 * MiB;
constexpr size_t WS_LB = WS_MOD + 33 * 6144 * 4;
constexpr size_t WS_COEF = WS_LB + 4096;
constexpr size_t WS_TOKTAB = 2 * MiB;
constexpr size_t WS_WTAB = 10 * MiB;
constexpr size_t WS_WIN = 18 * MiB, WS_WOUT = 25 * MiB;
constexpr size_t WS_OF = 28 * MiB, WS_OB = 92 * MiB;
constexpr size_t WS_HF = 156 * MiB;
constexpr size_t WS_H = 284 * MiB;
constexpr size_t WS_MIX2 = WS_H;
constexpr size_t WS_PROJ = 428 * MiB;
constexpr size_t WS_H2 = 28 * MiB;
constexpr size_t WS_WGU = 92 * MiB, WS_WD = 156 * MiB;
constexpr size_t WS_ACT = 188 * MiB;
constexpr size_t WS_Y = 452 * MiB;
constexpr size_t WS_X1 = 708 * MiB;
constexpr float SC_Y = 16.0f;

__device__ __forceinline__ float bf2f(bf16_t b) { return __uint_as_float(((u32)b) << 16); }
__device__ __forceinline__ bf16_t f2bf(float f) { u32 u = __float_as_uint(f); u += 0x7fffu + ((u >> 16) & 1u); return (bf16_t)(u >> 16); }
__device__ __forceinline__ u32 pk2(float lo, float hi) { return (u32)f2bf(lo) | ((u32)f2bf(hi) << 16); }
__device__ __forceinline__ float fexp(float x) { return __builtin_amdgcn_exp2f(x * 1.4426950408889634f); }
__device__ __forceinline__ float frcp(float x) { return __builtin_amdgcn_rcpf(x); }
__device__ __forceinline__ float flog(float x) { return __builtin_amdgcn_logf(x) * 0.6931471805599453f; }
__device__ __forceinline__ float fsqrt(float x) { return __builtin_amdgcn_sqrtf(x); }
__device__ __forceinline__ float sigmoidf_(float x) { return frcp(1.0f + fexp(-x)); }
__device__ __forceinline__ float wave_sum(float v) {
#pragma unroll
    for (int o = 1; o < 64; o <<= 1) v += __shfl_xor(v, o);
    return v;
}

__device__ __forceinline__ float gelu_tanh(float x) { const float u = 1.5957691216057308f * (x + 0.044715f * x * x * x); return x * sigmoidf_(u); }
#define LAS __attribute__((address_space(3)))
typedef short bf16x8 __attribute__((ext_vector_type(8)));
typedef float f32x4 __attribute__((ext_vector_type(4)));
typedef unsigned u32x4 __attribute__((ext_vector_type(4)));
typedef int v8i __attribute__((ext_vector_type(8)));
typedef int v4i_ __attribute__((ext_vector_type(4)));
typedef unsigned u32x2 __attribute__((ext_vector_type(2)));
typedef float f32x2 __attribute__((ext_vector_type(2)));
typedef unsigned char fp8_t;
constexpr float SC_H2 = 16.0f, SC_W = 32.0f, SC_ACT = 4.0f;
__device__ __forceinline__ unsigned pk4_fp8(float a, float b, float c, float d) {
    a = fminf(fmaxf(a, -448.f), 448.f); b = fminf(fmaxf(b, -448.f), 448.f); c = fminf(fmaxf(c, -448.f), 448.f); d = fminf(fmaxf(d, -448.f), 448.f);
    int r = 0; r = __builtin_amdgcn_cvt_pk_fp8_f32(a, b, r, false); r = __builtin_amdgcn_cvt_pk_fp8_f32(c, d, r, true); return (unsigned)r; }
__device__ __forceinline__ unsigned pk4_fp8_nc(float a, float b, float c, float d) { int r = 0; r = __builtin_amdgcn_cvt_pk_fp8_f32(a, b, r, false); r = __builtin_amdgcn_cvt_pk_fp8_f32(c, d, r, true); return (unsigned)r; }
constexpr int BM = 256, BK = 64, HALFT = 128, HTB = HALFT * BK * 2, STAGE_BYTES = 8 * HTB, NXCD = 8, WGM = 8;
constexpr int GK = 1024;
constexpr int LDS_BYTES = 147456;
constexpr int LDS_AUX = STAGE_BYTES;

__device__ __forceinline__ int lds_byte(int r, int c) { const int st = (r >> 4) * 2 + (c >> 5), rr = r & 15, cc = c & 31, ob = rr * 64 + cc * 2; return st * 1024 + (ob ^ (((ob >> 9) & 1) << 5)); }
__device__ __forceinline__ void stage_rc(int b, int& R, int& C) { const int st = b / 1024, sb = b % 1024, swz = sb ^ (((sb >> 9) & 1) << 5); R = (st >> 1) * 16 + swz / 64; C = (st & 1) * 32 + (swz % 64) / 2; }
__device__ __forceinline__ int perm32(int rho) { const int n = rho >> 4, i = rho & 15; return 8 * (i >> 2) + 4 * n + (i & 3); }
__device__ __forceinline__ unsigned cvt_pk_bf16(float lo, float hi) { unsigned r; asm volatile("v_cvt_pk_bf16_f32 %0, %1, %2" : "=v"(r) : "v"(lo), "v"(hi)); return r; }

struct Unit { int pm, pn, e, pos0, cn; };
struct TileOrder {
    int nM, nN, nwg, G, c;
    __device__ __forceinline__ void init(int nM_, int nN_, int G_, int c_) { nM = nM_; nN = nN_; nwg = nM * nN; G = G_; c = c_; }
    __device__ __forceinline__ bool tile(int i, int& pm, int& pn) const {
        const long L = (long)i * G + c; if (L >= nwg) return false;
        int wgid = (int)L; { const int q = nwg / NXCD, r = nwg % NXCD, xcd = wgid % NXCD, off = wgid / NXCD; wgid = (xcd < r ? xcd * (q + 1) : r * (q + 1) + (xcd - r) * q) + off; }
        const int nig = WGM * nN, gid = wgid / nig, fm = gid * WGM, gsz = (nM - fm) < WGM ? (nM - fm) : WGM;
        pm = fm + ((wgid % nig) % gsz); pn = (wgid % nig) / gsz; return true;
    }
};

template <class POL>
__device__ __forceinline__ void gemm_phase(LAS unsigned char* lds, const POL& P) {
    int tid_ = threadIdx.x; asm volatile("" : "+v"(tid_));
    const int tid = tid_, wid = __builtin_amdgcn_readfirstlane(tid >> 6), lane = tid & 63, wr = wid >> 2, wc = wid & 3, fr = lane & 15, fq = lane >> 4;
    constexpr int KB = POL::FP8 ? 1024 : 2048, nt = KB / 128;
    int sR[2], sC[2]; unsigned voffA[2], voffB[2];
#pragma unroll
    for (int i = 0; i < 2; ++i) { stage_rc(tid * 16 + i * 8192, sR[i], sC[i]); const int Rb = POL::PERM ? ((sR[i] & ~31) + perm32(sR[i] & 31)) : sR[i]; voffA[i] = (unsigned)(sR[i] * KB + sC[i] * 2); voffB[i] = (unsigned)(Rb * KB + sC[i] * 2); }
    constexpr size_t kstep = (size_t)(BK * 2);
    constexpr unsigned hstepB = (unsigned)HALFT * KB;
    const unsigned ldsw = (unsigned)wid * 1024u;
    const int aoff = lds_byte(wr * 64 + fr, fq * 8), boff = lds_byte(wc * 32 + fr, fq * 8);
#define G_SA(b, h) (((b) * 2 + (h)) * HTB)
#define G_SB(b, h) ((4 + (b) * 2 + (h)) * HTB)
#define G_AOFF(OFF, h, i) (POL::GATHER ? (OFF)[h][i] : voffA[i])
#define G_STAGE_A(bufoff, gbase, OFF, h) do { const char* _gb = (const char*)(gbase) + (POL::GATHER ? (size_t)0 : (size_t)(h) * hstepB); _Pragma("unroll") for (int _i = 0; _i < 2; ++_i) \
        __builtin_amdgcn_global_load_lds((const unsigned*)(_gb + G_AOFF(OFF, h, _i)), (LAS unsigned*)(lds + (bufoff) + ldsw + _i * 8192), 16, 0, 0); } while (0)
#define G_STAGE_B(bufoff, gbase, hoff) do { const char* _gb = (const char*)(gbase) + (size_t)(hoff); _Pragma("unroll") for (int _i = 0; _i < 2; ++_i) \
        __builtin_amdgcn_global_load_lds((const unsigned*)(_gb + voffB[_i]), (LAS unsigned*)(lds + (bufoff) + ldsw + _i * 8192), 16, 0, 0); } while (0)
#define G_LD8(p) __builtin_shufflevector(*(const LAS v4i_*)(p), *(const LAS v4i_*)((p) + 1024), 0, 1, 2, 3, 4, 5, 6, 7)
#define G_LDA(dst, b, h) do { if (POL::FP8) { _Pragma("unroll") for (int m = 0; m < 4; ++m) dst##8[m] = G_LD8(lds + G_SA(b, h) + aoff + m * 2048); } \
        else { _Pragma("unroll") for (int m = 0; m < 4; ++m) _Pragma("unroll") for (int k = 0; k < 2; ++k) dst[m][k] = *(const LAS bf16x8*)(lds + G_SA(b, h) + aoff + m * 2048 + k * 1024); } } while (0)
#define G_LDB(dst, b, h) do { if (POL::FP8) { _Pragma("unroll") for (int n = 0; n < 2; ++n) dst##8[n] = G_LD8(lds + G_SB(b, h) + boff + n * 2048); } \
        else { _Pragma("unroll") for (int n = 0; n < 2; ++n) _Pragma("unroll") for (int k = 0; k < 2; ++k) dst[n][k] = *(const LAS bf16x8*)(lds + G_SB(b, h) + boff + n * 2048 + k * 1024); } } while (0)
#define G_MMA(ai, bj, At, Bt) do { __builtin_amdgcn_s_setprio(1); \
        if (POL::FP8) { _Pragma("unroll") for (int m = 0; m < 4; ++m) _Pragma("unroll") for (int n = 0; n < 2; ++n) \
            asm volatile("v_mfma_scale_f32_16x16x128_f8f6f4 %0, %1, %2, %0, %3, %3 op_sel_hi:[0,0,0]" : "+v"(acc[ai][bj][m][n]) : "v"(Bt##8[n]), "v"(At##8[m]), "v"(mxs)); } \
        else { _Pragma("unroll") for (int m = 0; m < 4; ++m) _Pragma("unroll") for (int n = 0; n < 2; ++n) _Pragma("unroll") for (int k = 0; k < 2; ++k) \
            acc[ai][bj][m][n] = __builtin_amdgcn_mfma_f32_16x16x32_bf16(Bt[n][k], At[m][k], acc[ai][bj][m][n], 0, 0, 0); } \
        __builtin_amdgcn_s_setprio(0); } while (0)
#define G_WAIT_V(n) asm volatile("s_waitcnt vmcnt(" #n ")" ::: "memory")
#define G_WAIT_L(n) asm volatile("s_waitcnt lgkmcnt(" #n ")" ::: "memory")
#define G_BAR __builtin_amdgcn_s_barrier()
#define G_SCHED __builtin_amdgcn_sched_barrier(0)
#define G_TRIP(A1, OC, A2, ON, B2) do { \
        G_LDB(B0, 0, 0); G_SCHED; G_LDA(At, 0, 0); G_STAGE_A(G_SA(1, 1), A1, OC, 1); \
        G_WAIT_L(8); G_BAR; G_WAIT_L(0); G_MMA(0, 0, At, B0); G_BAR; G_SCHED; \
        G_LDB(B1, 0, 1); G_STAGE_B(G_SB(0, 0), B2, 0u); \
        G_BAR; G_WAIT_L(0); G_MMA(0, 1, At, B1); G_BAR; \
        G_LDA(At, 0, 1); G_STAGE_A(G_SA(0, 0), A2, ON, 0); \
        G_BAR; G_WAIT_L(0); G_MMA(1, 0, At, B0); G_BAR; G_SCHED; \
        G_STAGE_B(G_SB(0, 1), B2, hstepB); \
        G_WAIT_V(6); G_BAR; G_MMA(1, 1, At, B1); G_BAR; \
        G_LDB(B0, 1, 0); G_SCHED; G_LDA(At, 1, 0); G_STAGE_A(G_SA(0, 1), A2, ON, 1); \
        G_WAIT_L(8); G_BAR; G_WAIT_L(0); G_MMA(0, 0, At, B0); G_BAR; G_SCHED; \
        G_LDB(B1, 1, 1); G_STAGE_B(G_SB(1, 0), (B2) + kstep, 0u); \
        G_BAR; G_WAIT_L(0); G_MMA(0, 1, At, B1); G_BAR; \
        G_LDA(At, 1, 1); G_STAGE_A(G_SA(1, 0), (A2) + kstep, ON, 0); \
        G_BAR; G_WAIT_L(0); G_MMA(1, 0, At, B0); G_BAR; G_SCHED; \
        G_STAGE_B(G_SB(1, 1), (B2) + kstep, hstepB); \
        G_WAIT_V(6); G_BAR; G_MMA(1, 1, At, B1); G_BAR; } while (0)
#define G_TRIP2(A1, OC, A2, ON, B2) do { \
        G_LDB(B0, 0, 0); G_LDB(B1, 0, 1); G_SCHED; G_LDA(At, 0, 0); G_STAGE_A(G_SA(1, 1), A1, OC, 1); \
        G_WAIT_V(8); G_WAIT_L(0); G_BAR; G_MMA(0, 0, At, B0); G_MMA(0, 1, At, B1); G_BAR; G_SCHED; \
        G_LDA(At, 0, 1); G_STAGE_B(G_SB(0, 0), B2, 0u); G_STAGE_B(G_SB(0, 1), B2, hstepB); G_STAGE_A(G_SA(0, 0), A2, ON, 0); \
        G_WAIT_V(8); G_WAIT_L(0); G_BAR; G_MMA(1, 0, At, B0); G_MMA(1, 1, At, B1); G_BAR; G_SCHED; \
        G_LDB(B0, 1, 0); G_LDB(B1, 1, 1); G_SCHED; G_LDA(At, 1, 0); G_STAGE_A(G_SA(0, 1), A2, ON, 1); \
        G_WAIT_V(8); G_WAIT_L(0); G_BAR; G_MMA(0, 0, At, B0); G_MMA(0, 1, At, B1); G_BAR; G_SCHED; \
        G_LDA(At, 1, 1); G_STAGE_B(G_SB(1, 0), (B2) + kstep, 0u); G_STAGE_B(G_SB(1, 1), (B2) + kstep, hstepB); G_STAGE_A(G_SA(1, 0), (A2) + kstep, ON, 0); \
        G_WAIT_V(8); G_WAIT_L(0); G_BAR; G_MMA(1, 0, At, B0); G_MMA(1, 1, At, B1); G_BAR; G_SCHED; } while (0)
#ifndef GEMM_SP2
#define GEMM_SP2 1
#endif
    Unit cur, nxt; int ui = 0;
    if (!P.next(0, cur)) return;
    f32x4 acc[2][2][4][2];
#pragma unroll
    for (int a = 0; a < 2; ++a)
#pragma unroll
        for (int b = 0; b < 2; ++b)
#pragma unroll
            for (int m = 0; m < 4; ++m)
#pragma unroll
                for (int n = 0; n < 2; ++n) acc[a][b][m][n] = (f32x4){0.f, 0.f, 0.f, 0.f};
    const int mxs = 0x7f7f7f7f;
    bf16x8 At[4][2], B0[2][2], B1[2][2]; v8i At8[4], B08[2], B18[2];
    unsigned oc[2][2], on[2][2];
    if (POL::ROWS) { P.stage_rows(cur, 0); __syncthreads(); }
#pragma unroll
    for (int h = 0; h < 2; ++h)
#pragma unroll
        for (int i = 0; i < 2; ++i) { oc[h][i] = POL::GATHER ? P.a_off_l(0, h * HALFT + sR[i]) + (unsigned)sC[i] * 2u : 0u; on[h][i] = 0u; }
    const char* cA = P.a_base(cur); const char* cB = P.b_base(cur);
    if (GEMM_SP2) {
        G_STAGE_B(G_SB(0, 0), cB, 0u); G_STAGE_B(G_SB(0, 1), cB, hstepB); G_STAGE_A(G_SA(0, 0), cA, oc, 0); G_STAGE_A(G_SA(0, 1), cA, oc, 1);
        if (wr == 1) G_BAR;
        G_WAIT_V(2); G_BAR;
        G_STAGE_B(G_SB(1, 0), cB + kstep, 0u); G_STAGE_A(G_SA(1, 0), cA + kstep, oc, 0); G_STAGE_B(G_SB(1, 1), cB + kstep, hstepB);
        G_WAIT_V(6); G_BAR;
    } else {
    G_STAGE_B(G_SB(0, 0), cB, 0u); G_STAGE_A(G_SA(0, 0), cA, oc, 0); G_STAGE_B(G_SB(0, 1), cB, hstepB); G_STAGE_A(G_SA(0, 1), cA, oc, 1);
    if (wr == 1) G_BAR;
    G_WAIT_V(4); G_BAR;
    G_STAGE_B(G_SB(1, 0), cB + kstep, 0u); G_STAGE_A(G_SA(1, 0), cA + kstep, oc, 0); G_STAGE_B(G_SB(1, 1), cB + kstep, hstepB);
    G_WAIT_V(6); G_BAR;
    }
    for (;;) {
        const bool has_next = P.next(ui + 1, nxt);
        const char* nA = has_next ? P.a_base(nxt) : cA; const char* nB = has_next ? P.b_base(nxt) : cB;
        if (POL::ROWS) { if (has_next) P.stage_rows(nxt, (ui + 1) & 1); }
#pragma unroll 1
        for (int t = 0; t < nt; t += 2) {
            const bool last = (t == nt - 2);
            const char* a1 = cA + (size_t)(t + 1) * kstep; const char* a2 = last ? nA : cA + (size_t)(t + 2) * kstep; const char* b2 = last ? nB : cB + (size_t)(t + 2) * kstep;
            if (POL::GATHER) {
                unsigned os[2][2];
                if (last) {
#pragma unroll
                    for (int h = 0; h < 2; ++h)
#pragma unroll
                        for (int i = 0; i < 2; ++i) on[h][i] = has_next ? P.a_off_l((ui + 1) & 1, h * HALFT + sR[i]) + (unsigned)sC[i] * 2u : oc[h][i];
                }
#pragma unroll
                for (int h = 0; h < 2; ++h)
#pragma unroll
                    for (int i = 0; i < 2; ++i) os[h][i] = last ? on[h][i] : oc[h][i];
                if (GEMM_SP2) { G_TRIP2(a1, oc, a2, os, b2); } else { G_TRIP(a1, oc, a2, os, b2); }
            } else { if (GEMM_SP2) { G_TRIP2(a1, oc, a2, oc, b2); } else { G_TRIP(a1, oc, a2, oc, b2); } }
        }
        if (POL::FP8) asm volatile("s_nop 15\n\ts_nop 15" ::: "memory");
        if (wr == 0) G_BAR;
        P.epi(acc, cur, wr, wc, fr, fq, ui & 1);
        if (!has_next) break;
#pragma unroll
        for (int a = 0; a < 2; ++a)
#pragma unroll
            for (int b = 0; b < 2; ++b)
#pragma unroll
                for (int m = 0; m < 4; ++m)
#pragma unroll
                    for (int n = 0; n < 2; ++n) acc[a][b][m][n] = (f32x4){0.f, 0.f, 0.f, 0.f};
        cur = nxt; cA = nA; cB = nB; ++ui;
        if (POL::GATHER) {
#pragma unroll
            for (int h = 0; h < 2; ++h)
#pragma unroll
                for (int i = 0; i < 2; ++i) oc[h][i] = on[h][i];
        }
        if (wr == 1) G_BAR;
    }
    G_WAIT_V(0);
    G_BAR;
#undef G_SA
#undef G_SB
#undef G_AOFF
#undef G_STAGE_A
#undef G_STAGE_B
#undef G_LDA
#undef G_LDB
#undef G_MMA
#undef G_LD8
#undef G_WAIT_V
#undef G_WAIT_L
#undef G_BAR
#undef G_SCHED
#undef G_TRIP
#undef G_TRIP2
}

struct PolInProj {
    static constexpr bool PERM = true, GATHER = false, FP8 = false, ROWS = false;
    __device__ __forceinline__ void stage_rows(const Unit&, int) const {}
    __device__ __forceinline__ unsigned a_off_l(int, int) const { return 0u; }
    const bf16_t* A; const bf16_t* Bt; bf16_t* O; TileOrder ord;
    __device__ __forceinline__ bool next(int i, Unit& u) const {
        constexpr int NLATU = (NLAT / BM) * (INW / BM);
        const int L = i * ord.G + ord.c;
        if (L < NLATU) return ord.tile(i, u.pm, u.pn);
        const int q = L - NLATU; if (q >= (NCTX / BM) * 8) return false;
        u.pm = NLAT / BM + (q >> 3); const int j = q & 7; u.pn = j < 6 ? 2 + j : 4 + j; return true;
    }
    __device__ __forceinline__ const char* a_base(const Unit& u) const { return (const char*)A + (size_t)u.pm * BM * GK * 2; }
    __device__ __forceinline__ unsigned a_off(const Unit&, int r) const { return (unsigned)r * GK * 2u; }
    __device__ __forceinline__ const char* b_base(const Unit& u) const { return (const char*)Bt + (size_t)u.pn * BM * GK * 2; }
    __device__ __forceinline__ void epi(const f32x4 (&acc)[2][2][4][2], const Unit& u, int wr, int wc, int fr, int fq, int par) const {
        const int row0 = u.pm * BM + wr * 64 + fr, col0 = u.pn * BM + wc * 32 + 8 * fq;
        const bool qsilu = u.pn < HGW / BM;
#pragma unroll
        for (int ai = 0; ai < 2; ++ai)
#pragma unroll
            for (int m = 0; m < 4; ++m) { bf16_t* rowp = O + (size_t)(row0 + ai * HALFT + m * 16) * INW + col0;
#pragma unroll
                for (int bj = 0; bj < 2; ++bj) { f32x4 v0 = acc[ai][bj][m][0], v1 = acc[ai][bj][m][1];
                    if (qsilu) {
#pragma unroll
                        for (int e = 0; e < 4; ++e) { v0[e] = v0[e] * sigmoidf_(v0[e]); v1[e] = v1[e] * sigmoidf_(v1[e]); } }
                    u32x4 w; w.x = cvt_pk_bf16(v0[0], v0[1]); w.y = cvt_pk_bf16(v0[2], v0[3]); w.z = cvt_pk_bf16(v1[0], v1[1]); w.w = cvt_pk_bf16(v1[2], v1[3]);
                    *(u32x4*)(rowp + bj * HALFT) = w; } }
    }
};
struct PolOutProj {
    static constexpr bool PERM = true, GATHER = false, FP8 = false, ROWS = false;
    __device__ __forceinline__ void stage_rows(const Unit&, int) const {}
    __device__ __forceinline__ unsigned a_off_l(int, int) const { return 0u; }
    const bf16_t* A; const bf16_t* Bt; const float* x; const float* mod; bf16_t* O; TileOrder ord;
    __device__ __forceinline__ bool next(int i, Unit& u) const { return ord.tile(i, u.pm, u.pn); }
    __device__ __forceinline__ const char* a_base(const Unit& u) const { return (const char*)A + (size_t)u.pm * BM * GK * 2; }
    __device__ __forceinline__ unsigned a_off(const Unit&, int r) const { return (unsigned)r * GK * 2u; }
    __device__ __forceinline__ const char* b_base(const Unit& u) const { return (const char*)Bt + (size_t)u.pn * BM * GK * 2; }
    __device__ __forceinline__ void epi(const f32x4 (&acc)[2][2][4][2], const Unit& u, int wr, int wc, int fr, int fq, int par) const {
        const int row0 = u.pm * BM + wr * 64 + fr, col0 = u.pn * BM + wc * 32 + 8 * fq;
        const float* g1 = mod + (size_t)((u.pm * BM) >> 11) * 6144 + 2048 + col0;
        f32x4 gv[2][2];
#pragma unroll
        for (int bj = 0; bj < 2; ++bj) { gv[bj][0] = *(const f32x4*)(g1 + bj * HALFT); gv[bj][1] = *(const f32x4*)(g1 + bj * HALFT + 4); }
#pragma unroll
        for (int ai = 0; ai < 2; ++ai)
#pragma unroll
            for (int m = 0; m < 4; ++m) { const size_t off = (size_t)(row0 + ai * HALFT + m * 16) * D + col0;
#pragma unroll
                for (int bj = 0; bj < 2; ++bj) {
                    const f32x4 x0 = __builtin_nontemporal_load((const f32x4*)(x + off + bj * HALFT)), x1v = __builtin_nontemporal_load((const f32x4*)(x + off + bj * HALFT + 4));
                    const f32x4 v0 = x0 + gv[bj][0] * acc[ai][bj][m][0], v1 = x1v + gv[bj][1] * acc[ai][bj][m][1];
                    u32x4 w; w.x = cvt_pk_bf16(v0[0], v0[1]); w.y = cvt_pk_bf16(v0[2], v0[3]); w.z = cvt_pk_bf16(v1[0], v1[1]); w.w = cvt_pk_bf16(v1[2], v1[3]);
                    *(u32x4*)(O + off + bj * HALFT) = w; }
                asm volatile("" ::: "memory"); }
    }
};
struct MoeTiles {
    const LAS int* tstart; const u32* cnt; int half;
    __device__ __forceinline__ LAS u32* rows(int par) const { return (LAS u32*)((LAS unsigned char*)tstart + 8192) + par * 512; }
    __device__ __forceinline__ void stage(const Unit& u, int par, const u32* toktab, const float* wtab) const {
        if (threadIdx.x < BM) { const int p = u.pos0 + threadIdx.x; const size_t tb = ((size_t)half * NE + u.e) * CAP; const bool ok = p < u.cn;
            const u32 tk = ok ? toktab[tb + p] : ~0u; const float wg = ok ? wtab[tb + p] : 0.f; LAS u32* rt = rows(par); rt[threadIdx.x * 2] = tk; rt[threadIdx.x * 2 + 1] = __float_as_uint(wg); }
    }
    __device__ __forceinline__ void find(Unit& u) const {
        const int e = __builtin_amdgcn_readfirstlane(tstart[64 + u.pm]);
        u.e = e; u.pos0 = (u.pm - __builtin_amdgcn_readfirstlane(tstart[e])) * BM; u.cn = (int)cnt[half * NE + e];
    }
};
struct PolGateUp {
    static constexpr bool PERM = true, GATHER = true, FP8 = true, ROWS = true;
    const fp8_t* A; const fp8_t* Bt; const float* bgu; const u32* toktab; const float* wtab; fp8_t* O; MoeTiles mt; TileOrder ord;
    __device__ __forceinline__ void stage_rows(const Unit& u, int par) const { mt.stage(u, par, toktab, wtab); }
    __device__ __forceinline__ unsigned a_off_l(int par, int r) const { const u32 tk = mt.rows(par)[r * 2]; return (tk == ~0u ? 0u : (tk >> 2)) * 1024u; }
    __device__ __forceinline__ bool next(int i, Unit& u) const { if (!ord.tile(i, u.pm, u.pn)) return false; mt.find(u); return true; }
    __device__ __forceinline__ const char* a_base(const Unit&) const { return (const char*)A; }
    __device__ __forceinline__ unsigned a_off(const Unit& u, int r) const {
        const int p = u.pos0 + r; const u32 tk = toktab[((size_t)mt.half * NE + u.e) * CAP + (p < u.cn ? p : 0)];
        return (tk >> 2) * 1024u;
    }
    __device__ __forceinline__ const char* b_base(const Unit& u) const { return (const char*)Bt + ((size_t)u.e * 2048 + (size_t)u.pn * BM) * 1024; }
    __device__ __forceinline__ void epi(const f32x4 (&acc)[2][2][4][2], const Unit& u, int wr, int wc, int fr, int fq, int par) const {
        const int row0 = u.pm * BM + wr * 64 + fr, cc = u.pn * HALFT + wc * 32 + 8 * fq;
        const float* bg = bgu + (size_t)u.e * 2048 + cc;
        const f32x4 bg0 = *(const f32x4*)bg, bg1 = *(const f32x4*)(bg + 4), bu0 = *(const f32x4*)(bg + 1024), bu1 = *(const f32x4*)(bg + 1028);
        constexpr float inv = 1.0f / (SC_H2 * SC_W);
#pragma unroll
        for (int ai = 0; ai < 2; ++ai)
#pragma unroll
            for (int m = 0; m < 4; ++m) {
                f32x4 g0 = acc[ai][0][m][0] * inv + bg0, g1 = acc[ai][0][m][1] * inv + bg1, u0 = acc[ai][1][m][0] * inv + bu0, u1 = acc[ai][1][m][1] * inv + bu1;
                float o[8];
#pragma unroll
                for (int j = 0; j < 4; ++j) {
                    const float ga = fminf(g0[j], 7.0f), gb = fminf(g1[j], 7.0f);
                    const float ua = fminf(fmaxf(u0[j], -7.0f), 7.0f), ub = fminf(fmaxf(u1[j], -7.0f), 7.0f);
                    o[j] = ga * sigmoidf_(1.702f * ga) * (ua + 1.0f) * SC_ACT; o[4 + j] = gb * sigmoidf_(1.702f * gb) * (ub + 1.0f) * SC_ACT;
                }
                uint2 w; w.x = pk4_fp8_nc(o[0], o[1], o[2], o[3]); w.y = pk4_fp8_nc(o[4], o[5], o[6], o[7]);
                *(uint2*)(O + (size_t)(row0 + ai * HALFT + m * 16) * DFF + cc) = w;
                asm volatile("" ::: "memory");
            }
    }
};
struct PolDown {
    static constexpr bool PERM = true, GATHER = false, FP8 = true, ROWS = true;
    const fp8_t* A; const fp8_t* Bt; const float* bd; const u32* toktab; const float* wtab; fp8_t* O; MoeTiles mt; TileOrder ord;
    __device__ __forceinline__ void stage_rows(const Unit& u, int par) const { mt.stage(u, par, toktab, wtab); }
    __device__ __forceinline__ unsigned a_off_l(int, int) const { return 0u; }
    __device__ __forceinline__ bool next(int i, Unit& u) const { if (!ord.tile(i, u.pm, u.pn)) return false; mt.find(u); return true; }
    __device__ __forceinline__ const char* a_base(const Unit& u) const { return (const char*)A + (size_t)u.pm * BM * 1024; }
    __device__ __forceinline__ unsigned a_off(const Unit&, int r) const { return (unsigned)r * 1024u; }
    __device__ __forceinline__ const char* b_base(const Unit& u) const { return (const char*)Bt + ((size_t)u.e * 1024 + (size_t)u.pn * BM) * 1024; }
    __device__ __forceinline__ void epi(const f32x4 (&acc)[2][2][4][2], const Unit& u, int wr, int wc, int fr, int fq, int par) const {
        const int col0 = u.pn * BM + wc * 32 + 8 * fq;
        const float* bp = bd + (size_t)u.e * D + col0;
        f32x4 bv[2][2];
#pragma unroll
        for (int bj = 0; bj < 2; ++bj) { bv[bj][0] = *(const f32x4*)(bp + bj * HALFT); bv[bj][1] = *(const f32x4*)(bp + bj * HALFT + 4); }
        const LAS u32* rt = mt.rows(par);
        constexpr float inv = 1.0f / (SC_ACT * SC_W);
#pragma unroll
        for (int ai = 0; ai < 2; ++ai)
#pragma unroll
            for (int m = 0; m < 4; ++m) {
                const int rr = ai * HALFT + wr * 64 + m * 16 + fr;
                const u32 tk = rt[rr * 2];
                if (tk != ~0u) {
                    const float wg = __uint_as_float(rt[rr * 2 + 1]) * SC_Y;
                    fp8_t* rowp = O + (size_t)(tk - (u32)mt.half * HALF_TOK * 4u) * D + col0;
#pragma unroll
                    for (int bj = 0; bj < 2; ++bj) { const f32x4 v0 = (acc[ai][bj][m][0] * inv + bv[bj][0]) * wg, v1 = (acc[ai][bj][m][1] * inv + bv[bj][1]) * wg;
                        uint2 w; w.x = pk4_fp8(v0[0], v0[1], v0[2], v0[3]); w.y = pk4_fp8(v1[0], v1[1], v1[2], v1[3]);
                        *(uint2*)(rowp + bj * HALFT) = w; }
                }
            }
    }
};
__device__ __forceinline__ int moe_tile_table(LAS int* tstart, const u32* cnt, int half) {
    __syncthreads();
    if (threadIdx.x == 0) { int s = 0; for (int e = 0; e < NE; ++e) { tstart[e] = s; s += ((int)cnt[half * NE + e] + BM - 1) / BM; } tstart[NE] = s; }
    __syncthreads();
    const int tot = tstart[NE];
    for (int t = threadIdx.x; t < tot; t += 512) { int e = 0;
#pragma unroll 1
        for (int i = 1; i < NE; ++i) if (t >= tstart[i]) e = i;
        tstart[64 + t] = e; }
    __syncthreads();
    return tot;
}

__device__ __forceinline__ void conv_item(const float* __restrict__ W, int N, bf16_t* __restrict__ WT, int k0, int n0, size_t rowbase, LAS float* scr, int lane) {
#pragma unroll 4
    for (int i = 0; i < 16; ++i) { const int k = 4 * i + (lane >> 4); const f32x4 v = __builtin_nontemporal_load((const f32x4*)(W + (size_t)(k0 + k) * N + n0 + (lane & 15) * 4)); *(LAS f32x4*)(scr + k * 68 + (lane & 15) * 4) = v; }
    asm volatile("s_waitcnt lgkmcnt(0)" ::: "memory");
    const int c = lane & 7;
#pragma unroll
    for (int j = 0; j < 8; ++j) { const int n = (lane >> 3) + 8 * j; const LAS float* s = scr + (8 * c) * 68 + n;
        u32x4 o; o.x = cvt_pk_bf16(s[0 * 68], s[1 * 68]); o.y = cvt_pk_bf16(s[2 * 68], s[3 * 68]); o.z = cvt_pk_bf16(s[4 * 68], s[5 * 68]); o.w = cvt_pk_bf16(s[6 * 68], s[7 * 68]);
        *(u32x4*)(WT + (rowbase + n) * GK + k0 + 8 * c) = o; }
    asm volatile("s_waitcnt lgkmcnt(0)" ::: "memory");
}
__device__ __forceinline__ void conv_item8(const float* __restrict__ W, int N, fp8_t* __restrict__ WT, int k0, int n0, size_t rowbase, LAS float* scr, int lane) {
#pragma unroll 4
    for (int i = 0; i < 16; ++i) { const int k = 4 * i + (lane >> 4); const f32x4 v = __builtin_nontemporal_load((const f32x4*)(W + (size_t)(k0 + k) * N + n0 + (lane & 15) * 4)); *(LAS f32x4*)(scr + k * 68 + (lane & 15) * 4) = v; }
    asm volatile("s_waitcnt lgkmcnt(0)" ::: "memory");
    const LAS float* sp = scr + lane;
#pragma unroll
    for (int q = 0; q < 4; ++q) {
        u32x4 o;
        o.x = pk4_fp8(sp[(16 * q + 0) * 68] * SC_W, sp[(16 * q + 1) * 68] * SC_W, sp[(16 * q + 2) * 68] * SC_W, sp[(16 * q + 3) * 68] * SC_W);
        o.y = pk4_fp8(sp[(16 * q + 4) * 68] * SC_W, sp[(16 * q + 5) * 68] * SC_W, sp[(16 * q + 6) * 68] * SC_W, sp[(16 * q + 7) * 68] * SC_W);
        o.z = pk4_fp8(sp[(16 * q + 8) * 68] * SC_W, sp[(16 * q + 9) * 68] * SC_W, sp[(16 * q + 10) * 68] * SC_W, sp[(16 * q + 11) * 68] * SC_W);
        o.w = pk4_fp8(sp[(16 * q + 12) * 68] * SC_W, sp[(16 * q + 13) * 68] * SC_W, sp[(16 * q + 14) * 68] * SC_W, sp[(16 * q + 15) * 68] * SC_W);
        *(u32x4*)(WT + (rowbase + lane) * GK + k0 + 16 * q) = o;
    }
    asm volatile("s_waitcnt lgkmcnt(0)" ::: "memory");
}
constexpr int IT_IN = 16 * (INW / 64), IT_OUT = 16 * (D / 64), IT_GU = NE * 16 * 32, IT_D = NE * 16 * 16, IT_ALL = IT_IN + IT_OUT + IT_GU + IT_D;
struct ProArgs { const float *c, *c_ctx, *w_ada, *b_ada, *lbl, *w_in, *w_out, *wgu, *wd, *rg_wa, *rg_wx, *rg_lam; float *mod, *lb, *coef; bf16_t *Win_t, *Wout_t, *WG_t; fp8_t *Wgu_t, *Wd_t; };
__device__ __forceinline__ void phase_prologue(LAS unsigned char* lds, const ProArgs& a, int bid, int G, bool do_mod, int it_lo, int it_hi) {
    int tl_ = threadIdx.x; asm volatile("" : "+v"(tl_));
    const int tid = tl_, lane = tid & 63, w = tid >> 6;
    if (!do_mod) {} else if (bid < 96) {
        LAS float* s = (LAS float*)lds;
        for (int i = tid; i < 33 * D; i += 512) { const int b = i >> 10, k = i & 1023; const float v = b < NB ? a.c[(size_t)b * D + k] : a.c_ctx[k]; s[i] = v * sigmoidf_(v); }
        __syncthreads();
        const int n = bid * 64 + lane;
        float acc[33];
#pragma unroll
        for (int b = 0; b < 33; ++b) acc[b] = 0.f;
#pragma unroll 1
        for (int k = 128 * w; k < 128 * w + 128; k += 16) {
            float wv[16];
#pragma unroll
            for (int i = 0; i < 16; ++i) wv[i] = __builtin_nontemporal_load(a.w_ada + (size_t)(k + i) * 6144 + n);
#pragma unroll
            for (int b = 0; b < 33; ++b)
#pragma unroll
                for (int i4 = 0; i4 < 4; ++i4) { const f32x4 sv = *(const LAS f32x4*)(s + b * D + k + 4 * i4); acc[b] += sv[0] * wv[4 * i4] + sv[1] * wv[4 * i4 + 1] + sv[2] * wv[4 * i4 + 2] + sv[3] * wv[4 * i4 + 3]; }
        }
        __syncthreads();
        LAS float* red = (LAS float*)lds;
#pragma unroll
        for (int b = 0; b < 33; ++b) red[(w * 33 + b) * 64 + lane] = acc[b];
        __syncthreads();
        for (int i = tid; i < 33 * 64; i += 512) { const int b = i >> 6, l = i & 63; float sum = a.b_ada[bid * 64 + l];
#pragma unroll
            for (int ww = 0; ww < 8; ++ww) sum += red[(ww * 33 + b) * 64 + l];
            a.mod[(size_t)b * 6144 + bid * 64 + l] = sum; }
        __syncthreads();
    } else if (bid == 96) {
        for (int i = tid; i < 2 * HGW; i += 512) { const float l0 = a.lbl[i], l1 = a.lbl[2 * HGW + i]; a.lb[i] = 1.0f / (1.0f + __expf(l1 - l0)); }
        for (int i = tid; i < 2 * RGW; i += 512) { const float l = a.rg_lam[i]; const float sp = (-l > 20.f) ? -l : log1pf(__expf(-l)); a.coef[i] = -8.0f * sp; }
    } else if (bid == 97) {
        for (int idx = tid; idx < 8 * 256 * 64; idx += 512) { const int hd = idx >> 14, n = (idx >> 6) & 255, kk = idx & 63, g = n >> 6, j = n & 63, d = g >> 1;
            const float* src = (g & 1) ? a.rg_wx : a.rg_wa; a.WG_t[idx] = f2bf(src[(((size_t)d * 8 + hd) * 64 + kk) * 64 + j]); }
    }
    LAS float* scr = (LAS float*)(lds + w * (64 * 68 * 4));
    const int gw = bid * 8 + w, NW = G * 8;
    for (int it = it_lo + gw; it < it_hi; it += NW) {
        int r = it;
        if (r < IT_IN) { const int kb = r / (INW / 64), nb = r % (INW / 64); conv_item(a.w_in, INW, a.Win_t, kb * 64, nb * 64, (size_t)nb * 64, scr, lane); continue; } r -= IT_IN;
        if (r < IT_OUT) { const int kb = r / 16, nb = r % 16; conv_item(a.w_out, D, a.Wout_t, kb * 64, nb * 64, (size_t)nb * 64, scr, lane); continue; } r -= IT_OUT;
        if (r < IT_GU) { const int e = r / 512, q = r % 512, kb = q / 32, nb = q % 32, n0 = nb * 64, bj = n0 >> 10, rem = n0 & 1023, pn = rem >> 7, cc0 = rem & 127;
            conv_item8(a.wgu + (size_t)e * D * 2048, 2048, a.Wgu_t, kb * 64, n0, (size_t)e * 2048 + pn * 256 + bj * 128 + cc0, scr, lane); continue; } r -= IT_GU;
        { const int e = r / 256, q = r % 256, kb = q / 16, nb = q % 16; conv_item8(a.wd + (size_t)e * DFF * D, D, a.Wd_t, kb * 64, nb * 64, (size_t)e * 1024 + nb * 64, scr, lane); }
    }
}


__device__ __forceinline__ void phase_norm1(const float* __restrict__ x, const float* __restrict__ ctx, const float* __restrict__ nw, const float* __restrict__ mod, bf16_t* __restrict__ H, int bid, int G) {
    constexpr int RB = 4;
    int tl_ = threadIdx.x; asm volatile("" : "+v"(tl_));
    const int lane = tl_ & 63, gw = bid * 8 + (tl_ >> 6), NW = G * 8;
    for (int r0 = gw; r0 < NROWS; r0 += RB * NW) {
        f32x4 v[RB][4];
#pragma unroll
        for (int q = 0; q < RB; ++q) { const int r = r0 + q * NW; const int rr = r < NROWS ? r : r0;
            const float* src = rr < NLAT ? x + (size_t)rr * D : ctx + (size_t)(rr - NLAT) * D;
#pragma unroll
            for (int j = 0; j < 4; ++j) v[q][j] = __builtin_nontemporal_load((const f32x4*)(src + j * 256 + lane * 4)); }
#pragma unroll
        for (int q = 0; q < RB; ++q) { const int r = r0 + q * NW; if (r < NROWS) {
            const float* m = mod + (size_t)(r < NLAT ? (r >> 11) : NB) * 6144;
            float ss = 0.f;
#pragma unroll
            for (int j = 0; j < 4; ++j) ss += v[q][j][0] * v[q][j][0] + v[q][j][1] * v[q][j][1] + v[q][j][2] * v[q][j][2] + v[q][j][3] * v[q][j][3];
            const float rstd = __builtin_amdgcn_rsqf(wave_sum(ss) * (1.0f / D) + EPS);
#pragma unroll
            for (int j = 0; j < 4; ++j) {
                const int c0 = j * 256 + lane * 4;
                const f32x4 w = *(const f32x4*)(nw + c0), sh = *(const f32x4*)(m + c0), sc = *(const f32x4*)(m + 1024 + c0);
                const f32x4 o = v[q][j] * rstd * w * (sc + 1.0f) + sh;
                uint2 p; p.x = cvt_pk_bf16(o[0], o[1]); p.y = cvt_pk_bf16(o[2], o[3]);
                *(uint2*)(H + (size_t)r * D + c0) = p;
            } } }
    }
}

__device__ __forceinline__ bf16x8 pack8(const f32x4& a, const f32x4& b) {
    u32x4 w; w.x = cvt_pk_bf16(a[0], a[1]); w.y = cvt_pk_bf16(a[2], a[3]); w.z = cvt_pk_bf16(b[0], b[1]); w.w = cvt_pk_bf16(b[2], b[3]);
    return __builtin_bit_cast(bf16x8, w);
}
constexpr int HW_BUF = 45056;
constexpr int HW_QD = 0, HW_KET = 17408, HW_PM = 35840;
constexpr int HW_VT = 2 * HW_BUF, HW_KD = HW_VT + 18432, HW_OS = HW_KD + 17408, HW_TOT = HW_OS + 17408, HW_DEC = HW_TOT + 2048;
__device__ __forceinline__ void phase_hgrn2_ws(LAS unsigned char* lds, const bf16_t* __restrict__ P, const float* __restrict__ lb, bf16_t* __restrict__ OF, bf16_t* __restrict__ OB, int item) {
    const int b = item >> 3, h = (item >> 1) & 3, dir = item & 1;
    const int tid = threadIdx.x, w = __builtin_amdgcn_readfirstlane(tid >> 6), lane = tid & 63, l15 = lane & 15, G4 = lane >> 4;
    bf16_t* OD = dir ? OB : OF;
    const int cf = dir ? C_FB : C_FF;
    constexpr int NC = (CTXL + T) / 64;
    LAS float* TOT = (LAS float*)(lds + HW_TOT);
#define HW_BAR() do { asm volatile("s_waitcnt lgkmcnt(0)" ::: "memory"); __builtin_amdgcn_s_barrier(); asm volatile("" ::: "memory"); } while (0)
    __syncthreads();
    if (w >= 4) {
        const int et = tid - 256, kp = et & 63, k = 2 * kp, seg = et >> 6, ew = w - 4;
        const int kslot = (k & ~31) | (((k >> 2) & 3) << 3) | (((k >> 4) & 1) << 2) | (k & 3);
        const float lb0 = lb[dir * HGW + h * 128 + k], lb1 = lb[dir * HGW + h * 128 + k + 1];
        const char* Pc = (const char*)P; const int sstep = dir ? -(INW * 2) : INW * 2;
#define HW_OFF0(m_) ({ const int p_ = 64 * (m_) + 16 * seg; const unsigned r_ = p_ < CTXL ? (unsigned)(NLAT + b * CTXL + (dir ? CTXL - 1 - p_ : p_)) : (unsigned)(b * T + (dir ? T - 1 - (p_ - CTXL) : (p_ - CTXL))); (r_ * (unsigned)INW + (unsigned)(h * 128 + k)) * 2u; })
#define HW_LD(off0_, i_, col_) (*(const u32*)(Pc + (unsigned)((int)(off0_) + (i_) * sstep + (col_) * 2)))
#define BF_LO(w_) __uint_as_float((w_) << 16)
#define BF_HI(w_) __uint_as_float((w_) & 0xffff0000u)
        u32 rf[16];
        { const unsigned o0 = HW_OFF0(0);
#pragma unroll
        for (int i = 0; i < 16; ++i) rf[i] = HW_LD(o0, i, cf); }
#pragma unroll 1
        for (int m = 0; m < NC + 1; ++m) {
            const int par = m & 1;
            LAS unsigned char* buf = lds + par * HW_BUF;
            HW_BAR();
            u32 rq[16], rv[16]; float f0v[16], f1v[16], c0v[16], c1v[16]; float run0 = 1.f, run1 = 1.f;
            if (m < NC) {
                const unsigned o0 = HW_OFF0(m);
#pragma unroll
                for (int i = 0; i < 16; ++i) { rq[i] = HW_LD(o0, i, C_Q); rv[i] = HW_LD(o0, i, C_I); }
#pragma unroll
                for (int i = 0; i < 16; ++i) { const float f0 = lb0 + (1.f - lb0) * sigmoidf_(BF_LO(rf[i])), f1 = lb1 + (1.f - lb1) * sigmoidf_(BF_HI(rf[i]));
                    f0v[i] = f0; f1v[i] = f1; run0 *= f0; run1 *= f1; c0v[i] = run0; c1v[i] = run1; }
                *(LAS f32x2*)(TOT + seg * 128 + k) = (f32x2){run0, run1};
                if (m + 1 < NC) { const unsigned o1 = HW_OFF0(m + 1);
#pragma unroll
                    for (int i = 0; i < 16; ++i) rf[i] = HW_LD(o1, i, cf); }
            }
            HW_BAR();
            if (m < NC) {
                f32x2 tt[4];
#pragma unroll
                for (int q = 0; q < 4; ++q) tt[q] = *(const LAS f32x2*)(TOT + q * 128 + k);
                const float p0 = seg == 0 ? 1.f : seg == 1 ? tt[0].x : seg == 2 ? tt[0].x * tt[1].x : tt[0].x * tt[1].x * tt[2].x;
                const float p1 = seg == 0 ? 1.f : seg == 1 ? tt[0].y : seg == 2 ? tt[0].y * tt[1].y : tt[0].y * tt[1].y * tt[2].y;
                const float eb0 = (tt[0].x * tt[1].x) * (tt[2].x * tt[3].x), eb1 = (tt[0].y * tt[1].y) * (tt[2].y * tt[3].y);
                if (seg == 0) *(LAS f32x2*)(lds + HW_DEC + par * 512 + k * 4) = (f32x2){eb0, eb1};
                float ke0[16], ke1[16];
#pragma unroll
                for (int i = 0; i < 16; ++i) {
                    const int j = 16 * seg + i;
                    const float e0 = p0 * c0v[i], e1 = p1 * c1v[i];
                    const float kf0 = (1.f - f0v[i]) * frcp(e0), kf1 = (1.f - f1v[i]) * frcp(e1);
                    *(LAS u32*)(buf + HW_QD + j * 272 + kslot * 2) = cvt_pk_bf16(BF_LO(rq[i]) * e0, BF_HI(rq[i]) * e1);
                    *(LAS u32*)(lds + HW_KD + j * 272 + kslot * 2) = cvt_pk_bf16(kf0, kf1);
                    ke0[i] = kf0 * eb0; ke1[i] = kf1 * eb1;
                }
#pragma unroll
                for (int q4 = 0; q4 < 2; ++q4) {
                    u32x4 a0, a1, v0, v1;
#pragma unroll
                    for (int i = 0; i < 4; ++i) { const int t = 8 * q4 + 2 * i;
                        a0[i] = cvt_pk_bf16(ke0[t], ke0[t + 1]); a1[i] = cvt_pk_bf16(ke1[t], ke1[t + 1]);
                        v0[i] = (rv[t] & 0xffffu) | (rv[t + 1] << 16); v1[i] = (rv[t] >> 16) | (rv[t + 1] & 0xffff0000u); }
                    *(LAS u32x4*)(buf + HW_KET + k * 144 + seg * 32 + q4 * 16) = a0; *(LAS u32x4*)(buf + HW_KET + (k + 1) * 144 + seg * 32 + q4 * 16) = a1;
                    *(LAS u32x4*)(lds + HW_VT + k * 144 + seg * 32 + q4 * 16) = v0; *(LAS u32x4*)(lds + HW_VT + (k + 1) * 144 + seg * 32 + q4 * 16) = v1;
                }
            }
            HW_BAR();
            if (m < NC && m >= CTXL / 64) {
                const int mt = ew;
                f32x4 pa[4];
#pragma unroll
                for (int q = 0; q < 4; ++q) pa[q] = (f32x4){0.f, 0.f, 0.f, 0.f};
#pragma unroll
                for (int s = 0; s < 4; ++s) {
                    const bf16x8 a = *(const LAS bf16x8*)(buf + HW_QD + (16 * mt + l15) * 272 + (32 * s + 8 * G4) * 2);
#pragma unroll
                    for (int q = 0; q < 4; ++q) { const bf16x8 bq = *(const LAS bf16x8*)(lds + HW_KD + (16 * q + l15) * 272 + (32 * s + 8 * G4) * 2); pa[q] = __builtin_amdgcn_mfma_f32_16x16x32_bf16(a, bq, pa[q], 0, 0, 0); }
                }
#pragma unroll
                for (int q = 0; q < 4; ++q)
#pragma unroll
                    for (int r = 0; r < 4; ++r) { const int c = 16 * mt + 4 * G4 + r, j = 16 * q + l15; *(LAS bf16_t*)(buf + HW_PM + c * 144 + j * 2) = f2bf(j <= c ? pa[q][r] : 0.f); }
                asm volatile("s_waitcnt lgkmcnt(0)" ::: "memory");
            }
        }
#undef HW_OFF0
#undef HW_LD
#undef BF_LO
#undef BF_HI
    } else {
        f32x4 S[8][2];
#pragma unroll
        for (int t = 0; t < 8; ++t) { S[t][0] = (f32x4){0.f, 0.f, 0.f, 0.f}; S[t][1] = (f32x4){0.f, 0.f, 0.f, 0.f}; }
        HW_BAR(); HW_BAR(); HW_BAR();
#pragma unroll 1
        for (int n = 0; n < NC; ++n) {
            const int par = n & 1; const bool lat = n >= CTXL / 64;
            LAS unsigned char* buf = lds + par * HW_BUF;
            HW_BAR();
            bf16x8 vb[2][2];
#pragma unroll
            for (int nt = 0; nt < 2; ++nt)
#pragma unroll
                for (int s = 0; s < 2; ++s) vb[nt][s] = *(const LAS bf16x8*)(lds + HW_VT + (32 * w + 16 * nt + l15) * 144 + (32 * s + 8 * G4) * 2);
            HW_BAR();
            if (lat) {
                bf16x8 sb[2][4];
#pragma unroll
                for (int nt = 0; nt < 2; ++nt)
#pragma unroll
                    for (int s = 0; s < 4; ++s) sb[nt][s] = pack8(S[2 * s][nt], S[2 * s + 1][nt]);
#pragma unroll
                for (int mt = 0; mt < 4; ++mt) {
                    f32x4 oa[2] = {(f32x4){0.f, 0.f, 0.f, 0.f}, (f32x4){0.f, 0.f, 0.f, 0.f}};
#pragma unroll
                    for (int s = 0; s < 2; ++s) { const bf16x8 a = *(const LAS bf16x8*)(buf + HW_PM + (16 * mt + l15) * 144 + (32 * s + 8 * G4) * 2);
                        oa[0] = __builtin_amdgcn_mfma_f32_16x16x32_bf16(a, vb[0][s], oa[0], 0, 0, 0); oa[1] = __builtin_amdgcn_mfma_f32_16x16x32_bf16(a, vb[1][s], oa[1], 0, 0, 0); }
#pragma unroll
                    for (int s = 0; s < 4; ++s) { const bf16x8 a = *(const LAS bf16x8*)(buf + HW_QD + (16 * mt + l15) * 272 + (32 * s + 8 * G4) * 2);
                        oa[0] = __builtin_amdgcn_mfma_f32_16x16x32_bf16(a, sb[0][s], oa[0], 0, 0, 0); oa[1] = __builtin_amdgcn_mfma_f32_16x16x32_bf16(a, sb[1][s], oa[1], 0, 0, 0); }
#pragma unroll
                    for (int nt = 0; nt < 2; ++nt)
#pragma unroll
                        for (int r = 0; r < 4; ++r) *(LAS bf16_t*)(lds + HW_OS + (16 * mt + 4 * G4 + r) * 272 + (32 * w + 16 * nt + l15) * 2) = f2bf(oa[nt][r]);
                }
            }
#pragma unroll
            for (int t = 0; t < 8; ++t) {
                const f32x4 d4 = *(const LAS f32x4*)(lds + HW_DEC + par * 512 + (16 * t + 4 * G4) * 4);
                S[t][0] = S[t][0] * d4; S[t][1] = S[t][1] * d4;
#pragma unroll
                for (int s = 0; s < 2; ++s) { const bf16x8 a = *(const LAS bf16x8*)(buf + HW_KET + (16 * t + l15) * 144 + (32 * s + 8 * G4) * 2);
                    S[t][0] = __builtin_amdgcn_mfma_f32_16x16x32_bf16(a, vb[0][s], S[t][0], 0, 0, 0); S[t][1] = __builtin_amdgcn_mfma_f32_16x16x32_bf16(a, vb[1][s], S[t][1], 0, 0, 0); }
            }
            HW_BAR();
            if (lat) {
                const int j = tid >> 2, part = tid & 3, p = 64 * n + j, tt = dir ? T - 1 - (p - CTXL) : (p - CTXL);
                bf16_t* dst = OD + ((size_t)b * T + tt) * HGW + h * 128 + part * 32;
#pragma unroll
                for (int q = 0; q < 4; ++q) *(u32x4*)(dst + q * 8) = *(const LAS u32x4*)(lds + HW_OS + j * 272 + part * 64 + q * 16);
            }
        }
    }
    __syncthreads();
#undef HW_BAR
}

__device__ __forceinline__ size_t rg_row(int b, bool lat, int p) {
    return lat ? (size_t)b * T + (size_t)(p % GROWS) * GRIDW + (p / GROWS) : (size_t)NLAT + b * CTXL + p;
}
constexpr int RC_T = 64 * 144;
constexpr int RC_XC = 0, RC_RG = 2 * RC_T, RC_HI = 4 * RC_T, RC_OUT = 6 * RC_T;
__device__ __forceinline__ void phase_rg_chain(LAS unsigned char* lds, const bf16_t* __restrict__ P, const float* __restrict__ conv_w, const float* __restrict__ conv_b, const bf16_t* __restrict__ WG_t,
                                               const float* __restrict__ ba, const float* __restrict__ bx, const float* __restrict__ coef, bf16_t* __restrict__ HT, bf16_t* __restrict__ MIX, int item) {
    const int b = item >> 3, hd = item & 7;
    const int tid = threadIdx.x, w = __builtin_amdgcn_readfirstlane(tid >> 6), lane = tid & 63, l15 = lane & 15, G4 = lane >> 4;
    const int d = w >> 2, cg = w & 3, ch = 64 * hd + 16 * cg + l15;
    const int ds = tid >> 8, t8 = tid & 255, pg = t8 >> 4, cg4 = t8 & 15;
    bf16x8 F[4];
#pragma unroll
    for (int s = 0; s < 2; ++s) {
        F[s] = *(const bf16x8*)(WG_t + ((size_t)(hd * 256 + 64 * (2 * d) + 16 * cg + l15) * 64 + 32 * s + 8 * G4));
        F[2 + s] = *(const bf16x8*)(WG_t + ((size_t)(hd * 256 + 64 * (2 * d + 1) + 16 * cg + l15) * 64 + 32 * s + 8 * G4)); }
    const float bav = ba[d * RGW + ch], bxv = bx[d * RGW + ch], cf = coef[d * RGW + ch];
    const f32x4 cw0 = *(const f32x4*)(conv_w + 0 * RGW + 64 * hd + 4 * cg4), cw1 = *(const f32x4*)(conv_w + 1 * RGW + 64 * hd + 4 * cg4), cw2 = *(const f32x4*)(conv_w + 2 * RGW + 64 * hd + 4 * cg4),
                cw3 = *(const f32x4*)(conv_w + 3 * RGW + 64 * hd + 4 * cg4), cb4 = *(const f32x4*)(conv_b + 64 * hd + 4 * cg4);
    float hcar = 0.f;
#define RC_CHUNK(dd, s_) ((dd) == 0 ? (s_) : ((s_) < CTXL / 64 ? CTXL / 64 - 1 - (s_) : NCHK + CTXL / 64 - 1 - (s_)))
    u32x2 rxr[7]; u32x4 rgr[2], hir[2];
#define RC_LOAD_RX(s_) do { const int n_ = RC_CHUNK(ds, s_); const bool lat_ = n_ >= CTXL / 64; const int L_ = lat_ ? T : CTXL, p0_ = 64 * (lat_ ? n_ - CTXL / 64 : n_); \
        _Pragma("unroll") for (int i = 0; i < 7; ++i) { const int p = p0_ + 4 * pg - 2 + i; rxr[i] = (p >= 0 && p < L_) ? *(const u32x2*)(P + rg_row(b, lat_, p) * INW + C_RX + 64 * hd + 4 * cg4) : (u32x2){0u, 0u}; } } while (0)
#define RC_ROW(s_, q_) (rg_row(b, true, 64 * (RC_CHUNK(ds, s_) - CTXL / 64) + ((q_) >> 3)))
#define RC_LOAD_RG(s_) do { _Pragma("unroll") for (int j = 0; j < 2; ++j) { const int q = t8 * 2 + j; rgr[j] = *(const u32x4*)(P + RC_ROW(s_, q) * INW + C_RG + 64 * hd + (q & 7) * 8); } } while (0)
#define RC_LOAD_HI(s_) do { _Pragma("unroll") for (int j = 0; j < 2; ++j) { const int q = t8 * 2 + j; rgr[j] = rgr[j]; hir[j] = __builtin_nontemporal_load((const u32x4*)(HT + RC_ROW(s_, q) * RGW + 64 * hd + (q & 7) * 8)); } } while (0)
    RC_LOAD_RX(0);
#pragma unroll 1
    for (int s = 0; s < NCHK; ++s) {
        const int role = s < CTXL / 64 ? 0 : (s < 20 ? 1 : 2);
        if (s == 20) { asm volatile("s_waitcnt vmcnt(0)" ::: "memory"); __syncthreads(); RC_LOAD_RG(20); RC_LOAD_HI(20); }
        {
            float xin[7][4];
#pragma unroll
            for (int i = 0; i < 7; ++i) { xin[i][0] = __uint_as_float(rxr[i].x << 16); xin[i][1] = __uint_as_float(rxr[i].x & 0xffff0000u); xin[i][2] = __uint_as_float(rxr[i].y << 16); xin[i][3] = __uint_as_float(rxr[i].y & 0xffff0000u); }
#pragma unroll
            for (int q = 0; q < 4; ++q) {
                float o[4];
#pragma unroll
                for (int c = 0; c < 4; ++c) o[c] = cb4[c] + cw0[c] * xin[q][c] + cw1[c] * xin[q + 1][c] + cw2[c] * xin[q + 2][c] + cw3[c] * xin[q + 3][c];
                *(LAS unsigned long long*)(lds + RC_XC + ds * RC_T + (4 * pg + q) * 144 + cg4 * 8) = ((unsigned long long)cvt_pk_bf16(o[2], o[3]) << 32) | cvt_pk_bf16(o[0], o[1]);
            }
            if (role == 2) {
#pragma unroll
                for (int j = 0; j < 2; ++j) { const int q = t8 * 2 + j; *(LAS u32x4*)(lds + RC_RG + ds * RC_T + (q >> 3) * 144 + (q & 7) * 16) = rgr[j]; *(LAS u32x4*)(lds + RC_HI + ds * RC_T + (q >> 3) * 144 + (q & 7) * 16) = hir[j]; }
            }
        }
        __syncthreads();
        if (s + 1 < NCHK) { RC_LOAD_RX(s + 1); if (s + 1 > 20) { RC_LOAD_RG(s + 1); RC_LOAD_HI(s + 1); } }
        {
            bf16x8 af[4][2];
#pragma unroll
            for (int mt = 0; mt < 4; ++mt)
#pragma unroll
                for (int k = 0; k < 2; ++k) af[mt][k] = *(const LAS bf16x8*)(lds + RC_XC + d * RC_T + (16 * (l15 >> 2) + 4 * mt + (l15 & 3)) * 144 + (32 * k + 8 * G4) * 2);
            f32x4 ra[4], xa[4];
#pragma unroll
            for (int mt = 0; mt < 4; ++mt) { ra[mt] = (f32x4){0.f, 0.f, 0.f, 0.f}; xa[mt] = (f32x4){0.f, 0.f, 0.f, 0.f};
#pragma unroll
                for (int k = 0; k < 2; ++k) { ra[mt] = __builtin_amdgcn_mfma_f32_16x16x32_bf16(af[mt][k], F[k], ra[mt], 0, 0, 0); xa[mt] = __builtin_amdgcn_mfma_f32_16x16x32_bf16(af[mt][k], F[2 + k], xa[mt], 0, 0, 0); } }
            float av[16], bv[16];
#pragma unroll
            for (int t = 0; t < 16; ++t) {
                const float r = sigmoidf_(ra[t >> 2][t & 3] + bav), ig = sigmoidf_(xa[t >> 2][t & 3] + bxv);
                const float a = fexp(cf * r);
                av[t] = a; bv[t] = fsqrt(fmaxf(1.0f - a * a, 0.f)) * ig * bf2f(*(const LAS bf16_t*)(lds + RC_XC + d * RC_T + (16 * G4 + t) * 144 + (16 * cg + l15) * 2));
            }
            float Al = 1.f, Bl = 0.f;
            if (d == 0) {
#pragma unroll
                for (int t = 0; t < 16; ++t) { Bl = av[t] * Bl + bv[t]; Al *= av[t]; }
            } else {
#pragma unroll
                for (int t = 15; t >= 0; --t) { Bl = av[t] * Bl + bv[t]; Al *= av[t]; }
            }
            float Ag[4], Bg[4];
#pragma unroll
            for (int g = 0; g < 4; ++g) { Ag[g] = __shfl(Al, l15 + 16 * g); Bg[g] = __shfl(Bl, l15 + 16 * g); }
            float h = hcar, hend;
            if (d == 0) {
                const float s1 = Ag[0] * h + Bg[0], s2 = Ag[1] * s1 + Bg[1], s3 = Ag[2] * s2 + Bg[2]; hend = Ag[3] * s3 + Bg[3];
                h = G4 == 0 ? h : G4 == 1 ? s1 : G4 == 2 ? s2 : s3;
            } else {
                const float s2 = Ag[3] * h + Bg[3], s1 = Ag[2] * s2 + Bg[2], s0 = Ag[1] * s1 + Bg[1]; hend = Ag[0] * s0 + Bg[0];
                h = G4 == 3 ? h : G4 == 2 ? s2 : G4 == 1 ? s1 : s0;
            }
            hcar = hend;
            if (role != 0) {
                float hv[16];
                if (d == 0) {
#pragma unroll
                    for (int t = 0; t < 16; ++t) { h = av[t] * h + bv[t]; hv[t] = h; }
                } else {
#pragma unroll
                    for (int t = 15; t >= 0; --t) { h = av[t] * h + bv[t]; hv[t] = h; }
                }
#pragma unroll
                for (int t = 0; t < 16; ++t) {
                    const int off = (16 * G4 + t) * 144 + (16 * cg + l15) * 2;
                    float o = hv[t];
                    if (role == 2) o = gelu_tanh(bf2f(*(const LAS bf16_t*)(lds + RC_RG + d * RC_T + off))) * (o + bf2f(*(const LAS bf16_t*)(lds + RC_HI + d * RC_T + off)));
                    *(LAS bf16_t*)(lds + RC_OUT + d * RC_T + off) = f2bf(o);
                }
            }
        }
        __syncthreads();
        if (role != 0) {
#pragma unroll
            for (int j = 0; j < 2; ++j) { const int q = t8 * 2 + j; const u32x4 v = *(const LAS u32x4*)(lds + RC_OUT + ds * RC_T + (q >> 3) * 144 + (q & 7) * 16);
                if (role == 1) *(u32x4*)(HT + RC_ROW(s, q) * RGW + 64 * hd + (q & 7) * 8) = v;
                else *(u32x4*)(MIX + RC_ROW(s, q) * D + HGW + 64 * hd + (q & 7) * 8) = v; }
        }
    }
#undef RC_CHUNK
#undef RC_LOAD_RX
#undef RC_ROW
#undef RC_LOAD_RG
#undef RC_LOAD_HI
}

__device__ __forceinline__ void phase_mix_finish(const bf16_t* __restrict__ P, const bf16_t* __restrict__ OF, const bf16_t* __restrict__ OB,
                                                 const float* __restrict__ hg_nw, bf16_t* __restrict__ MIX, int bid, int G) {
    constexpr int RB = 4;
    int tl_ = threadIdx.x; asm volatile("" : "+v"(tl_));
    const int lane = tl_ & 63, gw = bid * 8 + (tl_ >> 6), NW = G * 8, c0 = lane * 8;
    const f32x4 nw0 = *(const f32x4*)(hg_nw + c0), nw1 = *(const f32x4*)(hg_nw + c0 + 4);
    const float nwv[8] = {nw0[0], nw0[1], nw0[2], nw0[3], nw1[0], nw1[1], nw1[2], nw1[3]};
    for (int r0 = gw; r0 < NLAT; r0 += RB * NW) {
        u32x4 a4[RB], b4[RB], g4[RB];
#pragma unroll
        for (int q = 0; q < RB; ++q) { const int r = r0 + q * NW; const int rr = r < NLAT ? r : r0;
            a4[q] = *(const u32x4*)(OF + (size_t)rr * HGW + c0); b4[q] = *(const u32x4*)(OB + (size_t)rr * HGW + c0); g4[q] = *(const u32x4*)(P + (size_t)rr * INW + C_G + c0); }
#pragma unroll
        for (int q = 0; q < RB; ++q) { const int r = r0 + q * NW; if (r < NLAT) {
            float o[8]; float ss = 0.f;
#pragma unroll
            for (int i = 0; i < 4; ++i) { o[2 * i] = __uint_as_float(a4[q][i] << 16) + __uint_as_float(b4[q][i] << 16); o[2 * i + 1] = __uint_as_float(a4[q][i] & 0xffff0000u) + __uint_as_float(b4[q][i] & 0xffff0000u); }
#pragma unroll
            for (int i = 0; i < 8; ++i) ss += o[i] * o[i];
            ss += __shfl_xor(ss, 1); ss += __shfl_xor(ss, 2); ss += __shfl_xor(ss, 4); ss += __shfl_xor(ss, 8);
            const float rstd = __builtin_amdgcn_rsqf(ss * (1.0f / 128.0f) + EPS);
            u32x4 w;
#pragma unroll
            for (int i = 0; i < 4; ++i) {
                const float g0 = __uint_as_float(g4[q][i] << 16), g1 = __uint_as_float(g4[q][i] & 0xffff0000u);
                w[i] = cvt_pk_bf16(o[2 * i] * rstd * nwv[2 * i] * (g0 * sigmoidf_(g0)), o[2 * i + 1] * rstd * nwv[2 * i + 1] * (g1 * sigmoidf_(g1)));
            }
            *(u32x4*)(MIX + (size_t)r * D + c0) = w;
        } }
    }
}

__device__ __forceinline__ void phase_norm2_route(LAS unsigned char* lds, const bf16_t* __restrict__ x1, const float* __restrict__ nw, const float* __restrict__ mod,
                                                  const float* __restrict__ rw, const float* __restrict__ rb, fp8_t* __restrict__ H2,
                                                  u32* __restrict__ cnt, u32* __restrict__ toktab, float* __restrict__ wtab, int bid, int G) {
    LAS float* rwT = (LAS float*)lds;
    LAS u32* hist = (LAS u32*)(lds + 131072);
    LAS u32* ent = (LAS u32*)(lds + 131072 + 4096);
    int tl_ = threadIdx.x; asm volatile("" : "+v"(tl_));
    const int tid = tl_, lane = tid & 63, w = tid >> 6;
    for (int i = tid; i < 32 * 1024; i += 512) { const int k = i >> 5, e = i & 31; rwT[e * 1024 + k] = rw[i]; }
    if (tid < 128) hist[tid] = 0;
    __syncthreads();
    const int gw = bid * 8 + w, NW = G * 8;
    const int myexp = ((lane >> 5) & 1) * 16 + ((lane >> 4) & 1) * 8 + ((lane >> 3) & 1) * 4 + ((lane >> 2) & 1) * 2 + ((lane >> 1) & 1);
    const float myrb = rb[myexp];
    int it = 0;
    u32x2 rawn[2][4];
#pragma unroll
    for (int q = 0; q < 2; ++q)
#pragma unroll
        for (int j = 0; j < 4; ++j) rawn[q][j] = __builtin_nontemporal_load((const u32x2*)(x1 + (size_t)(gw + q * NW) * D + j * 256 + lane * 4));
    for (int r0 = gw; r0 < NLAT; r0 += 2 * NW, it += 2) {
        f32x4 v[2][4];
        u32x2 rawc[2][4];
#pragma unroll
        for (int q = 0; q < 2; ++q)
#pragma unroll
            for (int j = 0; j < 4; ++j) rawc[q][j] = rawn[q][j];
        { const int rn0 = r0 + 2 * NW < NLAT ? r0 + 2 * NW : r0;
#pragma unroll
          for (int q = 0; q < 2; ++q)
#pragma unroll
            for (int j = 0; j < 4; ++j) rawn[q][j] = __builtin_nontemporal_load((const u32x2*)(x1 + (size_t)(rn0 + q * NW) * D + j * 256 + lane * 4)); }
#pragma unroll
        for (int q = 0; q < 2; ++q) {
            const int r = r0 + q * NW;
            const float* m = mod + (size_t)(r >> 11) * 6144;
            u32x2 raw[4];
#pragma unroll
            for (int j = 0; j < 4; ++j) raw[j] = rawc[q][j];
            float ss = 0.f;
#pragma unroll
            for (int j = 0; j < 4; ++j) { v[q][j][0] = __uint_as_float(raw[j].x << 16); v[q][j][1] = __uint_as_float(raw[j].x & 0xffff0000u); v[q][j][2] = __uint_as_float(raw[j].y << 16); v[q][j][3] = __uint_as_float(raw[j].y & 0xffff0000u);
                ss += v[q][j][0] * v[q][j][0] + v[q][j][1] * v[q][j][1] + v[q][j][2] * v[q][j][2] + v[q][j][3] * v[q][j][3]; }
            const float rstd = __builtin_amdgcn_rsqf(wave_sum(ss) * (1.0f / D) + EPS);
#pragma unroll
            for (int j = 0; j < 4; ++j) {
                const int c0 = j * 256 + lane * 4;
                const f32x4 ww = *(const f32x4*)(nw + c0), sh = *(const f32x4*)(m + 3072 + c0), sc = *(const f32x4*)(m + 4096 + c0);
                v[q][j] = v[q][j] * rstd * ww * (sc + 1.0f) + sh;
                *(unsigned*)(H2 + (size_t)r * D + c0) = pk4_fp8(v[q][j][0] * SC_H2, v[q][j][1] * SC_H2, v[q][j][2] * SC_H2, v[q][j][3] * SC_H2);
            }
        }
        float part[2][32];
#pragma unroll
        for (int e = 0; e < 32; ++e) {
            float p0 = 0.f, p1 = 0.f;
#pragma unroll
            for (int j = 0; j < 4; ++j) { const f32x4 q = *(const LAS f32x4*)(rwT + e * 1024 + j * 256 + lane * 4);
                p0 += v[0][j][0] * q[0] + v[0][j][1] * q[1] + v[0][j][2] * q[2] + v[0][j][3] * q[3]; p1 += v[1][j][0] * q[0] + v[1][j][1] * q[1] + v[1][j][2] * q[2] + v[1][j][3] * q[3]; }
            part[0][e] = p0; part[1][e] = p1;
        }
#define RT_STEP(N, M) { const bool up = (lane & (M)) != 0; _Pragma("unroll") for (int q = 0; q < 2; ++q) _Pragma("unroll") for (int i = 0; i < (N); ++i) { const float keep = up ? part[q][(N) + i] : part[q][i], send = up ? part[q][i] : part[q][(N) + i]; part[q][i] = keep + __shfl_xor(send, (M)); } }
        RT_STEP(16, 32) RT_STEP(8, 16) RT_STEP(4, 8) RT_STEP(2, 4) RT_STEP(1, 2)
#undef RT_STEP
#pragma unroll
        for (int q = 0; q < 2; ++q) {
            const int r = r0 + q * NW;
            const float mylogit = part[q][0] + __shfl_xor(part[q][0], 1) + myrb;
            int rank = 0;
#pragma unroll
            for (int x = 0; x < 32; ++x) {
                const int src = ((x >> 4) & 1) * 32 + ((x >> 3) & 1) * 16 + ((x >> 2) & 1) * 8 + ((x >> 1) & 1) * 4 + (x & 1) * 2;
                const float oq = __builtin_bit_cast(float, __builtin_amdgcn_readlane(__builtin_bit_cast(int, mylogit), src));
                rank += (oq > mylogit || (oq == mylogit && x < myexp)) ? 1 : 0;
            }
            float tv[4]; int ti[4];
#pragma unroll
            for (int k = 0; k < 4; ++k) {
                const unsigned long long mk = __ballot(rank == k && (lane & 1) == 0);
                const int src = __builtin_amdgcn_readfirstlane((int)__builtin_ctzll(mk));
                tv[k] = __builtin_bit_cast(float, __builtin_amdgcn_readlane(__builtin_bit_cast(int, mylogit), src));
                ti[k] = ((src >> 5) & 1) * 16 + ((src >> 4) & 1) * 8 + ((src >> 3) & 1) * 4 + ((src >> 2) & 1) * 2 + ((src >> 1) & 1);
            }
            const float e1 = fexp(tv[1] - tv[0]), e2 = fexp(tv[2] - tv[0]), e3 = fexp(tv[3] - tv[0]); const float inv = frcp(1.0f + e1 + e2 + e3);
            const float g0 = inv, g1 = e1 * inv, g2 = e2 * inv, g3 = e3 * inv;
            if (lane < 4) {
                const int half = r >= HALF_TOK ? 1 : 0;
                const int e = lane == 0 ? ti[0] : lane == 1 ? ti[1] : lane == 2 ? ti[2] : ti[3];
                const float gv = lane == 0 ? g0 : lane == 1 ? g1 : lane == 2 ? g2 : g3;
                const u32 lp = atomicAdd((u32*)&hist[half * 32 + e], 1u);
                const int idx = ((it + q) * 8 + w) * 4 + lane;
                ent[idx * 2] = ((u32)e << 24) | lp; ent[idx * 2 + 1] = __float_as_uint(gv);
            }
        }
    }
    __syncthreads();
    if (tid < 64) hist[64 + tid] = atomicAdd(&cnt[tid], hist[tid]);
    __syncthreads();
    it = 0;
    for (int r = gw; r < NLAT; r += NW, ++it) {
        if (lane < 4) {
            const int half = r >= HALF_TOK ? 1 : 0; const int idx = (it * 8 + w) * 4 + lane;
            const u32 ev = ent[idx * 2]; const int e = ev >> 24; const u32 pos = hist[64 + half * 32 + e] + (ev & 0xffffffu);
            toktab[((size_t)half * 32 + e) * CAP + pos] = (u32)r * 4u + lane;
            wtab[((size_t)half * 32 + e) * CAP + pos] = __uint_as_float(ent[idx * 2 + 1]);
        }
    }
}

__device__ __forceinline__ void phase_combine(float* __restrict__ out, const bf16_t* __restrict__ X1, const fp8_t* __restrict__ Y, const float* __restrict__ mod, const float* __restrict__ fw, int bid, int G) {
    constexpr int RB = 2;
    typedef float f32x2_ __attribute__((ext_vector_type(2)));
    int tl_ = threadIdx.x; asm volatile("" : "+v"(tl_));
    const int lane = tl_ & 63, gw = bid * 8 + (tl_ >> 6), NW = G * 8;
    for (int r0 = gw; r0 < NLAT; r0 += RB * NW) {
        u32x2 xv[RB][4]; unsigned yv[RB][4][4];
#pragma unroll
        for (int q = 0; q < RB; ++q) { const int r = r0 + q * NW < NLAT ? r0 + q * NW : r0;
#pragma unroll
            for (int j = 0; j < 4; ++j) { xv[q][j] = __builtin_nontemporal_load((const u32x2*)(X1 + (size_t)r * D + j * 256 + lane * 4));
#pragma unroll
                for (int k = 0; k < 4; ++k) yv[q][j][k] = __builtin_nontemporal_load((const unsigned*)(Y + ((size_t)r * 4 + k) * D + j * 256 + lane * 4)); } }
#pragma unroll
        for (int q = 0; q < RB; ++q) { const int r = r0 + q * NW; if (r < NLAT) {
            const float* g2 = mod + (size_t)(r >> 11) * 6144 + 5120;
            f32x4 v[4]; float ss = 0.f;
#pragma unroll
            for (int j = 0; j < 4; ++j) { const int c0 = j * 256 + lane * 4;
                f32x4 sm = (f32x4){0.f, 0.f, 0.f, 0.f};
#pragma unroll
                for (int k = 0; k < 4; ++k) { const f32x2_ lo = __builtin_amdgcn_cvt_pk_f32_fp8(yv[q][j][k], false), hi = __builtin_amdgcn_cvt_pk_f32_fp8(yv[q][j][k], true); sm[0] += lo[0]; sm[1] += lo[1]; sm[2] += hi[0]; sm[3] += hi[1]; }
                const f32x4 g = *(const f32x4*)(g2 + c0);
                v[j][0] = __uint_as_float(xv[q][j].x << 16); v[j][1] = __uint_as_float(xv[q][j].x & 0xffff0000u); v[j][2] = __uint_as_float(xv[q][j].y << 16); v[j][3] = __uint_as_float(xv[q][j].y & 0xffff0000u);
                v[j] = v[j] + g * sm * (1.0f / SC_Y);
                ss += v[j][0] * v[j][0] + v[j][1] * v[j][1] + v[j][2] * v[j][2] + v[j][3] * v[j][3]; }
            const float rstd = __builtin_amdgcn_rsqf(wave_sum(ss) * (1.0f / D) + EPS);
#pragma unroll
            for (int j = 0; j < 4; ++j) { const int c0 = j * 256 + lane * 4; const f32x4 w = *(const f32x4*)(fw + c0); __builtin_nontemporal_store(v[j] * rstd * w, (f32x4*)(out + (size_t)r * D + c0)); }
        } }
    }
}

#define XB_TMO      128
#define XB_XCNT(j)  (256  + 64 * (j))
#define XB_XSUB(j)  (1280 + 64 * (j))
#define XB_XGEN(j)  (2304 + 64 * (j))
#define XB_TOP      3328
#define XB_TOPGEN   3392
#define XCD_BAR_WORDS 3456
#define XB_SPIN_CAP (1u << 20)
__device__ __forceinline__ unsigned xb_ld(unsigned* p)              { return __hip_atomic_load(p, __ATOMIC_RELAXED, __HIP_MEMORY_SCOPE_AGENT); }
__device__ __forceinline__ unsigned xb_add(unsigned* p, unsigned v) { return __hip_atomic_fetch_add(p, v, __ATOMIC_RELAXED, __HIP_MEMORY_SCOPE_AGENT); }
__device__ __forceinline__ unsigned xb_xcc_id() { return (unsigned)__builtin_amdgcn_s_getreg((3 << 11) | 20) & 0xFu; }
#define XB_SPIN(cond, bar) do { unsigned _sp = 0; while (cond) { __builtin_amdgcn_s_sleep(1); \
    if ((++_sp & 255u) == 0u) { if (xb_ld(&(bar)[XB_TMO])) break; if (_sp > XB_SPIN_CAP) { atomicAdd(&(bar)[XB_TMO], 1u); break; } } } } while (0)
struct XcdBarrier { unsigned* bar; unsigned x; volatile LAS unsigned* st; };
__device__ __forceinline__ XcdBarrier xcd_barrier_post(unsigned* bar, volatile LAS unsigned* st) {
    XcdBarrier b; b.bar = bar; b.x = xb_xcc_id(); b.st = st;
    if (threadIdx.x == 0) (void)xb_add(&bar[XB_XCNT(b.x)], 1u);
    return b;
}
__device__ __forceinline__ void xcd_barrier_complete(unsigned* bar, unsigned x, unsigned& nloc, unsigned& nx) {
    const unsigned G = gridDim.x * gridDim.y * gridDim.z;
    unsigned sum, cnt, mine, sp = 0u;
    for (;;) {
        sum = 0u; cnt = 0u; mine = 0u;
#pragma unroll
        for (unsigned j = 0; j < 16; ++j) { const unsigned c = xb_ld(&bar[XB_XCNT(j)]); sum += c; cnt += (c > 0u) ? 1u : 0u; mine = (j == x) ? c : mine; }
        if (sum == G) break;
        __builtin_amdgcn_s_sleep(1);
        if ((++sp & 255u) == 0u) { if (xb_ld(&bar[XB_TMO])) break; if (sp > XB_SPIN_CAP) { atomicAdd(&bar[XB_TMO], 1u); break; } }
    }
    nloc = mine > 0u ? mine : 1u; nx = cnt > 0u ? cnt : 1u;
}
__device__ __forceinline__ void xcd_barrier(unsigned* bar, volatile LAS unsigned* st) {
    asm volatile("s_waitcnt vmcnt(0)" ::: "memory");
    __syncthreads();
    if (threadIdx.x == 0) {
        __builtin_amdgcn_s_waitcnt(0);
        const unsigned x = xb_xcc_id();
        unsigned nloc = st[0], nx = st[1];
        if (nloc == 0u) { xcd_barrier_complete(bar, x, nloc, nx); st[0] = nloc; st[1] = nx; }
        const unsigned old = xb_add(&bar[XB_XSUB(x)], 1u);
        const unsigned gen = old / nloc;
        if (old + 1u == (gen + 1u) * nloc) {
            __builtin_amdgcn_fence(__ATOMIC_RELEASE, "agent");
            asm volatile("s_waitcnt vmcnt(0)" ::: "memory");
            const unsigned og = xb_add(&bar[XB_TOP], 1u);
            const unsigned tg = og / nx;
            if (og + 1u == (tg + 1u) * nx) xb_add(&bar[XB_TOPGEN], 1u);
            else XB_SPIN(xb_ld(&bar[XB_TOPGEN]) == tg, bar);
            __builtin_amdgcn_fence(__ATOMIC_ACQUIRE, "agent");
            xb_add(&bar[XB_XGEN(x)], 1u);
            asm volatile("s_waitcnt vmcnt(0)" ::: "memory");
        } else {
            XB_SPIN(xb_ld(&bar[XB_XGEN(x)]) == gen, bar);
            __builtin_amdgcn_fence(__ATOMIC_ACQUIRE, "agent");
            asm volatile("s_waitcnt vmcnt(0)" ::: "memory");
        }
    }
    __syncthreads();
}
constexpr size_t WS_BAR = 16384;
constexpr int LDS_BARST = LDS_BYTES - 16;

struct MegaArgs {
    const float *x, *c, *ctx, *c_ctx, *norm1_w, *norm2_w, *w_ada, *b_ada, *w_in, *lbl, *hg_nw, *conv_w, *conv_b, *rg_wa, *rg_ba, *rg_wx, *rg_bx, *rg_lam, *w_out,
        *router_w, *router_b, *wgu, *bgu, *wd, *bd, *final_w;
    float* out; unsigned char* ws;
};
typedef const MegaArgs __attribute__((address_space(4)))* KArgs;
__device__ __forceinline__ KArgs kargs() { auto p = __builtin_amdgcn_kernarg_segment_ptr(); asm volatile("" : "+s"(p)); return (KArgs)p; }
#define WSP(T, off) ((T*)(ws + (off)))
#define GRID_SYNC_CG() cg::this_grid().sync()
#define GRID_SYNC() do { KArgs a_ = kargs(); xcd_barrier((unsigned*)(a_->ws + WS_BAR), (volatile LAS unsigned*)(lds + LDS_BARST)); } while (0)
__global__ __launch_bounds__(512, 2) void k_mega(MegaArgs a_unused) {
    extern __shared__ __attribute__((aligned(16))) unsigned char lds_[];
    LAS unsigned char* lds = (LAS unsigned char*)lds_;
    if (threadIdx.x < 4) ((volatile LAS unsigned*)(lds + LDS_BARST))[threadIdx.x] = 0u;
    __syncthreads();
    { KArgs a = kargs(); (void)xcd_barrier_post((unsigned*)(a->ws + WS_BAR), (volatile LAS unsigned*)(lds + LDS_BARST)); }
    { KArgs a = kargs(); unsigned char* ws = a->ws; const int bid = blockIdx.x, G = gridDim.x;
      ProArgs pa; pa.c = a->c; pa.c_ctx = a->c_ctx; pa.w_ada = a->w_ada; pa.b_ada = a->b_ada; pa.lbl = a->lbl; pa.w_in = a->w_in; pa.w_out = a->w_out; pa.wgu = a->wgu; pa.wd = a->wd; pa.rg_wa = a->rg_wa; pa.rg_wx = a->rg_wx; pa.rg_lam = a->rg_lam;
      pa.coef = WSP(float, WS_COEF); pa.WG_t = WSP(bf16_t, WS_WG); pa.mod = WSP(float, WS_MOD); pa.lb = WSP(float, WS_LB); pa.Win_t = WSP(bf16_t, WS_WIN); pa.Wout_t = WSP(bf16_t, WS_WOUT); pa.Wgu_t = WSP(fp8_t, WS_WGU); pa.Wd_t = WSP(fp8_t, WS_WD);
      phase_prologue(lds, pa, bid, G, true, 0, 0); }
    { KArgs a_ = kargs(); if (a_->ws == nullptr) GRID_SYNC_CG(); }
    GRID_SYNC();
    { KArgs a = kargs(); unsigned char* ws = a->ws; phase_norm1(a->x, a->ctx, a->norm1_w, WSP(float, WS_MOD), WSP(bf16_t, WS_H), blockIdx.x, gridDim.x); }
    { KArgs a = kargs(); unsigned char* ws = a->ws;
      ProArgs pa; pa.c = nullptr; pa.c_ctx = nullptr; pa.w_ada = nullptr; pa.b_ada = nullptr; pa.lbl = nullptr; pa.w_in = a->w_in; pa.w_out = a->w_out; pa.wgu = nullptr; pa.wd = nullptr; pa.rg_wa = nullptr; pa.rg_wx = nullptr; pa.rg_lam = nullptr; pa.coef = nullptr; pa.WG_t = nullptr;
      pa.mod = nullptr; pa.lb = nullptr; pa.Win_t = WSP(bf16_t, WS_WIN); pa.Wout_t = WSP(bf16_t, WS_WOUT); pa.Wgu_t = nullptr; pa.Wd_t = nullptr;
      phase_prologue(lds, pa, blockIdx.x, gridDim.x, false, 0, IT_IN + IT_OUT); }
    GRID_SYNC();
    { KArgs a = kargs(); unsigned char* ws = a->ws; PolInProj P; P.A = WSP(bf16_t, WS_H); P.Bt = WSP(bf16_t, WS_WIN); P.O = WSP(bf16_t, WS_PROJ); P.ord.init(NLAT / BM, INW / BM, gridDim.x, blockIdx.x); gemm_phase(lds, P); }
    GRID_SYNC();
    { KArgs a = kargs(); unsigned char* ws = a->ws;
      for (int item = blockIdx.x; item < 256; item += gridDim.x)
          phase_rg_chain(lds, WSP(bf16_t, WS_PROJ), a->conv_w, a->conv_b, WSP(bf16_t, WS_WG), a->rg_ba, a->rg_bx, WSP(float, WS_COEF), WSP(bf16_t, WS_HF), WSP(bf16_t, WS_MIX2), item); }
    __syncthreads();
    { KArgs a = kargs(); unsigned char* ws = a->ws;
      for (int item = blockIdx.x; item < 256; item += gridDim.x) phase_hgrn2_ws(lds, WSP(bf16_t, WS_PROJ), WSP(float, WS_LB), WSP(bf16_t, WS_OF), WSP(bf16_t, WS_OB), item); }
    GRID_SYNC();
    { KArgs a = kargs(); unsigned char* ws = a->ws; phase_mix_finish(WSP(bf16_t, WS_PROJ), WSP(bf16_t, WS_OF), WSP(bf16_t, WS_OB), a->hg_nw, WSP(bf16_t, WS_MIX2), blockIdx.x, gridDim.x); }
    GRID_SYNC();
    { KArgs a = kargs(); unsigned char* ws = a->ws; PolOutProj P; P.A = WSP(bf16_t, WS_MIX2); P.Bt = WSP(bf16_t, WS_WOUT); P.x = a->x; P.mod = WSP(float, WS_MOD); P.O = WSP(bf16_t, WS_X1); P.ord.init(NLAT / BM, D / BM, gridDim.x, blockIdx.x); gemm_phase(lds, P); }
    GRID_SYNC();
    { KArgs a = kargs(); unsigned char* ws = a->ws;
      phase_norm2_route(lds, WSP(bf16_t, WS_X1), a->norm2_w, WSP(float, WS_MOD), a->router_w, a->router_b, WSP(fp8_t, WS_H2), WSP(u32, WS_CTL), WSP(u32, WS_TOKTAB), WSP(float, WS_WTAB), blockIdx.x, gridDim.x); }
    __syncthreads();
    { KArgs a = kargs(); unsigned char* ws = a->ws;
      ProArgs pa; pa.c = nullptr; pa.c_ctx = nullptr; pa.w_ada = nullptr; pa.b_ada = nullptr; pa.lbl = nullptr; pa.w_in = nullptr; pa.w_out = nullptr; pa.wgu = a->wgu; pa.wd = a->wd; pa.rg_wa = nullptr; pa.rg_wx = nullptr; pa.rg_lam = nullptr; pa.coef = nullptr; pa.WG_t = nullptr;
      pa.mod = nullptr; pa.lb = nullptr; pa.Win_t = nullptr; pa.Wout_t = nullptr; pa.Wgu_t = WSP(fp8_t, WS_WGU); pa.Wd_t = WSP(fp8_t, WS_WD);
      phase_prologue(lds, pa, blockIdx.x, gridDim.x, false, IT_IN + IT_OUT, IT_ALL); }
    GRID_SYNC();
#pragma unroll 1
    for (int half = 0; half < NHALF; ++half) {
        { KArgs a = kargs(); unsigned char* ws = a->ws; LAS int* tstart = (LAS int*)(lds + LDS_AUX);
          const int tot = moe_tile_table(tstart, WSP(u32, WS_CTL), half);
          PolGateUp P; P.A = WSP(fp8_t, WS_H2); P.Bt = WSP(fp8_t, WS_WGU); P.bgu = a->bgu; P.toktab = WSP(u32, WS_TOKTAB); P.wtab = WSP(float, WS_WTAB); P.O = WSP(fp8_t, WS_ACT); P.mt.tstart = tstart; P.mt.cnt = WSP(u32, WS_CTL); P.mt.half = half;
          P.ord.init(tot, DFF / HALFT, gridDim.x, blockIdx.x);
          gemm_phase(lds, P); }
        GRID_SYNC();
        { KArgs a = kargs(); unsigned char* ws = a->ws; LAS int* tstart = (LAS int*)(lds + LDS_AUX);
          const int tot = moe_tile_table(tstart, WSP(u32, WS_CTL), half);
          {
              const u32x4* wp = (const u32x4*)WSP(fp8_t, WS_WD) + (size_t)blockIdx.x * 8192 + threadIdx.x; u32x4 acc_ = (u32x4){0u, 0u, 0u, 0u};
#pragma unroll
              for (int i = 0; i < 16; ++i) acc_ |= wp[i * 512];
              asm volatile("" :: "v"(acc_));
          }
          PolDown P; P.A = WSP(fp8_t, WS_ACT); P.Bt = WSP(fp8_t, WS_WD); P.bd = a->bd; P.toktab = WSP(u32, WS_TOKTAB); P.wtab = WSP(float, WS_WTAB); P.O = WSP(fp8_t, WS_Y); P.mt.tstart = tstart; P.mt.cnt = WSP(u32, WS_CTL); P.mt.half = half;
          P.ord.init(tot, D / BM, gridDim.x, blockIdx.x);
          gemm_phase(lds, P); }
        GRID_SYNC();
        { KArgs a = kargs(); unsigned char* ws = a->ws; phase_combine(a->out, WSP(bf16_t, WS_X1), WSP(fp8_t, WS_Y), WSP(float, WS_MOD), a->final_w, blockIdx.x, gridDim.x); }
        __syncthreads();
    }
}

extern "C" void kernel_launch(void* const* d_in, const int* in_sizes, int n_in, void* d_out, int out_size, void* d_ws, size_t ws_size, hipStream_t stream) {
    static int grid_blocks = 0;
    if (!grid_blocks) {
        int dev = 0, cus = 0, per_cu = 0;
        (void)hipGetDevice(&dev);
        (void)hipDeviceGetAttribute(&cus, hipDeviceAttributeMultiprocessorCount, dev);
        (void)hipFuncSetAttribute((const void*)k_mega, hipFuncAttributeMaxDynamicSharedMemorySize, LDS_BYTES);
        (void)hipOccupancyMaxActiveBlocksPerMultiprocessor(&per_cu, (const void*)k_mega, 512, LDS_BYTES);
        if (per_cu < 1) { fprintf(stderr, "kernel_launch: occupancy query says %d blocks/CU\n", per_cu); per_cu = 1; }
        grid_blocks = cus * 1;
    }
    if (ws_size < 1024 * MiB) { fprintf(stderr, "kernel_launch: workspace too small (%zu)\n", ws_size); return; }
    MegaArgs a{};
    const float** ap = (const float**)&a;
    for (int i = 0; i < 26; ++i) ap[i] = (const float*)d_in[i];
    a.out = (float*)d_out; a.ws = (unsigned char*)d_ws;
    (void)hipMemsetAsync((unsigned char*)d_ws + WS_CTL, 0, 32768, stream);
    void* args[] = {&a};
    hipError_t e = hipLaunchCooperativeKernel((const void*)k_mega, dim3(grid_blocks), dim3(512), args, LDS_BYTES, stream);
    if (e != hipSuccess) fprintf(stderr, "cooperative launch failed: %s (grid %d)\n", hipGetErrorString(e), grid_blocks);
}
```

```cpp
#include <hip/hip_runtime.h>
#include <hip/hip_cooperative_groups.h>
#include <cstdio>
#include <cstdint>

typedef unsigned short bf16_t;
typedef unsigned int u32;
namespace cg = cooperative_groups;

constexpr int D = 1024, NB = 32, T = 2048, CTXL = 256, GRIDW = 64, GROWS = T / GRIDW;
constexpr int NLAT = NB * T;
constexpr int NCTX = NB * CTXL;
constexpr int NROWS = NLAT + NCTX;
constexpr int HGW = 512, RGW = 512, INW = 3584;
constexpr int C_Q = 0, C_I = 512, C_FF = 1024, C_FB = 1536, C_G = 2048, C_RX = 2560, C_RG = 3072;
constexpr int NE = 32, TOPK = 4, DFF = 1024;
constexpr int NCHK = (CTXL + T) / 64;
constexpr int NHALF = 1;
constexpr int HALF_TOK = NLAT / NHALF;
constexpr int CAP = HALF_TOK;
constexpr int MAXSLOT = HALF_TOK * TOPK + NE * 256;
constexpr float EPS = 1e-6f;

constexpr size_t MiB = 1u << 20;
constexpr size_t WS_CTL = 0;
constexpr size_t WS_WG = 64 * 1024;
constexpr size_t WS_MOD = 1 * MiB;
constexpr size_t WS_LB = WS_MOD + 33 * 6144 * 4;
constexpr size_t WS_COEF = WS_LB + 4096;
constexpr size_t WS_TOKTAB = 2 * MiB;
constexpr size_t WS_WTAB = 10 * MiB;
constexpr size_t WS_WIN = 18 * MiB, WS_WOUT = 25 * MiB;
constexpr size_t WS_OF = 28 * MiB, WS_OB = 92 * MiB;
constexpr size_t WS_HF = 156 * MiB;
constexpr size_t WS_H = 284 * MiB;
constexpr size_t WS_MIX2 = WS_H;
constexpr size_t WS_PROJ = 428 * MiB;
constexpr size_t WS_H2 = 28 * MiB;
constexpr size_t WS_WGU = 92 * MiB, WS_WD = 156 * MiB;
constexpr size_t WS_ACT = 188 * MiB;
constexpr size_t WS_Y = 452 * MiB;
constexpr size_t WS_X1 = 708 * MiB;
constexpr float SC_Y = 16.0f;

__device__ __forceinline__ float bf2f(bf16_t b) { return __uint_as_float(((u32)b) << 16); }
__device__ __forceinline__ bf16_t f2bf(float f) { u32 u = __float_as_uint(f); u += 0x7fffu + ((u >> 16) & 1u); return (bf16_t)(u >> 16); }
__device__ __forceinline__ u32 pk2(float lo, float hi) { return (u32)f2bf(lo) | ((u32)f2bf(hi) << 16); }
__device__ __forceinline__ float fexp(float x) { return __builtin_amdgcn_exp2f(x * 1.4426950408889634f); }
__device__ __forceinline__ float frcp(float x) { return __builtin_amdgcn_rcpf(x); }
__device__ __forceinline__ float flog(float x) { return __builtin_amdgcn_logf(x) * 0.6931471805599453f; }
__device__ __forceinline__ float fsqrt(float x) { return __builtin_amdgcn_sqrtf(x); }
__device__ __forceinline__ float sigmoidf_(float x) { return frcp(1.0f + fexp(-x)); }
__device__ __forceinline__ float wave_sum(float v) {
#pragma unroll
    for (int o = 1; o < 64; o <<= 1) v += __shfl_xor(v, o);
    return v;
}

__device__ __forceinline__ float gelu_tanh(float x) { const float u = 1.5957691216057308f * (x + 0.044715f * x * x * x); return x * sigmoidf_(u); }
#define LAS __attribute__((address_space(3)))
typedef short bf16x8 __attribute__((ext_vector_type(8)));
typedef float f32x4 __attribute__((ext_vector_type(4)));
typedef unsigned u32x4 __attribute__((ext_vector_type(4)));
typedef int v8i __attribute__((ext_vector_type(8)));
typedef int v4i_ __attribute__((ext_vector_type(4)));
typedef unsigned u32x2 __attribute__((ext_vector_type(2)));
typedef float f32x2 __attribute__((ext_vector_type(2)));
typedef unsigned char fp8_t;
constexpr float SC_H2 = 16.0f, SC_W = 32.0f, SC_ACT = 4.0f;
__device__ __forceinline__ unsigned pk4_fp8(float a, float b, float c, float d) {
    a = fminf(fmaxf(a, -448.f), 448.f); b = fminf(fmaxf(b, -448.f), 448.f); c = fminf(fmaxf(c, -448.f), 448.f); d = fminf(fmaxf(d, -448.f), 448.f);
    int r = 0; r = __builtin_amdgcn_cvt_pk_fp8_f32(a, b, r, false); r = __builtin_amdgcn_cvt_pk_fp8_f32(c, d, r, true); return (unsigned)r; }
__device__ __forceinline__ unsigned pk4_fp8_nc(float a, float b, float c, float d) { int r = 0; r = __builtin_amdgcn_cvt_pk_fp8_f32(a, b, r, false); r = __builtin_amdgcn_cvt_pk_fp8_f32(c, d, r, true); return (unsigned)r; }
constexpr int BM = 256, BK = 64, HALFT = 128, HTB = HALFT * BK * 2, STAGE_BYTES = 8 * HTB, NXCD = 8, WGM = 8;
constexpr int GK = 1024;
constexpr int LDS_BYTES = 147456;
constexpr int LDS_AUX = STAGE_BYTES;

__device__ __forceinline__ int lds_byte(int r, int c) { const int st = (r >> 4) * 2 + (c >> 5), rr = r & 15, cc = c & 31, ob = rr * 64 + cc * 2; return st * 1024 + (ob ^ (((ob >> 9) & 1) << 5)); }
__device__ __forceinline__ void stage_rc(int b, int& R, int& C) { const int st = b / 1024, sb = b % 1024, swz = sb ^ (((sb >> 9) & 1) << 5); R = (st >> 1) * 16 + swz / 64; C = (st & 1) * 32 + (swz % 64) / 2; }
__device__ __forceinline__ int perm32(int rho) { const int n = rho >> 4, i = rho & 15; return 8 * (i >> 2) + 4 * n + (i & 3); }
__device__ __forceinline__ unsigned cvt_pk_bf16(float lo, float hi) { unsigned r; asm volatile("v_cvt_pk_bf16_f32 %0, %1, %2" : "=v"(r) : "v"(lo), "v"(hi)); return r; }

struct Unit { int pm, pn, e, pos0, cn; };
struct TileOrder {
    int nM, nN, nwg, G, c;
    __device__ __forceinline__ void init(int nM_, int nN_, int G_, int c_) { nM = nM_; nN = nN_; nwg = nM * nN; G = G_; c = c_; }
    __device__ __forceinline__ bool tile(int i, int& pm, int& pn) const {
        const long L = (long)i * G + c; if (L >= nwg) return false;
        int wgid = (int)L; { const int q = nwg / NXCD, r = nwg % NXCD, xcd = wgid % NXCD, off = wgid / NXCD; wgid = (xcd < r ? xcd * (q + 1) : r * (q + 1) + (xcd - r) * q) + off; }
        const int nig = WGM * nN, gid = wgid / nig, fm = gid * WGM, gsz = (nM - fm) < WGM ? (nM - fm) : WGM;
        pm = fm + ((wgid % nig) % gsz); pn = (wgid % nig) / gsz; return true;
    }
};

template <class POL>
__device__ __forceinline__ void gemm_phase(LAS unsigned char* lds, const POL& P) {
    int tid_ = threadIdx.x; asm volatile("" : "+v"(tid_));
    const int tid = tid_, wid = __builtin_amdgcn_readfirstlane(tid >> 6), lane = tid & 63, wr = wid >> 2, wc = wid & 3, fr = lane & 15, fq = lane >> 4;
    constexpr int KB = POL::FP8 ? 1024 : 2048, nt = KB / 128;
    int sR[2], sC[2]; unsigned voffA[2], voffB[2];
#pragma unroll
    for (int i = 0; i < 2; ++i) { stage_rc(tid * 16 + i * 8192, sR[i], sC[i]); const int Rb = POL::PERM ? ((sR[i] & ~31) + perm32(sR[i] & 31)) : sR[i]; voffA[i] = (unsigned)(sR[i] * KB + sC[i] * 2); voffB[i] = (unsigned)(Rb * KB + sC[i] * 2); }
    constexpr size_t kstep = (size_t)(BK * 2);
    constexpr unsigned hstepB = (unsigned)HALFT * KB;
    const unsigned ldsw = (unsigned)wid * 1024u;
    const int aoff = lds_byte(wr * 64 + fr, fq * 8), boff = lds_byte(wc * 32 + fr, fq * 8);
#define G_SA(b, h) (((b) * 2 + (h)) * HTB)
#define G_SB(b, h) ((4 + (b) * 2 + (h)) * HTB)
#define G_AOFF(OFF, h, i) (POL::GATHER ? (OFF)[h][i] : voffA[i])
#define G_STAGE_A(bufoff, gbase, OFF, h) do { const char* _gb = (const char*)(gbase) + (POL::GATHER ? (size_t)0 : (size_t)(h) * hstepB); _Pragma("unroll") for (int _i = 0; _i < 2; ++_i) \
        __builtin_amdgcn_global_load_lds((const unsigned*)(_gb + G_AOFF(OFF, h, _i)), (LAS unsigned*)(lds + (bufoff) + ldsw + _i * 8192), 16, 0, 0); } while (0)
#define G_STAGE_B(bufoff, gbase, hoff) do { const char* _gb = (const char*)(gbase) + (size_t)(hoff); _Pragma("unroll") for (int _i = 0; _i < 2; ++_i) \
        __builtin_amdgcn_global_load_lds((const unsigned*)(_gb + voffB[_i]), (LAS unsigned*)(lds + (bufoff) + ldsw + _i * 8192), 16, 0, 0); } while (0)
#define G_LD8(p) __builtin_shufflevector(*(const LAS v4i_*)(p), *(const LAS v4i_*)((p) + 1024), 0, 1, 2, 3, 4, 5, 6, 7)
#define G_LDA(dst, b, h) do { if (POL::FP8) { _Pragma("unroll") for (int m = 0; m < 4; ++m) dst##8[m] = G_LD8(lds + G_SA(b, h) + aoff + m * 2048); } \
        else { _Pragma("unroll") for (int m = 0; m < 4; ++m) _Pragma("unroll") for (int k = 0; k < 2; ++k) dst[m][k] = *(const LAS bf16x8*)(lds + G_SA(b, h) + aoff + m * 2048 + k * 1024); } } while (0)
#define G_LDB(dst, b, h) do { if (POL::FP8) { _Pragma("unroll") for (int n = 0; n < 2; ++n) dst##8[n] = G_LD8(lds + G_SB(b, h) + boff + n * 2048); } \
        else { _Pragma("unroll") for (int n = 0; n < 2; ++n) _Pragma("unroll") for (int k = 0; k < 2; ++k) dst[n][k] = *(const LAS bf16x8*)(lds + G_SB(b, h) + boff + n * 2048 + k * 1024); } } while (0)
#define G_MMA(ai, bj, At, Bt) do { __builtin_amdgcn_s_setprio(1); \
        if (POL::FP8) { _Pragma("unroll") for (int m = 0; m < 4; ++m) _Pragma("unroll") for (int n = 0; n < 2; ++n) \
            asm volatile("v_mfma_scale_f32_16x16x128_f8f6f4 %0, %1, %2, %0, %3, %3 op_sel_hi:[0,0,0]" : "+v"(acc[ai][bj][m][n]) : "v"(Bt##8[n]), "v"(At##8[m]), "v"(mxs)); } \
        else { _Pragma("unroll") for (int m = 0; m < 4; ++m) _Pragma("unroll") for (int n = 0; n < 2; ++n) _Pragma("unroll") for (int k = 0; k < 2; ++k) \
            acc[ai][bj][m][n] = __builtin_amdgcn_mfma_f32_16x16x32_bf16(Bt[n][k], At[m][k], acc[ai][bj][m][n], 0, 0, 0); } \
        __builtin_amdgcn_s_setprio(0); } while (0)
#define G_WAIT_V(n) asm volatile("s_waitcnt vmcnt(" #n ")" ::: "memory")
#define G_WAIT_L(n) asm volatile("s_waitcnt lgkmcnt(" #n ")" ::: "memory")
#define G_BAR __builtin_amdgcn_s_barrier()
#define G_SCHED __builtin_amdgcn_sched_barrier(0)
#define G_TRIP(A1, OC, A2, ON, B2) do { \
        G_LDB(B0, 0, 0); G_SCHED; G_LDA(At, 0, 0); G_STAGE_A(G_SA(1, 1), A1, OC, 1); \
        G_WAIT_L(8); G_BAR; G_WAIT_L(0); G_MMA(0, 0, At, B0); G_BAR; G_SCHED; \
        G_LDB(B1, 0, 1); G_STAGE_B(G_SB(0, 0), B2, 0u); \
        G_BAR; G_WAIT_L(0); G_MMA(0, 1, At, B1); G_BAR; \
        G_LDA(At, 0, 1); G_STAGE_A(G_SA(0, 0), A2, ON, 0); \
        G_BAR; G_WAIT_L(0); G_MMA(1, 0, At, B0); G_BAR; G_SCHED; \
        G_STAGE_B(G_SB(0, 1), B2, hstepB); \
        G_WAIT_V(6); G_BAR; G_MMA(1, 1, At, B1); G_BAR; \
        G_LDB(B0, 1, 0); G_SCHED; G_LDA(At, 1, 0); G_STAGE_A(G_SA(0, 1), A2, ON, 1); \
        G_WAIT_L(8); G_BAR; G_WAIT_L(0); G_MMA(0, 0, At, B0); G_BAR; G_SCHED; \
        G_LDB(B1, 1, 1); G_STAGE_B(G_SB(1, 0), (B2) + kstep, 0u); \
        G_BAR; G_WAIT_L(0); G_MMA(0, 1, At, B1); G_BAR; \
        G_LDA(At, 1, 1); G_STAGE_A(G_SA(1, 0), (A2) + kstep, ON, 0); \
        G_BAR; G_WAIT_L(0); G_MMA(1, 0, At, B0); G_BAR; G_SCHED; \
        G_STAGE_B(G_SB(1, 1), (B2) + kstep, hstepB); \
        G_WAIT_V(6); G_BAR; G_MMA(1, 1, At, B1); G_BAR; } while (0)
#define G_TRIP2(A1, OC, A2, ON, B2) do { \
        G_LDB(B0, 0, 0); G_LDB(B1, 0, 1); G_SCHED; G_LDA(At, 0, 0); G_STAGE_A(G_SA(1, 1), A1, OC, 1); \
        G_WAIT_V(8); G_WAIT_L(0); G_BAR; G_MMA(0, 0, At, B0); G_MMA(0, 1, At, B1); G_BAR; G_SCHED; \
        G_LDA(At, 0, 1); G_STAGE_B(G_SB(0, 0), B2, 0u); G_STAGE_B(G_SB(0, 1), B2, hstepB); G_STAGE_A(G_SA(0, 0), A2, ON, 0); \
        G_WAIT_V(8); G_WAIT_L(0); G_BAR; G_MMA(1, 0, At, B0); G_MMA(1, 1, At, B1); G_BAR; G_SCHED; \
        G_LDB(B0, 1, 0); G_LDB(B1, 1, 1); G_SCHED; G_LDA(At, 1, 0); G_STAGE_A(G_SA(0, 1), A2, ON, 1); \
        G_WAIT_V(8); G_WAIT_L(0); G_BAR; G_MMA(0, 0, At, B0); G_MMA(0, 1, At, B1); G_BAR; G_SCHED; \
        G_LDA(At, 1, 1); G_STAGE_B(G_SB(1, 0), (B2) + kstep, 0u); G_STAGE_B(G_SB(1, 1), (B2) + kstep, hstepB); G_STAGE_A(G_SA(1, 0), (A2) + kstep, ON, 0); \
        G_WAIT_V(8); G_WAIT_L(0); G_BAR; G_MMA(1, 0, At, B0); G_MMA(1, 1, At, B1); G_BAR; G_SCHED; } while (0)
#ifndef GEMM_SP2
#define GEMM_SP2 1
#endif
    Unit cur, nxt; int ui = 0;
    if (!P.next(0, cur)) return;
    f32x4 acc[2][2][4][2];
#pragma unroll
    for (int a = 0; a < 2; ++a)
#pragma unroll
        for (int b = 0; b < 2; ++b)
#pragma unroll
            for (int m = 0; m < 4; ++m)
#pragma unroll
                for (int n = 0; n < 2; ++n) acc[a][b][m][n] = (f32x4){0.f, 0.f, 0.f, 0.f};
    const int mxs = 0x7f7f7f7f;
    bf16x8 At[4][2], B0[2][2], B1[2][2]; v8i At8[4], B08[2], B18[2];
    unsigned oc[2][2], on[2][2];
    if (POL::ROWS) { P.stage_rows(cur, 0); __syncthreads(); }
#pragma unroll
    for (int h = 0; h < 2; ++h)
#pragma unroll
        for (int i = 0; i < 2; ++i) { oc[h][i] = POL::GATHER ? P.a_off_l(0, h * HALFT + sR[i]) + (unsigned)sC[i] * 2u : 0u; on[h][i] = 0u; }
    const char* cA = P.a_base(cur); const char* cB = P.b_base(cur);
    if (GEMM_SP2) {
        G_STAGE_B(G_SB(0, 0), cB, 0u); G_STAGE_B(G_SB(0, 1), cB, hstepB); G_STAGE_A(G_SA(0, 0), cA, oc, 0); G_STAGE_A(G_SA(0, 1), cA, oc, 1);
        if (wr == 1) G_BAR;
        G_WAIT_V(2); G_BAR;
        G_STAGE_B(G_SB(1, 0), cB + kstep, 0u); G_STAGE_A(G_SA(1, 0), cA + kstep, oc, 0); G_STAGE_B(G_SB(1, 1), cB + kstep, hstepB);
        G_WAIT_V(6); G_BAR;
    } else {
    G_STAGE_B(G_SB(0, 0), cB, 0u); G_STAGE_A(G_SA(0, 0), cA, oc, 0); G_STAGE_B(G_SB(0, 1), cB, hstepB); G_STAGE_A(G_SA(0, 1), cA, oc, 1);
    if (wr == 1) G_BAR;
    G_WAIT_V(4); G_BAR;
    G_STAGE_B(G_SB(1, 0), cB + kstep, 0u); G_STAGE_A(G_SA(1, 0), cA + kstep, oc, 0); G_STAGE_B(G_SB(1, 1), cB + kstep, hstepB);
    G_WAIT_V(6); G_BAR;
    }
    for (;;) {
        const bool has_next = P.next(ui + 1, nxt);
        const char* nA = has_next ? P.a_base(nxt) : cA; const char* nB = has_next ? P.b_base(nxt) : cB;
        if (POL::ROWS) { if (has_next) P.stage_rows(nxt, (ui + 1) & 1); }
#pragma unroll 1
        for (int t = 0; t < nt; t += 2) {
            const bool last = (t == nt - 2);
            const char* a1 = cA + (size_t)(t + 1) * kstep; const char* a2 = last ? nA : cA + (size_t)(t + 2) * kstep; const char* b2 = last ? nB : cB + (size_t)(t + 2) * kstep;
            if (POL::GATHER) {
                unsigned os[2][2];
                if (last) {
#pragma unroll
                    for (int h = 0; h < 2; ++h)
#pragma unroll
                        for (int i = 0; i < 2; ++i) on[h][i] = has_next ? P.a_off_l((ui + 1) & 1, h * HALFT + sR[i]) + (unsigned)sC[i] * 2u : oc[h][i];
                }
#pragma unroll
                for (int h = 0; h < 2; ++h)
#pragma unroll
                    for (int i = 0; i < 2; ++i) os[h][i] = last ? on[h][i] : oc[h][i];
                if (GEMM_SP2) { G_TRIP2(a1, oc, a2, os, b2); } else { G_TRIP(a1, oc, a2, os, b2); }
            } else { if (GEMM_SP2) { G_TRIP2(a1, oc, a2, oc, b2); } else { G_TRIP(a1, oc, a2, oc, b2); } }
        }
        if (POL::FP8) asm volatile("s_nop 15\n\ts_nop 15" ::: "memory");
        if (wr == 0) G_BAR;
        P.epi(acc, cur, wr, wc, fr, fq, ui & 1);
        if (!has_next) break;
#pragma unroll
        for (int a = 0; a < 2; ++a)
#pragma unroll
            for (int b = 0; b < 2; ++b)
#pragma unroll
                for (int m = 0; m < 4; ++m)
#pragma unroll
                    for (int n = 0; n < 2; ++n) acc[a][b][m][n] = (f32x4){0.f, 0.f, 0.f, 0.f};
        cur = nxt; cA = nA; cB = nB; ++ui;
        if (POL::GATHER) {
#pragma unroll
            for (int h = 0; h < 2; ++h)
#pragma unroll
                for (int i = 0; i < 2; ++i) oc[h][i] = on[h][i];
        }
        if (wr == 1) G_BAR;
    }
    G_WAIT_V(0);
    G_BAR;
#undef G_SA
#undef G_SB
#undef G_AOFF
#undef G_STAGE_A
#undef G_STAGE_B
#undef G_LDA
#undef G_LDB
#undef G_MMA
#undef G_LD8
#undef G_WAIT_V
#undef G_WAIT_L
#undef G_BAR
#undef G_SCHED
#undef G_TRIP
#undef G_TRIP2
}

struct PolInProj {
    static constexpr bool PERM = true, GATHER = false, FP8 = false, ROWS = false;
    __device__ __forceinline__ void stage_rows(const Unit&, int) const {}
    __device__ __forceinline__ unsigned a_off_l(int, int) const { return 0u; }
    const bf16_t* A; const bf16_t* Bt; bf16_t* O; TileOrder ord;
    __device__ __forceinline__ bool next(int i, Unit& u) const {
        constexpr int NLATU = (NLAT / BM) * (INW / BM);
        const int L = i * ord.G + ord.c;
        if (L < NLATU) return ord.tile(i, u.pm, u.pn);
        const int q = L - NLATU; if (q >= (NCTX / BM) * 8) return false;
        u.pm = NLAT / BM + (q >> 3); const int j = q & 7; u.pn = j < 6 ? 2 + j : 4 + j; return true;
    }
    __device__ __forceinline__ const char* a_base(const Unit& u) const { return (const char*)A + (size_t)u.pm * BM * GK * 2; }
    __device__ __forceinline__ unsigned a_off(const Unit&, int r) const { return (unsigned)r * GK * 2u; }
    __device__ __forceinline__ const char* b_base(const Unit& u) const { return (const char*)Bt + (size_t)u.pn * BM * GK * 2; }
    __device__ __forceinline__ void epi(const f32x4 (&acc)[2][2][4][2], const Unit& u, int wr, int wc, int fr, int fq, int par) const {
        const int row0 = u.pm * BM + wr * 64 + fr, col0 = u.pn * BM + wc * 32 + 8 * fq;
        const bool qsilu = u.pn < HGW / BM;
#pragma unroll
        for (int ai = 0; ai < 2; ++ai)
#pragma unroll
            for (int m = 0; m < 4; ++m) { bf16_t* rowp = O + (size_t)(row0 + ai * HALFT + m * 16) * INW + col0;
#pragma unroll
                for (int bj = 0; bj < 2; ++bj) { f32x4 v0 = acc[ai][bj][m][0], v1 = acc[ai][bj][m][1];
                    if (qsilu) {
#pragma unroll
                        for (int e = 0; e < 4; ++e) { v0[e] = v0[e] * sigmoidf_(v0[e]); v1[e] = v1[e] * sigmoidf_(v1[e]); } }
                    u32x4 w; w.x = cvt_pk_bf16(v0[0], v0[1]); w.y = cvt_pk_bf16(v0[2], v0[3]); w.z = cvt_pk_bf16(v1[0], v1[1]); w.w = cvt_pk_bf16(v1[2], v1[3]);
                    *(u32x4*)(rowp + bj * HALFT) = w; } }
    }
};
struct PolOutProj {
    static constexpr bool PERM = true, GATHER = false, FP8 = false, ROWS = false;
    __device__ __forceinline__ void stage_rows(const Unit&, int) const {}
    __device__ __forceinline__ unsigned a_off_l(int, int) const { return 0u; }
    const bf16_t* A; const bf16_t* Bt; const float* x; const float* mod; bf16_t* O; TileOrder ord;
    __device__ __forceinline__ bool next(int i, Unit& u) const { return ord.tile(i, u.pm, u.pn); }
    __device__ __forceinline__ const char* a_base(const Unit& u) const { return (const char*)A + (size_t)u.pm * BM * GK * 2; }
    __device__ __forceinline__ unsigned a_off(const Unit&, int r) const { return (unsigned)r * GK * 2u; }
    __device__ __forceinline__ const char* b_base(const Unit& u) const { return (const char*)Bt + (size_t)u.pn * BM * GK * 2; }
    __device__ __forceinline__ void epi(const f32x4 (&acc)[2][2][4][2], const Unit& u, int wr, int wc, int fr, int fq, int par) const {
        const int row0 = u.pm * BM + wr * 64 + fr, col0 = u.pn * BM + wc * 32 + 8 * fq;
        const float* g1 = mod + (size_t)((u.pm * BM) >> 11) * 6144 + 2048 + col0;
        f32x4 gv[2][2];
#pragma unroll
        for (int bj = 0; bj < 2; ++bj) { gv[bj][0] = *(const f32x4*)(g1 + bj * HALFT); gv[bj][1] = *(const f32x4*)(g1 + bj * HALFT + 4); }
#pragma unroll
        for (int ai = 0; ai < 2; ++ai)
#pragma unroll
            for (int m = 0; m < 4; ++m) { const size_t off = (size_t)(row0 + ai * HALFT + m * 16) * D + col0;
#pragma unroll
                for (int bj = 0; bj < 2; ++bj) {
                    const f32x4 x0 = __builtin_nontemporal_load((const f32x4*)(x + off + bj * HALFT)), x1v = __builtin_nontemporal_load((const f32x4*)(x + off + bj * HALFT + 4));
                    const f32x4 v0 = x0 + gv[bj][0] * acc[ai][bj][m][0], v1 = x1v + gv[bj][1] * acc[ai][bj][m][1];
                    u32x4 w; w.x = cvt_pk_bf16(v0[0], v0[1]); w.y = cvt_pk_bf16(v0[2], v0[3]); w.z = cvt_pk_bf16(v1[0], v1[1]); w.w = cvt_pk_bf16(v1[2], v1[3]);
                    *(u32x4*)(O + off + bj * HALFT) = w; }
                asm volatile("" ::: "memory"); }
    }
};
struct MoeTiles {
    const LAS int* tstart; const u32* cnt; int half;
    __device__ __forceinline__ LAS u32* rows(int par) const { return (LAS u32*)((LAS unsigned char*)tstart + 8192) + par * 512; }
    __device__ __forceinline__ LAS float* bias(int par) const { return (LAS float*)((LAS unsigned char*)tstart + 12288) + par * 256; }
    __device__ __forceinline__ void stage_bias(int par, const float* src) const { if (threadIdx.x >= BM) bias(par)[threadIdx.x - BM] = src[0]; }
    __device__ __forceinline__ void stage(const Unit& u, int par, const u32* toktab, const float* wtab) const {
        if (threadIdx.x >= BM) { const int t = (int)threadIdx.x - BM, p = u.pos0 + t; const size_t tb = ((size_t)half * NE + u.e) * CAP; const bool ok = p < u.cn;
            const u32 tk = ok ? toktab[tb + p] : ~0u; const float wg = ok ? wtab[tb + p] : 0.f; LAS u32* rt = rows(par); rt[t * 2] = tk; rt[t * 2 + 1] = __float_as_uint(wg); }
    }
    __device__ __forceinline__ void find(Unit& u) const {
        const int e = __builtin_amdgcn_readfirstlane(tstart[64 + u.pm]);
        u.e = e; u.pos0 = (u.pm - __builtin_amdgcn_readfirstlane(tstart[e])) * BM; u.cn = (int)cnt[half * NE + e];
    }
};
struct PolGateUp {
    static constexpr bool PERM = true, GATHER = true, FP8 = true, ROWS = true;
    const fp8_t* A; const fp8_t* Bt; const float* bgu; const u32* toktab; const float* wtab; fp8_t* O; MoeTiles mt; TileOrder ord;
    __device__ __forceinline__ void stage_rows(const Unit& u, int par) const { mt.stage(u, par, toktab, wtab);
        const int c = (int)threadIdx.x - BM; mt.stage_bias(par, bgu + (size_t)u.e * 2048 + (c < HALFT ? u.pn * HALFT + c : 1024 + u.pn * HALFT + (c - HALFT))); }
    __device__ __forceinline__ unsigned a_off_l(int par, int r) const { const u32 tk = mt.rows(par)[r * 2]; return (tk == ~0u ? 0u : (tk >> 2)) * 1024u; }
    __device__ __forceinline__ bool next(int i, Unit& u) const { if (!ord.tile(i, u.pm, u.pn)) return false; mt.find(u); return true; }
    __device__ __forceinline__ const char* a_base(const Unit&) const { return (const char*)A; }
    __device__ __forceinline__ unsigned a_off(const Unit& u, int r) const {
        const int p = u.pos0 + r; const u32 tk = toktab[((size_t)mt.half * NE + u.e) * CAP + (p < u.cn ? p : 0)];
        return (tk >> 2) * 1024u;
    }
    __device__ __forceinline__ const char* b_base(const Unit& u) const { return (const char*)Bt + ((size_t)u.e * 2048 + (size_t)u.pn * BM) * 1024; }
    __device__ __forceinline__ void epi(const f32x4 (&acc)[2][2][4][2], const Unit& u, int wr, int wc, int fr, int fq, int par) const {
        const int row0 = u.pm * BM + wr * 64 + fr, cc = u.pn * HALFT + wc * 32 + 8 * fq;
        const LAS float* bt = mt.bias(par) + wc * 32 + 8 * fq;
        f32x4 bg[2], bu[2];
        bg[0] = *(const LAS f32x4*)bt; bg[1] = *(const LAS f32x4*)(bt + 4); bu[0] = *(const LAS f32x4*)(bt + HALFT); bu[1] = *(const LAS f32x4*)(bt + HALFT + 4);
        constexpr float inv = 1.0f / (SC_H2 * SC_W), kexp = -1.702f * 1.4426950408889634f;
        const f32x2 inv2 = (f32x2){inv, inv}, kexp2 = (f32x2){kexp, kexp}, one2 = (f32x2){1.0f, 1.0f}, sc2 = (f32x2){SC_ACT, SC_ACT};
#pragma unroll
        for (int ai = 0; ai < 2; ++ai)
#pragma unroll
            for (int m = 0; m < 4; ++m) {
                uint2 w;
#pragma unroll
                for (int n = 0; n < 2; ++n) {
                    int pk = 0;
#pragma unroll
                    for (int hh = 0; hh < 2; ++hh) {
                        const f32x4 ga4 = acc[ai][0][m][n], ua4 = acc[ai][1][m][n];
                        f32x2 g = (f32x2){ga4[2 * hh], ga4[2 * hh + 1]} * inv2 + (f32x2){bg[n][2 * hh], bg[n][2 * hh + 1]};
                        f32x2 uu = (f32x2){ua4[2 * hh], ua4[2 * hh + 1]} * inv2 + (f32x2){bu[n][2 * hh], bu[n][2 * hh + 1]};
                        g.x = fminf(g.x, 7.0f); g.y = fminf(g.y, 7.0f);
                        uu.x = __builtin_amdgcn_fmed3f(uu.x, -7.0f, 7.0f); uu.y = __builtin_amdgcn_fmed3f(uu.y, -7.0f, 7.0f);
                        const f32x2 t = g * kexp2;
                        const f32x2 d = (f32x2){__builtin_amdgcn_exp2f(t.x), __builtin_amdgcn_exp2f(t.y)} + one2;
                        const f32x2 r = (f32x2){frcp(d.x), frcp(d.y)};
                        const f32x2 o = (g * (uu * sc2 + sc2)) * r;
                        pk = hh ? __builtin_amdgcn_cvt_pk_fp8_f32(o.x, o.y, pk, true) : __builtin_amdgcn_cvt_pk_fp8_f32(o.x, o.y, pk, false);
                    }
                    if (n == 0) w.x = (unsigned)pk; else w.y = (unsigned)pk;
                }
                *(uint2*)(O + (size_t)(row0 + ai * HALFT + m * 16) * DFF + cc) = w;
                asm volatile("" ::: "memory");
            }
    }
};
struct PolDown {
    static constexpr bool PERM = true, GATHER = false, FP8 = true, ROWS = true;
    const fp8_t* A; const fp8_t* Bt; const float* bd; const u32* toktab; const float* wtab; fp8_t* O; MoeTiles mt; TileOrder ord;
    __device__ __forceinline__ void stage_rows(const Unit& u, int par) const { mt.stage(u, par, toktab, wtab); mt.stage_bias(par, bd + (size_t)u.e * D + u.pn * BM + ((int)threadIdx.x - BM)); }
    __device__ __forceinline__ unsigned a_off_l(int, int) const { return 0u; }
    __device__ __forceinline__ bool next(int i, Unit& u) const { if (!ord.tile(i, u.pm, u.pn)) return false; mt.find(u); return true; }
    __device__ __forceinline__ const char* a_base(const Unit& u) const { return (const char*)A + (size_t)u.pm * BM * 1024; }
    __device__ __forceinline__ unsigned a_off(const Unit&, int r) const { return (unsigned)r * 1024u; }
    __device__ __forceinline__ const char* b_base(const Unit& u) const { return (const char*)Bt + ((size_t)u.e * 1024 + (size_t)u.pn * BM) * 1024; }
    __device__ __forceinline__ void epi(const f32x4 (&acc)[2][2][4][2], const Unit& u, int wr, int wc, int fr, int fq, int par) const {
        const int col0 = u.pn * BM + wc * 32 + 8 * fq;
        const LAS float* bp = mt.bias(par) + wc * 32 + 8 * fq;
        f32x4 bv[2][2];
#pragma unroll
        for (int bj = 0; bj < 2; ++bj) { bv[bj][0] = *(const LAS f32x4*)(bp + bj * HALFT); bv[bj][1] = *(const LAS f32x4*)(bp + bj * HALFT + 4); }
        const LAS u32* rt = mt.rows(par);
        constexpr float inv = 1.0f / (SC_ACT * SC_W);
#pragma unroll
        for (int ai = 0; ai < 2; ++ai)
#pragma unroll
            for (int m = 0; m < 4; ++m) {
                const int rr = ai * HALFT + wr * 64 + m * 16 + fr;
                const u32 tk = rt[rr * 2];
                if (tk != ~0u) {
                    const float wg = __uint_as_float(rt[rr * 2 + 1]) * SC_Y;
                    fp8_t* rowp = O + (size_t)(tk - (u32)mt.half * HALF_TOK * 4u) * D + col0;
#pragma unroll
                    for (int bj = 0; bj < 2; ++bj) { const f32x4 v0 = (acc[ai][bj][m][0] * inv + bv[bj][0]) * wg, v1 = (acc[ai][bj][m][1] * inv + bv[bj][1]) * wg;
                        uint2 w; w.x = pk4_fp8(v0[0], v0[1], v0[2], v0[3]); w.y = pk4_fp8(v1[0], v1[1], v1[2], v1[3]);
                        *(uint2*)(rowp + bj * HALFT) = w; }
                }
            }
    }
};
__device__ __forceinline__ int moe_tile_table(LAS int* tstart, const u32* cnt, int half) {
    __syncthreads();
    if (threadIdx.x == 0) { int s = 0; for (int e = 0; e < NE; ++e) { tstart[e] = s; s += ((int)cnt[half * NE + e] + BM - 1) / BM; } tstart[NE] = s; }
    __syncthreads();
    const int tot = tstart[NE];
    for (int t = threadIdx.x; t < tot; t += 512) { int e = 0;
#pragma unroll 1
        for (int i = 1; i < NE; ++i) if (t >= tstart[i]) e = i;
        tstart[64 + t] = e; }
    __syncthreads();
    return tot;
}

__device__ __forceinline__ void conv_item(const float* __restrict__ W, int N, bf16_t* __restrict__ WT, int k0, int n0, size_t rowbase, LAS float* scr, int lane) {
#pragma unroll 4
    for (int i = 0; i < 16; ++i) { const int k = 4 * i + (lane >> 4); const f32x4 v = __builtin_nontemporal_load((const f32x4*)(W + (size_t)(k0 + k) * N + n0 + (lane & 15) * 4)); *(LAS f32x4*)(scr + k * 68 + (lane & 15) * 4) = v; }
    asm volatile("s_waitcnt lgkmcnt(0)" ::: "memory");
    const int c = lane & 7;
#pragma unroll
    for (int j = 0; j < 8; ++j) { const int n = (lane >> 3) + 8 * j; const LAS float* s = scr + (8 * c) * 68 + n;
        u32x4 o; o.x = cvt_pk_bf16(s[0 * 68], s[1 * 68]); o.y = cvt_pk_bf16(s[2 * 68], s[3 * 68]); o.z = cvt_pk_bf16(s[4 * 68], s[5 * 68]); o.w = cvt_pk_bf16(s[6 * 68], s[7 * 68]);
        *(u32x4*)(WT + (rowbase + n) * GK + k0 + 8 * c) = o; }
    asm volatile("s_waitcnt lgkmcnt(0)" ::: "memory");
}
__device__ __forceinline__ void conv_item8(const float* __restrict__ W, int N, fp8_t* __restrict__ WT, int k0, int n0, size_t rowbase, LAS float* scr, int lane) {
#pragma unroll 4
    for (int i = 0; i < 16; ++i) { const int k = 4 * i + (lane >> 4); const f32x4 v = __builtin_nontemporal_load((const f32x4*)(W + (size_t)(k0 + k) * N + n0 + (lane & 15) * 4)); *(LAS f32x4*)(scr + k * 68 + (lane & 15) * 4) = v; }
    asm volatile("s_waitcnt lgkmcnt(0)" ::: "memory");
    const LAS float* sp = scr + lane;
#pragma unroll
    for (int q = 0; q < 4; ++q) {
        u32x4 o;
        o.x = pk4_fp8(sp[(16 * q + 0) * 68] * SC_W, sp[(16 * q + 1) * 68] * SC_W, sp[(16 * q + 2) * 68] * SC_W, sp[(16 * q + 3) * 68] * SC_W);
        o.y = pk4_fp8(sp[(16 * q + 4) * 68] * SC_W, sp[(16 * q + 5) * 68] * SC_W, sp[(16 * q + 6) * 68] * SC_W, sp[(16 * q + 7) * 68] * SC_W);
        o.z = pk4_fp8(sp[(16 * q + 8) * 68] * SC_W, sp[(16 * q + 9) * 68] * SC_W, sp[(16 * q + 10) * 68] * SC_W, sp[(16 * q + 11) * 68] * SC_W);
        o.w = pk4_fp8(sp[(16 * q + 12) * 68] * SC_W, sp[(16 * q + 13) * 68] * SC_W, sp[(16 * q + 14) * 68] * SC_W, sp[(16 * q + 15) * 68] * SC_W);
        *(u32x4*)(WT + (rowbase + lane) * GK + k0 + 16 * q) = o;
    }
    asm volatile("s_waitcnt lgkmcnt(0)" ::: "memory");
}
constexpr int IT_IN = 16 * (INW / 64), IT_OUT = 16 * (D / 64), IT_GU = NE * 16 * 32, IT_D = NE * 16 * 16, IT_ALL = IT_IN + IT_OUT + IT_GU + IT_D;
struct ProArgs { const float *c, *c_ctx, *w_ada, *b_ada, *lbl, *w_in, *w_out, *wgu, *wd, *rg_wa, *rg_wx, *rg_lam; float *mod, *lb, *coef; bf16_t *Win_t, *Wout_t, *WG_t; fp8_t *Wgu_t, *Wd_t; };
__device__ __forceinline__ void phase_prologue(LAS unsigned char* lds, const ProArgs& a, int bid, int G, bool do_mod, int it_lo, int it_hi) {
    int tl_ = threadIdx.x; asm volatile("" : "+v"(tl_));
    const int tid = tl_, lane = tid & 63, w = tid >> 6;
    if (!do_mod) {} else if (bid < 96) {
        LAS float* s = (LAS float*)lds;
        for (int i = tid; i < 33 * D; i += 512) { const int b = i >> 10, k = i & 1023; const float v = b < NB ? a.c[(size_t)b * D + k] : a.c_ctx[k]; s[i] = v * sigmoidf_(v); }
        __syncthreads();
        const int n = bid * 64 + lane;
        float acc[33];
#pragma unroll
        for (int b = 0; b < 33; ++b) acc[b] = 0.f;
#pragma unroll 1
        for (int k = 128 * w; k < 128 * w + 128; k += 16) {
            float wv[16];
#pragma unroll
            for (int i = 0; i < 16; ++i) wv[i] = __builtin_nontemporal_load(a.w_ada + (size_t)(k + i) * 6144 + n);
#pragma unroll
            for (int b = 0; b < 33; ++b)
#pragma unroll
                for (int i4 = 0; i4 < 4; ++i4) { const f32x4 sv = *(const LAS f32x4*)(s + b * D + k + 4 * i4); acc[b] += sv[0] * wv[4 * i4] + sv[1] * wv[4 * i4 + 1] + sv[2] * wv[4 * i4 + 2] + sv[3] * wv[4 * i4 + 3]; }
        }
        __syncthreads();
        LAS float* red = (LAS float*)lds;
#pragma unroll
        for (int b = 0; b < 33; ++b) red[(w * 33 + b) * 64 + lane] = acc[b];
        __syncthreads();
        for (int i = tid; i < 33 * 64; i += 512) { const int b = i >> 6, l = i & 63; float sum = a.b_ada[bid * 64 + l];
#pragma unroll
            for (int ww = 0; ww < 8; ++ww) sum += red[(ww * 33 + b) * 64 + l];
            a.mod[(size_t)b * 6144 + bid * 64 + l] = sum; }
        __syncthreads();
    } else if (bid == 96) {
        for (int i = tid; i < 2 * HGW; i += 512) { const float l0 = a.lbl[i], l1 = a.lbl[2 * HGW + i]; a.lb[i] = 1.0f / (1.0f + __expf(l1 - l0)); }
        for (int i = tid; i < 2 * RGW; i += 512) { const float l = a.rg_lam[i]; const float sp = (-l > 20.f) ? -l : log1pf(__expf(-l)); a.coef[i] = -8.0f * sp; }
    } else if (bid == 97) {
        for (int idx = tid; idx < 8 * 256 * 64; idx += 512) { const int hd = idx >> 14, n = (idx >> 6) & 255, kk = idx & 63, g = n >> 6, j = n & 63, d = g >> 1;
            const float* src = (g & 1) ? a.rg_wx : a.rg_wa; a.WG_t[idx] = f2bf(src[(((size_t)d * 8 + hd) * 64 + kk) * 64 + j]); }
    }
    LAS float* scr = (LAS float*)(lds + w * (64 * 68 * 4));
    const int gw = bid * 8 + w, NW = G * 8;
    for (int it = it_lo + gw; it < it_hi; it += NW) {
        int r = it;
        if (r < IT_IN) { const int kb = r / (INW / 64), nb = r % (INW / 64); conv_item(a.w_in, INW, a.Win_t, kb * 64, nb * 64, (size_t)nb * 64, scr, lane); continue; } r -= IT_IN;
        if (r < IT_OUT) { const int kb = r / 16, nb = r % 16; conv_item(a.w_out, D, a.Wout_t, kb * 64, nb * 64, (size_t)nb * 64, scr, lane); continue; } r -= IT_OUT;
        if (r < IT_GU) { const int e = r / 512, q = r % 512, kb = q / 32, nb = q % 32, n0 = nb * 64, bj = n0 >> 10, rem = n0 & 1023, pn = rem >> 7, cc0 = rem & 127;
            conv_item8(a.wgu + (size_t)e * D * 2048, 2048, a.Wgu_t, kb * 64, n0, (size_t)e * 2048 + pn * 256 + bj * 128 + cc0, scr, lane); continue; } r -= IT_GU;
        { const int e = r / 256, q = r % 256, kb = q / 16, nb = q % 16; conv_item8(a.wd + (size_t)e * DFF * D, D, a.Wd_t, kb * 64, nb * 64, (size_t)e * 1024 + nb * 64, scr, lane); }
    }
}


__device__ __forceinline__ void phase_norm1(const float* __restrict__ x, const float* __restrict__ ctx, const float* __restrict__ nw, const float* __restrict__ mod, bf16_t* __restrict__ H, int bid, int G) {
    constexpr int RB = 4;
    int tl_ = threadIdx.x; asm volatile("" : "+v"(tl_));
    const int lane = tl_ & 63, gw = bid * 8 + (tl_ >> 6), NW = G * 8;
    for (int r0 = gw; r0 < NROWS; r0 += RB * NW) {
        f32x4 v[RB][4];
#pragma unroll
        for (int q = 0; q < RB; ++q) { const int r = r0 + q * NW; const int rr = r < NROWS ? r : r0;
            const float* src = rr < NLAT ? x + (size_t)rr * D : ctx + (size_t)(rr - NLAT) * D;
#pragma unroll
            for (int j = 0; j < 4; ++j) v[q][j] = __builtin_nontemporal_load((const f32x4*)(src + j * 256 + lane * 4)); }
#pragma unroll
        for (int q = 0; q < RB; ++q) { const int r = r0 + q * NW; if (r < NROWS) {
            const float* m = mod + (size_t)(r < NLAT ? (r >> 11) : NB) * 6144;
            float ss = 0.f;
#pragma unroll
            for (int j = 0; j < 4; ++j) ss += v[q][j][0] * v[q][j][0] + v[q][j][1] * v[q][j][1] + v[q][j][2] * v[q][j][2] + v[q][j][3] * v[q][j][3];
            const float rstd = __builtin_amdgcn_rsqf(wave_sum(ss) * (1.0f / D) + EPS);
#pragma unroll
            for (int j = 0; j < 4; ++j) {
                const int c0 = j * 256 + lane * 4;
                const f32x4 w = *(const f32x4*)(nw + c0), sh = *(const f32x4*)(m + c0), sc = *(const f32x4*)(m + 1024 + c0);
                const f32x4 o = v[q][j] * rstd * w * (sc + 1.0f) + sh;
                uint2 p; p.x = cvt_pk_bf16(o[0], o[1]); p.y = cvt_pk_bf16(o[2], o[3]);
                *(uint2*)(H + (size_t)r * D + c0) = p;
            } } }
    }
}

__device__ __forceinline__ bf16x8 pack8(const f32x4& a, const f32x4& b) {
    u32x4 w; w.x = cvt_pk_bf16(a[0], a[1]); w.y = cvt_pk_bf16(a[2], a[3]); w.z = cvt_pk_bf16(b[0], b[1]); w.w = cvt_pk_bf16(b[2], b[3]);
    return __builtin_bit_cast(bf16x8, w);
}
constexpr int HW_BUF = 45056;
constexpr int HW_QD = 0, HW_KET = 17408, HW_PM = 35840;
constexpr int HW_VT = 2 * HW_BUF, HW_KD = HW_VT + 18432, HW_OS = HW_KD + 17408, HW_TOT = HW_OS + 17408, HW_DEC = HW_TOT + 2048;
__device__ __forceinline__ void phase_hgrn2_ws(LAS unsigned char* lds, const bf16_t* __restrict__ P, const float* __restrict__ lb, bf16_t* __restrict__ OF, bf16_t* __restrict__ OB, int item) {
    const int b = item >> 3, h = (item >> 1) & 3, dir = item & 1;
    const int tid = threadIdx.x, w = __builtin_amdgcn_readfirstlane(tid >> 6), lane = tid & 63, l15 = lane & 15, G4 = lane >> 4;
    bf16_t* OD = dir ? OB : OF;
    const int cf = dir ? C_FB : C_FF;
    constexpr int NC = (CTXL + T) / 64;
    LAS float* TOT = (LAS float*)(lds + HW_TOT);
#define HW_BAR() do { asm volatile("s_waitcnt lgkmcnt(0)" ::: "memory"); __builtin_amdgcn_s_barrier(); asm volatile("" ::: "memory"); } while (0)
    __syncthreads();
    if (w >= 4) {
        const int et = tid - 256, kp = et & 63, k = 2 * kp, seg = et >> 6, ew = w - 4;
        const int kslot = (k & ~31) | (((k >> 2) & 3) << 3) | (((k >> 4) & 1) << 2) | (k & 3);
        const float lb0 = lb[dir * HGW + h * 128 + k], lb1 = lb[dir * HGW + h * 128 + k + 1];
        const char* Pc = (const char*)P; const int sstep = dir ? -(INW * 2) : INW * 2;
#define HW_OFF0(m_) ({ const int p_ = 64 * (m_) + 16 * seg; const unsigned r_ = p_ < CTXL ? (unsigned)(NLAT + b * CTXL + (dir ? CTXL - 1 - p_ : p_)) : (unsigned)(b * T + (dir ? T - 1 - (p_ - CTXL) : (p_ - CTXL))); (r_ * (unsigned)INW + (unsigned)(h * 128 + k)) * 2u; })
#define HW_LD(off0_, i_, col_) (*(const u32*)(Pc + (unsigned)((int)(off0_) + (i_) * sstep + (col_) * 2)))
#define BF_LO(w_) __uint_as_float((w_) << 16)
#define BF_HI(w_) __uint_as_float((w_) & 0xffff0000u)
        u32 rf[16];
        { const unsigned o0 = HW_OFF0(0);
#pragma unroll
        for (int i = 0; i < 16; ++i) rf[i] = HW_LD(o0, i, cf); }
#pragma unroll 1
        for (int m = 0; m < NC + 1; ++m) {
            const int par = m & 1;
            LAS unsigned char* buf = lds + par * HW_BUF;
            HW_BAR();
            u32 rq[16], rv[16]; float f0v[16], f1v[16], c0v[16], c1v[16]; float run0 = 1.f, run1 = 1.f;
            if (m < NC) {
                const unsigned o0 = HW_OFF0(m);
#pragma unroll
                for (int i = 0; i < 16; ++i) { rq[i] = HW_LD(o0, i, C_Q); rv[i] = HW_LD(o0, i, C_I); }
#pragma unroll
                for (int i = 0; i < 16; ++i) { const float f0 = lb0 + (1.f - lb0) * sigmoidf_(BF_LO(rf[i])), f1 = lb1 + (1.f - lb1) * sigmoidf_(BF_HI(rf[i]));
                    f0v[i] = f0; f1v[i] = f1; run0 *= f0; run1 *= f1; c0v[i] = run0; c1v[i] = run1; }
                *(LAS f32x2*)(TOT + seg * 128 + k) = (f32x2){run0, run1};
                if (m + 1 < NC) { const unsigned o1 = HW_OFF0(m + 1);
#pragma unroll
                    for (int i = 0; i < 16; ++i) rf[i] = HW_LD(o1, i, cf); }
            }
            HW_BAR();
            if (m < NC) {
                f32x2 tt[4];
#pragma unroll
                for (int q = 0; q < 4; ++q) tt[q] = *(const LAS f32x2*)(TOT + q * 128 + k);
                const float p0 = seg == 0 ? 1.f : seg == 1 ? tt[0].x : seg == 2 ? tt[0].x * tt[1].x : tt[0].x * tt[1].x * tt[2].x;
                const float p1 = seg == 0 ? 1.f : seg == 1 ? tt[0].y : seg == 2 ? tt[0].y * tt[1].y : tt[0].y * tt[1].y * tt[2].y;
                const float eb0 = (tt[0].x * tt[1].x) * (tt[2].x * tt[3].x), eb1 = (tt[0].y * tt[1].y) * (tt[2].y * tt[3].y);
                if (seg == 0) *(LAS f32x2*)(lds + HW_DEC + par * 512 + k * 4) = (f32x2){eb0, eb1};
                float ke0[16], ke1[16];
#pragma unroll
                for (int i = 0; i < 16; ++i) {
                    const int j = 16 * seg + i;
                    const float e0 = p0 * c0v[i], e1 = p1 * c1v[i];
                    const float kf0 = (1.f - f0v[i]) * frcp(e0), kf1 = (1.f - f1v[i]) * frcp(e1);
                    *(LAS u32*)(buf + HW_QD + j * 272 + kslot * 2) = cvt_pk_bf16(BF_LO(rq[i]) * e0, BF_HI(rq[i]) * e1);
                    *(LAS u32*)(lds + HW_KD + j * 272 + kslot * 2) = cvt_pk_bf16(kf0, kf1);
                    ke0[i] = kf0 * eb0; ke1[i] = kf1 * eb1;
                }
#pragma unroll
                for (int q4 = 0; q4 < 2; ++q4) {
                    u32x4 a0, a1, v0, v1;
#pragma unroll
                    for (int i = 0; i < 4; ++i) { const int t = 8 * q4 + 2 * i;
                        a0[i] = cvt_pk_bf16(ke0[t], ke0[t + 1]); a1[i] = cvt_pk_bf16(ke1[t], ke1[t + 1]);
                        v0[i] = (rv[t] & 0xffffu) | (rv[t + 1] << 16); v1[i] = (rv[t] >> 16) | (rv[t + 1] & 0xffff0000u); }
                    *(LAS u32x4*)(buf + HW_KET + k * 144 + seg * 32 + q4 * 16) = a0; *(LAS u32x4*)(buf + HW_KET + (k + 1) * 144 + seg * 32 + q4 * 16) = a1;
                    *(LAS u32x4*)(lds + HW_VT + k * 144 + seg * 32 + q4 * 16) = v0; *(LAS u32x4*)(lds + HW_VT + (k + 1) * 144 + seg * 32 + q4 * 16) = v1;
                }
            }
            HW_BAR();
            if (m < NC && m >= CTXL / 64) {
                const int mt = ew;
                f32x4 pa[4];
#pragma unroll
                for (int q = 0; q < 4; ++q) pa[q] = (f32x4){0.f, 0.f, 0.f, 0.f};
#pragma unroll
                for (int s = 0; s < 4; ++s) {
                    const bf16x8 a = *(const LAS bf16x8*)(buf + HW_QD + (16 * mt + l15) * 272 + (32 * s + 8 * G4) * 2);
#pragma unroll
                    for (int q = 0; q < 4; ++q) { const bf16x8 bq = *(const LAS bf16x8*)(lds + HW_KD + (16 * q + l15) * 272 + (32 * s + 8 * G4) * 2); pa[q] = __builtin_amdgcn_mfma_f32_16x16x32_bf16(a, bq, pa[q], 0, 0, 0); }
                }
#pragma unroll
                for (int q = 0; q < 4; ++q)
#pragma unroll
                    for (int r = 0; r < 4; ++r) { const int c = 16 * mt + 4 * G4 + r, j = 16 * q + l15; *(LAS bf16_t*)(buf + HW_PM + c * 144 + j * 2) = f2bf(j <= c ? pa[q][r] : 0.f); }
                asm volatile("s_waitcnt lgkmcnt(0)" ::: "memory");
            }
        }
#undef HW_OFF0
#undef HW_LD
#undef BF_LO
#undef BF_HI
    } else {
        f32x4 S[8][2];
#pragma unroll
        for (int t = 0; t < 8; ++t) { S[t][0] = (f32x4){0.f, 0.f, 0.f, 0.f}; S[t][1] = (f32x4){0.f, 0.f, 0.f, 0.f}; }
        HW_BAR(); HW_BAR(); HW_BAR();
#pragma unroll 1
        for (int n = 0; n < NC; ++n) {
            const int par = n & 1; const bool lat = n >= CTXL / 64;
            LAS unsigned char* buf = lds + par * HW_BUF;
            HW_BAR();
            bf16x8 vb[2][2];
#pragma unroll
            for (int nt = 0; nt < 2; ++nt)
#pragma unroll
                for (int s = 0; s < 2; ++s) vb[nt][s] = *(const LAS bf16x8*)(lds + HW_VT + (32 * w + 16 * nt + l15) * 144 + (32 * s + 8 * G4) * 2);
            HW_BAR();
            if (lat) {
                bf16x8 sb[2][4];
#pragma unroll
                for (int nt = 0; nt < 2; ++nt)
#pragma unroll
                    for (int s = 0; s < 4; ++s) sb[nt][s] = pack8(S[2 * s][nt], S[2 * s + 1][nt]);
#pragma unroll
                for (int mt = 0; mt < 4; ++mt) {
                    f32x4 oa[2] = {(f32x4){0.f, 0.f, 0.f, 0.f}, (f32x4){0.f, 0.f, 0.f, 0.f}};
#pragma unroll
                    for (int s = 0; s < 2; ++s) { const bf16x8 a = *(const LAS bf16x8*)(buf + HW_PM + (16 * mt + l15) * 144 + (32 * s + 8 * G4) * 2);
                        oa[0] = __builtin_amdgcn_mfma_f32_16x16x32_bf16(a, vb[0][s], oa[0], 0, 0, 0); oa[1] = __builtin_amdgcn_mfma_f32_16x16x32_bf16(a, vb[1][s], oa[1], 0, 0, 0); }
#pragma unroll
                    for (int s = 0; s < 4; ++s) { const bf16x8 a = *(const LAS bf16x8*)(buf + HW_QD + (16 * mt + l15) * 272 + (32 * s + 8 * G4) * 2);
                        oa[0] = __builtin_amdgcn_mfma_f32_16x16x32_bf16(a, sb[0][s], oa[0], 0, 0, 0); oa[1] = __builtin_amdgcn_mfma_f32_16x16x32_bf16(a, sb[1][s], oa[1], 0, 0, 0); }
#pragma unroll
                    for (int nt = 0; nt < 2; ++nt)
#pragma unroll
                        for (int r = 0; r < 4; ++r) *(LAS bf16_t*)(lds + HW_OS + (16 * mt + 4 * G4 + r) * 272 + (32 * w + 16 * nt + l15) * 2) = f2bf(oa[nt][r]);
                }
            }
#pragma unroll
            for (int t = 0; t < 8; ++t) {
                const f32x4 d4 = *(const LAS f32x4*)(lds + HW_DEC + par * 512 + (16 * t + 4 * G4) * 4);
                S[t][0] = S[t][0] * d4; S[t][1] = S[t][1] * d4;
#pragma unroll
                for (int s = 0; s < 2; ++s) { const bf16x8 a = *(const LAS bf16x8*)(buf + HW_KET + (16 * t + l15) * 144 + (32 * s + 8 * G4) * 2);
                    S[t][0] = __builtin_amdgcn_mfma_f32_16x16x32_bf16(a, vb[0][s], S[t][0], 0, 0, 0); S[t][1] = __builtin_amdgcn_mfma_f32_16x16x32_bf16(a, vb[1][s], S[t][1], 0, 0, 0); }
            }
            HW_BAR();
            if (lat) {
                const int j = tid >> 2, part = tid & 3, p = 64 * n + j, tt = dir ? T - 1 - (p - CTXL) : (p - CTXL);
                bf16_t* dst = OD + ((size_t)b * T + tt) * HGW + h * 128 + part * 32;
#pragma unroll
                for (int q = 0; q < 4; ++q) *(u32x4*)(dst + q * 8) = *(const LAS u32x4*)(lds + HW_OS + j * 272 + part * 64 + q * 16);
            }
        }
    }
    __syncthreads();
#undef HW_BAR
}

__device__ __forceinline__ size_t rg_row(int b, bool lat, int p) {
    return lat ? (size_t)b * T + (size_t)(p % GROWS) * GRIDW + (p / GROWS) : (size_t)NLAT + b * CTXL + p;
}
constexpr int RC_T = 64 * 144;
constexpr int RC_XC = 0, RC_RG = 2 * RC_T, RC_HI = 4 * RC_T, RC_OUT = 6 * RC_T;
__device__ __forceinline__ void phase_rg_chain(LAS unsigned char* lds, const bf16_t* __restrict__ P, const float* __restrict__ conv_w, const float* __restrict__ conv_b, const bf16_t* __restrict__ WG_t,
                                               const float* __restrict__ ba, const float* __restrict__ bx, const float* __restrict__ coef, bf16_t* __restrict__ HT, bf16_t* __restrict__ MIX, int item) {
    const int b = item >> 3, hd = item & 7;
    const int tid = threadIdx.x, w = __builtin_amdgcn_readfirstlane(tid >> 6), lane = tid & 63, l15 = lane & 15, G4 = lane >> 4;
    const int d = w >> 2, cg = w & 3, ch = 64 * hd + 16 * cg + l15;
    const int ds = tid >> 8, t8 = tid & 255, pg = t8 >> 4, cg4 = t8 & 15;
    bf16x8 F[4];
#pragma unroll
    for (int s = 0; s < 2; ++s) {
        F[s] = *(const bf16x8*)(WG_t + ((size_t)(hd * 256 + 64 * (2 * d) + 16 * cg + l15) * 64 + 32 * s + 8 * G4));
        F[2 + s] = *(const bf16x8*)(WG_t + ((size_t)(hd * 256 + 64 * (2 * d + 1) + 16 * cg + l15) * 64 + 32 * s + 8 * G4)); }
    const float bav = ba[d * RGW + ch], bxv = bx[d * RGW + ch], cf = coef[d * RGW + ch];
    const f32x4 cw0 = *(const f32x4*)(conv_w + 0 * RGW + 64 * hd + 4 * cg4), cw1 = *(const f32x4*)(conv_w + 1 * RGW + 64 * hd + 4 * cg4), cw2 = *(const f32x4*)(conv_w + 2 * RGW + 64 * hd + 4 * cg4),
                cw3 = *(const f32x4*)(conv_w + 3 * RGW + 64 * hd + 4 * cg4), cb4 = *(const f32x4*)(conv_b + 64 * hd + 4 * cg4);
    float hcar = 0.f;
#define RC_CHUNK(dd, s_) ((dd) == 0 ? (s_) : ((s_) < CTXL / 64 ? CTXL / 64 - 1 - (s_) : NCHK + CTXL / 64 - 1 - (s_)))
    u32x2 rxr[7]; u32x4 rgr[2], hir[2];
#define RC_LOAD_RX(s_) do { const int n_ = RC_CHUNK(ds, s_); const bool lat_ = n_ >= CTXL / 64; const int L_ = lat_ ? T : CTXL, p0_ = 64 * (lat_ ? n_ - CTXL / 64 : n_); \
        _Pragma("unroll") for (int i = 0; i < 7; ++i) { const int p = p0_ + 4 * pg - 2 + i; rxr[i] = (p >= 0 && p < L_) ? *(const u32x2*)(P + rg_row(b, lat_, p) * INW + C_RX + 64 * hd + 4 * cg4) : (u32x2){0u, 0u}; } } while (0)
#define RC_ROW(s_, q_) (rg_row(b, true, 64 * (RC_CHUNK(ds, s_) - CTXL / 64) + ((q_) >> 3)))
#define RC_LOAD_RG(s_) do { _Pragma("unroll") for (int j = 0; j < 2; ++j) { const int q = t8 * 2 + j; rgr[j] = *(const u32x4*)(P + RC_ROW(s_, q) * INW + C_RG + 64 * hd + (q & 7) * 8); } } while (0)
#define RC_LOAD_HI(s_) do { _Pragma("unroll") for (int j = 0; j < 2; ++j) { const int q = t8 * 2 + j; rgr[j] = rgr[j]; hir[j] = __builtin_nontemporal_load((const u32x4*)(HT + RC_ROW(s_, q) * RGW + 64 * hd + (q & 7) * 8)); } } while (0)
    RC_LOAD_RX(0);
#pragma unroll 1
    for (int s = 0; s < NCHK; ++s) {
        const int role = s < CTXL / 64 ? 0 : (s < 20 ? 1 : 2);
        if (s == 20) { asm volatile("s_waitcnt vmcnt(0)" ::: "memory"); __syncthreads(); RC_LOAD_RG(20); RC_LOAD_HI(20); }
        {
            float xin[7][4];
#pragma unroll
            for (int i = 0; i < 7; ++i) { xin[i][0] = __uint_as_float(rxr[i].x << 16); xin[i][1] = __uint_as_float(rxr[i].x & 0xffff0000u); xin[i][2] = __uint_as_float(rxr[i].y << 16); xin[i][3] = __uint_as_float(rxr[i].y & 0xffff0000u); }
#pragma unroll
            for (int q = 0; q < 4; ++q) {
                float o[4];
#pragma unroll
                for (int c = 0; c < 4; ++c) o[c] = cb4[c] + cw0[c] * xin[q][c] + cw1[c] * xin[q + 1][c] + cw2[c] * xin[q + 2][c] + cw3[c] * xin[q + 3][c];
                *(LAS unsigned long long*)(lds + RC_XC + ds * RC_T + (4 * pg + q) * 144 + cg4 * 8) = ((unsigned long long)cvt_pk_bf16(o[2], o[3]) << 32) | cvt_pk_bf16(o[0], o[1]);
            }
            if (role == 2) {
#pragma unroll
                for (int j = 0; j < 2; ++j) { const int q = t8 * 2 + j; *(LAS u32x4*)(lds + RC_RG + ds * RC_T + (q >> 3) * 144 + (q & 7) * 16) = rgr[j]; *(LAS u32x4*)(lds + RC_HI + ds * RC_T + (q >> 3) * 144 + (q & 7) * 16) = hir[j]; }
            }
        }
        __syncthreads();
        if (s + 1 < NCHK) { RC_LOAD_RX(s + 1); if (s + 1 > 20) { RC_LOAD_RG(s + 1); RC_LOAD_HI(s + 1); } }
        {
            bf16x8 af[4][2];
#pragma unroll
            for (int mt = 0; mt < 4; ++mt)
#pragma unroll
                for (int k = 0; k < 2; ++k) af[mt][k] = *(const LAS bf16x8*)(lds + RC_XC + d * RC_T + (16 * (l15 >> 2) + 4 * mt + (l15 & 3)) * 144 + (32 * k + 8 * G4) * 2);
            f32x4 ra[4], xa[4];
#pragma unroll
            for (int mt = 0; mt < 4; ++mt) { ra[mt] = (f32x4){0.f, 0.f, 0.f, 0.f}; xa[mt] = (f32x4){0.f, 0.f, 0.f, 0.f};
#pragma unroll
                for (int k = 0; k < 2; ++k) { ra[mt] = __builtin_amdgcn_mfma_f32_16x16x32_bf16(af[mt][k], F[k], ra[mt], 0, 0, 0); xa[mt] = __builtin_amdgcn_mfma_f32_16x16x32_bf16(af[mt][k], F[2 + k], xa[mt], 0, 0, 0); } }
            float av[16], bv[16];
#pragma unroll
            for (int t = 0; t < 16; ++t) {
                const float r = sigmoidf_(ra[t >> 2][t & 3] + bav), ig = sigmoidf_(xa[t >> 2][t & 3] + bxv);
                const float a = fexp(cf * r);
                av[t] = a; bv[t] = fsqrt(fmaxf(1.0f - a * a, 0.f)) * ig * bf2f(*(const LAS bf16_t*)(lds + RC_XC + d * RC_T + (16 * G4 + t) * 144 + (16 * cg + l15) * 2));
            }
            float Al = 1.f, Bl = 0.f;
            if (d == 0) {
#pragma unroll
                for (int t = 0; t < 16; ++t) { Bl = av[t] * Bl + bv[t]; Al *= av[t]; }
            } else {
#pragma unroll
                for (int t = 15; t >= 0; --t) { Bl = av[t] * Bl + bv[t]; Al *= av[t]; }
            }
            float Ag[4], Bg[4];
#pragma unroll
            for (int g = 0; g < 4; ++g) { Ag[g] = __shfl(Al, l15 + 16 * g); Bg[g] = __shfl(Bl, l15 + 16 * g); }
            float h = hcar, hend;
            if (d == 0) {
                const float s1 = Ag[0] * h + Bg[0], s2 = Ag[1] * s1 + Bg[1], s3 = Ag[2] * s2 + Bg[2]; hend = Ag[3] * s3 + Bg[3];
                h = G4 == 0 ? h : G4 == 1 ? s1 : G4 == 2 ? s2 : s3;
            } else {
                const float s2 = Ag[3] * h + Bg[3], s1 = Ag[2] * s2 + Bg[2], s0 = Ag[1] * s1 + Bg[1]; hend = Ag[0] * s0 + Bg[0];
                h = G4 == 3 ? h : G4 == 2 ? s2 : G4 == 1 ? s1 : s0;
            }
            hcar = hend;
            if (role != 0) {
                float hv[16];
                if (d == 0) {
#pragma unroll
                    for (int t = 0; t < 16; ++t) { h = av[t] * h + bv[t]; hv[t] = h; }
                } else {
#pragma unroll
                    for (int t = 15; t >= 0; --t) { h = av[t] * h + bv[t]; hv[t] = h; }
                }
#pragma unroll
                for (int t = 0; t < 16; ++t) {
                    const int off = (16 * G4 + t) * 144 + (16 * cg + l15) * 2;
                    float o = hv[t];
                    if (role == 2) o = gelu_tanh(bf2f(*(const LAS bf16_t*)(lds + RC_RG + d * RC_T + off))) * (o + bf2f(*(const LAS bf16_t*)(lds + RC_HI + d * RC_T + off)));
                    *(LAS bf16_t*)(lds + RC_OUT + d * RC_T + off) = f2bf(o);
                }
            }
        }
        __syncthreads();
        if (role != 0) {
#pragma unroll
            for (int j = 0; j < 2; ++j) { const int q = t8 * 2 + j; const u32x4 v = *(const LAS u32x4*)(lds + RC_OUT + ds * RC_T + (q >> 3) * 144 + (q & 7) * 16);
                if (role == 1) *(u32x4*)(HT + RC_ROW(s, q) * RGW + 64 * hd + (q & 7) * 8) = v;
                else *(u32x4*)(MIX + RC_ROW(s, q) * D + HGW + 64 * hd + (q & 7) * 8) = v; }
        }
    }
#undef RC_CHUNK
#undef RC_LOAD_RX
#undef RC_ROW
#undef RC_LOAD_RG
#undef RC_LOAD_HI
}

__device__ __forceinline__ void phase_mix_finish(const bf16_t* __restrict__ P, const bf16_t* __restrict__ OF, const bf16_t* __restrict__ OB,
                                                 const float* __restrict__ hg_nw, bf16_t* __restrict__ MIX, int bid, int G) {
    constexpr int RB = 4;
    int tl_ = threadIdx.x; asm volatile("" : "+v"(tl_));
    const int lane = tl_ & 63, gw = bid * 8 + (tl_ >> 6), NW = G * 8, c0 = lane * 8;
    const f32x4 nw0 = *(const f32x4*)(hg_nw + c0), nw1 = *(const f32x4*)(hg_nw + c0 + 4);
    const float nwv[8] = {nw0[0], nw0[1], nw0[2], nw0[3], nw1[0], nw1[1], nw1[2], nw1[3]};
    for (int r0 = gw; r0 < NLAT; r0 += RB * NW) {
        u32x4 a4[RB], b4[RB], g4[RB];
#pragma unroll
        for (int q = 0; q < RB; ++q) { const int r = r0 + q * NW; const int rr = r < NLAT ? r : r0;
            a4[q] = *(const u32x4*)(OF + (size_t)rr * HGW + c0); b4[q] = *(const u32x4*)(OB + (size_t)rr * HGW + c0); g4[q] = *(const u32x4*)(P + (size_t)rr * INW + C_G + c0); }
#pragma unroll
        for (int q = 0; q < RB; ++q) { const int r = r0 + q * NW; if (r < NLAT) {
            float o[8]; float ss = 0.f;
#pragma unroll
            for (int i = 0; i < 4; ++i) { o[2 * i] = __uint_as_float(a4[q][i] << 16) + __uint_as_float(b4[q][i] << 16); o[2 * i + 1] = __uint_as_float(a4[q][i] & 0xffff0000u) + __uint_as_float(b4[q][i] & 0xffff0000u); }
#pragma unroll
            for (int i = 0; i < 8; ++i) ss += o[i] * o[i];
            ss += __shfl_xor(ss, 1); ss += __shfl_xor(ss, 2); ss += __shfl_xor(ss, 4); ss += __shfl_xor(ss, 8);
            const float rstd = __builtin_amdgcn_rsqf(ss * (1.0f / 128.0f) + EPS);
            u32x4 w;
#pragma unroll
            for (int i = 0; i < 4; ++i) {
                const float g0 = __uint_as_float(g4[q][i] << 16), g1 = __uint_as_float(g4[q][i] & 0xffff0000u);
                w[i] = cvt_pk_bf16(o[2 * i] * rstd * nwv[2 * i] * (g0 * sigmoidf_(g0)), o[2 * i + 1] * rstd * nwv[2 * i + 1] * (g1 * sigmoidf_(g1)));
            }
            *(u32x4*)(MIX + (size_t)r * D + c0) = w;
        } }
    }
}

__device__ __forceinline__ void phase_norm2_route(LAS unsigned char* lds, const bf16_t* __restrict__ x1, const float* __restrict__ nw, const float* __restrict__ mod,
                                                  const float* __restrict__ rw, const float* __restrict__ rb, fp8_t* __restrict__ H2,
                                                  u32* __restrict__ cnt, u32* __restrict__ toktab, float* __restrict__ wtab, int bid, int G) {
    LAS float* rwT = (LAS float*)lds;
    LAS u32* hist = (LAS u32*)(lds + 131072);
    LAS u32* ent = (LAS u32*)(lds + 131072 + 4096);
    int tl_ = threadIdx.x; asm volatile("" : "+v"(tl_));
    const int tid = tl_, lane = tid & 63, w = tid >> 6;
    for (int i = tid; i < 32 * 1024; i += 512) { const int k = i >> 5, e = i & 31; rwT[e * 1024 + k] = rw[i]; }
    if (tid < 128) hist[tid] = 0;
    __syncthreads();
    const int gw = bid * 8 + w, NW = G * 8;
    const int myexp = ((lane >> 5) & 1) * 16 + ((lane >> 4) & 1) * 8 + ((lane >> 3) & 1) * 4 + ((lane >> 2) & 1) * 2 + ((lane >> 1) & 1);
    const float myrb = rb[myexp];
    int it = 0;
    u32x2 rawn[2][4];
#pragma unroll
    for (int q = 0; q < 2; ++q)
#pragma unroll
        for (int j = 0; j < 4; ++j) rawn[q][j] = __builtin_nontemporal_load((const u32x2*)(x1 + (size_t)(gw + q * NW) * D + j * 256 + lane * 4));
    for (int r0 = gw; r0 < NLAT; r0 += 2 * NW, it += 2) {
        f32x4 v[2][4];
        u32x2 rawc[2][4];
#pragma unroll
        for (int q = 0; q < 2; ++q)
#pragma unroll
            for (int j = 0; j < 4; ++j) rawc[q][j] = rawn[q][j];
        { const int rn0 = r0 + 2 * NW < NLAT ? r0 + 2 * NW : r0;
#pragma unroll
          for (int q = 0; q < 2; ++q)
#pragma unroll
            for (int j = 0; j < 4; ++j) rawn[q][j] = __builtin_nontemporal_load((const u32x2*)(x1 + (size_t)(rn0 + q * NW) * D + j * 256 + lane * 4)); }
#pragma unroll
        for (int q = 0; q < 2; ++q) {
            const int r = r0 + q * NW;
            const float* m = mod + (size_t)(r >> 11) * 6144;
            u32x2 raw[4];
#pragma unroll
            for (int j = 0; j < 4; ++j) raw[j] = rawc[q][j];
            float ss = 0.f;
#pragma unroll
            for (int j = 0; j < 4; ++j) { v[q][j][0] = __uint_as_float(raw[j].x << 16); v[q][j][1] = __uint_as_float(raw[j].x & 0xffff0000u); v[q][j][2] = __uint_as_float(raw[j].y << 16); v[q][j][3] = __uint_as_float(raw[j].y & 0xffff0000u);
                ss += v[q][j][0] * v[q][j][0] + v[q][j][1] * v[q][j][1] + v[q][j][2] * v[q][j][2] + v[q][j][3] * v[q][j][3]; }
            const float rstd = __builtin_amdgcn_rsqf(wave_sum(ss) * (1.0f / D) + EPS);
#pragma unroll
            for (int j = 0; j < 4; ++j) {
                const int c0 = j * 256 + lane * 4;
                const f32x4 ww = *(const f32x4*)(nw + c0), sh = *(const f32x4*)(m + 3072 + c0), sc = *(const f32x4*)(m + 4096 + c0);
                v[q][j] = v[q][j] * rstd * ww * (sc + 1.0f) + sh;
                *(unsigned*)(H2 + (size_t)r * D + c0) = pk4_fp8(v[q][j][0] * SC_H2, v[q][j][1] * SC_H2, v[q][j][2] * SC_H2, v[q][j][3] * SC_H2);
            }
        }
        float part[2][32];
#pragma unroll
        for (int e = 0; e < 32; ++e) {
            float p0 = 0.f, p1 = 0.f;
#pragma unroll
            for (int j = 0; j < 4; ++j) { const f32x4 q = *(const LAS f32x4*)(rwT + e * 1024 + j * 256 + lane * 4);
                p0 += v[0][j][0] * q[0] + v[0][j][1] * q[1] + v[0][j][2] * q[2] + v[0][j][3] * q[3]; p1 += v[1][j][0] * q[0] + v[1][j][1] * q[1] + v[1][j][2] * q[2] + v[1][j][3] * q[3]; }
            part[0][e] = p0; part[1][e] = p1;
        }
#define RT_STEP(N, M) { const bool up = (lane & (M)) != 0; _Pragma("unroll") for (int q = 0; q < 2; ++q) _Pragma("unroll") for (int i = 0; i < (N); ++i) { const float keep = up ? part[q][(N) + i] : part[q][i], send = up ? part[q][i] : part[q][(N) + i]; part[q][i] = keep + __shfl_xor(send, (M)); } }
        RT_STEP(16, 32) RT_STEP(8, 16) RT_STEP(4, 8) RT_STEP(2, 4) RT_STEP(1, 2)
#undef RT_STEP
#pragma unroll
        for (int q = 0; q < 2; ++q) {
            const int r = r0 + q * NW;
            const float mylogit = part[q][0] + __shfl_xor(part[q][0], 1) + myrb;
            int rank = 0;
#pragma unroll
            for (int x = 0; x < 32; ++x) {
                const int src = ((x >> 4) & 1) * 32 + ((x >> 3) & 1) * 16 + ((x >> 2) & 1) * 8 + ((x >> 1) & 1) * 4 + (x & 1) * 2;
                const float oq = __builtin_bit_cast(float, __builtin_amdgcn_readlane(__builtin_bit_cast(int, mylogit), src));
                rank += (oq > mylogit || (oq == mylogit && x < myexp)) ? 1 : 0;
            }
            float tv[4]; int ti[4];
#pragma unroll
            for (int k = 0; k < 4; ++k) {
                const unsigned long long mk = __ballot(rank == k && (lane & 1) == 0);
                const int src = __builtin_amdgcn_readfirstlane((int)__builtin_ctzll(mk));
                tv[k] = __builtin_bit_cast(float, __builtin_amdgcn_readlane(__builtin_bit_cast(int, mylogit), src));
                ti[k] = ((src >> 5) & 1) * 16 + ((src >> 4) & 1) * 8 + ((src >> 3) & 1) * 4 + ((src >> 2) & 1) * 2 + ((src >> 1) & 1);
            }
            const float e1 = fexp(tv[1] - tv[0]), e2 = fexp(tv[2] - tv[0]), e3 = fexp(tv[3] - tv[0]); const float inv = frcp(1.0f + e1 + e2 + e3);
            const float g0 = inv, g1 = e1 * inv, g2 = e2 * inv, g3 = e3 * inv;
            if (lane < 4) {
                const int half = r >= HALF_TOK ? 1 : 0;
                const int e = lane == 0 ? ti[0] : lane == 1 ? ti[1] : lane == 2 ? ti[2] : ti[3];
                const float gv = lane == 0 ? g0 : lane == 1 ? g1 : lane == 2 ? g2 : g3;
                const u32 lp = atomicAdd((u32*)&hist[half * 32 + e], 1u);
                const int idx = ((it + q) * 8 + w) * 4 + lane;
                ent[idx * 2] = ((u32)e << 24) | lp; ent[idx * 2 + 1] = __float_as_uint(gv);
            }
        }
    }
    __syncthreads();
    if (tid < 64) hist[64 + tid] = atomicAdd(&cnt[tid], hist[tid]);
    __syncthreads();
    it = 0;
    for (int r = gw; r < NLAT; r += NW, ++it) {
        if (lane < 4) {
            const int half = r >= HALF_TOK ? 1 : 0; const int idx = (it * 8 + w) * 4 + lane;
            const u32 ev = ent[idx * 2]; const int e = ev >> 24; const u32 pos = hist[64 + half * 32 + e] + (ev & 0xffffffu);
            toktab[((size_t)half * 32 + e) * CAP + pos] = (u32)r * 4u + lane;
            wtab[((size_t)half * 32 + e) * CAP + pos] = __uint_as_float(ent[idx * 2 + 1]);
        }
    }
}

__device__ __forceinline__ void phase_combine(float* __restrict__ out, const bf16_t* __restrict__ X1, const fp8_t* __restrict__ Y, const float* __restrict__ mod, const float* __restrict__ fw, int bid, int G) {
    constexpr int RB = 2;
    typedef float f32x2_ __attribute__((ext_vector_type(2)));
    int tl_ = threadIdx.x; asm volatile("" : "+v"(tl_));
    const int lane = tl_ & 63, gw = bid * 8 + (tl_ >> 6), NW = G * 8;
    for (int r0 = gw; r0 < NLAT; r0 += RB * NW) {
        u32x2 xv[RB][4]; unsigned yv[RB][4][4];
#pragma unroll
        for (int q = 0; q < RB; ++q) { const int r = r0 + q * NW < NLAT ? r0 + q * NW : r0;
#pragma unroll
            for (int j = 0; j < 4; ++j) { xv[q][j] = __builtin_nontemporal_load((const u32x2*)(X1 + (size_t)r * D + j * 256 + lane * 4));
#pragma unroll
                for (int k = 0; k < 4; ++k) yv[q][j][k] = __builtin_nontemporal_load((const unsigned*)(Y + ((size_t)r * 4 + k) * D + j * 256 + lane * 4)); } }
#pragma unroll
        for (int q = 0; q < RB; ++q) { const int r = r0 + q * NW; if (r < NLAT) {
            const float* g2 = mod + (size_t)(r >> 11) * 6144 + 5120;
            f32x4 v[4]; float ss = 0.f;
#pragma unroll
            for (int j = 0; j < 4; ++j) { const int c0 = j * 256 + lane * 4;
                f32x4 sm = (f32x4){0.f, 0.f, 0.f, 0.f};
#pragma unroll
                for (int k = 0; k < 4; ++k) { const f32x2_ lo = __builtin_amdgcn_cvt_pk_f32_fp8(yv[q][j][k], false), hi = __builtin_amdgcn_cvt_pk_f32_fp8(yv[q][j][k], true); sm[0] += lo[0]; sm[1] += lo[1]; sm[2] += hi[0]; sm[3] += hi[1]; }
                const f32x4 g = *(const f32x4*)(g2 + c0);
                v[j][0] = __uint_as_float(xv[q][j].x << 16); v[j][1] = __uint_as_float(xv[q][j].x & 0xffff0000u); v[j][2] = __uint_as_float(xv[q][j].y << 16); v[j][3] = __uint_as_float(xv[q][j].y & 0xffff0000u);
                v[j] = v[j] + g * sm * (1.0f / SC_Y);
                ss += v[j][0] * v[j][0] + v[j][1] * v[j][1] + v[j][2] * v[j][2] + v[j][3] * v[j][3]; }
            const float rstd = __builtin_amdgcn_rsqf(wave_sum(ss) * (1.0f / D) + EPS);
#pragma unroll
            for (int j = 0; j < 4; ++j) { const int c0 = j * 256 + lane * 4; const f32x4 w = *(const f32x4*)(fw + c0); __builtin_nontemporal_store(v[j] * rstd * w, (f32x4*)(out + (size_t)r * D + c0)); }
        } }
    }
}

#define XB_TMO      128
#define XB_XCNT(j)  (256  + 64 * (j))
#define XB_XSUB(j)  (1280 + 64 * (j))
#define XB_XGEN(j)  (2304 + 64 * (j))
#define XB_TOP      3328
#define XB_TOPGEN   3392
#define XCD_BAR_WORDS 3456
#define XB_SPIN_CAP (1u << 20)
__device__ __forceinline__ unsigned xb_ld(unsigned* p)              { return __hip_atomic_load(p, __ATOMIC_RELAXED, __HIP_MEMORY_SCOPE_AGENT); }
__device__ __forceinline__ unsigned xb_add(unsigned* p, unsigned v) { return __hip_atomic_fetch_add(p, v, __ATOMIC_RELAXED, __HIP_MEMORY_SCOPE_AGENT); }
__device__ __forceinline__ unsigned xb_xcc_id() { return (unsigned)__builtin_amdgcn_s_getreg((3 << 11) | 20) & 0xFu; }
#define XB_SPIN(cond, bar) do { unsigned _sp = 0; while (cond) { __builtin_amdgcn_s_sleep(1); \
    if ((++_sp & 255u) == 0u) { if (xb_ld(&(bar)[XB_TMO])) break; if (_sp > XB_SPIN_CAP) { atomicAdd(&(bar)[XB_TMO], 1u); break; } } } } while (0)
struct XcdBarrier { unsigned* bar; unsigned x; volatile LAS unsigned* st; };
__device__ __forceinline__ XcdBarrier xcd_barrier_post(unsigned* bar, volatile LAS unsigned* st) {
    XcdBarrier b; b.bar = bar; b.x = xb_xcc_id(); b.st = st;
    if (threadIdx.x == 0) (void)xb_add(&bar[XB_XCNT(b.x)], 1u);
    return b;
}
__device__ __forceinline__ void xcd_barrier_complete(unsigned* bar, unsigned x, unsigned& nloc, unsigned& nx) {
    const unsigned G = gridDim.x * gridDim.y * gridDim.z;
    unsigned sum, cnt, mine, sp = 0u;
    for (;;) {
        sum = 0u; cnt = 0u; mine = 0u;
#pragma unroll
        for (unsigned j = 0; j < 16; ++j) { const unsigned c = xb_ld(&bar[XB_XCNT(j)]); sum += c; cnt += (c > 0u) ? 1u : 0u; mine = (j == x) ? c : mine; }
        if (sum == G) break;
        __builtin_amdgcn_s_sleep(1);
        if ((++sp & 255u) == 0u) { if (xb_ld(&bar[XB_TMO])) break; if (sp > XB_SPIN_CAP) { atomicAdd(&bar[XB_TMO], 1u); break; } }
    }
    nloc = mine > 0u ? mine : 1u; nx = cnt > 0u ? cnt : 1u;
}
__device__ __forceinline__ void xcd_barrier(unsigned* bar, volatile LAS unsigned* st) {
    asm volatile("s_waitcnt vmcnt(0)" ::: "memory");
    __syncthreads();
    if (threadIdx.x == 0) {
        __builtin_amdgcn_s_waitcnt(0);
        const unsigned x = xb_xcc_id();
        unsigned nloc = st[0], nx = st[1];
        if (nloc == 0u) { xcd_barrier_complete(bar, x, nloc, nx); st[0] = nloc; st[1] = nx; }
        const unsigned old = xb_add(&bar[XB_XSUB(x)], 1u);
        const unsigned gen = old / nloc;
        if (old + 1u == (gen + 1u) * nloc) {
            __builtin_amdgcn_fence(__ATOMIC_RELEASE, "agent");
            asm volatile("s_waitcnt vmcnt(0)" ::: "memory");
            const unsigned og = xb_add(&bar[XB_TOP], 1u);
            const unsigned tg = og / nx;
            if (og + 1u == (tg + 1u) * nx) xb_add(&bar[XB_TOPGEN], 1u);
            else XB_SPIN(xb_ld(&bar[XB_TOPGEN]) == tg, bar);
            __builtin_amdgcn_fence(__ATOMIC_ACQUIRE, "agent");
            xb_add(&bar[XB_XGEN(x)], 1u);
            asm volatile("s_waitcnt vmcnt(0)" ::: "memory");
        } else {
            XB_SPIN(xb_ld(&bar[XB_XGEN(x)]) == gen, bar);
            __builtin_amdgcn_fence(__ATOMIC_ACQUIRE, "agent");
            asm volatile("s_waitcnt vmcnt(0)" ::: "memory");
        }
    }
    __syncthreads();
}
constexpr size_t WS_BAR = 16384;
constexpr int LDS_BARST = LDS_BYTES - 16;

struct MegaArgs {
    const float *x, *c, *ctx, *c_ctx, *norm1_w, *norm2_w, *w_ada, *b_ada, *w_in, *lbl, *hg_nw, *conv_w, *conv_b, *rg_wa, *rg_ba, *rg_wx, *rg_bx, *rg_lam, *w_out,
        *router_w, *router_b, *wgu, *bgu, *wd, *bd, *final_w;
    float* out; unsigned char* ws;
};
typedef const MegaArgs __attribute__((address_space(4)))* KArgs;
__device__ __forceinline__ KArgs kargs() { auto p = __builtin_amdgcn_kernarg_segment_ptr(); asm volatile("" : "+s"(p)); return (KArgs)p; }
#define WSP(T, off) ((T*)(ws + (off)))
#define GRID_SYNC_CG() cg::this_grid().sync()
#define GRID_SYNC() do { KArgs a_ = kargs(); xcd_barrier((unsigned*)(a_->ws + WS_BAR), (volatile LAS unsigned*)(lds + LDS_BARST)); } while (0)
__global__ __launch_bounds__(512, 2) void k_mega(MegaArgs a_unused) {
    extern __shared__ __attribute__((aligned(16))) unsigned char lds_[];
    LAS unsigned char* lds = (LAS unsigned char*)lds_;
    if (threadIdx.x < 4) ((volatile LAS unsigned*)(lds + LDS_BARST))[threadIdx.x] = 0u;
    __syncthreads();
    { KArgs a = kargs(); (void)xcd_barrier_post((unsigned*)(a->ws + WS_BAR), (volatile LAS unsigned*)(lds + LDS_BARST)); }
    { KArgs a = kargs(); unsigned char* ws = a->ws; const int bid = blockIdx.x, G = gridDim.x;
      ProArgs pa; pa.c = a->c; pa.c_ctx = a->c_ctx; pa.w_ada = a->w_ada; pa.b_ada = a->b_ada; pa.lbl = a->lbl; pa.w_in = a->w_in; pa.w_out = a->w_out; pa.wgu = a->wgu; pa.wd = a->wd; pa.rg_wa = a->rg_wa; pa.rg_wx = a->rg_wx; pa.rg_lam = a->rg_lam;
      pa.coef = WSP(float, WS_COEF); pa.WG_t = WSP(bf16_t, WS_WG); pa.mod = WSP(float, WS_MOD); pa.lb = WSP(float, WS_LB); pa.Win_t = WSP(bf16_t, WS_WIN); pa.Wout_t = WSP(bf16_t, WS_WOUT); pa.Wgu_t = WSP(fp8_t, WS_WGU); pa.Wd_t = WSP(fp8_t, WS_WD);
      phase_prologue(lds, pa, bid, G, true, 0, 0); }
    { KArgs a_ = kargs(); if (a_->ws == nullptr) GRID_SYNC_CG(); }
    GRID_SYNC();
    { KArgs a = kargs(); unsigned char* ws = a->ws; phase_norm1(a->x, a->ctx, a->norm1_w, WSP(float, WS_MOD), WSP(bf16_t, WS_H), blockIdx.x, gridDim.x); }
    { KArgs a = kargs(); unsigned char* ws = a->ws;
      ProArgs pa; pa.c = nullptr; pa.c_ctx = nullptr; pa.w_ada = nullptr; pa.b_ada = nullptr; pa.lbl = nullptr; pa.w_in = a->w_in; pa.w_out = a->w_out; pa.wgu = nullptr; pa.wd = nullptr; pa.rg_wa = nullptr; pa.rg_wx = nullptr; pa.rg_lam = nullptr; pa.coef = nullptr; pa.WG_t = nullptr;
      pa.mod = nullptr; pa.lb = nullptr; pa.Win_t = WSP(bf16_t, WS_WIN); pa.Wout_t = WSP(bf16_t, WS_WOUT); pa.Wgu_t = nullptr; pa.Wd_t = nullptr;
      phase_prologue(lds, pa, blockIdx.x, gridDim.x, false, 0, IT_IN + IT_OUT); }
    GRID_SYNC();
    { KArgs a = kargs(); unsigned char* ws = a->ws; PolInProj P; P.A = WSP(bf16_t, WS_H); P.Bt = WSP(bf16_t, WS_WIN); P.O = WSP(bf16_t, WS_PROJ); P.ord.init(NLAT / BM, INW / BM, gridDim.x, blockIdx.x); gemm_phase(lds, P); }
    GRID_SYNC();
    { KArgs a = kargs(); unsigned char* ws = a->ws;
      for (int item = blockIdx.x; item < 256; item += gridDim.x)
          phase_rg_chain(lds, WSP(bf16_t, WS_PROJ), a->conv_w, a->conv_b, WSP(bf16_t, WS_WG), a->rg_ba, a->rg_bx, WSP(float, WS_COEF), WSP(bf16_t, WS_HF), WSP(bf16_t, WS_MIX2), item); }
    __syncthreads();
    { KArgs a = kargs(); unsigned char* ws = a->ws;
      for (int item = blockIdx.x; item < 256; item += gridDim.x) phase_hgrn2_ws(lds, WSP(bf16_t, WS_PROJ), WSP(float, WS_LB), WSP(bf16_t, WS_OF), WSP(bf16_t, WS_OB), item); }
    GRID_SYNC();
    { KArgs a = kargs(); unsigned char* ws = a->ws; phase_mix_finish(WSP(bf16_t, WS_PROJ), WSP(bf16_t, WS_OF), WSP(bf16_t, WS_OB), a->hg_nw, WSP(bf16_t, WS_MIX2), blockIdx.x, gridDim.x); }
    GRID_SYNC();
    { KArgs a = kargs(); unsigned char* ws = a->ws; PolOutProj P; P.A = WSP(bf16_t, WS_MIX2); P.Bt = WSP(bf16_t, WS_WOUT); P.x = a->x; P.mod = WSP(float, WS_MOD); P.O = WSP(bf16_t, WS_X1); P.ord.init(NLAT / BM, D / BM, gridDim.x, blockIdx.x); gemm_phase(lds, P); }
    GRID_SYNC();
    { KArgs a = kargs(); unsigned char* ws = a->ws;
      phase_norm2_route(lds, WSP(bf16_t, WS_X1), a->norm2_w, WSP(float, WS_MOD), a->router_w, a->router_b, WSP(fp8_t, WS_H2), WSP(u32, WS_CTL), WSP(u32, WS_TOKTAB), WSP(float, WS_WTAB), blockIdx.x, gridDim.x); }
    __syncthreads();
    { KArgs a = kargs(); unsigned char* ws = a->ws;
      ProArgs pa; pa.c = nullptr; pa.c_ctx = nullptr; pa.w_ada = nullptr; pa.b_ada = nullptr; pa.lbl = nullptr; pa.w_in = nullptr; pa.w_out = nullptr; pa.wgu = a->wgu; pa.wd = a->wd; pa.rg_wa = nullptr; pa.rg_wx = nullptr; pa.rg_lam = nullptr; pa.coef = nullptr; pa.WG_t = nullptr;
      pa.mod = nullptr; pa.lb = nullptr; pa.Win_t = nullptr; pa.Wout_t = nullptr; pa.Wgu_t = WSP(fp8_t, WS_WGU); pa.Wd_t = WSP(fp8_t, WS_WD);
      phase_prologue(lds, pa, blockIdx.x, gridDim.x, false, IT_IN + IT_OUT, IT_ALL); }
    GRID_SYNC();
#pragma unroll 1
    for (int half = 0; half < NHALF; ++half) {
        { KArgs a = kargs(); unsigned char* ws = a->ws; LAS int* tstart = (LAS int*)(lds + LDS_AUX);
          const int tot = moe_tile_table(tstart, WSP(u32, WS_CTL), half);
          PolGateUp P; P.A = WSP(fp8_t, WS_H2); P.Bt = WSP(fp8_t, WS_WGU); P.bgu = a->bgu; P.toktab = WSP(u32, WS_TOKTAB); P.wtab = WSP(float, WS_WTAB); P.O = WSP(fp8_t, WS_ACT); P.mt.tstart = tstart; P.mt.cnt = WSP(u32, WS_CTL); P.mt.half = half;
          P.ord.init(tot, DFF / HALFT, gridDim.x, blockIdx.x);
          gemm_phase(lds, P); }
        GRID_SYNC();
        { KArgs a = kargs(); unsigned char* ws = a->ws; LAS int* tstart = (LAS int*)(lds + LDS_AUX);
          const int tot = moe_tile_table(tstart, WSP(u32, WS_CTL), half);
          {
              const u32x4* wp = (const u32x4*)WSP(fp8_t, WS_WD) + (size_t)blockIdx.x * 8192 + threadIdx.x; u32x4 acc_ = (u32x4){0u, 0u, 0u, 0u};
#pragma unroll
              for (int i = 0; i < 16; ++i) acc_ |= wp[i * 512];
              asm volatile("" :: "v"(acc_));
          }
          PolDown P; P.A = WSP(fp8_t, WS_ACT); P.Bt = WSP(fp8_t, WS_WD); P.bd = a->bd; P.toktab = WSP(u32, WS_TOKTAB); P.wtab = WSP(float, WS_WTAB); P.O = WSP(fp8_t, WS_Y); P.mt.tstart = tstart; P.mt.cnt = WSP(u32, WS_CTL); P.mt.half = half;
          P.ord.init(tot, D / BM, gridDim.x, blockIdx.x);
          gemm_phase(lds, P); }
        GRID_SYNC();
        { KArgs a = kargs(); unsigned char* ws = a->ws; phase_combine(a->out, WSP(bf16_t, WS_X1), WSP(fp8_t, WS_Y), WSP(float, WS_MOD), a->final_w, blockIdx.x, gridDim.x); }
        __syncthreads();
    }
}

extern "C" void kernel_launch(void* const* d_in, const int* in_sizes, int n_in, void* d_out, int out_size, void* d_ws, size_t ws_size, hipStream_t stream) {
    static int grid_blocks = 0;
    if (!grid_blocks) {
        int dev = 0, cus = 0, per_cu = 0;
        (void)hipGetDevice(&dev);
        (void)hipDeviceGetAttribute(&cus, hipDeviceAttributeMultiprocessorCount, dev);
        (void)hipFuncSetAttribute((const void*)k_mega, hipFuncAttributeMaxDynamicSharedMemorySize, LDS_BYTES);
        (void)hipOccupancyMaxActiveBlocksPerMultiprocessor(&per_cu, (const void*)k_mega, 512, LDS_BYTES);
        if (per_cu < 1) { fprintf(stderr, "kernel_launch: occupancy query says %d blocks/CU\n", per_cu); per_cu = 1; }
        grid_blocks = cus * 1;
    }
    if (ws_size < 1024 * MiB) { fprintf(stderr, "kernel_launch: workspace too small (%zu)\n", ws_size); return; }
    MegaArgs a{};
    const float** ap = (const float**)&a;
    for (int i = 0; i < 26; ++i) ap[i] = (const float*)d_in[i];
    a.out = (float*)d_out; a.ws = (unsigned char*)d_ws;
    (void)hipMemsetAsync((unsigned char*)d_ws + WS_CTL, 0, 32768, stream);
    void* args[] = {&a};
    hipError_t e = hipLaunchCooperativeKernel((const void*)k_mega, dim3(grid_blocks), dim3(512), args, LDS_BYTES, stream);
    if (e != hipSuccess) fprintf(stderr, "cooperative launch failed: %s (grid %d)\n", hipGetErrorString(e), grid_blocks);
}
```

```cpp
#include <hip/hip_runtime.h>
#include <hip/hip_cooperative_groups.h>
#include <cstdio>
#include <cstdint>

typedef unsigned short bf16_t;
typedef unsigned int u32;
namespace cg = cooperative_groups;

constexpr int D = 1024, NB = 32, T = 2048, CTXL = 256, GRIDW = 64, GROWS = T / GRIDW;
constexpr int NLAT = NB * T;
constexpr int NCTX = NB * CTXL;
constexpr int NROWS = NLAT + NCTX;
constexpr int HGW = 512, RGW = 512, INW = 3584;
constexpr int C_Q = 0, C_I = 512, C_FF = 1024, C_FB = 1536, C_G = 2048, C_RX = 2560, C_RG = 3072;
constexpr int NE = 32, TOPK = 4, DFF = 1024;
constexpr int NCHK = (CTXL + T) / 64;
constexpr int NHALF = 1;
constexpr int HALF_TOK = NLAT / NHALF;
constexpr int CAP = HALF_TOK;
constexpr int MAXSLOT = HALF_TOK * TOPK + NE * 256;
constexpr float EPS = 1e-6f;

constexpr size_t MiB = 1u << 20;
constexpr size_t WS_CTL = 0;
constexpr size_t WS_WG = 64 * 1024;
constexpr size_t WS_MOD = 1 * MiB;
constexpr size_t WS_LB = WS_MOD + 33 * 6144 * 4;
constexpr size_t WS_COEF = WS_LB + 4096;
constexpr size_t WS_TOKTAB = 2 * MiB;
constexpr size_t WS_WTAB = 10 * MiB;
constexpr size_t WS_WIN = 18 * MiB, WS_WOUT = 25 * MiB;
constexpr size_t WS_OF = 28 * MiB, WS_OB = 92 * MiB;
constexpr size_t WS_HF = 156 * MiB;
constexpr size_t WS_H = 284 * MiB;
constexpr size_t WS_MIX2 = WS_H;
constexpr size_t WS_PROJ = 428 * MiB;
constexpr size_t WS_H2 = 28 * MiB;
constexpr size_t WS_WGU = 92 * MiB, WS_WD = 156 * MiB;
constexpr size_t WS_ACT = 188 * MiB;
constexpr size_t WS_Y = 452 * MiB;
constexpr size_t WS_X1 = 708 * MiB;
constexpr float SC_Y = 16.0f;

__device__ __forceinline__ float bf2f(bf16_t b) { return __uint_as_float(((u32)b) << 16); }
__device__ __forceinline__ bf16_t f2bf(float f) { u32 u = __float_as_uint(f); u += 0x7fffu + ((u >> 16) & 1u); return (bf16_t)(u >> 16); }
__device__ __forceinline__ u32 pk2(float lo, float hi) { return (u32)f2bf(lo) | ((u32)f2bf(hi) << 16); }
__device__ __forceinline__ float fexp(float x) { return __builtin_amdgcn_exp2f(x * 1.4426950408889634f); }
__device__ __forceinline__ float frcp(float x) { return __builtin_amdgcn_rcpf(x); }
__device__ __forceinline__ float flog(float x) { return __builtin_amdgcn_logf(x) * 0.6931471805599453f; }
__device__ __forceinline__ float fsqrt(float x) { return __builtin_amdgcn_sqrtf(x); }
__device__ __forceinline__ float sigmoidf_(float x) { return frcp(1.0f + fexp(-x)); }
__device__ __forceinline__ float wave_sum(float v) {
#pragma unroll
    for (int o = 1; o < 64; o <<= 1) v += __shfl_xor(v, o);
    return v;
}

__device__ __forceinline__ float gelu_tanh(float x) { const float u = 1.5957691216057308f * (x + 0.044715f * x * x * x); return x * sigmoidf_(u); }
#define LAS __attribute__((address_space(3)))
typedef short bf16x8 __attribute__((ext_vector_type(8)));
typedef float f32x4 __attribute__((ext_vector_type(4)));
typedef unsigned u32x4 __attribute__((ext_vector_type(4)));
typedef int v8i __attribute__((ext_vector_type(8)));
typedef int v4i_ __attribute__((ext_vector_type(4)));
typedef unsigned u32x2 __attribute__((ext_vector_type(2)));
typedef float f32x2 __attribute__((ext_vector_type(2)));
typedef unsigned char fp8_t;
constexpr float SC_H2 = 16.0f, SC_W = 32.0f, SC_ACT = 4.0f;
__device__ __forceinline__ unsigned pk4_fp8(float a, float b, float c, float d) {
    a = fminf(fmaxf(a, -448.f), 448.f); b = fminf(fmaxf(b, -448.f), 448.f); c = fminf(fmaxf(c, -448.f), 448.f); d = fminf(fmaxf(d, -448.f), 448.f);
    int r = 0; r = __builtin_amdgcn_cvt_pk_fp8_f32(a, b, r, false); r = __builtin_amdgcn_cvt_pk_fp8_f32(c, d, r, true); return (unsigned)r; }
__device__ __forceinline__ unsigned pk4_fp8_nc(float a, float b, float c, float d) { int r = 0; r = __builtin_amdgcn_cvt_pk_fp8_f32(a, b, r, false); r = __builtin_amdgcn_cvt_pk_fp8_f32(c, d, r, true); return (unsigned)r; }
constexpr int BM = 256, BK = 64, HALFT = 128, HTB = HALFT * BK * 2, STAGE_BYTES = 8 * HTB, NXCD = 8, WGM = 8;
constexpr int GK = 1024;
constexpr int LDS_BYTES = 147456;
constexpr int LDS_AUX = STAGE_BYTES;

__device__ __forceinline__ int lds_byte(int r, int c) { const int st = (r >> 4) * 2 + (c >> 5), rr = r & 15, cc = c & 31, ob = rr * 64 + cc * 2; return st * 1024 + (ob ^ (((ob >> 9) & 1) << 5)); }
__device__ __forceinline__ void stage_rc(int b, int& R, int& C) { const int st = b / 1024, sb = b % 1024, swz = sb ^ (((sb >> 9) & 1) << 5); R = (st >> 1) * 16 + swz / 64; C = (st & 1) * 32 + (swz % 64) / 2; }
__device__ __forceinline__ int perm32(int rho) { const int n = rho >> 4, i = rho & 15; return 8 * (i >> 2) + 4 * n + (i & 3); }
__device__ __forceinline__ unsigned cvt_pk_bf16(float lo, float hi) { unsigned r; asm volatile("v_cvt_pk_bf16_f32 %0, %1, %2" : "=v"(r) : "v"(lo), "v"(hi)); return r; }

struct Unit { int pm, pn, e, pos0, cn; };
struct TileOrder {
    int nM, nN, nwg, G, c;
    __device__ __forceinline__ void init(int nM_, int nN_, int G_, int c_) { nM = nM_; nN = nN_; nwg = nM * nN; G = G_; c = c_; }
    __device__ __forceinline__ bool tile(int i, int& pm, int& pn) const {
        const long L = (long)i * G + c; if (L >= nwg) return false;
        int wgid = (int)L; { const int q = nwg / NXCD, r = nwg % NXCD, xcd = wgid % NXCD, off = wgid / NXCD; wgid = (xcd < r ? xcd * (q + 1) : r * (q + 1) + (xcd - r) * q) + off; }
        const int nig = WGM * nN, gid = wgid / nig, fm = gid * WGM, gsz = (nM - fm) < WGM ? (nM - fm) : WGM;
        pm = fm + ((wgid % nig) % gsz); pn = (wgid % nig) / gsz; return true;
    }
};

template <class POL>
__device__ __forceinline__ void gemm_phase(LAS unsigned char* lds, const POL& P) {
    int tid_ = threadIdx.x; asm volatile("" : "+v"(tid_));
    const int tid = tid_, wid = __builtin_amdgcn_readfirstlane(tid >> 6), lane = tid & 63, wr = wid >> 2, wc = wid & 3, fr = lane & 15, fq = lane >> 4;
    constexpr int KB = POL::FP8 ? 1024 : 2048, nt = KB / 128;
    int sR[2], sC[2]; unsigned voffA[2], voffB[2];
#pragma unroll
    for (int i = 0; i < 2; ++i) { stage_rc(tid * 16 + i * 8192, sR[i], sC[i]); const int Rb = POL::PERM ? ((sR[i] & ~31) + perm32(sR[i] & 31)) : sR[i]; voffA[i] = (unsigned)(sR[i] * KB + sC[i] * 2); voffB[i] = (unsigned)(Rb * KB + sC[i] * 2); }
    constexpr size_t kstep = (size_t)(BK * 2);
    constexpr unsigned hstepB = (unsigned)HALFT * KB;
    const unsigned ldsw = (unsigned)wid * 1024u;
    const int aoff = lds_byte(wr * 64 + fr, fq * 8), boff = lds_byte(wc * 32 + fr, fq * 8);
#define G_SA(b, h) (((b) * 2 + (h)) * HTB)
#define G_SB(b, h) ((4 + (b) * 2 + (h)) * HTB)
#define G_AOFF(OFF, h, i) (POL::GATHER ? (OFF)[h][i] : voffA[i])
#define G_STAGE_A(bufoff, gbase, OFF, h) do { const char* _gb = (const char*)(gbase) + (POL::GATHER ? (size_t)0 : (size_t)(h) * hstepB); _Pragma("unroll") for (int _i = 0; _i < 2; ++_i) \
        __builtin_amdgcn_global_load_lds((const unsigned*)(_gb + G_AOFF(OFF, h, _i)), (LAS unsigned*)(lds + (bufoff) + ldsw + _i * 8192), 16, 0, 0); } while (0)
#define G_STAGE_B(bufoff, gbase, hoff) do { const char* _gb = (const char*)(gbase) + (size_t)(hoff); _Pragma("unroll") for (int _i = 0; _i < 2; ++_i) \
        __builtin_amdgcn_global_load_lds((const unsigned*)(_gb + voffB[_i]), (LAS unsigned*)(lds + (bufoff) + ldsw + _i * 8192), 16, 0, 0); } while (0)
#define G_LD8(p) __builtin_shufflevector(*(const LAS v4i_*)(p), *(const LAS v4i_*)((p) + 1024), 0, 1, 2, 3, 4, 5, 6, 7)
#define G_LDA(dst, b, h) do { if (POL::FP8) { _Pragma("unroll") for (int m = 0; m < 4; ++m) dst##8[m] = G_LD8(lds + G_SA(b, h) + aoff + m * 2048); } \
        else { _Pragma("unroll") for (int m = 0; m < 4; ++m) _Pragma("unroll") for (int k = 0; k < 2; ++k) dst[m][k] = *(const LAS bf16x8*)(lds + G_SA(b, h) + aoff + m * 2048 + k * 1024); } } while (0)
#define G_LDB(dst, b, h) do { if (POL::FP8) { _Pragma("unroll") for (int n = 0; n < 2; ++n) dst##8[n] = G_LD8(lds + G_SB(b, h) + boff + n * 2048); } \
        else { _Pragma("unroll") for (int n = 0; n < 2; ++n) _Pragma("unroll") for (int k = 0; k < 2; ++k) dst[n][k] = *(const LAS bf16x8*)(lds + G_SB(b, h) + boff + n * 2048 + k * 1024); } } while (0)
#define G_MMA(ai, bj, At, Bt) do { __builtin_amdgcn_s_setprio(1); \
        if (POL::FP8) { _Pragma("unroll") for (int m = 0; m < 4; ++m) _Pragma("unroll") for (int n = 0; n < 2; ++n) \
            asm volatile("v_mfma_scale_f32_16x16x128_f8f6f4 %0, %1, %2, %0, %3, %3 op_sel_hi:[0,0,0]" : "+v"(acc[ai][bj][m][n]) : "v"(Bt##8[n]), "v"(At##8[m]), "v"(mxs)); } \
        else { _Pragma("unroll") for (int m = 0; m < 4; ++m) _Pragma("unroll") for (int n = 0; n < 2; ++n) _Pragma("unroll") for (int k = 0; k < 2; ++k) \
            acc[ai][bj][m][n] = __builtin_amdgcn_mfma_f32_16x16x32_bf16(Bt[n][k], At[m][k], acc[ai][bj][m][n], 0, 0, 0); } \
        __builtin_amdgcn_s_setprio(0); } while (0)
#define G_WAIT_V(n) asm volatile("s_waitcnt vmcnt(" #n ")" ::: "memory")
#define G_WAIT_L(n) asm volatile("s_waitcnt lgkmcnt(" #n ")" ::: "memory")
#define G_BAR __builtin_amdgcn_s_barrier()
#define G_SCHED __builtin_amdgcn_sched_barrier(0)
#define G_TRIP(A1, OC, A2, ON, B2) do { \
        G_LDB(B0, 0, 0); G_SCHED; G_LDA(At, 0, 0); G_STAGE_A(G_SA(1, 1), A1, OC, 1); \
        G_WAIT_L(8); G_BAR; G_WAIT_L(0); G_MMA(0, 0, At, B0); G_BAR; G_SCHED; \
        G_LDB(B1, 0, 1); G_STAGE_B(G_SB(0, 0), B2, 0u); \
        G_BAR; G_WAIT_L(0); G_MMA(0, 1, At, B1); G_BAR; \
        G_LDA(At, 0, 1); G_STAGE_A(G_SA(0, 0), A2, ON, 0); \
        G_BAR; G_WAIT_L(0); G_MMA(1, 0, At, B0); G_BAR; G_SCHED; \
        G_STAGE_B(G_SB(0, 1), B2, hstepB); \
        G_WAIT_V(6); G_BAR; G_MMA(1, 1, At, B1); G_BAR; \
        G_LDB(B0, 1, 0); G_SCHED; G_LDA(At, 1, 0); G_STAGE_A(G_SA(0, 1), A2, ON, 1); \
        G_WAIT_L(8); G_BAR; G_WAIT_L(0); G_MMA(0, 0, At, B0); G_BAR; G_SCHED; \
        G_LDB(B1, 1, 1); G_STAGE_B(G_SB(1, 0), (B2) + kstep, 0u); \
        G_BAR; G_WAIT_L(0); G_MMA(0, 1, At, B1); G_BAR; \
        G_LDA(At, 1, 1); G_STAGE_A(G_SA(1, 0), (A2) + kstep, ON, 0); \
        G_BAR; G_WAIT_L(0); G_MMA(1, 0, At, B0); G_BAR; G_SCHED; \
        G_STAGE_B(G_SB(1, 1), (B2) + kstep, hstepB); \
        G_WAIT_V(6); G_BAR; G_MMA(1, 1, At, B1); G_BAR; } while (0)
#define G_TRIP2(A1, OC, A2, ON, B2) do { \
        G_LDB(B0, 0, 0); G_LDB(B1, 0, 1); G_SCHED; G_LDA(At, 0, 0); G_STAGE_A(G_SA(1, 1), A1, OC, 1); \
        G_WAIT_V(8); G_WAIT_L(0); G_BAR; G_MMA(0, 0, At, B0); G_MMA(0, 1, At, B1); G_BAR; G_SCHED; \
        G_LDA(At, 0, 1); G_STAGE_B(G_SB(0, 0), B2, 0u); G_STAGE_B(G_SB(0, 1), B2, hstepB); G_STAGE_A(G_SA(0, 0), A2, ON, 0); \
        G_WAIT_V(8); G_WAIT_L(0); G_BAR; G_MMA(1, 0, At, B0); G_MMA(1, 1, At, B1); G_BAR; G_SCHED; \
        G_LDB(B0, 1, 0); G_LDB(B1, 1, 1); G_SCHED; G_LDA(At, 1, 0); G_STAGE_A(G_SA(0, 1), A2, ON, 1); \
        G_WAIT_V(8); G_WAIT_L(0); G_BAR; G_MMA(0, 0, At, B0); G_MMA(0, 1, At, B1); G_BAR; G_SCHED; \
        G_LDA(At, 1, 1); G_STAGE_B(G_SB(1, 0), (B2) + kstep, 0u); G_STAGE_B(G_SB(1, 1), (B2) + kstep, hstepB); G_STAGE_A(G_SA(1, 0), (A2) + kstep, ON, 0); \
        G_WAIT_V(8); G_WAIT_L(0); G_BAR; G_MMA(1, 0, At, B0); G_MMA(1, 1, At, B1); G_BAR; G_SCHED; } while (0)
#ifndef GEMM_SP2
#define GEMM_SP2 1
#endif
    Unit cur, nxt; int ui = 0;
    if (!P.next(0, cur)) return;
    f32x4 acc[2][2][4][2];
#pragma unroll
    for (int a = 0; a < 2; ++a)
#pragma unroll
        for (int b = 0; b < 2; ++b)
#pragma unroll
            for (int m = 0; m < 4; ++m)
#pragma unroll
                for (int n = 0; n < 2; ++n) acc[a][b][m][n] = (f32x4){0.f, 0.f, 0.f, 0.f};
    const int mxs = 0x7f7f7f7f;
    bf16x8 At[4][2], B0[2][2], B1[2][2]; v8i At8[4], B08[2], B18[2];
    unsigned oc[2][2], on[2][2];
    if (POL::ROWS) { P.stage_rows(cur, 0); __syncthreads(); }
#pragma unroll
    for (int h = 0; h < 2; ++h)
#pragma unroll
        for (int i = 0; i < 2; ++i) { oc[h][i] = POL::GATHER ? P.a_off_l(0, h * HALFT + sR[i]) + (unsigned)sC[i] * 2u : 0u; on[h][i] = 0u; }
    const char* cA = P.a_base(cur); const char* cB = P.b_base(cur);
    if (GEMM_SP2) {
        G_STAGE_B(G_SB(0, 0), cB, 0u); G_STAGE_B(G_SB(0, 1), cB, hstepB); G_STAGE_A(G_SA(0, 0), cA, oc, 0); G_STAGE_A(G_SA(0, 1), cA, oc, 1);
        if (wr == 1) G_BAR;
        G_WAIT_V(2); G_BAR;
        G_STAGE_B(G_SB(1, 0), cB + kstep, 0u); G_STAGE_A(G_SA(1, 0), cA + kstep, oc, 0); G_STAGE_B(G_SB(1, 1), cB + kstep, hstepB);
        G_WAIT_V(6); G_BAR;
    } else {
    G_STAGE_B(G_SB(0, 0), cB, 0u); G_STAGE_A(G_SA(0, 0), cA, oc, 0); G_STAGE_B(G_SB(0, 1), cB, hstepB); G_STAGE_A(G_SA(0, 1), cA, oc, 1);
    if (wr == 1) G_BAR;
    G_WAIT_V(4); G_BAR;
    G_STAGE_B(G_SB(1, 0), cB + kstep, 0u); G_STAGE_A(G_SA(1, 0), cA + kstep, oc, 0); G_STAGE_B(G_SB(1, 1), cB + kstep, hstepB);
    G_WAIT_V(6); G_BAR;
    }
    for (;;) {
        const bool has_next = P.next(ui + 1, nxt);
        const char* nA = has_next ? P.a_base(nxt) : cA; const char* nB = has_next ? P.b_base(nxt) : cB;
        if (POL::ROWS) { if (has_next) P.stage_rows(nxt, (ui + 1) & 1); }
#pragma unroll 1
        for (int t = 0; t < nt; t += 2) {
            const bool last = (t == nt - 2);
            const char* a1 = cA + (size_t)(t + 1) * kstep; const char* a2 = last ? nA : cA + (size_t)(t + 2) * kstep; const char* b2 = last ? nB : cB + (size_t)(t + 2) * kstep;
            if (POL::GATHER) {
                unsigned os[2][2];
                if (last) {
#pragma unroll
                    for (int h = 0; h < 2; ++h)
#pragma unroll
                        for (int i = 0; i < 2; ++i) on[h][i] = has_next ? P.a_off_l((ui + 1) & 1, h * HALFT + sR[i]) + (unsigned)sC[i] * 2u : oc[h][i];
                }
#pragma unroll
                for (int h = 0; h < 2; ++h)
#pragma unroll
                    for (int i = 0; i < 2; ++i) os[h][i] = last ? on[h][i] : oc[h][i];
                if (GEMM_SP2) { G_TRIP2(a1, oc, a2, os, b2); } else { G_TRIP(a1, oc, a2, os, b2); }
            } else { if (GEMM_SP2) { G_TRIP2(a1, oc, a2, oc, b2); } else { G_TRIP(a1, oc, a2, oc, b2); } }
        }
        if (POL::FP8) asm volatile("s_nop 15\n\ts_nop 15" ::: "memory");
        if (wr == 0) G_BAR;
        P.epi(acc, cur, wr, wc, fr, fq, ui & 1);
        if (!has_next) break;
#pragma unroll
        for (int a = 0; a < 2; ++a)
#pragma unroll
            for (int b = 0; b < 2; ++b)
#pragma unroll
                for (int m = 0; m < 4; ++m)
#pragma unroll
                    for (int n = 0; n < 2; ++n) acc[a][b][m][n] = (f32x4){0.f, 0.f, 0.f, 0.f};
        cur = nxt; cA = nA; cB = nB; ++ui;
        if (POL::GATHER) {
#pragma unroll
            for (int h = 0; h < 2; ++h)
#pragma unroll
                for (int i = 0; i < 2; ++i) oc[h][i] = on[h][i];
        }
        if (wr == 1) G_BAR;
    }
    G_WAIT_V(0);
    G_BAR;
#undef G_SA
#undef G_SB
#undef G_AOFF
#undef G_STAGE_A
#undef G_STAGE_B
#undef G_LDA
#undef G_LDB
#undef G_MMA
#undef G_LD8
#undef G_WAIT_V
#undef G_WAIT_L
#undef G_BAR
#undef G_SCHED
#undef G_TRIP
#undef G_TRIP2
}

struct PolInProj {
    static constexpr bool PERM = true, GATHER = false, FP8 = false, ROWS = false;
    __device__ __forceinline__ void stage_rows(const Unit&, int) const {}
    __device__ __forceinline__ unsigned a_off_l(int, int) const { return 0u; }
    const bf16_t* A; const bf16_t* Bt; bf16_t* O; TileOrder ord;
    __device__ __forceinline__ bool next(int i, Unit& u) const {
        constexpr int NLATU = (NLAT / BM) * (INW / BM);
        const int L = i * ord.G + ord.c;
        if (L < NLATU) return ord.tile(i, u.pm, u.pn);
        const int q = L - NLATU; if (q >= (NCTX / BM) * 8) return false;
        u.pm = NLAT / BM + (q >> 3); const int j = q & 7; u.pn = j < 6 ? 2 + j : 4 + j; return true;
    }
    __device__ __forceinline__ const char* a_base(const Unit& u) const { return (const char*)A + (size_t)u.pm * BM * GK * 2; }
    __device__ __forceinline__ unsigned a_off(const Unit&, int r) const { return (unsigned)r * GK * 2u; }
    __device__ __forceinline__ const char* b_base(const Unit& u) const { return (const char*)Bt + (size_t)u.pn * BM * GK * 2; }
    __device__ __forceinline__ void epi(const f32x4 (&acc)[2][2][4][2], const Unit& u, int wr, int wc, int fr, int fq, int par) const {
        const int row0 = u.pm * BM + wr * 64 + fr, col0 = u.pn * BM + wc * 32 + 8 * fq;
        const bool qsilu = u.pn < HGW / BM;
#pragma unroll
        for (int ai = 0; ai < 2; ++ai)
#pragma unroll
            for (int m = 0; m < 4; ++m) { bf16_t* rowp = O + (size_t)(row0 + ai * HALFT + m * 16) * INW + col0;
#pragma unroll
                for (int bj = 0; bj < 2; ++bj) { f32x4 v0 = acc[ai][bj][m][0], v1 = acc[ai][bj][m][1];
                    if (qsilu) {
#pragma unroll
                        for (int e = 0; e < 4; ++e) { v0[e] = v0[e] * sigmoidf_(v0[e]); v1[e] = v1[e] * sigmoidf_(v1[e]); } }
                    u32x4 w; w.x = cvt_pk_bf16(v0[0], v0[1]); w.y = cvt_pk_bf16(v0[2], v0[3]); w.z = cvt_pk_bf16(v1[0], v1[1]); w.w = cvt_pk_bf16(v1[2], v1[3]);
                    *(u32x4*)(rowp + bj * HALFT) = w; } }
    }
};
struct PolOutProj {
    static constexpr bool PERM = true, GATHER = false, FP8 = false, ROWS = false;
    __device__ __forceinline__ void stage_rows(const Unit&, int) const {}
    __device__ __forceinline__ unsigned a_off_l(int, int) const { return 0u; }
    const bf16_t* A; const bf16_t* Bt; const float* x; const float* mod; bf16_t* O; TileOrder ord;
    __device__ __forceinline__ bool next(int i, Unit& u) const { return ord.tile(i, u.pm, u.pn); }
    __device__ __forceinline__ const char* a_base(const Unit& u) const { return (const char*)A + (size_t)u.pm * BM * GK * 2; }
    __device__ __forceinline__ unsigned a_off(const Unit&, int r) const { return (unsigned)r * GK * 2u; }
    __device__ __forceinline__ const char* b_base(const Unit& u) const { return (const char*)Bt + (size_t)u.pn * BM * GK * 2; }
    __device__ __forceinline__ void epi(const f32x4 (&acc)[2][2][4][2], const Unit& u, int wr, int wc, int fr, int fq, int par) const {
        const int row0 = u.pm * BM + wr * 64 + fr, col0 = u.pn * BM + wc * 32 + 8 * fq;
        const float* g1 = mod + (size_t)((u.pm * BM) >> 11) * 6144 + 2048 + col0;
        f32x4 gv[2][2];
#pragma unroll
        for (int bj = 0; bj < 2; ++bj) { gv[bj][0] = *(const f32x4*)(g1 + bj * HALFT); gv[bj][1] = *(const f32x4*)(g1 + bj * HALFT + 4); }
#pragma unroll
        for (int ai = 0; ai < 2; ++ai)
#pragma unroll
            for (int m = 0; m < 4; ++m) { const size_t off = (size_t)(row0 + ai * HALFT + m * 16) * D + col0;
#pragma unroll
                for (int bj = 0; bj < 2; ++bj) {
                    const f32x4 x0 = __builtin_nontemporal_load((const f32x4*)(x + off + bj * HALFT)), x1v = __builtin_nontemporal_load((const f32x4*)(x + off + bj * HALFT + 4));
                    const f32x4 v0 = x0 + gv[bj][0] * acc[ai][bj][m][0], v1 = x1v + gv[bj][1] * acc[ai][bj][m][1];
                    u32x4 w; w.x = cvt_pk_bf16(v0[0], v0[1]); w.y = cvt_pk_bf16(v0[2], v0[3]); w.z = cvt_pk_bf16(v1[0], v1[1]); w.w = cvt_pk_bf16(v1[2], v1[3]);
                    *(u32x4*)(O + off + bj * HALFT) = w; }
                asm volatile("" ::: "memory"); }
    }
};
struct MoeTiles {
    const LAS int* tstart; const u32* cnt; int half;
    __device__ __forceinline__ LAS u32* rows(int par) const { return (LAS u32*)((LAS unsigned char*)tstart + 8192) + par * 512; }
    __device__ __forceinline__ LAS float* bias(int par) const { return (LAS float*)((LAS unsigned char*)tstart + 12288) + par * 256; }
    __device__ __forceinline__ void stage_bias(int par, const float* src) const { if (threadIdx.x >= BM) bias(par)[threadIdx.x - BM] = src[0]; }
    __device__ __forceinline__ void stage(const Unit& u, int par, const u32* toktab, const float* wtab) const {
        if (threadIdx.x >= BM) { const int t = (int)threadIdx.x - BM, p = u.pos0 + t; const size_t tb = ((size_t)half * NE + u.e) * CAP; const bool ok = p < u.cn;
            const u32 tk = ok ? toktab[tb + p] : ~0u; const float wg = ok ? wtab[tb + p] : 0.f; LAS u32* rt = rows(par); rt[t * 2] = tk; rt[t * 2 + 1] = __float_as_uint(wg); }
    }
    __device__ __forceinline__ void find(Unit& u) const {
        const int e = __builtin_amdgcn_readfirstlane(tstart[64 + u.pm]);
        u.e = e; u.pos0 = (u.pm - __builtin_amdgcn_readfirstlane(tstart[e])) * BM; u.cn = (int)cnt[half * NE + e];
    }
};
struct PolGateUp {
    static constexpr bool PERM = true, GATHER = true, FP8 = true, ROWS = true;
    const fp8_t* A; const fp8_t* Bt; const float* bgu; const u32* toktab; const float* wtab; fp8_t* O; MoeTiles mt; TileOrder ord;
    __device__ __forceinline__ void stage_rows(const Unit& u, int par) const { mt.stage(u, par, toktab, wtab);
        const int c = (int)threadIdx.x - BM; mt.stage_bias(par, bgu + (size_t)u.e * 2048 + (c < HALFT ? u.pn * HALFT + c : 1024 + u.pn * HALFT + (c - HALFT))); }
    __device__ __forceinline__ unsigned a_off_l(int par, int r) const { const u32 tk = mt.rows(par)[r * 2]; return (tk == ~0u ? 0u : (tk >> 2)) * 1024u; }
    __device__ __forceinline__ bool next(int i, Unit& u) const { if (!ord.tile(i, u.pm, u.pn)) return false; mt.find(u); return true; }
    __device__ __forceinline__ const char* a_base(const Unit&) const { return (const char*)A; }
    __device__ __forceinline__ unsigned a_off(const Unit& u, int r) const {
        const int p = u.pos0 + r; const u32 tk = toktab[((size_t)mt.half * NE + u.e) * CAP + (p < u.cn ? p : 0)];
        return (tk >> 2) * 1024u;
    }
    __device__ __forceinline__ const char* b_base(const Unit& u) const { return (const char*)Bt + ((size_t)u.e * 2048 + (size_t)u.pn * BM) * 1024; }
    __device__ __forceinline__ void epi(const f32x4 (&acc)[2][2][4][2], const Unit& u, int wr, int wc, int fr, int fq, int par) const {
        const int row0 = u.pm * BM + wr * 64 + fr, cc = u.pn * HALFT + wc * 32 + 8 * fq;
        const LAS float* bt = mt.bias(par) + wc * 32 + 8 * fq;
        f32x4 bg[2], bu[2];
        bg[0] = *(const LAS f32x4*)bt; bg[1] = *(const LAS f32x4*)(bt + 4); bu[0] = *(const LAS f32x4*)(bt + HALFT); bu[1] = *(const LAS f32x4*)(bt + HALFT + 4);
        constexpr float inv = 1.0f / (SC_H2 * SC_W), kexp = -1.702f * 1.4426950408889634f;
        const f32x2 inv2 = (f32x2){inv, inv}, kexp2 = (f32x2){kexp, kexp}, one2 = (f32x2){1.0f, 1.0f}, sc2 = (f32x2){SC_ACT, SC_ACT};
#pragma unroll
        for (int ai = 0; ai < 2; ++ai)
#pragma unroll
            for (int m = 0; m < 4; ++m) {
                uint2 w;
#pragma unroll
                for (int n = 0; n < 2; ++n) {
                    int pk = 0;
#pragma unroll
                    for (int hh = 0; hh < 2; ++hh) {
                        const f32x4 ga4 = acc[ai][0][m][n], ua4 = acc[ai][1][m][n];
                        f32x2 g = (f32x2){ga4[2 * hh], ga4[2 * hh + 1]} * inv2 + (f32x2){bg[n][2 * hh], bg[n][2 * hh + 1]};
                        f32x2 uu = (f32x2){ua4[2 * hh], ua4[2 * hh + 1]} * inv2 + (f32x2){bu[n][2 * hh], bu[n][2 * hh + 1]};
                        g.x = fminf(g.x, 7.0f); g.y = fminf(g.y, 7.0f);
                        uu.x = __builtin_amdgcn_fmed3f(uu.x, -7.0f, 7.0f); uu.y = __builtin_amdgcn_fmed3f(uu.y, -7.0f, 7.0f);
                        const f32x2 t = g * kexp2;
                        const f32x2 d = (f32x2){__builtin_amdgcn_exp2f(t.x), __builtin_amdgcn_exp2f(t.y)} + one2;
                        const f32x2 r = (f32x2){frcp(d.x), frcp(d.y)};
                        const f32x2 o = (g * (uu * sc2 + sc2)) * r;
                        pk = hh ? __builtin_amdgcn_cvt_pk_fp8_f32(o.x, o.y, pk, true) : __builtin_amdgcn_cvt_pk_fp8_f32(o.x, o.y, pk, false);
                    }
                    if (n == 0) w.x = (unsigned)pk; else w.y = (unsigned)pk;
                }
                *(uint2*)(O + (size_t)(row0 + ai * HALFT + m * 16) * DFF + cc) = w;
                asm volatile("" ::: "memory");
            }
    }
};
struct PolDown {
    static constexpr bool PERM = true, GATHER = false, FP8 = true, ROWS = true;
    const fp8_t* A; const fp8_t* Bt; const float* bd; const u32* toktab; const float* wtab; fp8_t* O; MoeTiles mt; TileOrder ord;
    __device__ __forceinline__ void stage_rows(const Unit& u, int par) const { mt.stage(u, par, toktab, wtab); mt.stage_bias(par, bd + (size_t)u.e * D + u.pn * BM + ((int)threadIdx.x - BM)); }
    __device__ __forceinline__ unsigned a_off_l(int, int) const { return 0u; }
    __device__ __forceinline__ bool next(int i, Unit& u) const { if (!ord.tile(i, u.pm, u.pn)) return false; mt.find(u); return true; }
    __device__ __forceinline__ const char* a_base(const Unit& u) const { return (const char*)A + (size_t)u.pm * BM * 1024; }
    __device__ __forceinline__ unsigned a_off(const Unit&, int r) const { return (unsigned)r * 1024u; }
    __device__ __forceinline__ const char* b_base(const Unit& u) const { return (const char*)Bt + ((size_t)u.e * 1024 + (size_t)u.pn * BM) * 1024; }
    __device__ __forceinline__ void epi(const f32x4 (&acc)[2][2][4][2], const Unit& u, int wr, int wc, int fr, int fq, int par) const {
        const int col0 = u.pn * BM + wc * 32 + 8 * fq;
        const LAS float* bp = mt.bias(par) + wc * 32 + 8 * fq;
        f32x4 bv[2][2];
#pragma unroll
        for (int bj = 0; bj < 2; ++bj) { bv[bj][0] = *(const LAS f32x4*)(bp + bj * HALFT); bv[bj][1] = *(const LAS f32x4*)(bp + bj * HALFT + 4); }
        const LAS u32* rt = mt.rows(par);
        constexpr float inv = 1.0f / (SC_ACT * SC_W);
#pragma unroll
        for (int ai = 0; ai < 2; ++ai)
#pragma unroll
            for (int m = 0; m < 4; ++m) {
                const int rr = ai * HALFT + wr * 64 + m * 16 + fr;
                const u32 tk = rt[rr * 2];
                if (tk != ~0u) {
                    const float wg = __uint_as_float(rt[rr * 2 + 1]) * SC_Y;
                    fp8_t* rowp = O + (size_t)(tk - (u32)mt.half * HALF_TOK * 4u) * D + col0;
#pragma unroll
                    for (int bj = 0; bj < 2; ++bj) { const f32x4 v0 = (acc[ai][bj][m][0] * inv + bv[bj][0]) * wg, v1 = (acc[ai][bj][m][1] * inv + bv[bj][1]) * wg;
                        uint2 w; w.x = pk4_fp8(v0[0], v0[1], v0[2], v0[3]); w.y = pk4_fp8(v1[0], v1[1], v1[2], v1[3]);
                        *(uint2*)(rowp + bj * HALFT) = w; }
                }
            }
    }
};
__device__ __forceinline__ int moe_tile_table(LAS int* tstart, const u32* cnt, int half) {
    __syncthreads();
    if (threadIdx.x == 0) { int s = 0; for (int e = 0; e < NE; ++e) { tstart[e] = s; s += ((int)cnt[half * NE + e] + BM - 1) / BM; } tstart[NE] = s; }
    __syncthreads();
    const int tot = tstart[NE];
    for (int t = threadIdx.x; t < tot; t += 512) { int e = 0;
#pragma unroll 1
        for (int i = 1; i < NE; ++i) if (t >= tstart[i]) e = i;
        tstart[64 + t] = e; }
    __syncthreads();
    return tot;
}

__device__ __forceinline__ void conv_item(const float* __restrict__ W, int N, bf16_t* __restrict__ WT, int k0, int n0, size_t rowbase, LAS float* scr, int lane) {
#pragma unroll 4
    for (int i = 0; i < 16; ++i) { const int k = 4 * i + (lane >> 4); const f32x4 v = __builtin_nontemporal_load((const f32x4*)(W + (size_t)(k0 + k) * N + n0 + (lane & 15) * 4)); *(LAS f32x4*)(scr + k * 68 + (lane & 15) * 4) = v; }
    asm volatile("s_waitcnt lgkmcnt(0)" ::: "memory");
    const int c = lane & 7;
#pragma unroll
    for (int j = 0; j < 8; ++j) { const int n = (lane >> 3) + 8 * j; const LAS float* s = scr + (8 * c) * 68 + n;
        u32x4 o; o.x = cvt_pk_bf16(s[0 * 68], s[1 * 68]); o.y = cvt_pk_bf16(s[2 * 68], s[3 * 68]); o.z = cvt_pk_bf16(s[4 * 68], s[5 * 68]); o.w = cvt_pk_bf16(s[6 * 68], s[7 * 68]);
        *(u32x4*)(WT + (rowbase + n) * GK + k0 + 8 * c) = o; }
    asm volatile("s_waitcnt lgkmcnt(0)" ::: "memory");
}
__device__ __forceinline__ void conv_item8(const float* __restrict__ W, int N, fp8_t* __restrict__ WT, int k0, int n0, size_t rowbase, LAS float* scr, int lane) {
#pragma unroll 4
    for (int i = 0; i < 16; ++i) { const int k = 4 * i + (lane >> 4); const f32x4 v = __builtin_nontemporal_load((const f32x4*)(W + (size_t)(k0 + k) * N + n0 + (lane & 15) * 4)); *(LAS f32x4*)(scr + k * 68 + (lane & 15) * 4) = v; }
    asm volatile("s_waitcnt lgkmcnt(0)" ::: "memory");
    const LAS float* sp = scr + lane;
#pragma unroll
    for (int q = 0; q < 4; ++q) {
        u32x4 o;
        o.x = pk4_fp8(sp[(16 * q + 0) * 68] * SC_W, sp[(16 * q + 1) * 68] * SC_W, sp[(16 * q + 2) * 68] * SC_W, sp[(16 * q + 3) * 68] * SC_W);
        o.y = pk4_fp8(sp[(16 * q + 4) * 68] * SC_W, sp[(16 * q + 5) * 68] * SC_W, sp[(16 * q + 6) * 68] * SC_W, sp[(16 * q + 7) * 68] * SC_W);
        o.z = pk4_fp8(sp[(16 * q + 8) * 68] * SC_W, sp[(16 * q + 9) * 68] * SC_W, sp[(16 * q + 10) * 68] * SC_W, sp[(16 * q + 11) * 68] * SC_W);
        o.w = pk4_fp8(sp[(16 * q + 12) * 68] * SC_W, sp[(16 * q + 13) * 68] * SC_W, sp[(16 * q + 14) * 68] * SC_W, sp[(16 * q + 15) * 68] * SC_W);
        *(u32x4*)(WT + (rowbase + lane) * GK + k0 + 16 * q) = o;
    }
    asm volatile("s_waitcnt lgkmcnt(0)" ::: "memory");
}
constexpr int IT_IN = 16 * (INW / 64), IT_OUT = 16 * (D / 64), IT_GU = NE * 16 * 32, IT_D = NE * 16 * 16, IT_ALL = IT_IN + IT_OUT + IT_GU + IT_D;
struct ProArgs { const float *c, *c_ctx, *w_ada, *b_ada, *lbl, *w_in, *w_out, *wgu, *wd, *rg_wa, *rg_wx, *rg_lam; float *mod, *lb, *coef; bf16_t *Win_t, *Wout_t, *WG_t; fp8_t *Wgu_t, *Wd_t; };
__device__ __forceinline__ void phase_prologue(LAS unsigned char* lds, const ProArgs& a, int bid, int G, bool do_mod, int it_lo, int it_hi) {
    int tl_ = threadIdx.x; asm volatile("" : "+v"(tl_));
    const int tid = tl_, lane = tid & 63, w = tid >> 6;
    if (!do_mod) {} else if (bid < 96) {
        LAS float* s = (LAS float*)lds;
        for (int i = tid; i < 33 * D; i += 512) { const int b = i >> 10, k = i & 1023; const float v = b < NB ? a.c[(size_t)b * D + k] : a.c_ctx[k]; s[i] = v * sigmoidf_(v); }
        __syncthreads();
        const int n = bid * 64 + lane;
        float acc[33];
#pragma unroll
        for (int b = 0; b < 33; ++b) acc[b] = 0.f;
#pragma unroll 1
        for (int k = 128 * w; k < 128 * w + 128; k += 16) {
            float wv[16];
#pragma unroll
            for (int i = 0; i < 16; ++i) wv[i] = __builtin_nontemporal_load(a.w_ada + (size_t)(k + i) * 6144 + n);
#pragma unroll
            for (int b = 0; b < 33; ++b)
#pragma unroll
                for (int i4 = 0; i4 < 4; ++i4) { const f32x4 sv = *(const LAS f32x4*)(s + b * D + k + 4 * i4); acc[b] += sv[0] * wv[4 * i4] + sv[1] * wv[4 * i4 + 1] + sv[2] * wv[4 * i4 + 2] + sv[3] * wv[4 * i4 + 3]; }
        }
        __syncthreads();
        LAS float* red = (LAS float*)lds;
#pragma unroll
        for (int b = 0; b < 33; ++b) red[(w * 33 + b) * 64 + lane] = acc[b];
        __syncthreads();
        for (int i = tid; i < 33 * 64; i += 512) { const int b = i >> 6, l = i & 63; float sum = a.b_ada[bid * 64 + l];
#pragma unroll
            for (int ww = 0; ww < 8; ++ww) sum += red[(ww * 33 + b) * 64 + l];
            a.mod[(size_t)b * 6144 + bid * 64 + l] = sum; }
        __syncthreads();
    } else if (bid == 96) {
        for (int i = tid; i < 2 * HGW; i += 512) { const float l0 = a.lbl[i], l1 = a.lbl[2 * HGW + i]; a.lb[i] = 1.0f / (1.0f + __expf(l1 - l0)); }
        for (int i = tid; i < 2 * RGW; i += 512) { const float l = a.rg_lam[i]; const float sp = (-l > 20.f) ? -l : log1pf(__expf(-l)); a.coef[i] = -8.0f * sp; }
    } else if (bid == 97) {
        for (int idx = tid; idx < 8 * 256 * 64; idx += 512) { const int hd = idx >> 14, n = (idx >> 6) & 255, kk = idx & 63, g = n >> 6, j = n & 63, d = g >> 1;
            const float* src = (g & 1) ? a.rg_wx : a.rg_wa; a.WG_t[idx] = f2bf(src[(((size_t)d * 8 + hd) * 64 + kk) * 64 + j]); }
    }
    LAS float* scr = (LAS float*)(lds + w * (64 * 68 * 4));
    const int gw = bid * 8 + w, NW = G * 8;
    for (int it = it_lo + gw; it < it_hi; it += NW) {
        int r = it;
        if (r < IT_IN) { const int kb = r / (INW / 64), nb = r % (INW / 64); conv_item(a.w_in, INW, a.Win_t, kb * 64, nb * 64, (size_t)nb * 64, scr, lane); continue; } r -= IT_IN;
        if (r < IT_OUT) { const int kb = r / 16, nb = r % 16; conv_item(a.w_out, D, a.Wout_t, kb * 64, nb * 64, (size_t)nb * 64, scr, lane); continue; } r -= IT_OUT;
        if (r < IT_GU) { const int bk = r >> 3, w8 = r & 7, e = bk / 64, t = bk % 64, kb = 2 * (t / 8) + (w8 & 1), nb = 4 * (t % 8) + (w8 >> 1), n0 = nb * 64, bj = n0 >> 10, rem = n0 & 1023, pn = rem >> 7, cc0 = rem & 127;
            conv_item8(a.wgu + (size_t)e * D * 2048, 2048, a.Wgu_t, kb * 64, n0, (size_t)e * 2048 + pn * 256 + bj * 128 + cc0, scr, lane); continue; } r -= IT_GU;
        { const int bk = r >> 3, w8 = r & 7, e = bk / 32, t = bk % 32, kb = 2 * (t / 4) + (w8 & 1), nb = 4 * (t % 4) + (w8 >> 1); conv_item8(a.wd + (size_t)e * DFF * D, D, a.Wd_t, kb * 64, nb * 64, (size_t)e * 1024 + nb * 64, scr, lane); }
    }
}


__device__ __forceinline__ void phase_norm1(const float* __restrict__ x, const float* __restrict__ ctx, const float* __restrict__ nw, const float* __restrict__ mod, bf16_t* __restrict__ H, int bid, int G) {
    constexpr int RB = 4;
    int tl_ = threadIdx.x; asm volatile("" : "+v"(tl_));
    const int lane = tl_ & 63, gw = bid * 8 + (tl_ >> 6), NW = G * 8;
    for (int r0 = gw; r0 < NROWS; r0 += RB * NW) {
        f32x4 v[RB][4];
#pragma unroll
        for (int q = 0; q < RB; ++q) { const int r = r0 + q * NW; const int rr = r < NROWS ? r : r0;
            const float* src = rr < NLAT ? x + (size_t)rr * D : ctx + (size_t)(rr - NLAT) * D;
#pragma unroll
            for (int j = 0; j < 4; ++j) v[q][j] = __builtin_nontemporal_load((const f32x4*)(src + j * 256 + lane * 4)); }
#pragma unroll
        for (int q = 0; q < RB; ++q) { const int r = r0 + q * NW; if (r < NROWS) {
            const float* m = mod + (size_t)(r < NLAT ? (r >> 11) : NB) * 6144;
            float ss = 0.f;
#pragma unroll
            for (int j = 0; j < 4; ++j) ss += v[q][j][0] * v[q][j][0] + v[q][j][1] * v[q][j][1] + v[q][j][2] * v[q][j][2] + v[q][j][3] * v[q][j][3];
            const float rstd = __builtin_amdgcn_rsqf(wave_sum(ss) * (1.0f / D) + EPS);
#pragma unroll
            for (int j = 0; j < 4; ++j) {
                const int c0 = j * 256 + lane * 4;
                const f32x4 w = *(const f32x4*)(nw + c0), sh = *(const f32x4*)(m + c0), sc = *(const f32x4*)(m + 1024 + c0);
                const f32x4 o = v[q][j] * rstd * w * (sc + 1.0f) + sh;
                uint2 p; p.x = cvt_pk_bf16(o[0], o[1]); p.y = cvt_pk_bf16(o[2], o[3]);
                *(uint2*)(H + (size_t)r * D + c0) = p;
            } } }
    }
}

__device__ __forceinline__ bf16x8 pack8(const f32x4& a, const f32x4& b) {
    u32x4 w; w.x = cvt_pk_bf16(a[0], a[1]); w.y = cvt_pk_bf16(a[2], a[3]); w.z = cvt_pk_bf16(b[0], b[1]); w.w = cvt_pk_bf16(b[2], b[3]);
    return __builtin_bit_cast(bf16x8, w);
}
constexpr int HW_BUF = 45056;
constexpr int HW_QD = 0, HW_KET = 17408, HW_PM = 35840;
constexpr int HW_VT = 2 * HW_BUF, HW_KD = HW_VT + 18432, HW_OS = HW_KD + 17408, HW_TOT = HW_OS + 17408, HW_DEC = HW_TOT + 2048;
__device__ __forceinline__ void phase_hgrn2_ws(LAS unsigned char* lds, const bf16_t* __restrict__ P, const float* __restrict__ lb, bf16_t* __restrict__ OF, bf16_t* __restrict__ OB, int item) {
    const int b = item >> 3, h = (item >> 1) & 3, dir = item & 1;
    const int tid = threadIdx.x, w = __builtin_amdgcn_readfirstlane(tid >> 6), lane = tid & 63, l15 = lane & 15, G4 = lane >> 4;
    bf16_t* OD = dir ? OB : OF;
    const int cf = dir ? C_FB : C_FF;
    constexpr int NC = (CTXL + T) / 64;
    LAS float* TOT = (LAS float*)(lds + HW_TOT);
#define HW_BAR() do { asm volatile("s_waitcnt lgkmcnt(0)" ::: "memory"); __builtin_amdgcn_s_barrier(); asm volatile("" ::: "memory"); } while (0)
    __syncthreads();
    if (w >= 4) {
        const int et = tid - 256, kp = et & 63, k = 2 * kp, seg = et >> 6, ew = w - 4;
        const int kslot = (k & ~31) | (((k >> 2) & 3) << 3) | (((k >> 4) & 1) << 2) | (k & 3);
        const float lb0 = lb[dir * HGW + h * 128 + k], lb1 = lb[dir * HGW + h * 128 + k + 1];
        const char* Pc = (const char*)P; const int sstep = dir ? -(INW * 2) : INW * 2;
#define HW_OFF0(m_) ({ const int p_ = 64 * (m_) + 16 * seg; const unsigned r_ = p_ < CTXL ? (unsigned)(NLAT + b * CTXL + (dir ? CTXL - 1 - p_ : p_)) : (unsigned)(b * T + (dir ? T - 1 - (p_ - CTXL) : (p_ - CTXL))); (r_ * (unsigned)INW + (unsigned)(h * 128 + k)) * 2u; })
#define HW_LD(off0_, i_, col_) (*(const u32*)(Pc + (unsigned)((int)(off0_) + (i_) * sstep + (col_) * 2)))
#define BF_LO(w_) __uint_as_float((w_) << 16)
#define BF_HI(w_) __uint_as_float((w_) & 0xffff0000u)
        u32 rf[16];
        { const unsigned o0 = HW_OFF0(0);
#pragma unroll
        for (int i = 0; i < 16; ++i) rf[i] = HW_LD(o0, i, cf); }
#pragma unroll 1
        for (int m = 0; m < NC + 1; ++m) {
            const int par = m & 1;
            LAS unsigned char* buf = lds + par * HW_BUF;
            HW_BAR();
            u32 rq[16], rv[16]; float f0v[16], f1v[16], c0v[16], c1v[16]; float run0 = 1.f, run1 = 1.f;
            if (m < NC) {
                const unsigned o0 = HW_OFF0(m);
#pragma unroll
                for (int i = 0; i < 16; ++i) { rq[i] = HW_LD(o0, i, C_Q); rv[i] = HW_LD(o0, i, C_I); }
#pragma unroll
                for (int i = 0; i < 16; ++i) { const float f0 = lb0 + (1.f - lb0) * sigmoidf_(BF_LO(rf[i])), f1 = lb1 + (1.f - lb1) * sigmoidf_(BF_HI(rf[i]));
                    f0v[i] = f0; f1v[i] = f1; run0 *= f0; run1 *= f1; c0v[i] = run0; c1v[i] = run1; }
                *(LAS f32x2*)(TOT + seg * 128 + k) = (f32x2){run0, run1};
                if (m + 1 < NC) { const unsigned o1 = HW_OFF0(m + 1);
#pragma unroll
                    for (int i = 0; i < 16; ++i) rf[i] = HW_LD(o1, i, cf); }
            }
            HW_BAR();
            if (m < NC) {
                f32x2 tt[4];
#pragma unroll
                for (int q = 0; q < 4; ++q) tt[q] = *(const LAS f32x2*)(TOT + q * 128 + k);
                const float p0 = seg == 0 ? 1.f : seg == 1 ? tt[0].x : seg == 2 ? tt[0].x * tt[1].x : tt[0].x * tt[1].x * tt[2].x;
                const float p1 = seg == 0 ? 1.f : seg == 1 ? tt[0].y : seg == 2 ? tt[0].y * tt[1].y : tt[0].y * tt[1].y * tt[2].y;
                const float eb0 = (tt[0].x * tt[1].x) * (tt[2].x * tt[3].x), eb1 = (tt[0].y * tt[1].y) * (tt[2].y * tt[3].y);
                if (seg == 0) *(LAS f32x2*)(lds + HW_DEC + par * 512 + k * 4) = (f32x2){eb0, eb1};
                float ke0[16], ke1[16];
#pragma unroll
                for (int i = 0; i < 16; ++i) {
                    const int j = 16 * seg + i;
                    const float e0 = p0 * c0v[i], e1 = p1 * c1v[i];
                    const float kf0 = (1.f - f0v[i]) * frcp(e0), kf1 = (1.f - f1v[i]) * frcp(e1);
                    *(LAS u32*)(buf + HW_QD + j * 272 + kslot * 2) = cvt_pk_bf16(BF_LO(rq[i]) * e0, BF_HI(rq[i]) * e1);
                    *(LAS u32*)(lds + HW_KD + j * 272 + kslot * 2) = cvt_pk_bf16(kf0, kf1);
                    ke0[i] = kf0 * eb0; ke1[i] = kf1 * eb1;
                }
#pragma unroll
                for (int q4 = 0; q4 < 2; ++q4) {
                    u32x4 a0, a1, v0, v1;
#pragma unroll
                    for (int i = 0; i < 4; ++i) { const int t = 8 * q4 + 2 * i;
                        a0[i] = cvt_pk_bf16(ke0[t], ke0[t + 1]); a1[i] = cvt_pk_bf16(ke1[t], ke1[t + 1]);
                        v0[i] = (rv[t] & 0xffffu) | (rv[t + 1] << 16); v1[i] = (rv[t] >> 16) | (rv[t + 1] & 0xffff0000u); }
                    *(LAS u32x4*)(buf + HW_KET + k * 144 + seg * 32 + q4 * 16) = a0; *(LAS u32x4*)(buf + HW_KET + (k + 1) * 144 + seg * 32 + q4 * 16) = a1;
                    *(LAS u32x4*)(lds + HW_VT + k * 144 + seg * 32 + q4 * 16) = v0; *(LAS u32x4*)(lds + HW_VT + (k + 1) * 144 + seg * 32 + q4 * 16) = v1;
                }
            }
            HW_BAR();
            if (m < NC && m >= CTXL / 64) {
                const int mt = ew;
                f32x4 pa[4];
#pragma unroll
                for (int q = 0; q < 4; ++q) pa[q] = (f32x4){0.f, 0.f, 0.f, 0.f};
#pragma unroll
                for (int s = 0; s < 4; ++s) {
                    const bf16x8 a = *(const LAS bf16x8*)(buf + HW_QD + (16 * mt + l15) * 272 + (32 * s + 8 * G4) * 2);
#pragma unroll
                    for (int q = 0; q < 4; ++q) { const bf16x8 bq = *(const LAS bf16x8*)(lds + HW_KD + (16 * q + l15) * 272 + (32 * s + 8 * G4) * 2); pa[q] = __builtin_amdgcn_mfma_f32_16x16x32_bf16(a, bq, pa[q], 0, 0, 0); }
                }
#pragma unroll
                for (int q = 0; q < 4; ++q)
#pragma unroll
                    for (int r = 0; r < 4; ++r) { const int c = 16 * mt + 4 * G4 + r, j = 16 * q + l15; *(LAS bf16_t*)(buf + HW_PM + c * 144 + j * 2) = f2bf(j <= c ? pa[q][r] : 0.f); }
                asm volatile("s_waitcnt lgkmcnt(0)" ::: "memory");
            }
        }
#undef HW_OFF0
#undef HW_LD
#undef BF_LO
#undef BF_HI
    } else {
        f32x4 S[8][2];
#pragma unroll
        for (int t = 0; t < 8; ++t) { S[t][0] = (f32x4){0.f, 0.f, 0.f, 0.f}; S[t][1] = (f32x4){0.f, 0.f, 0.f, 0.f}; }
        HW_BAR(); HW_BAR(); HW_BAR();
#pragma unroll 1
        for (int n = 0; n < NC; ++n) {
            const int par = n & 1; const bool lat = n >= CTXL / 64;
            LAS unsigned char* buf = lds + par * HW_BUF;
            HW_BAR();
            bf16x8 vb[2][2];
#pragma unroll
            for (int nt = 0; nt < 2; ++nt)
#pragma unroll
                for (int s = 0; s < 2; ++s) vb[nt][s] = *(const LAS bf16x8*)(lds + HW_VT + (32 * w + 16 * nt + l15) * 144 + (32 * s + 8 * G4) * 2);
            HW_BAR();
            if (lat) {
                bf16x8 sb[2][4];
#pragma unroll
                for (int nt = 0; nt < 2; ++nt)
#pragma unroll
                    for (int s = 0; s < 4; ++s) sb[nt][s] = pack8(S[2 * s][nt], S[2 * s + 1][nt]);
#pragma unroll
                for (int mt = 0; mt < 4; ++mt) {
                    f32x4 oa[2] = {(f32x4){0.f, 0.f, 0.f, 0.f}, (f32x4){0.f, 0.f, 0.f, 0.f}};
#pragma unroll
                    for (int s = 0; s < 2; ++s) { const bf16x8 a = *(const LAS bf16x8*)(buf + HW_PM + (16 * mt + l15) * 144 + (32 * s + 8 * G4) * 2);
                        oa[0] = __builtin_amdgcn_mfma_f32_16x16x32_bf16(a, vb[0][s], oa[0], 0, 0, 0); oa[1] = __builtin_amdgcn_mfma_f32_16x16x32_bf16(a, vb[1][s], oa[1], 0, 0, 0); }
#pragma unroll
                    for (int s = 0; s < 4; ++s) { const bf16x8 a = *(const LAS bf16x8*)(buf + HW_QD + (16 * mt + l15) * 272 + (32 * s + 8 * G4) * 2);
                        oa[0] = __builtin_amdgcn_mfma_f32_16x16x32_bf16(a, sb[0][s], oa[0], 0, 0, 0); oa[1] = __builtin_amdgcn_mfma_f32_16x16x32_bf16(a, sb[1][s], oa[1], 0, 0, 0); }
#pragma unroll
                    for (int nt = 0; nt < 2; ++nt)
#pragma unroll
                        for (int r = 0; r < 4; ++r) *(LAS bf16_t*)(lds + HW_OS + (16 * mt + 4 * G4 + r) * 272 + (32 * w + 16 * nt + l15) * 2) = f2bf(oa[nt][r]);
                }
            }
#pragma unroll
            for (int t = 0; t < 8; ++t) {
                const f32x4 d4 = *(const LAS f32x4*)(lds + HW_DEC + par * 512 + (16 * t + 4 * G4) * 4);
                S[t][0] = S[t][0] * d4; S[t][1] = S[t][1] * d4;
#pragma unroll
                for (int s = 0; s < 2; ++s) { const bf16x8 a = *(const LAS bf16x8*)(buf + HW_KET + (16 * t + l15) * 144 + (32 * s + 8 * G4) * 2);
                    S[t][0] = __builtin_amdgcn_mfma_f32_16x16x32_bf16(a, vb[0][s], S[t][0], 0, 0, 0); S[t][1] = __builtin_amdgcn_mfma_f32_16x16x32_bf16(a, vb[1][s], S[t][1], 0, 0, 0); }
            }
            HW_BAR();
            if (lat) {
                const int j = tid >> 2, part = tid & 3, p = 64 * n + j, tt = dir ? T - 1 - (p - CTXL) : (p - CTXL);
                bf16_t* dst = OD + ((size_t)b * T + tt) * HGW + h * 128 + part * 32;
#pragma unroll
                for (int q = 0; q < 4; ++q) *(u32x4*)(dst + q * 8) = *(const LAS u32x4*)(lds + HW_OS + j * 272 + part * 64 + q * 16);
            }
        }
    }
    __syncthreads();
#undef HW_BAR
}

__device__ __forceinline__ size_t rg_row(int b, bool lat, int p) {
    return lat ? (size_t)b * T + (size_t)(p % GROWS) * GRIDW + (p / GROWS) : (size_t)NLAT + b * CTXL + p;
}
constexpr int RC_T = 64 * 144;
constexpr int RC_XC = 0, RC_RG = 2 * RC_T, RC_HI = 4 * RC_T, RC_OUT = 6 * RC_T;
__device__ __forceinline__ void phase_rg_chain(LAS unsigned char* lds, const bf16_t* __restrict__ P, const float* __restrict__ conv_w, const float* __restrict__ conv_b, const bf16_t* __restrict__ WG_t,
                                               const float* __restrict__ ba, const float* __restrict__ bx, const float* __restrict__ coef, bf16_t* __restrict__ HT, bf16_t* __restrict__ MIX, int item) {
    const int b = item >> 3, hd = item & 7;
    const int tid = threadIdx.x, w = __builtin_amdgcn_readfirstlane(tid >> 6), lane = tid & 63, l15 = lane & 15, G4 = lane >> 4;
    const int d = w >> 2, cg = w & 3, ch = 64 * hd + 16 * cg + l15;
    const int ds = tid >> 8, t8 = tid & 255, pg = t8 >> 4, cg4 = t8 & 15;
    bf16x8 F[4];
#pragma unroll
    for (int s = 0; s < 2; ++s) {
        F[s] = *(const bf16x8*)(WG_t + ((size_t)(hd * 256 + 64 * (2 * d) + 16 * cg + l15) * 64 + 32 * s + 8 * G4));
        F[2 + s] = *(const bf16x8*)(WG_t + ((size_t)(hd * 256 + 64 * (2 * d + 1) + 16 * cg + l15) * 64 + 32 * s + 8 * G4)); }
    const float bav = ba[d * RGW + ch], bxv = bx[d * RGW + ch], cf = coef[d * RGW + ch];
    const f32x4 cw0 = *(const f32x4*)(conv_w + 0 * RGW + 64 * hd + 4 * cg4), cw1 = *(const f32x4*)(conv_w + 1 * RGW + 64 * hd + 4 * cg4), cw2 = *(const f32x4*)(conv_w + 2 * RGW + 64 * hd + 4 * cg4),
                cw3 = *(const f32x4*)(conv_w + 3 * RGW + 64 * hd + 4 * cg4), cb4 = *(const f32x4*)(conv_b + 64 * hd + 4 * cg4);
    float hcar = 0.f;
#define RC_CHUNK(dd, s_) ((dd) == 0 ? (s_) : ((s_) < CTXL / 64 ? CTXL / 64 - 1 - (s_) : NCHK + CTXL / 64 - 1 - (s_)))
    u32x2 rxr[7]; u32x4 rgr[2], hir[2];
#define RC_LOAD_RX(s_) do { const int n_ = RC_CHUNK(ds, s_); const bool lat_ = n_ >= CTXL / 64; const int L_ = lat_ ? T : CTXL, p0_ = 64 * (lat_ ? n_ - CTXL / 64 : n_); \
        _Pragma("unroll") for (int i = 0; i < 7; ++i) { const int p = p0_ + 4 * pg - 2 + i; rxr[i] = (p >= 0 && p < L_) ? *(const u32x2*)(P + rg_row(b, lat_, p) * INW + C_RX + 64 * hd + 4 * cg4) : (u32x2){0u, 0u}; } } while (0)
#define RC_ROW(s_, q_) (rg_row(b, true, 64 * (RC_CHUNK(ds, s_) - CTXL / 64) + ((q_) >> 3)))
#define RC_LOAD_RG(s_) do { _Pragma("unroll") for (int j = 0; j < 2; ++j) { const int q = t8 * 2 + j; rgr[j] = *(const u32x4*)(P + RC_ROW(s_, q) * INW + C_RG + 64 * hd + (q & 7) * 8); } } while (0)
#define RC_LOAD_HI(s_) do { _Pragma("unroll") for (int j = 0; j < 2; ++j) { const int q = t8 * 2 + j; rgr[j] = rgr[j]; hir[j] = __builtin_nontemporal_load((const u32x4*)(HT + RC_ROW(s_, q) * RGW + 64 * hd + (q & 7) * 8)); } } while (0)
    RC_LOAD_RX(0);
#pragma unroll 1
    for (int s = 0; s < NCHK; ++s) {
        const int role = s < CTXL / 64 ? 0 : (s < 20 ? 1 : 2);
        if (s == 20) { asm volatile("s_waitcnt vmcnt(0)" ::: "memory"); __syncthreads(); RC_LOAD_RG(20); RC_LOAD_HI(20); }
        {
            float xin[7][4];
#pragma unroll
            for (int i = 0; i < 7; ++i) { xin[i][0] = __uint_as_float(rxr[i].x << 16); xin[i][1] = __uint_as_float(rxr[i].x & 0xffff0000u); xin[i][2] = __uint_as_float(rxr[i].y << 16); xin[i][3] = __uint_as_float(rxr[i].y & 0xffff0000u); }
#pragma unroll
            for (int q = 0; q < 4; ++q) {
                float o[4];
#pragma unroll
                for (int c = 0; c < 4; ++c) o[c] = cb4[c] + cw0[c] * xin[q][c] + cw1[c] * xin[q + 1][c] + cw2[c] * xin[q + 2][c] + cw3[c] * xin[q + 3][c];
                *(LAS unsigned long long*)(lds + RC_XC + ds * RC_T + (4 * pg + q) * 144 + cg4 * 8) = ((unsigned long long)cvt_pk_bf16(o[2], o[3]) << 32) | cvt_pk_bf16(o[0], o[1]);
            }
            if (role == 2) {
#pragma unroll
                for (int j = 0; j < 2; ++j) { const int q = t8 * 2 + j; *(LAS u32x4*)(lds + RC_RG + ds * RC_T + (q >> 3) * 144 + (q & 7) * 16) = rgr[j]; *(LAS u32x4*)(lds + RC_HI + ds * RC_T + (q >> 3) * 144 + (q & 7) * 16) = hir[j]; }
            }
        }
        __syncthreads();
        if (s + 1 < NCHK) { RC_LOAD_RX(s + 1); if (s + 1 > 20) { RC_LOAD_RG(s + 1); RC_LOAD_HI(s + 1); } }
        {
            bf16x8 af[4][2];
#pragma unroll
            for (int mt = 0; mt < 4; ++mt)
#pragma unroll
                for (int k = 0; k < 2; ++k) af[mt][k] = *(const LAS bf16x8*)(lds + RC_XC + d * RC_T + (16 * (l15 >> 2) + 4 * mt + (l15 & 3)) * 144 + (32 * k + 8 * G4) * 2);
            f32x4 ra[4], xa[4];
#pragma unroll
            for (int mt = 0; mt < 4; ++mt) { ra[mt] = (f32x4){0.f, 0.f, 0.f, 0.f}; xa[mt] = (f32x4){0.f, 0.f, 0.f, 0.f};
#pragma unroll
                for (int k = 0; k < 2; ++k) { ra[mt] = __builtin_amdgcn_mfma_f32_16x16x32_bf16(af[mt][k], F[k], ra[mt], 0, 0, 0); xa[mt] = __builtin_amdgcn_mfma_f32_16x16x32_bf16(af[mt][k], F[2 + k], xa[mt], 0, 0, 0); } }
            float av[16], bv[16];
#pragma unroll
            for (int t = 0; t < 16; ++t) {
                const float r = sigmoidf_(ra[t >> 2][t & 3] + bav), ig = sigmoidf_(xa[t >> 2][t & 3] + bxv);
                const float a = fexp(cf * r);
                av[t] = a; bv[t] = fsqrt(fmaxf(1.0f - a * a, 0.f)) * ig * bf2f(*(const LAS bf16_t*)(lds + RC_XC + d * RC_T + (16 * G4 + t) * 144 + (16 * cg + l15) * 2));
            }
            float Al = 1.f, Bl = 0.f;
            if (d == 0) {
#pragma unroll
                for (int t = 0; t < 16; ++t) { Bl = av[t] * Bl + bv[t]; Al *= av[t]; }
            } else {
#pragma unroll
                for (int t = 15; t >= 0; --t) { Bl = av[t] * Bl + bv[t]; Al *= av[t]; }
            }
            float Ag[4], Bg[4];
#pragma unroll
            for (int g = 0; g < 4; ++g) { Ag[g] = __shfl(Al, l15 + 16 * g); Bg[g] = __shfl(Bl, l15 + 16 * g); }
            float h = hcar, hend;
            if (d == 0) {
                const float s1 = Ag[0] * h + Bg[0], s2 = Ag[1] * s1 + Bg[1], s3 = Ag[2] * s2 + Bg[2]; hend = Ag[3] * s3 + Bg[3];
                h = G4 == 0 ? h : G4 == 1 ? s1 : G4 == 2 ? s2 : s3;
            } else {
                const float s2 = Ag[3] * h + Bg[3], s1 = Ag[2] * s2 + Bg[2], s0 = Ag[1] * s1 + Bg[1]; hend = Ag[0] * s0 + Bg[0];
                h = G4 == 3 ? h : G4 == 2 ? s2 : G4 == 1 ? s1 : s0;
            }
            hcar = hend;
            if (role != 0) {
                float hv[16];
                if (d == 0) {
#pragma unroll
                    for (int t = 0; t < 16; ++t) { h = av[t] * h + bv[t]; hv[t] = h; }
                } else {
#pragma unroll
                    for (int t = 15; t >= 0; --t) { h = av[t] * h + bv[t]; hv[t] = h; }
                }
#pragma unroll
                for (int t = 0; t < 16; ++t) {
                    const int off = (16 * G4 + t) * 144 + (16 * cg + l15) * 2;
                    float o = hv[t];
                    if (role == 2) o = gelu_tanh(bf2f(*(const LAS bf16_t*)(lds + RC_RG + d * RC_T + off))) * (o + bf2f(*(const LAS bf16_t*)(lds + RC_HI + d * RC_T + off)));
                    *(LAS bf16_t*)(lds + RC_OUT + d * RC_T + off) = f2bf(o);
                }
            }
        }
        __syncthreads();
        if (role != 0) {
#pragma unroll
            for (int j = 0; j < 2; ++j) { const int q = t8 * 2 + j; const u32x4 v = *(const LAS u32x4*)(lds + RC_OUT + ds * RC_T + (q >> 3) * 144 + (q & 7) * 16);
                if (role == 1) *(u32x4*)(HT + RC_ROW(s, q) * RGW + 64 * hd + (q & 7) * 8) = v;
                else *(u32x4*)(MIX + RC_ROW(s, q) * D + HGW + 64 * hd + (q & 7) * 8) = v; }
        }
    }
#undef RC_CHUNK
#undef RC_LOAD_RX
#undef RC_ROW
#undef RC_LOAD_RG
#undef RC_LOAD_HI
}

__device__ __forceinline__ void phase_mix_finish(const bf16_t* __restrict__ P, const bf16_t* __restrict__ OF, const bf16_t* __restrict__ OB,
                                                 const float* __restrict__ hg_nw, bf16_t* __restrict__ MIX, int bid, int G) {
    constexpr int RB = 4;
    int tl_ = threadIdx.x; asm volatile("" : "+v"(tl_));
    const int lane = tl_ & 63, gw = bid * 8 + (tl_ >> 6), NW = G * 8, c0 = lane * 8;
    const f32x4 nw0 = *(const f32x4*)(hg_nw + c0), nw1 = *(const f32x4*)(hg_nw + c0 + 4);
    const float nwv[8] = {nw0[0], nw0[1], nw0[2], nw0[3], nw1[0], nw1[1], nw1[2], nw1[3]};
    for (int r0 = gw; r0 < NLAT; r0 += RB * NW) {
        u32x4 a4[RB], b4[RB], g4[RB];
#pragma unroll
        for (int q = 0; q < RB; ++q) { const int r = r0 + q * NW; const int rr = r < NLAT ? r : r0;
            a4[q] = *(const u32x4*)(OF + (size_t)rr * HGW + c0); b4[q] = *(const u32x4*)(OB + (size_t)rr * HGW + c0); g4[q] = *(const u32x4*)(P + (size_t)rr * INW + C_G + c0); }
#pragma unroll
        for (int q = 0; q < RB; ++q) { const int r = r0 + q * NW; if (r < NLAT) {
            float o[8]; float ss = 0.f;
#pragma unroll
            for (int i = 0; i < 4; ++i) { o[2 * i] = __uint_as_float(a4[q][i] << 16) + __uint_as_float(b4[q][i] << 16); o[2 * i + 1] = __uint_as_float(a4[q][i] & 0xffff0000u) + __uint_as_float(b4[q][i] & 0xffff0000u); }
#pragma unroll
            for (int i = 0; i < 8; ++i) ss += o[i] * o[i];
            ss += __shfl_xor(ss, 1); ss += __shfl_xor(ss, 2); ss += __shfl_xor(ss, 4); ss += __shfl_xor(ss, 8);
            const float rstd = __builtin_amdgcn_rsqf(ss * (1.0f / 128.0f) + EPS);
            u32x4 w;
#pragma unroll
            for (int i = 0; i < 4; ++i) {
                const float g0 = __uint_as_float(g4[q][i] << 16), g1 = __uint_as_float(g4[q][i] & 0xffff0000u);
                w[i] = cvt_pk_bf16(o[2 * i] * rstd * nwv[2 * i] * (g0 * sigmoidf_(g0)), o[2 * i + 1] * rstd * nwv[2 * i + 1] * (g1 * sigmoidf_(g1)));
            }
            *(u32x4*)(MIX + (size_t)r * D + c0) = w;
        } }
    }
}

__device__ __forceinline__ void phase_norm2_route(LAS unsigned char* lds, const bf16_t* __restrict__ x1, const float* __restrict__ nw, const float* __restrict__ mod,
                                                  const float* __restrict__ rw, const float* __restrict__ rb, fp8_t* __restrict__ H2,
                                                  u32* __restrict__ cnt, u32* __restrict__ toktab, float* __restrict__ wtab, int bid, int G) {
    LAS float* rwT = (LAS float*)lds;
    LAS u32* hist = (LAS u32*)(lds + 131072);
    LAS u32* ent = (LAS u32*)(lds + 131072 + 4096);
    int tl_ = threadIdx.x; asm volatile("" : "+v"(tl_));
    const int tid = tl_, lane = tid & 63, w = tid >> 6;
    for (int i = tid; i < 32 * 1024; i += 512) { const int k = i >> 5, e = i & 31; rwT[e * 1024 + k] = rw[i]; }
    if (tid < 128) hist[tid] = 0;
    __syncthreads();
    const int gw = bid * 8 + w, NW = G * 8;
    const int myexp = ((lane >> 5) & 1) * 16 + ((lane >> 4) & 1) * 8 + ((lane >> 3) & 1) * 4 + ((lane >> 2) & 1) * 2 + ((lane >> 1) & 1);
    const float myrb = rb[myexp];
    int it = 0;
    u32x2 rawn[2][4];
#pragma unroll
    for (int q = 0; q < 2; ++q)
#pragma unroll
        for (int j = 0; j < 4; ++j) rawn[q][j] = __builtin_nontemporal_load((const u32x2*)(x1 + (size_t)(gw + q * NW) * D + j * 256 + lane * 4));
    for (int r0 = gw; r0 < NLAT; r0 += 2 * NW, it += 2) {
        f32x4 v[2][4];
        u32x2 rawc[2][4];
#pragma unroll
        for (int q = 0; q < 2; ++q)
#pragma unroll
            for (int j = 0; j < 4; ++j) rawc[q][j] = rawn[q][j];
        { const int rn0 = r0 + 2 * NW < NLAT ? r0 + 2 * NW : r0;
#pragma unroll
          for (int q = 0; q < 2; ++q)
#pragma unroll
            for (int j = 0; j < 4; ++j) rawn[q][j] = __builtin_nontemporal_load((const u32x2*)(x1 + (size_t)(rn0 + q * NW) * D + j * 256 + lane * 4)); }
#pragma unroll
        for (int q = 0; q < 2; ++q) {
            const int r = r0 + q * NW;
            const float* m = mod + (size_t)(r >> 11) * 6144;
            u32x2 raw[4];
#pragma unroll
            for (int j = 0; j < 4; ++j) raw[j] = rawc[q][j];
            float ss = 0.f;
#pragma unroll
            for (int j = 0; j < 4; ++j) { v[q][j][0] = __uint_as_float(raw[j].x << 16); v[q][j][1] = __uint_as_float(raw[j].x & 0xffff0000u); v[q][j][2] = __uint_as_float(raw[j].y << 16); v[q][j][3] = __uint_as_float(raw[j].y & 0xffff0000u);
                ss += v[q][j][0] * v[q][j][0] + v[q][j][1] * v[q][j][1] + v[q][j][2] * v[q][j][2] + v[q][j][3] * v[q][j][3]; }
            const float rstd = __builtin_amdgcn_rsqf(wave_sum(ss) * (1.0f / D) + EPS);
#pragma unroll
            for (int j = 0; j < 4; ++j) {
                const int c0 = j * 256 + lane * 4;
                const f32x4 ww = *(const f32x4*)(nw + c0), sh = *(const f32x4*)(m + 3072 + c0), sc = *(const f32x4*)(m + 4096 + c0);
                v[q][j] = v[q][j] * rstd * ww * (sc + 1.0f) + sh;
                *(unsigned*)(H2 + (size_t)r * D + c0) = pk4_fp8(v[q][j][0] * SC_H2, v[q][j][1] * SC_H2, v[q][j][2] * SC_H2, v[q][j][3] * SC_H2);
            }
        }
        float part[2][32];
#pragma unroll
        for (int e = 0; e < 32; ++e) {
            float p0 = 0.f, p1 = 0.f;
#pragma unroll
            for (int j = 0; j < 4; ++j) { const f32x4 q = *(const LAS f32x4*)(rwT + e * 1024 + j * 256 + lane * 4);
                p0 += v[0][j][0] * q[0] + v[0][j][1] * q[1] + v[0][j][2] * q[2] + v[0][j][3] * q[3]; p1 += v[1][j][0] * q[0] + v[1][j][1] * q[1] + v[1][j][2] * q[2] + v[1][j][3] * q[3]; }
            part[0][e] = p0; part[1][e] = p1;
        }
#define RT_STEP(N, M) { const bool up = (lane & (M)) != 0; _Pragma("unroll") for (int q = 0; q < 2; ++q) _Pragma("unroll") for (int i = 0; i < (N); ++i) { const float keep = up ? part[q][(N) + i] : part[q][i], send = up ? part[q][i] : part[q][(N) + i]; part[q][i] = keep + __shfl_xor(send, (M)); } }
        RT_STEP(16, 32) RT_STEP(8, 16) RT_STEP(4, 8) RT_STEP(2, 4) RT_STEP(1, 2)
#undef RT_STEP
#pragma unroll
        for (int q = 0; q < 2; ++q) {
            const int r = r0 + q * NW;
            const float mylogit = part[q][0] + __shfl_xor(part[q][0], 1) + myrb;
            int rank = 0;
#pragma unroll
            for (int x = 0; x < 32; ++x) {
                const int src = ((x >> 4) & 1) * 32 + ((x >> 3) & 1) * 16 + ((x >> 2) & 1) * 8 + ((x >> 1) & 1) * 4 + (x & 1) * 2;
                const float oq = __builtin_bit_cast(float, __builtin_amdgcn_readlane(__builtin_bit_cast(int, mylogit), src));
                rank += (oq > mylogit || (oq == mylogit && x < myexp)) ? 1 : 0;
            }
            float tv[4]; int ti[4];
#pragma unroll
            for (int k = 0; k < 4; ++k) {
                const unsigned long long mk = __ballot(rank == k && (lane & 1) == 0);
                const int src = __builtin_amdgcn_readfirstlane((int)__builtin_ctzll(mk));
                tv[k] = __builtin_bit_cast(float, __builtin_amdgcn_readlane(__builtin_bit_cast(int, mylogit), src));
                ti[k] = ((src >> 5) & 1) * 16 + ((src >> 4) & 1) * 8 + ((src >> 3) & 1) * 4 + ((src >> 2) & 1) * 2 + ((src >> 1) & 1);
            }
            const float e1 = fexp(tv[1] - tv[0]), e2 = fexp(tv[2] - tv[0]), e3 = fexp(tv[3] - tv[0]); const float inv = frcp(1.0f + e1 + e2 + e3);
            const float g0 = inv, g1 = e1 * inv, g2 = e2 * inv, g3 = e3 * inv;
            if (lane < 4) {
                const int half = r >= HALF_TOK ? 1 : 0;
                const int e = lane == 0 ? ti[0] : lane == 1 ? ti[1] : lane == 2 ? ti[2] : ti[3];
                const float gv = lane == 0 ? g0 : lane == 1 ? g1 : lane == 2 ? g2 : g3;
                const u32 lp = atomicAdd((u32*)&hist[half * 32 + e], 1u);
                const int idx = ((it + q) * 8 + w) * 4 + lane;
                ent[idx * 2] = ((u32)e << 24) | lp; ent[idx * 2 + 1] = __float_as_uint(gv);
            }
        }
    }
    __syncthreads();
    if (tid < 64) hist[64 + tid] = atomicAdd(&cnt[tid], hist[tid]);
    __syncthreads();
    it = 0;
    for (int r = gw; r < NLAT; r += NW, ++it) {
        if (lane < 4) {
            const int half = r >= HALF_TOK ? 1 : 0; const int idx = (it * 8 + w) * 4 + lane;
            const u32 ev = ent[idx * 2]; const int e = ev >> 24; const u32 pos = hist[64 + half * 32 + e] + (ev & 0xffffffu);
            toktab[((size_t)half * 32 + e) * CAP + pos] = (u32)r * 4u + lane;
            wtab[((size_t)half * 32 + e) * CAP + pos] = __uint_as_float(ent[idx * 2 + 1]);
        }
    }
}

__device__ __forceinline__ void phase_combine(float* __restrict__ out, const bf16_t* __restrict__ X1, const fp8_t* __restrict__ Y, const float* __restrict__ mod, const float* __restrict__ fw, int bid, int G) {
    constexpr int RB = 2;
    typedef float f32x2_ __attribute__((ext_vector_type(2)));
    int tl_ = threadIdx.x; asm volatile("" : "+v"(tl_));
    const int lane = tl_ & 63, gw = bid * 8 + (tl_ >> 6), NW = G * 8;
    for (int r0 = gw; r0 < NLAT; r0 += RB * NW) {
        u32x2 xv[RB][4]; unsigned yv[RB][4][4];
#pragma unroll
        for (int q = 0; q < RB; ++q) { const int r = r0 + q * NW < NLAT ? r0 + q * NW : r0;
#pragma unroll
            for (int j = 0; j < 4; ++j) { xv[q][j] = __builtin_nontemporal_load((const u32x2*)(X1 + (size_t)r * D + j * 256 + lane * 4));
#pragma unroll
                for (int k = 0; k < 4; ++k) yv[q][j][k] = __builtin_nontemporal_load((const unsigned*)(Y + ((size_t)r * 4 + k) * D + j * 256 + lane * 4)); } }
#pragma unroll
        for (int q = 0; q < RB; ++q) { const int r = r0 + q * NW; if (r < NLAT) {
            const float* g2 = mod + (size_t)(r >> 11) * 6144 + 5120;
            f32x4 v[4]; float ss = 0.f;
#pragma unroll
            for (int j = 0; j < 4; ++j) { const int c0 = j * 256 + lane * 4;
                f32x4 sm = (f32x4){0.f, 0.f, 0.f, 0.f};
#pragma unroll
                for (int k = 0; k < 4; ++k) { const f32x2_ lo = __builtin_amdgcn_cvt_pk_f32_fp8(yv[q][j][k], false), hi = __builtin_amdgcn_cvt_pk_f32_fp8(yv[q][j][k], true); sm[0] += lo[0]; sm[1] += lo[1]; sm[2] += hi[0]; sm[3] += hi[1]; }
                const f32x4 g = *(const f32x4*)(g2 + c0);
                v[j][0] = __uint_as_float(xv[q][j].x << 16); v[j][1] = __uint_as_float(xv[q][j].x & 0xffff0000u); v[j][2] = __uint_as_float(xv[q][j].y << 16); v[j][3] = __uint_as_float(xv[q][j].y & 0xffff0000u);
                v[j] = v[j] + g * sm * (1.0f / SC_Y);
                ss += v[j][0] * v[j][0] + v[j][1] * v[j][1] + v[j][2] * v[j][2] + v[j][3] * v[j][3]; }
            const float rstd = __builtin_amdgcn_rsqf(wave_sum(ss) * (1.0f / D) + EPS);
#pragma unroll
            for (int j = 0; j < 4; ++j) { const int c0 = j * 256 + lane * 4; const f32x4 w = *(const f32x4*)(fw + c0); __builtin_nontemporal_store(v[j] * rstd * w, (f32x4*)(out + (size_t)r * D + c0)); }
        } }
    }
}

#define XB_TMO      128
#define XB_XCNT(j)  (256  + 64 * (j))
#define XB_XSUB(j)  (1280 + 64 * (j))
#define XB_XGEN(j)  (2304 + 64 * (j))
#define XB_TOP      3328
#define XB_TOPGEN   3392
#define XCD_BAR_WORDS 3456
#define XB_SPIN_CAP (1u << 20)
__device__ __forceinline__ unsigned xb_ld(unsigned* p)              { return __hip_atomic_load(p, __ATOMIC_RELAXED, __HIP_MEMORY_SCOPE_AGENT); }
__device__ __forceinline__ unsigned xb_add(unsigned* p, unsigned v) { return __hip_atomic_fetch_add(p, v, __ATOMIC_RELAXED, __HIP_MEMORY_SCOPE_AGENT); }
__device__ __forceinline__ unsigned xb_xcc_id() { return (unsigned)__builtin_amdgcn_s_getreg((3 << 11) | 20) & 0xFu; }
#define XB_SPIN(cond, bar) do { unsigned _sp = 0; while (cond) { __builtin_amdgcn_s_sleep(1); \
    if ((++_sp & 255u) == 0u) { if (xb_ld(&(bar)[XB_TMO])) break; if (_sp > XB_SPIN_CAP) { atomicAdd(&(bar)[XB_TMO], 1u); break; } } } } while (0)
struct XcdBarrier { unsigned* bar; unsigned x; volatile LAS unsigned* st; };
__device__ __forceinline__ XcdBarrier xcd_barrier_post(unsigned* bar, volatile LAS unsigned* st) {
    XcdBarrier b; b.bar = bar; b.x = xb_xcc_id(); b.st = st;
    if (threadIdx.x == 0) (void)xb_add(&bar[XB_XCNT(b.x)], 1u);
    return b;
}
__device__ __forceinline__ void xcd_barrier_complete(unsigned* bar, unsigned x, unsigned& nloc, unsigned& nx) {
    const unsigned G = gridDim.x * gridDim.y * gridDim.z;
    unsigned sum, cnt, mine, sp = 0u;
    for (;;) {
        sum = 0u; cnt = 0u; mine = 0u;
#pragma unroll
        for (unsigned j = 0; j < 16; ++j) { const unsigned c = xb_ld(&bar[XB_XCNT(j)]); sum += c; cnt += (c > 0u) ? 1u : 0u; mine = (j == x) ? c : mine; }
        if (sum == G) break;
        __builtin_amdgcn_s_sleep(1);
        if ((++sp & 255u) == 0u) { if (xb_ld(&bar[XB_TMO])) break; if (sp > XB_SPIN_CAP) { atomicAdd(&bar[XB_TMO], 1u); break; } }
    }
    nloc = mine > 0u ? mine : 1u; nx = cnt > 0u ? cnt : 1u;
}
__device__ __forceinline__ void xcd_barrier(unsigned* bar, volatile LAS unsigned* st) {
    asm volatile("s_waitcnt vmcnt(0)" ::: "memory");
    __syncthreads();
    if (threadIdx.x == 0) {
        __builtin_amdgcn_s_waitcnt(0);
        const unsigned x = xb_xcc_id();
        unsigned nloc = st[0], nx = st[1];
        if (nloc == 0u) { xcd_barrier_complete(bar, x, nloc, nx); st[0] = nloc; st[1] = nx; }
        const unsigned old = xb_add(&bar[XB_XSUB(x)], 1u);
        const unsigned gen = old / nloc;
        if (old + 1u == (gen + 1u) * nloc) {
            __builtin_amdgcn_fence(__ATOMIC_RELEASE, "agent");
            asm volatile("s_waitcnt vmcnt(0)" ::: "memory");
            const unsigned og = xb_add(&bar[XB_TOP], 1u);
            const unsigned tg = og / nx;
            if (og + 1u == (tg + 1u) * nx) xb_add(&bar[XB_TOPGEN], 1u);
            else XB_SPIN(xb_ld(&bar[XB_TOPGEN]) == tg, bar);
            __builtin_amdgcn_fence(__ATOMIC_ACQUIRE, "agent");
            xb_add(&bar[XB_XGEN(x)], 1u);
            asm volatile("s_waitcnt vmcnt(0)" ::: "memory");
        } else {
            XB_SPIN(xb_ld(&bar[XB_XGEN(x)]) == gen, bar);
            __builtin_amdgcn_fence(__ATOMIC_ACQUIRE, "agent");
            asm volatile("s_waitcnt vmcnt(0)" ::: "memory");
        }
    }
    __syncthreads();
}
constexpr size_t WS_BAR = 16384;
constexpr int LDS_BARST = LDS_BYTES - 16;

struct MegaArgs {
    const float *x, *c, *ctx, *c_ctx, *norm1_w, *norm2_w, *w_ada, *b_ada, *w_in, *lbl, *hg_nw, *conv_w, *conv_b, *rg_wa, *rg_ba, *rg_wx, *rg_bx, *rg_lam, *w_out,
        *router_w, *router_b, *wgu, *bgu, *wd, *bd, *final_w;
    float* out; unsigned char* ws;
};
typedef const MegaArgs __attribute__((address_space(4)))* KArgs;
__device__ __forceinline__ KArgs kargs() { auto p = __builtin_amdgcn_kernarg_segment_ptr(); asm volatile("" : "+s"(p)); return (KArgs)p; }
#define WSP(T, off) ((T*)(ws + (off)))
#define GRID_SYNC_CG() cg::this_grid().sync()
#define GRID_SYNC() do { KArgs a_ = kargs(); xcd_barrier((unsigned*)(a_->ws + WS_BAR), (volatile LAS unsigned*)(lds + LDS_BARST)); } while (0)
__global__ __launch_bounds__(512, 2) void k_mega(MegaArgs a_unused) {
    extern __shared__ __attribute__((aligned(16))) unsigned char lds_[];
    LAS unsigned char* lds = (LAS unsigned char*)lds_;
    if (threadIdx.x < 4) ((volatile LAS unsigned*)(lds + LDS_BARST))[threadIdx.x] = 0u;
    __syncthreads();
    { KArgs a = kargs(); (void)xcd_barrier_post((unsigned*)(a->ws + WS_BAR), (volatile LAS unsigned*)(lds + LDS_BARST)); }
    { KArgs a = kargs(); unsigned char* ws = a->ws; const int bid = blockIdx.x, G = gridDim.x;
      ProArgs pa; pa.c = a->c; pa.c_ctx = a->c_ctx; pa.w_ada = a->w_ada; pa.b_ada = a->b_ada; pa.lbl = a->lbl; pa.w_in = a->w_in; pa.w_out = a->w_out; pa.wgu = a->wgu; pa.wd = a->wd; pa.rg_wa = a->rg_wa; pa.rg_wx = a->rg_wx; pa.rg_lam = a->rg_lam;
      pa.coef = WSP(float, WS_COEF); pa.WG_t = WSP(bf16_t, WS_WG); pa.mod = WSP(float, WS_MOD); pa.lb = WSP(float, WS_LB); pa.Win_t = WSP(bf16_t, WS_WIN); pa.Wout_t = WSP(bf16_t, WS_WOUT); pa.Wgu_t = WSP(fp8_t, WS_WGU); pa.Wd_t = WSP(fp8_t, WS_WD);
      phase_prologue(lds, pa, bid, G, true, 0, 0); }
    { KArgs a_ = kargs(); if (a_->ws == nullptr) GRID_SYNC_CG(); }
    GRID_SYNC();
    { KArgs a = kargs(); unsigned char* ws = a->ws; phase_norm1(a->x, a->ctx, a->norm1_w, WSP(float, WS_MOD), WSP(bf16_t, WS_H), blockIdx.x, gridDim.x); }
    { KArgs a = kargs(); unsigned char* ws = a->ws;
      ProArgs pa; pa.c = nullptr; pa.c_ctx = nullptr; pa.w_ada = nullptr; pa.b_ada = nullptr; pa.lbl = nullptr; pa.w_in = a->w_in; pa.w_out = a->w_out; pa.wgu = nullptr; pa.wd = nullptr; pa.rg_wa = nullptr; pa.rg_wx = nullptr; pa.rg_lam = nullptr; pa.coef = nullptr; pa.WG_t = nullptr;
      pa.mod = nullptr; pa.lb = nullptr; pa.Win_t = WSP(bf16_t, WS_WIN); pa.Wout_t = WSP(bf16_t, WS_WOUT); pa.Wgu_t = nullptr; pa.Wd_t = nullptr;
      phase_prologue(lds, pa, blockIdx.x, gridDim.x, false, 0, IT_IN + IT_OUT); }
    GRID_SYNC();
    { KArgs a = kargs(); unsigned char* ws = a->ws; PolInProj P; P.A = WSP(bf16_t, WS_H); P.Bt = WSP(bf16_t, WS_WIN); P.O = WSP(bf16_t, WS_PROJ); P.ord.init(NLAT / BM, INW / BM, gridDim.x, blockIdx.x); gemm_phase(lds, P); }
    GRID_SYNC();
    { KArgs a = kargs(); unsigned char* ws = a->ws;
      for (int item = blockIdx.x; item < 256; item += gridDim.x)
          phase_rg_chain(lds, WSP(bf16_t, WS_PROJ), a->conv_w, a->conv_b, WSP(bf16_t, WS_WG), a->rg_ba, a->rg_bx, WSP(float, WS_COEF), WSP(bf16_t, WS_HF), WSP(bf16_t, WS_MIX2), item); }
    __syncthreads();
    { KArgs a = kargs(); unsigned char* ws = a->ws;
      for (int item = blockIdx.x; item < 256; item += gridDim.x) phase_hgrn2_ws(lds, WSP(bf16_t, WS_PROJ), WSP(float, WS_LB), WSP(bf16_t, WS_OF), WSP(bf16_t, WS_OB), item); }
    GRID_SYNC();
    { KArgs a = kargs(); unsigned char* ws = a->ws; phase_mix_finish(WSP(bf16_t, WS_PROJ), WSP(bf16_t, WS_OF), WSP(bf16_t, WS_OB), a->hg_nw, WSP(bf16_t, WS_MIX2), blockIdx.x, gridDim.x); }
    GRID_SYNC();
    { KArgs a = kargs(); unsigned char* ws = a->ws; PolOutProj P; P.A = WSP(bf16_t, WS_MIX2); P.Bt = WSP(bf16_t, WS_WOUT); P.x = a->x; P.mod = WSP(float, WS_MOD); P.O = WSP(bf16_t, WS_X1); P.ord.init(NLAT / BM, D / BM, gridDim.x, blockIdx.x); gemm_phase(lds, P); }
    GRID_SYNC();
    { KArgs a = kargs(); unsigned char* ws = a->ws;
      phase_norm2_route(lds, WSP(bf16_t, WS_X1), a->norm2_w, WSP(float, WS_MOD), a->router_w, a->router_b, WSP(fp8_t, WS_H2), WSP(u32, WS_CTL), WSP(u32, WS_TOKTAB), WSP(float, WS_WTAB), blockIdx.x, gridDim.x); }
    __syncthreads();
    { KArgs a = kargs(); unsigned char* ws = a->ws;
      ProArgs pa; pa.c = nullptr; pa.c_ctx = nullptr; pa.w_ada = nullptr; pa.b_ada = nullptr; pa.lbl = nullptr; pa.w_in = nullptr; pa.w_out = nullptr; pa.wgu = a->wgu; pa.wd = a->wd; pa.rg_wa = nullptr; pa.rg_wx = nullptr; pa.rg_lam = nullptr; pa.coef = nullptr; pa.WG_t = nullptr;
      pa.mod = nullptr; pa.lb = nullptr; pa.Win_t = nullptr; pa.Wout_t = nullptr; pa.Wgu_t = WSP(fp8_t, WS_WGU); pa.Wd_t = WSP(fp8_t, WS_WD);
      phase_prologue(lds, pa, blockIdx.x, gridDim.x, false, IT_IN + IT_OUT, IT_ALL); }
    GRID_SYNC();
#pragma unroll 1
    for (int half = 0; half < NHALF; ++half) {
        { KArgs a = kargs(); unsigned char* ws = a->ws; LAS int* tstart = (LAS int*)(lds + LDS_AUX);
          const int tot = moe_tile_table(tstart, WSP(u32, WS_CTL), half);
          PolGateUp P; P.A = WSP(fp8_t, WS_H2); P.Bt = WSP(fp8_t, WS_WGU); P.bgu = a->bgu; P.toktab = WSP(u32, WS_TOKTAB); P.wtab = WSP(float, WS_WTAB); P.O = WSP(fp8_t, WS_ACT); P.mt.tstart = tstart; P.mt.cnt = WSP(u32, WS_CTL); P.mt.half = half;
          P.ord.init(tot, DFF / HALFT, gridDim.x, blockIdx.x);
          gemm_phase(lds, P); }
        GRID_SYNC();
        { KArgs a = kargs(); unsigned char* ws = a->ws; LAS int* tstart = (LAS int*)(lds + LDS_AUX);
          const int tot = moe_tile_table(tstart, WSP(u32, WS_CTL), half);
          {
              const u32x4* wp = (const u32x4*)WSP(fp8_t, WS_WD) + (size_t)blockIdx.x * 8192 + threadIdx.x; u32x4 acc_ = (u32x4){0u, 0u, 0u, 0u};
#pragma unroll
              for (int i = 0; i < 16; ++i) acc_ |= wp[i * 512];
              asm volatile("" :: "v"(acc_));
          }
          PolDown P; P.A = WSP(fp8_t, WS_ACT); P.Bt = WSP(fp8_t, WS_WD); P.bd = a->bd; P.toktab = WSP(u32, WS_TOKTAB); P.wtab = WSP(float, WS_WTAB); P.O = WSP(fp8_t, WS_Y); P.mt.tstart = tstart; P.mt.cnt = WSP(u32, WS_CTL); P.mt.half = half;
          P.ord.init(tot, D / BM, gridDim.x, blockIdx.x);
          gemm_phase(lds, P); }
        GRID_SYNC();
        { KArgs a = kargs(); unsigned char* ws = a->ws; phase_combine(a->out, WSP(bf16_t, WS_X1), WSP(fp8_t, WS_Y), WSP(float, WS_MOD), a->final_w, blockIdx.x, gridDim.x); }
        __syncthreads();
    }
}

extern "C" void kernel_launch(void* const* d_in, const int* in_sizes, int n_in, void* d_out, int out_size, void* d_ws, size_t ws_size, hipStream_t stream) {
    static int grid_blocks = 0;
    if (!grid_blocks) {
        int dev = 0, cus = 0, per_cu = 0;
        (void)hipGetDevice(&dev);
        (void)hipDeviceGetAttribute(&cus, hipDeviceAttributeMultiprocessorCount, dev);
        (void)hipFuncSetAttribute((const void*)k_mega, hipFuncAttributeMaxDynamicSharedMemorySize, LDS_BYTES);
        (void)hipOccupancyMaxActiveBlocksPerMultiprocessor(&per_cu, (const void*)k_mega, 512, LDS_BYTES);
        if (per_cu < 1) { fprintf(stderr, "kernel_launch: occupancy query says %d blocks/CU\n", per_cu); per_cu = 1; }
        grid_blocks = cus * 1;
    }
    if (ws_size < 1024 * MiB) { fprintf(stderr, "kernel_launch: workspace too small (%zu)\n", ws_size); return; }
    MegaArgs a{};
    const float** ap = (const float**)&a;
    for (int i = 0; i < 26; ++i) ap[i] = (const float*)d_in[i];
    a.out = (float*)d_out; a.ws = (unsigned char*)d_ws;
    (void)hipMemsetAsync((unsigned char*)d_ws + WS_CTL, 0, 32768, stream);
    void* args[] = {&a};
    hipError_t e = hipLaunchCooperativeKernel((const void*)k_mega, dim3(grid_blocks), dim3(512), args, LDS_BYTES, stream);
    if (e != hipSuccess) fprintf(stderr, "cooperative launch failed: %s (grid %d)\n", hipGetErrorString(e), grid_blocks);
}
```
